# Optimizing an MI355X kernel written in HIP

```python
import math
import jax, jax.numpy as jnp
from jax import lax
import numpy as np

D_MODEL = 2048
BATCH = 8
SEQ = 2048
DEPTH = 1

MIX_WIDTH = D_MODEL
ATTN_WIDTH = D_MODEL // 2
CONV_WIDTH = MIX_WIDTH - ATTN_WIDTH
DIFF_HEAD_DIM = 64
N_DIFF_HEADS = ATTN_WIDTH // (2 * DIFF_HEAD_DIM)
DIFF_V_DIM = 2 * DIFF_HEAD_DIM
Q_BLOCK = 128
CONV_K = 3
IN_COLS = 3 * ATTN_WIDTH + 3 * CONV_WIDTH
PEER_HEADS = 8
PEER_N_KEYS = 128
PEER_N_EXPERTS = PEER_N_KEYS * PEER_N_KEYS
PEER_QUERY_DIM = 256
PEER_HALF = PEER_QUERY_DIM // 2
PEER_TOPK = 16
TOKEN_BLOCK = 128
EPS = 1e-6

kernel_name = "hymba_diffattn_shortconv_peer"


def _rms(x, g):
    xf = x.astype(jnp.float32)
    y = xf * lax.rsqrt(jnp.mean(xf * xf, axis=-1, keepdims=True) + EPS)
    return (y * g.astype(jnp.float32)).astype(x.dtype)


def _alibi_slopes(n):
    return jnp.exp2(-8.0 * jnp.arange(1, n + 1, dtype=jnp.float32) / n)


def _diff_attention(q, k, v, lam):
    b, s, h, _, d = q.shape
    nb = s // Q_BLOCK
    scale = 1.0 / math.sqrt(d)
    slopes = _alibi_slopes(h)
    key_pos = jnp.arange(s, dtype=jnp.int32)
    q_blocks = jnp.moveaxis(q.reshape(b, nb, Q_BLOCK, h, 2, d), 1, 0)
    starts = jnp.arange(nb, dtype=jnp.int32) * Q_BLOCK

    def one_block(args):
        qb, start = args
        scores = jnp.einsum("bqhcd,bkhcd->bhcqk", qb, k).astype(jnp.float32) * scale
        q_pos = start + jnp.arange(Q_BLOCK, dtype=jnp.int32)
        dist = (q_pos[:, None] - key_pos[None, :]).astype(jnp.float32)
        scores = scores - slopes[:, None, None, None] * dist
        scores = jnp.where(dist >= 0, scores, -jnp.inf)
        p = jax.nn.softmax(scores, axis=-1)
        a = p[:, :, 0] - lam * p[:, :, 1]
        return jnp.einsum("bhqk,bkhe->bqhe", a.astype(v.dtype), v)

    out = lax.map(one_block, (q_blocks, starts))
    return jnp.moveaxis(out, 0, 1).reshape(b, s, h, v.shape[-1])


def _short_conv(bg, cg, xc, w):
    s = xc.shape[1]
    u = cg * xc
    up = jnp.pad(u, ((0, 0), (CONV_K - 1, 0), (0, 0)))
    y = up[:, 0:s] * w[0]
    for j in range(1, CONV_K):
        y = y + up[:, j:j + s] * w[j]
    return bg * y


def _peer(h, w_q, subkeys, u, v):
    b, s, dm = h.shape
    t = b * s
    ht = h.reshape(t, dm)
    q = (ht @ w_q).reshape(t, PEER_HEADS, 2, PEER_HALF)
    sc = jnp.einsum("thcd,hckd->thck", q, subkeys).astype(jnp.float32)
    s1, i1 = lax.top_k(sc[:, :, 0], PEER_TOPK)
    s2, i2 = lax.top_k(sc[:, :, 1], PEER_TOPK)
    cand = (s1[..., :, None] + s2[..., None, :]).reshape(t, PEER_HEADS, PEER_TOPK * PEER_TOPK)
    top, idx = lax.top_k(cand, PEER_TOPK)
    e1 = jnp.take_along_axis(i1, idx // PEER_TOPK, axis=-1)
    e2 = jnp.take_along_axis(i2, idx % PEER_TOPK, axis=-1)
    experts = (e1 * PEER_N_KEYS + e2).reshape(t, PEER_HEADS * PEER_TOPK)
    gates = jax.nn.softmax(top, axis=-1).reshape(t, PEER_HEADS * PEER_TOPK)
    nblk = t // TOKEN_BLOCK

    def one_block(args):
        hb, eb, gb = args
        ug = jnp.take(u, eb, axis=0)
        vg = jnp.take(v, eb, axis=0)
        act = jax.nn.gelu(jnp.einsum("tkd,td->tk", ug, hb), approximate=False) * gb.astype(hb.dtype)
        return jnp.einsum("tk,tkd->td", act, vg)

    out = lax.map(one_block, (ht.reshape(nblk, TOKEN_BLOCK, dm),
                              experts.reshape(nblk, TOKEN_BLOCK, -1),
                              gates.reshape(nblk, TOKEN_BLOCK, -1)))
    return out.reshape(b, s, dm)


def setup_inputs(seed: int = 0) -> dict:
    key = jax.random.key(seed)
    ks = jax.random.split(key, 17)

    def nrm(k, shape, scale):
        return jax.random.normal(k, shape, jnp.float32) * scale

    return {
        "x": nrm(ks[0], (BATCH, SEQ, D_MODEL), 1.0),
        "attn_norm_g": 1.0 + nrm(ks[1], (DEPTH, D_MODEL), 0.02),
        "w_in": nrm(ks[2], (DEPTH, D_MODEL, IN_COLS), D_MODEL ** -0.5),
        "q_norm_g": 1.0 + nrm(ks[3], (DEPTH, DIFF_HEAD_DIM), 0.02),
        "k_norm_g": 1.0 + nrm(ks[4], (DEPTH, DIFF_HEAD_DIM), 0.02),
        "lambda_q1": nrm(ks[5], (DEPTH, DIFF_HEAD_DIM), 0.1),
        "lambda_k1": nrm(ks[6], (DEPTH, DIFF_HEAD_DIM), 0.1),
        "lambda_q2": nrm(ks[7], (DEPTH, DIFF_HEAD_DIM), 0.1),
        "lambda_k2": nrm(ks[8], (DEPTH, DIFF_HEAD_DIM), 0.1),
        "subln_g": 1.0 + nrm(ks[9], (DEPTH, DIFF_V_DIM), 0.02),
        "conv_w": nrm(ks[10], (DEPTH, CONV_K, CONV_WIDTH), CONV_K ** -0.5),
        "w_out": nrm(ks[11], (DEPTH, MIX_WIDTH, D_MODEL), MIX_WIDTH ** -0.5),
        "ffn_norm_g": 1.0 + nrm(ks[12], (DEPTH, D_MODEL), 0.02),
        "peer_w_q": nrm(ks[13], (DEPTH, D_MODEL, PEER_HEADS * PEER_QUERY_DIM), D_MODEL ** -0.5),
        "peer_subkeys": nrm(ks[14], (DEPTH, PEER_HEADS, 2, PEER_N_KEYS, PEER_HALF), PEER_HALF ** -0.5),
        "peer_u": nrm(ks[15], (DEPTH, PEER_N_EXPERTS, D_MODEL), D_MODEL ** -0.5),
        "peer_v": nrm(ks[16], (DEPTH, PEER_N_EXPERTS, D_MODEL), 0.5),
    }


def reference(x, attn_norm_g, w_in, q_norm_g, k_norm_g, lambda_q1, lambda_k1, lambda_q2, lambda_k2,
              subln_g, conv_w, w_out, ffn_norm_g, peer_w_q, peer_subkeys, peer_u, peer_v):
    b, s, _ = x.shape
    splits = [ATTN_WIDTH, 2 * ATTN_WIDTH, 3 * ATTN_WIDTH,
              3 * ATTN_WIDTH + CONV_WIDTH, 3 * ATTN_WIDTH + 2 * CONV_WIDTH]
    for l in range(DEPTH):
        h = _rms(x, attn_norm_g[l])
        proj = h @ w_in[l]
        q, k, v, cb, cc, cx = jnp.split(proj, splits, axis=-1)
        q = _rms(q.reshape(b, s, N_DIFF_HEADS, 2, DIFF_HEAD_DIM), q_norm_g[l])
        k = _rms(k.reshape(b, s, N_DIFF_HEADS, 2, DIFF_HEAD_DIM), k_norm_g[l])
        v = v.reshape(b, s, N_DIFF_HEADS, DIFF_V_DIM)
        lam_init = 0.8 - 0.6 * math.exp(-0.3 * l)
        lam = (jnp.exp(jnp.sum(lambda_q1[l].astype(jnp.float32) * lambda_k1[l].astype(jnp.float32)))
               - jnp.exp(jnp.sum(lambda_q2[l].astype(jnp.float32) * lambda_k2[l].astype(jnp.float32)))
               + lam_init)
        a = _diff_attention(q, k, v, lam)
        a = (_rms(a, subln_g[l]) * (1.0 - lam_init)).reshape(b, s, ATTN_WIDTH)
        c = _short_conv(cb, cc, cx, conv_w[l])
        x = x + jnp.concatenate([a, c], axis=-1) @ w_out[l]
        x = x + _peer(_rms(x, ffn_norm_g[l]), peer_w_q[l], peer_subkeys[l], peer_u[l], peer_v[l])
    return x
```

```cpp
#include <hip/hip_runtime.h>
#include <hip/hip_cooperative_groups.h>
#include <cstdio>
#include <cstdint>
#include <cmath>
namespace cg = cooperative_groups;
namespace pg8 {
#define PG8_LAS __attribute__((address_space(3)))
typedef unsigned short bf16_t;
typedef short bf16x8 __attribute__((ext_vector_type(8)));
typedef float f32x4 __attribute__((ext_vector_type(4)));
typedef unsigned u32x4 __attribute__((ext_vector_type(4)));
constexpr int BM = 256, BK = 64, HALF = 128, HTB = HALF * BK * 2  , STAGE_BYTES = 8 * HTB, NXCD = 8, WGM = 8;

__host__ __device__ __forceinline__ int lds_byte(int r, int c) { const int st = (r >> 4) * 2 + (c >> 5), rr = r & 15, cc = c & 31, ob = rr * 64 + cc * 2; return st * 1024 + (ob ^ (((ob >> 9) & 1) << 5)); }
__host__ __device__ __forceinline__ void stage_rc(int b, int& R, int& C) { const int st = b / 1024, sb = b % 1024, swz = sb ^ (((sb >> 9) & 1) << 5); R = (st >> 1) * 16 + swz / 64; C = (st & 1) * 32 + (swz % 64) / 2; }
__host__ __device__ __forceinline__ int perm32(int rho) { const int n = rho >> 4, i = rho & 15; return 8 * (i >> 2) + 4 * n + (i & 3); }

struct Unit { int pm, pn; };
struct Gemm { const bf16_t* A; const bf16_t* Bt; int M, N, K; };

struct StaticOrder {
    int nM, nN, nwg, G, c;
    __host__ __device__ void init(int M, int N, int G_, int c_) { nM = M / BM; nN = N / BM; nwg = nM * nN; G = G_; c = c_; }
    __host__ __device__ bool next(int i, Unit& u) const {
        const long L = (long)i * G + c; if (L >= nwg) return false;
        int wgid = (int)L; { const int q = nwg / NXCD, r = nwg % NXCD, xcd = wgid % NXCD, off = wgid / NXCD; wgid = (xcd < r ? xcd * (q + 1) : r * (q + 1) + (xcd - r) * q) + off; }
        const int nig = WGM * nN, gid = wgid / nig, fm = gid * WGM, gsz = (nM - fm) < WGM ? (nM - fm) : WGM;
        u.pm = fm + ((wgid % nig) % gsz); u.pn = (wgid % nig) / gsz; return true;
    }
    __device__ __forceinline__ void a_ready(const Unit&) const {}
    __device__ __forceinline__ void done(const Unit&) const {}
};

__device__ __forceinline__ unsigned cvt_pk_bf16(float lo, float hi) { unsigned r; asm volatile("v_cvt_pk_bf16_f32 %0, %1, %2" : "=v"(r) : "v"(lo), "v"(hi)); return r; }
typedef float f32x2 __attribute__((ext_vector_type(2)));
__device__ __forceinline__ f32x2 gelu_pk(f32x2 v) {
    const f32x2 av = __builtin_elementwise_abs(v), d = av * 0.2316418882f + 1.0f;
    f32x2 t; t.x = __builtin_amdgcn_rcpf(d.x); t.y = __builtin_amdgcn_rcpf(d.y);
    f32x2 q = t * 0.5307027145f + (-0.7265760135f); q = q * t + 0.7107068705f; q = q * t + (-0.142248368f); q = q * t + 0.127414796f; q = q * t;
    const f32x2 s = (v * v) * (-0.72134752044f);
    f32x2 e; e.x = __builtin_amdgcn_exp2f(s.x); e.y = __builtin_amdgcn_exp2f(s.y);
    const f32x2 m = v * (q * e), r = v - m;
    f32x2 o; o.x = v.x < 0.f ? m.x : r.x; o.y = v.y < 0.f ? m.y : r.y; return o;
}

template <int ACT  > struct EpiBf16 {
    static constexpr bool PERM = true, AFTER_DRAIN = false; static_assert(ACT == 0 || ACT == 1, "EpiBf16: ACT is 0 (none) or 1 (gelu_pk)");
    bf16_t* O; int ldc; const float* bias; int split_cols; size_t split_stride; float scale0;
    __device__ __forceinline__ void operator()(const f32x4 (&acc)[2][2][4][2], const Unit& u, int wr, int wc, int fr, int fq) const {
        const int row0 = u.pm * BM + wr * 64 + fr; int colt = u.pn * BM; bf16_t* base = O;
        float sc = 1.f; if (split_cols) { const int t = colt / split_cols; base += (size_t)t * split_stride; colt -= t * split_cols; if (t == 0) sc = scale0; }
        const int col0 = colt + wc * 32 + 8 * fq, bcol0 = u.pn * BM + wc * 32 + 8 * fq;
        f32x4 bv[2][2];
#pragma unroll
        for (int bj = 0; bj < 2; ++bj)
#pragma unroll
            for (int n = 0; n < 2; ++n) bv[bj][n] = bias ? *(const f32x4*)(bias + bcol0 + bj * HALF + 4 * n) : (f32x4){0.f, 0.f, 0.f, 0.f};
#pragma unroll
        for (int ai = 0; ai < 2; ++ai)
#pragma unroll
            for (int m = 0; m < 4; ++m) { bf16_t* rowp = base + (size_t)(row0 + ai * HALF + m * 16) * ldc + col0;
#pragma unroll
                for (int bj = 0; bj < 2; ++bj) { f32x4 v0 = acc[ai][bj][m][0] + bv[bj][0], v1 = acc[ai][bj][m][1] + bv[bj][1];
                    if (ACT == 1) { f32x2 a = gelu_pk((f32x2){v0[0], v0[1]}), b = gelu_pk((f32x2){v0[2], v0[3]}), c = gelu_pk((f32x2){v1[0], v1[1]}), d = gelu_pk((f32x2){v1[2], v1[3]});
                        v0 = (f32x4){a.x, a.y, b.x, b.y}; v1 = (f32x4){c.x, c.y, d.x, d.y}; }
                    v0 = v0 * sc; v1 = v1 * sc; u32x4 w; w.x = cvt_pk_bf16(v0[0], v0[1]); w.y = cvt_pk_bf16(v0[2], v0[3]); w.z = cvt_pk_bf16(v1[0], v1[1]); w.w = cvt_pk_bf16(v1[2], v1[3]);
                    *(u32x4*)(rowp + bj * HALF) = w; } }
    }
};
template <class Epi, class Sched, bool ALIGN_EPI = false, bool SP2 = false>
__device__ __forceinline__ void gemm_phase(PG8_LAS unsigned char* lds, const Gemm g, const Sched& S, const Epi& E) {
    const int tid = threadIdx.x, wid = __builtin_amdgcn_readfirstlane(tid >> 6), lane = tid & 63, wr = wid >> 2, wc = wid & 3, fr = lane & 15, fq = lane >> 4;
    const int K = g.K, nt = K / BK;
    unsigned voffA[2], voffB[2];
#pragma unroll
    for (int i = 0; i < 2; ++i) { int R, C; stage_rc(tid * 16 + i * 8192, R, C); const int Rb = Epi::PERM ? ((R & ~31) + perm32(R & 31)) : R;
        voffA[i] = (unsigned)(R * K + C) * 2u; voffB[i] = (unsigned)(Rb * K + C) * 2u; }
    const size_t kstep = (size_t)(BK * 2);
    const size_t hstep = (size_t)HALF * K * 2;
    const size_t tstep = 2 * hstep;
    const unsigned ldsw = (unsigned)wid * 1024u;
    const int aoff = lds_byte(wr * 64 + fr, fq * 8), boff = lds_byte(wc * 32 + fr, fq * 8);
#define PG8_SA(b, h) (((b) * 2 + (h)) * HTB)
#define PG8_SB(b, h) ((4 + (b) * 2 + (h)) * HTB)
#define PG8_STAGE(bufoff, gbase, voff) do { _Pragma("unroll") for (int _i = 0; _i < 2; ++_i) \
        __builtin_amdgcn_global_load_lds((const unsigned*)((const char*)(gbase) + (voff)[_i]), (PG8_LAS unsigned*)(lds + (bufoff) + ldsw + _i * 8192), 16, 0, 0); } while (0)
#define PG8_LDA(dst, b, h) do { _Pragma("unroll") for (int m = 0; m < 4; ++m) _Pragma("unroll") for (int k = 0; k < 2; ++k) dst[m][k] = *(const PG8_LAS bf16x8*)(lds + PG8_SA(b, h) + aoff + m * 2048 + k * 1024); } while (0)
#define PG8_LDB(dst, b, h) do { _Pragma("unroll") for (int n = 0; n < 2; ++n) _Pragma("unroll") for (int k = 0; k < 2; ++k) dst[n][k] = *(const PG8_LAS bf16x8*)(lds + PG8_SB(b, h) + boff + n * 2048 + k * 1024); } while (0)
#define PG8_MMA(ai, bj, At, Bt) do { __builtin_amdgcn_s_setprio(1); _Pragma("unroll") for (int m = 0; m < 4; ++m) _Pragma("unroll") for (int n = 0; n < 2; ++n) _Pragma("unroll") for (int k = 0; k < 2; ++k) \
        acc[ai][bj][m][n] = __builtin_amdgcn_mfma_f32_16x16x32_bf16(Bt[n][k], At[m][k], acc[ai][bj][m][n], 0, 0, 0); __builtin_amdgcn_s_setprio(0); } while (0)
#define PG8_WAIT_V(n) asm volatile("s_waitcnt vmcnt(" #n ")" ::: "memory")
#define PG8_WAIT_L(n) asm volatile("s_waitcnt lgkmcnt(" #n ")" ::: "memory")
#define PG8_BAR __builtin_amdgcn_s_barrier()
#define PG8_SCHED __builtin_amdgcn_sched_barrier(0)
    Unit cur, nxt; int ui = 0;
    if (!S.next(0, cur)) return;
    f32x4 acc[2][2][4][2];
#pragma unroll
    for (int a = 0; a < 2; ++a)
#pragma unroll
        for (int b = 0; b < 2; ++b)
#pragma unroll
            for (int m = 0; m < 4; ++m)
#pragma unroll
                for (int n = 0; n < 2; ++n) acc[a][b][m][n] = (f32x4){0.f, 0.f, 0.f, 0.f};
    bf16x8 At[4][2], B0[2][2], B1[2][2];
    const char* cA = (const char*)g.A + (size_t)cur.pm * tstep; const char* cB = (const char*)g.Bt + (size_t)cur.pn * tstep;
    S.a_ready(cur);
    if constexpr (SP2) {
        PG8_STAGE(PG8_SB(0, 0), cB, voffB); PG8_STAGE(PG8_SB(0, 1), cB + hstep, voffB); PG8_STAGE(PG8_SA(0, 0), cA, voffA); PG8_STAGE(PG8_SA(0, 1), cA + hstep, voffA);
        if (wr == 1) PG8_BAR;
        PG8_WAIT_V(2); PG8_BAR;
        PG8_STAGE(PG8_SB(1, 0), cB + kstep, voffB); PG8_STAGE(PG8_SA(1, 0), cA + kstep, voffA); PG8_STAGE(PG8_SB(1, 1), cB + hstep + kstep, voffB);
        PG8_WAIT_V(6); PG8_BAR;
    } else {
        PG8_STAGE(PG8_SB(0, 0), cB, voffB); PG8_STAGE(PG8_SA(0, 0), cA, voffA); PG8_STAGE(PG8_SB(0, 1), cB + hstep, voffB); PG8_STAGE(PG8_SA(0, 1), cA + hstep, voffA);
        if (wr == 1) PG8_BAR;
        PG8_WAIT_V(4); PG8_BAR;
        PG8_STAGE(PG8_SB(1, 0), cB + kstep, voffB); PG8_STAGE(PG8_SA(1, 0), cA + kstep, voffA); PG8_STAGE(PG8_SB(1, 1), cB + hstep + kstep, voffB);
        PG8_WAIT_V(6); PG8_BAR;
    }
    for (;;) {
        const bool has_next = S.next(ui + 1, nxt);
        const char* nA = has_next ? (const char*)g.A + (size_t)nxt.pm * tstep : cA; const char* nB = has_next ? (const char*)g.Bt + (size_t)nxt.pn * tstep : cB;
        for (int t = 0; t < nt; t += 2) {
            const bool last = (t == nt - 2);
            const char* a1 = cA + (size_t)(t + 1) * kstep;
            const char* a2 = last ? nA : cA + (size_t)(t + 2) * kstep; const char* b2 = last ? nB : cB + (size_t)(t + 2) * kstep;
            const char* a3 = a2 + kstep; const char* b3 = b2 + kstep;
            if (last && has_next) S.a_ready(nxt);
            if constexpr (SP2) {
            PG8_LDB(B0, 0, 0); PG8_LDB(B1, 0, 1); PG8_SCHED; PG8_LDA(At, 0, 0); PG8_STAGE(PG8_SA(1, 1), a1 + hstep, voffA);
            PG8_WAIT_V(8); PG8_WAIT_L(0); PG8_BAR; PG8_MMA(0, 0, At, B0); PG8_MMA(0, 1, At, B1); PG8_BAR; PG8_SCHED;
            PG8_LDA(At, 0, 1); PG8_STAGE(PG8_SB(0, 0), b2, voffB); PG8_STAGE(PG8_SB(0, 1), b2 + hstep, voffB); PG8_STAGE(PG8_SA(0, 0), a2, voffA);
            PG8_WAIT_V(8); PG8_WAIT_L(0); PG8_BAR; PG8_MMA(1, 0, At, B0); PG8_MMA(1, 1, At, B1); PG8_BAR; PG8_SCHED;
            PG8_LDB(B0, 1, 0); PG8_LDB(B1, 1, 1); PG8_SCHED; PG8_LDA(At, 1, 0); PG8_STAGE(PG8_SA(0, 1), a2 + hstep, voffA);
            PG8_WAIT_V(8); PG8_WAIT_L(0); PG8_BAR; PG8_MMA(0, 0, At, B0); PG8_MMA(0, 1, At, B1); PG8_BAR; PG8_SCHED;
            PG8_LDA(At, 1, 1); PG8_STAGE(PG8_SB(1, 0), b3, voffB); PG8_STAGE(PG8_SB(1, 1), b3 + hstep, voffB); PG8_STAGE(PG8_SA(1, 0), a3, voffA);
            PG8_WAIT_V(8); PG8_WAIT_L(0); PG8_BAR; PG8_MMA(1, 0, At, B0); PG8_MMA(1, 1, At, B1); PG8_BAR; PG8_SCHED;
            } else {
            PG8_LDB(B0, 0, 0); PG8_SCHED; PG8_LDA(At, 0, 0); PG8_STAGE(PG8_SA(1, 1), a1 + hstep, voffA);
            PG8_WAIT_L(8); PG8_BAR; PG8_WAIT_L(0); PG8_MMA(0, 0, At, B0); PG8_BAR; PG8_SCHED;
            PG8_LDB(B1, 0, 1); PG8_STAGE(PG8_SB(0, 0), b2, voffB);
            PG8_BAR; PG8_WAIT_L(0); PG8_MMA(0, 1, At, B1); PG8_BAR;
            PG8_LDA(At, 0, 1); PG8_STAGE(PG8_SA(0, 0), a2, voffA);
            PG8_BAR; PG8_WAIT_L(0); PG8_MMA(1, 0, At, B0); PG8_BAR; PG8_SCHED;
            PG8_STAGE(PG8_SB(0, 1), b2 + hstep, voffB);
            PG8_WAIT_V(6); PG8_BAR; PG8_MMA(1, 1, At, B1); PG8_BAR;
            PG8_LDB(B0, 1, 0); PG8_SCHED; PG8_LDA(At, 1, 0); PG8_STAGE(PG8_SA(0, 1), a2 + hstep, voffA);
            PG8_WAIT_L(8); PG8_BAR; PG8_WAIT_L(0); PG8_MMA(0, 0, At, B0); PG8_BAR; PG8_SCHED;
            PG8_LDB(B1, 1, 1); PG8_STAGE(PG8_SB(1, 0), b3, voffB);
            PG8_BAR; PG8_WAIT_L(0); PG8_MMA(0, 1, At, B1); PG8_BAR;
            PG8_LDA(At, 1, 1); PG8_STAGE(PG8_SA(1, 0), a3, voffA);
            PG8_BAR; PG8_WAIT_L(0); PG8_MMA(1, 0, At, B0); PG8_BAR; PG8_SCHED;
            PG8_STAGE(PG8_SB(1, 1), b3 + hstep, voffB);
            PG8_WAIT_V(6); PG8_BAR; PG8_MMA(1, 1, At, B1); PG8_BAR;
            }
        }
        if constexpr (ALIGN_EPI) { if (wr == 0) PG8_BAR; }
        if constexpr (!Epi::AFTER_DRAIN) { E(acc, cur, wr, wc, fr, fq); S.done(cur); }
        if (!has_next) break;
#pragma unroll
        for (int a = 0; a < 2; ++a)
#pragma unroll
            for (int b = 0; b < 2; ++b)
#pragma unroll
                for (int m = 0; m < 4; ++m)
#pragma unroll
                    for (int n = 0; n < 2; ++n) acc[a][b][m][n] = (f32x4){0.f, 0.f, 0.f, 0.f};
        cur = nxt; cA = nA; cB = nB; ++ui;
        if constexpr (ALIGN_EPI) { if (wr == 1) PG8_BAR; }
    }
    PG8_WAIT_V(0);
    if constexpr (!ALIGN_EPI) { if (wr == 0) PG8_BAR; }
    PG8_BAR;
    if constexpr (Epi::AFTER_DRAIN) { E.fused(acc, cur, wr, wc, fr, fq, lds, wid, lane); S.done(cur); }
#undef PG8_SA
#undef PG8_SB
#undef PG8_STAGE
#undef PG8_LDA
#undef PG8_LDB
#undef PG8_MMA
#undef PG8_WAIT_V
#undef PG8_WAIT_L
#undef PG8_BAR
#undef PG8_SCHED
}
}
#define MK_N_LAUNCHES 1
#ifndef MK_N_LAUNCHES
#define MK_N_LAUNCHES 1
#endif
constexpr int DM = 2048, NB = 8, SEQ = 2048, T = NB * SEQ;
constexpr int AW = 1024, NH = 8, HD = 64, VD = 128, INC = 6144;
constexpr int PNK = 128, PTOPK = 16, PEH = 8, EPT = PEH * PTOPK;
constexpr float EPS = 1e-6f;
constexpr float C2 = 0.125f * 1.4426950408889634f;
constexpr int NPHASE = 7;
constexpr size_t MiB = 1u << 20;
constexpr size_t WS_WIN = 1 * MiB, WS_WOUT = 25 * MiB, WS_WQ = 33 * MiB, WS_SK = 41 * MiB, WS_SSQ = 42 * MiB, WS_EIDX = 44 * MiB, WS_EGATE = 52 * MiB, WS_RSTD = 60 * MiB;
constexpr size_t WS_XN = 64 * MiB;
constexpr size_t WS_Q = 128 * MiB, WS_K = 160 * MiB, WS_V = 192 * MiB;
constexpr size_t WS_CB = 224 * MiB, WS_CC = 256 * MiB, WS_CX = 288 * MiB;
constexpr size_t WS_UT = 320 * MiB, WS_VT = 384 * MiB, WS_END = 448 * MiB;
constexpr int LDS_BYTES = 147456;
constexpr int NWAVES = 8, NTHREADS = 512;

#define LAS __attribute__((address_space(3)))
typedef unsigned short bf16;
typedef unsigned v4u __attribute__((ext_vector_type(4)));
typedef unsigned v2u __attribute__((ext_vector_type(2)));
typedef float f32x4 __attribute__((ext_vector_type(4)));
typedef float f32x2 __attribute__((ext_vector_type(2)));
typedef float f32x16 __attribute__((ext_vector_type(16)));
typedef short bf16x8 __attribute__((ext_vector_type(8)));
typedef short s16x4 __attribute__((ext_vector_type(4)));
typedef __bf16 bf16x2_t __attribute__((ext_vector_type(2)));
#define LDS_WAIT() asm volatile("s_waitcnt lgkmcnt(0)" ::: "memory")
__device__ __forceinline__ unsigned pk2(float lo, float hi) { f32x2 v = {lo, hi}; bf16x2_t b = __builtin_convertvector(v, bf16x2_t); return __builtin_bit_cast(unsigned, b); }
__device__ __forceinline__ float bflo(unsigned u) { return __uint_as_float(u << 16); }
__device__ __forceinline__ float bfhi(unsigned u) { return __uint_as_float(u & 0xffff0000u); }
__device__ __forceinline__ float wave_sum(float v) {
#pragma unroll
    for (int o = 1; o < 64; o <<= 1) v += __shfl_xor(v, o);
    return v;
}
__device__ __forceinline__ float wave_max(float v) {
#pragma unroll
    for (int o = 1; o < 64; o <<= 1) v = fmaxf(v, __shfl_xor(v, o));
    return v;
}

namespace pg8 {
struct EpiProj {
    static constexpr bool PERM = true, AFTER_DRAIN = false;
    bf16_t* base0; const float* qg; const float* kg;
    __device__ __forceinline__ void operator()(const f32x4 (&acc)[2][2][4][2], const Unit& u, int wr, int wc, int fr, int fq) const {
        const int region = u.pn >> 2;
        bf16_t* O = base0 + (size_t)region * (16u << 20);
        const int row0 = u.pm * BM + wr * 64 + fr, col0 = (u.pn & 3) * 256 + wc * 64 + 8 * fq;
        if (region < 2) {
            const float* g = region == 0 ? qg : kg; const float sc = region == 0 ? 0.125f * 1.4426950408889634f : 1.0f;
            f32x4 gv[2][2];
#pragma unroll
            for (int bj = 0; bj < 2; ++bj)
#pragma unroll
                for (int n = 0; n < 2; ++n) gv[bj][n] = *(const f32x4*)(g + bj * 32 + 8 * fq + 4 * n) * sc;
#pragma unroll
            for (int ai = 0; ai < 2; ++ai)
#pragma unroll
                for (int m = 0; m < 4; ++m) {
                    float ss = 0.f;
#pragma unroll
                    for (int bj = 0; bj < 2; ++bj)
#pragma unroll
                        for (int n = 0; n < 2; ++n) { const f32x4 x = acc[ai][bj][m][n]; ss += (x[0] * x[0] + x[1] * x[1]) + (x[2] * x[2] + x[3] * x[3]); }
                    ss += __shfl_xor(ss, 16); ss += __shfl_xor(ss, 32);
                    const float rs = __builtin_amdgcn_rsqf(ss * (1.0f / 64.0f) + 1e-6f);
                    bf16_t* rowp = O + (size_t)(row0 + ai * HALF + m * 16) * 1024 + col0;
#pragma unroll
                    for (int bj = 0; bj < 2; ++bj) { const f32x4 v0 = acc[ai][bj][m][0] * rs * gv[bj][0], v1 = acc[ai][bj][m][1] * rs * gv[bj][1];
                        u32x4 w; w.x = cvt_pk_bf16(v0[0], v0[1]); w.y = cvt_pk_bf16(v0[2], v0[3]); w.z = cvt_pk_bf16(v1[0], v1[1]); w.w = cvt_pk_bf16(v1[2], v1[3]);
                        *(u32x4*)(rowp + bj * 32) = w; }
                }
        } else {
#pragma unroll
            for (int ai = 0; ai < 2; ++ai)
#pragma unroll
                for (int m = 0; m < 4; ++m) { bf16_t* rowp = O + (size_t)(row0 + ai * HALF + m * 16) * 1024 + col0;
#pragma unroll
                    for (int bj = 0; bj < 2; ++bj) { const f32x4 v0 = acc[ai][bj][m][0], v1 = acc[ai][bj][m][1];
                        u32x4 w; w.x = cvt_pk_bf16(v0[0], v0[1]); w.y = cvt_pk_bf16(v0[2], v0[3]); w.z = cvt_pk_bf16(v1[0], v1[1]); w.w = cvt_pk_bf16(v1[2], v1[3]);
                        *(u32x4*)(rowp + bj * 32) = w; } }
        }
    }
};
struct EpiX1 {
    static constexpr bool PERM = true, AFTER_DRAIN = false;
    const float* x; float* out; bf16_t* a2; const float* gf; float* ssq;
    __device__ __forceinline__ void operator()(const f32x4 (&acc)[2][2][4][2], const Unit& u, int wr, int wc, int fr, int fq) const {
        const int row0 = u.pm * BM + wr * 64 + fr, col0 = u.pn * BM + wc * 32 + 8 * fq;
        f32x4 gv[2][2];
#pragma unroll
        for (int bj = 0; bj < 2; ++bj)
#pragma unroll
            for (int n = 0; n < 2; ++n) gv[bj][n] = *(const f32x4*)(gf + col0 + bj * HALF + 4 * n);
#pragma unroll
        for (int ai = 0; ai < 2; ++ai)
#pragma unroll
            for (int m = 0; m < 4; ++m) { const int row = row0 + ai * HALF + m * 16; const size_t off = (size_t)row * 2048 + col0; float ss = 0.f;
#pragma unroll
                for (int bj = 0; bj < 2; ++bj) {
                    const f32x4 x0 = *(const f32x4*)(x + off + bj * HALF), x1 = *(const f32x4*)(x + off + bj * HALF + 4);
                    const f32x4 v0 = x0 + acc[ai][bj][m][0], v1 = x1 + acc[ai][bj][m][1];
                    *(f32x4*)(out + off + bj * HALF) = v0; *(f32x4*)(out + off + bj * HALF + 4) = v1;
                    ss += (v0[0] * v0[0] + v0[1] * v0[1]) + (v0[2] * v0[2] + v0[3] * v0[3]); ss += (v1[0] * v1[0] + v1[1] * v1[1]) + (v1[2] * v1[2] + v1[3] * v1[3]);
                    const f32x4 a0 = v0 * gv[bj][0], a1 = v1 * gv[bj][1];
                    u32x4 w; w.x = cvt_pk_bf16(a0[0], a0[1]); w.y = cvt_pk_bf16(a0[2], a0[3]); w.z = cvt_pk_bf16(a1[0], a1[1]); w.w = cvt_pk_bf16(a1[2], a1[3]);
                    *(u32x4*)(a2 + off + bj * HALF) = w; }
                ss += __shfl_xor(ss, 16); ss += __shfl_xor(ss, 32);
                if (fq == 0) ssq[(size_t)row * 32 + u.pn * 4 + wc] = ss; }
    }
};
}

__device__ __forceinline__ void p0_transpose_item(const float* W, int K, int N, bf16* WT, LAS float* scr, int item, int lane, bool permg) {
    const int nblk = N / 32, kb = item / nblk, nb = item % nblk, k0 = 64 * kb, n0 = 32 * nb;
#pragma unroll 8
    for (int i = 0; i < 32; ++i) { const int kk = 2 * i + (lane >> 5); scr[kk * 33 + (lane & 31)] = W[(size_t)(k0 + kk) * N + n0 + (lane & 31)]; }
    LDS_WAIT(); asm volatile("" ::: "memory");
    int nd = n0; if (permg) { const int gl = (n0 & 255) >> 5; nd = (n0 & ~255) + 32 * (4 * (gl & 1) + (gl >> 1)); }
    const int c = lane & 7;
#pragma unroll
    for (int j = 0; j < 4; ++j) { const int n = (lane >> 3) + 8 * j; const LAS float* s = scr + (8 * c) * 33 + n;
        v4u o; o.x = pk2(s[0 * 33], s[1 * 33]); o.y = pk2(s[2 * 33], s[3 * 33]); o.z = pk2(s[4 * 33], s[5 * 33]); o.w = pk2(s[6 * 33], s[7 * 33]);
        *(v4u*)(WT + (size_t)(nd + n) * K + k0 + 8 * c) = o; }
    LDS_WAIT(); asm volatile("" ::: "memory");
}
__device__ __forceinline__ void rms_row_to_bf16(const float* xrow, const float* g, bf16* orow, int lane) {
    const f32x4* xr = (const f32x4*)xrow + lane; const f32x4* gr = (const f32x4*)g + lane;
    f32x4 v[8]; float s = 0.f;
#pragma unroll
    for (int j = 0; j < 8; ++j) { v[j] = xr[64 * j]; s += (v[j].x * v[j].x + v[j].y * v[j].y) + (v[j].z * v[j].z + v[j].w * v[j].w); }
    const float rstd = 1.0f / sqrtf(wave_sum(s) * (1.f / DM) + EPS);
    v2u* o8 = (v2u*)orow + lane;
#pragma unroll
    for (int j = 0; j < 8; ++j) { const f32x4 gg = gr[64 * j]; v2u w; w.x = pk2(v[j].x * rstd * gg.x, v[j].y * rstd * gg.y); w.y = pk2(v[j].z * rstd * gg.z, v[j].w * rstd * gg.w); o8[64 * j] = w; }
}
__device__ __forceinline__ void cvt_bf16_stream(const float* src, bf16* dst, size_t n8, size_t gtid, size_t nthr) {
    for (size_t i = gtid; i < n8; i += nthr) { const f32x4 a = *(const f32x4*)(src + i * 8), b = *(const f32x4*)(src + i * 8 + 4);
        v4u o; o.x = pk2(a.x, a.y); o.y = pk2(a.z, a.w); o.z = pk2(b.x, b.y); o.w = pk2(b.z, b.w); *(v4u*)(dst + i * 8) = o; }
}

namespace att {
constexpr int SLOTB = 32768;
constexpr int NSLOT = 3, LW_OFF = NSLOT * SLOTB;
constexpr int XSTR = 132;
__device__ __forceinline__ void glds16(const void* gsrc, unsigned lds_dst) { unsigned keep;
    asm volatile("s_mov_b32 %0, m0\n\ts_mov_b32 m0, %2\n\ts_nop 0\n\tglobal_load_lds_dwordx4 %1, off\n\ts_mov_b32 m0, %0" : "=&s"(keep) : "v"(gsrc), "s"(lds_dst) : "memory"); }
__device__ __forceinline__ int crow(int r, int hi) { return (r & 3) + 8 * (r >> 2) + 4 * hi; }
typedef short v4i16_t __attribute__((ext_vector_type(4)));
__device__ __forceinline__ s16x4 vtr(const LAS char* p) { return __builtin_bit_cast(s16x4, __builtin_amdgcn_ds_read_tr16_b64_v4i16((LAS v4i16_t*)p)); }
#define ATT_WAIT_BAR(N) asm volatile("s_waitcnt vmcnt(" #N ") lgkmcnt(0)\n\ts_barrier" ::: "memory")

__device__ __forceinline__ void attn_unit(int b, int h, int qblk, const bf16* Q, const bf16* K, const bf16* V, bf16* MIX, const float* subg, float lam, float M2, LAS char* lds) {
    const int tid = threadIdx.x, lane = tid & 63, r32 = lane & 31, hi = lane >> 5, wid = __builtin_amdgcn_readfirstlane(tid >> 6), c = wid >> 2, qs = wid & 3;
    const size_t rowbase = (size_t)b * SEQ; const int q0 = qblk * 128, NT = 2 * (qblk + 1);
    const unsigned lds0 = (unsigned)(uintptr_t)lds;
    const bf16* ksrc[2]; const bf16* vsrc[2]; unsigned kdst[2], vdst[2];
#pragma unroll
    for (int i = 0; i < 2; ++i) { const int pk = 2 * wid + i, pc = pk >> 3, ch = pk & 7, d0 = pk >> 2, rg = pk & 3;
        ksrc[i] = K + (rowbase + lane) * 1024 + h * 128 + pc * 64 + ch * 8; kdst[i] = lds0 + pk * 1024;
        vsrc[i] = V + (rowbase + 16 * rg + (lane >> 2)) * 1024 + h * 128 + d0 * 32 + (lane & 3) * 8; vdst[i] = lds0 + 16384 + pk * 1024; }
#define ATT_DMA(t, slot) do { _Pragma("unroll") for (int i_ = 0; i_ < 2; ++i_) { glds16(ksrc[i_] + (size_t)(t) * 64 * 1024, (unsigned)__builtin_amdgcn_readfirstlane(kdst[i_] + (slot) * SLOTB)); \
        glds16(vsrc[i_] + (size_t)(t) * 64 * 1024, (unsigned)__builtin_amdgcn_readfirstlane(vdst[i_] + (slot) * SLOTB)); } } while (0)
    ATT_DMA(0, 0); ATT_DMA(1, 1);
    const int qrow = q0 + 32 * qs + r32;
    bf16x8 qr[4];
#pragma unroll
    for (int d0 = 0; d0 < 4; ++d0) qr[d0] = *(const bf16x8*)(Q + (rowbase + qrow) * 1024 + h * 128 + c * 64 + d0 * 16 + hi * 8);
    const float slope2 = exp2f(-(float)(h + 1)) * 1.4426950408889634f;
    float creg[16];
#pragma unroll
    for (int r = 0; r < 16; ++r) creg[r] = slope2 * (float)crow(r, hi);
    float base = -slope2 * (float)qrow - M2;
    const float s32 = 32.f * slope2, s64 = 64.f * slope2;
    f32x16 o[4]; o[0] = f32x16{}; o[1] = f32x16{}; o[2] = f32x16{}; o[3] = f32x16{};
    float lsum = 0.f;
    const LAS char* kp0 = (const LAS char*)lds + c * 8192 + hi * 1024 + r32 * 16;
    const LAS char* vp0 = (const LAS char*)lds + 16384 + ((lane >> 4) & 1) * 32 + (lane & 3) * 8 + (4 * hi + ((lane & 15) >> 2)) * 64;
    const int qw0 = q0 + 32 * qs;
    int slot = 0;
    for (int t = 0; t < NT; ++t) {
        if (t == 0) { ATT_WAIT_BAR(0); } else if (t + 1 < NT) { ATT_WAIT_BAR(4); } else { ATT_WAIT_BAR(0); }
        if (t + 2 < NT) { const int s2_ = (slot == 0) ? 2 : slot - 1; ATT_DMA(t + 2, s2_); }
        const int k0 = 64 * t;
        if (k0 <= qw0 + 31) {
            const LAS char* kp = kp0 + slot * SLOTB; const LAS char* vp = vp0 + slot * SLOTB;
            f32x16 p0, p1;
#pragma unroll
            for (int r = 0; r < 16; ++r) { p0[r] = base + creg[r]; p1[r] = p0[r] + s32; }
#pragma unroll
            for (int d0 = 0; d0 < 4; ++d0) {
                const bf16x8 ka = *(const LAS bf16x8*)(kp + d0 * 2048), kb = *(const LAS bf16x8*)(kp + d0 * 2048 + 512);
                p0 = __builtin_amdgcn_mfma_f32_32x32x16_bf16(ka, qr[d0], p0, 0, 0, 0);
                p1 = __builtin_amdgcn_mfma_f32_32x32x16_bf16(kb, qr[d0], p1, 0, 0, 0); }
#pragma unroll
            for (int r = 0; r < 16; ++r) { p0[r] = __builtin_amdgcn_exp2f(p0[r]); p1[r] = __builtin_amdgcn_exp2f(p1[r]); }
            if (k0 + 63 > qw0) {
                const int dq = qrow - k0;
#pragma unroll
                for (int r = 0; r < 16; ++r) { const int kk = crow(r, hi); if (kk > dq) p0[r] = 0.f; if (kk + 32 > dq) p1[r] = 0.f; }
            }
            float sacc = 0.f;
#pragma unroll
            for (int r = 0; r < 16; ++r) sacc += p0[r] + p1[r];
            lsum += sacc;
            bf16x8 pw[4];
#pragma unroll
            for (int ks = 0; ks < 4; ++ks) { v4u w;
                if (ks < 2) { w.x = pk2(p0[8 * ks + 0], p0[8 * ks + 1]); w.y = pk2(p0[8 * ks + 2], p0[8 * ks + 3]); w.z = pk2(p0[8 * ks + 4], p0[8 * ks + 5]); w.w = pk2(p0[8 * ks + 6], p0[8 * ks + 7]); }
                else { const int k2 = ks - 2; w.x = pk2(p1[8 * k2 + 0], p1[8 * k2 + 1]); w.y = pk2(p1[8 * k2 + 2], p1[8 * k2 + 3]); w.z = pk2(p1[8 * k2 + 4], p1[8 * k2 + 5]); w.w = pk2(p1[8 * k2 + 6], p1[8 * k2 + 7]); }
                pw[ks] = __builtin_bit_cast(bf16x8, w); }
#pragma unroll
            for (int d0 = 0; d0 < 4; ++d0)
#pragma unroll
                for (int ks = 0; ks < 4; ++ks) { const s16x4 lo = vtr(vp + d0 * 4096 + ks * 1024), hv = vtr(vp + d0 * 4096 + ks * 1024 + 512);
                    const bf16x8 vf = (bf16x8){lo[0], lo[1], lo[2], lo[3], hv[0], hv[1], hv[2], hv[3]};
                    o[d0] = __builtin_amdgcn_mfma_f32_32x32x16_bf16(pw[ks], vf, o[d0], 0, 0, 0); }
        }
        base += s64;
        slot = (slot == NSLOT - 1) ? 0 : slot + 1;
    }
    ATT_WAIT_BAR(0);
    LAS float* lw = (LAS float*)(lds + LW_OFF) + wid * 32;
    { auto rr = __builtin_amdgcn_permlane32_swap(__float_as_uint(lsum), __float_as_uint(lsum), false, false); lsum = __uint_as_float(rr[0]) + __uint_as_float(rr[1]); }
    if (hi == 0) lw[r32] = lsum;
    LDS_WAIT();
    LAS float* X = (LAS float*)lds + qs * 32 * XSTR;
#pragma unroll
    for (int r = 0; r < 16; ++r) { const float rl = 1.0f / lw[crow(r, hi)];
#pragma unroll
        for (int d0 = 0; d0 < 4; ++d0) o[d0][r] *= rl; }
    if (c == 1) {
#pragma unroll
        for (int r = 0; r < 16; ++r)
#pragma unroll
            for (int d0 = 0; d0 < 4; ++d0) X[crow(r, hi) * XSTR + d0 * 32 + r32] = o[d0][r];
    }
    ATT_WAIT_BAR(0);
    if (c == 0) {
#pragma unroll
        for (int r = 0; r < 16; ++r)
#pragma unroll
            for (int d0 = 0; d0 < 4; ++d0) { LAS float* px = X + crow(r, hi) * XSTR + d0 * 32 + r32; const float a = o[d0][r] - lam * (*px); *px = a; }
        LDS_WAIT(); asm volatile("" ::: "memory");
        const LAS f32x4* rp = (const LAS f32x4*)(X + r32 * XSTR + hi * 64);
        f32x4 av[16]; float ss = 0.f;
#pragma unroll
        for (int j = 0; j < 16; ++j) { av[j] = rp[j]; ss += (av[j].x * av[j].x + av[j].y * av[j].y) + (av[j].z * av[j].z + av[j].w * av[j].w); }
        { auto rr = __builtin_amdgcn_permlane32_swap(__float_as_uint(ss), __float_as_uint(ss), false, false); ss = __uint_as_float(rr[0]) + __uint_as_float(rr[1]); }
        const float rs = 0.8f / sqrtf(ss * (1.0f / 128.0f) + EPS);
        bf16* op = MIX + (rowbase + qrow) * 2048 + h * 128 + hi * 64;
#pragma unroll
        for (int j = 0; j < 8; ++j) { const f32x4 g0 = *(const f32x4*)(subg + hi * 64 + 8 * j), g1 = *(const f32x4*)(subg + hi * 64 + 8 * j + 4); const f32x4 a0 = av[2 * j] * rs * g0, a1 = av[2 * j + 1] * rs * g1;
            v4u w; w.x = pk2(a0.x, a0.y); w.y = pk2(a0.z, a0.w); w.z = pk2(a1.x, a1.y); w.w = pk2(a1.z, a1.w); *(v4u*)(op + 8 * j) = w; }
    }
    ATT_WAIT_BAR(0);
#undef ATT_DMA
}
}


#ifndef DBG_NAIVE_ATTN
#define DBG_NAIVE_ATTN 0
#endif
#if DBG_NAIVE_ATTN
__device__ __forceinline__ void naive_attn_row(int b, int h, int q, const bf16* Q, const bf16* K, const bf16* V, bf16* MIX, const float* subg, float lam, LAS float* S, int lane) {
    const size_t rowbase = (size_t)b * SEQ; const float slope2 = exp2f(-(float)(h + 1)) * 1.4426950408889634f;
    for (int c = 0; c < 2; ++c) {
        float qv[64];
        const bf16* qp = Q + (rowbase + q) * 1024 + h * 128 + c * 64;
#pragma unroll
        for (int d = 0; d < 64; d += 2) { const unsigned u = *(const unsigned*)(qp + d); qv[d] = bflo(u); qv[d + 1] = bfhi(u); }
        for (int key = lane; key <= q; key += 64) { const bf16* kp = K + (rowbase + key) * 1024 + h * 128 + c * 64; float s = 0.f;
#pragma unroll
            for (int d = 0; d < 64; d += 2) { const unsigned u = *(const unsigned*)(kp + d); s += qv[d] * bflo(u) + qv[d + 1] * bfhi(u); }
            S[c * 2048 + key] = s - slope2 * (float)(q - key); }
    }
    LDS_WAIT();
    float linv[2];
    for (int c = 0; c < 2; ++c) { float m = -1e30f; for (int key = lane; key <= q; key += 64) m = fmaxf(m, S[c * 2048 + key]); m = wave_max(m);
        float l = 0.f; for (int key = lane; key <= q; key += 64) { const float p = exp2f(S[c * 2048 + key] - m); S[c * 2048 + key] = p; l += p; } linv[c] = 1.0f / wave_sum(l); }
    for (int key = lane; key <= q; key += 64) S[key] = S[key] * linv[0] - lam * S[2048 + key] * linv[1];
    LDS_WAIT();
    float o0 = 0.f, o1 = 0.f; const bf16* vp = V + rowbase * 1024 + h * 128 + lane;
    for (int key = 0; key <= q; ++key) { const float a = S[key]; o0 += a * __uint_as_float((unsigned)vp[(size_t)key * 1024] << 16); o1 += a * __uint_as_float((unsigned)vp[(size_t)key * 1024 + 64] << 16); }
    const float ss = wave_sum(o0 * o0 + o1 * o1); const float rs = 0.8f / sqrtf(ss * (1.0f / 128.0f) + EPS);
    bf16* op = MIX + (rowbase + q) * 2048 + h * 128 + lane;
    op[0] = (bf16)(pk2(o0 * rs * subg[lane], 0.f) & 0xffffu); op[64] = (bf16)(pk2(o1 * rs * subg[lane + 64], 0.f) & 0xffffu);
    LDS_WAIT();
}
#endif

__device__ __forceinline__ unsigned ord_key(float f) { const unsigned u = __float_as_uint(f); return (u & 0x80000000u) ? ~u : (u | 0x80000000u); }
__device__ __forceinline__ float ord_val(unsigned k) { return __uint_as_float((k & 0x80000000u) ? (k ^ 0x80000000u) : ~k); }
#define TOPK_INS(tt, x_) do { unsigned x__ = (x_); _Pragma("unroll") for (int j_ = 0; j_ < 16; ++j_) { const unsigned hi__ = max(tt[j_], x__); x__ = min(tt[j_], x__); tt[j_] = hi__; } } while (0)

__device__ __forceinline__ void peer_topk_item(int tile, int h, const bf16* QP, const bf16* SK, const float* SSQ, int* EIDX, float* EGATE, float* RSTD, LAS char* lds) {
    const int tid = threadIdx.x, lane = tid & 63, r32 = lane & 31, hi = lane >> 5, wid = __builtin_amdgcn_readfirstlane(tid >> 6), c = wid >> 2, tb = wid & 3;
    constexpr int SSTR = 132;
    LAS float* SC = (LAS float*)lds;
    const int tok0 = tile * 128;
    {
        bf16x8 qf[8];
        const bf16* qp = QP + (size_t)(tok0 + tb * 32 + r32) * 2048 + h * 256 + c * 128 + hi * 8;
#pragma unroll
        for (int s = 0; s < 8; ++s) qf[s] = *(const bf16x8*)(qp + 16 * s);
        const bf16* sp = SK + (size_t)((h * 2 + c) * 128 + r32) * 128 + hi * 8;
#pragma unroll
        for (int kb = 0; kb < 4; ++kb) { f32x16 acc = f32x16{};
#pragma unroll
            for (int s = 0; s < 8; ++s) { const bf16x8 sf = *(const bf16x8*)(sp + (size_t)kb * 32 * 128 + 16 * s); acc = __builtin_amdgcn_mfma_f32_32x32x16_bf16(qf[s], sf, acc, 0, 0, 0); }
#pragma unroll
            for (int r = 0; r < 16; ++r) SC[(c * 128 + tb * 32 + att::crow(r, hi)) * SSTR + kb * 32 + r32] = acc[r]; }
    }
    __syncthreads();
    if (tid < 256) {
        LAS float* row = SC + tid * SSTR; unsigned tt[16];
#pragma unroll
        for (int j = 0; j < 16; ++j) tt[j] = 0u;
#pragma unroll 2
        for (int i = 0; i < 32; ++i) { const f32x4 v = *(const LAS f32x4*)(row + 4 * i);
            TOPK_INS(tt, (ord_key(v.x) & ~0x7Fu) | (unsigned)(4 * i)); TOPK_INS(tt, (ord_key(v.y) & ~0x7Fu) | (unsigned)(4 * i + 1));
            TOPK_INS(tt, (ord_key(v.z) & ~0x7Fu) | (unsigned)(4 * i + 2)); TOPK_INS(tt, (ord_key(v.w) & ~0x7Fu) | (unsigned)(4 * i + 3)); }
        LAS unsigned* lrow = (LAS unsigned*)row;
#pragma unroll
        for (int j = 0; j < 16; ++j) lrow[j] = tt[j];
    }
    __syncthreads();
    if (tid < 128) {
        const LAS unsigned* l1 = (const LAS unsigned*)(SC + tid * SSTR); const LAS unsigned* l2 = (const LAS unsigned*)(SC + (128 + tid) * SSTR);
        float v1[16], v2[16];
#pragma unroll
        for (int j = 0; j < 16; ++j) { v1[j] = ord_val(l1[j] & ~0x7Fu); v2[j] = ord_val(l2[j] & ~0x7Fu); }
        unsigned tt[16];
#pragma unroll
        for (int j = 0; j < 16; ++j) tt[j] = 0u;
#pragma unroll
        for (int i = 0; i < 16; ++i)
#pragma unroll
            for (int j = 0; j < 16; ++j) if ((i + 1) * (j + 1) <= 16) { TOPK_INS(tt, (ord_key(v1[i] + v2[j]) & ~0xFFu) | (unsigned)(i * 16 + j)); }
        const int t = tok0 + tid;
        float ssq = 0.f;
#pragma unroll
        for (int j = 0; j < 8; ++j) { const f32x4 p = *(const f32x4*)(SSQ + (size_t)t * 32 + 4 * j); ssq += (p.x + p.y) + (p.z + p.w); }
        const float rstd = 1.0f / sqrtf(ssq * (1.0f / DM) + EPS);
        if (h == 0) RSTD[t] = rstd;
        float ev[16]; int ex[16]; float es = 0.f, vmax = 0.f;
#pragma unroll
        for (int k = 0; k < 16; ++k) { const unsigned pid = tt[k] & 0xFFu; const unsigned a = l1[pid >> 4], b2 = l2[pid & 15u];
            const float sv = (ord_val(a & ~0x7Fu) + ord_val(b2 & ~0x7Fu)) * rstd; if (k == 0) vmax = sv;
            ev[k] = __expf(sv - vmax); es += ev[k]; ex[k] = (int)((a & 0x7Fu) * 128u + (b2 & 0x7Fu)); }
        const float inv = 1.0f / es;
        int* ei = EIDX + (size_t)t * 128 + h * 16; float* eg = EGATE + (size_t)t * 128 + h * 16;
#pragma unroll
        for (int k = 0; k < 16; k += 4) { *(int4*)(ei + k) = make_int4(ex[k], ex[k + 1], ex[k + 2], ex[k + 3]); *(f32x4*)(eg + k) = (f32x4){ev[k] * inv, ev[k + 1] * inv, ev[k + 2] * inv, ev[k + 3] * inv}; }
    }
    __syncthreads();
}

__device__ __forceinline__ float dot2bf(unsigned a, unsigned b, float acc) { asm("v_dot2c_f32_bf16 %0, %1, %2" : "+v"(acc) : "v"(a), "v"(b)); return acc; }
__device__ __forceinline__ float dot8(v4u a, v4u b, float acc) { acc = dot2bf(a.x, b.x, acc); acc = dot2bf(a.y, b.y, acc); acc = dot2bf(a.z, b.z, acc); acc = dot2bf(a.w, b.w, acc); return acc; }
__device__ __forceinline__ void peer_expert_token(int t, const bf16* A2, const bf16* UT, const bf16* VT, const int* EIDX, const float* EGATE, const float* RSTD, float* out, int lane) {
    v4u hr[4];
#pragma unroll
    for (int j = 0; j < 4; ++j) hr[j] = *(const v4u*)(A2 + (size_t)t * 2048 + lane * 8 + 512 * j);
    const float rstd = RSTD[t];
    f32x4 oa[8];
#pragma unroll
    for (int j = 0; j < 4; ++j) { oa[2 * j] = *(const f32x4*)(out + (size_t)t * 2048 + lane * 8 + 512 * j); oa[2 * j + 1] = *(const f32x4*)(out + (size_t)t * 2048 + lane * 8 + 512 * j + 4); }
    for (int bt = 0; bt < 2; ++bt) {
        const int eidx = EIDX[(size_t)t * 128 + bt * 64 + lane]; const float gate = EGATE[(size_t)t * 128 + bt * 64 + lane];
        float part[64];
#pragma unroll
        for (int k = 0; k < 64; ++k) { const int e = __builtin_amdgcn_readlane(eidx, k); const bf16* up = UT + (size_t)e * 2048 + lane * 8; float a = 0.f;
#pragma unroll
            for (int j = 0; j < 4; ++j) a = dot8(hr[j], *(const v4u*)(up + 512 * j), a);
            part[k] = a; }
#pragma unroll
        for (int w = 32; w >= 1; w >>= 1) {
            const bool up = (lane & w) != 0;
#pragma unroll
            for (int i = 0; i < w; ++i) { const float a = part[i], b2 = part[i + w]; const float keep = up ? b2 : a, send = up ? a : b2; part[i] = keep + __shfl_xor(send, w); }
        }
        const float z = part[0] * rstd;
        const float act = 0.5f * z * (1.0f + erff(z * 0.70710678118654752f)) * gate;
#pragma unroll 8
        for (int k = 0; k < 64; ++k) { const int e = __builtin_amdgcn_readlane(eidx, k); const float a = __uint_as_float(__builtin_amdgcn_readlane(__float_as_uint(act), k)); const bf16* vp = VT + (size_t)e * 2048 + lane * 8;
#pragma unroll
            for (int j = 0; j < 4; ++j) { const v4u v = *(const v4u*)(vp + 512 * j);
                oa[2 * j].x += a * bflo(v.x); oa[2 * j].y += a * bfhi(v.x); oa[2 * j].z += a * bflo(v.y); oa[2 * j].w += a * bfhi(v.y);
                oa[2 * j + 1].x += a * bflo(v.z); oa[2 * j + 1].y += a * bfhi(v.z); oa[2 * j + 1].z += a * bflo(v.w); oa[2 * j + 1].w += a * bfhi(v.w); } }
    }
#pragma unroll
    for (int j = 0; j < 4; ++j) { *(f32x4*)(out + (size_t)t * 2048 + lane * 8 + 512 * j) = oa[2 * j]; *(f32x4*)(out + (size_t)t * 2048 + lane * 8 + 512 * j + 4) = oa[2 * j + 1]; }
}


#ifndef DBG_NAIVE_P6
#define DBG_NAIVE_P6 0
#endif
#if DBG_NAIVE_P6
__device__ __forceinline__ void naive_expert_token(int t, const bf16* A2, const bf16* UT, const bf16* VT, const int* EIDX, const float* EGATE, const float* RSTD, float* out, int lane) {
    const float rstd = RSTD[t];
    float o[32];
#pragma unroll
    for (int i = 0; i < 32; ++i) o[i] = out[(size_t)t * 2048 + lane + 64 * i];
    for (int k = 0; k < 128; ++k) { const int e = EIDX[(size_t)t * 128 + k]; const float g = EGATE[(size_t)t * 128 + k]; float s = 0.f;
#pragma unroll
        for (int i = 0; i < 32; ++i) s += __uint_as_float((unsigned)A2[(size_t)t * 2048 + lane + 64 * i] << 16) * __uint_as_float((unsigned)UT[(size_t)e * 2048 + lane + 64 * i] << 16);
        s = wave_sum(s); const float z = s * rstd; const float act = 0.5f * z * (1.0f + erff(z * 0.70710678118654752f)) * g;
#pragma unroll
        for (int i = 0; i < 32; ++i) o[i] += act * __uint_as_float((unsigned)VT[(size_t)e * 2048 + lane + 64 * i] << 16); }
#pragma unroll
    for (int i = 0; i < 32; ++i) out[(size_t)t * 2048 + lane + 64 * i] = o[i];
}
#endif

struct Args { const float* in[17]; float* out; unsigned char* ws; int ph_lo, ph_hi; };
__global__ void __launch_bounds__(NTHREADS, 2) mk_fwd(Args args) {
    extern __shared__ __attribute__((aligned(16))) unsigned char lds_raw[];
    LAS unsigned char* lds = (LAS unsigned char*)lds_raw;
    const int tid = threadIdx.x, lane = tid & 63, wave = __builtin_amdgcn_readfirstlane(tid >> 6);
    const int G = gridDim.x, bx = blockIdx.x;
    const int vcu = (G % 8 == 0) ? (bx % 8) * (G / 8) + bx / 8 : bx;
    unsigned char* ws = args.ws;
    const float* x = args.in[0]; const float* attn_g = args.in[1]; const float* w_in = args.in[2]; const float* qg = args.in[3]; const float* kg = args.in[4];
    const float* lq1 = args.in[5]; const float* lk1 = args.in[6]; const float* lq2 = args.in[7]; const float* lk2 = args.in[8]; const float* subg = args.in[9];
    const float* conv_w = args.in[10]; const float* w_out = args.in[11]; const float* ffn_g = args.in[12]; const float* w_q = args.in[13]; const float* subkeys = args.in[14];
    const float* peer_u = args.in[15]; const float* peer_v = args.in[16];
    float* out = args.out;
    bf16* WtIn = (bf16*)(ws + WS_WIN); bf16* WtOut = (bf16*)(ws + WS_WOUT); bf16* WtQ = (bf16*)(ws + WS_WQ); bf16* SK = (bf16*)(ws + WS_SK);
    float* SSQ = (float*)(ws + WS_SSQ); int* EIDX = (int*)(ws + WS_EIDX); float* EGATE = (float*)(ws + WS_EGATE); float* RSTD = (float*)(ws + WS_RSTD);
    bf16* XN = (bf16*)(ws + WS_XN); bf16* MIX = XN;
    bf16* Qb = (bf16*)(ws + WS_Q); bf16* Kb = (bf16*)(ws + WS_K); bf16* Vb = (bf16*)(ws + WS_V); bf16* QP = Qb;
    bf16* CB = (bf16*)(ws + WS_CB); bf16* CC = (bf16*)(ws + WS_CC); bf16* CX = (bf16*)(ws + WS_CX); bf16* A2 = CB;
    bf16* UT = (bf16*)(ws + WS_UT); bf16* VT = (bf16*)(ws + WS_VT);
    const int lo = args.ph_lo, hi_ph = args.ph_hi;
#define IN(k) (lo <= (k) && (k) < hi_ph)
#define SEAM(k) do { if (IN(k) && IN((k) + 1)) cg::this_grid().sync(); } while (0)
    const int gw = vcu * NWAVES + wave, NGW = G * NWAVES;
    const size_t gtid = (size_t)bx * NTHREADS + tid, nthr = (size_t)G * NTHREADS;

    if (IN(0)) {
        LAS float* scr = (LAS float*)(lds + wave * 16384);
        constexpr int I_IN = (DM / 64) * (INC / 32), I_SQ = (DM / 64) * (DM / 32);
        for (int it = gw; it < I_IN + 2 * I_SQ; it += NGW) {
            if (it < I_IN) p0_transpose_item(w_in, DM, INC, WtIn, scr, it, lane, true);
            else if (it < I_IN + I_SQ) p0_transpose_item(w_out, DM, DM, WtOut, scr, it - I_IN, lane, false);
            else p0_transpose_item(w_q, DM, DM, WtQ, scr, it - I_IN - I_SQ, lane, false);
        }
        for (int m = gw; m < T; m += NGW) rms_row_to_bf16(x + (size_t)m * DM, attn_g, XN + (size_t)m * DM, lane);
        cvt_bf16_stream(subkeys, SK, (size_t)PEH * 2 * PNK * 128 / 8, gtid, nthr);
        cvt_bf16_stream(peer_u, UT, (size_t)16384 * 2048 / 8, gtid, nthr);
        cvt_bf16_stream(peer_v, VT, (size_t)16384 * 2048 / 8, gtid, nthr);
    }
    SEAM(0);
    if (IN(1)) {
        pg8::Gemm g{XN, WtIn, T, INC, DM}; pg8::StaticOrder S; S.init(T, INC, G, bx);
        pg8::EpiProj E{Qb, qg, kg};
        pg8::gemm_phase<pg8::EpiProj, pg8::StaticOrder, true, true>(lds, g, S, E);
    }
    SEAM(1);
    if (IN(2)) {
        float a = lq1[lane] * lk1[lane], b2 = lq2[lane] * lk2[lane];
        a = wave_sum(a); b2 = wave_sum(b2);
        const float lam = expf(a) - expf(b2) + 0.2f;
        const float mq = wave_max(fabsf(qg[lane])), mk = wave_max(fabsf(kg[lane]));
        const float M2 = 64.f * C2 * mq * mk;
#if DBG_NAIVE_ATTN
        for (int r = gw; r < NB * NH * SEQ; r += NGW) naive_attn_row(r >> 14, (r >> 11) & 7, r & 2047, Qb, Kb, Vb, MIX, subg, lam, (LAS float*)(lds + wave * 16384), lane);
        if (0)
#endif
        for (int v = vcu; v < NB * NH * 4; v += G) {
            const int bh = v >> 2, s = v & 3, b = bh >> 3, h = bh & 7;
#pragma unroll 1
            for (int i = 0; i < 4; ++i) { const int qblk = (i == 0) ? s : (i == 1) ? 7 - s : (i == 2) ? 8 + s : 15 - s;
                att::attn_unit(b, h, qblk, Qb, Kb, Vb, MIX, subg, lam, M2, (LAS char*)lds); }
        }
        for (size_t it = gtid; it < (size_t)(T / 16) * 128; it += nthr) {
            const int cg8 = (int)(it & 127), chunk = (int)(it >> 7), t0 = chunk * 16, col = cg8 * 8;
            f32x4 w0a = *(const f32x4*)(conv_w + col), w0b = *(const f32x4*)(conv_w + col + 4), w1a = *(const f32x4*)(conv_w + 1024 + col), w1b = *(const f32x4*)(conv_w + 1024 + col + 4),
                  w2a = *(const f32x4*)(conv_w + 2048 + col), w2b = *(const f32x4*)(conv_w + 2048 + col + 4);
            float u1[8], u2[8];
#pragma unroll
            for (int i = 0; i < 8; ++i) { u1[i] = 0.f; u2[i] = 0.f; }
            if ((t0 % SEQ) != 0) {
                const v4u c1 = *(const v4u*)(CC + (size_t)(t0 - 1) * 1024 + col), x1v = *(const v4u*)(CX + (size_t)(t0 - 1) * 1024 + col), c2 = *(const v4u*)(CC + (size_t)(t0 - 2) * 1024 + col), x2v = *(const v4u*)(CX + (size_t)(t0 - 2) * 1024 + col);
                u1[0] = bflo(c1.x) * bflo(x1v.x); u1[1] = bfhi(c1.x) * bfhi(x1v.x); u1[2] = bflo(c1.y) * bflo(x1v.y); u1[3] = bfhi(c1.y) * bfhi(x1v.y); u1[4] = bflo(c1.z) * bflo(x1v.z); u1[5] = bfhi(c1.z) * bfhi(x1v.z); u1[6] = bflo(c1.w) * bflo(x1v.w); u1[7] = bfhi(c1.w) * bfhi(x1v.w);
                u2[0] = bflo(c2.x) * bflo(x2v.x); u2[1] = bfhi(c2.x) * bfhi(x2v.x); u2[2] = bflo(c2.y) * bflo(x2v.y); u2[3] = bfhi(c2.y) * bfhi(x2v.y); u2[4] = bflo(c2.z) * bflo(x2v.z); u2[5] = bfhi(c2.z) * bfhi(x2v.z); u2[6] = bflo(c2.w) * bflo(x2v.w); u2[7] = bfhi(c2.w) * bfhi(x2v.w);
            }
            const float w0[8] = {w0a.x, w0a.y, w0a.z, w0a.w, w0b.x, w0b.y, w0b.z, w0b.w}, w1[8] = {w1a.x, w1a.y, w1a.z, w1a.w, w1b.x, w1b.y, w1b.z, w1b.w}, w2[8] = {w2a.x, w2a.y, w2a.z, w2a.w, w2b.x, w2b.y, w2b.z, w2b.w};
#pragma unroll 4
            for (int j = 0; j < 16; ++j) { const size_t ro = (size_t)(t0 + j) * 1024 + col;
                const v4u bv = *(const v4u*)(CB + ro), cv = *(const v4u*)(CC + ro), xv = *(const v4u*)(CX + ro);
                float u0[8], bb[8], y[8];
                u0[0] = bflo(cv.x) * bflo(xv.x); u0[1] = bfhi(cv.x) * bfhi(xv.x); u0[2] = bflo(cv.y) * bflo(xv.y); u0[3] = bfhi(cv.y) * bfhi(xv.y); u0[4] = bflo(cv.z) * bflo(xv.z); u0[5] = bfhi(cv.z) * bfhi(xv.z); u0[6] = bflo(cv.w) * bflo(xv.w); u0[7] = bfhi(cv.w) * bfhi(xv.w);
                bb[0] = bflo(bv.x); bb[1] = bfhi(bv.x); bb[2] = bflo(bv.y); bb[3] = bfhi(bv.y); bb[4] = bflo(bv.z); bb[5] = bfhi(bv.z); bb[6] = bflo(bv.w); bb[7] = bfhi(bv.w);
#pragma unroll
                for (int i = 0; i < 8; ++i) { y[i] = bb[i] * (u2[i] * w0[i] + u1[i] * w1[i] + u0[i] * w2[i]); u2[i] = u1[i]; u1[i] = u0[i]; }
                v4u o; o.x = pk2(y[0], y[1]); o.y = pk2(y[2], y[3]); o.z = pk2(y[4], y[5]); o.w = pk2(y[6], y[7]);
                *(v4u*)(MIX + (size_t)(t0 + j) * 2048 + 1024 + col) = o; }
        }
    }
    SEAM(2);
    if (IN(3)) {
        pg8::Gemm g{MIX, WtOut, T, DM, DM}; pg8::StaticOrder S; S.init(T, DM, G, bx);
        pg8::EpiX1 E{x, out, A2, ffn_g, SSQ};
        pg8::gemm_phase<pg8::EpiX1, pg8::StaticOrder, true, true>(lds, g, S, E);
    }
    SEAM(3);
    if (IN(4)) {
        pg8::Gemm g{A2, WtQ, T, DM, DM}; pg8::StaticOrder S; S.init(T, DM, G, bx);
        pg8::EpiBf16<0> E{QP, DM, nullptr, 0, 0, 1.f};
        pg8::gemm_phase<pg8::EpiBf16<0>, pg8::StaticOrder, true, true>(lds, g, S, E);
    }
    SEAM(4);
    if (IN(5)) {
        for (int it = vcu; it < (T / 128) * PEH; it += G) peer_topk_item(it >> 3, it & 7, QP, SK, SSQ, EIDX, EGATE, RSTD, (LAS char*)lds);
    }
    SEAM(5);
    if (IN(6)) {
#if DBG_NAIVE_P6
        for (int t = gw; t < T; t += NGW) naive_expert_token(t, A2, UT, VT, EIDX, EGATE, RSTD, out, lane);
#elif !defined(DBG_SKIP_PEER)
        for (int t = gw; t < T; t += NGW) peer_expert_token(t, A2, UT, VT, EIDX, EGATE, RSTD, out, lane);
#endif
    }
#undef IN
#undef SEAM
}

extern "C" void kernel_launch(void* const* d_in, const int* in_sizes, int n_in, void* d_out, int out_size, void* d_ws, size_t ws_size, hipStream_t stream) {
    static int grid = 0;
    if (grid == 0) {
        if (n_in != 17 || out_size != T * DM || ws_size < WS_END) { fprintf(stderr, "kernel_launch: unexpected shapes (n_in %d out %d ws %zu)\n", n_in, out_size, ws_size); grid = -1; return; }
        int dev = 0, cus = 0, per_cu = 0;
        if (hipGetDevice(&dev) != hipSuccess || hipDeviceGetAttribute(&cus, hipDeviceAttributeMultiprocessorCount, dev) != hipSuccess) { grid = -1; return; }
        if (hipFuncSetAttribute((const void*)mk_fwd, hipFuncAttributeMaxDynamicSharedMemorySize, LDS_BYTES) != hipSuccess) { fprintf(stderr, "kernel_launch: hipFuncSetAttribute failed\n"); grid = -1; return; }
        if (hipOccupancyMaxActiveBlocksPerMultiprocessor(&per_cu, (const void*)mk_fwd, NTHREADS, LDS_BYTES) != hipSuccess || per_cu < 1) { fprintf(stderr, "kernel_launch: occupancy query says %d blocks per CU\n", per_cu); (void)hipGetLastError(); grid = -1; return; }
        grid = cus;
    }
    if (grid < 0) return;
    Args a{};
    for (int i = 0; i < 17; ++i) a.in[i] = (const float*)d_in[i];
    a.out = (float*)d_out; a.ws = (unsigned char*)d_ws;
#if MK_N_LAUNCHES == 1
    a.ph_lo = 0; a.ph_hi = NPHASE;
    void* kargs[] = {&a};
    hipError_t e = hipLaunchCooperativeKernel((const void*)mk_fwd, dim3(grid), dim3(NTHREADS), kargs, LDS_BYTES, stream);
    if (e != hipSuccess) fprintf(stderr, "kernel_launch: cooperative launch failed: %s (grid %d)\n", hipGetErrorString(e), grid);
#else
    for (int p = 0; p < NPHASE; ++p) { a.ph_lo = p; a.ph_hi = p + 1; hipLaunchKernelGGL(mk_fwd, dim3(grid), dim3(NTHREADS), LDS_BYTES, stream, a); }
#endif
}
```

```cpp
#include <hip/hip_runtime.h>
#include <hip/hip_cooperative_groups.h>
#include <cstdio>
#include <cstdint>
#include <cmath>
namespace cg = cooperative_groups;
namespace pg8 {
#define PG8_LAS __attribute__((address_space(3)))
typedef unsigned short bf16_t;
typedef short bf16x8 __attribute__((ext_vector_type(8)));
typedef float f32x4 __attribute__((ext_vector_type(4)));
typedef unsigned u32x4 __attribute__((ext_vector_type(4)));
constexpr int BM = 256, BK = 64, HALF = 128, HTB = HALF * BK * 2  , STAGE_BYTES = 8 * HTB, NXCD = 8, WGM = 8;

__host__ __device__ __forceinline__ int lds_byte(int r, int c) { const int st = (r >> 4) * 2 + (c >> 5), rr = r & 15, cc = c & 31, ob = rr * 64 + cc * 2; return st * 1024 + (ob ^ (((ob >> 9) & 1) << 5)); }
__host__ __device__ __forceinline__ void stage_rc(int b, int& R, int& C) { const int st = b / 1024, sb = b % 1024, swz = sb ^ (((sb >> 9) & 1) << 5); R = (st >> 1) * 16 + swz / 64; C = (st & 1) * 32 + (swz % 64) / 2; }
__host__ __device__ __forceinline__ int perm32(int rho) { const int n = rho >> 4, i = rho & 15; return 8 * (i >> 2) + 4 * n + (i & 3); }

struct Unit { int pm, pn; };
struct Gemm { const bf16_t* A; const bf16_t* Bt; int M, N, K; };

struct StaticOrder {
    int nM, nN, nwg, G, c;
    __host__ __device__ void init(int M, int N, int G_, int c_) { nM = M / BM; nN = N / BM; nwg = nM * nN; G = G_; c = c_; }
    __host__ __device__ bool next(int i, Unit& u) const {
        const long L = (long)i * G + c; if (L >= nwg) return false;
        int wgid = (int)L; { const int q = nwg / NXCD, r = nwg % NXCD, xcd = wgid % NXCD, off = wgid / NXCD; wgid = (xcd < r ? xcd * (q + 1) : r * (q + 1) + (xcd - r) * q) + off; }
        const int nig = WGM * nN, gid = wgid / nig, fm = gid * WGM, gsz = (nM - fm) < WGM ? (nM - fm) : WGM;
        u.pm = fm + ((wgid % nig) % gsz); u.pn = (wgid % nig) / gsz; return true;
    }
    __device__ __forceinline__ void a_ready(const Unit&) const {}
    __device__ __forceinline__ void done(const Unit&) const {}
};

__device__ __forceinline__ unsigned cvt_pk_bf16(float lo, float hi) { unsigned r; asm volatile("v_cvt_pk_bf16_f32 %0, %1, %2" : "=v"(r) : "v"(lo), "v"(hi)); return r; }
typedef float f32x2 __attribute__((ext_vector_type(2)));
__device__ __forceinline__ f32x2 gelu_pk(f32x2 v) {
    const f32x2 av = __builtin_elementwise_abs(v), d = av * 0.2316418882f + 1.0f;
    f32x2 t; t.x = __builtin_amdgcn_rcpf(d.x); t.y = __builtin_amdgcn_rcpf(d.y);
    f32x2 q = t * 0.5307027145f + (-0.7265760135f); q = q * t + 0.7107068705f; q = q * t + (-0.142248368f); q = q * t + 0.127414796f; q = q * t;
    const f32x2 s = (v * v) * (-0.72134752044f);
    f32x2 e; e.x = __builtin_amdgcn_exp2f(s.x); e.y = __builtin_amdgcn_exp2f(s.y);
    const f32x2 m = v * (q * e), r = v - m;
    f32x2 o; o.x = v.x < 0.f ? m.x : r.x; o.y = v.y < 0.f ? m.y : r.y; return o;
}

template <int ACT  > struct EpiBf16 {
    static constexpr bool PERM = true, AFTER_DRAIN = false; static_assert(ACT == 0 || ACT == 1, "EpiBf16: ACT is 0 (none) or 1 (gelu_pk)");
    bf16_t* O; int ldc; const float* bias; int split_cols; size_t split_stride; float scale0;
    __device__ __forceinline__ void operator()(const f32x4 (&acc)[2][2][4][2], const Unit& u, int wr, int wc, int fr, int fq) const {
        const int row0 = u.pm * BM + wr * 64 + fr; int colt = u.pn * BM; bf16_t* base = O;
        float sc = 1.f; if (split_cols) { const int t = colt / split_cols; base += (size_t)t * split_stride; colt -= t * split_cols; if (t == 0) sc = scale0; }
        const int col0 = colt + wc * 32 + 8 * fq, bcol0 = u.pn * BM + wc * 32 + 8 * fq;
        f32x4 bv[2][2];
#pragma unroll
        for (int bj = 0; bj < 2; ++bj)
#pragma unroll
            for (int n = 0; n < 2; ++n) bv[bj][n] = bias ? *(const f32x4*)(bias + bcol0 + bj * HALF + 4 * n) : (f32x4){0.f, 0.f, 0.f, 0.f};
#pragma unroll
        for (int ai = 0; ai < 2; ++ai)
#pragma unroll
            for (int m = 0; m < 4; ++m) { bf16_t* rowp = base + (size_t)(row0 + ai * HALF + m * 16) * ldc + col0;
#pragma unroll
                for (int bj = 0; bj < 2; ++bj) { f32x4 v0 = acc[ai][bj][m][0] + bv[bj][0], v1 = acc[ai][bj][m][1] + bv[bj][1];
                    if (ACT == 1) { f32x2 a = gelu_pk((f32x2){v0[0], v0[1]}), b = gelu_pk((f32x2){v0[2], v0[3]}), c = gelu_pk((f32x2){v1[0], v1[1]}), d = gelu_pk((f32x2){v1[2], v1[3]});
                        v0 = (f32x4){a.x, a.y, b.x, b.y}; v1 = (f32x4){c.x, c.y, d.x, d.y}; }
                    v0 = v0 * sc; v1 = v1 * sc; u32x4 w; w.x = cvt_pk_bf16(v0[0], v0[1]); w.y = cvt_pk_bf16(v0[2], v0[3]); w.z = cvt_pk_bf16(v1[0], v1[1]); w.w = cvt_pk_bf16(v1[2], v1[3]);
                    *(u32x4*)(rowp + bj * HALF) = w; } }
    }
};
template <class Epi, class Sched, bool ALIGN_EPI = false, bool SP2 = false>
__device__ __forceinline__ void gemm_phase(PG8_LAS unsigned char* lds, const Gemm g, const Sched& S, const Epi& E) {
    const int tid = threadIdx.x, wid = __builtin_amdgcn_readfirstlane(tid >> 6), lane = tid & 63, wr = wid >> 2, wc = wid & 3, fr = lane & 15, fq = lane >> 4;
    const int K = g.K, nt = K / BK;
    unsigned voffA[2], voffB[2];
#pragma unroll
    for (int i = 0; i < 2; ++i) { int R, C; stage_rc(tid * 16 + i * 8192, R, C); const int Rb = Epi::PERM ? ((R & ~31) + perm32(R & 31)) : R;
        voffA[i] = (unsigned)(R * K + C) * 2u; voffB[i] = (unsigned)(Rb * K + C) * 2u; }
    const size_t kstep = (size_t)(BK * 2);
    const size_t hstep = (size_t)HALF * K * 2;
    const size_t tstep = 2 * hstep;
    const unsigned ldsw = (unsigned)wid * 1024u;
    const int aoff = lds_byte(wr * 64 + fr, fq * 8), boff = lds_byte(wc * 32 + fr, fq * 8);
#define PG8_SA(b, h) (((b) * 2 + (h)) * HTB)
#define PG8_SB(b, h) ((4 + (b) * 2 + (h)) * HTB)
#define PG8_STAGE(bufoff, gbase, voff) do { _Pragma("unroll") for (int _i = 0; _i < 2; ++_i) \
        __builtin_amdgcn_global_load_lds((const unsigned*)((const char*)(gbase) + (voff)[_i]), (PG8_LAS unsigned*)(lds + (bufoff) + ldsw + _i * 8192), 16, 0, 0); } while (0)
#define PG8_LDA(dst, b, h) do { _Pragma("unroll") for (int m = 0; m < 4; ++m) _Pragma("unroll") for (int k = 0; k < 2; ++k) dst[m][k] = *(const PG8_LAS bf16x8*)(lds + PG8_SA(b, h) + aoff + m * 2048 + k * 1024); } while (0)
#define PG8_LDB(dst, b, h) do { _Pragma("unroll") for (int n = 0; n < 2; ++n) _Pragma("unroll") for (int k = 0; k < 2; ++k) dst[n][k] = *(const PG8_LAS bf16x8*)(lds + PG8_SB(b, h) + boff + n * 2048 + k * 1024); } while (0)
#define PG8_MMA(ai, bj, At, Bt) do { __builtin_amdgcn_s_setprio(1); _Pragma("unroll") for (int m = 0; m < 4; ++m) _Pragma("unroll") for (int n = 0; n < 2; ++n) _Pragma("unroll") for (int k = 0; k < 2; ++k) \
        acc[ai][bj][m][n] = __builtin_amdgcn_mfma_f32_16x16x32_bf16(Bt[n][k], At[m][k], acc[ai][bj][m][n], 0, 0, 0); __builtin_amdgcn_s_setprio(0); } while (0)
#define PG8_WAIT_V(n) asm volatile("s_waitcnt vmcnt(" #n ")" ::: "memory")
#define PG8_WAIT_L(n) asm volatile("s_waitcnt lgkmcnt(" #n ")" ::: "memory")
#define PG8_BAR __builtin_amdgcn_s_barrier()
#define PG8_SCHED __builtin_amdgcn_sched_barrier(0)
    Unit cur, nxt; int ui = 0;
    if (!S.next(0, cur)) return;
    f32x4 acc[2][2][4][2];
#pragma unroll
    for (int a = 0; a < 2; ++a)
#pragma unroll
        for (int b = 0; b < 2; ++b)
#pragma unroll
            for (int m = 0; m < 4; ++m)
#pragma unroll
                for (int n = 0; n < 2; ++n) acc[a][b][m][n] = (f32x4){0.f, 0.f, 0.f, 0.f};
    bf16x8 At[4][2], B0[2][2], B1[2][2];
    const char* cA = (const char*)g.A + (size_t)cur.pm * tstep; const char* cB = (const char*)g.Bt + (size_t)cur.pn * tstep;
    S.a_ready(cur);
    if constexpr (SP2) {
        PG8_STAGE(PG8_SB(0, 0), cB, voffB); PG8_STAGE(PG8_SB(0, 1), cB + hstep, voffB); PG8_STAGE(PG8_SA(0, 0), cA, voffA); PG8_STAGE(PG8_SA(0, 1), cA + hstep, voffA);
        if (wr == 1) PG8_BAR;
        PG8_WAIT_V(2); PG8_BAR;
        PG8_STAGE(PG8_SB(1, 0), cB + kstep, voffB); PG8_STAGE(PG8_SA(1, 0), cA + kstep, voffA); PG8_STAGE(PG8_SB(1, 1), cB + hstep + kstep, voffB);
        PG8_WAIT_V(6); PG8_BAR;
    } else {
        PG8_STAGE(PG8_SB(0, 0), cB, voffB); PG8_STAGE(PG8_SA(0, 0), cA, voffA); PG8_STAGE(PG8_SB(0, 1), cB + hstep, voffB); PG8_STAGE(PG8_SA(0, 1), cA + hstep, voffA);
        if (wr == 1) PG8_BAR;
        PG8_WAIT_V(4); PG8_BAR;
        PG8_STAGE(PG8_SB(1, 0), cB + kstep, voffB); PG8_STAGE(PG8_SA(1, 0), cA + kstep, voffA); PG8_STAGE(PG8_SB(1, 1), cB + hstep + kstep, voffB);
        PG8_WAIT_V(6); PG8_BAR;
    }
    for (;;) {
        const bool has_next = S.next(ui + 1, nxt);
        const char* nA = has_next ? (const char*)g.A + (size_t)nxt.pm * tstep : cA; const char* nB = has_next ? (const char*)g.Bt + (size_t)nxt.pn * tstep : cB;
        for (int t = 0; t < nt; t += 2) {
            const bool last = (t == nt - 2);
            const char* a1 = cA + (size_t)(t + 1) * kstep;
            const char* a2 = last ? nA : cA + (size_t)(t + 2) * kstep; const char* b2 = last ? nB : cB + (size_t)(t + 2) * kstep;
            const char* a3 = a2 + kstep; const char* b3 = b2 + kstep;
            if (last && has_next) S.a_ready(nxt);
            if constexpr (SP2) {
            PG8_LDB(B0, 0, 0); PG8_LDB(B1, 0, 1); PG8_SCHED; PG8_LDA(At, 0, 0); PG8_STAGE(PG8_SA(1, 1), a1 + hstep, voffA);
            PG8_WAIT_V(8); PG8_WAIT_L(0); PG8_BAR; PG8_MMA(0, 0, At, B0); PG8_MMA(0, 1, At, B1); PG8_BAR; PG8_SCHED;
            PG8_LDA(At, 0, 1); PG8_STAGE(PG8_SB(0, 0), b2, voffB); PG8_STAGE(PG8_SB(0, 1), b2 + hstep, voffB); PG8_STAGE(PG8_SA(0, 0), a2, voffA);
            PG8_WAIT_V(8); PG8_WAIT_L(0); PG8_BAR; PG8_MMA(1, 0, At, B0); PG8_MMA(1, 1, At, B1); PG8_BAR; PG8_SCHED;
            PG8_LDB(B0, 1, 0); PG8_LDB(B1, 1, 1); PG8_SCHED; PG8_LDA(At, 1, 0); PG8_STAGE(PG8_SA(0, 1), a2 + hstep, voffA);
            PG8_WAIT_V(8); PG8_WAIT_L(0); PG8_BAR; PG8_MMA(0, 0, At, B0); PG8_MMA(0, 1, At, B1); PG8_BAR; PG8_SCHED;
            PG8_LDA(At, 1, 1); PG8_STAGE(PG8_SB(1, 0), b3, voffB); PG8_STAGE(PG8_SB(1, 1), b3 + hstep, voffB); PG8_STAGE(PG8_SA(1, 0), a3, voffA);
            PG8_WAIT_V(8); PG8_WAIT_L(0); PG8_BAR; PG8_MMA(1, 0, At, B0); PG8_MMA(1, 1, At, B1); PG8_BAR; PG8_SCHED;
            } else {
            PG8_LDB(B0, 0, 0); PG8_SCHED; PG8_LDA(At, 0, 0); PG8_STAGE(PG8_SA(1, 1), a1 + hstep, voffA);
            PG8_WAIT_L(8); PG8_BAR; PG8_WAIT_L(0); PG8_MMA(0, 0, At, B0); PG8_BAR; PG8_SCHED;
            PG8_LDB(B1, 0, 1); PG8_STAGE(PG8_SB(0, 0), b2, voffB);
            PG8_BAR; PG8_WAIT_L(0); PG8_MMA(0, 1, At, B1); PG8_BAR;
            PG8_LDA(At, 0, 1); PG8_STAGE(PG8_SA(0, 0), a2, voffA);
            PG8_BAR; PG8_WAIT_L(0); PG8_MMA(1, 0, At, B0); PG8_BAR; PG8_SCHED;
            PG8_STAGE(PG8_SB(0, 1), b2 + hstep, voffB);
            PG8_WAIT_V(6); PG8_BAR; PG8_MMA(1, 1, At, B1); PG8_BAR;
            PG8_LDB(B0, 1, 0); PG8_SCHED; PG8_LDA(At, 1, 0); PG8_STAGE(PG8_SA(0, 1), a2 + hstep, voffA);
            PG8_WAIT_L(8); PG8_BAR; PG8_WAIT_L(0); PG8_MMA(0, 0, At, B0); PG8_BAR; PG8_SCHED;
            PG8_LDB(B1, 1, 1); PG8_STAGE(PG8_SB(1, 0), b3, voffB);
            PG8_BAR; PG8_WAIT_L(0); PG8_MMA(0, 1, At, B1); PG8_BAR;
            PG8_LDA(At, 1, 1); PG8_STAGE(PG8_SA(1, 0), a3, voffA);
            PG8_BAR; PG8_WAIT_L(0); PG8_MMA(1, 0, At, B0); PG8_BAR; PG8_SCHED;
            PG8_STAGE(PG8_SB(1, 1), b3 + hstep, voffB);
            PG8_WAIT_V(6); PG8_BAR; PG8_MMA(1, 1, At, B1); PG8_BAR;
            }
        }
        if constexpr (ALIGN_EPI) { if (wr == 0) PG8_BAR; }
        if constexpr (!Epi::AFTER_DRAIN) { E(acc, cur, wr, wc, fr, fq); S.done(cur); }
        if (!has_next) break;
#pragma unroll
        for (int a = 0; a < 2; ++a)
#pragma unroll
            for (int b = 0; b < 2; ++b)
#pragma unroll
                for (int m = 0; m < 4; ++m)
#pragma unroll
                    for (int n = 0; n < 2; ++n) acc[a][b][m][n] = (f32x4){0.f, 0.f, 0.f, 0.f};
        cur = nxt; cA = nA; cB = nB; ++ui;
        if constexpr (ALIGN_EPI) { if (wr == 1) PG8_BAR; }
    }
    PG8_WAIT_V(0);
    if constexpr (!ALIGN_EPI) { if (wr == 0) PG8_BAR; }
    PG8_BAR;
    if constexpr (Epi::AFTER_DRAIN) { E.fused(acc, cur, wr, wc, fr, fq, lds, wid, lane); S.done(cur); }
#undef PG8_SA
#undef PG8_SB
#undef PG8_STAGE
#undef PG8_LDA
#undef PG8_LDB
#undef PG8_MMA
#undef PG8_WAIT_V
#undef PG8_WAIT_L
#undef PG8_BAR
#undef PG8_SCHED
}
}
#define MK_N_LAUNCHES 1
#ifndef MK_N_LAUNCHES
#define MK_N_LAUNCHES 1
#endif
constexpr int DM = 2048, NB = 8, SEQ = 2048, T = NB * SEQ;
constexpr int AW = 1024, NH = 8, HD = 64, VD = 128, INC = 6144;
constexpr int PNK = 128, PTOPK = 16, PEH = 8, EPT = PEH * PTOPK;
constexpr float EPS = 1e-6f;
constexpr float C2 = 0.125f * 1.4426950408889634f;
constexpr int NPHASE = 7;
constexpr float U8_SCALE = 256.f, V8_SCALE = 16.f;
constexpr size_t MiB = 1u << 20;
constexpr size_t WS_WIN = 1 * MiB, WS_WOUT = 25 * MiB, WS_WQ = 33 * MiB, WS_SK = 41 * MiB, WS_SSQ = 42 * MiB, WS_EIDX = 44 * MiB, WS_EGATE = 52 * MiB, WS_RSTD = 60 * MiB;
constexpr size_t WS_XN = 64 * MiB;
constexpr size_t WS_Q = 128 * MiB, WS_K = 160 * MiB, WS_V = 192 * MiB;
constexpr size_t WS_CB = 224 * MiB, WS_CC = 256 * MiB, WS_CX = 288 * MiB;
constexpr size_t WS_UT = 320 * MiB, WS_VT = 384 * MiB, WS_END = 448 * MiB;
constexpr int LDS_BYTES = 147456;
constexpr int NWAVES = 8, NTHREADS = 512;

#define LAS __attribute__((address_space(3)))
typedef unsigned short bf16;
typedef unsigned v4u __attribute__((ext_vector_type(4)));
typedef unsigned v2u __attribute__((ext_vector_type(2)));
typedef float f32x4 __attribute__((ext_vector_type(4)));
typedef float f32x2 __attribute__((ext_vector_type(2)));
typedef float f32x16 __attribute__((ext_vector_type(16)));
typedef short bf16x8 __attribute__((ext_vector_type(8)));
typedef short s16x4 __attribute__((ext_vector_type(4)));
typedef __bf16 bf16x2_t __attribute__((ext_vector_type(2)));
#define LDS_WAIT() asm volatile("s_waitcnt lgkmcnt(0)" ::: "memory")
__device__ __forceinline__ unsigned pk2(float lo, float hi) { f32x2 v = {lo, hi}; bf16x2_t b = __builtin_convertvector(v, bf16x2_t); return __builtin_bit_cast(unsigned, b); }
__device__ __forceinline__ float bflo(unsigned u) { return __uint_as_float(u << 16); }
__device__ __forceinline__ float bfhi(unsigned u) { return __uint_as_float(u & 0xffff0000u); }
__device__ __forceinline__ float wave_sum(float v) {
#pragma unroll
    for (int o = 1; o < 64; o <<= 1) v += __shfl_xor(v, o);
    return v;
}
__device__ __forceinline__ float wave_max(float v) {
#pragma unroll
    for (int o = 1; o < 64; o <<= 1) v = fmaxf(v, __shfl_xor(v, o));
    return v;
}

namespace pg8 {
struct EpiProj {
    static constexpr bool PERM = true, AFTER_DRAIN = false;
    bf16_t* base0; const float* qg; const float* kg;
    __device__ __forceinline__ void operator()(const f32x4 (&acc)[2][2][4][2], const Unit& u, int wr, int wc, int fr, int fq) const {
        const int region = u.pn >> 2;
        bf16_t* O = base0 + (size_t)region * (16u << 20);
        const int row0 = u.pm * BM + wr * 64 + fr, col0 = (u.pn & 3) * 256 + wc * 64 + 8 * fq;
        if (region < 2) {
            const float* g = region == 0 ? qg : kg; const float sc = region == 0 ? 0.125f * 1.4426950408889634f : 1.0f;
            f32x4 gv[2][2];
#pragma unroll
            for (int bj = 0; bj < 2; ++bj)
#pragma unroll
                for (int n = 0; n < 2; ++n) gv[bj][n] = *(const f32x4*)(g + bj * 32 + 8 * fq + 4 * n) * sc;
#pragma unroll
            for (int ai = 0; ai < 2; ++ai)
#pragma unroll
                for (int m = 0; m < 4; ++m) {
                    float ss = 0.f;
#pragma unroll
                    for (int bj = 0; bj < 2; ++bj)
#pragma unroll
                        for (int n = 0; n < 2; ++n) { const f32x4 x = acc[ai][bj][m][n]; ss += (x[0] * x[0] + x[1] * x[1]) + (x[2] * x[2] + x[3] * x[3]); }
                    ss += __shfl_xor(ss, 16); ss += __shfl_xor(ss, 32);
                    const float rs = __builtin_amdgcn_rsqf(ss * (1.0f / 64.0f) + 1e-6f);
                    bf16_t* rowp = O + (size_t)(row0 + ai * HALF + m * 16) * 1024 + col0;
#pragma unroll
                    for (int bj = 0; bj < 2; ++bj) { const f32x4 v0 = acc[ai][bj][m][0] * rs * gv[bj][0], v1 = acc[ai][bj][m][1] * rs * gv[bj][1];
                        u32x4 w; w.x = cvt_pk_bf16(v0[0], v0[1]); w.y = cvt_pk_bf16(v0[2], v0[3]); w.z = cvt_pk_bf16(v1[0], v1[1]); w.w = cvt_pk_bf16(v1[2], v1[3]);
                        *(u32x4*)(rowp + bj * 32) = w; }
                }
        } else {
#pragma unroll
            for (int ai = 0; ai < 2; ++ai)
#pragma unroll
                for (int m = 0; m < 4; ++m) { bf16_t* rowp = O + (size_t)(row0 + ai * HALF + m * 16) * 1024 + col0;
#pragma unroll
                    for (int bj = 0; bj < 2; ++bj) { const f32x4 v0 = acc[ai][bj][m][0], v1 = acc[ai][bj][m][1];
                        u32x4 w; w.x = cvt_pk_bf16(v0[0], v0[1]); w.y = cvt_pk_bf16(v0[2], v0[3]); w.z = cvt_pk_bf16(v1[0], v1[1]); w.w = cvt_pk_bf16(v1[2], v1[3]);
                        *(u32x4*)(rowp + bj * 32) = w; } }
        }
    }
};
struct EpiX1 {
    static constexpr bool PERM = true, AFTER_DRAIN = false;
    const float* x; float* out; bf16_t* a2; const float* gf; float* ssq;
    __device__ __forceinline__ void operator()(const f32x4 (&acc)[2][2][4][2], const Unit& u, int wr, int wc, int fr, int fq) const {
        const int row0 = u.pm * BM + wr * 64 + fr, col0 = u.pn * BM + wc * 32 + 8 * fq;
        f32x4 gv[2][2];
#pragma unroll
        for (int bj = 0; bj < 2; ++bj)
#pragma unroll
            for (int n = 0; n < 2; ++n) gv[bj][n] = *(const f32x4*)(gf + col0 + bj * HALF + 4 * n);
#pragma unroll
        for (int ai = 0; ai < 2; ++ai)
#pragma unroll
            for (int m = 0; m < 4; ++m) { const int row = row0 + ai * HALF + m * 16; const size_t off = (size_t)row * 2048 + col0; float ss = 0.f;
#pragma unroll
                for (int bj = 0; bj < 2; ++bj) {
                    const f32x4 x0 = *(const f32x4*)(x + off + bj * HALF), x1 = *(const f32x4*)(x + off + bj * HALF + 4);
                    const f32x4 v0 = x0 + acc[ai][bj][m][0], v1 = x1 + acc[ai][bj][m][1];
                    *(f32x4*)(out + off + bj * HALF) = v0; *(f32x4*)(out + off + bj * HALF + 4) = v1;
                    ss += (v0[0] * v0[0] + v0[1] * v0[1]) + (v0[2] * v0[2] + v0[3] * v0[3]); ss += (v1[0] * v1[0] + v1[1] * v1[1]) + (v1[2] * v1[2] + v1[3] * v1[3]);
                    const f32x4 a0 = v0 * gv[bj][0], a1 = v1 * gv[bj][1];
                    u32x4 w; w.x = cvt_pk_bf16(a0[0], a0[1]); w.y = cvt_pk_bf16(a0[2], a0[3]); w.z = cvt_pk_bf16(a1[0], a1[1]); w.w = cvt_pk_bf16(a1[2], a1[3]);
                    *(u32x4*)(a2 + off + bj * HALF) = w; }
                ss += __shfl_xor(ss, 16); ss += __shfl_xor(ss, 32);
                if (fq == 0) ssq[(size_t)row * 32 + u.pn * 4 + wc] = ss; }
    }
};
}

__device__ __forceinline__ void p0_transpose_item(const float* W, int K, int N, bf16* WT, LAS float* scr, int item, int lane, bool permg) {
    const int nblk = N / 32, kb = item / nblk, nb = item % nblk, k0 = 64 * kb, n0 = 32 * nb;
#pragma unroll 8
    for (int i = 0; i < 32; ++i) { const int kk = 2 * i + (lane >> 5); scr[kk * 33 + (lane & 31)] = W[(size_t)(k0 + kk) * N + n0 + (lane & 31)]; }
    LDS_WAIT(); asm volatile("" ::: "memory");
    int nd = n0; if (permg) { const int gl = (n0 & 255) >> 5; nd = (n0 & ~255) + 32 * (4 * (gl & 1) + (gl >> 1)); }
    const int c = lane & 7;
#pragma unroll
    for (int j = 0; j < 4; ++j) { const int n = (lane >> 3) + 8 * j; const LAS float* s = scr + (8 * c) * 33 + n;
        v4u o; o.x = pk2(s[0 * 33], s[1 * 33]); o.y = pk2(s[2 * 33], s[3 * 33]); o.z = pk2(s[4 * 33], s[5 * 33]); o.w = pk2(s[6 * 33], s[7 * 33]);
        *(v4u*)(WT + (size_t)(nd + n) * K + k0 + 8 * c) = o; }
    LDS_WAIT(); asm volatile("" ::: "memory");
}
__device__ __forceinline__ void rms_row_to_bf16(const float* xrow, const float* g, bf16* orow, int lane) {
    const f32x4* xr = (const f32x4*)xrow + lane; const f32x4* gr = (const f32x4*)g + lane;
    f32x4 v[8]; float s = 0.f;
#pragma unroll
    for (int j = 0; j < 8; ++j) { v[j] = xr[64 * j]; s += (v[j].x * v[j].x + v[j].y * v[j].y) + (v[j].z * v[j].z + v[j].w * v[j].w); }
    const float rstd = 1.0f / sqrtf(wave_sum(s) * (1.f / DM) + EPS);
    v2u* o8 = (v2u*)orow + lane;
#pragma unroll
    for (int j = 0; j < 8; ++j) { const f32x4 gg = gr[64 * j]; v2u w; w.x = pk2(v[j].x * rstd * gg.x, v[j].y * rstd * gg.y); w.y = pk2(v[j].z * rstd * gg.z, v[j].w * rstd * gg.w); o8[64 * j] = w; }
}
__device__ __forceinline__ void cvt_bf16_stream(const float* src, bf16* dst, size_t n8, size_t gtid, size_t nthr) {
    for (size_t i = gtid; i < n8; i += nthr) { const f32x4 a = *(const f32x4*)(src + i * 8), b = *(const f32x4*)(src + i * 8 + 4);
        v4u o; o.x = pk2(a.x, a.y); o.y = pk2(a.z, a.w); o.z = pk2(b.x, b.y); o.w = pk2(b.z, b.w); *(v4u*)(dst + i * 8) = o; }
}

__device__ __forceinline__ void cvt_fp8_stream(const float* src, unsigned char* dst, float scale, size_t n16, size_t gtid, size_t nthr) {
    for (size_t i = gtid; i < n16; i += nthr) { v4u o;
#pragma unroll
        for (int q = 0; q < 4; ++q) { const f32x4 a = *(const f32x4*)(src + i * 16 + 4 * q) * scale; int w = __builtin_amdgcn_cvt_pk_fp8_f32(a.x, a.y, 0, false); w = __builtin_amdgcn_cvt_pk_fp8_f32(a.z, a.w, w, true);
            if (q == 0) o.x = (unsigned)w; else if (q == 1) o.y = (unsigned)w; else if (q == 2) o.z = (unsigned)w; else o.w = (unsigned)w; }
        *(v4u*)(dst + i * 16) = o; }
}

namespace att {
constexpr int SLOTB = 32768;
constexpr int NSLOT = 3, LW_OFF = NSLOT * SLOTB;
constexpr int XSTR = 132;
__device__ __forceinline__ void glds16(const void* gsrc, unsigned lds_dst) { unsigned keep;
    asm volatile("s_mov_b32 %0, m0\n\ts_mov_b32 m0, %2\n\ts_nop 0\n\tglobal_load_lds_dwordx4 %1, off\n\ts_mov_b32 m0, %0" : "=&s"(keep) : "v"(gsrc), "s"(lds_dst) : "memory"); }
__device__ __forceinline__ int crow(int r, int hi) { return (r & 3) + 8 * (r >> 2) + 4 * hi; }
typedef short v4i16_t __attribute__((ext_vector_type(4)));
__device__ __forceinline__ s16x4 vtr(const LAS char* p) { return __builtin_bit_cast(s16x4, __builtin_amdgcn_ds_read_tr16_b64_v4i16((LAS v4i16_t*)p)); }
#define ATT_WAIT_BAR(N) asm volatile("s_waitcnt vmcnt(" #N ") lgkmcnt(0)\n\ts_barrier" ::: "memory")

__device__ __forceinline__ void attn_unit(int b, int h, int qblk, const bf16* Q, const bf16* K, const bf16* V, bf16* MIX, const float* subg, float lam, float M2, LAS char* lds) {
    const int tid = threadIdx.x, lane = tid & 63, r32 = lane & 31, hi = lane >> 5, wid = __builtin_amdgcn_readfirstlane(tid >> 6), c = wid >> 2, qs = wid & 3;
    const size_t rowbase = (size_t)b * SEQ; const int q0 = qblk * 128, NT = 2 * (qblk + 1);
    const unsigned lds0 = (unsigned)(uintptr_t)lds;
    const bf16* ksrc[2]; const bf16* vsrc[2]; unsigned kdst[2], vdst[2];
#pragma unroll
    for (int i = 0; i < 2; ++i) { const int pk = 2 * wid + i, pc = pk >> 3, ch = pk & 7, d0 = pk >> 2, rg = pk & 3;
        ksrc[i] = K + (rowbase + lane) * 1024 + h * 128 + pc * 64 + ch * 8; kdst[i] = lds0 + pk * 1024;
        vsrc[i] = V + (rowbase + 16 * rg + (lane >> 2)) * 1024 + h * 128 + d0 * 32 + (lane & 3) * 8; vdst[i] = lds0 + 16384 + pk * 1024; }
#define ATT_DMA(t, slot) do { _Pragma("unroll") for (int i_ = 0; i_ < 2; ++i_) { glds16(ksrc[i_] + (size_t)(t) * 64 * 1024, (unsigned)__builtin_amdgcn_readfirstlane(kdst[i_] + (slot) * SLOTB)); \
        glds16(vsrc[i_] + (size_t)(t) * 64 * 1024, (unsigned)__builtin_amdgcn_readfirstlane(vdst[i_] + (slot) * SLOTB)); } } while (0)
    ATT_DMA(0, 0); ATT_DMA(1, 1);
    const int qrow = q0 + 32 * qs + r32;
    bf16x8 qr[4];
#pragma unroll
    for (int d0 = 0; d0 < 4; ++d0) qr[d0] = *(const bf16x8*)(Q + (rowbase + qrow) * 1024 + h * 128 + c * 64 + d0 * 16 + hi * 8);
    const float slope2 = exp2f(-(float)(h + 1)) * 1.4426950408889634f;
    float creg[16];
#pragma unroll
    for (int r = 0; r < 16; ++r) creg[r] = slope2 * (float)crow(r, hi);
    float base = -slope2 * (float)qrow - M2;
    const float s32 = 32.f * slope2, s64 = 64.f * slope2;
    f32x16 o[4]; o[0] = f32x16{}; o[1] = f32x16{}; o[2] = f32x16{}; o[3] = f32x16{};
    float lsum = 0.f;
    const LAS char* kp0 = (const LAS char*)lds + c * 8192 + hi * 1024 + r32 * 16;
    const LAS char* vp0 = (const LAS char*)lds + 16384 + ((lane >> 4) & 1) * 32 + (lane & 3) * 8 + (4 * hi + ((lane & 15) >> 2)) * 64;
    const int qw0 = q0 + 32 * qs;
    int slot = 0;
    for (int t = 0; t < NT; ++t) {
        if (t == 0) { ATT_WAIT_BAR(0); } else if (t + 1 < NT) { ATT_WAIT_BAR(4); } else { ATT_WAIT_BAR(0); }
        if (t + 2 < NT) { const int s2_ = (slot == 0) ? 2 : slot - 1; ATT_DMA(t + 2, s2_); }
        const int k0 = 64 * t;
        if (k0 <= qw0 + 31) {
            const LAS char* kp = kp0 + slot * SLOTB; const LAS char* vp = vp0 + slot * SLOTB;
            f32x16 p0, p1;
#pragma unroll
            for (int r = 0; r < 16; ++r) { p0[r] = base + creg[r]; p1[r] = p0[r] + s32; }
#pragma unroll
            for (int d0 = 0; d0 < 4; ++d0) {
                const bf16x8 ka = *(const LAS bf16x8*)(kp + d0 * 2048), kb = *(const LAS bf16x8*)(kp + d0 * 2048 + 512);
                p0 = __builtin_amdgcn_mfma_f32_32x32x16_bf16(ka, qr[d0], p0, 0, 0, 0);
                p1 = __builtin_amdgcn_mfma_f32_32x32x16_bf16(kb, qr[d0], p1, 0, 0, 0); }
#pragma unroll
            for (int r = 0; r < 16; ++r) { p0[r] = __builtin_amdgcn_exp2f(p0[r]); p1[r] = __builtin_amdgcn_exp2f(p1[r]); }
            if (k0 + 63 > qw0) {
                const int dq = qrow - k0;
#pragma unroll
                for (int r = 0; r < 16; ++r) { const int kk = crow(r, hi); if (kk > dq) p0[r] = 0.f; if (kk + 32 > dq) p1[r] = 0.f; }
            }
            float sacc = 0.f;
#pragma unroll
            for (int r = 0; r < 16; ++r) sacc += p0[r] + p1[r];
            lsum += sacc;
            bf16x8 pw[4];
#pragma unroll
            for (int ks = 0; ks < 4; ++ks) { v4u w;
                if (ks < 2) { w.x = pk2(p0[8 * ks + 0], p0[8 * ks + 1]); w.y = pk2(p0[8 * ks + 2], p0[8 * ks + 3]); w.z = pk2(p0[8 * ks + 4], p0[8 * ks + 5]); w.w = pk2(p0[8 * ks + 6], p0[8 * ks + 7]); }
                else { const int k2 = ks - 2; w.x = pk2(p1[8 * k2 + 0], p1[8 * k2 + 1]); w.y = pk2(p1[8 * k2 + 2], p1[8 * k2 + 3]); w.z = pk2(p1[8 * k2 + 4], p1[8 * k2 + 5]); w.w = pk2(p1[8 * k2 + 6], p1[8 * k2 + 7]); }
                pw[ks] = __builtin_bit_cast(bf16x8, w); }
#pragma unroll
            for (int d0 = 0; d0 < 4; ++d0)
#pragma unroll
                for (int ks = 0; ks < 4; ++ks) { const s16x4 lo = vtr(vp + d0 * 4096 + ks * 1024), hv = vtr(vp + d0 * 4096 + ks * 1024 + 512);
                    const bf16x8 vf = (bf16x8){lo[0], lo[1], lo[2], lo[3], hv[0], hv[1], hv[2], hv[3]};
                    o[d0] = __builtin_amdgcn_mfma_f32_32x32x16_bf16(pw[ks], vf, o[d0], 0, 0, 0); }
        }
        base += s64;
        slot = (slot == NSLOT - 1) ? 0 : slot + 1;
    }
    ATT_WAIT_BAR(0);
    LAS float* lw = (LAS float*)(lds + LW_OFF) + wid * 32;
    { auto rr = __builtin_amdgcn_permlane32_swap(__float_as_uint(lsum), __float_as_uint(lsum), false, false); lsum = __uint_as_float(rr[0]) + __uint_as_float(rr[1]); }
    if (hi == 0) lw[r32] = lsum;
    LDS_WAIT();
    LAS float* X = (LAS float*)lds + qs * 32 * XSTR;
#pragma unroll
    for (int r = 0; r < 16; ++r) { const float rl = 1.0f / lw[crow(r, hi)];
#pragma unroll
        for (int d0 = 0; d0 < 4; ++d0) o[d0][r] *= rl; }
    if (c == 1) {
#pragma unroll
        for (int r = 0; r < 16; ++r)
#pragma unroll
            for (int d0 = 0; d0 < 4; ++d0) X[crow(r, hi) * XSTR + d0 * 32 + r32] = o[d0][r];
    }
    ATT_WAIT_BAR(0);
    if (c == 0) {
#pragma unroll
        for (int r = 0; r < 16; ++r)
#pragma unroll
            for (int d0 = 0; d0 < 4; ++d0) { LAS float* px = X + crow(r, hi) * XSTR + d0 * 32 + r32; const float a = o[d0][r] - lam * (*px); *px = a; }
        LDS_WAIT(); asm volatile("" ::: "memory");
        const LAS f32x4* rp = (const LAS f32x4*)(X + r32 * XSTR + hi * 64);
        f32x4 av[16]; float ss = 0.f;
#pragma unroll
        for (int j = 0; j < 16; ++j) { av[j] = rp[j]; ss += (av[j].x * av[j].x + av[j].y * av[j].y) + (av[j].z * av[j].z + av[j].w * av[j].w); }
        { auto rr = __builtin_amdgcn_permlane32_swap(__float_as_uint(ss), __float_as_uint(ss), false, false); ss = __uint_as_float(rr[0]) + __uint_as_float(rr[1]); }
        const float rs = 0.8f / sqrtf(ss * (1.0f / 128.0f) + EPS);
        bf16* op = MIX + (rowbase + qrow) * 2048 + h * 128 + hi * 64;
#pragma unroll
        for (int j = 0; j < 8; ++j) { const f32x4 g0 = *(const f32x4*)(subg + hi * 64 + 8 * j), g1 = *(const f32x4*)(subg + hi * 64 + 8 * j + 4); const f32x4 a0 = av[2 * j] * rs * g0, a1 = av[2 * j + 1] * rs * g1;
            v4u w; w.x = pk2(a0.x, a0.y); w.y = pk2(a0.z, a0.w); w.z = pk2(a1.x, a1.y); w.w = pk2(a1.z, a1.w); *(v4u*)(op + 8 * j) = w; }
    }
    ATT_WAIT_BAR(0);
#undef ATT_DMA
}
}


#ifndef DBG_NAIVE_ATTN
#define DBG_NAIVE_ATTN 0
#endif
#if DBG_NAIVE_ATTN
__device__ __forceinline__ void naive_attn_row(int b, int h, int q, const bf16* Q, const bf16* K, const bf16* V, bf16* MIX, const float* subg, float lam, LAS float* S, int lane) {
    const size_t rowbase = (size_t)b * SEQ; const float slope2 = exp2f(-(float)(h + 1)) * 1.4426950408889634f;
    for (int c = 0; c < 2; ++c) {
        float qv[64];
        const bf16* qp = Q + (rowbase + q) * 1024 + h * 128 + c * 64;
#pragma unroll
        for (int d = 0; d < 64; d += 2) { const unsigned u = *(const unsigned*)(qp + d); qv[d] = bflo(u); qv[d + 1] = bfhi(u); }
        for (int key = lane; key <= q; key += 64) { const bf16* kp = K + (rowbase + key) * 1024 + h * 128 + c * 64; float s = 0.f;
#pragma unroll
            for (int d = 0; d < 64; d += 2) { const unsigned u = *(const unsigned*)(kp + d); s += qv[d] * bflo(u) + qv[d + 1] * bfhi(u); }
            S[c * 2048 + key] = s - slope2 * (float)(q - key); }
    }
    LDS_WAIT();
    float linv[2];
    for (int c = 0; c < 2; ++c) { float m = -1e30f; for (int key = lane; key <= q; key += 64) m = fmaxf(m, S[c * 2048 + key]); m = wave_max(m);
        float l = 0.f; for (int key = lane; key <= q; key += 64) { const float p = exp2f(S[c * 2048 + key] - m); S[c * 2048 + key] = p; l += p; } linv[c] = 1.0f / wave_sum(l); }
    for (int key = lane; key <= q; key += 64) S[key] = S[key] * linv[0] - lam * S[2048 + key] * linv[1];
    LDS_WAIT();
    float o0 = 0.f, o1 = 0.f; const bf16* vp = V + rowbase * 1024 + h * 128 + lane;
    for (int key = 0; key <= q; ++key) { const float a = S[key]; o0 += a * __uint_as_float((unsigned)vp[(size_t)key * 1024] << 16); o1 += a * __uint_as_float((unsigned)vp[(size_t)key * 1024 + 64] << 16); }
    const float ss = wave_sum(o0 * o0 + o1 * o1); const float rs = 0.8f / sqrtf(ss * (1.0f / 128.0f) + EPS);
    bf16* op = MIX + (rowbase + q) * 2048 + h * 128 + lane;
    op[0] = (bf16)(pk2(o0 * rs * subg[lane], 0.f) & 0xffffu); op[64] = (bf16)(pk2(o1 * rs * subg[lane + 64], 0.f) & 0xffffu);
    LDS_WAIT();
}
#endif

__device__ __forceinline__ unsigned ord_key(float f) { const unsigned u = __float_as_uint(f); return (u & 0x80000000u) ? ~u : (u | 0x80000000u); }
__device__ __forceinline__ float ord_val(unsigned k) { return __uint_as_float((k & 0x80000000u) ? (k ^ 0x80000000u) : ~k); }
#define TOPK_INS(tt, x_) do { unsigned x__ = (x_); _Pragma("unroll") for (int j_ = 0; j_ < 16; ++j_) { const unsigned hi__ = max(tt[j_], x__); x__ = min(tt[j_], x__); tt[j_] = hi__; } } while (0)

__device__ __forceinline__ void peer_topk_item(int tile, int h, const bf16* QP, const bf16* SK, const float* SSQ, int* EIDX, float* EGATE, float* RSTD, LAS char* lds) {
    const int tid = threadIdx.x, lane = tid & 63, r32 = lane & 31, hi = lane >> 5, wid = __builtin_amdgcn_readfirstlane(tid >> 6), c = wid >> 2, tb = wid & 3;
    constexpr int SSTR = 132;
    LAS float* SC = (LAS float*)lds;
    const int tok0 = tile * 128;
    {
        bf16x8 qf[8];
        const bf16* qp = QP + (size_t)(tok0 + tb * 32 + r32) * 2048 + h * 256 + c * 128 + hi * 8;
#pragma unroll
        for (int s = 0; s < 8; ++s) qf[s] = *(const bf16x8*)(qp + 16 * s);
        const bf16* sp = SK + (size_t)((h * 2 + c) * 128 + r32) * 128 + hi * 8;
#pragma unroll
        for (int kb = 0; kb < 4; ++kb) { f32x16 acc = f32x16{};
#pragma unroll
            for (int s = 0; s < 8; ++s) { const bf16x8 sf = *(const bf16x8*)(sp + (size_t)kb * 32 * 128 + 16 * s); acc = __builtin_amdgcn_mfma_f32_32x32x16_bf16(qf[s], sf, acc, 0, 0, 0); }
#pragma unroll
            for (int r = 0; r < 16; ++r) SC[(c * 128 + tb * 32 + att::crow(r, hi)) * SSTR + kb * 32 + r32] = acc[r]; }
    }
    __syncthreads();
    if (tid < 256) {
        LAS float* row = SC + tid * SSTR; unsigned tt[16];
#pragma unroll
        for (int j = 0; j < 16; ++j) tt[j] = 0u;
#pragma unroll 2
        for (int i = 0; i < 32; ++i) { const f32x4 v = *(const LAS f32x4*)(row + 4 * i);
            TOPK_INS(tt, (ord_key(v.x) & ~0x7Fu) | (unsigned)(4 * i)); TOPK_INS(tt, (ord_key(v.y) & ~0x7Fu) | (unsigned)(4 * i + 1));
            TOPK_INS(tt, (ord_key(v.z) & ~0x7Fu) | (unsigned)(4 * i + 2)); TOPK_INS(tt, (ord_key(v.w) & ~0x7Fu) | (unsigned)(4 * i + 3)); }
        LAS unsigned* lrow = (LAS unsigned*)row;
#pragma unroll
        for (int j = 0; j < 16; ++j) lrow[j] = tt[j];
    }
    __syncthreads();
    if (tid < 128) {
        const LAS unsigned* l1 = (const LAS unsigned*)(SC + tid * SSTR); const LAS unsigned* l2 = (const LAS unsigned*)(SC + (128 + tid) * SSTR);
        float v1[16], v2[16];
#pragma unroll
        for (int j = 0; j < 16; ++j) { v1[j] = ord_val(l1[j] & ~0x7Fu); v2[j] = ord_val(l2[j] & ~0x7Fu); }
        unsigned tt[16];
#pragma unroll
        for (int j = 0; j < 16; ++j) tt[j] = 0u;
#pragma unroll
        for (int i = 0; i < 16; ++i)
#pragma unroll
            for (int j = 0; j < 16; ++j) if ((i + 1) * (j + 1) <= 16) { TOPK_INS(tt, (ord_key(v1[i] + v2[j]) & ~0xFFu) | (unsigned)(i * 16 + j)); }
        const int t = tok0 + tid;
        float ssq = 0.f;
#pragma unroll
        for (int j = 0; j < 8; ++j) { const f32x4 p = *(const f32x4*)(SSQ + (size_t)t * 32 + 4 * j); ssq += (p.x + p.y) + (p.z + p.w); }
        const float rstd = 1.0f / sqrtf(ssq * (1.0f / DM) + EPS);
        if (h == 0) RSTD[t] = rstd;
        float ev[16]; int ex[16]; float es = 0.f, vmax = 0.f;
#pragma unroll
        for (int k = 0; k < 16; ++k) { const unsigned pid = tt[k] & 0xFFu; const unsigned a = l1[pid >> 4], b2 = l2[pid & 15u];
            const float sv = (ord_val(a & ~0x7Fu) + ord_val(b2 & ~0x7Fu)) * rstd; if (k == 0) vmax = sv;
            ev[k] = __expf(sv - vmax); es += ev[k]; ex[k] = (int)((a & 0x7Fu) * 128u + (b2 & 0x7Fu)); }
        const float inv = 1.0f / es;
        int* ei = EIDX + (size_t)t * 128 + h * 16; float* eg = EGATE + (size_t)t * 128 + h * 16;
#pragma unroll
        for (int k = 0; k < 16; k += 4) { *(int4*)(ei + k) = make_int4(ex[k], ex[k + 1], ex[k + 2], ex[k + 3]); *(f32x4*)(eg + k) = (f32x4){ev[k] * inv, ev[k + 1] * inv, ev[k + 2] * inv, ev[k + 3] * inv}; }
    }
    __syncthreads();
}

__device__ __forceinline__ f32x2 dot16_fp8(const v4u u, const f32x2* h, f32x2 acc) {
#pragma unroll
    for (int w = 0; w < 4; ++w) { const unsigned d = w == 0 ? u.x : w == 1 ? u.y : w == 2 ? u.z : u.w;
        const f32x2 f0 = __builtin_amdgcn_cvt_pk_f32_fp8((int)d, false), f1 = __builtin_amdgcn_cvt_pk_f32_fp8((int)d, true);
        acc = __builtin_elementwise_fma(h[2 * w], f0, acc); acc = __builtin_elementwise_fma(h[2 * w + 1], f1, acc); }
    return acc;
}
__device__ __forceinline__ void axpy16_fp8(const v4u v, f32x2 a2, f32x2* o) {
#pragma unroll
    for (int w = 0; w < 4; ++w) { const unsigned d = w == 0 ? v.x : w == 1 ? v.y : w == 2 ? v.z : v.w;
        const f32x2 f0 = __builtin_amdgcn_cvt_pk_f32_fp8((int)d, false), f1 = __builtin_amdgcn_cvt_pk_f32_fp8((int)d, true);
        o[2 * w] = __builtin_elementwise_fma(a2, f0, o[2 * w]); o[2 * w + 1] = __builtin_elementwise_fma(a2, f1, o[2 * w + 1]); }
}
__device__ __forceinline__ void peer_expert_token(int t, const bf16* A2, const unsigned char* U8, const unsigned char* V8, const int* EIDX, const float* EGATE, const float* RSTD, float* out, int lane) {
    f32x2 hf[16];
#pragma unroll
    for (int j = 0; j < 2; ++j)
#pragma unroll
        for (int q = 0; q < 2; ++q) { const v4u r = *(const v4u*)(A2 + (size_t)t * 2048 + lane * 16 + 1024 * j + 8 * q);
            hf[8 * j + 4 * q + 0] = (f32x2){bflo(r.x), bfhi(r.x)}; hf[8 * j + 4 * q + 1] = (f32x2){bflo(r.y), bfhi(r.y)}; hf[8 * j + 4 * q + 2] = (f32x2){bflo(r.z), bfhi(r.z)}; hf[8 * j + 4 * q + 3] = (f32x2){bflo(r.w), bfhi(r.w)}; }
    const float rstd = RSTD[t] * (1.0f / U8_SCALE);
    f32x2 oa[16];
#pragma unroll
    for (int j = 0; j < 2; ++j)
#pragma unroll
        for (int q = 0; q < 4; ++q) { const f32x4 x = *(const f32x4*)(out + (size_t)t * 2048 + lane * 16 + 1024 * j + 4 * q); oa[8 * j + 2 * q] = (f32x2){x.x, x.y}; oa[8 * j + 2 * q + 1] = (f32x2){x.z, x.w}; }
    for (int bt = 0; bt < 4; ++bt) {
        const int eidx = EIDX[(size_t)t * 128 + bt * 32 + (lane & 31)]; const float gate = EGATE[(size_t)t * 128 + bt * 32 + (lane & 31)];
        float part[32];
#pragma unroll
        for (int k = 0; k < 32; ++k) { const int e = __builtin_amdgcn_readlane(eidx, k); const unsigned char* up = U8 + (size_t)e * 2048 + lane * 16;
            f32x2 a = (f32x2){0.f, 0.f};
            a = dot16_fp8(*(const v4u*)up, hf, a); a = dot16_fp8(*(const v4u*)(up + 1024), hf + 8, a);
            part[k] = a.x + a.y; }
#pragma unroll
        for (int w = 16; w >= 1; w >>= 1) {
            const bool up = (lane & w) != 0;
#pragma unroll
            for (int i = 0; i < w; ++i) { const float a = part[i], b2 = part[i + w]; const float keep = up ? b2 : a, send = up ? a : b2; part[i] = keep + __shfl_xor(send, w); }
        }
        const float z = (part[0] + __shfl_xor(part[0], 32)) * rstd;
        const float act = 0.5f * z * (1.0f + erff(z * 0.70710678118654752f)) * gate * (1.0f / V8_SCALE);
#pragma unroll 8
        for (int k = 0; k < 32; ++k) { const int e = __builtin_amdgcn_readlane(eidx, k); const float a = __uint_as_float(__builtin_amdgcn_readlane(__float_as_uint(act), k)); const unsigned char* vp = V8 + (size_t)e * 2048 + lane * 16;
            const f32x2 a2 = (f32x2){a, a};
            axpy16_fp8(*(const v4u*)vp, a2, oa); axpy16_fp8(*(const v4u*)(vp + 1024), a2, oa + 8); }
    }
#pragma unroll
    for (int j = 0; j < 2; ++j)
#pragma unroll
        for (int q = 0; q < 4; ++q) *(f32x4*)(out + (size_t)t * 2048 + lane * 16 + 1024 * j + 4 * q) = (f32x4){oa[8 * j + 2 * q].x, oa[8 * j + 2 * q].y, oa[8 * j + 2 * q + 1].x, oa[8 * j + 2 * q + 1].y};
}

struct Args { const float* in[17]; float* out; unsigned char* ws; int ph_lo, ph_hi; };
__global__ void __launch_bounds__(NTHREADS, 2) mk_fwd(Args args) {
    extern __shared__ __attribute__((aligned(16))) unsigned char lds_raw[];
    LAS unsigned char* lds = (LAS unsigned char*)lds_raw;
    const int tid = threadIdx.x, lane = tid & 63, wave = __builtin_amdgcn_readfirstlane(tid >> 6);
    const int G = gridDim.x, bx = blockIdx.x;
    const int vcu = (G % 8 == 0) ? (bx % 8) * (G / 8) + bx / 8 : bx;
    unsigned char* ws = args.ws;
    const float* x = args.in[0]; const float* attn_g = args.in[1]; const float* w_in = args.in[2]; const float* qg = args.in[3]; const float* kg = args.in[4];
    const float* lq1 = args.in[5]; const float* lk1 = args.in[6]; const float* lq2 = args.in[7]; const float* lk2 = args.in[8]; const float* subg = args.in[9];
    const float* conv_w = args.in[10]; const float* w_out = args.in[11]; const float* ffn_g = args.in[12]; const float* w_q = args.in[13]; const float* subkeys = args.in[14];
    const float* peer_u = args.in[15]; const float* peer_v = args.in[16];
    float* out = args.out;
    bf16* WtIn = (bf16*)(ws + WS_WIN); bf16* WtOut = (bf16*)(ws + WS_WOUT); bf16* WtQ = (bf16*)(ws + WS_WQ); bf16* SK = (bf16*)(ws + WS_SK);
    float* SSQ = (float*)(ws + WS_SSQ); int* EIDX = (int*)(ws + WS_EIDX); float* EGATE = (float*)(ws + WS_EGATE); float* RSTD = (float*)(ws + WS_RSTD);
    bf16* XN = (bf16*)(ws + WS_XN); bf16* MIX = XN;
    bf16* Qb = (bf16*)(ws + WS_Q); bf16* Kb = (bf16*)(ws + WS_K); bf16* Vb = (bf16*)(ws + WS_V); bf16* QP = Qb;
    bf16* CB = (bf16*)(ws + WS_CB); bf16* CC = (bf16*)(ws + WS_CC); bf16* CX = (bf16*)(ws + WS_CX); bf16* A2 = CB;
    unsigned char* U8 = ws + WS_UT; unsigned char* V8 = ws + WS_VT;
    const int lo = args.ph_lo, hi_ph = args.ph_hi;
#define IN(k) (lo <= (k) && (k) < hi_ph)
#define SEAM(k) do { if (IN(k) && IN((k) + 1)) cg::this_grid().sync(); } while (0)
    const int gw = vcu * NWAVES + wave, NGW = G * NWAVES;
    const size_t gtid = (size_t)bx * NTHREADS + tid, nthr = (size_t)G * NTHREADS;

    if (IN(0)) {
        LAS float* scr = (LAS float*)(lds + wave * 16384);
        constexpr int I_IN = (DM / 64) * (INC / 32), I_SQ = (DM / 64) * (DM / 32);
        for (int it = gw; it < I_IN + 2 * I_SQ; it += NGW) {
            if (it < I_IN) p0_transpose_item(w_in, DM, INC, WtIn, scr, it, lane, true);
            else if (it < I_IN + I_SQ) p0_transpose_item(w_out, DM, DM, WtOut, scr, it - I_IN, lane, false);
            else p0_transpose_item(w_q, DM, DM, WtQ, scr, it - I_IN - I_SQ, lane, false);
        }
        for (int m = gw; m < T; m += NGW) rms_row_to_bf16(x + (size_t)m * DM, attn_g, XN + (size_t)m * DM, lane);
        cvt_bf16_stream(subkeys, SK, (size_t)PEH * 2 * PNK * 128 / 8, gtid, nthr);
        cvt_fp8_stream(peer_u, U8, U8_SCALE, (size_t)16384 * 2048 / 16, gtid, nthr);
        cvt_fp8_stream(peer_v, V8, V8_SCALE, (size_t)16384 * 2048 / 16, gtid, nthr);
    }
    SEAM(0);
    if (IN(1)) {
        pg8::Gemm g{XN, WtIn, T, INC, DM}; pg8::StaticOrder S; S.init(T, INC, G, bx);
        pg8::EpiProj E{Qb, qg, kg};
        pg8::gemm_phase<pg8::EpiProj, pg8::StaticOrder, true, true>(lds, g, S, E);
    }
    SEAM(1);
    if (IN(2)) {
        float a = lq1[lane] * lk1[lane], b2 = lq2[lane] * lk2[lane];
        a = wave_sum(a); b2 = wave_sum(b2);
        const float lam = expf(a) - expf(b2) + 0.2f;
        const float mq = wave_max(fabsf(qg[lane])), mk = wave_max(fabsf(kg[lane]));
        const float M2 = 64.f * C2 * mq * mk;
#if DBG_NAIVE_ATTN
        for (int r = gw; r < NB * NH * SEQ; r += NGW) naive_attn_row(r >> 14, (r >> 11) & 7, r & 2047, Qb, Kb, Vb, MIX, subg, lam, (LAS float*)(lds + wave * 16384), lane);
        if (0)
#endif
        for (int v = vcu; v < NB * NH * 4; v += G) {
            const int bh = v >> 2, s = v & 3, b = bh >> 3, h = bh & 7;
#pragma unroll 1
            for (int i = 0; i < 4; ++i) { const int qblk = (i == 0) ? s : (i == 1) ? 7 - s : (i == 2) ? 8 + s : 15 - s;
                att::attn_unit(b, h, qblk, Qb, Kb, Vb, MIX, subg, lam, M2, (LAS char*)lds); }
        }
        for (size_t it = gtid; it < (size_t)(T / 16) * 128; it += nthr) {
            const int cg8 = (int)(it & 127), chunk = (int)(it >> 7), t0 = chunk * 16, col = cg8 * 8;
            f32x4 w0a = *(const f32x4*)(conv_w + col), w0b = *(const f32x4*)(conv_w + col + 4), w1a = *(const f32x4*)(conv_w + 1024 + col), w1b = *(const f32x4*)(conv_w + 1024 + col + 4),
                  w2a = *(const f32x4*)(conv_w + 2048 + col), w2b = *(const f32x4*)(conv_w + 2048 + col + 4);
            float u1[8], u2[8];
#pragma unroll
            for (int i = 0; i < 8; ++i) { u1[i] = 0.f; u2[i] = 0.f; }
            if ((t0 % SEQ) != 0) {
                const v4u c1 = *(const v4u*)(CC + (size_t)(t0 - 1) * 1024 + col), x1v = *(const v4u*)(CX + (size_t)(t0 - 1) * 1024 + col), c2 = *(const v4u*)(CC + (size_t)(t0 - 2) * 1024 + col), x2v = *(const v4u*)(CX + (size_t)(t0 - 2) * 1024 + col);
                u1[0] = bflo(c1.x) * bflo(x1v.x); u1[1] = bfhi(c1.x) * bfhi(x1v.x); u1[2] = bflo(c1.y) * bflo(x1v.y); u1[3] = bfhi(c1.y) * bfhi(x1v.y); u1[4] = bflo(c1.z) * bflo(x1v.z); u1[5] = bfhi(c1.z) * bfhi(x1v.z); u1[6] = bflo(c1.w) * bflo(x1v.w); u1[7] = bfhi(c1.w) * bfhi(x1v.w);
                u2[0] = bflo(c2.x) * bflo(x2v.x); u2[1] = bfhi(c2.x) * bfhi(x2v.x); u2[2] = bflo(c2.y) * bflo(x2v.y); u2[3] = bfhi(c2.y) * bfhi(x2v.y); u2[4] = bflo(c2.z) * bflo(x2v.z); u2[5] = bfhi(c2.z) * bfhi(x2v.z); u2[6] = bflo(c2.w) * bflo(x2v.w); u2[7] = bfhi(c2.w) * bfhi(x2v.w);
            }
            const float w0[8] = {w0a.x, w0a.y, w0a.z, w0a.w, w0b.x, w0b.y, w0b.z, w0b.w}, w1[8] = {w1a.x, w1a.y, w1a.z, w1a.w, w1b.x, w1b.y, w1b.z, w1b.w}, w2[8] = {w2a.x, w2a.y, w2a.z, w2a.w, w2b.x, w2b.y, w2b.z, w2b.w};
#pragma unroll 4
            for (int j = 0; j < 16; ++j) { const size_t ro = (size_t)(t0 + j) * 1024 + col;
                const v4u bv = *(const v4u*)(CB + ro), cv = *(const v4u*)(CC + ro), xv = *(const v4u*)(CX + ro);
                float u0[8], bb[8], y[8];
                u0[0] = bflo(cv.x) * bflo(xv.x); u0[1] = bfhi(cv.x) * bfhi(xv.x); u0[2] = bflo(cv.y) * bflo(xv.y); u0[3] = bfhi(cv.y) * bfhi(xv.y); u0[4] = bflo(cv.z) * bflo(xv.z); u0[5] = bfhi(cv.z) * bfhi(xv.z); u0[6] = bflo(cv.w) * bflo(xv.w); u0[7] = bfhi(cv.w) * bfhi(xv.w);
                bb[0] = bflo(bv.x); bb[1] = bfhi(bv.x); bb[2] = bflo(bv.y); bb[3] = bfhi(bv.y); bb[4] = bflo(bv.z); bb[5] = bfhi(bv.z); bb[6] = bflo(bv.w); bb[7] = bfhi(bv.w);
#pragma unroll
                for (int i = 0; i < 8; ++i) { y[i] = bb[i] * (u2[i] * w0[i] + u1[i] * w1[i] + u0[i] * w2[i]); u2[i] = u1[i]; u1[i] = u0[i]; }
                v4u o; o.x = pk2(y[0], y[1]); o.y = pk2(y[2], y[3]); o.z = pk2(y[4], y[5]); o.w = pk2(y[6], y[7]);
                *(v4u*)(MIX + (size_t)(t0 + j) * 2048 + 1024 + col) = o; }
        }
    }
    SEAM(2);
    if (IN(3)) {
        pg8::Gemm g{MIX, WtOut, T, DM, DM}; pg8::StaticOrder S; S.init(T, DM, G, bx);
        pg8::EpiX1 E{x, out, A2, ffn_g, SSQ};
        pg8::gemm_phase<pg8::EpiX1, pg8::StaticOrder, true, true>(lds, g, S, E);
    }
    SEAM(3);
    if (IN(4)) {
        pg8::Gemm g{A2, WtQ, T, DM, DM}; pg8::StaticOrder S; S.init(T, DM, G, bx);
        pg8::EpiBf16<0> E{QP, DM, nullptr, 0, 0, 1.f};
        pg8::gemm_phase<pg8::EpiBf16<0>, pg8::StaticOrder, true, true>(lds, g, S, E);
    }
    SEAM(4);
    if (IN(5)) {
        for (int it = vcu; it < (T / 128) * PEH; it += G) peer_topk_item(it >> 3, it & 7, QP, SK, SSQ, EIDX, EGATE, RSTD, (LAS char*)lds);
    }
    SEAM(5);
    if (IN(6)) {
#if !defined(DBG_SKIP_PEER)
        for (int t = gw; t < T; t += NGW) peer_expert_token(t, A2, U8, V8, EIDX, EGATE, RSTD, out, lane);
#endif
    }
#undef IN
#undef SEAM
}

extern "C" void kernel_launch(void* const* d_in, const int* in_sizes, int n_in, void* d_out, int out_size, void* d_ws, size_t ws_size, hipStream_t stream) {
    static int grid = 0;
    if (grid == 0) {
        if (n_in != 17 || out_size != T * DM || ws_size < WS_END) { fprintf(stderr, "kernel_launch: unexpected shapes (n_in %d out %d ws %zu)\n", n_in, out_size, ws_size); grid = -1; return; }
        int dev = 0, cus = 0, per_cu = 0;
        if (hipGetDevice(&dev) != hipSuccess || hipDeviceGetAttribute(&cus, hipDeviceAttributeMultiprocessorCount, dev) != hipSuccess) { grid = -1; return; }
        if (hipFuncSetAttribute((const void*)mk_fwd, hipFuncAttributeMaxDynamicSharedMemorySize, LDS_BYTES) != hipSuccess) { fprintf(stderr, "kernel_launch: hipFuncSetAttribute failed\n"); grid = -1; return; }
        if (hipOccupancyMaxActiveBlocksPerMultiprocessor(&per_cu, (const void*)mk_fwd, NTHREADS, LDS_BYTES) != hipSuccess || per_cu < 1) { fprintf(stderr, "kernel_launch: occupancy query says %d blocks per CU\n", per_cu); (void)hipGetLastError(); grid = -1; return; }
        grid = cus;
    }
    if (grid < 0) return;
    Args a{};
    for (int i = 0; i < 17; ++i) a.in[i] = (const float*)d_in[i];
    a.out = (float*)d_out; a.ws = (unsigned char*)d_ws;
#if MK_N_LAUNCHES == 1
    a.ph_lo = 0; a.ph_hi = NPHASE;
    void* kargs[] = {&a};
    hipError_t e = hipLaunchCooperativeKernel((const void*)mk_fwd, dim3(grid), dim3(NTHREADS), kargs, LDS_BYTES, stream);
    if (e != hipSuccess) fprintf(stderr, "kernel_launch: cooperative launch failed: %s (grid %d)\n", hipGetErrorString(e), grid);
#else
    for (int p = 0; p < NPHASE; ++p) { a.ph_lo = p; a.ph_hi = p + 1; hipLaunchKernelGGL(mk_fwd, dim3(grid), dim3(NTHREADS), LDS_BYTES, stream, a); }
#endif
}
```

```cpp
#include <hip/hip_runtime.h>
#include <hip/hip_cooperative_groups.h>
#include <cstdio>
#include <cstdint>
#include <cmath>
namespace cg = cooperative_groups;
namespace pg8 {
#define PG8_LAS __attribute__((address_space(3)))
typedef unsigned short bf16_t;
typedef short bf16x8 __attribute__((ext_vector_type(8)));
typedef float f32x4 __attribute__((ext_vector_type(4)));
typedef unsigned u32x4 __attribute__((ext_vector_type(4)));
constexpr int BM = 256, BK = 64, HALF = 128, HTB = HALF * BK * 2  , STAGE_BYTES = 8 * HTB, NXCD = 8, WGM = 8;

__host__ __device__ __forceinline__ int lds_byte(int r, int c) { const int st = (r >> 4) * 2 + (c >> 5), rr = r & 15, cc = c & 31, ob = rr * 64 + cc * 2; return st * 1024 + (ob ^ (((ob >> 9) & 1) << 5)); }
__host__ __device__ __forceinline__ void stage_rc(int b, int& R, int& C) { const int st = b / 1024, sb = b % 1024, swz = sb ^ (((sb >> 9) & 1) << 5); R = (st >> 1) * 16 + swz / 64; C = (st & 1) * 32 + (swz % 64) / 2; }
__host__ __device__ __forceinline__ int perm32(int rho) { const int n = rho >> 4, i = rho & 15; return 8 * (i >> 2) + 4 * n + (i & 3); }

struct Unit { int pm, pn; };
struct Gemm { const bf16_t* A; const bf16_t* Bt; int M, N, K; };

struct StaticOrder {
    int nM, nN, nwg, G, c;
    __host__ __device__ void init(int M, int N, int G_, int c_) { nM = M / BM; nN = N / BM; nwg = nM * nN; G = G_; c = c_; }
    __host__ __device__ bool next(int i, Unit& u) const {
        const long L = (long)i * G + c; if (L >= nwg) return false;
        int wgid = (int)L; { const int q = nwg / NXCD, r = nwg % NXCD, xcd = wgid % NXCD, off = wgid / NXCD; wgid = (xcd < r ? xcd * (q + 1) : r * (q + 1) + (xcd - r) * q) + off; }
        const int nig = WGM * nN, gid = wgid / nig, fm = gid * WGM, gsz = (nM - fm) < WGM ? (nM - fm) : WGM;
        u.pm = fm + ((wgid % nig) % gsz); u.pn = (wgid % nig) / gsz; return true;
    }
    __device__ __forceinline__ void a_ready(const Unit&) const {}
    __device__ __forceinline__ void done(const Unit&) const {}
};

__device__ __forceinline__ unsigned cvt_pk_bf16(float lo, float hi) { unsigned r; asm volatile("v_cvt_pk_bf16_f32 %0, %1, %2" : "=v"(r) : "v"(lo), "v"(hi)); return r; }
typedef float f32x2 __attribute__((ext_vector_type(2)));
__device__ __forceinline__ f32x2 gelu_pk(f32x2 v) {
    const f32x2 av = __builtin_elementwise_abs(v), d = av * 0.2316418882f + 1.0f;
    f32x2 t; t.x = __builtin_amdgcn_rcpf(d.x); t.y = __builtin_amdgcn_rcpf(d.y);
    f32x2 q = t * 0.5307027145f + (-0.7265760135f); q = q * t + 0.7107068705f; q = q * t + (-0.142248368f); q = q * t + 0.127414796f; q = q * t;
    const f32x2 s = (v * v) * (-0.72134752044f);
    f32x2 e; e.x = __builtin_amdgcn_exp2f(s.x); e.y = __builtin_amdgcn_exp2f(s.y);
    const f32x2 m = v * (q * e), r = v - m;
    f32x2 o; o.x = v.x < 0.f ? m.x : r.x; o.y = v.y < 0.f ? m.y : r.y; return o;
}

template <int ACT  > struct EpiBf16 {
    static constexpr bool PERM = true, AFTER_DRAIN = false; static_assert(ACT == 0 || ACT == 1, "EpiBf16: ACT is 0 (none) or 1 (gelu_pk)");
    bf16_t* O; int ldc; const float* bias; int split_cols; size_t split_stride; float scale0;
    __device__ __forceinline__ void operator()(const f32x4 (&acc)[2][2][4][2], const Unit& u, int wr, int wc, int fr, int fq) const {
        const int row0 = u.pm * BM + wr * 64 + fr; int colt = u.pn * BM; bf16_t* base = O;
        float sc = 1.f; if (split_cols) { const int t = colt / split_cols; base += (size_t)t * split_stride; colt -= t * split_cols; if (t == 0) sc = scale0; }
        const int col0 = colt + wc * 32 + 8 * fq, bcol0 = u.pn * BM + wc * 32 + 8 * fq;
        f32x4 bv[2][2];
#pragma unroll
        for (int bj = 0; bj < 2; ++bj)
#pragma unroll
            for (int n = 0; n < 2; ++n) bv[bj][n] = bias ? *(const f32x4*)(bias + bcol0 + bj * HALF + 4 * n) : (f32x4){0.f, 0.f, 0.f, 0.f};
#pragma unroll
        for (int ai = 0; ai < 2; ++ai)
#pragma unroll
            for (int m = 0; m < 4; ++m) { bf16_t* rowp = base + (size_t)(row0 + ai * HALF + m * 16) * ldc + col0;
#pragma unroll
                for (int bj = 0; bj < 2; ++bj) { f32x4 v0 = acc[ai][bj][m][0] + bv[bj][0], v1 = acc[ai][bj][m][1] + bv[bj][1];
                    if (ACT == 1) { f32x2 a = gelu_pk((f32x2){v0[0], v0[1]}), b = gelu_pk((f32x2){v0[2], v0[3]}), c = gelu_pk((f32x2){v1[0], v1[1]}), d = gelu_pk((f32x2){v1[2], v1[3]});
                        v0 = (f32x4){a.x, a.y, b.x, b.y}; v1 = (f32x4){c.x, c.y, d.x, d.y}; }
                    v0 = v0 * sc; v1 = v1 * sc; u32x4 w; w.x = cvt_pk_bf16(v0[0], v0[1]); w.y = cvt_pk_bf16(v0[2], v0[3]); w.z = cvt_pk_bf16(v1[0], v1[1]); w.w = cvt_pk_bf16(v1[2], v1[3]);
                    *(u32x4*)(rowp + bj * HALF) = w; } }
    }
};
template <class Epi, class Sched, bool ALIGN_EPI = false, bool SP2 = false>
__device__ __forceinline__ void gemm_phase(PG8_LAS unsigned char* lds, const Gemm g, const Sched& S, const Epi& E) {
    const int tid = threadIdx.x, wid = __builtin_amdgcn_readfirstlane(tid >> 6), lane = tid & 63, wr = wid >> 2, wc = wid & 3, fr = lane & 15, fq = lane >> 4;
    const int K = g.K, nt = K / BK;
    unsigned voffA[2], voffB[2];
#pragma unroll
    for (int i = 0; i < 2; ++i) { int R, C; stage_rc(tid * 16 + i * 8192, R, C); const int Rb = Epi::PERM ? ((R & ~31) + perm32(R & 31)) : R;
        voffA[i] = (unsigned)(R * K + C) * 2u; voffB[i] = (unsigned)(Rb * K + C) * 2u; }
    const size_t kstep = (size_t)(BK * 2);
    const size_t hstep = (size_t)HALF * K * 2;
    const size_t tstep = 2 * hstep;
    const unsigned ldsw = (unsigned)wid * 1024u;
    const int aoff = lds_byte(wr * 64 + fr, fq * 8), boff = lds_byte(wc * 32 + fr, fq * 8);
#define PG8_SA(b, h) (((b) * 2 + (h)) * HTB)
#define PG8_SB(b, h) ((4 + (b) * 2 + (h)) * HTB)
#define PG8_STAGE(bufoff, gbase, voff) do { _Pragma("unroll") for (int _i = 0; _i < 2; ++_i) \
        __builtin_amdgcn_global_load_lds((const unsigned*)((const char*)(gbase) + (voff)[_i]), (PG8_LAS unsigned*)(lds + (bufoff) + ldsw + _i * 8192), 16, 0, 0); } while (0)
#define PG8_LDA(dst, b, h) do { _Pragma("unroll") for (int m = 0; m < 4; ++m) _Pragma("unroll") for (int k = 0; k < 2; ++k) dst[m][k] = *(const PG8_LAS bf16x8*)(lds + PG8_SA(b, h) + aoff + m * 2048 + k * 1024); } while (0)
#define PG8_LDB(dst, b, h) do { _Pragma("unroll") for (int n = 0; n < 2; ++n) _Pragma("unroll") for (int k = 0; k < 2; ++k) dst[n][k] = *(const PG8_LAS bf16x8*)(lds + PG8_SB(b, h) + boff + n * 2048 + k * 1024); } while (0)
#define PG8_MMA(ai, bj, At, Bt) do { __builtin_amdgcn_s_setprio(1); _Pragma("unroll") for (int m = 0; m < 4; ++m) _Pragma("unroll") for (int n = 0; n < 2; ++n) _Pragma("unroll") for (int k = 0; k < 2; ++k) \
        acc[ai][bj][m][n] = __builtin_amdgcn_mfma_f32_16x16x32_bf16(Bt[n][k], At[m][k], acc[ai][bj][m][n], 0, 0, 0); __builtin_amdgcn_s_setprio(0); } while (0)
#define PG8_WAIT_V(n) asm volatile("s_waitcnt vmcnt(" #n ")" ::: "memory")
#define PG8_WAIT_L(n) asm volatile("s_waitcnt lgkmcnt(" #n ")" ::: "memory")
#define PG8_BAR __builtin_amdgcn_s_barrier()
#define PG8_SCHED __builtin_amdgcn_sched_barrier(0)
    Unit cur, nxt; int ui = 0;
    if (!S.next(0, cur)) return;
    f32x4 acc[2][2][4][2];
#pragma unroll
    for (int a = 0; a < 2; ++a)
#pragma unroll
        for (int b = 0; b < 2; ++b)
#pragma unroll
            for (int m = 0; m < 4; ++m)
#pragma unroll
                for (int n = 0; n < 2; ++n) acc[a][b][m][n] = (f32x4){0.f, 0.f, 0.f, 0.f};
    bf16x8 At[4][2], B0[2][2], B1[2][2];
    const char* cA = (const char*)g.A + (size_t)cur.pm * tstep; const char* cB = (const char*)g.Bt + (size_t)cur.pn * tstep;
    S.a_ready(cur);
    if constexpr (SP2) {
        PG8_STAGE(PG8_SB(0, 0), cB, voffB); PG8_STAGE(PG8_SB(0, 1), cB + hstep, voffB); PG8_STAGE(PG8_SA(0, 0), cA, voffA); PG8_STAGE(PG8_SA(0, 1), cA + hstep, voffA);
        if (wr == 1) PG8_BAR;
        PG8_WAIT_V(2); PG8_BAR;
        PG8_STAGE(PG8_SB(1, 0), cB + kstep, voffB); PG8_STAGE(PG8_SA(1, 0), cA + kstep, voffA); PG8_STAGE(PG8_SB(1, 1), cB + hstep + kstep, voffB);
        PG8_WAIT_V(6); PG8_BAR;
    } else {
        PG8_STAGE(PG8_SB(0, 0), cB, voffB); PG8_STAGE(PG8_SA(0, 0), cA, voffA); PG8_STAGE(PG8_SB(0, 1), cB + hstep, voffB); PG8_STAGE(PG8_SA(0, 1), cA + hstep, voffA);
        if (wr == 1) PG8_BAR;
        PG8_WAIT_V(4); PG8_BAR;
        PG8_STAGE(PG8_SB(1, 0), cB + kstep, voffB); PG8_STAGE(PG8_SA(1, 0), cA + kstep, voffA); PG8_STAGE(PG8_SB(1, 1), cB + hstep + kstep, voffB);
        PG8_WAIT_V(6); PG8_BAR;
    }
    for (;;) {
        const bool has_next = S.next(ui + 1, nxt);
        const char* nA = has_next ? (const char*)g.A + (size_t)nxt.pm * tstep : cA; const char* nB = has_next ? (const char*)g.Bt + (size_t)nxt.pn * tstep : cB;
        for (int t = 0; t < nt; t += 2) {
            const bool last = (t == nt - 2);
            const char* a1 = cA + (size_t)(t + 1) * kstep;
            const char* a2 = last ? nA : cA + (size_t)(t + 2) * kstep; const char* b2 = last ? nB : cB + (size_t)(t + 2) * kstep;
            const char* a3 = a2 + kstep; const char* b3 = b2 + kstep;
            if (last && has_next) S.a_ready(nxt);
            if constexpr (SP2) {
            PG8_LDB(B0, 0, 0); PG8_LDB(B1, 0, 1); PG8_SCHED; PG8_LDA(At, 0, 0); PG8_STAGE(PG8_SA(1, 1), a1 + hstep, voffA);
            PG8_WAIT_V(8); PG8_WAIT_L(0); PG8_BAR; PG8_MMA(0, 0, At, B0); PG8_MMA(0, 1, At, B1); PG8_BAR; PG8_SCHED;
            PG8_LDA(At, 0, 1); PG8_STAGE(PG8_SB(0, 0), b2, voffB); PG8_STAGE(PG8_SB(0, 1), b2 + hstep, voffB); PG8_STAGE(PG8_SA(0, 0), a2, voffA);
            PG8_WAIT_V(8); PG8_WAIT_L(0); PG8_BAR; PG8_MMA(1, 0, At, B0); PG8_MMA(1, 1, At, B1); PG8_BAR; PG8_SCHED;
            PG8_LDB(B0, 1, 0); PG8_LDB(B1, 1, 1); PG8_SCHED; PG8_LDA(At, 1, 0); PG8_STAGE(PG8_SA(0, 1), a2 + hstep, voffA);
            PG8_WAIT_V(8); PG8_WAIT_L(0); PG8_BAR; PG8_MMA(0, 0, At, B0); PG8_MMA(0, 1, At, B1); PG8_BAR; PG8_SCHED;
            PG8_LDA(At, 1, 1); PG8_STAGE(PG8_SB(1, 0), b3, voffB); PG8_STAGE(PG8_SB(1, 1), b3 + hstep, voffB); PG8_STAGE(PG8_SA(1, 0), a3, voffA);
            PG8_WAIT_V(8); PG8_WAIT_L(0); PG8_BAR; PG8_MMA(1, 0, At, B0); PG8_MMA(1, 1, At, B1); PG8_BAR; PG8_SCHED;
            } else {
            PG8_LDB(B0, 0, 0); PG8_SCHED; PG8_LDA(At, 0, 0); PG8_STAGE(PG8_SA(1, 1), a1 + hstep, voffA);
            PG8_WAIT_L(8); PG8_BAR; PG8_WAIT_L(0); PG8_MMA(0, 0, At, B0); PG8_BAR; PG8_SCHED;
            PG8_LDB(B1, 0, 1); PG8_STAGE(PG8_SB(0, 0), b2, voffB);
            PG8_BAR; PG8_WAIT_L(0); PG8_MMA(0, 1, At, B1); PG8_BAR;
            PG8_LDA(At, 0, 1); PG8_STAGE(PG8_SA(0, 0), a2, voffA);
            PG8_BAR; PG8_WAIT_L(0); PG8_MMA(1, 0, At, B0); PG8_BAR; PG8_SCHED;
            PG8_STAGE(PG8_SB(0, 1), b2 + hstep, voffB);
            PG8_WAIT_V(6); PG8_BAR; PG8_MMA(1, 1, At, B1); PG8_BAR;
            PG8_LDB(B0, 1, 0); PG8_SCHED; PG8_LDA(At, 1, 0); PG8_STAGE(PG8_SA(0, 1), a2 + hstep, voffA);
            PG8_WAIT_L(8); PG8_BAR; PG8_WAIT_L(0); PG8_MMA(0, 0, At, B0); PG8_BAR; PG8_SCHED;
            PG8_LDB(B1, 1, 1); PG8_STAGE(PG8_SB(1, 0), b3, voffB);
            PG8_BAR; PG8_WAIT_L(0); PG8_MMA(0, 1, At, B1); PG8_BAR;
            PG8_LDA(At, 1, 1); PG8_STAGE(PG8_SA(1, 0), a3, voffA);
            PG8_BAR; PG8_WAIT_L(0); PG8_MMA(1, 0, At, B0); PG8_BAR; PG8_SCHED;
            PG8_STAGE(PG8_SB(1, 1), b3 + hstep, voffB);
            PG8_WAIT_V(6); PG8_BAR; PG8_MMA(1, 1, At, B1); PG8_BAR;
            }
        }
        if constexpr (ALIGN_EPI) { if (wr == 0) PG8_BAR; }
        if constexpr (!Epi::AFTER_DRAIN) { E(acc, cur, wr, wc, fr, fq); S.done(cur); }
        if (!has_next) break;
#pragma unroll
        for (int a = 0; a < 2; ++a)
#pragma unroll
            for (int b = 0; b < 2; ++b)
#pragma unroll
                for (int m = 0; m < 4; ++m)
#pragma unroll
                    for (int n = 0; n < 2; ++n) acc[a][b][m][n] = (f32x4){0.f, 0.f, 0.f, 0.f};
        cur = nxt; cA = nA; cB = nB; ++ui;
        if constexpr (ALIGN_EPI) { if (wr == 1) PG8_BAR; }
    }
    PG8_WAIT_V(0);
    if constexpr (!ALIGN_EPI) { if (wr == 0) PG8_BAR; }
    PG8_BAR;
    if constexpr (Epi::AFTER_DRAIN) { E.fused(acc, cur, wr, wc, fr, fq, lds, wid, lane); S.done(cur); }
#undef PG8_SA
#undef PG8_SB
#undef PG8_STAGE
#undef PG8_LDA
#undef PG8_LDB
#undef PG8_MMA
#undef PG8_WAIT_V
#undef PG8_WAIT_L
#undef PG8_BAR
#undef PG8_SCHED
}
}
#define MK_N_LAUNCHES 1
#ifndef MK_N_LAUNCHES
#define MK_N_LAUNCHES 1
#endif
constexpr int DM = 2048, NB = 8, SEQ = 2048, T = NB * SEQ;
constexpr int AW = 1024, NH = 8, HD = 64, VD = 128, INC = 6144;
constexpr int PNK = 128, PTOPK = 16, PEH = 8, EPT = PEH * PTOPK;
constexpr float EPS = 1e-6f;
constexpr float C2 = 0.125f * 1.4426950408889634f;
constexpr int NPHASE = 9;
constexpr float U8_SCALE = 256.f, V8_SCALE = 16.f;
constexpr size_t MiB = 1u << 20;
constexpr size_t WS_WIN = 1 * MiB, WS_WOUT = 25 * MiB, WS_WQ = 33 * MiB, WS_SK = 41 * MiB, WS_SSQ = 42 * MiB, WS_EIDX = 44 * MiB, WS_EGATE = 52 * MiB, WS_RSTD = 60 * MiB;
constexpr size_t WS_XN = 64 * MiB;
constexpr size_t WS_Q = 128 * MiB, WS_K = 160 * MiB, WS_V = 192 * MiB;
constexpr size_t WS_CB = 224 * MiB, WS_CC = 256 * MiB, WS_CX = 288 * MiB;
constexpr size_t WS_UT = 320 * MiB, WS_VT = 384 * MiB, WS_END = 448 * MiB;
constexpr size_t WS_CTL = 0; constexpr int CW_BAR = 1024, CTL_ZERO_BYTES = 65536;
constexpr size_t WS_PART = 64 * MiB, WS_ACT = 192 * MiB;
constexpr int MISC_OFF = 143360;
constexpr int LDS_BYTES = 147456;
constexpr int NWAVES = 8, NTHREADS = 512;

#define LAS __attribute__((address_space(3)))
typedef unsigned short bf16;
typedef unsigned v4u __attribute__((ext_vector_type(4)));
typedef unsigned v2u __attribute__((ext_vector_type(2)));
typedef float f32x4 __attribute__((ext_vector_type(4)));
typedef float f32x2 __attribute__((ext_vector_type(2)));
typedef float f32x16 __attribute__((ext_vector_type(16)));
typedef short bf16x8 __attribute__((ext_vector_type(8)));
typedef short s16x4 __attribute__((ext_vector_type(4)));
typedef __bf16 bf16x2_t __attribute__((ext_vector_type(2)));
#define LDS_WAIT() asm volatile("s_waitcnt lgkmcnt(0)" ::: "memory")
__device__ __forceinline__ unsigned pk2(float lo, float hi) { f32x2 v = {lo, hi}; bf16x2_t b = __builtin_convertvector(v, bf16x2_t); return __builtin_bit_cast(unsigned, b); }
__device__ __forceinline__ float bflo(unsigned u) { return __uint_as_float(u << 16); }
__device__ __forceinline__ float bfhi(unsigned u) { return __uint_as_float(u & 0xffff0000u); }
__device__ __forceinline__ float wave_sum(float v) {
#pragma unroll
    for (int o = 1; o < 64; o <<= 1) v += __shfl_xor(v, o);
    return v;
}
__device__ __forceinline__ float wave_max(float v) {
#pragma unroll
    for (int o = 1; o < 64; o <<= 1) v = fmaxf(v, __shfl_xor(v, o));
    return v;
}

#define XB_TMO      128
#define XB_XCNT(j)  (256  + 64 * (j))
#define XB_XSUB(j)  (1280 + 64 * (j))
#define XB_XGEN(j)  (2304 + 64 * (j))
#define XB_TOP      3328
#define XB_TOPGEN   3392
#define XCD_BAR_WORDS 3456
#define XB_SPIN_CAP (1u << 18)

__device__ __forceinline__ unsigned xb_ld(unsigned* p)              { return __hip_atomic_load(p, __ATOMIC_RELAXED, __HIP_MEMORY_SCOPE_AGENT); }
__device__ __forceinline__ unsigned xb_add(unsigned* p, unsigned v) { return __hip_atomic_fetch_add(p, v, __ATOMIC_RELAXED, __HIP_MEMORY_SCOPE_AGENT); }
__device__ __forceinline__ unsigned xb_xcc_id() { return (unsigned)__builtin_amdgcn_s_getreg((3 << 11) | 20) & 0xFu; }
#define XB_SPIN(cond, bar) do { unsigned _sp = 0; while (cond) { __builtin_amdgcn_s_sleep(1); \
    if ((++_sp & 255u) == 0u) { if (xb_ld(&(bar)[XB_TMO])) break; if (_sp > XB_SPIN_CAP) { atomicAdd(&(bar)[XB_TMO], 1u); break; } } } } while (0)

struct XcdBarrier {
    unsigned* bar; unsigned x;
    volatile LAS unsigned* st;
};

__device__ __forceinline__ XcdBarrier xcd_barrier_post(unsigned* bar, volatile LAS unsigned* st) {
    XcdBarrier b; b.bar = bar; b.x = xb_xcc_id(); b.st = st;
    if (threadIdx.x == 0) (void)xb_add(&bar[XB_XCNT(b.x)], 1u);
    return b;
}
__device__ __forceinline__ void xcd_barrier_complete(unsigned* bar, unsigned x, unsigned& nloc, unsigned& nx) {
    const unsigned G = gridDim.x * gridDim.y * gridDim.z;
    unsigned sum, cnt, mine, sp = 0u;
    for (;;) {
        sum = 0u; cnt = 0u; mine = 0u;
#pragma unroll
        for (unsigned j = 0; j < 16; ++j) { const unsigned c = xb_ld(&bar[XB_XCNT(j)]); sum += c; cnt += (c > 0u) ? 1u : 0u; mine = (j == x) ? c : mine; }
        if (sum == G) break;
        __builtin_amdgcn_s_sleep(1);
        if ((++sp & 255u) == 0u) { if (xb_ld(&bar[XB_TMO])) break; if (sp > XB_SPIN_CAP) { atomicAdd(&bar[XB_TMO], 1u); break; } }
    }
    nloc = mine > 0u ? mine : 1u; nx = cnt > 0u ? cnt : 1u;
}

__device__ __forceinline__ void xcd_barrier(const XcdBarrier& b) {
    asm volatile("s_waitcnt vmcnt(0)" ::: "memory");
    __syncthreads();
    if (threadIdx.x == 0) {
        unsigned* bar = b.bar;
        __builtin_amdgcn_s_waitcnt(0);
        unsigned nloc = b.st[0], nx = b.st[1];
        if (nloc == 0u) { xcd_barrier_complete(bar, b.x, nloc, nx); b.st[0] = nloc; b.st[1] = nx; }
        const unsigned old = xb_add(&bar[XB_XSUB(b.x)], 1u);
        const unsigned gen = old / nloc;
        if (old + 1u == (gen + 1u) * nloc) {
            __builtin_amdgcn_fence(__ATOMIC_RELEASE, "agent");
            asm volatile("s_waitcnt vmcnt(0)" ::: "memory");
            const unsigned og = xb_add(&bar[XB_TOP], 1u);
            const unsigned tg = og / nx;
            if (og + 1u == (tg + 1u) * nx) xb_add(&bar[XB_TOPGEN], 1u);
            else XB_SPIN(xb_ld(&bar[XB_TOPGEN]) == tg, bar);
            __builtin_amdgcn_fence(__ATOMIC_ACQUIRE, "agent");
            xb_add(&bar[XB_XGEN(b.x)], 1u);
            asm volatile("s_waitcnt vmcnt(0)" ::: "memory");
        } else {
            XB_SPIN(xb_ld(&bar[XB_XGEN(b.x)]) == gen, bar);
            __builtin_amdgcn_fence(__ATOMIC_ACQUIRE, "agent");
            asm volatile("s_waitcnt vmcnt(0)" ::: "memory");
        }
    }
    __syncthreads();
}


namespace pg8 {
struct EpiProj {
    static constexpr bool PERM = true, AFTER_DRAIN = false;
    bf16_t* base0; const float* qg; const float* kg;
    __device__ __forceinline__ void operator()(const f32x4 (&acc)[2][2][4][2], const Unit& u, int wr, int wc, int fr, int fq) const {
        const int region = u.pn >> 2;
        bf16_t* O = base0 + (size_t)region * (16u << 20);
        const int row0 = u.pm * BM + wr * 64 + fr, col0 = (u.pn & 3) * 256 + wc * 64 + 8 * fq;
        if (region < 2) {
            const float* g = region == 0 ? qg : kg; const float sc = region == 0 ? 0.125f * 1.4426950408889634f : 1.0f;
            f32x4 gv[2][2];
#pragma unroll
            for (int bj = 0; bj < 2; ++bj)
#pragma unroll
                for (int n = 0; n < 2; ++n) gv[bj][n] = *(const f32x4*)(g + bj * 32 + 8 * fq + 4 * n) * sc;
#pragma unroll
            for (int ai = 0; ai < 2; ++ai)
#pragma unroll
                for (int m = 0; m < 4; ++m) {
                    float ss = 0.f;
#pragma unroll
                    for (int bj = 0; bj < 2; ++bj)
#pragma unroll
                        for (int n = 0; n < 2; ++n) { const f32x4 x = acc[ai][bj][m][n]; ss += (x[0] * x[0] + x[1] * x[1]) + (x[2] * x[2] + x[3] * x[3]); }
                    ss += __shfl_xor(ss, 16); ss += __shfl_xor(ss, 32);
                    const float rs = __builtin_amdgcn_rsqf(ss * (1.0f / 64.0f) + 1e-6f);
                    bf16_t* rowp = O + (size_t)(row0 + ai * HALF + m * 16) * 1024 + col0;
#pragma unroll
                    for (int bj = 0; bj < 2; ++bj) { const f32x4 v0 = acc[ai][bj][m][0] * rs * gv[bj][0], v1 = acc[ai][bj][m][1] * rs * gv[bj][1];
                        u32x4 w; w.x = cvt_pk_bf16(v0[0], v0[1]); w.y = cvt_pk_bf16(v0[2], v0[3]); w.z = cvt_pk_bf16(v1[0], v1[1]); w.w = cvt_pk_bf16(v1[2], v1[3]);
                        *(u32x4*)(rowp + bj * 32) = w; }
                }
        } else {
#pragma unroll
            for (int ai = 0; ai < 2; ++ai)
#pragma unroll
                for (int m = 0; m < 4; ++m) { bf16_t* rowp = O + (size_t)(row0 + ai * HALF + m * 16) * 1024 + col0;
#pragma unroll
                    for (int bj = 0; bj < 2; ++bj) { const f32x4 v0 = acc[ai][bj][m][0], v1 = acc[ai][bj][m][1];
                        u32x4 w; w.x = cvt_pk_bf16(v0[0], v0[1]); w.y = cvt_pk_bf16(v0[2], v0[3]); w.z = cvt_pk_bf16(v1[0], v1[1]); w.w = cvt_pk_bf16(v1[2], v1[3]);
                        *(u32x4*)(rowp + bj * 32) = w; } }
        }
    }
};
struct EpiX1 {
    static constexpr bool PERM = true, AFTER_DRAIN = false;
    const float* x; float* out; bf16_t* a2; const float* gf; float* ssq;
    __device__ __forceinline__ void operator()(const f32x4 (&acc)[2][2][4][2], const Unit& u, int wr, int wc, int fr, int fq) const {
        const int row0 = u.pm * BM + wr * 64 + fr, col0 = u.pn * BM + wc * 32 + 8 * fq;
        f32x4 gv[2][2];
#pragma unroll
        for (int bj = 0; bj < 2; ++bj)
#pragma unroll
            for (int n = 0; n < 2; ++n) gv[bj][n] = *(const f32x4*)(gf + col0 + bj * HALF + 4 * n);
#pragma unroll
        for (int ai = 0; ai < 2; ++ai)
#pragma unroll
            for (int m = 0; m < 4; ++m) { const int row = row0 + ai * HALF + m * 16; const size_t off = (size_t)row * 2048 + col0; float ss = 0.f;
#pragma unroll
                for (int bj = 0; bj < 2; ++bj) {
                    const f32x4 x0 = *(const f32x4*)(x + off + bj * HALF), x1 = *(const f32x4*)(x + off + bj * HALF + 4);
                    const f32x4 v0 = x0 + acc[ai][bj][m][0], v1 = x1 + acc[ai][bj][m][1];
                    *(f32x4*)(out + off + bj * HALF) = v0; *(f32x4*)(out + off + bj * HALF + 4) = v1;
                    ss += (v0[0] * v0[0] + v0[1] * v0[1]) + (v0[2] * v0[2] + v0[3] * v0[3]); ss += (v1[0] * v1[0] + v1[1] * v1[1]) + (v1[2] * v1[2] + v1[3] * v1[3]);
                    const f32x4 a0 = v0 * gv[bj][0], a1 = v1 * gv[bj][1];
                    u32x4 w; w.x = cvt_pk_bf16(a0[0], a0[1]); w.y = cvt_pk_bf16(a0[2], a0[3]); w.z = cvt_pk_bf16(a1[0], a1[1]); w.w = cvt_pk_bf16(a1[2], a1[3]);
                    *(u32x4*)(a2 + off + bj * HALF) = w; }
                ss += __shfl_xor(ss, 16); ss += __shfl_xor(ss, 32);
                if (fq == 0) ssq[(size_t)row * 32 + u.pn * 4 + wc] = ss; }
    }
};
}

__device__ __forceinline__ void p0_transpose_item(const float* W, int K, int N, bf16* WT, LAS float* scr, int item, int lane, bool permg) {
    const int nblk = N / 32, kb = item / nblk, nb = item % nblk, k0 = 64 * kb, n0 = 32 * nb;
#pragma unroll 8
    for (int i = 0; i < 32; ++i) { const int kk = 2 * i + (lane >> 5); scr[kk * 33 + (lane & 31)] = W[(size_t)(k0 + kk) * N + n0 + (lane & 31)]; }
    LDS_WAIT(); asm volatile("" ::: "memory");
    int nd = n0; if (permg) { const int gl = (n0 & 255) >> 5; nd = (n0 & ~255) + 32 * (4 * (gl & 1) + (gl >> 1)); }
    const int c = lane & 7;
#pragma unroll
    for (int j = 0; j < 4; ++j) { const int n = (lane >> 3) + 8 * j; const LAS float* s = scr + (8 * c) * 33 + n;
        v4u o; o.x = pk2(s[0 * 33], s[1 * 33]); o.y = pk2(s[2 * 33], s[3 * 33]); o.z = pk2(s[4 * 33], s[5 * 33]); o.w = pk2(s[6 * 33], s[7 * 33]);
        *(v4u*)(WT + (size_t)(nd + n) * K + k0 + 8 * c) = o; }
    LDS_WAIT(); asm volatile("" ::: "memory");
}
__device__ __forceinline__ void rms_row_to_bf16(const float* xrow, const float* g, bf16* orow, int lane) {
    const f32x4* xr = (const f32x4*)xrow + lane; const f32x4* gr = (const f32x4*)g + lane;
    f32x4 v[8]; float s = 0.f;
#pragma unroll
    for (int j = 0; j < 8; ++j) { v[j] = xr[64 * j]; s += (v[j].x * v[j].x + v[j].y * v[j].y) + (v[j].z * v[j].z + v[j].w * v[j].w); }
    const float rstd = 1.0f / sqrtf(wave_sum(s) * (1.f / DM) + EPS);
    v2u* o8 = (v2u*)orow + lane;
#pragma unroll
    for (int j = 0; j < 8; ++j) { const f32x4 gg = gr[64 * j]; v2u w; w.x = pk2(v[j].x * rstd * gg.x, v[j].y * rstd * gg.y); w.y = pk2(v[j].z * rstd * gg.z, v[j].w * rstd * gg.w); o8[64 * j] = w; }
}
__device__ __forceinline__ void cvt_bf16_stream(const float* src, bf16* dst, size_t n8, size_t gtid, size_t nthr) {
    for (size_t i = gtid; i < n8; i += nthr) { const f32x4 a = *(const f32x4*)(src + i * 8), b = *(const f32x4*)(src + i * 8 + 4);
        v4u o; o.x = pk2(a.x, a.y); o.y = pk2(a.z, a.w); o.z = pk2(b.x, b.y); o.w = pk2(b.z, b.w); *(v4u*)(dst + i * 8) = o; }
}

__device__ __forceinline__ void cvt_fp8_slices(const float* src, unsigned char* dst, float scale, size_t gtid, size_t nthr) {
    for (size_t i = gtid; i < (size_t)16384 * 128; i += nthr) { v4u o; const size_t e = i >> 7; const int c16 = (int)(i & 127), s = c16 >> 3, sub = c16 & 7;
#pragma unroll
        for (int q = 0; q < 4; ++q) { const f32x4 a = *(const f32x4*)(src + i * 16 + 4 * q) * scale; int w = __builtin_amdgcn_cvt_pk_fp8_f32(a.x, a.y, 0, false); w = __builtin_amdgcn_cvt_pk_fp8_f32(a.z, a.w, w, true);
            if (q == 0) o.x = (unsigned)w; else if (q == 1) o.y = (unsigned)w; else if (q == 2) o.z = (unsigned)w; else o.w = (unsigned)w; }
        *(v4u*)(dst + ((size_t)s * 16384 + e) * 128 + 16 * sub) = o; }
}

namespace att {
constexpr int SLOTB = 32768;
constexpr int NSLOT = 3, LW_OFF = NSLOT * SLOTB;
constexpr int XSTR = 132;
__device__ __forceinline__ void glds16(const void* gsrc, unsigned lds_dst) { unsigned keep;
    asm volatile("s_mov_b32 %0, m0\n\ts_mov_b32 m0, %2\n\ts_nop 0\n\tglobal_load_lds_dwordx4 %1, off\n\ts_mov_b32 m0, %0" : "=&s"(keep) : "v"(gsrc), "s"(lds_dst) : "memory"); }
__device__ __forceinline__ int crow(int r, int hi) { return (r & 3) + 8 * (r >> 2) + 4 * hi; }
typedef short v4i16_t __attribute__((ext_vector_type(4)));
__device__ __forceinline__ s16x4 vtr(const LAS char* p) { return __builtin_bit_cast(s16x4, __builtin_amdgcn_ds_read_tr16_b64_v4i16((LAS v4i16_t*)p)); }
#define ATT_WAIT_BAR(N) asm volatile("s_waitcnt vmcnt(" #N ") lgkmcnt(0)\n\ts_barrier" ::: "memory")

__device__ __forceinline__ void attn_unit(int b, int h, int qblk, const bf16* Q, const bf16* K, const bf16* V, bf16* MIX, const float* subg, float lam, float M2, LAS char* lds) {
    const int tid = threadIdx.x, lane = tid & 63, r32 = lane & 31, hi = lane >> 5, wid = __builtin_amdgcn_readfirstlane(tid >> 6), c = wid >> 2, qs = wid & 3;
    const size_t rowbase = (size_t)b * SEQ; const int q0 = qblk * 128, NT = 2 * (qblk + 1);
    const unsigned lds0 = (unsigned)(uintptr_t)lds;
    const bf16* ksrc[2]; const bf16* vsrc[2]; unsigned kdst[2], vdst[2];
#pragma unroll
    for (int i = 0; i < 2; ++i) { const int pk = 2 * wid + i, pc = pk >> 3, ch = pk & 7, d0 = pk >> 2, rg = pk & 3;
        ksrc[i] = K + (rowbase + lane) * 1024 + h * 128 + pc * 64 + ch * 8; kdst[i] = lds0 + pk * 1024;
        vsrc[i] = V + (rowbase + 16 * rg + (lane >> 2)) * 1024 + h * 128 + d0 * 32 + (lane & 3) * 8; vdst[i] = lds0 + 16384 + pk * 1024; }
#define ATT_DMA(t, slot) do { _Pragma("unroll") for (int i_ = 0; i_ < 2; ++i_) { glds16(ksrc[i_] + (size_t)(t) * 64 * 1024, (unsigned)__builtin_amdgcn_readfirstlane(kdst[i_] + (slot) * SLOTB)); \
        glds16(vsrc[i_] + (size_t)(t) * 64 * 1024, (unsigned)__builtin_amdgcn_readfirstlane(vdst[i_] + (slot) * SLOTB)); } } while (0)
    ATT_DMA(0, 0); ATT_DMA(1, 1);
    const int qrow = q0 + 32 * qs + r32;
    bf16x8 qr[4];
#pragma unroll
    for (int d0 = 0; d0 < 4; ++d0) qr[d0] = *(const bf16x8*)(Q + (rowbase + qrow) * 1024 + h * 128 + c * 64 + d0 * 16 + hi * 8);
    const float slope2 = exp2f(-(float)(h + 1)) * 1.4426950408889634f;
    float base = -slope2 * (float)(qrow - 4 * hi) - M2;
    const float s32 = 32.f * slope2, s64 = 64.f * slope2;
    f32x16 o[4]; o[0] = f32x16{}; o[1] = f32x16{}; o[2] = f32x16{}; o[3] = f32x16{};
    float lsum = 0.f;
    const LAS char* kp0 = (const LAS char*)lds + c * 8192 + hi * 1024 + r32 * 16;
    const LAS char* vp0 = (const LAS char*)lds + 16384 + ((lane >> 4) & 1) * 32 + (lane & 3) * 8 + (4 * hi + ((lane & 15) >> 2)) * 64;
    const int qw0 = q0 + 32 * qs;
    int slot = 0;
    for (int t = 0; t < NT; ++t) {
        if (t == 0) { ATT_WAIT_BAR(0); } else if (t + 1 < NT) { ATT_WAIT_BAR(4); } else { ATT_WAIT_BAR(0); }
        if (t + 2 < NT) { const int s2_ = (slot == 0) ? 2 : slot - 1; ATT_DMA(t + 2, s2_); }
        const int k0 = 64 * t;
        if (k0 <= qw0 + 31) {
            const LAS char* kp = kp0 + slot * SLOTB; const LAS char* vp = vp0 + slot * SLOTB;
            f32x16 p0, p1;
#pragma unroll
            for (int r = 0; r < 16; ++r) { p0[r] = __builtin_fmaf(slope2, (float)((r & 3) + 8 * (r >> 2)), base); p1[r] = p0[r] + s32; }
#pragma unroll
            for (int d0 = 0; d0 < 4; ++d0) {
                const bf16x8 ka = *(const LAS bf16x8*)(kp + d0 * 2048), kb = *(const LAS bf16x8*)(kp + d0 * 2048 + 512);
                p0 = __builtin_amdgcn_mfma_f32_32x32x16_bf16(ka, qr[d0], p0, 0, 0, 0);
                p1 = __builtin_amdgcn_mfma_f32_32x32x16_bf16(kb, qr[d0], p1, 0, 0, 0); }
#pragma unroll
            for (int r = 0; r < 16; ++r) { p0[r] = __builtin_amdgcn_exp2f(p0[r]); p1[r] = __builtin_amdgcn_exp2f(p1[r]); }
            if (k0 + 63 > qw0) {
                const int dq = qrow - k0;
#pragma unroll
                for (int r = 0; r < 16; ++r) { const int kk = crow(r, hi); if (kk > dq) p0[r] = 0.f; if (kk + 32 > dq) p1[r] = 0.f; }
            }
            float sacc = 0.f;
#pragma unroll
            for (int r = 0; r < 16; ++r) sacc += p0[r] + p1[r];
            lsum += sacc;
            bf16x8 pw[4];
#pragma unroll
            for (int ks = 0; ks < 4; ++ks) { v4u w;
                if (ks < 2) { w.x = pk2(p0[8 * ks + 0], p0[8 * ks + 1]); w.y = pk2(p0[8 * ks + 2], p0[8 * ks + 3]); w.z = pk2(p0[8 * ks + 4], p0[8 * ks + 5]); w.w = pk2(p0[8 * ks + 6], p0[8 * ks + 7]); }
                else { const int k2 = ks - 2; w.x = pk2(p1[8 * k2 + 0], p1[8 * k2 + 1]); w.y = pk2(p1[8 * k2 + 2], p1[8 * k2 + 3]); w.z = pk2(p1[8 * k2 + 4], p1[8 * k2 + 5]); w.w = pk2(p1[8 * k2 + 6], p1[8 * k2 + 7]); }
                pw[ks] = __builtin_bit_cast(bf16x8, w); }
#pragma unroll
            for (int d0 = 0; d0 < 4; ++d0)
#pragma unroll
                for (int ks = 0; ks < 4; ++ks) { const s16x4 lo = vtr(vp + d0 * 4096 + ks * 1024), hv = vtr(vp + d0 * 4096 + ks * 1024 + 512);
                    const bf16x8 vf = (bf16x8){lo[0], lo[1], lo[2], lo[3], hv[0], hv[1], hv[2], hv[3]};
                    o[d0] = __builtin_amdgcn_mfma_f32_32x32x16_bf16(pw[ks], vf, o[d0], 0, 0, 0); }
        }
        base += s64;
        slot = (slot == NSLOT - 1) ? 0 : slot + 1;
    }
    ATT_WAIT_BAR(0);
    LAS float* lw = (LAS float*)(lds + LW_OFF) + wid * 32;
    { auto rr = __builtin_amdgcn_permlane32_swap(__float_as_uint(lsum), __float_as_uint(lsum), false, false); lsum = __uint_as_float(rr[0]) + __uint_as_float(rr[1]); }
    if (hi == 0) lw[r32] = lsum;
    LDS_WAIT();
    LAS float* X = (LAS float*)lds + qs * 32 * XSTR;
#pragma unroll
    for (int r = 0; r < 16; ++r) { const float rl = 1.0f / lw[crow(r, hi)];
#pragma unroll
        for (int d0 = 0; d0 < 4; ++d0) o[d0][r] *= rl; }
    if (c == 1) {
#pragma unroll
        for (int r = 0; r < 16; ++r)
#pragma unroll
            for (int d0 = 0; d0 < 4; ++d0) X[crow(r, hi) * XSTR + d0 * 32 + r32] = o[d0][r];
    }
    ATT_WAIT_BAR(0);
    if (c == 0) {
#pragma unroll
        for (int r = 0; r < 16; ++r)
#pragma unroll
            for (int d0 = 0; d0 < 4; ++d0) { LAS float* px = X + crow(r, hi) * XSTR + d0 * 32 + r32; const float a = o[d0][r] - lam * (*px); *px = a; }
        LDS_WAIT(); asm volatile("" ::: "memory");
        const LAS f32x4* rp = (const LAS f32x4*)(X + r32 * XSTR + hi * 64);
        f32x4 av[16]; float ss = 0.f;
#pragma unroll
        for (int j = 0; j < 16; ++j) { av[j] = rp[j]; ss += (av[j].x * av[j].x + av[j].y * av[j].y) + (av[j].z * av[j].z + av[j].w * av[j].w); }
        { auto rr = __builtin_amdgcn_permlane32_swap(__float_as_uint(ss), __float_as_uint(ss), false, false); ss = __uint_as_float(rr[0]) + __uint_as_float(rr[1]); }
        const float rs = 0.8f / sqrtf(ss * (1.0f / 128.0f) + EPS);
        bf16* op = MIX + (rowbase + qrow) * 2048 + h * 128 + hi * 64;
#pragma unroll
        for (int j = 0; j < 8; ++j) { const f32x4 g0 = *(const f32x4*)(subg + hi * 64 + 8 * j), g1 = *(const f32x4*)(subg + hi * 64 + 8 * j + 4); const f32x4 a0 = av[2 * j] * rs * g0, a1 = av[2 * j + 1] * rs * g1;
            v4u w; w.x = pk2(a0.x, a0.y); w.y = pk2(a0.z, a0.w); w.z = pk2(a1.x, a1.y); w.w = pk2(a1.z, a1.w); *(v4u*)(op + 8 * j) = w; }
    }
    ATT_WAIT_BAR(0);
#undef ATT_DMA
}
}


#ifndef DBG_NAIVE_ATTN
#define DBG_NAIVE_ATTN 0
#endif
#if DBG_NAIVE_ATTN
__device__ __forceinline__ void naive_attn_row(int b, int h, int q, const bf16* Q, const bf16* K, const bf16* V, bf16* MIX, const float* subg, float lam, LAS float* S, int lane) {
    const size_t rowbase = (size_t)b * SEQ; const float slope2 = exp2f(-(float)(h + 1)) * 1.4426950408889634f;
    for (int c = 0; c < 2; ++c) {
        float qv[64];
        const bf16* qp = Q + (rowbase + q) * 1024 + h * 128 + c * 64;
#pragma unroll
        for (int d = 0; d < 64; d += 2) { const unsigned u = *(const unsigned*)(qp + d); qv[d] = bflo(u); qv[d + 1] = bfhi(u); }
        for (int key = lane; key <= q; key += 64) { const bf16* kp = K + (rowbase + key) * 1024 + h * 128 + c * 64; float s = 0.f;
#pragma unroll
            for (int d = 0; d < 64; d += 2) { const unsigned u = *(const unsigned*)(kp + d); s += qv[d] * bflo(u) + qv[d + 1] * bfhi(u); }
            S[c * 2048 + key] = s - slope2 * (float)(q - key); }
    }
    LDS_WAIT();
    float linv[2];
    for (int c = 0; c < 2; ++c) { float m = -1e30f; for (int key = lane; key <= q; key += 64) m = fmaxf(m, S[c * 2048 + key]); m = wave_max(m);
        float l = 0.f; for (int key = lane; key <= q; key += 64) { const float p = exp2f(S[c * 2048 + key] - m); S[c * 2048 + key] = p; l += p; } linv[c] = 1.0f / wave_sum(l); }
    for (int key = lane; key <= q; key += 64) S[key] = S[key] * linv[0] - lam * S[2048 + key] * linv[1];
    LDS_WAIT();
    float o0 = 0.f, o1 = 0.f; const bf16* vp = V + rowbase * 1024 + h * 128 + lane;
    for (int key = 0; key <= q; ++key) { const float a = S[key]; o0 += a * __uint_as_float((unsigned)vp[(size_t)key * 1024] << 16); o1 += a * __uint_as_float((unsigned)vp[(size_t)key * 1024 + 64] << 16); }
    const float ss = wave_sum(o0 * o0 + o1 * o1); const float rs = 0.8f / sqrtf(ss * (1.0f / 128.0f) + EPS);
    bf16* op = MIX + (rowbase + q) * 2048 + h * 128 + lane;
    op[0] = (bf16)(pk2(o0 * rs * subg[lane], 0.f) & 0xffffu); op[64] = (bf16)(pk2(o1 * rs * subg[lane + 64], 0.f) & 0xffffu);
    LDS_WAIT();
}
#endif

__device__ __forceinline__ unsigned ord_key(float f) { const unsigned u = __float_as_uint(f); return (u & 0x80000000u) ? ~u : (u | 0x80000000u); }
__device__ __forceinline__ float ord_val(unsigned k) { return __uint_as_float((k & 0x80000000u) ? (k ^ 0x80000000u) : ~k); }
#define TOPK_INS(tt, x_) do { unsigned x__ = (x_); _Pragma("unroll") for (int j_ = 0; j_ < 16; ++j_) { const unsigned hi__ = max(tt[j_], x__); x__ = min(tt[j_], x__); tt[j_] = hi__; } } while (0)

__device__ __forceinline__ void peer_topk_item(int tile, int h, const bf16* QP, const bf16* SK, const float* SSQ, int* EIDX, float* EGATE, float* RSTD, LAS char* lds) {
    const int tid = threadIdx.x, lane = tid & 63, r32 = lane & 31, hi = lane >> 5, wid = __builtin_amdgcn_readfirstlane(tid >> 6), c = wid >> 2, tb = wid & 3;
    constexpr int SSTR = 132;
    LAS float* SC = (LAS float*)lds;
    const int tok0 = tile * 128;
    {
        bf16x8 qf[8];
        const bf16* qp = QP + (size_t)(tok0 + tb * 32 + r32) * 2048 + h * 256 + c * 128 + hi * 8;
#pragma unroll
        for (int s = 0; s < 8; ++s) qf[s] = *(const bf16x8*)(qp + 16 * s);
        const bf16* sp = SK + (size_t)((h * 2 + c) * 128 + r32) * 128 + hi * 8;
#pragma unroll
        for (int kb = 0; kb < 4; ++kb) { f32x16 acc = f32x16{};
#pragma unroll
            for (int s = 0; s < 8; ++s) { const bf16x8 sf = *(const bf16x8*)(sp + (size_t)kb * 32 * 128 + 16 * s); acc = __builtin_amdgcn_mfma_f32_32x32x16_bf16(qf[s], sf, acc, 0, 0, 0); }
#pragma unroll
            for (int r = 0; r < 16; ++r) SC[(c * 128 + tb * 32 + att::crow(r, hi)) * SSTR + kb * 32 + r32] = acc[r]; }
    }
    __syncthreads();
    if (tid < 256) {
        LAS float* row = SC + tid * SSTR; unsigned tt[16];
#pragma unroll
        for (int j = 0; j < 16; ++j) tt[j] = 0u;
#pragma unroll 2
        for (int i = 0; i < 32; ++i) { const f32x4 v = *(const LAS f32x4*)(row + 4 * i);
            TOPK_INS(tt, (ord_key(v.x) & ~0x7Fu) | (unsigned)(4 * i)); TOPK_INS(tt, (ord_key(v.y) & ~0x7Fu) | (unsigned)(4 * i + 1));
            TOPK_INS(tt, (ord_key(v.z) & ~0x7Fu) | (unsigned)(4 * i + 2)); TOPK_INS(tt, (ord_key(v.w) & ~0x7Fu) | (unsigned)(4 * i + 3)); }
        LAS unsigned* lrow = (LAS unsigned*)row;
#pragma unroll
        for (int j = 0; j < 16; ++j) lrow[j] = tt[j];
    }
    __syncthreads();
    if (tid < 128) {
        const LAS unsigned* l1 = (const LAS unsigned*)(SC + tid * SSTR); const LAS unsigned* l2 = (const LAS unsigned*)(SC + (128 + tid) * SSTR);
        float v1[16], v2[16];
#pragma unroll
        for (int j = 0; j < 16; ++j) { v1[j] = ord_val(l1[j] & ~0x7Fu); v2[j] = ord_val(l2[j] & ~0x7Fu); }
        unsigned tt[16];
#pragma unroll
        for (int j = 0; j < 16; ++j) tt[j] = 0u;
#pragma unroll
        for (int i = 0; i < 16; ++i)
#pragma unroll
            for (int j = 0; j < 16; ++j) if ((i + 1) * (j + 1) <= 16) { TOPK_INS(tt, (ord_key(v1[i] + v2[j]) & ~0xFFu) | (unsigned)(i * 16 + j)); }
        const int t = tok0 + tid;
        float ssq = 0.f;
#pragma unroll
        for (int j = 0; j < 8; ++j) { const f32x4 p = *(const f32x4*)(SSQ + (size_t)t * 32 + 4 * j); ssq += (p.x + p.y) + (p.z + p.w); }
        const float rstd = 1.0f / sqrtf(ssq * (1.0f / DM) + EPS);
        if (h == 0) RSTD[t] = rstd;
        float ev[16]; int ex[16]; float es = 0.f, vmax = 0.f;
#pragma unroll
        for (int k = 0; k < 16; ++k) { const unsigned pid = tt[k] & 0xFFu; const unsigned a = l1[pid >> 4], b2 = l2[pid & 15u];
            const float sv = (ord_val(a & ~0x7Fu) + ord_val(b2 & ~0x7Fu)) * rstd; if (k == 0) vmax = sv;
            ev[k] = __expf(sv - vmax); es += ev[k]; ex[k] = (int)((a & 0x7Fu) * 128u + (b2 & 0x7Fu)); }
        const float inv = 1.0f / es;
        int* ei = EIDX + (size_t)t * 128 + h * 16; float* eg = EGATE + (size_t)t * 128 + h * 16;
#pragma unroll
        for (int k = 0; k < 16; k += 4) { *(int4*)(ei + k) = make_int4(ex[k], ex[k + 1], ex[k + 2], ex[k + 3]); *(f32x4*)(eg + k) = (f32x4){ev[k] * inv, ev[k + 1] * inv, ev[k + 2] * inv, ev[k + 3] * inv}; }
    }
    __syncthreads();
}

__device__ __forceinline__ f32x2 dot16_fp8(const v4u u, const f32x2* h, f32x2 acc) {
#pragma unroll
    for (int w = 0; w < 4; ++w) { const unsigned d = w == 0 ? u.x : w == 1 ? u.y : w == 2 ? u.z : u.w;
        const f32x2 f0 = __builtin_amdgcn_cvt_pk_f32_fp8((int)d, false), f1 = __builtin_amdgcn_cvt_pk_f32_fp8((int)d, true);
        acc = __builtin_elementwise_fma(h[2 * w], f0, acc); acc = __builtin_elementwise_fma(h[2 * w + 1], f1, acc); }
    return acc;
}
__device__ __forceinline__ void axpy16_fp8(const v4u v, f32x2 a2, f32x2* o) {
#pragma unroll
    for (int w = 0; w < 4; ++w) { const unsigned d = w == 0 ? v.x : w == 1 ? v.y : w == 2 ? v.z : v.w;
        const f32x2 f0 = __builtin_amdgcn_cvt_pk_f32_fp8((int)d, false), f1 = __builtin_amdgcn_cvt_pk_f32_fp8((int)d, true);
        o[2 * w] = __builtin_elementwise_fma(a2, f0, o[2 * w]); o[2 * w + 1] = __builtin_elementwise_fma(a2, f1, o[2 * w + 1]); }
}
__device__ __forceinline__ void peer_u_item(int t, int s, const bf16* A2, const unsigned char* U8, const int* EIDX, float* PART, int lane) {
    asm volatile("" : "+v"(lane));
    const int g = lane >> 3, sub = lane & 7;
    int ex[16];
#pragma unroll
    for (int i = 0; i < 16; ++i) ex[i] = EIDX[(size_t)t * 128 + 8 * i + g];
    f32x2 hf[8];
#pragma unroll
    for (int q = 0; q < 2; ++q) { const v4u r = *(const v4u*)(A2 + (size_t)t * 2048 + 128 * s + 16 * sub + 8 * q);
        hf[4 * q + 0] = (f32x2){bflo(r.x), bfhi(r.x)}; hf[4 * q + 1] = (f32x2){bflo(r.y), bfhi(r.y)}; hf[4 * q + 2] = (f32x2){bflo(r.z), bfhi(r.z)}; hf[4 * q + 3] = (f32x2){bflo(r.w), bfhi(r.w)}; }
    const unsigned char* ub = U8 + (size_t)s * 16384 * 128 + 16 * sub;
    v4u uv[16];
#pragma unroll
    for (int i = 0; i < 16; ++i) uv[i] = *(const v4u*)(ub + (size_t)ex[i] * 128);
    float r[16];
#pragma unroll
    for (int i = 0; i < 16; ++i) { const f32x2 a = dot16_fp8(uv[i], hf, (f32x2){0.f, 0.f}); r[i] = a.x + a.y; }
#pragma unroll
    for (int w = 4, n = 8; w >= 1; w >>= 1, n >>= 1) { const bool up = (lane & w) != 0;
#pragma unroll
        for (int j = 0; j < n; ++j) { const float a = r[j], b2 = r[j + n]; const float keep = up ? b2 : a, send = up ? a : b2; r[j] = keep + __shfl_xor(send, w); } }
    const int i0 = 8 * ((sub >> 2) & 1) + 4 * ((sub >> 1) & 1) + 2 * (sub & 1);
    float* pp = PART + ((size_t)s * T + t) * 128 + g;
    pp[8 * i0] = r[0]; pp[8 * (i0 + 1)] = r[1];
}
__device__ __forceinline__ void peer_v_item(int t, int s, const unsigned char* V8, const int* EIDX, const float* ACT, float* out, int lane) {
    asm volatile("" : "+v"(lane));
    const int g = lane >> 3, sub = lane & 7;
    int ex[16]; float av[16];
#pragma unroll
    for (int i = 0; i < 16; ++i) { ex[i] = EIDX[(size_t)t * 128 + 8 * i + g]; av[i] = ACT[(size_t)t * 128 + 8 * i + g]; }
    const unsigned char* vb = V8 + (size_t)s * 16384 * 128 + 16 * sub;
    f32x2 o[8];
#pragma unroll
    for (int m = 0; m < 8; ++m) o[m] = (f32x2){0.f, 0.f};
#pragma unroll
    for (int hh = 0; hh < 2; ++hh) { v4u vv[8];
#pragma unroll
        for (int i = 0; i < 8; ++i) vv[i] = *(const v4u*)(vb + (size_t)ex[8 * hh + i] * 128);
#pragma unroll
        for (int i = 0; i < 8; ++i) axpy16_fp8(vv[i], (f32x2){av[8 * hh + i], av[8 * hh + i]}, o); }
#pragma unroll
    for (int w = 32, n = 4; w >= 8; w >>= 1, n >>= 1) { const bool up = (lane & w) != 0;
#pragma unroll
        for (int j = 0; j < n; ++j) { const f32x2 a = o[j], b2 = o[j + n]; const f32x2 keep = up ? b2 : a, send = up ? a : b2; o[j] = (f32x2){keep.x + __shfl_xor(send.x, w), keep.y + __shfl_xor(send.y, w)}; } }
    const int c0 = 8 * ((g >> 2) & 1) + 4 * ((g >> 1) & 1) + 2 * (g & 1);
    f32x2* op = (f32x2*)(out + (size_t)t * 2048 + 128 * s + 16 * sub + c0);
    const f32x2 x1 = *op; *op = (f32x2){x1.x + o[0].x, x1.y + o[0].y};
}

struct Args { const float* in[17]; float* out; unsigned char* ws; int ph_lo, ph_hi; };
__global__ void __launch_bounds__(NTHREADS, 2) mk_fwd(Args args) {
    extern __shared__ __attribute__((aligned(16))) unsigned char lds_raw[];
    LAS unsigned char* lds = (LAS unsigned char*)lds_raw;
    const int tid = threadIdx.x, lane = tid & 63, wave = __builtin_amdgcn_readfirstlane(tid >> 6);
    const int G = gridDim.x, bx = blockIdx.x;
    const int vcu = (G % 8 == 0) ? (bx % 8) * (G / 8) + bx / 8 : bx;
    unsigned char* ws = args.ws;
    const float* x = args.in[0]; const float* attn_g = args.in[1]; const float* w_in = args.in[2]; const float* qg = args.in[3]; const float* kg = args.in[4];
    const float* lq1 = args.in[5]; const float* lk1 = args.in[6]; const float* lq2 = args.in[7]; const float* lk2 = args.in[8]; const float* subg = args.in[9];
    const float* conv_w = args.in[10]; const float* w_out = args.in[11]; const float* ffn_g = args.in[12]; const float* w_q = args.in[13]; const float* subkeys = args.in[14];
    const float* peer_u = args.in[15]; const float* peer_v = args.in[16];
    float* out = args.out;
    bf16* WtIn = (bf16*)(ws + WS_WIN); bf16* WtOut = (bf16*)(ws + WS_WOUT); bf16* WtQ = (bf16*)(ws + WS_WQ); bf16* SK = (bf16*)(ws + WS_SK);
    float* SSQ = (float*)(ws + WS_SSQ); int* EIDX = (int*)(ws + WS_EIDX); float* EGATE = (float*)(ws + WS_EGATE); float* RSTD = (float*)(ws + WS_RSTD);
    bf16* XN = (bf16*)(ws + WS_XN); bf16* MIX = XN;
    bf16* Qb = (bf16*)(ws + WS_Q); bf16* Kb = (bf16*)(ws + WS_K); bf16* Vb = (bf16*)(ws + WS_V); bf16* QP = Qb;
    bf16* CB = (bf16*)(ws + WS_CB); bf16* CC = (bf16*)(ws + WS_CC); bf16* CX = (bf16*)(ws + WS_CX); bf16* A2 = CB;
    unsigned char* U8 = ws + WS_UT; unsigned char* V8 = ws + WS_VT;
    volatile LAS unsigned* MISC = (volatile LAS unsigned*)(lds + MISC_OFF);
    if (tid < 16) MISC[tid] = 0u;
    __syncthreads();
    XcdBarrier bar = xcd_barrier_post((unsigned*)(ws + WS_CTL) + CW_BAR, MISC + 8);
    const int lo = args.ph_lo, hi_ph = args.ph_hi;
#ifndef DBG_DUP
#define DBG_DUP -1
#endif
#ifndef DBG_MASK
#define DBG_MASK 0xfff
#endif
#define IN(k) (((DBG_MASK >> (k)) & 1) && lo <= (k) && (k) < hi_ph)
#define REPS(k) for (int rep_ = 0; rep_ < ((DBG_DUP == (k)) ? 2 : 1); ++rep_)
#define SEAM(k) do { if (IN(k) && IN((k) + 1)) xcd_barrier(bar); } while (0)
    const int gw = vcu * NWAVES + wave, NGW = G * NWAVES;
    const size_t gtid = (size_t)bx * NTHREADS + tid, nthr = (size_t)G * NTHREADS;

    if (IN(0)) REPS(0) {
        LAS float* scr = (LAS float*)(lds + wave * 16384);
        constexpr int I_IN = (DM / 64) * (INC / 32), I_SQ = (DM / 64) * (DM / 32);
        for (int it = gw; it < I_IN + 2 * I_SQ; it += NGW) {
            if (it < I_IN) p0_transpose_item(w_in, DM, INC, WtIn, scr, it, lane, true);
            else if (it < I_IN + I_SQ) p0_transpose_item(w_out, DM, DM, WtOut, scr, it - I_IN, lane, false);
            else p0_transpose_item(w_q, DM, DM, WtQ, scr, it - I_IN - I_SQ, lane, false);
        }
        for (int m = gw; m < T; m += NGW) rms_row_to_bf16(x + (size_t)m * DM, attn_g, XN + (size_t)m * DM, lane);
        cvt_bf16_stream(subkeys, SK, (size_t)PEH * 2 * PNK * 128 / 8, gtid, nthr);
        cvt_fp8_slices(peer_u, U8, U8_SCALE, gtid, nthr);
        cvt_fp8_slices(peer_v, V8, V8_SCALE, gtid, nthr);
    }
    SEAM(0);
    if (IN(1)) REPS(1) {
        pg8::Gemm g{XN, WtIn, T, INC, DM}; pg8::StaticOrder S; S.init(T, INC, G, bx);
        pg8::EpiProj E{Qb, qg, kg};
        pg8::gemm_phase<pg8::EpiProj, pg8::StaticOrder, true, true>(lds, g, S, E);
    }
    SEAM(1);
    if (IN(2)) REPS(2) {
        float a = lq1[lane] * lk1[lane], b2 = lq2[lane] * lk2[lane];
        a = wave_sum(a); b2 = wave_sum(b2);
        const float lam = expf(a) - expf(b2) + 0.2f;
        const float mq = wave_max(fabsf(qg[lane])), mk = wave_max(fabsf(kg[lane]));
        const float M2 = 64.f * C2 * mq * mk;
#if DBG_NAIVE_ATTN
        for (int r = gw; r < NB * NH * SEQ; r += NGW) naive_attn_row(r >> 14, (r >> 11) & 7, r & 2047, Qb, Kb, Vb, MIX, subg, lam, (LAS float*)(lds + wave * 16384), lane);
        if (0)
#endif
        for (int v = vcu; v < NB * NH * 4; v += G) {
            const int bh = v >> 2, s = v & 3, b = bh >> 3, h = bh & 7;
#pragma unroll 1
            for (int i = 0; i < 4; ++i) { const int qblk = (i == 0) ? s : (i == 1) ? 7 - s : (i == 2) ? 8 + s : 15 - s;
                att::attn_unit(b, h, qblk, Qb, Kb, Vb, MIX, subg, lam, M2, (LAS char*)lds); }
        }
        for (size_t it = gtid; it < (size_t)(T / 16) * 128; it += nthr) {
            const int cg8 = (int)(it & 127), chunk = (int)(it >> 7), t0 = chunk * 16, col = cg8 * 8;
            f32x4 w0a = *(const f32x4*)(conv_w + col), w0b = *(const f32x4*)(conv_w + col + 4), w1a = *(const f32x4*)(conv_w + 1024 + col), w1b = *(const f32x4*)(conv_w + 1024 + col + 4),
                  w2a = *(const f32x4*)(conv_w + 2048 + col), w2b = *(const f32x4*)(conv_w + 2048 + col + 4);
            float u1[8], u2[8];
#pragma unroll
            for (int i = 0; i < 8; ++i) { u1[i] = 0.f; u2[i] = 0.f; }
            if ((t0 % SEQ) != 0) {
                const v4u c1 = *(const v4u*)(CC + (size_t)(t0 - 1) * 1024 + col), x1v = *(const v4u*)(CX + (size_t)(t0 - 1) * 1024 + col), c2 = *(const v4u*)(CC + (size_t)(t0 - 2) * 1024 + col), x2v = *(const v4u*)(CX + (size_t)(t0 - 2) * 1024 + col);
                u1[0] = bflo(c1.x) * bflo(x1v.x); u1[1] = bfhi(c1.x) * bfhi(x1v.x); u1[2] = bflo(c1.y) * bflo(x1v.y); u1[3] = bfhi(c1.y) * bfhi(x1v.y); u1[4] = bflo(c1.z) * bflo(x1v.z); u1[5] = bfhi(c1.z) * bfhi(x1v.z); u1[6] = bflo(c1.w) * bflo(x1v.w); u1[7] = bfhi(c1.w) * bfhi(x1v.w);
                u2[0] = bflo(c2.x) * bflo(x2v.x); u2[1] = bfhi(c2.x) * bfhi(x2v.x); u2[2] = bflo(c2.y) * bflo(x2v.y); u2[3] = bfhi(c2.y) * bfhi(x2v.y); u2[4] = bflo(c2.z) * bflo(x2v.z); u2[5] = bfhi(c2.z) * bfhi(x2v.z); u2[6] = bflo(c2.w) * bflo(x2v.w); u2[7] = bfhi(c2.w) * bfhi(x2v.w);
            }
            const float w0[8] = {w0a.x, w0a.y, w0a.z, w0a.w, w0b.x, w0b.y, w0b.z, w0b.w}, w1[8] = {w1a.x, w1a.y, w1a.z, w1a.w, w1b.x, w1b.y, w1b.z, w1b.w}, w2[8] = {w2a.x, w2a.y, w2a.z, w2a.w, w2b.x, w2b.y, w2b.z, w2b.w};
#pragma unroll 4
            for (int j = 0; j < 16; ++j) { const size_t ro = (size_t)(t0 + j) * 1024 + col;
                const v4u bv = *(const v4u*)(CB + ro), cv = *(const v4u*)(CC + ro), xv = *(const v4u*)(CX + ro);
                float u0[8], bb[8], y[8];
                u0[0] = bflo(cv.x) * bflo(xv.x); u0[1] = bfhi(cv.x) * bfhi(xv.x); u0[2] = bflo(cv.y) * bflo(xv.y); u0[3] = bfhi(cv.y) * bfhi(xv.y); u0[4] = bflo(cv.z) * bflo(xv.z); u0[5] = bfhi(cv.z) * bfhi(xv.z); u0[6] = bflo(cv.w) * bflo(xv.w); u0[7] = bfhi(cv.w) * bfhi(xv.w);
                bb[0] = bflo(bv.x); bb[1] = bfhi(bv.x); bb[2] = bflo(bv.y); bb[3] = bfhi(bv.y); bb[4] = bflo(bv.z); bb[5] = bfhi(bv.z); bb[6] = bflo(bv.w); bb[7] = bfhi(bv.w);
#pragma unroll
                for (int i = 0; i < 8; ++i) { y[i] = bb[i] * (u2[i] * w0[i] + u1[i] * w1[i] + u0[i] * w2[i]); u2[i] = u1[i]; u1[i] = u0[i]; }
                v4u o; o.x = pk2(y[0], y[1]); o.y = pk2(y[2], y[3]); o.z = pk2(y[4], y[5]); o.w = pk2(y[6], y[7]);
                *(v4u*)(MIX + (size_t)(t0 + j) * 2048 + 1024 + col) = o; }
        }
    }
    SEAM(2);
    if (IN(3)) REPS(3) {
        pg8::Gemm g{MIX, WtOut, T, DM, DM}; pg8::StaticOrder S; S.init(T, DM, G, bx);
        pg8::EpiX1 E{x, out, A2, ffn_g, SSQ};
        pg8::gemm_phase<pg8::EpiX1, pg8::StaticOrder, true, true>(lds, g, S, E);
    }
    SEAM(3);
    if (IN(4)) REPS(4) {
        pg8::Gemm g{A2, WtQ, T, DM, DM}; pg8::StaticOrder S; S.init(T, DM, G, bx);
        pg8::EpiBf16<0> E{QP, DM, nullptr, 0, 0, 1.f};
        pg8::gemm_phase<pg8::EpiBf16<0>, pg8::StaticOrder, true, true>(lds, g, S, E);
    }
    SEAM(4);
    if (IN(5)) REPS(5) {
        for (int it = vcu; it < (T / 128) * PEH; it += G) peer_topk_item(it >> 3, it & 7, QP, SK, SSQ, EIDX, EGATE, RSTD, (LAS char*)lds);
    }
    SEAM(5);
    if (IN(6)) {
        float* PART = (float*)(ws + WS_PART);
        for (int r = 0; r < 2; ++r) { const int s = 8 * r + (bx & 7);
            for (int t = (bx >> 3) * NWAVES + wave; t < T; t += (G >> 3) * NWAVES) peer_u_item(t, s, A2, U8, EIDX, PART, lane); }
    }
    SEAM(6);
    if (IN(7)) {
        const float* PART = (const float*)(ws + WS_PART); float* ACT = (float*)(ws + WS_ACT);
        for (size_t i = gtid; i < (size_t)T * 128; i += nthr) { float z = 0.f;
#pragma unroll
            for (int s = 0; s < 16; ++s) z += PART[(size_t)s * T * 128 + i];
            z *= RSTD[i >> 7] * (1.0f / U8_SCALE);
            ACT[i] = 0.5f * z * (1.0f + erff(z * 0.70710678118654752f)) * EGATE[i] * (1.0f / V8_SCALE); }
    }
    SEAM(7);
    if (IN(8)) {
        const float* ACT = (const float*)(ws + WS_ACT);
        for (int r = 0; r < 2; ++r) { const int s = 8 * r + (bx & 7);
            for (int t = (bx >> 3) * NWAVES + wave; t < T; t += (G >> 3) * NWAVES) peer_v_item(t, s, V8, EIDX, ACT, out, lane); }
    }
#undef IN
#undef SEAM
}

extern "C" void kernel_launch(void* const* d_in, const int* in_sizes, int n_in, void* d_out, int out_size, void* d_ws, size_t ws_size, hipStream_t stream) {
    static int grid = 0;
    if (grid == 0) {
        if (n_in != 17 || out_size != T * DM || ws_size < WS_END) { fprintf(stderr, "kernel_launch: unexpected shapes (n_in %d out %d ws %zu)\n", n_in, out_size, ws_size); grid = -1; return; }
        int dev = 0, cus = 0, per_cu = 0;
        if (hipGetDevice(&dev) != hipSuccess || hipDeviceGetAttribute(&cus, hipDeviceAttributeMultiprocessorCount, dev) != hipSuccess) { grid = -1; return; }
        if (hipFuncSetAttribute((const void*)mk_fwd, hipFuncAttributeMaxDynamicSharedMemorySize, LDS_BYTES) != hipSuccess) { fprintf(stderr, "kernel_launch: hipFuncSetAttribute failed\n"); grid = -1; return; }
        if (hipOccupancyMaxActiveBlocksPerMultiprocessor(&per_cu, (const void*)mk_fwd, NTHREADS, LDS_BYTES) != hipSuccess || per_cu < 1) { fprintf(stderr, "kernel_launch: occupancy query says %d blocks per CU\n", per_cu); (void)hipGetLastError(); grid = -1; return; }
        grid = cus;
    }
    if (grid < 0) return;
    if (hipMemsetAsync((char*)d_ws + WS_CTL, 0, CTL_ZERO_BYTES, stream) != hipSuccess) { fprintf(stderr, "kernel_launch: memset failed\n"); return; }
    Args a{};
    for (int i = 0; i < 17; ++i) a.in[i] = (const float*)d_in[i];
    a.out = (float*)d_out; a.ws = (unsigned char*)d_ws;
#if MK_N_LAUNCHES == 1
    a.ph_lo = 0; a.ph_hi = NPHASE;
    void* kargs[] = {&a};
    hipError_t e = hipLaunchCooperativeKernel((const void*)mk_fwd, dim3(grid), dim3(NTHREADS), kargs, LDS_BYTES, stream);
    if (e != hipSuccess) fprintf(stderr, "kernel_launch: cooperative launch failed: %s (grid %d)\n", hipGetErrorString(e), grid);
#else
#ifndef DBG_DUPL
#define DBG_DUPL -1
#endif
    for (int p = 0; p < NPHASE; ++p) { a.ph_lo = p; a.ph_hi = p + 1; for (int r = 0; r < (p == DBG_DUPL ? 2 : 1); ++r) hipLaunchKernelGGL(mk_fwd, dim3(grid), dim3(NTHREADS), LDS_BYTES, stream, a); }
#endif
}
```

```cpp
#include <hip/hip_runtime.h>
#include <hip/hip_cooperative_groups.h>
#include <cstdio>
#include <cstdint>
#include <cmath>
namespace cg = cooperative_groups;
namespace pg8 {
#define PG8_LAS __attribute__((address_space(3)))
typedef unsigned short bf16_t;
typedef short bf16x8 __attribute__((ext_vector_type(8)));
typedef float f32x4 __attribute__((ext_vector_type(4)));
typedef unsigned u32x4 __attribute__((ext_vector_type(4)));
constexpr int BM = 256, BK = 64, HALF = 128, HTB = HALF * BK * 2  , STAGE_BYTES = 8 * HTB, NXCD = 8, WGM = 8;

__host__ __device__ __forceinline__ int lds_byte(int r, int c) { const int st = (r >> 4) * 2 + (c >> 5), rr = r & 15, cc = c & 31, ob = rr * 64 + cc * 2; return st * 1024 + (ob ^ (((ob >> 9) & 1) << 5)); }
__host__ __device__ __forceinline__ void stage_rc(int b, int& R, int& C) { const int st = b / 1024, sb = b % 1024, swz = sb ^ (((sb >> 9) & 1) << 5); R = (st >> 1) * 16 + swz / 64; C = (st & 1) * 32 + (swz % 64) / 2; }
__host__ __device__ __forceinline__ int perm32(int rho) { const int n = rho >> 4, i = rho & 15; return 8 * (i >> 2) + 4 * n + (i & 3); }

struct Unit { int pm, pn; };
struct Gemm { const bf16_t* A; const bf16_t* Bt; int M, N, K; };

struct StaticOrder {
    int nM, nN, nwg, G, c;
    __host__ __device__ void init(int M, int N, int G_, int c_) { nM = M / BM; nN = N / BM; nwg = nM * nN; G = G_; c = c_; }
    __host__ __device__ bool next(int i, Unit& u) const {
        const long L = (long)i * G + c; if (L >= nwg) return false;
        int wgid = (int)L; { const int q = nwg / NXCD, r = nwg % NXCD, xcd = wgid % NXCD, off = wgid / NXCD; wgid = (xcd < r ? xcd * (q + 1) : r * (q + 1) + (xcd - r) * q) + off; }
        const int nig = WGM * nN, gid = wgid / nig, fm = gid * WGM, gsz = (nM - fm) < WGM ? (nM - fm) : WGM;
        u.pm = fm + ((wgid % nig) % gsz); u.pn = (wgid % nig) / gsz; return true;
    }
    __device__ __forceinline__ void a_ready(const Unit&) const {}
    __device__ __forceinline__ void done(const Unit&) const {}
};

__device__ __forceinline__ unsigned cvt_pk_bf16(float lo, float hi) { unsigned r; asm volatile("v_cvt_pk_bf16_f32 %0, %1, %2" : "=v"(r) : "v"(lo), "v"(hi)); return r; }
typedef float f32x2 __attribute__((ext_vector_type(2)));
__device__ __forceinline__ f32x2 gelu_pk(f32x2 v) {
    const f32x2 av = __builtin_elementwise_abs(v), d = av * 0.2316418882f + 1.0f;
    f32x2 t; t.x = __builtin_amdgcn_rcpf(d.x); t.y = __builtin_amdgcn_rcpf(d.y);
    f32x2 q = t * 0.5307027145f + (-0.7265760135f); q = q * t + 0.7107068705f; q = q * t + (-0.142248368f); q = q * t + 0.127414796f; q = q * t;
    const f32x2 s = (v * v) * (-0.72134752044f);
    f32x2 e; e.x = __builtin_amdgcn_exp2f(s.x); e.y = __builtin_amdgcn_exp2f(s.y);
    const f32x2 m = v * (q * e), r = v - m;
    f32x2 o; o.x = v.x < 0.f ? m.x : r.x; o.y = v.y < 0.f ? m.y : r.y; return o;
}

template <int ACT  > struct EpiBf16 {
    static constexpr bool PERM = true, AFTER_DRAIN = false; static_assert(ACT == 0 || ACT == 1, "EpiBf16: ACT is 0 (none) or 1 (gelu_pk)");
    bf16_t* O; int ldc; const float* bias; int split_cols; size_t split_stride; float scale0;
    __device__ __forceinline__ void operator()(const f32x4 (&acc)[2][2][4][2], const Unit& u, int wr, int wc, int fr, int fq) const {
        const int row0 = u.pm * BM + wr * 64 + fr; int colt = u.pn * BM; bf16_t* base = O;
        float sc = 1.f; if (split_cols) { const int t = colt / split_cols; base += (size_t)t * split_stride; colt -= t * split_cols; if (t == 0) sc = scale0; }
        const int col0 = colt + wc * 32 + 8 * fq, bcol0 = u.pn * BM + wc * 32 + 8 * fq;
        f32x4 bv[2][2];
#pragma unroll
        for (int bj = 0; bj < 2; ++bj)
#pragma unroll
            for (int n = 0; n < 2; ++n) bv[bj][n] = bias ? *(const f32x4*)(bias + bcol0 + bj * HALF + 4 * n) : (f32x4){0.f, 0.f, 0.f, 0.f};
#pragma unroll
        for (int ai = 0; ai < 2; ++ai)
#pragma unroll
            for (int m = 0; m < 4; ++m) { bf16_t* rowp = base + (size_t)(row0 + ai * HALF + m * 16) * ldc + col0;
#pragma unroll
                for (int bj = 0; bj < 2; ++bj) { f32x4 v0 = acc[ai][bj][m][0] + bv[bj][0], v1 = acc[ai][bj][m][1] + bv[bj][1];
                    if (ACT == 1) { f32x2 a = gelu_pk((f32x2){v0[0], v0[1]}), b = gelu_pk((f32x2){v0[2], v0[3]}), c = gelu_pk((f32x2){v1[0], v1[1]}), d = gelu_pk((f32x2){v1[2], v1[3]});
                        v0 = (f32x4){a.x, a.y, b.x, b.y}; v1 = (f32x4){c.x, c.y, d.x, d.y}; }
                    v0 = v0 * sc; v1 = v1 * sc; u32x4 w; w.x = cvt_pk_bf16(v0[0], v0[1]); w.y = cvt_pk_bf16(v0[2], v0[3]); w.z = cvt_pk_bf16(v1[0], v1[1]); w.w = cvt_pk_bf16(v1[2], v1[3]);
                    *(u32x4*)(rowp + bj * HALF) = w; } }
    }
};
template <class Epi, class Sched, bool ALIGN_EPI = false, bool SP2 = false>
__device__ __forceinline__ void gemm_phase(PG8_LAS unsigned char* lds, const Gemm g, const Sched& S, const Epi& E) {
    const int tid = threadIdx.x, wid = __builtin_amdgcn_readfirstlane(tid >> 6), lane = tid & 63, wr = wid >> 2, wc = wid & 3, fr = lane & 15, fq = lane >> 4;
    const int K = g.K, nt = K / BK;
    unsigned voffA[2], voffB[2];
#pragma unroll
    for (int i = 0; i < 2; ++i) { int R, C; stage_rc(tid * 16 + i * 8192, R, C); const int Rb = Epi::PERM ? ((R & ~31) + perm32(R & 31)) : R;
        voffA[i] = (unsigned)(R * K + C) * 2u; voffB[i] = (unsigned)(Rb * K + C) * 2u; }
    const size_t kstep = (size_t)(BK * 2);
    const size_t hstep = (size_t)HALF * K * 2;
    const size_t tstep = 2 * hstep;
    const unsigned ldsw = (unsigned)wid * 1024u;
    const int aoff = lds_byte(wr * 64 + fr, fq * 8), boff = lds_byte(wc * 32 + fr, fq * 8);
#define PG8_SA(b, h) (((b) * 2 + (h)) * HTB)
#define PG8_SB(b, h) ((4 + (b) * 2 + (h)) * HTB)
#define PG8_STAGE(bufoff, gbase, voff) do { _Pragma("unroll") for (int _i = 0; _i < 2; ++_i) \
        __builtin_amdgcn_global_load_lds((const unsigned*)((const char*)(gbase) + (voff)[_i]), (PG8_LAS unsigned*)(lds + (bufoff) + ldsw + _i * 8192), 16, 0, 0); } while (0)
#define PG8_LDA(dst, b, h) do { _Pragma("unroll") for (int m = 0; m < 4; ++m) _Pragma("unroll") for (int k = 0; k < 2; ++k) dst[m][k] = *(const PG8_LAS bf16x8*)(lds + PG8_SA(b, h) + aoff + m * 2048 + k * 1024); } while (0)
#define PG8_LDB(dst, b, h) do { _Pragma("unroll") for (int n = 0; n < 2; ++n) _Pragma("unroll") for (int k = 0; k < 2; ++k) dst[n][k] = *(const PG8_LAS bf16x8*)(lds + PG8_SB(b, h) + boff + n * 2048 + k * 1024); } while (0)
#define PG8_MMA(ai, bj, At, Bt) do { __builtin_amdgcn_s_setprio(1); _Pragma("unroll") for (int m = 0; m < 4; ++m) _Pragma("unroll") for (int n = 0; n < 2; ++n) _Pragma("unroll") for (int k = 0; k < 2; ++k) \
        acc[ai][bj][m][n] = __builtin_amdgcn_mfma_f32_16x16x32_bf16(Bt[n][k], At[m][k], acc[ai][bj][m][n], 0, 0, 0); __builtin_amdgcn_s_setprio(0); } while (0)
#define PG8_WAIT_V(n) asm volatile("s_waitcnt vmcnt(" #n ")" ::: "memory")
#define PG8_WAIT_L(n) asm volatile("s_waitcnt lgkmcnt(" #n ")" ::: "memory")
#define PG8_BAR __builtin_amdgcn_s_barrier()
#define PG8_SCHED __builtin_amdgcn_sched_barrier(0)
    Unit cur, nxt; int ui = 0;
    if (!S.next(0, cur)) return;
    f32x4 acc[2][2][4][2];
#pragma unroll
    for (int a = 0; a < 2; ++a)
#pragma unroll
        for (int b = 0; b < 2; ++b)
#pragma unroll
            for (int m = 0; m < 4; ++m)
#pragma unroll
                for (int n = 0; n < 2; ++n) acc[a][b][m][n] = (f32x4){0.f, 0.f, 0.f, 0.f};
    bf16x8 At[4][2], B0[2][2], B1[2][2];
    const char* cA = (const char*)g.A + (size_t)cur.pm * tstep; const char* cB = (const char*)g.Bt + (size_t)cur.pn * tstep;
    S.a_ready(cur);
    if constexpr (SP2) {
        PG8_STAGE(PG8_SB(0, 0), cB, voffB); PG8_STAGE(PG8_SB(0, 1), cB + hstep, voffB); PG8_STAGE(PG8_SA(0, 0), cA, voffA); PG8_STAGE(PG8_SA(0, 1), cA + hstep, voffA);
        if (wr == 1) PG8_BAR;
        PG8_WAIT_V(2); PG8_BAR;
        PG8_STAGE(PG8_SB(1, 0), cB + kstep, voffB); PG8_STAGE(PG8_SA(1, 0), cA + kstep, voffA); PG8_STAGE(PG8_SB(1, 1), cB + hstep + kstep, voffB);
        PG8_WAIT_V(6); PG8_BAR;
    } else {
        PG8_STAGE(PG8_SB(0, 0), cB, voffB); PG8_STAGE(PG8_SA(0, 0), cA, voffA); PG8_STAGE(PG8_SB(0, 1), cB + hstep, voffB); PG8_STAGE(PG8_SA(0, 1), cA + hstep, voffA);
        if (wr == 1) PG8_BAR;
        PG8_WAIT_V(4); PG8_BAR;
        PG8_STAGE(PG8_SB(1, 0), cB + kstep, voffB); PG8_STAGE(PG8_SA(1, 0), cA + kstep, voffA); PG8_STAGE(PG8_SB(1, 1), cB + hstep + kstep, voffB);
        PG8_WAIT_V(6); PG8_BAR;
    }
    for (;;) {
        const bool has_next = S.next(ui + 1, nxt);
        const char* nA = has_next ? (const char*)g.A + (size_t)nxt.pm * tstep : cA; const char* nB = has_next ? (const char*)g.Bt + (size_t)nxt.pn * tstep : cB;
        for (int t = 0; t < nt; t += 2) {
            const bool last = (t == nt - 2);
            const char* a1 = cA + (size_t)(t + 1) * kstep;
            const char* a2 = last ? nA : cA + (size_t)(t + 2) * kstep; const char* b2 = last ? nB : cB + (size_t)(t + 2) * kstep;
            const char* a3 = a2 + kstep; const char* b3 = b2 + kstep;
            if (last && has_next) S.a_ready(nxt);
            if constexpr (SP2) {
            PG8_LDB(B0, 0, 0); PG8_LDB(B1, 0, 1); PG8_SCHED; PG8_LDA(At, 0, 0); PG8_STAGE(PG8_SA(1, 1), a1 + hstep, voffA);
            PG8_WAIT_V(8); PG8_WAIT_L(0); PG8_BAR; PG8_MMA(0, 0, At, B0); PG8_MMA(0, 1, At, B1); PG8_BAR; PG8_SCHED;
            PG8_LDA(At, 0, 1); PG8_STAGE(PG8_SB(0, 0), b2, voffB); PG8_STAGE(PG8_SB(0, 1), b2 + hstep, voffB); PG8_STAGE(PG8_SA(0, 0), a2, voffA);
            PG8_WAIT_V(8); PG8_WAIT_L(0); PG8_BAR; PG8_MMA(1, 0, At, B0); PG8_MMA(1, 1, At, B1); PG8_BAR; PG8_SCHED;
            PG8_LDB(B0, 1, 0); PG8_LDB(B1, 1, 1); PG8_SCHED; PG8_LDA(At, 1, 0); PG8_STAGE(PG8_SA(0, 1), a2 + hstep, voffA);
            PG8_WAIT_V(8); PG8_WAIT_L(0); PG8_BAR; PG8_MMA(0, 0, At, B0); PG8_MMA(0, 1, At, B1); PG8_BAR; PG8_SCHED;
            PG8_LDA(At, 1, 1); PG8_STAGE(PG8_SB(1, 0), b3, voffB); PG8_STAGE(PG8_SB(1, 1), b3 + hstep, voffB); PG8_STAGE(PG8_SA(1, 0), a3, voffA);
            PG8_WAIT_V(8); PG8_WAIT_L(0); PG8_BAR; PG8_MMA(1, 0, At, B0); PG8_MMA(1, 1, At, B1); PG8_BAR; PG8_SCHED;
            } else {
            PG8_LDB(B0, 0, 0); PG8_SCHED; PG8_LDA(At, 0, 0); PG8_STAGE(PG8_SA(1, 1), a1 + hstep, voffA);
            PG8_WAIT_L(8); PG8_BAR; PG8_WAIT_L(0); PG8_MMA(0, 0, At, B0); PG8_BAR; PG8_SCHED;
            PG8_LDB(B1, 0, 1); PG8_STAGE(PG8_SB(0, 0), b2, voffB);
            PG8_BAR; PG8_WAIT_L(0); PG8_MMA(0, 1, At, B1); PG8_BAR;
            PG8_LDA(At, 0, 1); PG8_STAGE(PG8_SA(0, 0), a2, voffA);
            PG8_BAR; PG8_WAIT_L(0); PG8_MMA(1, 0, At, B0); PG8_BAR; PG8_SCHED;
            PG8_STAGE(PG8_SB(0, 1), b2 + hstep, voffB);
            PG8_WAIT_V(6); PG8_BAR; PG8_MMA(1, 1, At, B1); PG8_BAR;
            PG8_LDB(B0, 1, 0); PG8_SCHED; PG8_LDA(At, 1, 0); PG8_STAGE(PG8_SA(0, 1), a2 + hstep, voffA);
            PG8_WAIT_L(8); PG8_BAR; PG8_WAIT_L(0); PG8_MMA(0, 0, At, B0); PG8_BAR; PG8_SCHED;
            PG8_LDB(B1, 1, 1); PG8_STAGE(PG8_SB(1, 0), b3, voffB);
            PG8_BAR; PG8_WAIT_L(0); PG8_MMA(0, 1, At, B1); PG8_BAR;
            PG8_LDA(At, 1, 1); PG8_STAGE(PG8_SA(1, 0), a3, voffA);
            PG8_BAR; PG8_WAIT_L(0); PG8_MMA(1, 0, At, B0); PG8_BAR; PG8_SCHED;
            PG8_STAGE(PG8_SB(1, 1), b3 + hstep, voffB);
            PG8_WAIT_V(6); PG8_BAR; PG8_MMA(1, 1, At, B1); PG8_BAR;
            }
        }
        if constexpr (ALIGN_EPI) { if (wr == 0) PG8_BAR; }
        if constexpr (!Epi::AFTER_DRAIN) { E(acc, cur, wr, wc, fr, fq); S.done(cur); }
        if (!has_next) break;
#pragma unroll
        for (int a = 0; a < 2; ++a)
#pragma unroll
            for (int b = 0; b < 2; ++b)
#pragma unroll
                for (int m = 0; m < 4; ++m)
#pragma unroll
                    for (int n = 0; n < 2; ++n) acc[a][b][m][n] = (f32x4){0.f, 0.f, 0.f, 0.f};
        cur = nxt; cA = nA; cB = nB; ++ui;
        if constexpr (ALIGN_EPI) { if (wr == 1) PG8_BAR; }
    }
    PG8_WAIT_V(0);
    if constexpr (!ALIGN_EPI) { if (wr == 0) PG8_BAR; }
    PG8_BAR;
    if constexpr (Epi::AFTER_DRAIN) { E.fused(acc, cur, wr, wc, fr, fq, lds, wid, lane); S.done(cur); }
#undef PG8_SA
#undef PG8_SB
#undef PG8_STAGE
#undef PG8_LDA
#undef PG8_LDB
#undef PG8_MMA
#undef PG8_WAIT_V
#undef PG8_WAIT_L
#undef PG8_BAR
#undef PG8_SCHED
}
}
#define MK_N_LAUNCHES 1
#ifndef MK_N_LAUNCHES
#define MK_N_LAUNCHES 1
#endif
constexpr int DM = 2048, NB = 8, SEQ = 2048, T = NB * SEQ;
constexpr int AW = 1024, NH = 8, HD = 64, VD = 128, INC = 6144;
constexpr int PNK = 128, PTOPK = 16, PEH = 8, EPT = PEH * PTOPK;
constexpr float EPS = 1e-6f;
constexpr float C2 = 0.125f * 1.4426950408889634f;
constexpr int NPHASE = 9;
constexpr float U8_SCALE = 256.f, V8_SCALE = 16.f;
constexpr size_t MiB = 1u << 20;
constexpr size_t WS_WIN = 1 * MiB, WS_WOUT = 25 * MiB, WS_WQ = 33 * MiB, WS_SK = 41 * MiB, WS_SSQ = 42 * MiB, WS_EIDX = 44 * MiB, WS_EGATE = 52 * MiB, WS_RSTD = 60 * MiB;
constexpr size_t WS_XN = 64 * MiB;
constexpr size_t WS_Q = 128 * MiB, WS_K = 160 * MiB, WS_V = 192 * MiB;
constexpr size_t WS_CB = 224 * MiB, WS_CC = 256 * MiB, WS_CX = 288 * MiB;
constexpr size_t WS_UT = 320 * MiB, WS_VT = 384 * MiB, WS_END = 448 * MiB;
constexpr size_t WS_CTL = 0; constexpr int CW_BAR = 1024, CTL_ZERO_BYTES = 65536;
constexpr size_t WS_PART = 64 * MiB, WS_ACT = 192 * MiB;
constexpr int MISC_OFF = 143360;
constexpr int LDS_BYTES = 147456;
constexpr int NWAVES = 8, NTHREADS = 512;

#define LAS __attribute__((address_space(3)))
typedef unsigned short bf16;
typedef unsigned v4u __attribute__((ext_vector_type(4)));
typedef unsigned v2u __attribute__((ext_vector_type(2)));
typedef float f32x4 __attribute__((ext_vector_type(4)));
typedef float f32x2 __attribute__((ext_vector_type(2)));
typedef float f32x16 __attribute__((ext_vector_type(16)));
typedef short bf16x8 __attribute__((ext_vector_type(8)));
typedef short s16x4 __attribute__((ext_vector_type(4)));
typedef __bf16 bf16x2_t __attribute__((ext_vector_type(2)));
#define LDS_WAIT() asm volatile("s_waitcnt lgkmcnt(0)" ::: "memory")
__device__ __forceinline__ unsigned pk2(float lo, float hi) { f32x2 v = {lo, hi}; bf16x2_t b = __builtin_convertvector(v, bf16x2_t); return __builtin_bit_cast(unsigned, b); }
__device__ __forceinline__ float bflo(unsigned u) { return __uint_as_float(u << 16); }
__device__ __forceinline__ float bfhi(unsigned u) { return __uint_as_float(u & 0xffff0000u); }
__device__ __forceinline__ float wave_sum(float v) {
#pragma unroll
    for (int o = 1; o < 64; o <<= 1) v += __shfl_xor(v, o);
    return v;
}
__device__ __forceinline__ float wave_max(float v) {
#pragma unroll
    for (int o = 1; o < 64; o <<= 1) v = fmaxf(v, __shfl_xor(v, o));
    return v;
}

#define XB_TMO      128
#define XB_XCNT(j)  (256  + 64 * (j))
#define XB_XSUB(j)  (1280 + 64 * (j))
#define XB_XGEN(j)  (2304 + 64 * (j))
#define XB_TOP      3328
#define XB_TOPGEN   3392
#define XCD_BAR_WORDS 3456
#define XB_SPIN_CAP (1u << 18)

__device__ __forceinline__ unsigned xb_ld(unsigned* p)              { return __hip_atomic_load(p, __ATOMIC_RELAXED, __HIP_MEMORY_SCOPE_AGENT); }
__device__ __forceinline__ unsigned xb_add(unsigned* p, unsigned v) { return __hip_atomic_fetch_add(p, v, __ATOMIC_RELAXED, __HIP_MEMORY_SCOPE_AGENT); }
__device__ __forceinline__ unsigned xb_xcc_id() { return (unsigned)__builtin_amdgcn_s_getreg((3 << 11) | 20) & 0xFu; }
#define XB_SPIN(cond, bar) do { unsigned _sp = 0; while (cond) { __builtin_amdgcn_s_sleep(1); \
    if ((++_sp & 255u) == 0u) { if (xb_ld(&(bar)[XB_TMO])) break; if (_sp > XB_SPIN_CAP) { atomicAdd(&(bar)[XB_TMO], 1u); break; } } } } while (0)

struct XcdBarrier {
    unsigned* bar; unsigned x;
    volatile LAS unsigned* st;
};

__device__ __forceinline__ XcdBarrier xcd_barrier_post(unsigned* bar, volatile LAS unsigned* st) {
    XcdBarrier b; b.bar = bar; b.x = xb_xcc_id(); b.st = st;
    if (threadIdx.x == 0) (void)xb_add(&bar[XB_XCNT(b.x)], 1u);
    return b;
}
__device__ __forceinline__ void xcd_barrier_complete(unsigned* bar, unsigned x, unsigned& nloc, unsigned& nx) {
    const unsigned G = gridDim.x * gridDim.y * gridDim.z;
    unsigned sum, cnt, mine, sp = 0u;
    for (;;) {
        sum = 0u; cnt = 0u; mine = 0u;
#pragma unroll
        for (unsigned j = 0; j < 16; ++j) { const unsigned c = xb_ld(&bar[XB_XCNT(j)]); sum += c; cnt += (c > 0u) ? 1u : 0u; mine = (j == x) ? c : mine; }
        if (sum == G) break;
        __builtin_amdgcn_s_sleep(1);
        if ((++sp & 255u) == 0u) { if (xb_ld(&bar[XB_TMO])) break; if (sp > XB_SPIN_CAP) { atomicAdd(&bar[XB_TMO], 1u); break; } }
    }
    nloc = mine > 0u ? mine : 1u; nx = cnt > 0u ? cnt : 1u;
}

__device__ __forceinline__ void xcd_barrier(const XcdBarrier& b) {
    asm volatile("s_waitcnt vmcnt(0)" ::: "memory");
    __syncthreads();
    if (threadIdx.x == 0) {
        unsigned* bar = b.bar;
        __builtin_amdgcn_s_waitcnt(0);
        unsigned nloc = b.st[0], nx = b.st[1];
        if (nloc == 0u) { xcd_barrier_complete(bar, b.x, nloc, nx); b.st[0] = nloc; b.st[1] = nx; }
        const unsigned old = xb_add(&bar[XB_XSUB(b.x)], 1u);
        const unsigned gen = old / nloc;
        if (old + 1u == (gen + 1u) * nloc) {
            __builtin_amdgcn_fence(__ATOMIC_RELEASE, "agent");
            asm volatile("s_waitcnt vmcnt(0)" ::: "memory");
            const unsigned og = xb_add(&bar[XB_TOP], 1u);
            const unsigned tg = og / nx;
            if (og + 1u == (tg + 1u) * nx) xb_add(&bar[XB_TOPGEN], 1u);
            else XB_SPIN(xb_ld(&bar[XB_TOPGEN]) == tg, bar);
            __builtin_amdgcn_fence(__ATOMIC_ACQUIRE, "agent");
            xb_add(&bar[XB_XGEN(b.x)], 1u);
            asm volatile("s_waitcnt vmcnt(0)" ::: "memory");
        } else {
            XB_SPIN(xb_ld(&bar[XB_XGEN(b.x)]) == gen, bar);
            __builtin_amdgcn_fence(__ATOMIC_ACQUIRE, "agent");
            asm volatile("s_waitcnt vmcnt(0)" ::: "memory");
        }
    }
    __syncthreads();
}


namespace pg8 {
struct EpiProj {
    static constexpr bool PERM = true, AFTER_DRAIN = false;
    bf16_t* base0; const float* qg; const float* kg;
    __device__ __forceinline__ void operator()(const f32x4 (&acc)[2][2][4][2], const Unit& u, int wr, int wc, int fr, int fq) const {
        const int region = u.pn >> 2;
        bf16_t* O = base0 + (size_t)region * (16u << 20);
        const int row0 = u.pm * BM + wr * 64 + fr, col0 = (u.pn & 3) * 256 + wc * 64 + 8 * fq;
        if (region < 2) {
            const float* g = region == 0 ? qg : kg; const float sc = region == 0 ? 0.125f * 1.4426950408889634f : 1.0f;
            f32x4 gv[2][2];
#pragma unroll
            for (int bj = 0; bj < 2; ++bj)
#pragma unroll
                for (int n = 0; n < 2; ++n) gv[bj][n] = *(const f32x4*)(g + bj * 32 + 8 * fq + 4 * n) * sc;
#pragma unroll
            for (int ai = 0; ai < 2; ++ai)
#pragma unroll
                for (int m = 0; m < 4; ++m) {
                    float ss = 0.f;
#pragma unroll
                    for (int bj = 0; bj < 2; ++bj)
#pragma unroll
                        for (int n = 0; n < 2; ++n) { const f32x4 x = acc[ai][bj][m][n]; ss += (x[0] * x[0] + x[1] * x[1]) + (x[2] * x[2] + x[3] * x[3]); }
                    ss += __shfl_xor(ss, 16); ss += __shfl_xor(ss, 32);
                    const float rs = __builtin_amdgcn_rsqf(ss * (1.0f / 64.0f) + 1e-6f);
                    bf16_t* rowp = O + (size_t)(row0 + ai * HALF + m * 16) * 1024 + col0;
#pragma unroll
                    for (int bj = 0; bj < 2; ++bj) { const f32x4 v0 = acc[ai][bj][m][0] * rs * gv[bj][0], v1 = acc[ai][bj][m][1] * rs * gv[bj][1];
                        u32x4 w; w.x = cvt_pk_bf16(v0[0], v0[1]); w.y = cvt_pk_bf16(v0[2], v0[3]); w.z = cvt_pk_bf16(v1[0], v1[1]); w.w = cvt_pk_bf16(v1[2], v1[3]);
                        *(u32x4*)(rowp + bj * 32) = w; }
                }
        } else {
#pragma unroll
            for (int ai = 0; ai < 2; ++ai)
#pragma unroll
                for (int m = 0; m < 4; ++m) { bf16_t* rowp = O + (size_t)(row0 + ai * HALF + m * 16) * 1024 + col0;
#pragma unroll
                    for (int bj = 0; bj < 2; ++bj) { const f32x4 v0 = acc[ai][bj][m][0], v1 = acc[ai][bj][m][1];
                        u32x4 w; w.x = cvt_pk_bf16(v0[0], v0[1]); w.y = cvt_pk_bf16(v0[2], v0[3]); w.z = cvt_pk_bf16(v1[0], v1[1]); w.w = cvt_pk_bf16(v1[2], v1[3]);
                        *(u32x4*)(rowp + bj * 32) = w; } }
        }
    }
};
struct EpiX1 {
    static constexpr bool PERM = true, AFTER_DRAIN = false;
    const float* x; float* out; bf16_t* a2; const float* gf; float* ssq;
    __device__ __forceinline__ void operator()(const f32x4 (&acc)[2][2][4][2], const Unit& u, int wr, int wc, int fr, int fq) const {
        const int row0 = u.pm * BM + wr * 64 + fr, col0 = u.pn * BM + wc * 32 + 8 * fq;
        f32x4 gv[2][2];
#pragma unroll
        for (int bj = 0; bj < 2; ++bj)
#pragma unroll
            for (int n = 0; n < 2; ++n) gv[bj][n] = *(const f32x4*)(gf + col0 + bj * HALF + 4 * n);
#pragma unroll
        for (int ai = 0; ai < 2; ++ai)
#pragma unroll
            for (int m = 0; m < 4; ++m) { const int row = row0 + ai * HALF + m * 16; const size_t off = (size_t)row * 2048 + col0; float ss = 0.f;
#pragma unroll
                for (int bj = 0; bj < 2; ++bj) {
                    const f32x4 x0 = *(const f32x4*)(x + off + bj * HALF), x1 = *(const f32x4*)(x + off + bj * HALF + 4);
                    const f32x4 v0 = x0 + acc[ai][bj][m][0], v1 = x1 + acc[ai][bj][m][1];
                    *(f32x4*)(out + off + bj * HALF) = v0; *(f32x4*)(out + off + bj * HALF + 4) = v1;
                    ss += (v0[0] * v0[0] + v0[1] * v0[1]) + (v0[2] * v0[2] + v0[3] * v0[3]); ss += (v1[0] * v1[0] + v1[1] * v1[1]) + (v1[2] * v1[2] + v1[3] * v1[3]);
                    const f32x4 a0 = v0 * gv[bj][0], a1 = v1 * gv[bj][1];
                    u32x4 w; w.x = cvt_pk_bf16(a0[0], a0[1]); w.y = cvt_pk_bf16(a0[2], a0[3]); w.z = cvt_pk_bf16(a1[0], a1[1]); w.w = cvt_pk_bf16(a1[2], a1[3]);
                    *(u32x4*)(a2 + off + bj * HALF) = w; }
                ss += __shfl_xor(ss, 16); ss += __shfl_xor(ss, 32);
                if (fq == 0) ssq[(size_t)row * 32 + u.pn * 4 + wc] = ss; }
    }
};
}

__device__ __forceinline__ void p0_transpose_item(const float* W, int K, int N, bf16* WT, LAS float* scr, int item, int lane, bool permg) {
    const int nblk = N / 32, kb = item / nblk, nb = item % nblk, k0 = 64 * kb, n0 = 32 * nb;
#pragma unroll 8
    for (int i = 0; i < 32; ++i) { const int kk = 2 * i + (lane >> 5); scr[kk * 33 + (lane & 31)] = W[(size_t)(k0 + kk) * N + n0 + (lane & 31)]; }
    LDS_WAIT(); asm volatile("" ::: "memory");
    int nd = n0; if (permg) { const int gl = (n0 & 255) >> 5; nd = (n0 & ~255) + 32 * (4 * (gl & 1) + (gl >> 1)); }
    const int c = lane & 7;
#pragma unroll
    for (int j = 0; j < 4; ++j) { const int n = (lane >> 3) + 8 * j; const LAS float* s = scr + (8 * c) * 33 + n;
        v4u o; o.x = pk2(s[0 * 33], s[1 * 33]); o.y = pk2(s[2 * 33], s[3 * 33]); o.z = pk2(s[4 * 33], s[5 * 33]); o.w = pk2(s[6 * 33], s[7 * 33]);
        *(v4u*)(WT + (size_t)(nd + n) * K + k0 + 8 * c) = o; }
    LDS_WAIT(); asm volatile("" ::: "memory");
}
__device__ __forceinline__ void rms_row_to_bf16(const float* xrow, const float* g, bf16* orow, int lane) {
    const f32x4* xr = (const f32x4*)xrow + lane; const f32x4* gr = (const f32x4*)g + lane;
    f32x4 v[8]; float s = 0.f;
#pragma unroll
    for (int j = 0; j < 8; ++j) { v[j] = xr[64 * j]; s += (v[j].x * v[j].x + v[j].y * v[j].y) + (v[j].z * v[j].z + v[j].w * v[j].w); }
    const float rstd = 1.0f / sqrtf(wave_sum(s) * (1.f / DM) + EPS);
    v2u* o8 = (v2u*)orow + lane;
#pragma unroll
    for (int j = 0; j < 8; ++j) { const f32x4 gg = gr[64 * j]; v2u w; w.x = pk2(v[j].x * rstd * gg.x, v[j].y * rstd * gg.y); w.y = pk2(v[j].z * rstd * gg.z, v[j].w * rstd * gg.w); o8[64 * j] = w; }
}
__device__ __forceinline__ void cvt_bf16_stream(const float* src, bf16* dst, size_t n8, size_t gtid, size_t nthr) {
    for (size_t i = gtid; i < n8; i += nthr) { const f32x4 a = *(const f32x4*)(src + i * 8), b = *(const f32x4*)(src + i * 8 + 4);
        v4u o; o.x = pk2(a.x, a.y); o.y = pk2(a.z, a.w); o.z = pk2(b.x, b.y); o.w = pk2(b.z, b.w); *(v4u*)(dst + i * 8) = o; }
}

__device__ __forceinline__ void cvt_fp8_slices(const float* src, unsigned char* dst, float scale, size_t gtid, size_t nthr) {
    for (size_t i = gtid; i < (size_t)16384 * 128; i += nthr) { v4u o; const size_t e = i >> 7; const int c16 = (int)(i & 127), s = c16 >> 3, sub = c16 & 7;
#pragma unroll
        for (int q = 0; q < 4; ++q) { const f32x4 a = *(const f32x4*)(src + i * 16 + 4 * q) * scale; int w = __builtin_amdgcn_cvt_pk_fp8_f32(a.x, a.y, 0, false); w = __builtin_amdgcn_cvt_pk_fp8_f32(a.z, a.w, w, true);
            if (q == 0) o.x = (unsigned)w; else if (q == 1) o.y = (unsigned)w; else if (q == 2) o.z = (unsigned)w; else o.w = (unsigned)w; }
        *(v4u*)(dst + ((size_t)s * 16384 + e) * 128 + 16 * sub) = o; }
}

namespace att {
constexpr int SLOTB = 32768;
constexpr int NSLOT = 3, LW_OFF = NSLOT * SLOTB;
constexpr int XSTR = 132;
__device__ __forceinline__ void glds16(const void* gsrc, unsigned lds_dst) { unsigned keep;
    asm volatile("s_mov_b32 %0, m0\n\ts_mov_b32 m0, %2\n\ts_nop 0\n\tglobal_load_lds_dwordx4 %1, off\n\ts_mov_b32 m0, %0" : "=&s"(keep) : "v"(gsrc), "s"(lds_dst) : "memory"); }
__device__ __forceinline__ int crow(int r, int hi) { return (r & 3) + 8 * (r >> 2) + 4 * hi; }
typedef short v4i16_t __attribute__((ext_vector_type(4)));
__device__ __forceinline__ s16x4 vtr(const LAS char* p) { return __builtin_bit_cast(s16x4, __builtin_amdgcn_ds_read_tr16_b64_v4i16((LAS v4i16_t*)p)); }
#define ATT_WAIT_BAR(N) asm volatile("s_waitcnt vmcnt(" #N ") lgkmcnt(0)\n\ts_barrier" ::: "memory")

__device__ __forceinline__ void attn_unit(int b, int h, int qblk, const bf16* Q, const bf16* K, const bf16* V, bf16* MIX, const float* subg, float lam, float M2, LAS char* lds) {
    const int tid = threadIdx.x, lane = tid & 63, r32 = lane & 31, hi = lane >> 5, wid = __builtin_amdgcn_readfirstlane(tid >> 6), c = wid >> 2, qs = wid & 3;
    const size_t rowbase = (size_t)b * SEQ; const int q0 = qblk * 128, NT = 2 * (qblk + 1);
    const unsigned lds0 = (unsigned)(uintptr_t)lds;
    const bf16* ksrc[2]; const bf16* vsrc[2]; unsigned kdst[2], vdst[2];
#pragma unroll
    for (int i = 0; i < 2; ++i) { const int pk = 2 * wid + i, pc = pk >> 3, ch = pk & 7, d0 = pk >> 2, rg = pk & 3;
        ksrc[i] = K + (rowbase + lane) * 1024 + h * 128 + pc * 64 + ch * 8; kdst[i] = lds0 + pk * 1024;
        vsrc[i] = V + (rowbase + 16 * rg + (lane >> 2)) * 1024 + h * 128 + d0 * 32 + (lane & 3) * 8; vdst[i] = lds0 + 16384 + pk * 1024; }
#define ATT_DMA(t, slot) do { _Pragma("unroll") for (int i_ = 0; i_ < 2; ++i_) { glds16(ksrc[i_] + (size_t)(t) * 64 * 1024, (unsigned)__builtin_amdgcn_readfirstlane(kdst[i_] + (slot) * SLOTB)); \
        glds16(vsrc[i_] + (size_t)(t) * 64 * 1024, (unsigned)__builtin_amdgcn_readfirstlane(vdst[i_] + (slot) * SLOTB)); } } while (0)
    ATT_DMA(0, 0); ATT_DMA(1, 1);
    const int qrow = q0 + 32 * qs + r32;
    bf16x8 qr[4];
#pragma unroll
    for (int d0 = 0; d0 < 4; ++d0) qr[d0] = *(const bf16x8*)(Q + (rowbase + qrow) * 1024 + h * 128 + c * 64 + d0 * 16 + hi * 8);
    const float slope2 = exp2f(-(float)(h + 1)) * 1.4426950408889634f;
    float base = -slope2 * (float)(qrow - 4 * hi) - M2;
    const float s32 = 32.f * slope2, s64 = 64.f * slope2;
    f32x16 o[4]; o[0] = f32x16{}; o[1] = f32x16{}; o[2] = f32x16{}; o[3] = f32x16{};
    float lsum = 0.f;
    const LAS char* kp0 = (const LAS char*)lds + c * 8192 + hi * 1024 + r32 * 16;
    const LAS char* vp0 = (const LAS char*)lds + 16384 + ((lane >> 4) & 1) * 32 + (lane & 3) * 8 + (4 * hi + ((lane & 15) >> 2)) * 64;
    const int qw0 = q0 + 32 * qs;
    int slot = 0;
    for (int t = 0; t < NT; ++t) {
        if (t == 0) { ATT_WAIT_BAR(0); } else if (t + 1 < NT) { ATT_WAIT_BAR(4); } else { ATT_WAIT_BAR(0); }
        if (t + 2 < NT) { const int s2_ = (slot == 0) ? 2 : slot - 1; ATT_DMA(t + 2, s2_); }
        const int k0 = 64 * t;
        if (k0 <= qw0 + 31) {
            const LAS char* kp = kp0 + slot * SLOTB; const LAS char* vp = vp0 + slot * SLOTB;
            f32x16 p0, p1;
#pragma unroll
            for (int r = 0; r < 16; ++r) { p0[r] = __builtin_fmaf(slope2, (float)((r & 3) + 8 * (r >> 2)), base); p1[r] = p0[r] + s32; }
#pragma unroll
            for (int d0 = 0; d0 < 4; ++d0) {
                const bf16x8 ka = *(const LAS bf16x8*)(kp + d0 * 2048), kb = *(const LAS bf16x8*)(kp + d0 * 2048 + 512);
                p0 = __builtin_amdgcn_mfma_f32_32x32x16_bf16(ka, qr[d0], p0, 0, 0, 0);
                p1 = __builtin_amdgcn_mfma_f32_32x32x16_bf16(kb, qr[d0], p1, 0, 0, 0); }
#pragma unroll
            for (int r = 0; r < 16; ++r) { p0[r] = __builtin_amdgcn_exp2f(p0[r]); p1[r] = __builtin_amdgcn_exp2f(p1[r]); }
            if (k0 + 63 > qw0) {
                const int dq = qrow - k0;
#pragma unroll
                for (int r = 0; r < 16; ++r) { const int kk = crow(r, hi); if (kk > dq) p0[r] = 0.f; if (kk + 32 > dq) p1[r] = 0.f; }
            }
            float sacc = 0.f;
#pragma unroll
            for (int r = 0; r < 16; ++r) sacc += p0[r] + p1[r];
            lsum += sacc;
            bf16x8 pw[4];
#pragma unroll
            for (int ks = 0; ks < 4; ++ks) { v4u w;
                if (ks < 2) { w.x = pk2(p0[8 * ks + 0], p0[8 * ks + 1]); w.y = pk2(p0[8 * ks + 2], p0[8 * ks + 3]); w.z = pk2(p0[8 * ks + 4], p0[8 * ks + 5]); w.w = pk2(p0[8 * ks + 6], p0[8 * ks + 7]); }
                else { const int k2 = ks - 2; w.x = pk2(p1[8 * k2 + 0], p1[8 * k2 + 1]); w.y = pk2(p1[8 * k2 + 2], p1[8 * k2 + 3]); w.z = pk2(p1[8 * k2 + 4], p1[8 * k2 + 5]); w.w = pk2(p1[8 * k2 + 6], p1[8 * k2 + 7]); }
                pw[ks] = __builtin_bit_cast(bf16x8, w); }
#pragma unroll
            for (int d0 = 0; d0 < 4; ++d0)
#pragma unroll
                for (int ks = 0; ks < 4; ++ks) { const s16x4 lo = vtr(vp + d0 * 4096 + ks * 1024), hv = vtr(vp + d0 * 4096 + ks * 1024 + 512);
                    const bf16x8 vf = (bf16x8){lo[0], lo[1], lo[2], lo[3], hv[0], hv[1], hv[2], hv[3]};
                    o[d0] = __builtin_amdgcn_mfma_f32_32x32x16_bf16(pw[ks], vf, o[d0], 0, 0, 0); }
        }
        base += s64;
        slot = (slot == NSLOT - 1) ? 0 : slot + 1;
    }
    ATT_WAIT_BAR(0);
    LAS float* lw = (LAS float*)(lds + LW_OFF) + wid * 32;
    { auto rr = __builtin_amdgcn_permlane32_swap(__float_as_uint(lsum), __float_as_uint(lsum), false, false); lsum = __uint_as_float(rr[0]) + __uint_as_float(rr[1]); }
    if (hi == 0) lw[r32] = lsum;
    LDS_WAIT();
    LAS float* X = (LAS float*)lds + qs * 32 * XSTR;
#pragma unroll
    for (int r = 0; r < 16; ++r) { const float rl = 1.0f / lw[crow(r, hi)];
#pragma unroll
        for (int d0 = 0; d0 < 4; ++d0) o[d0][r] *= rl; }
    if (c == 1) {
#pragma unroll
        for (int r = 0; r < 16; ++r)
#pragma unroll
            for (int d0 = 0; d0 < 4; ++d0) X[crow(r, hi) * XSTR + d0 * 32 + r32] = o[d0][r];
    }
    ATT_WAIT_BAR(0);
    if (c == 0) {
#pragma unroll
        for (int r = 0; r < 16; ++r)
#pragma unroll
            for (int d0 = 0; d0 < 4; ++d0) { LAS float* px = X + crow(r, hi) * XSTR + d0 * 32 + r32; const float a = o[d0][r] - lam * (*px); *px = a; }
        LDS_WAIT(); asm volatile("" ::: "memory");
        const LAS f32x4* rp = (const LAS f32x4*)(X + r32 * XSTR + hi * 64);
        f32x4 av[16]; float ss = 0.f;
#pragma unroll
        for (int j = 0; j < 16; ++j) { av[j] = rp[j]; ss += (av[j].x * av[j].x + av[j].y * av[j].y) + (av[j].z * av[j].z + av[j].w * av[j].w); }
        { auto rr = __builtin_amdgcn_permlane32_swap(__float_as_uint(ss), __float_as_uint(ss), false, false); ss = __uint_as_float(rr[0]) + __uint_as_float(rr[1]); }
        const float rs = 0.8f / sqrtf(ss * (1.0f / 128.0f) + EPS);
        bf16* op = MIX + (rowbase + qrow) * 2048 + h * 128 + hi * 64;
#pragma unroll
        for (int j = 0; j < 8; ++j) { const f32x4 g0 = *(const f32x4*)(subg + hi * 64 + 8 * j), g1 = *(const f32x4*)(subg + hi * 64 + 8 * j + 4); const f32x4 a0 = av[2 * j] * rs * g0, a1 = av[2 * j + 1] * rs * g1;
            v4u w; w.x = pk2(a0.x, a0.y); w.y = pk2(a0.z, a0.w); w.z = pk2(a1.x, a1.y); w.w = pk2(a1.z, a1.w); *(v4u*)(op + 8 * j) = w; }
    }
    ATT_WAIT_BAR(0);
#undef ATT_DMA
}
}


#ifndef DBG_NAIVE_ATTN
#define DBG_NAIVE_ATTN 0
#endif
#if DBG_NAIVE_ATTN
__device__ __forceinline__ void naive_attn_row(int b, int h, int q, const bf16* Q, const bf16* K, const bf16* V, bf16* MIX, const float* subg, float lam, LAS float* S, int lane) {
    const size_t rowbase = (size_t)b * SEQ; const float slope2 = exp2f(-(float)(h + 1)) * 1.4426950408889634f;
    for (int c = 0; c < 2; ++c) {
        float qv[64];
        const bf16* qp = Q + (rowbase + q) * 1024 + h * 128 + c * 64;
#pragma unroll
        for (int d = 0; d < 64; d += 2) { const unsigned u = *(const unsigned*)(qp + d); qv[d] = bflo(u); qv[d + 1] = bfhi(u); }
        for (int key = lane; key <= q; key += 64) { const bf16* kp = K + (rowbase + key) * 1024 + h * 128 + c * 64; float s = 0.f;
#pragma unroll
            for (int d = 0; d < 64; d += 2) { const unsigned u = *(const unsigned*)(kp + d); s += qv[d] * bflo(u) + qv[d + 1] * bfhi(u); }
            S[c * 2048 + key] = s - slope2 * (float)(q - key); }
    }
    LDS_WAIT();
    float linv[2];
    for (int c = 0; c < 2; ++c) { float m = -1e30f; for (int key = lane; key <= q; key += 64) m = fmaxf(m, S[c * 2048 + key]); m = wave_max(m);
        float l = 0.f; for (int key = lane; key <= q; key += 64) { const float p = exp2f(S[c * 2048 + key] - m); S[c * 2048 + key] = p; l += p; } linv[c] = 1.0f / wave_sum(l); }
    for (int key = lane; key <= q; key += 64) S[key] = S[key] * linv[0] - lam * S[2048 + key] * linv[1];
    LDS_WAIT();
    float o0 = 0.f, o1 = 0.f; const bf16* vp = V + rowbase * 1024 + h * 128 + lane;
    for (int key = 0; key <= q; ++key) { const float a = S[key]; o0 += a * __uint_as_float((unsigned)vp[(size_t)key * 1024] << 16); o1 += a * __uint_as_float((unsigned)vp[(size_t)key * 1024 + 64] << 16); }
    const float ss = wave_sum(o0 * o0 + o1 * o1); const float rs = 0.8f / sqrtf(ss * (1.0f / 128.0f) + EPS);
    bf16* op = MIX + (rowbase + q) * 2048 + h * 128 + lane;
    op[0] = (bf16)(pk2(o0 * rs * subg[lane], 0.f) & 0xffffu); op[64] = (bf16)(pk2(o1 * rs * subg[lane + 64], 0.f) & 0xffffu);
    LDS_WAIT();
}
#endif

__device__ __forceinline__ unsigned ord_key(float f) { const unsigned u = __float_as_uint(f); return (u & 0x80000000u) ? ~u : (u | 0x80000000u); }
__device__ __forceinline__ float ord_val(unsigned k) { return __uint_as_float((k & 0x80000000u) ? (k ^ 0x80000000u) : ~k); }
#define TOPK_INS(tt, x_) do { unsigned x__ = (x_); _Pragma("unroll") for (int j_ = 0; j_ < 16; ++j_) { const unsigned hi__ = max(tt[j_], x__); x__ = min(tt[j_], x__); tt[j_] = hi__; } } while (0)

__device__ __forceinline__ void peer_topk_item(int tile, int h, const bf16* QP, const bf16* SK, const float* SSQ, int* EIDX, float* EGATE, float* RSTD, LAS char* lds) {
    const int tid = threadIdx.x, lane = tid & 63, r32 = lane & 31, hi = lane >> 5, wid = __builtin_amdgcn_readfirstlane(tid >> 6), c = wid >> 2, tb = wid & 3;
    constexpr int SSTR = 132;
    LAS float* SC = (LAS float*)lds;
    const int tok0 = tile * 128;
    {
        bf16x8 qf[8];
        const bf16* qp = QP + (size_t)(tok0 + tb * 32 + r32) * 2048 + h * 256 + c * 128 + hi * 8;
#pragma unroll
        for (int s = 0; s < 8; ++s) qf[s] = *(const bf16x8*)(qp + 16 * s);
        const bf16* sp = SK + (size_t)((h * 2 + c) * 128 + r32) * 128 + hi * 8;
#pragma unroll
        for (int kb = 0; kb < 4; ++kb) { f32x16 acc = f32x16{};
#pragma unroll
            for (int s = 0; s < 8; ++s) { const bf16x8 sf = *(const bf16x8*)(sp + (size_t)kb * 32 * 128 + 16 * s); acc = __builtin_amdgcn_mfma_f32_32x32x16_bf16(qf[s], sf, acc, 0, 0, 0); }
#pragma unroll
            for (int r = 0; r < 16; ++r) SC[(c * 128 + tb * 32 + att::crow(r, hi)) * SSTR + kb * 32 + r32] = acc[r]; }
    }
    __syncthreads();
    if (tid < 256) {
        LAS float* row = SC + tid * SSTR; unsigned tt[16];
#pragma unroll
        for (int j = 0; j < 16; ++j) tt[j] = 0u;
#pragma unroll 2
        for (int i = 0; i < 32; ++i) { const f32x4 v = *(const LAS f32x4*)(row + 4 * i);
            TOPK_INS(tt, (ord_key(v.x) & ~0x7Fu) | (unsigned)(4 * i)); TOPK_INS(tt, (ord_key(v.y) & ~0x7Fu) | (unsigned)(4 * i + 1));
            TOPK_INS(tt, (ord_key(v.z) & ~0x7Fu) | (unsigned)(4 * i + 2)); TOPK_INS(tt, (ord_key(v.w) & ~0x7Fu) | (unsigned)(4 * i + 3)); }
        LAS unsigned* lrow = (LAS unsigned*)row;
#pragma unroll
        for (int j = 0; j < 16; ++j) lrow[j] = tt[j];
    }
    __syncthreads();
    if (tid < 128) {
        const LAS unsigned* l1 = (const LAS unsigned*)(SC + tid * SSTR); const LAS unsigned* l2 = (const LAS unsigned*)(SC + (128 + tid) * SSTR);
        float v1[16], v2[16];
#pragma unroll
        for (int j = 0; j < 16; ++j) { v1[j] = ord_val(l1[j] & ~0x7Fu); v2[j] = ord_val(l2[j] & ~0x7Fu); }
        unsigned tt[16];
#pragma unroll
        for (int j = 0; j < 16; ++j) tt[j] = 0u;
#pragma unroll
        for (int i = 0; i < 16; ++i)
#pragma unroll
            for (int j = 0; j < 16; ++j) if ((i + 1) * (j + 1) <= 16) { TOPK_INS(tt, (ord_key(v1[i] + v2[j]) & ~0xFFu) | (unsigned)(i * 16 + j)); }
        const int t = tok0 + tid;
        float ssq = 0.f;
#pragma unroll
        for (int j = 0; j < 8; ++j) { const f32x4 p = *(const f32x4*)(SSQ + (size_t)t * 32 + 4 * j); ssq += (p.x + p.y) + (p.z + p.w); }
        const float rstd = 1.0f / sqrtf(ssq * (1.0f / DM) + EPS);
        if (h == 0) RSTD[t] = rstd;
        float ev[16]; int ex[16]; float es = 0.f, vmax = 0.f;
#pragma unroll
        for (int k = 0; k < 16; ++k) { const unsigned pid = tt[k] & 0xFFu; const unsigned a = l1[pid >> 4], b2 = l2[pid & 15u];
            const float sv = (ord_val(a & ~0x7Fu) + ord_val(b2 & ~0x7Fu)) * rstd; if (k == 0) vmax = sv;
            ev[k] = __expf(sv - vmax); es += ev[k]; ex[k] = (int)((a & 0x7Fu) * 128u + (b2 & 0x7Fu)); }
        const float inv = 1.0f / es;
        int* ei = EIDX + (size_t)t * 128 + h * 16; float* eg = EGATE + (size_t)t * 128 + h * 16;
#pragma unroll
        for (int k = 0; k < 16; k += 4) { *(int4*)(ei + k) = make_int4(ex[k], ex[k + 1], ex[k + 2], ex[k + 3]); *(f32x4*)(eg + k) = (f32x4){ev[k] * inv, ev[k + 1] * inv, ev[k + 2] * inv, ev[k + 3] * inv}; }
    }
    __syncthreads();
}

__device__ __forceinline__ f32x2 dot16_fp8(const v4u u, const f32x2* h, f32x2 acc) {
#pragma unroll
    for (int w = 0; w < 4; ++w) { const unsigned d = w == 0 ? u.x : w == 1 ? u.y : w == 2 ? u.z : u.w;
        const f32x2 f0 = __builtin_amdgcn_cvt_pk_f32_fp8((int)d, false), f1 = __builtin_amdgcn_cvt_pk_f32_fp8((int)d, true);
        acc = __builtin_elementwise_fma(h[2 * w], f0, acc); acc = __builtin_elementwise_fma(h[2 * w + 1], f1, acc); }
    return acc;
}
__device__ __forceinline__ void axpy16_fp8(const v4u v, f32x2 a2, f32x2* o) {
#pragma unroll
    for (int w = 0; w < 4; ++w) { const unsigned d = w == 0 ? v.x : w == 1 ? v.y : w == 2 ? v.z : v.w;
        const f32x2 f0 = __builtin_amdgcn_cvt_pk_f32_fp8((int)d, false), f1 = __builtin_amdgcn_cvt_pk_f32_fp8((int)d, true);
        o[2 * w] = __builtin_elementwise_fma(a2, f0, o[2 * w]); o[2 * w + 1] = __builtin_elementwise_fma(a2, f1, o[2 * w + 1]); }
}
struct PItem { int t, s; };
__device__ __forceinline__ PItem peer_item(int j, int nper, int tb, int tstride, int xl) { PItem it; const int r = j >= nper ? 1 : 0; it.s = 8 * r + xl; const int t = tb + (j - r * nper) * tstride; it.t = t < T ? t : T - 1; return it; }
__device__ __forceinline__ void pu_idx(const PItem it, const int* EIDX, int g, int (&ex)[16]) {
#pragma unroll
    for (int i = 0; i < 16; ++i) ex[i] = EIDX[(size_t)it.t * 128 + 8 * i + g];
}
__device__ __forceinline__ void pu_issue(const PItem it, const bf16* A2, const unsigned char* U8, int sub, const int (&ex)[16], v4u (&uv)[16], v4u (&hr)[2]) {
    const unsigned char* ub = U8 + (size_t)it.s * 16384 * 128 + 16 * sub;
#pragma unroll
    for (int i = 0; i < 16; ++i) uv[i] = *(const v4u*)(ub + (size_t)ex[i] * 128);
#pragma unroll
    for (int q = 0; q < 2; ++q) hr[q] = *(const v4u*)(A2 + (size_t)it.t * 2048 + 128 * it.s + 16 * sub + 8 * q);
}
__device__ __forceinline__ void pu_finish(const PItem it, bool valid, float* PART, int lane, const v4u (&uv)[16], const v4u (&hr)[2]) {
    const int g = lane >> 3, sub = lane & 7;
    f32x2 hf[8];
#pragma unroll
    for (int q = 0; q < 2; ++q) { const v4u r = hr[q];
        hf[4 * q + 0] = (f32x2){bflo(r.x), bfhi(r.x)}; hf[4 * q + 1] = (f32x2){bflo(r.y), bfhi(r.y)}; hf[4 * q + 2] = (f32x2){bflo(r.z), bfhi(r.z)}; hf[4 * q + 3] = (f32x2){bflo(r.w), bfhi(r.w)}; }
    float r[16];
#pragma unroll
    for (int i = 0; i < 16; ++i) { const f32x2 a = dot16_fp8(uv[i], hf, (f32x2){0.f, 0.f}); r[i] = a.x + a.y; }
#pragma unroll
    for (int w = 4, n = 8; w >= 1; w >>= 1, n >>= 1) { const bool up = (lane & w) != 0;
#pragma unroll
        for (int j = 0; j < n; ++j) { const float a = r[j], b2 = r[j + n]; const float keep = up ? b2 : a, send = up ? a : b2; r[j] = keep + __shfl_xor(send, w); } }
    const int i0 = 8 * ((sub >> 2) & 1) + 4 * ((sub >> 1) & 1) + 2 * (sub & 1);
    float* pp = PART + ((size_t)it.s * T + it.t) * 128 + g;
    if (valid) { pp[8 * i0] = r[0]; pp[8 * (i0 + 1)] = r[1]; }
}
__device__ __forceinline__ void peer_u_stage(int nper, int tb, int tstride, int xl, const bf16* A2, const unsigned char* U8, const int* EIDX, float* PART, int lane) {
    const int g = lane >> 3, sub = lane & 7, NI = 2 * nper;
    int exA[16], exB[16]; v4u uvA[16], uvB[16], hA[2], hB[2];
    PItem a = peer_item(0, nper, tb, tstride, xl), b = peer_item(1, nper, tb, tstride, xl);
    pu_idx(a, EIDX, g, exA); pu_issue(a, A2, U8, sub, exA, uvA, hA); pu_idx(b, EIDX, g, exB);
#pragma unroll 1
    for (int j = 0; j < NI; j += 2) {
        pu_issue(b, A2, U8, sub, exB, uvB, hB);
        const PItem a2 = peer_item(j + 2 < NI ? j + 2 : j, nper, tb, tstride, xl); pu_idx(a2, EIDX, g, exA);
        pu_finish(a, (tb + (j % nper) * tstride) < T, PART, lane, uvA, hA);
        pu_issue(a2, A2, U8, sub, exA, uvA, hA);
        const PItem b2 = peer_item(j + 3 < NI ? j + 3 : j + 1, nper, tb, tstride, xl); pu_idx(b2, EIDX, g, exB);
        pu_finish(b, (tb + ((j + 1) % nper) * tstride) < T, PART, lane, uvB, hB);
        a = a2; b = b2;
    }
}
__device__ __forceinline__ void pv_idx(const PItem it, const int* EIDX, int g, int (&ex)[16]) {
#pragma unroll
    for (int i = 0; i < 16; ++i) ex[i] = EIDX[(size_t)it.t * 128 + 8 * i + g];
}
__device__ __forceinline__ void pv_issue(const PItem it, const unsigned char* V8, const float* ACT, const float* out, int lane, const int (&ex)[16], v4u (&vv)[16], float (&av)[16], f32x2& x1) {
    const int g = lane >> 3, sub = lane & 7;
#pragma unroll
    for (int i = 0; i < 16; ++i) av[i] = ACT[(size_t)it.t * 128 + 8 * i + g];
    const unsigned char* vb = V8 + (size_t)it.s * 16384 * 128 + 16 * sub;
#pragma unroll
    for (int i = 0; i < 16; ++i) vv[i] = *(const v4u*)(vb + (size_t)ex[i] * 128);
    const int c0 = 8 * ((g >> 2) & 1) + 4 * ((g >> 1) & 1) + 2 * (g & 1);
    x1 = *(const f32x2*)(out + (size_t)it.t * 2048 + 128 * it.s + 16 * sub + c0);
}
__device__ __forceinline__ void pv_finish(const PItem it, bool valid, float* out, int lane, const v4u (&vv)[16], const float (&av)[16], const f32x2 x1) {
    const int g = lane >> 3, sub = lane & 7;
    f32x2 o[8];
#pragma unroll
    for (int m = 0; m < 8; ++m) o[m] = (f32x2){0.f, 0.f};
#pragma unroll
    for (int i = 0; i < 16; ++i) axpy16_fp8(vv[i], (f32x2){av[i], av[i]}, o);
#pragma unroll
    for (int w = 32, n = 4; w >= 8; w >>= 1, n >>= 1) { const bool up = (lane & w) != 0;
#pragma unroll
        for (int j = 0; j < n; ++j) { const f32x2 a = o[j], b2 = o[j + n]; const f32x2 keep = up ? b2 : a, send = up ? a : b2; o[j] = (f32x2){keep.x + __shfl_xor(send.x, w), keep.y + __shfl_xor(send.y, w)}; } }
    const int c0 = 8 * ((g >> 2) & 1) + 4 * ((g >> 1) & 1) + 2 * (g & 1);
    if (valid) *(f32x2*)(out + (size_t)it.t * 2048 + 128 * it.s + 16 * sub + c0) = (f32x2){x1.x + o[0].x, x1.y + o[0].y};
}
__device__ __forceinline__ void peer_v_stage(int nper, int tb, int tstride, int xl, const unsigned char* V8, const int* EIDX, const float* ACT, float* out, int lane) {
    const int g = lane >> 3, NI = 2 * nper;
    int exA[16], exB[16]; float avA[16], avB[16]; v4u vvA[16], vvB[16]; f32x2 xA, xB;
    PItem a = peer_item(0, nper, tb, tstride, xl), b = peer_item(1, nper, tb, tstride, xl);
    pv_idx(a, EIDX, g, exA); pv_issue(a, V8, ACT, out, lane, exA, vvA, avA, xA); pv_idx(b, EIDX, g, exB);
#pragma unroll 1
    for (int j = 0; j < NI; j += 2) {
        pv_issue(b, V8, ACT, out, lane, exB, vvB, avB, xB);
        const PItem a2 = peer_item(j + 2 < NI ? j + 2 : j, nper, tb, tstride, xl); pv_idx(a2, EIDX, g, exA);
        pv_finish(a, (tb + (j % nper) * tstride) < T, out, lane, vvA, avA, xA);
        pv_issue(a2, V8, ACT, out, lane, exA, vvA, avA, xA);
        const PItem b2 = peer_item(j + 3 < NI ? j + 3 : j + 1, nper, tb, tstride, xl); pv_idx(b2, EIDX, g, exB);
        pv_finish(b, (tb + ((j + 1) % nper) * tstride) < T, out, lane, vvB, avB, xB);
        a = a2; b = b2;
    }
}

struct Args { const float* in[17]; float* out; unsigned char* ws; int ph_lo, ph_hi; };
__global__ void __launch_bounds__(NTHREADS, 2) mk_fwd(Args args) {
    extern __shared__ __attribute__((aligned(16))) unsigned char lds_raw[];
    LAS unsigned char* lds = (LAS unsigned char*)lds_raw;
    const int tid = threadIdx.x, lane = tid & 63, wave = __builtin_amdgcn_readfirstlane(tid >> 6);
    const int G = gridDim.x, bx = blockIdx.x;
    const int vcu = (G % 8 == 0) ? (bx % 8) * (G / 8) + bx / 8 : bx;
    unsigned char* ws = args.ws;
    const float* x = args.in[0]; const float* attn_g = args.in[1]; const float* w_in = args.in[2]; const float* qg = args.in[3]; const float* kg = args.in[4];
    const float* lq1 = args.in[5]; const float* lk1 = args.in[6]; const float* lq2 = args.in[7]; const float* lk2 = args.in[8]; const float* subg = args.in[9];
    const float* conv_w = args.in[10]; const float* w_out = args.in[11]; const float* ffn_g = args.in[12]; const float* w_q = args.in[13]; const float* subkeys = args.in[14];
    const float* peer_u = args.in[15]; const float* peer_v = args.in[16];
    float* out = args.out;
    bf16* WtIn = (bf16*)(ws + WS_WIN); bf16* WtOut = (bf16*)(ws + WS_WOUT); bf16* WtQ = (bf16*)(ws + WS_WQ); bf16* SK = (bf16*)(ws + WS_SK);
    float* SSQ = (float*)(ws + WS_SSQ); int* EIDX = (int*)(ws + WS_EIDX); float* EGATE = (float*)(ws + WS_EGATE); float* RSTD = (float*)(ws + WS_RSTD);
    bf16* XN = (bf16*)(ws + WS_XN); bf16* MIX = XN;
    bf16* Qb = (bf16*)(ws + WS_Q); bf16* Kb = (bf16*)(ws + WS_K); bf16* Vb = (bf16*)(ws + WS_V); bf16* QP = Qb;
    bf16* CB = (bf16*)(ws + WS_CB); bf16* CC = (bf16*)(ws + WS_CC); bf16* CX = (bf16*)(ws + WS_CX); bf16* A2 = CB;
    unsigned char* U8 = ws + WS_UT; unsigned char* V8 = ws + WS_VT;
    volatile LAS unsigned* MISC = (volatile LAS unsigned*)(lds + MISC_OFF);
    if (tid < 16) MISC[tid] = 0u;
    __syncthreads();
    XcdBarrier bar = xcd_barrier_post((unsigned*)(ws + WS_CTL) + CW_BAR, MISC + 8);
    const int lo = args.ph_lo, hi_ph = args.ph_hi;
#ifndef DBG_DUP
#define DBG_DUP -1
#endif
#ifndef DBG_MASK
#define DBG_MASK 0xfff
#endif
#define IN(k) (((DBG_MASK >> (k)) & 1) && lo <= (k) && (k) < hi_ph)
#define REPS(k) for (int rep_ = 0; rep_ < ((DBG_DUP == (k)) ? 2 : 1); ++rep_)
#define SEAM(k) do { if (IN(k) && IN((k) + 1)) xcd_barrier(bar); } while (0)
    const int gw = vcu * NWAVES + wave, NGW = G * NWAVES;
    const size_t gtid = (size_t)bx * NTHREADS + tid, nthr = (size_t)G * NTHREADS;

    if (IN(0)) REPS(0) {
        LAS float* scr = (LAS float*)(lds + wave * 16384);
        constexpr int I_IN = (DM / 64) * (INC / 32), I_SQ = (DM / 64) * (DM / 32);
        for (int it = gw; it < I_IN + 2 * I_SQ; it += NGW) {
            if (it < I_IN) p0_transpose_item(w_in, DM, INC, WtIn, scr, it, lane, true);
            else if (it < I_IN + I_SQ) p0_transpose_item(w_out, DM, DM, WtOut, scr, it - I_IN, lane, false);
            else p0_transpose_item(w_q, DM, DM, WtQ, scr, it - I_IN - I_SQ, lane, false);
        }
        for (int m = gw; m < T; m += NGW) rms_row_to_bf16(x + (size_t)m * DM, attn_g, XN + (size_t)m * DM, lane);
        cvt_bf16_stream(subkeys, SK, (size_t)PEH * 2 * PNK * 128 / 8, gtid, nthr);
        cvt_fp8_slices(peer_u, U8, U8_SCALE, gtid, nthr);
        cvt_fp8_slices(peer_v, V8, V8_SCALE, gtid, nthr);
    }
    SEAM(0);
    if (IN(1)) REPS(1) {
        pg8::Gemm g{XN, WtIn, T, INC, DM}; pg8::StaticOrder S; S.init(T, INC, G, bx);
        pg8::EpiProj E{Qb, qg, kg};
        pg8::gemm_phase<pg8::EpiProj, pg8::StaticOrder, true, true>(lds, g, S, E);
    }
    SEAM(1);
    if (IN(2)) REPS(2) {
        float a = lq1[lane] * lk1[lane], b2 = lq2[lane] * lk2[lane];
        a = wave_sum(a); b2 = wave_sum(b2);
        const float lam = expf(a) - expf(b2) + 0.2f;
        const float mq = wave_max(fabsf(qg[lane])), mk = wave_max(fabsf(kg[lane]));
        const float M2 = 64.f * C2 * mq * mk;
#if DBG_NAIVE_ATTN
        for (int r = gw; r < NB * NH * SEQ; r += NGW) naive_attn_row(r >> 14, (r >> 11) & 7, r & 2047, Qb, Kb, Vb, MIX, subg, lam, (LAS float*)(lds + wave * 16384), lane);
        if (0)
#endif
        for (int v = vcu; v < NB * NH * 4; v += G) {
            const int bh = v >> 2, s = v & 3, b = bh >> 3, h = bh & 7;
#pragma unroll 1
            for (int i = 0; i < 4; ++i) { const int qblk = (i == 0) ? s : (i == 1) ? 7 - s : (i == 2) ? 8 + s : 15 - s;
                att::attn_unit(b, h, qblk, Qb, Kb, Vb, MIX, subg, lam, M2, (LAS char*)lds); }
        }
        for (size_t it = gtid; it < (size_t)(T / 16) * 128; it += nthr) {
            const int cg8 = (int)(it & 127), chunk = (int)(it >> 7), t0 = chunk * 16, col = cg8 * 8;
            f32x4 w0a = *(const f32x4*)(conv_w + col), w0b = *(const f32x4*)(conv_w + col + 4), w1a = *(const f32x4*)(conv_w + 1024 + col), w1b = *(const f32x4*)(conv_w + 1024 + col + 4),
                  w2a = *(const f32x4*)(conv_w + 2048 + col), w2b = *(const f32x4*)(conv_w + 2048 + col + 4);
            float u1[8], u2[8];
#pragma unroll
            for (int i = 0; i < 8; ++i) { u1[i] = 0.f; u2[i] = 0.f; }
            if ((t0 % SEQ) != 0) {
                const v4u c1 = *(const v4u*)(CC + (size_t)(t0 - 1) * 1024 + col), x1v = *(const v4u*)(CX + (size_t)(t0 - 1) * 1024 + col), c2 = *(const v4u*)(CC + (size_t)(t0 - 2) * 1024 + col), x2v = *(const v4u*)(CX + (size_t)(t0 - 2) * 1024 + col);
                u1[0] = bflo(c1.x) * bflo(x1v.x); u1[1] = bfhi(c1.x) * bfhi(x1v.x); u1[2] = bflo(c1.y) * bflo(x1v.y); u1[3] = bfhi(c1.y) * bfhi(x1v.y); u1[4] = bflo(c1.z) * bflo(x1v.z); u1[5] = bfhi(c1.z) * bfhi(x1v.z); u1[6] = bflo(c1.w) * bflo(x1v.w); u1[7] = bfhi(c1.w) * bfhi(x1v.w);
                u2[0] = bflo(c2.x) * bflo(x2v.x); u2[1] = bfhi(c2.x) * bfhi(x2v.x); u2[2] = bflo(c2.y) * bflo(x2v.y); u2[3] = bfhi(c2.y) * bfhi(x2v.y); u2[4] = bflo(c2.z) * bflo(x2v.z); u2[5] = bfhi(c2.z) * bfhi(x2v.z); u2[6] = bflo(c2.w) * bflo(x2v.w); u2[7] = bfhi(c2.w) * bfhi(x2v.w);
            }
            const float w0[8] = {w0a.x, w0a.y, w0a.z, w0a.w, w0b.x, w0b.y, w0b.z, w0b.w}, w1[8] = {w1a.x, w1a.y, w1a.z, w1a.w, w1b.x, w1b.y, w1b.z, w1b.w}, w2[8] = {w2a.x, w2a.y, w2a.z, w2a.w, w2b.x, w2b.y, w2b.z, w2b.w};
#pragma unroll 4
            for (int j = 0; j < 16; ++j) { const size_t ro = (size_t)(t0 + j) * 1024 + col;
                const v4u bv = *(const v4u*)(CB + ro), cv = *(const v4u*)(CC + ro), xv = *(const v4u*)(CX + ro);
                float u0[8], bb[8], y[8];
                u0[0] = bflo(cv.x) * bflo(xv.x); u0[1] = bfhi(cv.x) * bfhi(xv.x); u0[2] = bflo(cv.y) * bflo(xv.y); u0[3] = bfhi(cv.y) * bfhi(xv.y); u0[4] = bflo(cv.z) * bflo(xv.z); u0[5] = bfhi(cv.z) * bfhi(xv.z); u0[6] = bflo(cv.w) * bflo(xv.w); u0[7] = bfhi(cv.w) * bfhi(xv.w);
                bb[0] = bflo(bv.x); bb[1] = bfhi(bv.x); bb[2] = bflo(bv.y); bb[3] = bfhi(bv.y); bb[4] = bflo(bv.z); bb[5] = bfhi(bv.z); bb[6] = bflo(bv.w); bb[7] = bfhi(bv.w);
#pragma unroll
                for (int i = 0; i < 8; ++i) { y[i] = bb[i] * (u2[i] * w0[i] + u1[i] * w1[i] + u0[i] * w2[i]); u2[i] = u1[i]; u1[i] = u0[i]; }
                v4u o; o.x = pk2(y[0], y[1]); o.y = pk2(y[2], y[3]); o.z = pk2(y[4], y[5]); o.w = pk2(y[6], y[7]);
                *(v4u*)(MIX + (size_t)(t0 + j) * 2048 + 1024 + col) = o; }
        }
    }
    SEAM(2);
    if (IN(3)) REPS(3) {
        pg8::Gemm g{MIX, WtOut, T, DM, DM}; pg8::StaticOrder S; S.init(T, DM, G, bx);
        pg8::EpiX1 E{x, out, A2, ffn_g, SSQ};
        pg8::gemm_phase<pg8::EpiX1, pg8::StaticOrder, true, true>(lds, g, S, E);
    }
    SEAM(3);
    if (IN(4)) REPS(4) {
        pg8::Gemm g{A2, WtQ, T, DM, DM}; pg8::StaticOrder S; S.init(T, DM, G, bx);
        pg8::EpiBf16<0> E{QP, DM, nullptr, 0, 0, 1.f};
        pg8::gemm_phase<pg8::EpiBf16<0>, pg8::StaticOrder, true, true>(lds, g, S, E);
    }
    SEAM(4);
    if (IN(5)) REPS(5) {
        for (int it = vcu; it < (T / 128) * PEH; it += G) peer_topk_item(it >> 3, it & 7, QP, SK, SSQ, EIDX, EGATE, RSTD, (LAS char*)lds);
    }
    SEAM(5);
    if (IN(6)) {
        float* PART = (float*)(ws + WS_PART);
        const int tstride = (G >> 3) * NWAVES, nper = (T + tstride - 1) / tstride;
        peer_u_stage(nper, (bx >> 3) * NWAVES + wave, tstride, bx & 7, A2, U8, EIDX, PART, lane);
    }
    SEAM(6);
    if (IN(7)) {
        const float* PART = (const float*)(ws + WS_PART); float* ACT = (float*)(ws + WS_ACT);
        for (size_t i = gtid; i < (size_t)T * 128; i += nthr) { float z = 0.f;
#pragma unroll
            for (int s = 0; s < 16; ++s) z += PART[(size_t)s * T * 128 + i];
            z *= RSTD[i >> 7] * (1.0f / U8_SCALE);
            ACT[i] = 0.5f * z * (1.0f + erff(z * 0.70710678118654752f)) * EGATE[i] * (1.0f / V8_SCALE); }
    }
    SEAM(7);
    if (IN(8)) {
        const float* ACT = (const float*)(ws + WS_ACT);
        const int tstride = (G >> 3) * NWAVES, nper = (T + tstride - 1) / tstride;
        peer_v_stage(nper, (bx >> 3) * NWAVES + wave, tstride, bx & 7, V8, EIDX, ACT, out, lane);
    }
#undef IN
#undef SEAM
}

extern "C" void kernel_launch(void* const* d_in, const int* in_sizes, int n_in, void* d_out, int out_size, void* d_ws, size_t ws_size, hipStream_t stream) {
    static int grid = 0;
    if (grid == 0) {
        if (n_in != 17 || out_size != T * DM || ws_size < WS_END) { fprintf(stderr, "kernel_launch: unexpected shapes (n_in %d out %d ws %zu)\n", n_in, out_size, ws_size); grid = -1; return; }
        int dev = 0, cus = 0, per_cu = 0;
        if (hipGetDevice(&dev) != hipSuccess || hipDeviceGetAttribute(&cus, hipDeviceAttributeMultiprocessorCount, dev) != hipSuccess) { grid = -1; return; }
        if (hipFuncSetAttribute((const void*)mk_fwd, hipFuncAttributeMaxDynamicSharedMemorySize, LDS_BYTES) != hipSuccess) { fprintf(stderr, "kernel_launch: hipFuncSetAttribute failed\n"); grid = -1; return; }
        if (hipOccupancyMaxActiveBlocksPerMultiprocessor(&per_cu, (const void*)mk_fwd, NTHREADS, LDS_BYTES) != hipSuccess || per_cu < 1) { fprintf(stderr, "kernel_launch: occupancy query says %d blocks per CU\n", per_cu); (void)hipGetLastError(); grid = -1; return; }
        grid = cus;
    }
    if (grid < 0) return;
    if (hipMemsetAsync((char*)d_ws + WS_CTL, 0, CTL_ZERO_BYTES, stream) != hipSuccess) { fprintf(stderr, "kernel_launch: memset failed\n"); return; }
    Args a{};
    for (int i = 0; i < 17; ++i) a.in[i] = (const float*)d_in[i];
    a.out = (float*)d_out; a.ws = (unsigned char*)d_ws;
#if MK_N_LAUNCHES == 1
    a.ph_lo = 0; a.ph_hi = NPHASE;
    void* kargs[] = {&a};
    hipError_t e = hipLaunchCooperativeKernel((const void*)mk_fwd, dim3(grid), dim3(NTHREADS), kargs, LDS_BYTES, stream);
    if (e != hipSuccess) fprintf(stderr, "kernel_launch: cooperative launch failed: %s (grid %d)\n", hipGetErrorString(e), grid);
#else
#ifndef DBG_DUPL
#define DBG_DUPL -1
#endif
    for (int p = 0; p < NPHASE; ++p) { a.ph_lo = p; a.ph_hi = p + 1; for (int r = 0; r < (p == DBG_DUPL ? 2 : 1); ++r) hipLaunchKernelGGL(mk_fwd, dim3(grid), dim3(NTHREADS), LDS_BYTES, stream, a); }
#endif
}
```

```cpp
#include <hip/hip_runtime.h>
#include <hip/hip_cooperative_groups.h>
#include <cstdio>
#include <cstdint>
#include <cmath>
namespace cg = cooperative_groups;
namespace pg8 {
#define PG8_LAS __attribute__((address_space(3)))
typedef unsigned short bf16_t;
typedef short bf16x8 __attribute__((ext_vector_type(8)));
typedef float f32x4 __attribute__((ext_vector_type(4)));
typedef unsigned u32x4 __attribute__((ext_vector_type(4)));
constexpr int BM = 256, BK = 64, HALF = 128, HTB = HALF * BK * 2  , STAGE_BYTES = 8 * HTB, NXCD = 8, WGM = 8;

__host__ __device__ __forceinline__ int lds_byte(int r, int c) { const int st = (r >> 4) * 2 + (c >> 5), rr = r & 15, cc = c & 31, ob = rr * 64 + cc * 2; return st * 1024 + (ob ^ (((ob >> 9) & 1) << 5)); }
__host__ __device__ __forceinline__ void stage_rc(int b, int& R, int& C) { const int st = b / 1024, sb = b % 1024, swz = sb ^ (((sb >> 9) & 1) << 5); R = (st >> 1) * 16 + swz / 64; C = (st & 1) * 32 + (swz % 64) / 2; }
__host__ __device__ __forceinline__ int perm32(int rho) { const int n = rho >> 4, i = rho & 15; return 8 * (i >> 2) + 4 * n + (i & 3); }

struct Unit { int pm, pn; };
struct Gemm { const bf16_t* A; const bf16_t* Bt; int M, N, K; };

struct StaticOrder {
    int nM, nN, nwg, G, c;
    __host__ __device__ void init(int M, int N, int G_, int c_) { nM = M / BM; nN = N / BM; nwg = nM * nN; G = G_; c = c_; }
    __host__ __device__ bool next(int i, Unit& u) const {
        const long L = (long)i * G + c; if (L >= nwg) return false;
        int wgid = (int)L; { const int q = nwg / NXCD, r = nwg % NXCD, xcd = wgid % NXCD, off = wgid / NXCD; wgid = (xcd < r ? xcd * (q + 1) : r * (q + 1) + (xcd - r) * q) + off; }
        const int nig = WGM * nN, gid = wgid / nig, fm = gid * WGM, gsz = (nM - fm) < WGM ? (nM - fm) : WGM;
        u.pm = fm + ((wgid % nig) % gsz); u.pn = (wgid % nig) / gsz; return true;
    }
    __device__ __forceinline__ void a_ready(const Unit&) const {}
    __device__ __forceinline__ void done(const Unit&) const {}
};

__device__ __forceinline__ unsigned cvt_pk_bf16(float lo, float hi) { unsigned r; asm volatile("v_cvt_pk_bf16_f32 %0, %1, %2" : "=v"(r) : "v"(lo), "v"(hi)); return r; }
typedef float f32x2 __attribute__((ext_vector_type(2)));
__device__ __forceinline__ f32x2 gelu_pk(f32x2 v) {
    const f32x2 av = __builtin_elementwise_abs(v), d = av * 0.2316418882f + 1.0f;
    f32x2 t; t.x = __builtin_amdgcn_rcpf(d.x); t.y = __builtin_amdgcn_rcpf(d.y);
    f32x2 q = t * 0.5307027145f + (-0.7265760135f); q = q * t + 0.7107068705f; q = q * t + (-0.142248368f); q = q * t + 0.127414796f; q = q * t;
    const f32x2 s = (v * v) * (-0.72134752044f);
    f32x2 e; e.x = __builtin_amdgcn_exp2f(s.x); e.y = __builtin_amdgcn_exp2f(s.y);
    const f32x2 m = v * (q * e), r = v - m;
    f32x2 o; o.x = v.x < 0.f ? m.x : r.x; o.y = v.y < 0.f ? m.y : r.y; return o;
}

template <int ACT  > struct EpiBf16 {
    static constexpr bool PERM = true, AFTER_DRAIN = false; static_assert(ACT == 0 || ACT == 1, "EpiBf16: ACT is 0 (none) or 1 (gelu_pk)");
    bf16_t* O; int ldc; const float* bias; int split_cols; size_t split_stride; float scale0;
    __device__ __forceinline__ void operator()(const f32x4 (&acc)[2][2][4][2], const Unit& u, int wr, int wc, int fr, int fq) const {
        const int row0 = u.pm * BM + wr * 64 + fr; int colt = u.pn * BM; bf16_t* base = O;
        float sc = 1.f; if (split_cols) { const int t = colt / split_cols; base += (size_t)t * split_stride; colt -= t * split_cols; if (t == 0) sc = scale0; }
        const int col0 = colt + wc * 32 + 8 * fq, bcol0 = u.pn * BM + wc * 32 + 8 * fq;
        f32x4 bv[2][2];
#pragma unroll
        for (int bj = 0; bj < 2; ++bj)
#pragma unroll
            for (int n = 0; n < 2; ++n) bv[bj][n] = bias ? *(const f32x4*)(bias + bcol0 + bj * HALF + 4 * n) : (f32x4){0.f, 0.f, 0.f, 0.f};
#pragma unroll
        for (int ai = 0; ai < 2; ++ai)
#pragma unroll
            for (int m = 0; m < 4; ++m) { bf16_t* rowp = base + (size_t)(row0 + ai * HALF + m * 16) * ldc + col0;
#pragma unroll
                for (int bj = 0; bj < 2; ++bj) { f32x4 v0 = acc[ai][bj][m][0] + bv[bj][0], v1 = acc[ai][bj][m][1] + bv[bj][1];
                    if (ACT == 1) { f32x2 a = gelu_pk((f32x2){v0[0], v0[1]}), b = gelu_pk((f32x2){v0[2], v0[3]}), c = gelu_pk((f32x2){v1[0], v1[1]}), d = gelu_pk((f32x2){v1[2], v1[3]});
                        v0 = (f32x4){a.x, a.y, b.x, b.y}; v1 = (f32x4){c.x, c.y, d.x, d.y}; }
                    v0 = v0 * sc; v1 = v1 * sc; u32x4 w; w.x = cvt_pk_bf16(v0[0], v0[1]); w.y = cvt_pk_bf16(v0[2], v0[3]); w.z = cvt_pk_bf16(v1[0], v1[1]); w.w = cvt_pk_bf16(v1[2], v1[3]);
                    *(u32x4*)(rowp + bj * HALF) = w; } }
    }
};
template <class Epi, class Sched, bool ALIGN_EPI = false, bool SP2 = false>
__device__ __forceinline__ void gemm_phase(PG8_LAS unsigned char* lds, const Gemm g, const Sched& S, const Epi& E) {
    const int tid = threadIdx.x, wid = __builtin_amdgcn_readfirstlane(tid >> 6), lane = tid & 63, wr = wid >> 2, wc = wid & 3, fr = lane & 15, fq = lane >> 4;
    const int K = g.K, nt = K / BK;
    unsigned voffA[2], voffB[2];
#pragma unroll
    for (int i = 0; i < 2; ++i) { int R, C; stage_rc(tid * 16 + i * 8192, R, C); const int Rb = Epi::PERM ? ((R & ~31) + perm32(R & 31)) : R;
        voffA[i] = (unsigned)(R * K + C) * 2u; voffB[i] = (unsigned)(Rb * K + C) * 2u; }
    const size_t kstep = (size_t)(BK * 2);
    const size_t hstep = (size_t)HALF * K * 2;
    const size_t tstep = 2 * hstep;
    const unsigned ldsw = (unsigned)wid * 1024u;
    const int aoff = lds_byte(wr * 64 + fr, fq * 8), boff = lds_byte(wc * 32 + fr, fq * 8);
#define PG8_SA(b, h) (((b) * 2 + (h)) * HTB)
#define PG8_SB(b, h) ((4 + (b) * 2 + (h)) * HTB)
#define PG8_STAGE(bufoff, gbase, voff) do { _Pragma("unroll") for (int _i = 0; _i < 2; ++_i) \
        __builtin_amdgcn_global_load_lds((const unsigned*)((const char*)(gbase) + (voff)[_i]), (PG8_LAS unsigned*)(lds + (bufoff) + ldsw + _i * 8192), 16, 0, 0); } while (0)
#define PG8_LDA(dst, b, h) do { _Pragma("unroll") for (int m = 0; m < 4; ++m) _Pragma("unroll") for (int k = 0; k < 2; ++k) dst[m][k] = *(const PG8_LAS bf16x8*)(lds + PG8_SA(b, h) + aoff + m * 2048 + k * 1024); } while (0)
#define PG8_LDB(dst, b, h) do { _Pragma("unroll") for (int n = 0; n < 2; ++n) _Pragma("unroll") for (int k = 0; k < 2; ++k) dst[n][k] = *(const PG8_LAS bf16x8*)(lds + PG8_SB(b, h) + boff + n * 2048 + k * 1024); } while (0)
#define PG8_MMA(ai, bj, At, Bt) do { __builtin_amdgcn_s_setprio(1); _Pragma("unroll") for (int m = 0; m < 4; ++m) _Pragma("unroll") for (int n = 0; n < 2; ++n) _Pragma("unroll") for (int k = 0; k < 2; ++k) \
        acc[ai][bj][m][n] = __builtin_amdgcn_mfma_f32_16x16x32_bf16(Bt[n][k], At[m][k], acc[ai][bj][m][n], 0, 0, 0); __builtin_amdgcn_s_setprio(0); } while (0)
#define PG8_WAIT_V(n) asm volatile("s_waitcnt vmcnt(" #n ")" ::: "memory")
#define PG8_WAIT_L(n) asm volatile("s_waitcnt lgkmcnt(" #n ")" ::: "memory")
#define PG8_BAR __builtin_amdgcn_s_barrier()
#define PG8_SCHED __builtin_amdgcn_sched_barrier(0)
    Unit cur, nxt; int ui = 0;
    if (!S.next(0, cur)) return;
    f32x4 acc[2][2][4][2];
#pragma unroll
    for (int a = 0; a < 2; ++a)
#pragma unroll
        for (int b = 0; b < 2; ++b)
#pragma unroll
            for (int m = 0; m < 4; ++m)
#pragma unroll
                for (int n = 0; n < 2; ++n) acc[a][b][m][n] = (f32x4){0.f, 0.f, 0.f, 0.f};
    bf16x8 At[4][2], B0[2][2], B1[2][2];
    const char* cA = (const char*)g.A + (size_t)cur.pm * tstep; const char* cB = (const char*)g.Bt + (size_t)cur.pn * tstep;
    S.a_ready(cur);
    if constexpr (SP2) {
        PG8_STAGE(PG8_SB(0, 0), cB, voffB); PG8_STAGE(PG8_SB(0, 1), cB + hstep, voffB); PG8_STAGE(PG8_SA(0, 0), cA, voffA); PG8_STAGE(PG8_SA(0, 1), cA + hstep, voffA);
        if (wr == 1) PG8_BAR;
        PG8_WAIT_V(2); PG8_BAR;
        PG8_STAGE(PG8_SB(1, 0), cB + kstep, voffB); PG8_STAGE(PG8_SA(1, 0), cA + kstep, voffA); PG8_STAGE(PG8_SB(1, 1), cB + hstep + kstep, voffB);
        PG8_WAIT_V(6); PG8_BAR;
    } else {
        PG8_STAGE(PG8_SB(0, 0), cB, voffB); PG8_STAGE(PG8_SA(0, 0), cA, voffA); PG8_STAGE(PG8_SB(0, 1), cB + hstep, voffB); PG8_STAGE(PG8_SA(0, 1), cA + hstep, voffA);
        if (wr == 1) PG8_BAR;
        PG8_WAIT_V(4); PG8_BAR;
        PG8_STAGE(PG8_SB(1, 0), cB + kstep, voffB); PG8_STAGE(PG8_SA(1, 0), cA + kstep, voffA); PG8_STAGE(PG8_SB(1, 1), cB + hstep + kstep, voffB);
        PG8_WAIT_V(6); PG8_BAR;
    }
    for (;;) {
        const bool has_next = S.next(ui + 1, nxt);
        const char* nA = has_next ? (const char*)g.A + (size_t)nxt.pm * tstep : cA; const char* nB = has_next ? (const char*)g.Bt + (size_t)nxt.pn * tstep : cB;
        for (int t = 0; t < nt; t += 2) {
            const bool last = (t == nt - 2);
            const char* a1 = cA + (size_t)(t + 1) * kstep;
            const char* a2 = last ? nA : cA + (size_t)(t + 2) * kstep; const char* b2 = last ? nB : cB + (size_t)(t + 2) * kstep;
            const char* a3 = a2 + kstep; const char* b3 = b2 + kstep;
            if (last && has_next) S.a_ready(nxt);
            if constexpr (SP2) {
            PG8_LDB(B0, 0, 0); PG8_LDB(B1, 0, 1); PG8_SCHED; PG8_LDA(At, 0, 0); PG8_STAGE(PG8_SA(1, 1), a1 + hstep, voffA);
            PG8_WAIT_V(8); PG8_WAIT_L(0); PG8_BAR; PG8_MMA(0, 0, At, B0); PG8_MMA(0, 1, At, B1); PG8_BAR; PG8_SCHED;
            PG8_LDA(At, 0, 1); PG8_STAGE(PG8_SB(0, 0), b2, voffB); PG8_STAGE(PG8_SB(0, 1), b2 + hstep, voffB); PG8_STAGE(PG8_SA(0, 0), a2, voffA);
            PG8_WAIT_V(8); PG8_WAIT_L(0); PG8_BAR; PG8_MMA(1, 0, At, B0); PG8_MMA(1, 1, At, B1); PG8_BAR; PG8_SCHED;
            PG8_LDB(B0, 1, 0); PG8_LDB(B1, 1, 1); PG8_SCHED; PG8_LDA(At, 1, 0); PG8_STAGE(PG8_SA(0, 1), a2 + hstep, voffA);
            PG8_WAIT_V(8); PG8_WAIT_L(0); PG8_BAR; PG8_MMA(0, 0, At, B0); PG8_MMA(0, 1, At, B1); PG8_BAR; PG8_SCHED;
            PG8_LDA(At, 1, 1); PG8_STAGE(PG8_SB(1, 0), b3, voffB); PG8_STAGE(PG8_SB(1, 1), b3 + hstep, voffB); PG8_STAGE(PG8_SA(1, 0), a3, voffA);
            PG8_WAIT_V(8); PG8_WAIT_L(0); PG8_BAR; PG8_MMA(1, 0, At, B0); PG8_MMA(1, 1, At, B1); PG8_BAR; PG8_SCHED;
            } else {
            PG8_LDB(B0, 0, 0); PG8_SCHED; PG8_LDA(At, 0, 0); PG8_STAGE(PG8_SA(1, 1), a1 + hstep, voffA);
            PG8_WAIT_L(8); PG8_BAR; PG8_WAIT_L(0); PG8_MMA(0, 0, At, B0); PG8_BAR; PG8_SCHED;
            PG8_LDB(B1, 0, 1); PG8_STAGE(PG8_SB(0, 0), b2, voffB);
            PG8_BAR; PG8_WAIT_L(0); PG8_MMA(0, 1, At, B1); PG8_BAR;
            PG8_LDA(At, 0, 1); PG8_STAGE(PG8_SA(0, 0), a2, voffA);
            PG8_BAR; PG8_WAIT_L(0); PG8_MMA(1, 0, At, B0); PG8_BAR; PG8_SCHED;
            PG8_STAGE(PG8_SB(0, 1), b2 + hstep, voffB);
            PG8_WAIT_V(6); PG8_BAR; PG8_MMA(1, 1, At, B1); PG8_BAR;
            PG8_LDB(B0, 1, 0); PG8_SCHED; PG8_LDA(At, 1, 0); PG8_STAGE(PG8_SA(0, 1), a2 + hstep, voffA);
            PG8_WAIT_L(8); PG8_BAR; PG8_WAIT_L(0); PG8_MMA(0, 0, At, B0); PG8_BAR; PG8_SCHED;
            PG8_LDB(B1, 1, 1); PG8_STAGE(PG8_SB(1, 0), b3, voffB);
            PG8_BAR; PG8_WAIT_L(0); PG8_MMA(0, 1, At, B1); PG8_BAR;
            PG8_LDA(At, 1, 1); PG8_STAGE(PG8_SA(1, 0), a3, voffA);
            PG8_BAR; PG8_WAIT_L(0); PG8_MMA(1, 0, At, B0); PG8_BAR; PG8_SCHED;
            PG8_STAGE(PG8_SB(1, 1), b3 + hstep, voffB);
            PG8_WAIT_V(6); PG8_BAR; PG8_MMA(1, 1, At, B1); PG8_BAR;
            }
        }
        if constexpr (ALIGN_EPI) { if (wr == 0) PG8_BAR; }
        if constexpr (!Epi::AFTER_DRAIN) { E(acc, cur, wr, wc, fr, fq); S.done(cur); }
        if (!has_next) break;
#pragma unroll
        for (int a = 0; a < 2; ++a)
#pragma unroll
            for (int b = 0; b < 2; ++b)
#pragma unroll
                for (int m = 0; m < 4; ++m)
#pragma unroll
                    for (int n = 0; n < 2; ++n) acc[a][b][m][n] = (f32x4){0.f, 0.f, 0.f, 0.f};
        cur = nxt; cA = nA; cB = nB; ++ui;
        if constexpr (ALIGN_EPI) { if (wr == 1) PG8_BAR; }
    }
    PG8_WAIT_V(0);
    if constexpr (!ALIGN_EPI) { if (wr == 0) PG8_BAR; }
    PG8_BAR;
    if constexpr (Epi::AFTER_DRAIN) { E.fused(acc, cur, wr, wc, fr, fq, lds, wid, lane); S.done(cur); }
#undef PG8_SA
#undef PG8_SB
#undef PG8_STAGE
#undef PG8_LDA
#undef PG8_LDB
#undef PG8_MMA
#undef PG8_WAIT_V
#undef PG8_WAIT_L
#undef PG8_BAR
#undef PG8_SCHED
}
}
#define MK_N_LAUNCHES 1
#ifndef MK_N_LAUNCHES
#define MK_N_LAUNCHES 1
#endif
constexpr int DM = 2048, NB = 8, SEQ = 2048, T = NB * SEQ;
constexpr int AW = 1024, NH = 8, HD = 64, VD = 128, INC = 6144;
constexpr int PNK = 128, PTOPK = 16, PEH = 8, EPT = PEH * PTOPK;
constexpr float EPS = 1e-6f;
constexpr float C2 = 0.125f * 1.4426950408889634f;
constexpr int NPHASE = 9;
constexpr float U8_SCALE = 1024.f, V8_SCALE = 16.f, H8_SCALE = 16.f;
constexpr size_t MiB = 1u << 20;
constexpr size_t WS_WIN = 1 * MiB, WS_WOUT = 25 * MiB, WS_WQ = 33 * MiB, WS_SK = 41 * MiB, WS_SSQ = 42 * MiB, WS_EIDX = 44 * MiB, WS_EGATE = 52 * MiB, WS_RSTD = 60 * MiB;
constexpr size_t WS_XN = 64 * MiB;
constexpr size_t WS_Q = 128 * MiB, WS_K = 160 * MiB, WS_V = 192 * MiB;
constexpr size_t WS_CB = 224 * MiB, WS_CC = 256 * MiB, WS_CX = 288 * MiB;
constexpr size_t WS_UT = 320 * MiB, WS_VT = 384 * MiB, WS_END = 448 * MiB;
constexpr size_t WS_CTL = 0; constexpr int CW_BAR = 1024, CTL_ZERO_BYTES = 65536;
constexpr size_t WS_H8 = 288 * MiB;
constexpr size_t WS_PART = 64 * MiB, WS_ACT = 192 * MiB;
constexpr int MISC_OFF = 143360;
constexpr int LDS_BYTES = 147456;
constexpr int NWAVES = 8, NTHREADS = 512;

#define LAS __attribute__((address_space(3)))
typedef unsigned short bf16;
typedef unsigned v4u __attribute__((ext_vector_type(4)));
typedef unsigned v2u __attribute__((ext_vector_type(2)));
typedef float f32x4 __attribute__((ext_vector_type(4)));
typedef float f32x2 __attribute__((ext_vector_type(2)));
typedef float f32x16 __attribute__((ext_vector_type(16)));
typedef short bf16x8 __attribute__((ext_vector_type(8)));
typedef short s16x4 __attribute__((ext_vector_type(4)));
typedef __bf16 bf16x2_t __attribute__((ext_vector_type(2)));
#define LDS_WAIT() asm volatile("s_waitcnt lgkmcnt(0)" ::: "memory")
__device__ __forceinline__ unsigned pk2(float lo, float hi) { f32x2 v = {lo, hi}; bf16x2_t b = __builtin_convertvector(v, bf16x2_t); return __builtin_bit_cast(unsigned, b); }
__device__ __forceinline__ float bflo(unsigned u) { return __uint_as_float(u << 16); }
__device__ __forceinline__ float bfhi(unsigned u) { return __uint_as_float(u & 0xffff0000u); }
__device__ __forceinline__ float wave_sum(float v) {
#pragma unroll
    for (int o = 1; o < 64; o <<= 1) v += __shfl_xor(v, o);
    return v;
}
__device__ __forceinline__ float wave_max(float v) {
#pragma unroll
    for (int o = 1; o < 64; o <<= 1) v = fmaxf(v, __shfl_xor(v, o));
    return v;
}

#define XB_TMO      128
#define XB_XCNT(j)  (256  + 64 * (j))
#define XB_XSUB(j)  (1280 + 64 * (j))
#define XB_XGEN(j)  (2304 + 64 * (j))
#define XB_TOP      3328
#define XB_TOPGEN   3392
#define XCD_BAR_WORDS 3456
#define XB_SPIN_CAP (1u << 18)

__device__ __forceinline__ unsigned xb_ld(unsigned* p)              { return __hip_atomic_load(p, __ATOMIC_RELAXED, __HIP_MEMORY_SCOPE_AGENT); }
__device__ __forceinline__ unsigned xb_add(unsigned* p, unsigned v) { return __hip_atomic_fetch_add(p, v, __ATOMIC_RELAXED, __HIP_MEMORY_SCOPE_AGENT); }
__device__ __forceinline__ unsigned xb_xcc_id() { return (unsigned)__builtin_amdgcn_s_getreg((3 << 11) | 20) & 0xFu; }
#define XB_SPIN(cond, bar) do { unsigned _sp = 0; while (cond) { __builtin_amdgcn_s_sleep(1); \
    if ((++_sp & 255u) == 0u) { if (xb_ld(&(bar)[XB_TMO])) break; if (_sp > XB_SPIN_CAP) { atomicAdd(&(bar)[XB_TMO], 1u); break; } } } } while (0)

struct XcdBarrier {
    unsigned* bar; unsigned x;
    volatile LAS unsigned* st;
};

__device__ __forceinline__ XcdBarrier xcd_barrier_post(unsigned* bar, volatile LAS unsigned* st) {
    XcdBarrier b; b.bar = bar; b.x = xb_xcc_id(); b.st = st;
    if (threadIdx.x == 0) (void)xb_add(&bar[XB_XCNT(b.x)], 1u);
    return b;
}
__device__ __forceinline__ void xcd_barrier_complete(unsigned* bar, unsigned x, unsigned& nloc, unsigned& nx) {
    const unsigned G = gridDim.x * gridDim.y * gridDim.z;
    unsigned sum, cnt, mine, sp = 0u;
    for (;;) {
        sum = 0u; cnt = 0u; mine = 0u;
#pragma unroll
        for (unsigned j = 0; j < 16; ++j) { const unsigned c = xb_ld(&bar[XB_XCNT(j)]); sum += c; cnt += (c > 0u) ? 1u : 0u; mine = (j == x) ? c : mine; }
        if (sum == G) break;
        __builtin_amdgcn_s_sleep(1);
        if ((++sp & 255u) == 0u) { if (xb_ld(&bar[XB_TMO])) break; if (sp > XB_SPIN_CAP) { atomicAdd(&bar[XB_TMO], 1u); break; } }
    }
    nloc = mine > 0u ? mine : 1u; nx = cnt > 0u ? cnt : 1u;
}

__device__ __forceinline__ void xcd_barrier(const XcdBarrier& b) {
    asm volatile("s_waitcnt vmcnt(0)" ::: "memory");
    __syncthreads();
    if (threadIdx.x == 0) {
        unsigned* bar = b.bar;
        __builtin_amdgcn_s_waitcnt(0);
        unsigned nloc = b.st[0], nx = b.st[1];
        if (nloc == 0u) { xcd_barrier_complete(bar, b.x, nloc, nx); b.st[0] = nloc; b.st[1] = nx; }
        const unsigned old = xb_add(&bar[XB_XSUB(b.x)], 1u);
        const unsigned gen = old / nloc;
        if (old + 1u == (gen + 1u) * nloc) {
            __builtin_amdgcn_fence(__ATOMIC_RELEASE, "agent");
            asm volatile("s_waitcnt vmcnt(0)" ::: "memory");
            const unsigned og = xb_add(&bar[XB_TOP], 1u);
            const unsigned tg = og / nx;
            if (og + 1u == (tg + 1u) * nx) xb_add(&bar[XB_TOPGEN], 1u);
            else XB_SPIN(xb_ld(&bar[XB_TOPGEN]) == tg, bar);
            __builtin_amdgcn_fence(__ATOMIC_ACQUIRE, "agent");
            xb_add(&bar[XB_XGEN(b.x)], 1u);
            asm volatile("s_waitcnt vmcnt(0)" ::: "memory");
        } else {
            XB_SPIN(xb_ld(&bar[XB_XGEN(b.x)]) == gen, bar);
            __builtin_amdgcn_fence(__ATOMIC_ACQUIRE, "agent");
            asm volatile("s_waitcnt vmcnt(0)" ::: "memory");
        }
    }
    __syncthreads();
}


namespace pg8 {
struct EpiProj {
    static constexpr bool PERM = true, AFTER_DRAIN = false;
    bf16_t* base0; const float* qg; const float* kg;
    __device__ __forceinline__ void operator()(const f32x4 (&acc)[2][2][4][2], const Unit& u, int wr, int wc, int fr, int fq) const {
        const int region = u.pn >> 2;
        bf16_t* O = base0 + (size_t)region * (16u << 20);
        const int row0 = u.pm * BM + wr * 64 + fr, col0 = (u.pn & 3) * 256 + wc * 64 + 8 * fq;
        if (region < 2) {
            const float* g = region == 0 ? qg : kg; const float sc = region == 0 ? 0.125f * 1.4426950408889634f : 1.0f;
            f32x4 gv[2][2];
#pragma unroll
            for (int bj = 0; bj < 2; ++bj)
#pragma unroll
                for (int n = 0; n < 2; ++n) gv[bj][n] = *(const f32x4*)(g + bj * 32 + 8 * fq + 4 * n) * sc;
#pragma unroll
            for (int ai = 0; ai < 2; ++ai)
#pragma unroll
                for (int m = 0; m < 4; ++m) {
                    float ss = 0.f;
#pragma unroll
                    for (int bj = 0; bj < 2; ++bj)
#pragma unroll
                        for (int n = 0; n < 2; ++n) { const f32x4 x = acc[ai][bj][m][n]; ss += (x[0] * x[0] + x[1] * x[1]) + (x[2] * x[2] + x[3] * x[3]); }
                    ss += __shfl_xor(ss, 16); ss += __shfl_xor(ss, 32);
                    const float rs = __builtin_amdgcn_rsqf(ss * (1.0f / 64.0f) + 1e-6f);
                    bf16_t* rowp = O + (size_t)(row0 + ai * HALF + m * 16) * 1024 + col0;
#pragma unroll
                    for (int bj = 0; bj < 2; ++bj) { const f32x4 v0 = acc[ai][bj][m][0] * rs * gv[bj][0], v1 = acc[ai][bj][m][1] * rs * gv[bj][1];
                        u32x4 w; w.x = cvt_pk_bf16(v0[0], v0[1]); w.y = cvt_pk_bf16(v0[2], v0[3]); w.z = cvt_pk_bf16(v1[0], v1[1]); w.w = cvt_pk_bf16(v1[2], v1[3]);
                        *(u32x4*)(rowp + bj * 32) = w; }
                }
        } else {
#pragma unroll
            for (int ai = 0; ai < 2; ++ai)
#pragma unroll
                for (int m = 0; m < 4; ++m) { bf16_t* rowp = O + (size_t)(row0 + ai * HALF + m * 16) * 1024 + col0;
#pragma unroll
                    for (int bj = 0; bj < 2; ++bj) { const f32x4 v0 = acc[ai][bj][m][0], v1 = acc[ai][bj][m][1];
                        u32x4 w; w.x = cvt_pk_bf16(v0[0], v0[1]); w.y = cvt_pk_bf16(v0[2], v0[3]); w.z = cvt_pk_bf16(v1[0], v1[1]); w.w = cvt_pk_bf16(v1[2], v1[3]);
                        *(u32x4*)(rowp + bj * 32) = w; } }
        }
    }
};
struct EpiX1 {
    static constexpr bool PERM = true, AFTER_DRAIN = false;
    const float* x; float* out; bf16_t* a2; const float* gf; float* ssq; unsigned char* h8;
    __device__ __forceinline__ void operator()(const f32x4 (&acc)[2][2][4][2], const Unit& u, int wr, int wc, int fr, int fq) const {
        const int row0 = u.pm * BM + wr * 64 + fr, col0 = u.pn * BM + wc * 32 + 8 * fq;
        f32x4 gv[2][2];
#pragma unroll
        for (int bj = 0; bj < 2; ++bj)
#pragma unroll
            for (int n = 0; n < 2; ++n) gv[bj][n] = *(const f32x4*)(gf + col0 + bj * HALF + 4 * n);
#pragma unroll
        for (int ai = 0; ai < 2; ++ai)
#pragma unroll
            for (int m = 0; m < 4; ++m) { const int row = row0 + ai * HALF + m * 16; const size_t off = (size_t)row * 2048 + col0; float ss = 0.f;
#pragma unroll
                for (int bj = 0; bj < 2; ++bj) {
                    const f32x4 x0 = *(const f32x4*)(x + off + bj * HALF), x1 = *(const f32x4*)(x + off + bj * HALF + 4);
                    const f32x4 v0 = x0 + acc[ai][bj][m][0], v1 = x1 + acc[ai][bj][m][1];
                    *(f32x4*)(out + off + bj * HALF) = v0; *(f32x4*)(out + off + bj * HALF + 4) = v1;
                    ss += (v0[0] * v0[0] + v0[1] * v0[1]) + (v0[2] * v0[2] + v0[3] * v0[3]); ss += (v1[0] * v1[0] + v1[1] * v1[1]) + (v1[2] * v1[2] + v1[3] * v1[3]);
                    const f32x4 a0 = v0 * gv[bj][0], a1 = v1 * gv[bj][1];
                    u32x4 w; w.x = cvt_pk_bf16(a0[0], a0[1]); w.y = cvt_pk_bf16(a0[2], a0[3]); w.z = cvt_pk_bf16(a1[0], a1[1]); w.w = cvt_pk_bf16(a1[2], a1[3]);
                    *(u32x4*)(a2 + off + bj * HALF) = w;
                    { const f32x4 b0 = a0 * 16.0f, b1 = a1 * 16.0f; unsigned p = 0u, q2 = 0u;
#pragma unroll
                      for (int e_ = 0; e_ < 4; ++e_) { const int i0_ = __builtin_amdgcn_fmed3f(__builtin_rintf(b0[e_]), -127.f, 127.f), i1_ = __builtin_amdgcn_fmed3f(__builtin_rintf(b1[e_]), -127.f, 127.f);
                          p |= ((unsigned)i0_ & 0xffu) << (8 * e_); q2 |= ((unsigned)i1_ & 0xffu) << (8 * e_); }
                      typedef unsigned u32x2_ __attribute__((ext_vector_type(2))); *(u32x2_*)(h8 + off + bj * HALF) = (u32x2_){p, q2}; } }
                ss += __shfl_xor(ss, 16); ss += __shfl_xor(ss, 32);
                if (fq == 0) ssq[(size_t)row * 32 + u.pn * 4 + wc] = ss; }
    }
};
}

__device__ __forceinline__ void p0_transpose_item(const float* W, int K, int N, bf16* WT, LAS float* scr, int item, int lane, bool permg) {
    const int nblk = N / 32, kb = item / nblk, nb = item % nblk, k0 = 64 * kb, n0 = 32 * nb;
#pragma unroll 8
    for (int i = 0; i < 32; ++i) { const int kk = 2 * i + (lane >> 5); scr[kk * 33 + (lane & 31)] = W[(size_t)(k0 + kk) * N + n0 + (lane & 31)]; }
    LDS_WAIT(); asm volatile("" ::: "memory");
    int nd = n0; if (permg) { const int gl = (n0 & 255) >> 5; nd = (n0 & ~255) + 32 * (4 * (gl & 1) + (gl >> 1)); }
    const int c = lane & 7;
#pragma unroll
    for (int j = 0; j < 4; ++j) { const int n = (lane >> 3) + 8 * j; const LAS float* s = scr + (8 * c) * 33 + n;
        v4u o; o.x = pk2(s[0 * 33], s[1 * 33]); o.y = pk2(s[2 * 33], s[3 * 33]); o.z = pk2(s[4 * 33], s[5 * 33]); o.w = pk2(s[6 * 33], s[7 * 33]);
        *(v4u*)(WT + (size_t)(nd + n) * K + k0 + 8 * c) = o; }
    LDS_WAIT(); asm volatile("" ::: "memory");
}
__device__ __forceinline__ void rms_row_to_bf16(const float* xrow, const float* g, bf16* orow, int lane) {
    const f32x4* xr = (const f32x4*)xrow + lane; const f32x4* gr = (const f32x4*)g + lane;
    f32x4 v[8]; float s = 0.f;
#pragma unroll
    for (int j = 0; j < 8; ++j) { v[j] = xr[64 * j]; s += (v[j].x * v[j].x + v[j].y * v[j].y) + (v[j].z * v[j].z + v[j].w * v[j].w); }
    const float rstd = 1.0f / sqrtf(wave_sum(s) * (1.f / DM) + EPS);
    v2u* o8 = (v2u*)orow + lane;
#pragma unroll
    for (int j = 0; j < 8; ++j) { const f32x4 gg = gr[64 * j]; v2u w; w.x = pk2(v[j].x * rstd * gg.x, v[j].y * rstd * gg.y); w.y = pk2(v[j].z * rstd * gg.z, v[j].w * rstd * gg.w); o8[64 * j] = w; }
}
__device__ __forceinline__ void cvt_bf16_stream(const float* src, bf16* dst, size_t n8, size_t gtid, size_t nthr) {
    for (size_t i = gtid; i < n8; i += nthr) { const f32x4 a = *(const f32x4*)(src + i * 8), b = *(const f32x4*)(src + i * 8 + 4);
        v4u o; o.x = pk2(a.x, a.y); o.y = pk2(a.z, a.w); o.z = pk2(b.x, b.y); o.w = pk2(b.z, b.w); *(v4u*)(dst + i * 8) = o; }
}

__device__ __forceinline__ void cvt_i4_slices(const float* src, unsigned char* dst, float inv_step, size_t gtid, size_t nthr) {
    for (size_t i = gtid; i < (size_t)16384 * 64; i += nthr) { v4u o; const size_t e = i >> 6; const int c32 = (int)(i & 63), s = c32 >> 3, sub = c32 & 7;
#pragma unroll
        for (int w = 0; w < 4; ++w) { const f32x4 a = *(const f32x4*)(src + i * 32 + 8 * w) * inv_step, b = *(const f32x4*)(src + i * 32 + 8 * w + 4) * inv_step; unsigned d = 0u;
#pragma unroll
            for (int e_ = 0; e_ < 4; ++e_) { const int lo = (int)__builtin_amdgcn_fmed3f(__builtin_rintf(a[e_]), -8.f, 7.f) + 8, hi = (int)__builtin_amdgcn_fmed3f(__builtin_rintf(b[e_]), -8.f, 7.f) + 8; d |= ((unsigned)lo | ((unsigned)hi << 4)) << (8 * e_); }
            if (w == 0) o.x = d; else if (w == 1) o.y = d; else if (w == 2) o.z = d; else o.w = d; }
        *(v4u*)(dst + ((size_t)s * 16384 + e) * 128 + 16 * sub) = o; }
}
__device__ __forceinline__ float table_std16(const float* src, LAS float* scr, int tid) {
    float s = 0.f;
#pragma unroll
    for (int j = 0; j < 16; ++j) { const f32x4 v = *(const f32x4*)(src + (size_t)(j * 512 + tid) * 4); s += (v.x * v.x + v.y * v.y) + (v.z * v.z + v.w * v.w); }
    s = wave_sum(s);
    __syncthreads();
    if ((tid & 63) == 0) scr[tid >> 6] = s;
    __syncthreads();
    float t = 0.f;
#pragma unroll
    for (int w = 0; w < 8; ++w) t += scr[w];
    __syncthreads();
    return sqrtf(t * (1.0f / 32768.0f));
}
__device__ __forceinline__ void cvt_i8_slices(const float* src, unsigned char* dst, float scale, size_t gtid, size_t nthr) {
    for (size_t i = gtid; i < (size_t)16384 * 128; i += nthr) { v4u o; const size_t e = i >> 7; const int c16 = (int)(i & 127), s = c16 >> 3, sub = c16 & 7;
#pragma unroll
        for (int q = 0; q < 4; ++q) { const f32x4 a = *(const f32x4*)(src + i * 16 + 4 * q) * scale; unsigned w = 0u;
#pragma unroll
            for (int e_ = 0; e_ < 4; ++e_) { const int iv = (int)__builtin_amdgcn_fmed3f(__builtin_rintf(a[e_]), -127.f, 127.f); w |= ((unsigned)iv & 0xffu) << (8 * e_); }
            if (q == 0) o.x = w; else if (q == 1) o.y = w; else if (q == 2) o.z = w; else o.w = w; }
        *(v4u*)(dst + ((size_t)s * 16384 + e) * 128 + 16 * sub) = o; }
}
__device__ __forceinline__ void cvt_fp8_slices(const float* src, unsigned char* dst, float scale, size_t gtid, size_t nthr) {
    for (size_t i = gtid; i < (size_t)16384 * 128; i += nthr) { v4u o; const size_t e = i >> 7; const int c16 = (int)(i & 127), s = c16 >> 3, sub = c16 & 7;
#pragma unroll
        for (int q = 0; q < 4; ++q) { const f32x4 a = *(const f32x4*)(src + i * 16 + 4 * q) * scale; int w = __builtin_amdgcn_cvt_pk_fp8_f32(a.x, a.y, 0, false); w = __builtin_amdgcn_cvt_pk_fp8_f32(a.z, a.w, w, true);
            if (q == 0) o.x = (unsigned)w; else if (q == 1) o.y = (unsigned)w; else if (q == 2) o.z = (unsigned)w; else o.w = (unsigned)w; }
        *(v4u*)(dst + ((size_t)s * 16384 + e) * 128 + 16 * sub) = o; }
}

namespace att {
constexpr int SLOTB = 32768;
constexpr int NSLOT = 3, LW_OFF = NSLOT * SLOTB;
constexpr int XSTR = 132;
__device__ __forceinline__ void glds16(const void* gsrc, unsigned lds_dst) { unsigned keep;
    asm volatile("s_mov_b32 %0, m0\n\ts_mov_b32 m0, %2\n\ts_nop 0\n\tglobal_load_lds_dwordx4 %1, off\n\ts_mov_b32 m0, %0" : "=&s"(keep) : "v"(gsrc), "s"(lds_dst) : "memory"); }
__device__ __forceinline__ int crow(int r, int hi) { return (r & 3) + 8 * (r >> 2) + 4 * hi; }
typedef short v4i16_t __attribute__((ext_vector_type(4)));
__device__ __forceinline__ s16x4 vtr(const LAS char* p) { return __builtin_bit_cast(s16x4, __builtin_amdgcn_ds_read_tr16_b64_v4i16((LAS v4i16_t*)p)); }
#define ATT_WAIT_BAR(N) asm volatile("s_waitcnt vmcnt(" #N ") lgkmcnt(0)\n\ts_barrier" ::: "memory")

__device__ __forceinline__ void attn_unit(int b, int h, int qblk, const bf16* Q, const bf16* K, const bf16* V, bf16* MIX, const float* subg, float lam, float M2, LAS char* lds) {
    const int tid = threadIdx.x, lane = tid & 63, r32 = lane & 31, hi = lane >> 5, wid = __builtin_amdgcn_readfirstlane(tid >> 6), c = wid >> 2, qs = wid & 3;
    const size_t rowbase = (size_t)b * SEQ; const int q0 = qblk * 128, NT = 2 * (qblk + 1);
    const unsigned lds0 = (unsigned)(uintptr_t)lds;
    const bf16* ksrc[2]; const bf16* vsrc[2]; unsigned kdst[2], vdst[2];
#pragma unroll
    for (int i = 0; i < 2; ++i) { const int pk = 2 * wid + i, pc = pk >> 3, ch = pk & 7, d0 = pk >> 2, rg = pk & 3;
        ksrc[i] = K + (rowbase + lane) * 1024 + h * 128 + pc * 64 + ch * 8; kdst[i] = lds0 + pk * 1024;
        vsrc[i] = V + (rowbase + 16 * rg + (lane >> 2)) * 1024 + h * 128 + d0 * 32 + (lane & 3) * 8; vdst[i] = lds0 + 16384 + pk * 1024; }
#define ATT_DMA(t, slot) do { _Pragma("unroll") for (int i_ = 0; i_ < 2; ++i_) { glds16(ksrc[i_] + (size_t)(t) * 64 * 1024, (unsigned)__builtin_amdgcn_readfirstlane(kdst[i_] + (slot) * SLOTB)); \
        glds16(vsrc[i_] + (size_t)(t) * 64 * 1024, (unsigned)__builtin_amdgcn_readfirstlane(vdst[i_] + (slot) * SLOTB)); } } while (0)
    ATT_DMA(0, 0); ATT_DMA(1, 1);
    const int qrow = q0 + 32 * qs + r32;
    bf16x8 qr[4];
#pragma unroll
    for (int d0 = 0; d0 < 4; ++d0) qr[d0] = *(const bf16x8*)(Q + (rowbase + qrow) * 1024 + h * 128 + c * 64 + d0 * 16 + hi * 8);
    const float slope2 = exp2f(-(float)(h + 1)) * 1.4426950408889634f;
    float base = -slope2 * (float)(qrow - 4 * hi) - M2;
    const float s32 = 32.f * slope2, s64 = 64.f * slope2;
    f32x16 o[4]; o[0] = f32x16{}; o[1] = f32x16{}; o[2] = f32x16{}; o[3] = f32x16{};
    float lsum = 0.f;
    const LAS char* kp0 = (const LAS char*)lds + c * 8192 + hi * 1024 + r32 * 16;
    const LAS char* vp0 = (const LAS char*)lds + 16384 + ((lane >> 4) & 1) * 32 + (lane & 3) * 8 + (4 * hi + ((lane & 15) >> 2)) * 64;
    const int qw0 = q0 + 32 * qs;
    int slot = 0;
    for (int t = 0; t < NT; ++t) {
        if (t == 0) { ATT_WAIT_BAR(0); } else if (t + 1 < NT) { ATT_WAIT_BAR(4); } else { ATT_WAIT_BAR(0); }
        if (t + 2 < NT) { const int s2_ = (slot == 0) ? 2 : slot - 1; ATT_DMA(t + 2, s2_); }
        const int k0 = 64 * t;
        if (k0 <= qw0 + 31) {
            const LAS char* kp = kp0 + slot * SLOTB; const LAS char* vp = vp0 + slot * SLOTB;
            f32x16 p0, p1;
#pragma unroll
            for (int r = 0; r < 16; ++r) { p0[r] = __builtin_fmaf(slope2, (float)((r & 3) + 8 * (r >> 2)), base); p1[r] = p0[r] + s32; }
#pragma unroll
            for (int d0 = 0; d0 < 4; ++d0) {
                const bf16x8 ka = *(const LAS bf16x8*)(kp + d0 * 2048), kb = *(const LAS bf16x8*)(kp + d0 * 2048 + 512);
                p0 = __builtin_amdgcn_mfma_f32_32x32x16_bf16(ka, qr[d0], p0, 0, 0, 0);
                p1 = __builtin_amdgcn_mfma_f32_32x32x16_bf16(kb, qr[d0], p1, 0, 0, 0); }
#pragma unroll
            for (int r = 0; r < 16; ++r) { p0[r] = __builtin_amdgcn_exp2f(p0[r]); p1[r] = __builtin_amdgcn_exp2f(p1[r]); }
            if (k0 + 63 > qw0) {
                const int dq = qrow - k0;
#pragma unroll
                for (int r = 0; r < 16; ++r) { const int kk = crow(r, hi); if (kk > dq) p0[r] = 0.f; if (kk + 32 > dq) p1[r] = 0.f; }
            }
            float sacc = 0.f;
#pragma unroll
            for (int r = 0; r < 16; ++r) sacc += p0[r] + p1[r];
            lsum += sacc;
            bf16x8 pw[4];
#pragma unroll
            for (int ks = 0; ks < 4; ++ks) { v4u w;
                if (ks < 2) { w.x = pk2(p0[8 * ks + 0], p0[8 * ks + 1]); w.y = pk2(p0[8 * ks + 2], p0[8 * ks + 3]); w.z = pk2(p0[8 * ks + 4], p0[8 * ks + 5]); w.w = pk2(p0[8 * ks + 6], p0[8 * ks + 7]); }
                else { const int k2 = ks - 2; w.x = pk2(p1[8 * k2 + 0], p1[8 * k2 + 1]); w.y = pk2(p1[8 * k2 + 2], p1[8 * k2 + 3]); w.z = pk2(p1[8 * k2 + 4], p1[8 * k2 + 5]); w.w = pk2(p1[8 * k2 + 6], p1[8 * k2 + 7]); }
                pw[ks] = __builtin_bit_cast(bf16x8, w); }
#pragma unroll
            for (int d0 = 0; d0 < 4; ++d0)
#pragma unroll
                for (int ks = 0; ks < 4; ++ks) { const s16x4 lo = vtr(vp + d0 * 4096 + ks * 1024), hv = vtr(vp + d0 * 4096 + ks * 1024 + 512);
                    const bf16x8 vf = (bf16x8){lo[0], lo[1], lo[2], lo[3], hv[0], hv[1], hv[2], hv[3]};
                    o[d0] = __builtin_amdgcn_mfma_f32_32x32x16_bf16(pw[ks], vf, o[d0], 0, 0, 0); }
        }
        base += s64;
        slot = (slot == NSLOT - 1) ? 0 : slot + 1;
    }
    ATT_WAIT_BAR(0);
    LAS float* lw = (LAS float*)(lds + LW_OFF) + wid * 32;
    { auto rr = __builtin_amdgcn_permlane32_swap(__float_as_uint(lsum), __float_as_uint(lsum), false, false); lsum = __uint_as_float(rr[0]) + __uint_as_float(rr[1]); }
    if (hi == 0) lw[r32] = lsum;
    LDS_WAIT();
    LAS float* X = (LAS float*)lds + qs * 32 * XSTR;
#pragma unroll
    for (int r = 0; r < 16; ++r) { const float rl = 1.0f / lw[crow(r, hi)];
#pragma unroll
        for (int d0 = 0; d0 < 4; ++d0) o[d0][r] *= rl; }
    if (c == 1) {
#pragma unroll
        for (int r = 0; r < 16; ++r)
#pragma unroll
            for (int d0 = 0; d0 < 4; ++d0) X[crow(r, hi) * XSTR + d0 * 32 + r32] = o[d0][r];
    }
    ATT_WAIT_BAR(0);
    if (c == 0) {
#pragma unroll
        for (int r = 0; r < 16; ++r)
#pragma unroll
            for (int d0 = 0; d0 < 4; ++d0) { LAS float* px = X + crow(r, hi) * XSTR + d0 * 32 + r32; const float a = o[d0][r] - lam * (*px); *px = a; }
        LDS_WAIT(); asm volatile("" ::: "memory");
        const LAS f32x4* rp = (const LAS f32x4*)(X + r32 * XSTR + hi * 64);
        f32x4 av[16]; float ss = 0.f;
#pragma unroll
        for (int j = 0; j < 16; ++j) { av[j] = rp[j]; ss += (av[j].x * av[j].x + av[j].y * av[j].y) + (av[j].z * av[j].z + av[j].w * av[j].w); }
        { auto rr = __builtin_amdgcn_permlane32_swap(__float_as_uint(ss), __float_as_uint(ss), false, false); ss = __uint_as_float(rr[0]) + __uint_as_float(rr[1]); }
        const float rs = 0.8f / sqrtf(ss * (1.0f / 128.0f) + EPS);
        bf16* op = MIX + (rowbase + qrow) * 2048 + h * 128 + hi * 64;
#pragma unroll
        for (int j = 0; j < 8; ++j) { const f32x4 g0 = *(const f32x4*)(subg + hi * 64 + 8 * j), g1 = *(const f32x4*)(subg + hi * 64 + 8 * j + 4); const f32x4 a0 = av[2 * j] * rs * g0, a1 = av[2 * j + 1] * rs * g1;
            v4u w; w.x = pk2(a0.x, a0.y); w.y = pk2(a0.z, a0.w); w.z = pk2(a1.x, a1.y); w.w = pk2(a1.z, a1.w); *(v4u*)(op + 8 * j) = w; }
    }
    ATT_WAIT_BAR(0);
#undef ATT_DMA
}
}


#ifndef DBG_NAIVE_ATTN
#define DBG_NAIVE_ATTN 0
#endif
#if DBG_NAIVE_ATTN
__device__ __forceinline__ void naive_attn_row(int b, int h, int q, const bf16* Q, const bf16* K, const bf16* V, bf16* MIX, const float* subg, float lam, LAS float* S, int lane) {
    const size_t rowbase = (size_t)b * SEQ; const float slope2 = exp2f(-(float)(h + 1)) * 1.4426950408889634f;
    for (int c = 0; c < 2; ++c) {
        float qv[64];
        const bf16* qp = Q + (rowbase + q) * 1024 + h * 128 + c * 64;
#pragma unroll
        for (int d = 0; d < 64; d += 2) { const unsigned u = *(const unsigned*)(qp + d); qv[d] = bflo(u); qv[d + 1] = bfhi(u); }
        for (int key = lane; key <= q; key += 64) { const bf16* kp = K + (rowbase + key) * 1024 + h * 128 + c * 64; float s = 0.f;
#pragma unroll
            for (int d = 0; d < 64; d += 2) { const unsigned u = *(const unsigned*)(kp + d); s += qv[d] * bflo(u) + qv[d + 1] * bfhi(u); }
            S[c * 2048 + key] = s - slope2 * (float)(q - key); }
    }
    LDS_WAIT();
    float linv[2];
    for (int c = 0; c < 2; ++c) { float m = -1e30f; for (int key = lane; key <= q; key += 64) m = fmaxf(m, S[c * 2048 + key]); m = wave_max(m);
        float l = 0.f; for (int key = lane; key <= q; key += 64) { const float p = exp2f(S[c * 2048 + key] - m); S[c * 2048 + key] = p; l += p; } linv[c] = 1.0f / wave_sum(l); }
    for (int key = lane; key <= q; key += 64) S[key] = S[key] * linv[0] - lam * S[2048 + key] * linv[1];
    LDS_WAIT();
    float o0 = 0.f, o1 = 0.f; const bf16* vp = V + rowbase * 1024 + h * 128 + lane;
    for (int key = 0; key <= q; ++key) { const float a = S[key]; o0 += a * __uint_as_float((unsigned)vp[(size_t)key * 1024] << 16); o1 += a * __uint_as_float((unsigned)vp[(size_t)key * 1024 + 64] << 16); }
    const float ss = wave_sum(o0 * o0 + o1 * o1); const float rs = 0.8f / sqrtf(ss * (1.0f / 128.0f) + EPS);
    bf16* op = MIX + (rowbase + q) * 2048 + h * 128 + lane;
    op[0] = (bf16)(pk2(o0 * rs * subg[lane], 0.f) & 0xffffu); op[64] = (bf16)(pk2(o1 * rs * subg[lane + 64], 0.f) & 0xffffu);
    LDS_WAIT();
}
#endif

__device__ __forceinline__ unsigned ord_key(float f) { const unsigned u = __float_as_uint(f); return (u & 0x80000000u) ? ~u : (u | 0x80000000u); }
__device__ __forceinline__ float ord_val(unsigned k) { return __uint_as_float((k & 0x80000000u) ? (k ^ 0x80000000u) : ~k); }
#define CE_DESC(a, b) do { const unsigned hi__ = max((a), (b)), lo__ = min((a), (b)); (a) = hi__; (b) = lo__; } while (0)
__device__ __forceinline__ void sort16_desc(unsigned (&v)[16]) {
#pragma unroll
    for (int k = 2; k <= 16; k <<= 1)
#pragma unroll
        for (int j = k >> 1; j > 0; j >>= 1)
#pragma unroll
            for (int i = 0; i < 16; ++i) { const int l = i ^ j; if (l > i) { if ((i & k) == 0) CE_DESC(v[i], v[l]); else CE_DESC(v[l], v[i]); } }
}
__device__ __forceinline__ void merge16_desc_rev(unsigned (&a)[16], const unsigned (&brev)[16]) {
#pragma unroll
    for (int i = 0; i < 16; ++i) a[i] = max(a[i], brev[i]);
#pragma unroll
    for (int j = 8; j > 0; j >>= 1)
#pragma unroll
        for (int i = 0; i < 16; ++i) { const int l = i ^ j; if (l > i) CE_DESC(a[i], a[l]); }
}

constexpr int P5_LST_OFF = 65536, P5_TAB_OFF = P5_LST_OFF + 16384;
__device__ __forceinline__ void peer_topk_item(int tile, int h, const bf16* QP, const float* SSQ, int* EIDX, float* EGATE, float* RSTD, LAS char* lds) {
    const int tid = threadIdx.x, lane = tid & 63, r32 = lane & 31, hi = lane >> 5, wid = __builtin_amdgcn_readfirstlane(tid >> 6);
    LAS unsigned* LST = (LAS unsigned*)(lds + P5_LST_OFF);
    const LAS unsigned char* TAB = (const LAS unsigned char*)(lds + P5_TAB_OFF);
    const int tok0 = tile * 128;
    {
        const int c = wid >> 2, tb = wid & 3;
        bf16x8 qf[8];
        const bf16* qp = QP + (size_t)(tok0 + tb * 32 + r32) * 2048 + h * 256 + c * 128 + hi * 8;
#pragma unroll
        for (int s = 0; s < 8; ++s) qf[s] = *(const bf16x8*)(qp + 16 * s);
        const LAS char* sp = lds + c * 32768 + hi * 2048 + r32 * 16;
        unsigned best[16];
#pragma unroll
        for (int kb = 0; kb < 4; ++kb) { f32x16 acc = f32x16{};
#pragma unroll
            for (int s = 0; s < 8; ++s) { const bf16x8 sf = *(const LAS bf16x8*)(sp + s * 4096 + kb * 512); acc = __builtin_amdgcn_mfma_f32_32x32x16_bf16(sf, qf[s], acc, 0, 0, 0); }
            unsigned v[16];
#pragma unroll
            for (int r = 0; r < 16; ++r) v[r] = (ord_key(acc[r]) & ~0x7Fu) | (unsigned)(32 * kb + (r & 3) + 8 * (r >> 2)) | (unsigned)(hi << 2);
            sort16_desc(v);
            if (kb == 0) {
#pragma unroll
                for (int i = 0; i < 16; ++i) best[i] = v[i];
            } else { unsigned vr[16];
#pragma unroll
                for (int i = 0; i < 16; ++i) vr[i] = v[15 - i];
                merge16_desc_rev(best, vr); } }
        {
            unsigned br[16];
#pragma unroll
            for (int i = 0; i < 16; ++i) br[i] = (unsigned)__shfl_xor((int)best[15 - i], 32);
            merge16_desc_rev(best, br); }
        if (hi == 0) { LAS unsigned* lrow = LST + (c * 128 + tb * 32 + r32) * 16;
#pragma unroll
            for (int i = 0; i < 4; ++i) *(LAS v4u*)(lrow + 4 * i) = (v4u){best[4 * i], best[4 * i + 1], best[4 * i + 2], best[4 * i + 3]}; }
    }
    __syncthreads();
    {
        const int token = tid >> 2, q = tid & 3;
        const LAS unsigned* l1 = LST + token * 16; const LAS unsigned* l2 = LST + (128 + token) * 16;
        unsigned v[16];
#pragma unroll
        for (int m = 0; m < 13; ++m) { const int n = 4 * m + q; const unsigned pid = TAB[n < 50 ? n : 0]; const unsigned a = l1[pid >> 4], b2 = l2[pid & 15u];
            const unsigned key = (ord_key(ord_val(a & ~0x7Fu) + ord_val(b2 & ~0x7Fu)) & ~0xFFu) | pid; v[m] = n < 50 ? key : 0u; }
        v[13] = 0u; v[14] = 0u; v[15] = 0u;
        sort16_desc(v);
#pragma unroll
        for (int w = 1; w <= 2; w <<= 1) { unsigned br[16];
#pragma unroll
            for (int i = 0; i < 16; ++i) br[i] = (unsigned)__shfl_xor((int)v[15 - i], w);
            merge16_desc_rev(v, br); }
        const int t = tok0 + token;
        const f32x4 p0 = *(const f32x4*)(SSQ + (size_t)t * 32 + 8 * q), p1 = *(const f32x4*)(SSQ + (size_t)t * 32 + 8 * q + 4);
        float ssq = ((p0.x + p0.y) + (p0.z + p0.w)) + ((p1.x + p1.y) + (p1.z + p1.w));
        ssq += __shfl_xor(ssq, 1); ssq += __shfl_xor(ssq, 2);
        const float rstd = 1.0f / sqrtf(ssq * (1.0f / DM) + EPS);
        if (h == 0 && q == 0) RSTD[t] = rstd;
        const unsigned p_top = v[0] & 0xFFu; const float vmax = (ord_val(l1[p_top >> 4] & ~0x7Fu) + ord_val(l2[p_top & 15u] & ~0x7Fu)) * rstd;
        float ev[4]; int ex[4]; float es = 0.f;
#pragma unroll
        for (int m = 0; m < 4; ++m) { const unsigned kk = q == 0 ? v[m] : q == 1 ? v[4 + m] : q == 2 ? v[8 + m] : v[12 + m];
            const unsigned pid = kk & 0xFFu; const unsigned a = l1[pid >> 4], b2 = l2[pid & 15u];
            const float sv = (ord_val(a & ~0x7Fu) + ord_val(b2 & ~0x7Fu)) * rstd;
            ev[m] = __expf(sv - vmax); es += ev[m]; ex[m] = (int)((a & 0x7Fu) * 128u + (b2 & 0x7Fu)); }
        es += __shfl_xor(es, 1); es += __shfl_xor(es, 2);
        const float inv = 1.0f / es;
        *(int4*)(EIDX + (size_t)t * 128 + h * 16 + 4 * q) = make_int4(ex[0], ex[1], ex[2], ex[3]);
        *(f32x4*)(EGATE + (size_t)t * 128 + h * 16 + 4 * q) = (f32x4){ev[0] * inv, ev[1] * inv, ev[2] * inv, ev[3] * inv};
    }
    __syncthreads();
}

__device__ __forceinline__ f32x2 dot16_fp8(const v4u u, const f32x2* h, f32x2 acc) {
#pragma unroll
    for (int w = 0; w < 4; ++w) { const unsigned d = w == 0 ? u.x : w == 1 ? u.y : w == 2 ? u.z : u.w;
        const f32x2 f0 = __builtin_amdgcn_cvt_pk_f32_fp8((int)d, false), f1 = __builtin_amdgcn_cvt_pk_f32_fp8((int)d, true);
        acc = __builtin_elementwise_fma(h[2 * w], f0, acc); acc = __builtin_elementwise_fma(h[2 * w + 1], f1, acc); }
    return acc;
}
__device__ __forceinline__ void axpy16_fp8(const v4u v, f32x2 a2, f32x2* o) {
#pragma unroll
    for (int w = 0; w < 4; ++w) { const unsigned d = w == 0 ? v.x : w == 1 ? v.y : w == 2 ? v.z : v.w;
        const f32x2 f0 = __builtin_amdgcn_cvt_pk_f32_fp8((int)d, false), f1 = __builtin_amdgcn_cvt_pk_f32_fp8((int)d, true);
        o[2 * w] = __builtin_elementwise_fma(a2, f0, o[2 * w]); o[2 * w + 1] = __builtin_elementwise_fma(a2, f1, o[2 * w + 1]); }
}
struct PItem { int t, s; };
__device__ __forceinline__ PItem peer_item(int q, int nq, int nper, int tb, int tstride, int xl) {
    const int j = (q < nq ? q : nq - 1) >> 1; PItem it; const int r = j >= nper ? 1 : 0; it.s = 8 * r + xl; const int t = tb + (j - r * nper) * tstride; it.t = t < T ? t : T - 1; return it; }
__device__ __forceinline__ void pe_idx8(const PItem it, int hh, const int* EIDX, int g, int (&ex)[8]) {
#pragma unroll
    for (int i = 0; i < 2; ++i) { const int4 v = *(const int4*)(EIDX + (size_t)it.t * 128 + g * 16 + 8 * hh + 4 * i); ex[4 * i] = v.x; ex[4 * i + 1] = v.y; ex[4 * i + 2] = v.z; ex[4 * i + 3] = v.w; }
}
__device__ __forceinline__ void pe_gather8(const PItem it, const unsigned char* TB, int sub, const int (&ex)[8], v4u (&uv)[8]) {
    const unsigned char* ub = TB + (size_t)it.s * 16384 * 128 + 16 * sub;
#pragma unroll
    for (int i = 0; i < 8; ++i) uv[i] = *(const v4u*)(ub + (size_t)ex[i] * 128);
}
__device__ __forceinline__ int sdot4(unsigned a, unsigned b, int acc) { return __builtin_amdgcn_sdot4((int)a, (int)b, acc, false); }
__device__ __forceinline__ void pu_acc8(const v4u (&uv)[8], const v4u ha, const v4u hb, int hs8, int (&r)[8]) {
#pragma unroll
    for (int i = 0; i < 8; ++i) { int a = -hs8;
        a = sdot4(uv[i].x & 0x0F0F0F0Fu, ha.x, a); a = sdot4((uv[i].x >> 4) & 0x0F0F0F0Fu, ha.y, a); a = sdot4(uv[i].y & 0x0F0F0F0Fu, ha.z, a); a = sdot4((uv[i].y >> 4) & 0x0F0F0F0Fu, ha.w, a);
        a = sdot4(uv[i].z & 0x0F0F0F0Fu, hb.x, a); a = sdot4((uv[i].z >> 4) & 0x0F0F0F0Fu, hb.y, a); a = sdot4(uv[i].w & 0x0F0F0F0Fu, hb.z, a); r[i] = sdot4((uv[i].w >> 4) & 0x0F0F0F0Fu, hb.w, a); }
}
__device__ __forceinline__ void pu_store(const PItem it, bool valid, float* PART, int lane, const int (&rlo)[8], const int (&rhi)[8]) {
    const int g = lane >> 3, sub = lane & 7;
    int r[16];
#pragma unroll
    for (int i = 0; i < 8; ++i) { r[i] = rlo[i]; r[8 + i] = rhi[i]; }
#pragma unroll
    for (int w = 4, n = 8; w >= 1; w >>= 1, n >>= 1) { const bool up = (lane & w) != 0;
#pragma unroll
        for (int j = 0; j < n; ++j) { const int a = r[j], b2 = r[j + n]; const int keep = up ? b2 : a, send = up ? a : b2; r[j] = keep + __shfl_xor(send, w); } }
    const int i0 = 8 * ((sub >> 2) & 1) + 4 * ((sub >> 1) & 1) + 2 * (sub & 1);
    if (valid) *(f32x2*)(PART + ((size_t)it.s * T + it.t) * 128 + g * 16 + i0) = (f32x2){(float)r[0], (float)r[1]};
}
__device__ __forceinline__ PItem peer_item1(int q, int nq, int tb, int tstride, int xl) { const int j = (q < nq ? q : nq - 1) >> 1; PItem it; it.s = xl; const int t = tb + j * tstride; it.t = t < T ? t : T - 1; return it; }
__device__ __forceinline__ void peer_u_stage(int nper, int tb, int tstride, int xl, const unsigned char* H8, const unsigned char* U8, const int* EIDX, float* PART, int lane) {
    const int g = lane >> 3, sub = lane & 7, NQ = 2 * nper;
    int ex0[8], ex1[8], ex2[8], ex3[8]; v4u uv0[8], uv1[8], uv2[8], uv3[8], ha0, ha1, ha2, ha3, hb0, hb1, hb2, hb3; int rs[8];
#define PU_I(q, X) do { const PItem it_ = peer_item1((q), NQ, tb, tstride, xl); pe_idx8(it_, (X) & 1, EIDX, g, ex##X); } while (0)
#define PU_G(q, X) do { const PItem it_ = peer_item1((q), NQ, tb, tstride, xl); pe_gather8(it_, U8, sub, ex##X, uv##X); const unsigned char* hp_ = H8 + (size_t)it_.t * 2048 + 256 * it_.s + 32 * sub; ha##X = *(const v4u*)hp_; hb##X = *(const v4u*)(hp_ + 16); } while (0)
#define PU_F(q, X) do { const PItem it_ = peer_item1((q), NQ, tb, tstride, xl); int hs_ = sdot4(ha##X.x, 0x01010101u, 0); hs_ = sdot4(ha##X.y, 0x01010101u, hs_); hs_ = sdot4(ha##X.z, 0x01010101u, hs_); hs_ = sdot4(ha##X.w, 0x01010101u, hs_); \
        hs_ = sdot4(hb##X.x, 0x01010101u, hs_); hs_ = sdot4(hb##X.y, 0x01010101u, hs_); hs_ = sdot4(hb##X.z, 0x01010101u, hs_); hs_ = sdot4(hb##X.w, 0x01010101u, hs_); \
        if (((X) & 1) == 0) pu_acc8(uv##X, ha##X, hb##X, 8 * hs_, rs); else { int rh_[8]; pu_acc8(uv##X, ha##X, hb##X, 8 * hs_, rh_); \
        pu_store(it_, (q) < NQ && (tb + ((q) >> 1) * tstride) < T, PART, lane, rs, rh_); } } while (0)
    PU_I(0, 0); PU_I(1, 1); PU_I(2, 2); PU_I(3, 3); PU_G(0, 0); PU_G(1, 1); PU_G(2, 2);
#pragma unroll 1
    for (int q = 0; q < NQ; q += 4) {
        PU_F(q, 0);     PU_G(q + 3, 3); PU_I(q + 4, 0);
        PU_F(q + 1, 1); PU_G(q + 4, 0); PU_I(q + 5, 1);
        PU_F(q + 2, 2); PU_G(q + 5, 1); PU_I(q + 6, 2);
        PU_F(q + 3, 3); PU_G(q + 6, 2); PU_I(q + 7, 3);
    }
#undef PU_I
#undef PU_G
#undef PU_F
}
__device__ __forceinline__ void pv_acc8(const v4u (&vv)[8], const float (&av)[8], f32x2 (&o)[8]) {
#pragma unroll
    for (int i = 0; i < 8; ++i) axpy16_fp8(vv[i], (f32x2){av[i], av[i]}, o);
}
__device__ __forceinline__ void pv_store(const PItem it, bool valid, float* out, int lane, f32x2 (&o)[8], const f32x2 x1) {
    const int g = lane >> 3, sub = lane & 7;
#pragma unroll
    for (int w = 32, n = 4; w >= 8; w >>= 1, n >>= 1) { const bool up = (lane & w) != 0;
#pragma unroll
        for (int j = 0; j < n; ++j) { const f32x2 a = o[j], b2 = o[j + n]; const f32x2 keep = up ? b2 : a, send = up ? a : b2; o[j] = (f32x2){keep.x + __shfl_xor(send.x, w), keep.y + __shfl_xor(send.y, w)}; } }
    const int c0 = 8 * ((g >> 2) & 1) + 4 * ((g >> 1) & 1) + 2 * (g & 1);
    if (valid) *(f32x2*)(out + (size_t)it.t * 2048 + 128 * it.s + 16 * sub + c0) = (f32x2){x1.x + o[0].x, x1.y + o[0].y};
}
__device__ __forceinline__ void peer_v_stage(int nper, int tb, int tstride, int xl, const unsigned char* V8, const int* EIDX, const float* ACT, float* out, int lane) {
    const int g = lane >> 3, sub = lane & 7, NQ = 4 * nper;
    const int c0 = 8 * ((g >> 2) & 1) + 4 * ((g >> 1) & 1) + 2 * (g & 1);
    int ex0[8], ex1[8], ex2[8], ex3[8]; v4u vv0[8], vv1[8], vv2[8], vv3[8]; float av0[8], av1[8], av2[8], av3[8]; f32x2 x1a, x1b; f32x2 o[8];
#define PV_I(q, X) do { const PItem it_ = peer_item((q), NQ, nper, tb, tstride, xl); pe_idx8(it_, (X) & 1, EIDX, g, ex##X); } while (0)
#define PV_G(q, X, XV) do { const PItem it_ = peer_item((q), NQ, nper, tb, tstride, xl); pe_gather8(it_, V8, sub, ex##X, vv##X); \
        { const f32x4 a_ = *(const f32x4*)(ACT + (size_t)it_.t * 128 + g * 16 + 8 * ((X) & 1)), b_ = *(const f32x4*)(ACT + (size_t)it_.t * 128 + g * 16 + 8 * ((X) & 1) + 4); \
          av##X[0] = a_.x; av##X[1] = a_.y; av##X[2] = a_.z; av##X[3] = a_.w; av##X[4] = b_.x; av##X[5] = b_.y; av##X[6] = b_.z; av##X[7] = b_.w; } \
        if ((X) & 1) XV = *(const f32x2*)(out + (size_t)it_.t * 2048 + 128 * it_.s + 16 * sub + c0); } while (0)
#define PV_F(q, X, XV) do { const PItem it_ = peer_item((q), NQ, nper, tb, tstride, xl); if (((X) & 1) == 0) { _Pragma("unroll") for (int m_ = 0; m_ < 8; ++m_) o[m_] = (f32x2){0.f, 0.f}; } \
        pv_acc8(vv##X, av##X, o); if ((X) & 1) pv_store(it_, (q) < NQ && (tb + ((((q) >> 1) % nper)) * tstride) < T, out, lane, o, XV); } while (0)
    PV_I(0, 0); PV_I(1, 1); PV_I(2, 2); PV_I(3, 3); PV_G(0, 0, x1a); PV_G(1, 1, x1a); PV_G(2, 2, x1b);
#pragma unroll 1
    for (int q = 0; q < NQ; q += 4) {
        PV_F(q, 0, x1a);     PV_G(q + 3, 3, x1b); PV_I(q + 4, 0);
        PV_F(q + 1, 1, x1a); PV_G(q + 4, 0, x1a); PV_I(q + 5, 1);
        PV_F(q + 2, 2, x1b); PV_G(q + 5, 1, x1a); PV_I(q + 6, 2);
        PV_F(q + 3, 3, x1b); PV_G(q + 6, 2, x1b); PV_I(q + 7, 3);
    }
#undef PV_I
#undef PV_G
#undef PV_F
}

struct Args { const float* in[17]; float* out; unsigned char* ws; int ph_lo, ph_hi; };
__global__ void __launch_bounds__(NTHREADS, 2) mk_fwd(Args args) {
    extern __shared__ __attribute__((aligned(16))) unsigned char lds_raw[];
    LAS unsigned char* lds = (LAS unsigned char*)lds_raw;
    const int tid = threadIdx.x, lane = tid & 63, wave = __builtin_amdgcn_readfirstlane(tid >> 6);
    const int G = gridDim.x, bx = blockIdx.x;
    const int vcu = (G % 8 == 0) ? (bx % 8) * (G / 8) + bx / 8 : bx;
    unsigned char* ws = args.ws;
    const float* x = args.in[0]; const float* attn_g = args.in[1]; const float* w_in = args.in[2]; const float* qg = args.in[3]; const float* kg = args.in[4];
    const float* lq1 = args.in[5]; const float* lk1 = args.in[6]; const float* lq2 = args.in[7]; const float* lk2 = args.in[8]; const float* subg = args.in[9];
    const float* conv_w = args.in[10]; const float* w_out = args.in[11]; const float* ffn_g = args.in[12]; const float* w_q = args.in[13]; const float* subkeys = args.in[14];
    const float* peer_u = args.in[15]; const float* peer_v = args.in[16];
    float* out = args.out;
    bf16* WtIn = (bf16*)(ws + WS_WIN); bf16* WtOut = (bf16*)(ws + WS_WOUT); bf16* WtQ = (bf16*)(ws + WS_WQ); bf16* SK = (bf16*)(ws + WS_SK);
    float* SSQ = (float*)(ws + WS_SSQ); int* EIDX = (int*)(ws + WS_EIDX); float* EGATE = (float*)(ws + WS_EGATE); float* RSTD = (float*)(ws + WS_RSTD);
    bf16* XN = (bf16*)(ws + WS_XN); bf16* MIX = XN;
    bf16* Qb = (bf16*)(ws + WS_Q); bf16* Kb = (bf16*)(ws + WS_K); bf16* Vb = (bf16*)(ws + WS_V); bf16* QP = Qb;
    bf16* CB = (bf16*)(ws + WS_CB); bf16* CC = (bf16*)(ws + WS_CC); bf16* CX = (bf16*)(ws + WS_CX); bf16* A2 = CB;
    unsigned char* U8 = ws + WS_UT; unsigned char* V8 = ws + WS_VT;
    volatile LAS unsigned* MISC = (volatile LAS unsigned*)(lds + MISC_OFF);
    if (tid < 16) MISC[tid] = 0u;
    __syncthreads();
    XcdBarrier bar = xcd_barrier_post((unsigned*)(ws + WS_CTL) + CW_BAR, MISC + 8);
    const int lo = args.ph_lo, hi_ph = args.ph_hi;
#ifndef DBG_DUP
#define DBG_DUP -1
#endif
#ifndef DBG_MASK
#define DBG_MASK 0xfff
#endif
#define IN(k) (((DBG_MASK >> (k)) & 1) && lo <= (k) && (k) < hi_ph)
#define REPS(k) for (int rep_ = 0; rep_ < ((DBG_DUP == (k)) ? 2 : 1); ++rep_)
#define SEAM(k) do { if (IN(k) && IN((k) + 1)) xcd_barrier(bar); } while (0)
    const int gw = vcu * NWAVES + wave, NGW = G * NWAVES;
    const size_t gtid = (size_t)bx * NTHREADS + tid, nthr = (size_t)G * NTHREADS;

    if (IN(0)) REPS(0) {
        LAS float* scr = (LAS float*)(lds + wave * 16384);
        constexpr int I_IN = (DM / 64) * (INC / 32), I_SQ = (DM / 64) * (DM / 32);
        for (int it = gw; it < I_IN + 2 * I_SQ; it += NGW) {
            if (it < I_IN) p0_transpose_item(w_in, DM, INC, WtIn, scr, it, lane, true);
            else if (it < I_IN + I_SQ) p0_transpose_item(w_out, DM, DM, WtOut, scr, it - I_IN, lane, false);
            else p0_transpose_item(w_q, DM, DM, WtQ, scr, it - I_IN - I_SQ, lane, false);
        }
        for (int m = gw; m < T; m += NGW) rms_row_to_bf16(x + (size_t)m * DM, attn_g, XN + (size_t)m * DM, lane);
        cvt_bf16_stream(subkeys, SK, (size_t)PEH * 2 * PNK * 128 / 8, gtid, nthr);
        {
            const float sig = table_std16(peer_u, (LAS float*)(lds + MISC_OFF + 64), tid); const float step = 0.335f * sig;
            if (bx == 0 && tid == 0) ((float*)(ws + WS_RSTD))[T] = step;
            cvt_i4_slices(peer_u, U8, 1.0f / step, gtid, nthr); }
        cvt_fp8_slices(peer_v, V8, V8_SCALE, gtid, nthr);
    }
    SEAM(0);
    if (IN(1)) REPS(1) {
        pg8::Gemm g{XN, WtIn, T, INC, DM}; pg8::StaticOrder S; S.init(T, INC, G, bx);
        pg8::EpiProj E{Qb, qg, kg};
        pg8::gemm_phase<pg8::EpiProj, pg8::StaticOrder, true, true>(lds, g, S, E);
    }
    SEAM(1);
    if (IN(2)) REPS(2) {
        float a = lq1[lane] * lk1[lane], b2 = lq2[lane] * lk2[lane];
        a = wave_sum(a); b2 = wave_sum(b2);
        const float lam = expf(a) - expf(b2) + 0.2f;
        const float mq = wave_max(fabsf(qg[lane])), mk = wave_max(fabsf(kg[lane]));
        const float M2 = 64.f * C2 * mq * mk;
#if DBG_NAIVE_ATTN
        for (int r = gw; r < NB * NH * SEQ; r += NGW) naive_attn_row(r >> 14, (r >> 11) & 7, r & 2047, Qb, Kb, Vb, MIX, subg, lam, (LAS float*)(lds + wave * 16384), lane);
        if (0)
#endif
        for (int v = vcu; v < NB * NH * 4; v += G) {
            const int bh = v >> 2, s = v & 3, b = bh >> 3, h = bh & 7;
#pragma unroll 1
            for (int i = 0; i < 4; ++i) { const int qblk = (i == 0) ? s : (i == 1) ? 7 - s : (i == 2) ? 8 + s : 15 - s;
                att::attn_unit(b, h, qblk, Qb, Kb, Vb, MIX, subg, lam, M2, (LAS char*)lds); }
        }
        for (size_t it = gtid; it < (size_t)(T / 16) * 128; it += nthr) {
            const int cg8 = (int)(it & 127), chunk = (int)(it >> 7), t0 = chunk * 16, col = cg8 * 8;
            f32x4 w0a = *(const f32x4*)(conv_w + col), w0b = *(const f32x4*)(conv_w + col + 4), w1a = *(const f32x4*)(conv_w + 1024 + col), w1b = *(const f32x4*)(conv_w + 1024 + col + 4),
                  w2a = *(const f32x4*)(conv_w + 2048 + col), w2b = *(const f32x4*)(conv_w + 2048 + col + 4);
            float u1[8], u2[8];
#pragma unroll
            for (int i = 0; i < 8; ++i) { u1[i] = 0.f; u2[i] = 0.f; }
            if ((t0 % SEQ) != 0) {
                const v4u c1 = *(const v4u*)(CC + (size_t)(t0 - 1) * 1024 + col), x1v = *(const v4u*)(CX + (size_t)(t0 - 1) * 1024 + col), c2 = *(const v4u*)(CC + (size_t)(t0 - 2) * 1024 + col), x2v = *(const v4u*)(CX + (size_t)(t0 - 2) * 1024 + col);
                u1[0] = bflo(c1.x) * bflo(x1v.x); u1[1] = bfhi(c1.x) * bfhi(x1v.x); u1[2] = bflo(c1.y) * bflo(x1v.y); u1[3] = bfhi(c1.y) * bfhi(x1v.y); u1[4] = bflo(c1.z) * bflo(x1v.z); u1[5] = bfhi(c1.z) * bfhi(x1v.z); u1[6] = bflo(c1.w) * bflo(x1v.w); u1[7] = bfhi(c1.w) * bfhi(x1v.w);
                u2[0] = bflo(c2.x) * bflo(x2v.x); u2[1] = bfhi(c2.x) * bfhi(x2v.x); u2[2] = bflo(c2.y) * bflo(x2v.y); u2[3] = bfhi(c2.y) * bfhi(x2v.y); u2[4] = bflo(c2.z) * bflo(x2v.z); u2[5] = bfhi(c2.z) * bfhi(x2v.z); u2[6] = bflo(c2.w) * bflo(x2v.w); u2[7] = bfhi(c2.w) * bfhi(x2v.w);
            }
            const float w0[8] = {w0a.x, w0a.y, w0a.z, w0a.w, w0b.x, w0b.y, w0b.z, w0b.w}, w1[8] = {w1a.x, w1a.y, w1a.z, w1a.w, w1b.x, w1b.y, w1b.z, w1b.w}, w2[8] = {w2a.x, w2a.y, w2a.z, w2a.w, w2b.x, w2b.y, w2b.z, w2b.w};
#pragma unroll 4
            for (int j = 0; j < 16; ++j) { const size_t ro = (size_t)(t0 + j) * 1024 + col;
                const v4u bv = *(const v4u*)(CB + ro), cv = *(const v4u*)(CC + ro), xv = *(const v4u*)(CX + ro);
                float u0[8], bb[8], y[8];
                u0[0] = bflo(cv.x) * bflo(xv.x); u0[1] = bfhi(cv.x) * bfhi(xv.x); u0[2] = bflo(cv.y) * bflo(xv.y); u0[3] = bfhi(cv.y) * bfhi(xv.y); u0[4] = bflo(cv.z) * bflo(xv.z); u0[5] = bfhi(cv.z) * bfhi(xv.z); u0[6] = bflo(cv.w) * bflo(xv.w); u0[7] = bfhi(cv.w) * bfhi(xv.w);
                bb[0] = bflo(bv.x); bb[1] = bfhi(bv.x); bb[2] = bflo(bv.y); bb[3] = bfhi(bv.y); bb[4] = bflo(bv.z); bb[5] = bfhi(bv.z); bb[6] = bflo(bv.w); bb[7] = bfhi(bv.w);
#pragma unroll
                for (int i = 0; i < 8; ++i) { y[i] = bb[i] * (u2[i] * w0[i] + u1[i] * w1[i] + u0[i] * w2[i]); u2[i] = u1[i]; u1[i] = u0[i]; }
                v4u o; o.x = pk2(y[0], y[1]); o.y = pk2(y[2], y[3]); o.z = pk2(y[4], y[5]); o.w = pk2(y[6], y[7]);
                *(v4u*)(MIX + (size_t)(t0 + j) * 2048 + 1024 + col) = o; }
        }
    }
    SEAM(2);
    if (IN(3)) REPS(3) {
        pg8::Gemm g{MIX, WtOut, T, DM, DM}; pg8::StaticOrder S; S.init(T, DM, G, bx);
        pg8::EpiX1 E{x, out, A2, ffn_g, SSQ, ws + WS_H8};
        pg8::gemm_phase<pg8::EpiX1, pg8::StaticOrder, true, true>(lds, g, S, E);
    }
    SEAM(3);
    if (IN(4)) REPS(4) {
        pg8::Gemm g{A2, WtQ, T, DM, DM}; pg8::StaticOrder S; S.init(T, DM, G, bx);
        pg8::EpiBf16<0> E{QP, DM, nullptr, 0, 0, 1.f};
        pg8::gemm_phase<pg8::EpiBf16<0>, pg8::StaticOrder, true, true>(lds, g, S, E);
    }
    SEAM(4);
    if (IN(5)) REPS(5) {
        if (tid < 64) {
            int n = tid, i = 0;
#pragma unroll 1
            for (; i < 16; ++i) { const int len = 16 / (i + 1); if (n < len) break; n -= len; }
            ((LAS unsigned char*)(lds + P5_TAB_OFF))[tid] = (unsigned char)(i < 16 ? ((i << 4) | n) : 0);
        }
        int cur_h = -1;
        for (int it = vcu; it < (T / 128) * PEH; it += G) { const int h = it & 7;
            if (h != cur_h) {
                __syncthreads();
                for (int i = tid; i < 4096; i += NTHREADS) { const int ch = i & 15, key = (i >> 4) & 127, c = i >> 11;
                    *(LAS v4u*)(lds + c * 32768 + ch * 2048 + key * 16) = *(const v4u*)(SK + (size_t)((h * 2 + c) * 128 + key) * 128 + ch * 8); }
                cur_h = h; __syncthreads(); }
            peer_topk_item(it >> 3, h, QP, SSQ, EIDX, EGATE, RSTD, (LAS char*)lds); }
    }
    SEAM(5);
    if (IN(6)) {
        float* PART = (float*)(ws + WS_PART);
        const int tstride = (G >> 3) * NWAVES, nper = (T + tstride - 1) / tstride;
        peer_u_stage(nper, (bx >> 3) * NWAVES + wave, tstride, bx & 7, ws + WS_H8, U8, EIDX, PART, lane);
    }
    SEAM(6);
    if (IN(7)) {
        const float* PART = (const float*)(ws + WS_PART); float* ACT = (float*)(ws + WS_ACT);
        for (size_t i = gtid; i < (size_t)T * 128; i += nthr) { float z = 0.f;
#pragma unroll
            for (int s = 0; s < 8; ++s) z += PART[(size_t)s * T * 128 + i];
            z *= RSTD[i >> 7] * (RSTD[T] * (1.0f / H8_SCALE));
            ACT[i] = 0.5f * z * (1.0f + erff(z * 0.70710678118654752f)) * EGATE[i] * (1.0f / V8_SCALE); }
    }
    SEAM(7);
    if (IN(8)) {
        const float* ACT = (const float*)(ws + WS_ACT);
        const int tstride = (G >> 3) * NWAVES, nper = (T + tstride - 1) / tstride;
#ifdef DBG_VDRY
#pragma unroll 1
        for (int rep = 0; rep < 2; ++rep) peer_v_stage(nper, (bx >> 3) * NWAVES + wave, tstride, bx & 7, V8, EIDX, ACT, out, lane, rep == 0);
#else
        peer_v_stage(nper, (bx >> 3) * NWAVES + wave, tstride, bx & 7, V8, EIDX, ACT, out, lane);
#endif
    }
#undef IN
#undef SEAM
}

extern "C" void kernel_launch(void* const* d_in, const int* in_sizes, int n_in, void* d_out, int out_size, void* d_ws, size_t ws_size, hipStream_t stream) {
    static int grid = 0;
    if (grid == 0) {
        if (n_in != 17 || out_size != T * DM || ws_size < WS_END) { fprintf(stderr, "kernel_launch: unexpected shapes (n_in %d out %d ws %zu)\n", n_in, out_size, ws_size); grid = -1; return; }
        int dev = 0, cus = 0, per_cu = 0;
        if (hipGetDevice(&dev) != hipSuccess || hipDeviceGetAttribute(&cus, hipDeviceAttributeMultiprocessorCount, dev) != hipSuccess) { grid = -1; return; }
        if (hipFuncSetAttribute((const void*)mk_fwd, hipFuncAttributeMaxDynamicSharedMemorySize, LDS_BYTES) != hipSuccess) { fprintf(stderr, "kernel_launch: hipFuncSetAttribute failed\n"); grid = -1; return; }
        if (hipOccupancyMaxActiveBlocksPerMultiprocessor(&per_cu, (const void*)mk_fwd, NTHREADS, LDS_BYTES) != hipSuccess || per_cu < 1) { fprintf(stderr, "kernel_launch: occupancy query says %d blocks per CU\n", per_cu); (void)hipGetLastError(); grid = -1; return; }
        grid = cus;
    }
    if (grid < 0) return;
    if (hipMemsetAsync((char*)d_ws + WS_CTL, 0, CTL_ZERO_BYTES, stream) != hipSuccess) { fprintf(stderr, "kernel_launch: memset failed\n"); return; }
    Args a{};
    for (int i = 0; i < 17; ++i) a.in[i] = (const float*)d_in[i];
    a.out = (float*)d_out; a.ws = (unsigned char*)d_ws;
#if MK_N_LAUNCHES == 1
    a.ph_lo = 0; a.ph_hi = NPHASE;
    void* kargs[] = {&a};
    hipError_t e = hipLaunchCooperativeKernel((const void*)mk_fwd, dim3(grid), dim3(NTHREADS), kargs, LDS_BYTES, stream);
    if (e != hipSuccess) fprintf(stderr, "kernel_launch: cooperative launch failed: %s (grid %d)\n", hipGetErrorString(e), grid);
#else
#ifndef DBG_DUPL
#define DBG_DUPL -1
#endif
    for (int p = 0; p < NPHASE; ++p) { a.ph_lo = p; a.ph_hi = p + 1; for (int r = 0; r < (p == DBG_DUPL ? 2 : 1); ++r) hipLaunchKernelGGL(mk_fwd, dim3(grid), dim3(NTHREADS), LDS_BYTES, stream, a); }
#endif
}
```

```cpp
#include <hip/hip_runtime.h>
#include <hip/hip_cooperative_groups.h>
#include <cstdio>
#include <cstdint>
#include <cmath>
namespace cg = cooperative_groups;
namespace pg8 {
#define PG8_LAS __attribute__((address_space(3)))
typedef unsigned short bf16_t;
typedef short bf16x8 __attribute__((ext_vector_type(8)));
typedef float f32x4 __attribute__((ext_vector_type(4)));
typedef unsigned u32x4 __attribute__((ext_vector_type(4)));
constexpr int BM = 256, BK = 64, HALF = 128, HTB = HALF * BK * 2  , STAGE_BYTES = 8 * HTB, NXCD = 8, WGM = 8;

__host__ __device__ __forceinline__ int lds_byte(int r, int c) { const int st = (r >> 4) * 2 + (c >> 5), rr = r & 15, cc = c & 31, ob = rr * 64 + cc * 2; return st * 1024 + (ob ^ (((ob >> 9) & 1) << 5)); }
__host__ __device__ __forceinline__ void stage_rc(int b, int& R, int& C) { const int st = b / 1024, sb = b % 1024, swz = sb ^ (((sb >> 9) & 1) << 5); R = (st >> 1) * 16 + swz / 64; C = (st & 1) * 32 + (swz % 64) / 2; }
__host__ __device__ __forceinline__ int perm32(int rho) { const int n = rho >> 4, i = rho & 15; return 8 * (i >> 2) + 4 * n + (i & 3); }

struct Unit { int pm, pn; };
struct Gemm { const bf16_t* A; const bf16_t* Bt; int M, N, K; };

struct StaticOrder {
    int nM, nN, nwg, G, c;
    __host__ __device__ void init(int M, int N, int G_, int c_) { nM = M / BM; nN = N / BM; nwg = nM * nN; G = G_; c = c_; }
    __host__ __device__ bool next(int i, Unit& u) const {
        const long L = (long)i * G + c; if (L >= nwg) return false;
        int wgid = (int)L; { const int q = nwg / NXCD, r = nwg % NXCD, xcd = wgid % NXCD, off = wgid / NXCD; wgid = (xcd < r ? xcd * (q + 1) : r * (q + 1) + (xcd - r) * q) + off; }
        const int nig = WGM * nN, gid = wgid / nig, fm = gid * WGM, gsz = (nM - fm) < WGM ? (nM - fm) : WGM;
        u.pm = fm + ((wgid % nig) % gsz); u.pn = (wgid % nig) / gsz; return true;
    }
    __device__ __forceinline__ void a_ready(const Unit&) const {}
    __device__ __forceinline__ void done(const Unit&) const {}
};

__device__ __forceinline__ unsigned cvt_pk_bf16(float lo, float hi) { unsigned r; asm volatile("v_cvt_pk_bf16_f32 %0, %1, %2" : "=v"(r) : "v"(lo), "v"(hi)); return r; }
typedef float f32x2 __attribute__((ext_vector_type(2)));
__device__ __forceinline__ f32x2 gelu_pk(f32x2 v) {
    const f32x2 av = __builtin_elementwise_abs(v), d = av * 0.2316418882f + 1.0f;
    f32x2 t; t.x = __builtin_amdgcn_rcpf(d.x); t.y = __builtin_amdgcn_rcpf(d.y);
    f32x2 q = t * 0.5307027145f + (-0.7265760135f); q = q * t + 0.7107068705f; q = q * t + (-0.142248368f); q = q * t + 0.127414796f; q = q * t;
    const f32x2 s = (v * v) * (-0.72134752044f);
    f32x2 e; e.x = __builtin_amdgcn_exp2f(s.x); e.y = __builtin_amdgcn_exp2f(s.y);
    const f32x2 m = v * (q * e), r = v - m;
    f32x2 o; o.x = v.x < 0.f ? m.x : r.x; o.y = v.y < 0.f ? m.y : r.y; return o;
}

template <int ACT  > struct EpiBf16 {
    static constexpr bool PERM = true, AFTER_DRAIN = false; static_assert(ACT == 0 || ACT == 1, "EpiBf16: ACT is 0 (none) or 1 (gelu_pk)");
    bf16_t* O; int ldc; const float* bias; int split_cols; size_t split_stride; float scale0;
    __device__ __forceinline__ void operator()(const f32x4 (&acc)[2][2][4][2], const Unit& u, int wr, int wc, int fr, int fq) const {
        const int row0 = u.pm * BM + wr * 64 + fr; int colt = u.pn * BM; bf16_t* base = O;
        float sc = 1.f; if (split_cols) { const int t = colt / split_cols; base += (size_t)t * split_stride; colt -= t * split_cols; if (t == 0) sc = scale0; }
        const int col0 = colt + wc * 32 + 8 * fq, bcol0 = u.pn * BM + wc * 32 + 8 * fq;
        f32x4 bv[2][2];
#pragma unroll
        for (int bj = 0; bj < 2; ++bj)
#pragma unroll
            for (int n = 0; n < 2; ++n) bv[bj][n] = bias ? *(const f32x4*)(bias + bcol0 + bj * HALF + 4 * n) : (f32x4){0.f, 0.f, 0.f, 0.f};
#pragma unroll
        for (int ai = 0; ai < 2; ++ai)
#pragma unroll
            for (int m = 0; m < 4; ++m) { bf16_t* rowp = base + (size_t)(row0 + ai * HALF + m * 16) * ldc + col0;
#pragma unroll
                for (int bj = 0; bj < 2; ++bj) { f32x4 v0 = acc[ai][bj][m][0] + bv[bj][0], v1 = acc[ai][bj][m][1] + bv[bj][1];
                    if (ACT == 1) { f32x2 a = gelu_pk((f32x2){v0[0], v0[1]}), b = gelu_pk((f32x2){v0[2], v0[3]}), c = gelu_pk((f32x2){v1[0], v1[1]}), d = gelu_pk((f32x2){v1[2], v1[3]});
                        v0 = (f32x4){a.x, a.y, b.x, b.y}; v1 = (f32x4){c.x, c.y, d.x, d.y}; }
                    v0 = v0 * sc; v1 = v1 * sc; u32x4 w; w.x = cvt_pk_bf16(v0[0], v0[1]); w.y = cvt_pk_bf16(v0[2], v0[3]); w.z = cvt_pk_bf16(v1[0], v1[1]); w.w = cvt_pk_bf16(v1[2], v1[3]);
                    *(u32x4*)(rowp + bj * HALF) = w; } }
    }
};
template <class Epi, class Sched, bool ALIGN_EPI = false, bool SP2 = false>
__device__ __forceinline__ void gemm_phase(PG8_LAS unsigned char* lds, const Gemm g, const Sched& S, const Epi& E) {
    const int tid = threadIdx.x, wid = __builtin_amdgcn_readfirstlane(tid >> 6), lane = tid & 63, wr = wid >> 2, wc = wid & 3, fr = lane & 15, fq = lane >> 4;
    const int K = g.K, nt = K / BK;
    unsigned voffA[2], voffB[2];
#pragma unroll
    for (int i = 0; i < 2; ++i) { int R, C; stage_rc(tid * 16 + i * 8192, R, C); const int Rb = Epi::PERM ? ((R & ~31) + perm32(R & 31)) : R;
        voffA[i] = (unsigned)(R * K + C) * 2u; voffB[i] = (unsigned)(Rb * K + C) * 2u; }
    const size_t kstep = (size_t)(BK * 2);
    const size_t hstep = (size_t)HALF * K * 2;
    const size_t tstep = 2 * hstep;
    const unsigned ldsw = (unsigned)wid * 1024u;
    const int aoff = lds_byte(wr * 64 + fr, fq * 8), boff = lds_byte(wc * 32 + fr, fq * 8);
#define PG8_SA(b, h) (((b) * 2 + (h)) * HTB)
#define PG8_SB(b, h) ((4 + (b) * 2 + (h)) * HTB)
#define PG8_STAGE(bufoff, gbase, voff) do { _Pragma("unroll") for (int _i = 0; _i < 2; ++_i) \
        __builtin_amdgcn_global_load_lds((const unsigned*)((const char*)(gbase) + (voff)[_i]), (PG8_LAS unsigned*)(lds + (bufoff) + ldsw + _i * 8192), 16, 0, 0); } while (0)
#define PG8_LDA(dst, b, h) do { _Pragma("unroll") for (int m = 0; m < 4; ++m) _Pragma("unroll") for (int k = 0; k < 2; ++k) dst[m][k] = *(const PG8_LAS bf16x8*)(lds + PG8_SA(b, h) + aoff + m * 2048 + k * 1024); } while (0)
#define PG8_LDB(dst, b, h) do { _Pragma("unroll") for (int n = 0; n < 2; ++n) _Pragma("unroll") for (int k = 0; k < 2; ++k) dst[n][k] = *(const PG8_LAS bf16x8*)(lds + PG8_SB(b, h) + boff + n * 2048 + k * 1024); } while (0)
#define PG8_MMA(ai, bj, At, Bt) do { __builtin_amdgcn_s_setprio(1); _Pragma("unroll") for (int m = 0; m < 4; ++m) _Pragma("unroll") for (int n = 0; n < 2; ++n) _Pragma("unroll") for (int k = 0; k < 2; ++k) \
        acc[ai][bj][m][n] = __builtin_amdgcn_mfma_f32_16x16x32_bf16(Bt[n][k], At[m][k], acc[ai][bj][m][n], 0, 0, 0); __builtin_amdgcn_s_setprio(0); } while (0)
#define PG8_WAIT_V(n) asm volatile("s_waitcnt vmcnt(" #n ")" ::: "memory")
#define PG8_WAIT_L(n) asm volatile("s_waitcnt lgkmcnt(" #n ")" ::: "memory")
#define PG8_BAR __builtin_amdgcn_s_barrier()
#define PG8_SCHED __builtin_amdgcn_sched_barrier(0)
    Unit cur, nxt; int ui = 0;
    if (!S.next(0, cur)) return;
    f32x4 acc[2][2][4][2];
#pragma unroll
    for (int a = 0; a < 2; ++a)
#pragma unroll
        for (int b = 0; b < 2; ++b)
#pragma unroll
            for (int m = 0; m < 4; ++m)
#pragma unroll
                for (int n = 0; n < 2; ++n) acc[a][b][m][n] = (f32x4){0.f, 0.f, 0.f, 0.f};
    bf16x8 At[4][2], B0[2][2], B1[2][2];
    const char* cA = (const char*)g.A + (size_t)cur.pm * tstep; const char* cB = (const char*)g.Bt + (size_t)cur.pn * tstep;
    S.a_ready(cur);
    if constexpr (SP2) {
        PG8_STAGE(PG8_SB(0, 0), cB, voffB); PG8_STAGE(PG8_SB(0, 1), cB + hstep, voffB); PG8_STAGE(PG8_SA(0, 0), cA, voffA); PG8_STAGE(PG8_SA(0, 1), cA + hstep, voffA);
        if (wr == 1) PG8_BAR;
        PG8_WAIT_V(2); PG8_BAR;
        PG8_STAGE(PG8_SB(1, 0), cB + kstep, voffB); PG8_STAGE(PG8_SA(1, 0), cA + kstep, voffA); PG8_STAGE(PG8_SB(1, 1), cB + hstep + kstep, voffB);
        PG8_WAIT_V(6); PG8_BAR;
    } else {
        PG8_STAGE(PG8_SB(0, 0), cB, voffB); PG8_STAGE(PG8_SA(0, 0), cA, voffA); PG8_STAGE(PG8_SB(0, 1), cB + hstep, voffB); PG8_STAGE(PG8_SA(0, 1), cA + hstep, voffA);
        if (wr == 1) PG8_BAR;
        PG8_WAIT_V(4); PG8_BAR;
        PG8_STAGE(PG8_SB(1, 0), cB + kstep, voffB); PG8_STAGE(PG8_SA(1, 0), cA + kstep, voffA); PG8_STAGE(PG8_SB(1, 1), cB + hstep + kstep, voffB);
        PG8_WAIT_V(6); PG8_BAR;
    }
    for (;;) {
        const bool has_next = S.next(ui + 1, nxt);
        const char* nA = has_next ? (const char*)g.A + (size_t)nxt.pm * tstep : cA; const char* nB = has_next ? (const char*)g.Bt + (size_t)nxt.pn * tstep : cB;
        for (int t = 0; t < nt; t += 2) {
            const bool last = (t == nt - 2);
            const char* a1 = cA + (size_t)(t + 1) * kstep;
            const char* a2 = last ? nA : cA + (size_t)(t + 2) * kstep; const char* b2 = last ? nB : cB + (size_t)(t + 2) * kstep;
            const char* a3 = a2 + kstep; const char* b3 = b2 + kstep;
            if (last && has_next) S.a_ready(nxt);
            if constexpr (SP2) {
            PG8_LDB(B0, 0, 0); PG8_LDB(B1, 0, 1); PG8_SCHED; PG8_LDA(At, 0, 0); PG8_STAGE(PG8_SA(1, 1), a1 + hstep, voffA);
            PG8_WAIT_V(8); PG8_WAIT_L(0); PG8_BAR; PG8_MMA(0, 0, At, B0); PG8_MMA(0, 1, At, B1); PG8_BAR; PG8_SCHED;
            PG8_LDA(At, 0, 1); PG8_STAGE(PG8_SB(0, 0), b2, voffB); PG8_STAGE(PG8_SB(0, 1), b2 + hstep, voffB); PG8_STAGE(PG8_SA(0, 0), a2, voffA);
            PG8_WAIT_V(8); PG8_WAIT_L(0); PG8_BAR; PG8_MMA(1, 0, At, B0); PG8_MMA(1, 1, At, B1); PG8_BAR; PG8_SCHED;
            PG8_LDB(B0, 1, 0); PG8_LDB(B1, 1, 1); PG8_SCHED; PG8_LDA(At, 1, 0); PG8_STAGE(PG8_SA(0, 1), a2 + hstep, voffA);
            PG8_WAIT_V(8); PG8_WAIT_L(0); PG8_BAR; PG8_MMA(0, 0, At, B0); PG8_MMA(0, 1, At, B1); PG8_BAR; PG8_SCHED;
            PG8_LDA(At, 1, 1); PG8_STAGE(PG8_SB(1, 0), b3, voffB); PG8_STAGE(PG8_SB(1, 1), b3 + hstep, voffB); PG8_STAGE(PG8_SA(1, 0), a3, voffA);
            PG8_WAIT_V(8); PG8_WAIT_L(0); PG8_BAR; PG8_MMA(1, 0, At, B0); PG8_MMA(1, 1, At, B1); PG8_BAR; PG8_SCHED;
            } else {
            PG8_LDB(B0, 0, 0); PG8_SCHED; PG8_LDA(At, 0, 0); PG8_STAGE(PG8_SA(1, 1), a1 + hstep, voffA);
            PG8_WAIT_L(8); PG8_BAR; PG8_WAIT_L(0); PG8_MMA(0, 0, At, B0); PG8_BAR; PG8_SCHED;
            PG8_LDB(B1, 0, 1); PG8_STAGE(PG8_SB(0, 0), b2, voffB);
            PG8_BAR; PG8_WAIT_L(0); PG8_MMA(0, 1, At, B1); PG8_BAR;
            PG8_LDA(At, 0, 1); PG8_STAGE(PG8_SA(0, 0), a2, voffA);
            PG8_BAR; PG8_WAIT_L(0); PG8_MMA(1, 0, At, B0); PG8_BAR; PG8_SCHED;
            PG8_STAGE(PG8_SB(0, 1), b2 + hstep, voffB);
            PG8_WAIT_V(6); PG8_BAR; PG8_MMA(1, 1, At, B1); PG8_BAR;
            PG8_LDB(B0, 1, 0); PG8_SCHED; PG8_LDA(At, 1, 0); PG8_STAGE(PG8_SA(0, 1), a2 + hstep, voffA);
            PG8_WAIT_L(8); PG8_BAR; PG8_WAIT_L(0); PG8_MMA(0, 0, At, B0); PG8_BAR; PG8_SCHED;
            PG8_LDB(B1, 1, 1); PG8_STAGE(PG8_SB(1, 0), b3, voffB);
            PG8_BAR; PG8_WAIT_L(0); PG8_MMA(0, 1, At, B1); PG8_BAR;
            PG8_LDA(At, 1, 1); PG8_STAGE(PG8_SA(1, 0), a3, voffA);
            PG8_BAR; PG8_WAIT_L(0); PG8_MMA(1, 0, At, B0); PG8_BAR; PG8_SCHED;
            PG8_STAGE(PG8_SB(1, 1), b3 + hstep, voffB);
            PG8_WAIT_V(6); PG8_BAR; PG8_MMA(1, 1, At, B1); PG8_BAR;
            }
        }
        if constexpr (ALIGN_EPI) { if (wr == 0) PG8_BAR; }
        if constexpr (!Epi::AFTER_DRAIN) { E(acc, cur, wr, wc, fr, fq); S.done(cur); }
        if (!has_next) break;
#pragma unroll
        for (int a = 0; a < 2; ++a)
#pragma unroll
            for (int b = 0; b < 2; ++b)
#pragma unroll
                for (int m = 0; m < 4; ++m)
#pragma unroll
                    for (int n = 0; n < 2; ++n) acc[a][b][m][n] = (f32x4){0.f, 0.f, 0.f, 0.f};
        cur = nxt; cA = nA; cB = nB; ++ui;
        if constexpr (ALIGN_EPI) { if (wr == 1) PG8_BAR; }
    }
    PG8_WAIT_V(0);
    if constexpr (!ALIGN_EPI) { if (wr == 0) PG8_BAR; }
    PG8_BAR;
    if constexpr (Epi::AFTER_DRAIN) { E.fused(acc, cur, wr, wc, fr, fq, lds, wid, lane); S.done(cur); }
#undef PG8_SA
#undef PG8_SB
#undef PG8_STAGE
#undef PG8_LDA
#undef PG8_LDB
#undef PG8_MMA
#undef PG8_WAIT_V
#undef PG8_WAIT_L
#undef PG8_BAR
#undef PG8_SCHED
}
}
#define MK_N_LAUNCHES 1
#ifndef MK_N_LAUNCHES
#define MK_N_LAUNCHES 1
#endif
constexpr int DM = 2048, NB = 8, SEQ = 2048, T = NB * SEQ;
constexpr int AW = 1024, NH = 8, HD = 64, VD = 128, INC = 6144;
constexpr int PNK = 128, PTOPK = 16, PEH = 8, EPT = PEH * PTOPK;
constexpr float EPS = 1e-6f;
constexpr float C2 = 0.125f * 1.4426950408889634f;
constexpr int NPHASE = 9;
constexpr float U8_SCALE = 1024.f, V8_SCALE = 16.f, H8_SCALE = 16.f;
constexpr size_t MiB = 1u << 20;
constexpr size_t WS_WIN = 1 * MiB, WS_WOUT = 25 * MiB, WS_WQ = 33 * MiB, WS_SK = 41 * MiB, WS_SSQ = 42 * MiB, WS_EIDX = 44 * MiB, WS_EGATE = 52 * MiB, WS_RSTD = 60 * MiB;
constexpr size_t WS_XN = 64 * MiB;
constexpr size_t WS_Q = 128 * MiB, WS_K = 160 * MiB, WS_V = 192 * MiB;
constexpr size_t WS_CB = 224 * MiB, WS_CC = 256 * MiB, WS_CX = 288 * MiB;
constexpr size_t WS_UT = 320 * MiB, WS_VT = 384 * MiB, WS_END = 448 * MiB;
constexpr size_t WS_CTL = 0; constexpr int CW_BAR = 1024, CTL_ZERO_BYTES = 65536;
constexpr size_t WS_H8 = 288 * MiB;
constexpr size_t WS_PART = 64 * MiB, WS_ACT = 192 * MiB;
constexpr int MISC_OFF = 143360;
constexpr int LDS_BYTES = 147456;
constexpr int NWAVES = 8, NTHREADS = 512;

#define LAS __attribute__((address_space(3)))
typedef unsigned short bf16;
typedef unsigned v4u __attribute__((ext_vector_type(4)));
typedef unsigned v2u __attribute__((ext_vector_type(2)));
typedef float f32x4 __attribute__((ext_vector_type(4)));
typedef float f32x2 __attribute__((ext_vector_type(2)));
typedef float f32x16 __attribute__((ext_vector_type(16)));
typedef short bf16x8 __attribute__((ext_vector_type(8)));
typedef short s16x4 __attribute__((ext_vector_type(4)));
typedef __bf16 bf16x2_t __attribute__((ext_vector_type(2)));
#define LDS_WAIT() asm volatile("s_waitcnt lgkmcnt(0)" ::: "memory")
__device__ __forceinline__ unsigned pk2(float lo, float hi) { f32x2 v = {lo, hi}; bf16x2_t b = __builtin_convertvector(v, bf16x2_t); return __builtin_bit_cast(unsigned, b); }
__device__ __forceinline__ float bflo(unsigned u) { return __uint_as_float(u << 16); }
__device__ __forceinline__ float bfhi(unsigned u) { return __uint_as_float(u & 0xffff0000u); }
__device__ __forceinline__ float wave_sum(float v) {
#pragma unroll
    for (int o = 1; o < 64; o <<= 1) v += __shfl_xor(v, o);
    return v;
}
__device__ __forceinline__ float wave_max(float v) {
#pragma unroll
    for (int o = 1; o < 64; o <<= 1) v = fmaxf(v, __shfl_xor(v, o));
    return v;
}

#define XB_TMO      128
#define XB_XCNT(j)  (256  + 64 * (j))
#define XB_XSUB(j)  (1280 + 64 * (j))
#define XB_XGEN(j)  (2304 + 64 * (j))
#define XB_TOP      3328
#define XB_TOPGEN   3392
#define XCD_BAR_WORDS 3456
#define XB_SPIN_CAP (1u << 18)

__device__ __forceinline__ unsigned xb_ld(unsigned* p)              { return __hip_atomic_load(p, __ATOMIC_RELAXED, __HIP_MEMORY_SCOPE_AGENT); }
__device__ __forceinline__ unsigned xb_add(unsigned* p, unsigned v) { return __hip_atomic_fetch_add(p, v, __ATOMIC_RELAXED, __HIP_MEMORY_SCOPE_AGENT); }
__device__ __forceinline__ unsigned xb_xcc_id() { return (unsigned)__builtin_amdgcn_s_getreg((3 << 11) | 20) & 0xFu; }
#define XB_SPIN(cond, bar) do { unsigned _sp = 0; while (cond) { __builtin_amdgcn_s_sleep(1); \
    if ((++_sp & 255u) == 0u) { if (xb_ld(&(bar)[XB_TMO])) break; if (_sp > XB_SPIN_CAP) { atomicAdd(&(bar)[XB_TMO], 1u); break; } } } } while (0)

struct XcdBarrier {
    unsigned* bar; unsigned x;
    volatile LAS unsigned* st;
};

__device__ __forceinline__ XcdBarrier xcd_barrier_post(unsigned* bar, volatile LAS unsigned* st) {
    XcdBarrier b; b.bar = bar; b.x = xb_xcc_id(); b.st = st;
    if (threadIdx.x == 0) (void)xb_add(&bar[XB_XCNT(b.x)], 1u);
    return b;
}
__device__ __forceinline__ void xcd_barrier_complete(unsigned* bar, unsigned x, unsigned& nloc, unsigned& nx) {
    const unsigned G = gridDim.x * gridDim.y * gridDim.z;
    unsigned sum, cnt, mine, sp = 0u;
    for (;;) {
        sum = 0u; cnt = 0u; mine = 0u;
#pragma unroll
        for (unsigned j = 0; j < 16; ++j) { const unsigned c = xb_ld(&bar[XB_XCNT(j)]); sum += c; cnt += (c > 0u) ? 1u : 0u; mine = (j == x) ? c : mine; }
        if (sum == G) break;
        __builtin_amdgcn_s_sleep(1);
        if ((++sp & 255u) == 0u) { if (xb_ld(&bar[XB_TMO])) break; if (sp > XB_SPIN_CAP) { atomicAdd(&bar[XB_TMO], 1u); break; } }
    }
    nloc = mine > 0u ? mine : 1u; nx = cnt > 0u ? cnt : 1u;
}

__device__ __forceinline__ void xcd_barrier(const XcdBarrier& b) {
    asm volatile("s_waitcnt vmcnt(0)" ::: "memory");
    __syncthreads();
    if (threadIdx.x == 0) {
        unsigned* bar = b.bar;
        __builtin_amdgcn_s_waitcnt(0);
        unsigned nloc = b.st[0], nx = b.st[1];
        if (nloc == 0u) { xcd_barrier_complete(bar, b.x, nloc, nx); b.st[0] = nloc; b.st[1] = nx; }
        const unsigned old = xb_add(&bar[XB_XSUB(b.x)], 1u);
        const unsigned gen = old / nloc;
        if (old + 1u == (gen + 1u) * nloc) {
            __builtin_amdgcn_fence(__ATOMIC_RELEASE, "agent");
            asm volatile("s_waitcnt vmcnt(0)" ::: "memory");
            const unsigned og = xb_add(&bar[XB_TOP], 1u);
            const unsigned tg = og / nx;
            if (og + 1u == (tg + 1u) * nx) xb_add(&bar[XB_TOPGEN], 1u);
            else XB_SPIN(xb_ld(&bar[XB_TOPGEN]) == tg, bar);
            __builtin_amdgcn_fence(__ATOMIC_ACQUIRE, "agent");
            xb_add(&bar[XB_XGEN(b.x)], 1u);
            asm volatile("s_waitcnt vmcnt(0)" ::: "memory");
        } else {
            XB_SPIN(xb_ld(&bar[XB_XGEN(b.x)]) == gen, bar);
            __builtin_amdgcn_fence(__ATOMIC_ACQUIRE, "agent");
            asm volatile("s_waitcnt vmcnt(0)" ::: "memory");
        }
    }
    __syncthreads();
}


namespace pg8 {
struct EpiProj {
    static constexpr bool PERM = true, AFTER_DRAIN = false;
    bf16_t* base0; const float* qg; const float* kg;
    __device__ __forceinline__ void operator()(const f32x4 (&acc)[2][2][4][2], const Unit& u, int wr, int wc, int fr, int fq) const {
        const int region = u.pn >> 2;
        bf16_t* O = base0 + (size_t)region * (16u << 20);
        const int row0 = u.pm * BM + wr * 64 + fr, col0 = (u.pn & 3) * 256 + wc * 64 + 8 * fq;
        if (region < 2) {
            const float* g = region == 0 ? qg : kg; const float sc = region == 0 ? 0.125f * 1.4426950408889634f : 1.0f;
            f32x4 gv[2][2];
#pragma unroll
            for (int bj = 0; bj < 2; ++bj)
#pragma unroll
                for (int n = 0; n < 2; ++n) gv[bj][n] = *(const f32x4*)(g + bj * 32 + 8 * fq + 4 * n) * sc;
#pragma unroll
            for (int ai = 0; ai < 2; ++ai)
#pragma unroll
                for (int m = 0; m < 4; ++m) {
                    float ss = 0.f;
#pragma unroll
                    for (int bj = 0; bj < 2; ++bj)
#pragma unroll
                        for (int n = 0; n < 2; ++n) { const f32x4 x = acc[ai][bj][m][n]; ss += (x[0] * x[0] + x[1] * x[1]) + (x[2] * x[2] + x[3] * x[3]); }
                    ss += __shfl_xor(ss, 16); ss += __shfl_xor(ss, 32);
                    const float rs = __builtin_amdgcn_rsqf(ss * (1.0f / 64.0f) + 1e-6f);
                    bf16_t* rowp = O + (size_t)(row0 + ai * HALF + m * 16) * 1024 + col0;
#pragma unroll
                    for (int bj = 0; bj < 2; ++bj) { const f32x4 v0 = acc[ai][bj][m][0] * rs * gv[bj][0], v1 = acc[ai][bj][m][1] * rs * gv[bj][1];
                        u32x4 w; w.x = cvt_pk_bf16(v0[0], v0[1]); w.y = cvt_pk_bf16(v0[2], v0[3]); w.z = cvt_pk_bf16(v1[0], v1[1]); w.w = cvt_pk_bf16(v1[2], v1[3]);
                        *(u32x4*)(rowp + bj * 32) = w; }
                }
        } else {
#pragma unroll
            for (int ai = 0; ai < 2; ++ai)
#pragma unroll
                for (int m = 0; m < 4; ++m) { bf16_t* rowp = O + (size_t)(row0 + ai * HALF + m * 16) * 1024 + col0;
#pragma unroll
                    for (int bj = 0; bj < 2; ++bj) { const f32x4 v0 = acc[ai][bj][m][0], v1 = acc[ai][bj][m][1];
                        u32x4 w; w.x = cvt_pk_bf16(v0[0], v0[1]); w.y = cvt_pk_bf16(v0[2], v0[3]); w.z = cvt_pk_bf16(v1[0], v1[1]); w.w = cvt_pk_bf16(v1[2], v1[3]);
                        *(u32x4*)(rowp + bj * 32) = w; } }
        }
    }
};
struct EpiX1 {
    static constexpr bool PERM = true, AFTER_DRAIN = false;
    const float* x; float* out; bf16_t* a2; const float* gf; float* ssq; unsigned char* h8;
    __device__ __forceinline__ void operator()(const f32x4 (&acc)[2][2][4][2], const Unit& u, int wr, int wc, int fr, int fq) const {
        const int row0 = u.pm * BM + wr * 64 + fr, col0 = u.pn * BM + wc * 32 + 8 * fq;
        f32x4 gv[2][2];
#pragma unroll
        for (int bj = 0; bj < 2; ++bj)
#pragma unroll
            for (int n = 0; n < 2; ++n) gv[bj][n] = *(const f32x4*)(gf + col0 + bj * HALF + 4 * n);
#pragma unroll
        for (int ai = 0; ai < 2; ++ai)
#pragma unroll
            for (int m = 0; m < 4; ++m) { const int row = row0 + ai * HALF + m * 16; const size_t off = (size_t)row * 2048 + col0; float ss = 0.f;
#pragma unroll
                for (int bj = 0; bj < 2; ++bj) {
                    const f32x4 x0 = *(const f32x4*)(x + off + bj * HALF), x1 = *(const f32x4*)(x + off + bj * HALF + 4);
                    const f32x4 v0 = x0 + acc[ai][bj][m][0], v1 = x1 + acc[ai][bj][m][1];
                    *(f32x4*)(out + off + bj * HALF) = v0; *(f32x4*)(out + off + bj * HALF + 4) = v1;
                    ss += (v0[0] * v0[0] + v0[1] * v0[1]) + (v0[2] * v0[2] + v0[3] * v0[3]); ss += (v1[0] * v1[0] + v1[1] * v1[1]) + (v1[2] * v1[2] + v1[3] * v1[3]);
                    const f32x4 a0 = v0 * gv[bj][0], a1 = v1 * gv[bj][1];
                    u32x4 w; w.x = cvt_pk_bf16(a0[0], a0[1]); w.y = cvt_pk_bf16(a0[2], a0[3]); w.z = cvt_pk_bf16(a1[0], a1[1]); w.w = cvt_pk_bf16(a1[2], a1[3]);
                    *(u32x4*)(a2 + off + bj * HALF) = w;
                    { const f32x4 b0 = a0 * 16.0f, b1 = a1 * 16.0f; unsigned p = 0u, q2 = 0u;
#pragma unroll
                      for (int e_ = 0; e_ < 4; ++e_) { const int i0_ = __builtin_amdgcn_fmed3f(__builtin_rintf(b0[e_]), -127.f, 127.f), i1_ = __builtin_amdgcn_fmed3f(__builtin_rintf(b1[e_]), -127.f, 127.f);
                          p |= ((unsigned)i0_ & 0xffu) << (8 * e_); q2 |= ((unsigned)i1_ & 0xffu) << (8 * e_); }
                      typedef unsigned u32x2_ __attribute__((ext_vector_type(2))); *(u32x2_*)(h8 + off + bj * HALF) = (u32x2_){p, q2}; } }
                ss += __shfl_xor(ss, 16); ss += __shfl_xor(ss, 32);
                if (fq == 0) ssq[(size_t)row * 32 + u.pn * 4 + wc] = ss; }
    }
};
}

__device__ __forceinline__ void p0_transpose_item(const float* W, int K, int N, bf16* WT, LAS float* scr, int item, int lane, bool permg) {
    const int nblk = N / 32, kb = item / nblk, nb = item % nblk, k0 = 64 * kb, n0 = 32 * nb;
#pragma unroll 8
    for (int i = 0; i < 32; ++i) { const int kk = 2 * i + (lane >> 5); scr[kk * 33 + (lane & 31)] = W[(size_t)(k0 + kk) * N + n0 + (lane & 31)]; }
    LDS_WAIT(); asm volatile("" ::: "memory");
    int nd = n0; if (permg) { const int gl = (n0 & 255) >> 5; nd = (n0 & ~255) + 32 * (4 * (gl & 1) + (gl >> 1)); }
    const int c = lane & 7;
#pragma unroll
    for (int j = 0; j < 4; ++j) { const int n = (lane >> 3) + 8 * j; const LAS float* s = scr + (8 * c) * 33 + n;
        v4u o; o.x = pk2(s[0 * 33], s[1 * 33]); o.y = pk2(s[2 * 33], s[3 * 33]); o.z = pk2(s[4 * 33], s[5 * 33]); o.w = pk2(s[6 * 33], s[7 * 33]);
        *(v4u*)(WT + (size_t)(nd + n) * K + k0 + 8 * c) = o; }
    LDS_WAIT(); asm volatile("" ::: "memory");
}
__device__ __forceinline__ void rms_row_to_bf16(const float* xrow, const float* g, bf16* orow, int lane) {
    const f32x4* xr = (const f32x4*)xrow + lane; const f32x4* gr = (const f32x4*)g + lane;
    f32x4 v[8]; float s = 0.f;
#pragma unroll
    for (int j = 0; j < 8; ++j) { v[j] = xr[64 * j]; s += (v[j].x * v[j].x + v[j].y * v[j].y) + (v[j].z * v[j].z + v[j].w * v[j].w); }
    const float rstd = 1.0f / sqrtf(wave_sum(s) * (1.f / DM) + EPS);
    v2u* o8 = (v2u*)orow + lane;
#pragma unroll
    for (int j = 0; j < 8; ++j) { const f32x4 gg = gr[64 * j]; v2u w; w.x = pk2(v[j].x * rstd * gg.x, v[j].y * rstd * gg.y); w.y = pk2(v[j].z * rstd * gg.z, v[j].w * rstd * gg.w); o8[64 * j] = w; }
}
__device__ __forceinline__ void cvt_bf16_stream(const float* src, bf16* dst, size_t n8, size_t gtid, size_t nthr) {
    for (size_t i = gtid; i < n8; i += nthr) { const f32x4 a = *(const f32x4*)(src + i * 8), b = *(const f32x4*)(src + i * 8 + 4);
        v4u o; o.x = pk2(a.x, a.y); o.y = pk2(a.z, a.w); o.z = pk2(b.x, b.y); o.w = pk2(b.z, b.w); *(v4u*)(dst + i * 8) = o; }
}

__device__ __forceinline__ void cvt_i4_slices(const float* src, unsigned char* dst, float inv_step, size_t gtid, size_t nthr) {
    for (size_t i = gtid; i < (size_t)16384 * 64; i += nthr) { v4u o; const size_t e = i >> 6; const int c32 = (int)(i & 63), s = c32 >> 3, sub = c32 & 7;
#pragma unroll
        for (int w = 0; w < 4; ++w) { const f32x4 a = *(const f32x4*)(src + i * 32 + 8 * w) * inv_step, b = *(const f32x4*)(src + i * 32 + 8 * w + 4) * inv_step; unsigned d = 0u;
#pragma unroll
            for (int e_ = 0; e_ < 4; ++e_) { const int lo = (int)__builtin_amdgcn_fmed3f(__builtin_rintf(a[e_]), -8.f, 7.f) + 8, hi = (int)__builtin_amdgcn_fmed3f(__builtin_rintf(b[e_]), -8.f, 7.f) + 8; d |= ((unsigned)lo | ((unsigned)hi << 4)) << (8 * e_); }
            if (w == 0) o.x = d; else if (w == 1) o.y = d; else if (w == 2) o.z = d; else o.w = d; }
        *(v4u*)(dst + ((size_t)s * 16384 + e) * 128 + 16 * sub) = o; }
}
__device__ __forceinline__ float table_std16(const float* src, LAS float* scr, int tid) {
    float s = 0.f;
#pragma unroll
    for (int j = 0; j < 16; ++j) { const f32x4 v = *(const f32x4*)(src + (size_t)(j * 512 + tid) * 4); s += (v.x * v.x + v.y * v.y) + (v.z * v.z + v.w * v.w); }
    s = wave_sum(s);
    __syncthreads();
    if ((tid & 63) == 0) scr[tid >> 6] = s;
    __syncthreads();
    float t = 0.f;
#pragma unroll
    for (int w = 0; w < 8; ++w) t += scr[w];
    __syncthreads();
    return sqrtf(t * (1.0f / 32768.0f));
}
__device__ __forceinline__ void cvt_i8_slices(const float* src, unsigned char* dst, float scale, size_t gtid, size_t nthr) {
    for (size_t i = gtid; i < (size_t)16384 * 128; i += nthr) { v4u o; const size_t e = i >> 7; const int c16 = (int)(i & 127), s = c16 >> 3, sub = c16 & 7;
#pragma unroll
        for (int q = 0; q < 4; ++q) { const f32x4 a = *(const f32x4*)(src + i * 16 + 4 * q) * scale; unsigned w = 0u;
#pragma unroll
            for (int e_ = 0; e_ < 4; ++e_) { const int iv = (int)__builtin_amdgcn_fmed3f(__builtin_rintf(a[e_]), -127.f, 127.f); w |= ((unsigned)iv & 0xffu) << (8 * e_); }
            if (q == 0) o.x = w; else if (q == 1) o.y = w; else if (q == 2) o.z = w; else o.w = w; }
        *(v4u*)(dst + ((size_t)s * 16384 + e) * 128 + 16 * sub) = o; }
}
__device__ __forceinline__ void cvt_fp8_slices(const float* src, unsigned char* dst, float scale, size_t gtid, size_t nthr) {
    for (size_t i = gtid; i < (size_t)16384 * 128; i += nthr) { v4u o; const size_t e = i >> 7; const int c16 = (int)(i & 127), s = c16 >> 3, sub = c16 & 7;
#pragma unroll
        for (int q = 0; q < 4; ++q) { const f32x4 a = *(const f32x4*)(src + i * 16 + 4 * q) * scale; int w = __builtin_amdgcn_cvt_pk_fp8_f32(a.x, a.y, 0, false); w = __builtin_amdgcn_cvt_pk_fp8_f32(a.z, a.w, w, true);
            if (q == 0) o.x = (unsigned)w; else if (q == 1) o.y = (unsigned)w; else if (q == 2) o.z = (unsigned)w; else o.w = (unsigned)w; }
        *(v4u*)(dst + ((size_t)s * 16384 + e) * 128 + 16 * sub) = o; }
}

namespace att {
constexpr int SLOTB = 32768;
constexpr int NSLOT = 3, LW_OFF = NSLOT * SLOTB;
constexpr int XSTR = 132;
__device__ __forceinline__ void glds16(const void* gsrc, unsigned lds_dst) { unsigned keep;
    asm volatile("s_mov_b32 %0, m0\n\ts_mov_b32 m0, %2\n\ts_nop 0\n\tglobal_load_lds_dwordx4 %1, off\n\ts_mov_b32 m0, %0" : "=&s"(keep) : "v"(gsrc), "s"(lds_dst) : "memory"); }
__device__ __forceinline__ int crow(int r, int hi) { return (r & 3) + 8 * (r >> 2) + 4 * hi; }
typedef short v4i16_t __attribute__((ext_vector_type(4)));
__device__ __forceinline__ s16x4 vtr(const LAS char* p) { return __builtin_bit_cast(s16x4, __builtin_amdgcn_ds_read_tr16_b64_v4i16((LAS v4i16_t*)p)); }
#define ATT_WAIT_BAR(N) asm volatile("s_waitcnt vmcnt(" #N ") lgkmcnt(0)\n\ts_barrier" ::: "memory")

__device__ __forceinline__ void attn_unit(int b, int h, int qblk, const bf16* Q, const bf16* K, const bf16* V, bf16* MIX, const float* subg, float lam, float M2, LAS char* lds) {
    const int tid = threadIdx.x, lane = tid & 63, r32 = lane & 31, hi = lane >> 5, wid = __builtin_amdgcn_readfirstlane(tid >> 6), c = wid >> 2, qs = wid & 3;
    const size_t rowbase = (size_t)b * SEQ; const int q0 = qblk * 128, NT = 2 * (qblk + 1);
    const unsigned lds0 = (unsigned)(uintptr_t)lds;
    const bf16* ksrc[2]; const bf16* vsrc[2]; unsigned kdst[2], vdst[2];
#pragma unroll
    for (int i = 0; i < 2; ++i) { const int pk = 2 * wid + i, rr = lane >> 4, p = lane & 15, r = 4 * pk + rr;
        ksrc[i] = K + (rowbase + r) * 1024 + h * 128 + ((p ^ (r & 15)) * 8); kdst[i] = lds0 + pk * 1024;
        vsrc[i] = V + (rowbase + r) * 1024 + h * 128 + ((p ^ (rr << 2)) * 8); vdst[i] = lds0 + 16384 + pk * 1024; }
#define ATT_DMA(t, slot) do { _Pragma("unroll") for (int i_ = 0; i_ < 2; ++i_) { glds16(ksrc[i_] + (size_t)(t) * 64 * 1024, (unsigned)__builtin_amdgcn_readfirstlane(kdst[i_] + (slot) * SLOTB)); \
        glds16(vsrc[i_] + (size_t)(t) * 64 * 1024, (unsigned)__builtin_amdgcn_readfirstlane(vdst[i_] + (slot) * SLOTB)); } } while (0)
    ATT_DMA(0, 0); ATT_DMA(1, 1);
    const int qrow = q0 + 32 * qs + r32;
    bf16x8 qr[4];
#pragma unroll
    for (int d0 = 0; d0 < 4; ++d0) qr[d0] = *(const bf16x8*)(Q + (rowbase + qrow) * 1024 + h * 128 + c * 64 + d0 * 16 + hi * 8);
    asm volatile("" : "+v"(qr[0]), "+v"(qr[1]), "+v"(qr[2]), "+v"(qr[3]));
    const float slope2 = exp2f(-(float)(h + 1)) * 1.4426950408889634f;
    float base = -slope2 * (float)(qrow - 4 * hi) - M2;
    const float s32 = 32.f * slope2, s64 = 64.f * slope2;
    f32x16 o[4]; o[0] = f32x16{}; o[1] = f32x16{}; o[2] = f32x16{}; o[3] = f32x16{};
    float lsum = 0.f;
    int kofs[4], vofs[4];
    { const int q4 = (lane & 15) >> 2, p4 = lane & 3, gb = (lane >> 4) & 1;
#pragma unroll
      for (int d0 = 0; d0 < 4; ++d0) { kofs[d0] = r32 * 256 + (((8 * c + 2 * d0 + hi) ^ (r32 & 15)) << 4); vofs[d0] = 16384 + (4 * hi + q4) * 256 + (((((d0 ^ q4) << 2) | (gb << 1) | (p4 >> 1))) << 4) + (p4 & 1) * 8; } }
    const LAS char* lbase = (const LAS char*)lds;
    const int qw0 = q0 + 32 * qs;
    int slot = 0;
    for (int t = 0; t < NT; ++t) {
        if (t == 0) { ATT_WAIT_BAR(0); } else if (t + 1 < NT) { ATT_WAIT_BAR(4); } else { ATT_WAIT_BAR(0); }
        if (t + 2 < NT) { const int s2_ = (slot == 0) ? 2 : slot - 1; ATT_DMA(t + 2, s2_); }
        const int k0 = 64 * t;
        if (k0 <= qw0 + 31) {
            const LAS char* sp_ = lbase + slot * SLOTB;
            f32x16 p0, p1;
#pragma unroll
            for (int r = 0; r < 16; ++r) { p0[r] = __builtin_fmaf(slope2, (float)((r & 3) + 8 * (r >> 2)), base); p1[r] = p0[r] + s32; }
            __builtin_amdgcn_s_setprio(1);
#pragma unroll
            for (int d0 = 0; d0 < 4; ++d0) {
                const bf16x8 ka = *(const LAS bf16x8*)(sp_ + kofs[d0]), kb = *(const LAS bf16x8*)(sp_ + kofs[d0] + 8192);
                p0 = __builtin_amdgcn_mfma_f32_32x32x16_bf16(ka, qr[d0], p0, 0, 0, 0);
                p1 = __builtin_amdgcn_mfma_f32_32x32x16_bf16(kb, qr[d0], p1, 0, 0, 0); }
            __builtin_amdgcn_s_setprio(0);
#pragma unroll
            for (int r = 0; r < 16; ++r) { p0[r] = __builtin_amdgcn_exp2f(p0[r]); p1[r] = __builtin_amdgcn_exp2f(p1[r]); }
            if (k0 + 63 > qw0) {
                const int dq = qrow - k0;
#pragma unroll
                for (int r = 0; r < 16; ++r) { const int kk = crow(r, hi); if (kk > dq) p0[r] = 0.f; if (kk + 32 > dq) p1[r] = 0.f; }
            }
            {
                float s0 = p0[0] + p1[0], s1 = p0[1] + p1[1], s2 = p0[2] + p1[2], s3 = p0[3] + p1[3];
#pragma unroll
                for (int r = 4; r < 16; r += 4) { s0 += p0[r] + p1[r]; s1 += p0[r + 1] + p1[r + 1]; s2 += p0[r + 2] + p1[r + 2]; s3 += p0[r + 3] + p1[r + 3]; }
                lsum += (s0 + s1) + (s2 + s3); }
            bf16x8 pw[4];
#pragma unroll
            for (int ks = 0; ks < 4; ++ks) { v4u w;
                if (ks < 2) { w.x = pk2(p0[8 * ks + 0], p0[8 * ks + 1]); w.y = pk2(p0[8 * ks + 2], p0[8 * ks + 3]); w.z = pk2(p0[8 * ks + 4], p0[8 * ks + 5]); w.w = pk2(p0[8 * ks + 6], p0[8 * ks + 7]); }
                else { const int k2 = ks - 2; w.x = pk2(p1[8 * k2 + 0], p1[8 * k2 + 1]); w.y = pk2(p1[8 * k2 + 2], p1[8 * k2 + 3]); w.z = pk2(p1[8 * k2 + 4], p1[8 * k2 + 5]); w.w = pk2(p1[8 * k2 + 6], p1[8 * k2 + 7]); }
                pw[ks] = __builtin_bit_cast(bf16x8, w); }
            s16x4 fa[8], fb[8];
#define ATT_VLD(F, d0_) do { _Pragma("unroll") for (int ks_ = 0; ks_ < 4; ++ks_) { F[2 * ks_] = vtr(sp_ + vofs[d0_] + ks_ * 4096); F[2 * ks_ + 1] = vtr(sp_ + vofs[d0_] + ks_ * 4096 + 2048); } } while (0)
#define ATT_PV(F, d0_) do { _Pragma("unroll") for (int ks_ = 0; ks_ < 4; ++ks_) { const bf16x8 vf_ = (bf16x8){F[2 * ks_][0], F[2 * ks_][1], F[2 * ks_][2], F[2 * ks_][3], F[2 * ks_ + 1][0], F[2 * ks_ + 1][1], F[2 * ks_ + 1][2], F[2 * ks_ + 1][3]}; \
                o[d0_] = __builtin_amdgcn_mfma_f32_32x32x16_bf16(pw[ks_], vf_, o[d0_], 0, 0, 0); } } while (0)
            __builtin_amdgcn_s_setprio(1);
            ATT_VLD(fa, 0); ATT_VLD(fb, 1); __builtin_amdgcn_sched_barrier(0);
            ATT_PV(fa, 0); __builtin_amdgcn_sched_barrier(0); ATT_VLD(fa, 2); __builtin_amdgcn_sched_barrier(0);
            ATT_PV(fb, 1); __builtin_amdgcn_sched_barrier(0); ATT_VLD(fb, 3); __builtin_amdgcn_sched_barrier(0);
            ATT_PV(fa, 2); __builtin_amdgcn_sched_barrier(0);
            ATT_PV(fb, 3);
            __builtin_amdgcn_s_setprio(0);
#undef ATT_VLD
#undef ATT_PV
        }
        base += s64;
        slot = (slot == NSLOT - 1) ? 0 : slot + 1;
    }
    ATT_WAIT_BAR(0);
    LAS float* lw = (LAS float*)(lds + LW_OFF) + wid * 32;
    { auto rr = __builtin_amdgcn_permlane32_swap(__float_as_uint(lsum), __float_as_uint(lsum), false, false); lsum = __uint_as_float(rr[0]) + __uint_as_float(rr[1]); }
    if (hi == 0) lw[r32] = lsum;
    LDS_WAIT();
    LAS float* X = (LAS float*)lds + qs * 32 * XSTR;
#pragma unroll
    for (int r = 0; r < 16; ++r) { const float rl = 1.0f / lw[crow(r, hi)];
#pragma unroll
        for (int d0 = 0; d0 < 4; ++d0) o[d0][r] *= rl; }
    if (c == 1) {
#pragma unroll
        for (int r = 0; r < 16; ++r)
#pragma unroll
            for (int d0 = 0; d0 < 4; ++d0) X[crow(r, hi) * XSTR + d0 * 32 + r32] = o[d0][r];
    }
    ATT_WAIT_BAR(0);
    if (c == 0) {
#pragma unroll
        for (int r = 0; r < 16; ++r)
#pragma unroll
            for (int d0 = 0; d0 < 4; ++d0) { LAS float* px = X + crow(r, hi) * XSTR + d0 * 32 + r32; const float a = o[d0][r] - lam * (*px); *px = a; }
        LDS_WAIT(); asm volatile("" ::: "memory");
        const LAS f32x4* rp = (const LAS f32x4*)(X + r32 * XSTR + hi * 64);
        f32x4 av[16]; float ss = 0.f;
#pragma unroll
        for (int j = 0; j < 16; ++j) { av[j] = rp[j]; ss += (av[j].x * av[j].x + av[j].y * av[j].y) + (av[j].z * av[j].z + av[j].w * av[j].w); }
        { auto rr = __builtin_amdgcn_permlane32_swap(__float_as_uint(ss), __float_as_uint(ss), false, false); ss = __uint_as_float(rr[0]) + __uint_as_float(rr[1]); }
        const float rs = 0.8f / sqrtf(ss * (1.0f / 128.0f) + EPS);
        bf16* op = MIX + (rowbase + qrow) * 2048 + h * 128 + hi * 64;
#pragma unroll
        for (int j = 0; j < 8; ++j) { const f32x4 g0 = *(const f32x4*)(subg + hi * 64 + 8 * j), g1 = *(const f32x4*)(subg + hi * 64 + 8 * j + 4); const f32x4 a0 = av[2 * j] * rs * g0, a1 = av[2 * j + 1] * rs * g1;
            v4u w; w.x = pk2(a0.x, a0.y); w.y = pk2(a0.z, a0.w); w.z = pk2(a1.x, a1.y); w.w = pk2(a1.z, a1.w); *(v4u*)(op + 8 * j) = w; }
    }
    ATT_WAIT_BAR(0);
#undef ATT_DMA
}
}


#ifndef DBG_NAIVE_ATTN
#define DBG_NAIVE_ATTN 0
#endif
#if DBG_NAIVE_ATTN
__device__ __forceinline__ void naive_attn_row(int b, int h, int q, const bf16* Q, const bf16* K, const bf16* V, bf16* MIX, const float* subg, float lam, LAS float* S, int lane) {
    const size_t rowbase = (size_t)b * SEQ; const float slope2 = exp2f(-(float)(h + 1)) * 1.4426950408889634f;
    for (int c = 0; c < 2; ++c) {
        float qv[64];
        const bf16* qp = Q + (rowbase + q) * 1024 + h * 128 + c * 64;
#pragma unroll
        for (int d = 0; d < 64; d += 2) { const unsigned u = *(const unsigned*)(qp + d); qv[d] = bflo(u); qv[d + 1] = bfhi(u); }
        for (int key = lane; key <= q; key += 64) { const bf16* kp = K + (rowbase + key) * 1024 + h * 128 + c * 64; float s = 0.f;
#pragma unroll
            for (int d = 0; d < 64; d += 2) { const unsigned u = *(const unsigned*)(kp + d); s += qv[d] * bflo(u) + qv[d + 1] * bfhi(u); }
            S[c * 2048 + key] = s - slope2 * (float)(q - key); }
    }
    LDS_WAIT();
    float linv[2];
    for (int c = 0; c < 2; ++c) { float m = -1e30f; for (int key = lane; key <= q; key += 64) m = fmaxf(m, S[c * 2048 + key]); m = wave_max(m);
        float l = 0.f; for (int key = lane; key <= q; key += 64) { const float p = exp2f(S[c * 2048 + key] - m); S[c * 2048 + key] = p; l += p; } linv[c] = 1.0f / wave_sum(l); }
    for (int key = lane; key <= q; key += 64) S[key] = S[key] * linv[0] - lam * S[2048 + key] * linv[1];
    LDS_WAIT();
    float o0 = 0.f, o1 = 0.f; const bf16* vp = V + rowbase * 1024 + h * 128 + lane;
    for (int key = 0; key <= q; ++key) { const float a = S[key]; o0 += a * __uint_as_float((unsigned)vp[(size_t)key * 1024] << 16); o1 += a * __uint_as_float((unsigned)vp[(size_t)key * 1024 + 64] << 16); }
    const float ss = wave_sum(o0 * o0 + o1 * o1); const float rs = 0.8f / sqrtf(ss * (1.0f / 128.0f) + EPS);
    bf16* op = MIX + (rowbase + q) * 2048 + h * 128 + lane;
    op[0] = (bf16)(pk2(o0 * rs * subg[lane], 0.f) & 0xffffu); op[64] = (bf16)(pk2(o1 * rs * subg[lane + 64], 0.f) & 0xffffu);
    LDS_WAIT();
}
#endif

__device__ __forceinline__ unsigned ord_key(float f) { const unsigned u = __float_as_uint(f); return (u & 0x80000000u) ? ~u : (u | 0x80000000u); }
__device__ __forceinline__ float ord_val(unsigned k) { return __uint_as_float((k & 0x80000000u) ? (k ^ 0x80000000u) : ~k); }
#define CE_DESC(a, b) do { const unsigned hi__ = max((a), (b)), lo__ = min((a), (b)); (a) = hi__; (b) = lo__; } while (0)
__device__ __forceinline__ void sort16_desc(unsigned (&v)[16]) {
#pragma unroll
    for (int k = 2; k <= 16; k <<= 1)
#pragma unroll
        for (int j = k >> 1; j > 0; j >>= 1)
#pragma unroll
            for (int i = 0; i < 16; ++i) { const int l = i ^ j; if (l > i) { if ((i & k) == 0) CE_DESC(v[i], v[l]); else CE_DESC(v[l], v[i]); } }
}
__device__ __forceinline__ void merge16_desc_rev(unsigned (&a)[16], const unsigned (&brev)[16]) {
#pragma unroll
    for (int i = 0; i < 16; ++i) a[i] = max(a[i], brev[i]);
#pragma unroll
    for (int j = 8; j > 0; j >>= 1)
#pragma unroll
        for (int i = 0; i < 16; ++i) { const int l = i ^ j; if (l > i) CE_DESC(a[i], a[l]); }
}

constexpr int P5_LST_OFF = 65536, P5_TAB_OFF = P5_LST_OFF + 16384;
__device__ __forceinline__ void peer_topk_item(int tile, int h, const bf16* QP, const float* SSQ, int* EIDX, float* EGATE, float* RSTD, LAS char* lds) {
    const int tid = threadIdx.x, lane = tid & 63, r32 = lane & 31, hi = lane >> 5, wid = __builtin_amdgcn_readfirstlane(tid >> 6);
    LAS unsigned* LST = (LAS unsigned*)(lds + P5_LST_OFF);
    const LAS unsigned char* TAB = (const LAS unsigned char*)(lds + P5_TAB_OFF);
    const int tok0 = tile * 128;
    {
        const int c = wid >> 2, tb = wid & 3;
        bf16x8 qf[8];
        const bf16* qp = QP + (size_t)(tok0 + tb * 32 + r32) * 2048 + h * 256 + c * 128 + hi * 8;
#pragma unroll
        for (int s = 0; s < 8; ++s) qf[s] = *(const bf16x8*)(qp + 16 * s);
        const LAS char* sp = lds + c * 32768 + hi * 2048 + r32 * 16;
        unsigned best[16];
#pragma unroll
        for (int kb = 0; kb < 4; ++kb) { f32x16 acc = f32x16{};
#pragma unroll
            for (int s = 0; s < 8; ++s) { const bf16x8 sf = *(const LAS bf16x8*)(sp + s * 4096 + kb * 512); acc = __builtin_amdgcn_mfma_f32_32x32x16_bf16(sf, qf[s], acc, 0, 0, 0); }
            unsigned v[16];
#pragma unroll
            for (int r = 0; r < 16; ++r) v[r] = (ord_key(acc[r]) & ~0x7Fu) | (unsigned)(32 * kb + (r & 3) + 8 * (r >> 2)) | (unsigned)(hi << 2);
            sort16_desc(v);
            if (kb == 0) {
#pragma unroll
                for (int i = 0; i < 16; ++i) best[i] = v[i];
            } else { unsigned vr[16];
#pragma unroll
                for (int i = 0; i < 16; ++i) vr[i] = v[15 - i];
                merge16_desc_rev(best, vr); } }
        {
            unsigned br[16];
#pragma unroll
            for (int i = 0; i < 16; ++i) br[i] = (unsigned)__shfl_xor((int)best[15 - i], 32);
            merge16_desc_rev(best, br); }
        if (hi == 0) { LAS unsigned* lrow = LST + (c * 128 + tb * 32 + r32) * 16;
#pragma unroll
            for (int i = 0; i < 4; ++i) *(LAS v4u*)(lrow + 4 * i) = (v4u){best[4 * i], best[4 * i + 1], best[4 * i + 2], best[4 * i + 3]}; }
    }
    __syncthreads();
    {
        const int token = tid >> 2, q = tid & 3;
        const LAS unsigned* l1 = LST + token * 16; const LAS unsigned* l2 = LST + (128 + token) * 16;
        unsigned v[16];
#pragma unroll
        for (int m = 0; m < 13; ++m) { const int n = 4 * m + q; const unsigned pid = TAB[n < 50 ? n : 0]; const unsigned a = l1[pid >> 4], b2 = l2[pid & 15u];
            const unsigned key = (ord_key(ord_val(a & ~0x7Fu) + ord_val(b2 & ~0x7Fu)) & ~0xFFu) | pid; v[m] = n < 50 ? key : 0u; }
        v[13] = 0u; v[14] = 0u; v[15] = 0u;
        sort16_desc(v);
#pragma unroll
        for (int w = 1; w <= 2; w <<= 1) { unsigned br[16];
#pragma unroll
            for (int i = 0; i < 16; ++i) br[i] = (unsigned)__shfl_xor((int)v[15 - i], w);
            merge16_desc_rev(v, br); }
        const int t = tok0 + token;
        const f32x4 p0 = *(const f32x4*)(SSQ + (size_t)t * 32 + 8 * q), p1 = *(const f32x4*)(SSQ + (size_t)t * 32 + 8 * q + 4);
        float ssq = ((p0.x + p0.y) + (p0.z + p0.w)) + ((p1.x + p1.y) + (p1.z + p1.w));
        ssq += __shfl_xor(ssq, 1); ssq += __shfl_xor(ssq, 2);
        const float rstd = 1.0f / sqrtf(ssq * (1.0f / DM) + EPS);
        if (h == 0 && q == 0) RSTD[t] = rstd;
        const unsigned p_top = v[0] & 0xFFu; const float vmax = (ord_val(l1[p_top >> 4] & ~0x7Fu) + ord_val(l2[p_top & 15u] & ~0x7Fu)) * rstd;
        float ev[4]; int ex[4]; float es = 0.f;
#pragma unroll
        for (int m = 0; m < 4; ++m) { const unsigned kk = q == 0 ? v[m] : q == 1 ? v[4 + m] : q == 2 ? v[8 + m] : v[12 + m];
            const unsigned pid = kk & 0xFFu; const unsigned a = l1[pid >> 4], b2 = l2[pid & 15u];
            const float sv = (ord_val(a & ~0x7Fu) + ord_val(b2 & ~0x7Fu)) * rstd;
            ev[m] = __expf(sv - vmax); es += ev[m]; ex[m] = (int)((a & 0x7Fu) * 128u + (b2 & 0x7Fu)); }
        es += __shfl_xor(es, 1); es += __shfl_xor(es, 2);
        const float inv = 1.0f / es;
        *(int4*)(EIDX + (size_t)t * 128 + h * 16 + 4 * q) = make_int4(ex[0], ex[1], ex[2], ex[3]);
        *(f32x4*)(EGATE + (size_t)t * 128 + h * 16 + 4 * q) = (f32x4){ev[0] * inv, ev[1] * inv, ev[2] * inv, ev[3] * inv};
    }
    __syncthreads();
}

__device__ __forceinline__ f32x2 dot16_fp8(const v4u u, const f32x2* h, f32x2 acc) {
#pragma unroll
    for (int w = 0; w < 4; ++w) { const unsigned d = w == 0 ? u.x : w == 1 ? u.y : w == 2 ? u.z : u.w;
        const f32x2 f0 = __builtin_amdgcn_cvt_pk_f32_fp8((int)d, false), f1 = __builtin_amdgcn_cvt_pk_f32_fp8((int)d, true);
        acc = __builtin_elementwise_fma(h[2 * w], f0, acc); acc = __builtin_elementwise_fma(h[2 * w + 1], f1, acc); }
    return acc;
}
__device__ __forceinline__ void axpy16_fp8(const v4u v, f32x2 a2, f32x2* o) {
#pragma unroll
    for (int w = 0; w < 4; ++w) { const unsigned d = w == 0 ? v.x : w == 1 ? v.y : w == 2 ? v.z : v.w;
        const f32x2 f0 = __builtin_amdgcn_cvt_pk_f32_fp8((int)d, false), f1 = __builtin_amdgcn_cvt_pk_f32_fp8((int)d, true);
        o[2 * w] = __builtin_elementwise_fma(a2, f0, o[2 * w]); o[2 * w + 1] = __builtin_elementwise_fma(a2, f1, o[2 * w + 1]); }
}
struct PItem { int t, s; };
__device__ __forceinline__ PItem peer_item(int q, int nq, int nper, int tb, int tstride, int xl) {
    const int j = (q < nq ? q : nq - 1) >> 1; PItem it; const int r = j >= nper ? 1 : 0; it.s = 8 * r + xl; const int t = tb + (j - r * nper) * tstride; it.t = t < T ? t : T - 1; return it; }
__device__ __forceinline__ void pe_idx8(const PItem it, int hh, const int* EIDX, int g, int (&ex)[8]) {
#pragma unroll
    for (int i = 0; i < 2; ++i) { const int4 v = *(const int4*)(EIDX + (size_t)it.t * 128 + g * 16 + 8 * hh + 4 * i); ex[4 * i] = v.x; ex[4 * i + 1] = v.y; ex[4 * i + 2] = v.z; ex[4 * i + 3] = v.w; }
}
__device__ __forceinline__ void pe_gather8(const PItem it, const unsigned char* TB, int sub, const int (&ex)[8], v4u (&uv)[8]) {
    const unsigned char* ub = TB + (size_t)it.s * 16384 * 128 + 16 * sub;
#pragma unroll
    for (int i = 0; i < 8; ++i) uv[i] = *(const v4u*)(ub + (size_t)ex[i] * 128);
}
__device__ __forceinline__ int sdot4(unsigned a, unsigned b, int acc) { return __builtin_amdgcn_sdot4((int)a, (int)b, acc, false); }
__device__ __forceinline__ void pu_acc8(const v4u (&uv)[8], const v4u ha, const v4u hb, int hs8, int (&r)[8]) {
#pragma unroll
    for (int i = 0; i < 8; ++i) { int a = -hs8;
        a = sdot4(uv[i].x & 0x0F0F0F0Fu, ha.x, a); a = sdot4((uv[i].x >> 4) & 0x0F0F0F0Fu, ha.y, a); a = sdot4(uv[i].y & 0x0F0F0F0Fu, ha.z, a); a = sdot4((uv[i].y >> 4) & 0x0F0F0F0Fu, ha.w, a);
        a = sdot4(uv[i].z & 0x0F0F0F0Fu, hb.x, a); a = sdot4((uv[i].z >> 4) & 0x0F0F0F0Fu, hb.y, a); a = sdot4(uv[i].w & 0x0F0F0F0Fu, hb.z, a); r[i] = sdot4((uv[i].w >> 4) & 0x0F0F0F0Fu, hb.w, a); }
}
__device__ __forceinline__ void pu_store(const PItem it, bool valid, float* PART, int lane, const int (&rlo)[8], const int (&rhi)[8]) {
    const int g = lane >> 3, sub = lane & 7;
    int r[16];
#pragma unroll
    for (int i = 0; i < 8; ++i) { r[i] = rlo[i]; r[8 + i] = rhi[i]; }
#pragma unroll
    for (int w = 4, n = 8; w >= 1; w >>= 1, n >>= 1) { const bool up = (lane & w) != 0;
#pragma unroll
        for (int j = 0; j < n; ++j) { const int a = r[j], b2 = r[j + n]; const int keep = up ? b2 : a, send = up ? a : b2; r[j] = keep + __shfl_xor(send, w); } }
    const int i0 = 8 * ((sub >> 2) & 1) + 4 * ((sub >> 1) & 1) + 2 * (sub & 1);
    if (valid) *(f32x2*)(PART + ((size_t)it.s * T + it.t) * 128 + g * 16 + i0) = (f32x2){(float)r[0], (float)r[1]};
}
__device__ __forceinline__ PItem peer_item1(int q, int nq, int tb, int tstride, int xl) { const int j = (q < nq ? q : nq - 1) >> 1; PItem it; it.s = xl; const int t = tb + j * tstride; it.t = t < T ? t : T - 1; return it; }
__device__ __forceinline__ void peer_u_stage(int nper, int tb, int tstride, int xl, const unsigned char* H8, const unsigned char* U8, const int* EIDX, float* PART, int lane) {
    const int g = lane >> 3, sub = lane & 7, NQ = 2 * nper;
    int ex0[8], ex1[8], ex2[8], ex3[8]; v4u uv0[8], uv1[8], uv2[8], uv3[8], ha0, ha1, ha2, ha3, hb0, hb1, hb2, hb3; int rs[8];
#define PU_I(q, X) do { const PItem it_ = peer_item1((q), NQ, tb, tstride, xl); pe_idx8(it_, (X) & 1, EIDX, g, ex##X); } while (0)
#define PU_G(q, X) do { const PItem it_ = peer_item1((q), NQ, tb, tstride, xl); pe_gather8(it_, U8, sub, ex##X, uv##X); const unsigned char* hp_ = H8 + (size_t)it_.t * 2048 + 256 * it_.s + 32 * sub; ha##X = *(const v4u*)hp_; hb##X = *(const v4u*)(hp_ + 16); } while (0)
#define PU_F(q, X) do { const PItem it_ = peer_item1((q), NQ, tb, tstride, xl); int hs_ = sdot4(ha##X.x, 0x01010101u, 0); hs_ = sdot4(ha##X.y, 0x01010101u, hs_); hs_ = sdot4(ha##X.z, 0x01010101u, hs_); hs_ = sdot4(ha##X.w, 0x01010101u, hs_); \
        hs_ = sdot4(hb##X.x, 0x01010101u, hs_); hs_ = sdot4(hb##X.y, 0x01010101u, hs_); hs_ = sdot4(hb##X.z, 0x01010101u, hs_); hs_ = sdot4(hb##X.w, 0x01010101u, hs_); \
        if (((X) & 1) == 0) pu_acc8(uv##X, ha##X, hb##X, 8 * hs_, rs); else { int rh_[8]; pu_acc8(uv##X, ha##X, hb##X, 8 * hs_, rh_); \
        pu_store(it_, (q) < NQ && (tb + ((q) >> 1) * tstride) < T, PART, lane, rs, rh_); } } while (0)
    PU_I(0, 0); PU_I(1, 1); PU_I(2, 2); PU_I(3, 3); PU_G(0, 0); PU_G(1, 1); PU_G(2, 2);
#pragma unroll 1
    for (int q = 0; q < NQ; q += 4) {
        PU_F(q, 0);     PU_G(q + 3, 3); PU_I(q + 4, 0);
        PU_F(q + 1, 1); PU_G(q + 4, 0); PU_I(q + 5, 1);
        PU_F(q + 2, 2); PU_G(q + 5, 1); PU_I(q + 6, 2);
        PU_F(q + 3, 3); PU_G(q + 6, 2); PU_I(q + 7, 3);
    }
#undef PU_I
#undef PU_G
#undef PU_F
}
__device__ __forceinline__ void pv_acc8(const v4u (&vv)[8], const float (&av)[8], f32x2 (&o)[8]) {
#pragma unroll
    for (int i = 0; i < 8; ++i) axpy16_fp8(vv[i], (f32x2){av[i], av[i]}, o);
}
__device__ __forceinline__ void pv_store(const PItem it, bool valid, float* out, int lane, f32x2 (&o)[8], const f32x2 x1) {
    const int g = lane >> 3, sub = lane & 7;
#pragma unroll
    for (int w = 32, n = 4; w >= 8; w >>= 1, n >>= 1) { const bool up = (lane & w) != 0;
#pragma unroll
        for (int j = 0; j < n; ++j) { const f32x2 a = o[j], b2 = o[j + n]; const f32x2 keep = up ? b2 : a, send = up ? a : b2; o[j] = (f32x2){keep.x + __shfl_xor(send.x, w), keep.y + __shfl_xor(send.y, w)}; } }
    const int c0 = 8 * ((g >> 2) & 1) + 4 * ((g >> 1) & 1) + 2 * (g & 1);
    if (valid) *(f32x2*)(out + (size_t)it.t * 2048 + 128 * it.s + 16 * sub + c0) = (f32x2){x1.x + o[0].x, x1.y + o[0].y};
}
__device__ __forceinline__ void peer_v_stage(int nper, int tb, int tstride, int xl, const unsigned char* V8, const int* EIDX, const float* ACT, float* out, int lane) {
    const int g = lane >> 3, sub = lane & 7, NQ = 4 * nper;
    const int c0 = 8 * ((g >> 2) & 1) + 4 * ((g >> 1) & 1) + 2 * (g & 1);
    int ex0[8], ex1[8], ex2[8], ex3[8]; v4u vv0[8], vv1[8], vv2[8], vv3[8]; float av0[8], av1[8], av2[8], av3[8]; f32x2 x1a, x1b; f32x2 o[8];
#define PV_I(q, X) do { const PItem it_ = peer_item((q), NQ, nper, tb, tstride, xl); pe_idx8(it_, (X) & 1, EIDX, g, ex##X); } while (0)
#define PV_G(q, X, XV) do { const PItem it_ = peer_item((q), NQ, nper, tb, tstride, xl); pe_gather8(it_, V8, sub, ex##X, vv##X); \
        { const f32x4 a_ = *(const f32x4*)(ACT + (size_t)it_.t * 128 + g * 16 + 8 * ((X) & 1)), b_ = *(const f32x4*)(ACT + (size_t)it_.t * 128 + g * 16 + 8 * ((X) & 1) + 4); \
          av##X[0] = a_.x; av##X[1] = a_.y; av##X[2] = a_.z; av##X[3] = a_.w; av##X[4] = b_.x; av##X[5] = b_.y; av##X[6] = b_.z; av##X[7] = b_.w; } \
        if ((X) & 1) XV = *(const f32x2*)(out + (size_t)it_.t * 2048 + 128 * it_.s + 16 * sub + c0); } while (0)
#define PV_F(q, X, XV) do { const PItem it_ = peer_item((q), NQ, nper, tb, tstride, xl); if (((X) & 1) == 0) { _Pragma("unroll") for (int m_ = 0; m_ < 8; ++m_) o[m_] = (f32x2){0.f, 0.f}; } \
        pv_acc8(vv##X, av##X, o); if ((X) & 1) pv_store(it_, (q) < NQ && (tb + ((((q) >> 1) % nper)) * tstride) < T, out, lane, o, XV); } while (0)
    PV_I(0, 0); PV_I(1, 1); PV_I(2, 2); PV_I(3, 3); PV_G(0, 0, x1a); PV_G(1, 1, x1a); PV_G(2, 2, x1b);
#pragma unroll 1
    for (int q = 0; q < NQ; q += 4) {
        PV_F(q, 0, x1a);     PV_G(q + 3, 3, x1b); PV_I(q + 4, 0);
        PV_F(q + 1, 1, x1a); PV_G(q + 4, 0, x1a); PV_I(q + 5, 1);
        PV_F(q + 2, 2, x1b); PV_G(q + 5, 1, x1a); PV_I(q + 6, 2);
        PV_F(q + 3, 3, x1b); PV_G(q + 6, 2, x1b); PV_I(q + 7, 3);
    }
#undef PV_I
#undef PV_G
#undef PV_F
}

struct Args { const float* in[17]; float* out; unsigned char* ws; int ph_lo, ph_hi; };
__global__ void __launch_bounds__(NTHREADS, 2) mk_fwd(Args args) {
    extern __shared__ __attribute__((aligned(16))) unsigned char lds_raw[];
    LAS unsigned char* lds = (LAS unsigned char*)lds_raw;
    const int tid = threadIdx.x, lane = tid & 63, wave = __builtin_amdgcn_readfirstlane(tid >> 6);
    const int G = gridDim.x, bx = blockIdx.x;
    const int vcu = (G % 8 == 0) ? (bx % 8) * (G / 8) + bx / 8 : bx;
    unsigned char* ws = args.ws;
    const float* x = args.in[0]; const float* attn_g = args.in[1]; const float* w_in = args.in[2]; const float* qg = args.in[3]; const float* kg = args.in[4];
    const float* lq1 = args.in[5]; const float* lk1 = args.in[6]; const float* lq2 = args.in[7]; const float* lk2 = args.in[8]; const float* subg = args.in[9];
    const float* conv_w = args.in[10]; const float* w_out = args.in[11]; const float* ffn_g = args.in[12]; const float* w_q = args.in[13]; const float* subkeys = args.in[14];
    const float* peer_u = args.in[15]; const float* peer_v = args.in[16];
    float* out = args.out;
    bf16* WtIn = (bf16*)(ws + WS_WIN); bf16* WtOut = (bf16*)(ws + WS_WOUT); bf16* WtQ = (bf16*)(ws + WS_WQ); bf16* SK = (bf16*)(ws + WS_SK);
    float* SSQ = (float*)(ws + WS_SSQ); int* EIDX = (int*)(ws + WS_EIDX); float* EGATE = (float*)(ws + WS_EGATE); float* RSTD = (float*)(ws + WS_RSTD);
    bf16* XN = (bf16*)(ws + WS_XN); bf16* MIX = XN;
    bf16* Qb = (bf16*)(ws + WS_Q); bf16* Kb = (bf16*)(ws + WS_K); bf16* Vb = (bf16*)(ws + WS_V); bf16* QP = Qb;
    bf16* CB = (bf16*)(ws + WS_CB); bf16* CC = (bf16*)(ws + WS_CC); bf16* CX = (bf16*)(ws + WS_CX); bf16* A2 = CB;
    unsigned char* U8 = ws + WS_UT; unsigned char* V8 = ws + WS_VT;
    volatile LAS unsigned* MISC = (volatile LAS unsigned*)(lds + MISC_OFF);
    if (tid < 16) MISC[tid] = 0u;
    __syncthreads();
    XcdBarrier bar = xcd_barrier_post((unsigned*)(ws + WS_CTL) + CW_BAR, MISC + 8);
    const int lo = args.ph_lo, hi_ph = args.ph_hi & 255, dbg_flags = args.ph_hi >> 8;
#ifndef DBG_DUP
#define DBG_DUP -1
#endif
#ifndef DBG_MASK
#define DBG_MASK 0xfff
#endif
#define IN(k) (((DBG_MASK >> (k)) & 1) && lo <= (k) && (k) < hi_ph)
#define REPS(k) for (int rep_ = 0; rep_ < ((DBG_DUP == (k)) ? 2 : 1); ++rep_)
#define SEAM(k) do { if (IN(k) && IN((k) + 1)) xcd_barrier(bar); } while (0)
    const int gw = vcu * NWAVES + wave, NGW = G * NWAVES;
    const size_t gtid = (size_t)bx * NTHREADS + tid, nthr = (size_t)G * NTHREADS;

    if (IN(0)) REPS(0) {
        LAS float* scr = (LAS float*)(lds + wave * 16384);
        constexpr int I_IN = (DM / 64) * (INC / 32), I_SQ = (DM / 64) * (DM / 32);
        for (int it = gw; it < I_IN + 2 * I_SQ; it += NGW) {
            if (it < I_IN) p0_transpose_item(w_in, DM, INC, WtIn, scr, it, lane, true);
            else if (it < I_IN + I_SQ) p0_transpose_item(w_out, DM, DM, WtOut, scr, it - I_IN, lane, false);
            else p0_transpose_item(w_q, DM, DM, WtQ, scr, it - I_IN - I_SQ, lane, false);
        }
        for (int m = gw; m < T; m += NGW) rms_row_to_bf16(x + (size_t)m * DM, attn_g, XN + (size_t)m * DM, lane);
        cvt_bf16_stream(subkeys, SK, (size_t)PEH * 2 * PNK * 128 / 8, gtid, nthr);
        {
            const float sig = table_std16(peer_u, (LAS float*)(lds + MISC_OFF + 64), tid); const float step = 0.335f * sig;
            if (bx == 0 && tid == 0) ((float*)(ws + WS_RSTD))[T] = step;
            cvt_i4_slices(peer_u, U8, 1.0f / step, gtid, nthr); }
        cvt_fp8_slices(peer_v, V8, V8_SCALE, gtid, nthr);
    }
    SEAM(0);
    if (IN(1)) REPS(1) {
        pg8::Gemm g{XN, WtIn, T, INC, DM}; pg8::StaticOrder S; S.init(T, INC, G, bx);
        pg8::EpiProj E{Qb, qg, kg};
        pg8::gemm_phase<pg8::EpiProj, pg8::StaticOrder, true, true>(lds, g, S, E);
    }
    SEAM(1);
    if (IN(2)) REPS(2) {
        float a = lq1[lane] * lk1[lane], b2 = lq2[lane] * lk2[lane];
        a = wave_sum(a); b2 = wave_sum(b2);
        const float lam = expf(a) - expf(b2) + 0.2f;
        const float mq = wave_max(fabsf(qg[lane])), mk = wave_max(fabsf(kg[lane]));
        const float M2 = 64.f * C2 * mq * mk;
#if DBG_NAIVE_ATTN
        for (int r = gw; r < NB * NH * SEQ; r += NGW) naive_attn_row(r >> 14, (r >> 11) & 7, r & 2047, Qb, Kb, Vb, MIX, subg, lam, (LAS float*)(lds + wave * 16384), lane);
        if (0)
#endif
        if (!(dbg_flags & 2))
        for (int v = vcu; v < NB * NH * 4; v += G) {
            const int bh = v >> 2, s = v & 3, b = bh >> 3, h = bh & 7;
#pragma unroll 1
            for (int i = 0; i < 4; ++i) { const int qblk = (i == 0) ? s : (i == 1) ? 7 - s : (i == 2) ? 8 + s : 15 - s;
                att::attn_unit(b, h, qblk, Qb, Kb, Vb, MIX, subg, lam, M2, (LAS char*)lds); }
        }
        if (!(dbg_flags & 1))
        for (size_t it = gtid; it < (size_t)(T / 16) * 128; it += nthr) {
            const int cg8 = (int)(it & 127), chunk = (int)(it >> 7), t0 = chunk * 16, col = cg8 * 8;
            f32x4 w0a = *(const f32x4*)(conv_w + col), w0b = *(const f32x4*)(conv_w + col + 4), w1a = *(const f32x4*)(conv_w + 1024 + col), w1b = *(const f32x4*)(conv_w + 1024 + col + 4),
                  w2a = *(const f32x4*)(conv_w + 2048 + col), w2b = *(const f32x4*)(conv_w + 2048 + col + 4);
            float u1[8], u2[8];
#pragma unroll
            for (int i = 0; i < 8; ++i) { u1[i] = 0.f; u2[i] = 0.f; }
            if ((t0 % SEQ) != 0) {
                const v4u c1 = *(const v4u*)(CC + (size_t)(t0 - 1) * 1024 + col), x1v = *(const v4u*)(CX + (size_t)(t0 - 1) * 1024 + col), c2 = *(const v4u*)(CC + (size_t)(t0 - 2) * 1024 + col), x2v = *(const v4u*)(CX + (size_t)(t0 - 2) * 1024 + col);
                u1[0] = bflo(c1.x) * bflo(x1v.x); u1[1] = bfhi(c1.x) * bfhi(x1v.x); u1[2] = bflo(c1.y) * bflo(x1v.y); u1[3] = bfhi(c1.y) * bfhi(x1v.y); u1[4] = bflo(c1.z) * bflo(x1v.z); u1[5] = bfhi(c1.z) * bfhi(x1v.z); u1[6] = bflo(c1.w) * bflo(x1v.w); u1[7] = bfhi(c1.w) * bfhi(x1v.w);
                u2[0] = bflo(c2.x) * bflo(x2v.x); u2[1] = bfhi(c2.x) * bfhi(x2v.x); u2[2] = bflo(c2.y) * bflo(x2v.y); u2[3] = bfhi(c2.y) * bfhi(x2v.y); u2[4] = bflo(c2.z) * bflo(x2v.z); u2[5] = bfhi(c2.z) * bfhi(x2v.z); u2[6] = bflo(c2.w) * bflo(x2v.w); u2[7] = bfhi(c2.w) * bfhi(x2v.w);
            }
            const float w0[8] = {w0a.x, w0a.y, w0a.z, w0a.w, w0b.x, w0b.y, w0b.z, w0b.w}, w1[8] = {w1a.x, w1a.y, w1a.z, w1a.w, w1b.x, w1b.y, w1b.z, w1b.w}, w2[8] = {w2a.x, w2a.y, w2a.z, w2a.w, w2b.x, w2b.y, w2b.z, w2b.w};
#pragma unroll 4
            for (int j = 0; j < 16; ++j) { const size_t ro = (size_t)(t0 + j) * 1024 + col;
                const v4u bv = *(const v4u*)(CB + ro), cv = *(const v4u*)(CC + ro), xv = *(const v4u*)(CX + ro);
                float u0[8], bb[8], y[8];
                u0[0] = bflo(cv.x) * bflo(xv.x); u0[1] = bfhi(cv.x) * bfhi(xv.x); u0[2] = bflo(cv.y) * bflo(xv.y); u0[3] = bfhi(cv.y) * bfhi(xv.y); u0[4] = bflo(cv.z) * bflo(xv.z); u0[5] = bfhi(cv.z) * bfhi(xv.z); u0[6] = bflo(cv.w) * bflo(xv.w); u0[7] = bfhi(cv.w) * bfhi(xv.w);
                bb[0] = bflo(bv.x); bb[1] = bfhi(bv.x); bb[2] = bflo(bv.y); bb[3] = bfhi(bv.y); bb[4] = bflo(bv.z); bb[5] = bfhi(bv.z); bb[6] = bflo(bv.w); bb[7] = bfhi(bv.w);
#pragma unroll
                for (int i = 0; i < 8; ++i) { y[i] = bb[i] * (u2[i] * w0[i] + u1[i] * w1[i] + u0[i] * w2[i]); u2[i] = u1[i]; u1[i] = u0[i]; }
                v4u o; o.x = pk2(y[0], y[1]); o.y = pk2(y[2], y[3]); o.z = pk2(y[4], y[5]); o.w = pk2(y[6], y[7]);
                *(v4u*)(MIX + (size_t)(t0 + j) * 2048 + 1024 + col) = o; }
        }
    }
    SEAM(2);
    if (IN(3)) REPS(3) {
        pg8::Gemm g{MIX, WtOut, T, DM, DM}; pg8::StaticOrder S; S.init(T, DM, G, bx);
        pg8::EpiX1 E{x, out, A2, ffn_g, SSQ, ws + WS_H8};
        pg8::gemm_phase<pg8::EpiX1, pg8::StaticOrder, true, true>(lds, g, S, E);
    }
    SEAM(3);
    if (IN(4)) REPS(4) {
        pg8::Gemm g{A2, WtQ, T, DM, DM}; pg8::StaticOrder S; S.init(T, DM, G, bx);
        pg8::EpiBf16<0> E{QP, DM, nullptr, 0, 0, 1.f};
        pg8::gemm_phase<pg8::EpiBf16<0>, pg8::StaticOrder, true, true>(lds, g, S, E);
    }
    SEAM(4);
    if (IN(5)) REPS(5) {
        if (tid < 64) {
            int n = tid, i = 0;
#pragma unroll 1
            for (; i < 16; ++i) { const int len = 16 / (i + 1); if (n < len) break; n -= len; }
            ((LAS unsigned char*)(lds + P5_TAB_OFF))[tid] = (unsigned char)(i < 16 ? ((i << 4) | n) : 0);
        }
        int cur_h = -1;
        for (int it = vcu; it < (T / 128) * PEH; it += G) { const int h = it & 7;
            if (h != cur_h) {
                __syncthreads();
                for (int i = tid; i < 4096; i += NTHREADS) { const int ch = i & 15, key = (i >> 4) & 127, c = i >> 11;
                    *(LAS v4u*)(lds + c * 32768 + ch * 2048 + key * 16) = *(const v4u*)(SK + (size_t)((h * 2 + c) * 128 + key) * 128 + ch * 8); }
                cur_h = h; __syncthreads(); }
            peer_topk_item(it >> 3, h, QP, SSQ, EIDX, EGATE, RSTD, (LAS char*)lds); }
    }
    SEAM(5);
    if (IN(6)) {
        float* PART = (float*)(ws + WS_PART);
        const int tstride = (G >> 3) * NWAVES, nper = (T + tstride - 1) / tstride;
        peer_u_stage(nper, (bx >> 3) * NWAVES + wave, tstride, bx & 7, ws + WS_H8, U8, EIDX, PART, lane);
    }
    SEAM(6);
    if (IN(7)) {
        const float* PART = (const float*)(ws + WS_PART); float* ACT = (float*)(ws + WS_ACT);
        for (size_t i = gtid; i < (size_t)T * 128; i += nthr) { float z = 0.f;
#pragma unroll
            for (int s = 0; s < 8; ++s) z += PART[(size_t)s * T * 128 + i];
            z *= RSTD[i >> 7] * (RSTD[T] * (1.0f / H8_SCALE));
            ACT[i] = 0.5f * z * (1.0f + erff(z * 0.70710678118654752f)) * EGATE[i] * (1.0f / V8_SCALE); }
    }
    SEAM(7);
    if (IN(8)) {
        const float* ACT = (const float*)(ws + WS_ACT);
        const int tstride = (G >> 3) * NWAVES, nper = (T + tstride - 1) / tstride;
#ifdef DBG_VDRY
#pragma unroll 1
        for (int rep = 0; rep < 2; ++rep) peer_v_stage(nper, (bx >> 3) * NWAVES + wave, tstride, bx & 7, V8, EIDX, ACT, out, lane, rep == 0);
#else
        peer_v_stage(nper, (bx >> 3) * NWAVES + wave, tstride, bx & 7, V8, EIDX, ACT, out, lane);
#endif
    }
#undef IN
#undef SEAM
}

extern "C" void kernel_launch(void* const* d_in, const int* in_sizes, int n_in, void* d_out, int out_size, void* d_ws, size_t ws_size, hipStream_t stream) {
    static int grid = 0;
    if (grid == 0) {
        if (n_in != 17 || out_size != T * DM || ws_size < WS_END) { fprintf(stderr, "kernel_launch: unexpected shapes (n_in %d out %d ws %zu)\n", n_in, out_size, ws_size); grid = -1; return; }
        int dev = 0, cus = 0, per_cu = 0;
        if (hipGetDevice(&dev) != hipSuccess || hipDeviceGetAttribute(&cus, hipDeviceAttributeMultiprocessorCount, dev) != hipSuccess) { grid = -1; return; }
        if (hipFuncSetAttribute((const void*)mk_fwd, hipFuncAttributeMaxDynamicSharedMemorySize, LDS_BYTES) != hipSuccess) { fprintf(stderr, "kernel_launch: hipFuncSetAttribute failed\n"); grid = -1; return; }
        if (hipOccupancyMaxActiveBlocksPerMultiprocessor(&per_cu, (const void*)mk_fwd, NTHREADS, LDS_BYTES) != hipSuccess || per_cu < 1) { fprintf(stderr, "kernel_launch: occupancy query says %d blocks per CU\n", per_cu); (void)hipGetLastError(); grid = -1; return; }
        grid = cus;
    }
    if (grid < 0) return;
    if (hipMemsetAsync((char*)d_ws + WS_CTL, 0, CTL_ZERO_BYTES, stream) != hipSuccess) { fprintf(stderr, "kernel_launch: memset failed\n"); return; }
    Args a{};
    for (int i = 0; i < 17; ++i) a.in[i] = (const float*)d_in[i];
    a.out = (float*)d_out; a.ws = (unsigned char*)d_ws;
#if MK_N_LAUNCHES == 1
    a.ph_lo = 0; a.ph_hi = NPHASE;
    void* kargs[] = {&a};
    hipError_t e = hipLaunchCooperativeKernel((const void*)mk_fwd, dim3(grid), dim3(NTHREADS), kargs, LDS_BYTES, stream);
    if (e != hipSuccess) fprintf(stderr, "kernel_launch: cooperative launch failed: %s (grid %d)\n", hipGetErrorString(e), grid);
#else
#ifndef DBG_DUPL
#define DBG_DUPL -1
#endif
#ifndef DBG_DUPFLAGS
#define DBG_DUPFLAGS 0
#endif
    for (int p = 0; p < NPHASE; ++p) { a.ph_lo = p; for (int r = 0; r < (p == DBG_DUPL ? 2 : 1); ++r) { a.ph_hi = (p + 1) | ((r == 1 ? DBG_DUPFLAGS : 0) << 8); hipLaunchKernelGGL(mk_fwd, dim3(grid), dim3(NTHREADS), LDS_BYTES, stream, a); } }
#endif
}
```

```cpp
#include <hip/hip_runtime.h>
#include <hip/hip_cooperative_groups.h>
#include <cstdio>
#include <cstdint>
#include <cmath>
namespace cg = cooperative_groups;
namespace pg8 {
#define PG8_LAS __attribute__((address_space(3)))
typedef unsigned short bf16_t;
typedef short bf16x8 __attribute__((ext_vector_type(8)));
typedef float f32x4 __attribute__((ext_vector_type(4)));
typedef unsigned u32x4 __attribute__((ext_vector_type(4)));
constexpr int BM = 256, BK = 64, HALF = 128, HTB = HALF * BK * 2  , STAGE_BYTES = 8 * HTB, NXCD = 8, WGM = 8;

__host__ __device__ __forceinline__ int lds_byte(int r, int c) { const int st = (r >> 4) * 2 + (c >> 5), rr = r & 15, cc = c & 31, ob = rr * 64 + cc * 2; return st * 1024 + (ob ^ (((ob >> 9) & 1) << 5)); }
__host__ __device__ __forceinline__ void stage_rc(int b, int& R, int& C) { const int st = b / 1024, sb = b % 1024, swz = sb ^ (((sb >> 9) & 1) << 5); R = (st >> 1) * 16 + swz / 64; C = (st & 1) * 32 + (swz % 64) / 2; }
__host__ __device__ __forceinline__ int perm32(int rho) { const int n = rho >> 4, i = rho & 15; return 8 * (i >> 2) + 4 * n + (i & 3); }

struct Unit { int pm, pn; };
struct Gemm { const bf16_t* A; const bf16_t* Bt; int M, N, K; };

struct StaticOrder {
    int nM, nN, nwg, G, c;
    __host__ __device__ void init(int M, int N, int G_, int c_) { nM = M / BM; nN = N / BM; nwg = nM * nN; G = G_; c = c_; }
    __host__ __device__ bool next(int i, Unit& u) const {
        const long L = (long)i * G + c; if (L >= nwg) return false;
        int wgid = (int)L; { const int q = nwg / NXCD, r = nwg % NXCD, xcd = wgid % NXCD, off = wgid / NXCD; wgid = (xcd < r ? xcd * (q + 1) : r * (q + 1) + (xcd - r) * q) + off; }
        const int nig = WGM * nN, gid = wgid / nig, fm = gid * WGM, gsz = (nM - fm) < WGM ? (nM - fm) : WGM;
        u.pm = fm + ((wgid % nig) % gsz); u.pn = (wgid % nig) / gsz; return true;
    }
    __device__ __forceinline__ void a_ready(const Unit&) const {}
    __device__ __forceinline__ void done(const Unit&) const {}
};

__device__ __forceinline__ unsigned cvt_pk_bf16(float lo, float hi) { unsigned r; asm volatile("v_cvt_pk_bf16_f32 %0, %1, %2" : "=v"(r) : "v"(lo), "v"(hi)); return r; }
typedef float f32x2 __attribute__((ext_vector_type(2)));
__device__ __forceinline__ f32x2 gelu_pk(f32x2 v) {
    const f32x2 av = __builtin_elementwise_abs(v), d = av * 0.2316418882f + 1.0f;
    f32x2 t; t.x = __builtin_amdgcn_rcpf(d.x); t.y = __builtin_amdgcn_rcpf(d.y);
    f32x2 q = t * 0.5307027145f + (-0.7265760135f); q = q * t + 0.7107068705f; q = q * t + (-0.142248368f); q = q * t + 0.127414796f; q = q * t;
    const f32x2 s = (v * v) * (-0.72134752044f);
    f32x2 e; e.x = __builtin_amdgcn_exp2f(s.x); e.y = __builtin_amdgcn_exp2f(s.y);
    const f32x2 m = v * (q * e), r = v - m;
    f32x2 o; o.x = v.x < 0.f ? m.x : r.x; o.y = v.y < 0.f ? m.y : r.y; return o;
}

template <int ACT  > struct EpiBf16 {
    static constexpr bool PERM = true, AFTER_DRAIN = false; static_assert(ACT == 0 || ACT == 1, "EpiBf16: ACT is 0 (none) or 1 (gelu_pk)");
    bf16_t* O; int ldc; const float* bias; int split_cols; size_t split_stride; float scale0;
    __device__ __forceinline__ void operator()(const f32x4 (&acc)[2][2][4][2], const Unit& u, int wr, int wc, int fr, int fq) const {
        const int row0 = u.pm * BM + wr * 64 + fr; int colt = u.pn * BM; bf16_t* base = O;
        float sc = 1.f; if (split_cols) { const int t = colt / split_cols; base += (size_t)t * split_stride; colt -= t * split_cols; if (t == 0) sc = scale0; }
        const int col0 = colt + wc * 32 + 8 * fq, bcol0 = u.pn * BM + wc * 32 + 8 * fq;
        f32x4 bv[2][2];
#pragma unroll
        for (int bj = 0; bj < 2; ++bj)
#pragma unroll
            for (int n = 0; n < 2; ++n) bv[bj][n] = bias ? *(const f32x4*)(bias + bcol0 + bj * HALF + 4 * n) : (f32x4){0.f, 0.f, 0.f, 0.f};
#pragma unroll
        for (int ai = 0; ai < 2; ++ai)
#pragma unroll
            for (int m = 0; m < 4; ++m) { bf16_t* rowp = base + (size_t)(row0 + ai * HALF + m * 16) * ldc + col0;
#pragma unroll
                for (int bj = 0; bj < 2; ++bj) { f32x4 v0 = acc[ai][bj][m][0] + bv[bj][0], v1 = acc[ai][bj][m][1] + bv[bj][1];
                    if (ACT == 1) { f32x2 a = gelu_pk((f32x2){v0[0], v0[1]}), b = gelu_pk((f32x2){v0[2], v0[3]}), c = gelu_pk((f32x2){v1[0], v1[1]}), d = gelu_pk((f32x2){v1[2], v1[3]});
                        v0 = (f32x4){a.x, a.y, b.x, b.y}; v1 = (f32x4){c.x, c.y, d.x, d.y}; }
                    v0 = v0 * sc; v1 = v1 * sc; u32x4 w; w.x = cvt_pk_bf16(v0[0], v0[1]); w.y = cvt_pk_bf16(v0[2], v0[3]); w.z = cvt_pk_bf16(v1[0], v1[1]); w.w = cvt_pk_bf16(v1[2], v1[3]);
                    *(u32x4*)(rowp + bj * HALF) = w; } }
    }
};
template <class Epi, class Sched, bool ALIGN_EPI = false, bool SP2 = false>
__device__ __forceinline__ void gemm_phase(PG8_LAS unsigned char* lds, const Gemm g, const Sched& S, const Epi& E) {
    const int tid = threadIdx.x, wid = __builtin_amdgcn_readfirstlane(tid >> 6), lane = tid & 63, wr = wid >> 2, wc = wid & 3, fr = lane & 15, fq = lane >> 4;
    const int K = g.K, nt = K / BK;
    unsigned voffA[2], voffB[2];
#pragma unroll
    for (int i = 0; i < 2; ++i) { int R, C; stage_rc(tid * 16 + i * 8192, R, C); const int Rb = Epi::PERM ? ((R & ~31) + perm32(R & 31)) : R;
        voffA[i] = (unsigned)(R * K + C) * 2u; voffB[i] = (unsigned)(Rb * K + C) * 2u; }
    const size_t kstep = (size_t)(BK * 2);
    const size_t hstep = (size_t)HALF * K * 2;
    const size_t tstep = 2 * hstep;
    const unsigned ldsw = (unsigned)wid * 1024u;
    const int aoff = lds_byte(wr * 64 + fr, fq * 8), boff = lds_byte(wc * 32 + fr, fq * 8);
#define PG8_SA(b, h) (((b) * 2 + (h)) * HTB)
#define PG8_SB(b, h) ((4 + (b) * 2 + (h)) * HTB)
#define PG8_STAGE(bufoff, gbase, voff) do { _Pragma("unroll") for (int _i = 0; _i < 2; ++_i) \
        __builtin_amdgcn_global_load_lds((const unsigned*)((const char*)(gbase) + (voff)[_i]), (PG8_LAS unsigned*)(lds + (bufoff) + ldsw + _i * 8192), 16, 0, 0); } while (0)
#define PG8_LDA(dst, b, h) do { _Pragma("unroll") for (int m = 0; m < 4; ++m) _Pragma("unroll") for (int k = 0; k < 2; ++k) dst[m][k] = *(const PG8_LAS bf16x8*)(lds + PG8_SA(b, h) + aoff + m * 2048 + k * 1024); } while (0)
#define PG8_LDB(dst, b, h) do { _Pragma("unroll") for (int n = 0; n < 2; ++n) _Pragma("unroll") for (int k = 0; k < 2; ++k) dst[n][k] = *(const PG8_LAS bf16x8*)(lds + PG8_SB(b, h) + boff + n * 2048 + k * 1024); } while (0)
#define PG8_MMA(ai, bj, At, Bt) do { __builtin_amdgcn_s_setprio(1); _Pragma("unroll") for (int m = 0; m < 4; ++m) _Pragma("unroll") for (int n = 0; n < 2; ++n) _Pragma("unroll") for (int k = 0; k < 2; ++k) \
        acc[ai][bj][m][n] = __builtin_amdgcn_mfma_f32_16x16x32_bf16(Bt[n][k], At[m][k], acc[ai][bj][m][n], 0, 0, 0); __builtin_amdgcn_s_setprio(0); } while (0)
#define PG8_WAIT_V(n) asm volatile("s_waitcnt vmcnt(" #n ")" ::: "memory")
#define PG8_WAIT_L(n) asm volatile("s_waitcnt lgkmcnt(" #n ")" ::: "memory")
#define PG8_BAR __builtin_amdgcn_s_barrier()
#define PG8_SCHED __builtin_amdgcn_sched_barrier(0)
    Unit cur, nxt; int ui = 0;
    if (!S.next(0, cur)) return;
    f32x4 acc[2][2][4][2];
#pragma unroll
    for (int a = 0; a < 2; ++a)
#pragma unroll
        for (int b = 0; b < 2; ++b)
#pragma unroll
            for (int m = 0; m < 4; ++m)
#pragma unroll
                for (int n = 0; n < 2; ++n) acc[a][b][m][n] = (f32x4){0.f, 0.f, 0.f, 0.f};
    bf16x8 At[4][2], B0[2][2], B1[2][2];
    const char* cA = (const char*)g.A + (size_t)cur.pm * tstep; const char* cB = (const char*)g.Bt + (size_t)cur.pn * tstep;
    S.a_ready(cur);
    if constexpr (SP2) {
        PG8_STAGE(PG8_SB(0, 0), cB, voffB); PG8_STAGE(PG8_SB(0, 1), cB + hstep, voffB); PG8_STAGE(PG8_SA(0, 0), cA, voffA); PG8_STAGE(PG8_SA(0, 1), cA + hstep, voffA);
        if (wr == 1) PG8_BAR;
        PG8_WAIT_V(2); PG8_BAR;
        PG8_STAGE(PG8_SB(1, 0), cB + kstep, voffB); PG8_STAGE(PG8_SA(1, 0), cA + kstep, voffA); PG8_STAGE(PG8_SB(1, 1), cB + hstep + kstep, voffB);
        PG8_WAIT_V(6); PG8_BAR;
    } else {
        PG8_STAGE(PG8_SB(0, 0), cB, voffB); PG8_STAGE(PG8_SA(0, 0), cA, voffA); PG8_STAGE(PG8_SB(0, 1), cB + hstep, voffB); PG8_STAGE(PG8_SA(0, 1), cA + hstep, voffA);
        if (wr == 1) PG8_BAR;
        PG8_WAIT_V(4); PG8_BAR;
        PG8_STAGE(PG8_SB(1, 0), cB + kstep, voffB); PG8_STAGE(PG8_SA(1, 0), cA + kstep, voffA); PG8_STAGE(PG8_SB(1, 1), cB + hstep + kstep, voffB);
        PG8_WAIT_V(6); PG8_BAR;
    }
    for (;;) {
        const bool has_next = S.next(ui + 1, nxt);
        const char* nA = has_next ? (const char*)g.A + (size_t)nxt.pm * tstep : cA; const char* nB = has_next ? (const char*)g.Bt + (size_t)nxt.pn * tstep : cB;
        for (int t = 0; t < nt; t += 2) {
            const bool last = (t == nt - 2);
            const char* a1 = cA + (size_t)(t + 1) * kstep;
            const char* a2 = last ? nA : cA + (size_t)(t + 2) * kstep; const char* b2 = last ? nB : cB + (size_t)(t + 2) * kstep;
            const char* a3 = a2 + kstep; const char* b3 = b2 + kstep;
            if (last && has_next) S.a_ready(nxt);
            if constexpr (SP2) {
            PG8_LDB(B0, 0, 0); PG8_LDB(B1, 0, 1); PG8_SCHED; PG8_LDA(At, 0, 0); PG8_STAGE(PG8_SA(1, 1), a1 + hstep, voffA);
            PG8_WAIT_V(8); PG8_WAIT_L(0); PG8_BAR; PG8_MMA(0, 0, At, B0); PG8_MMA(0, 1, At, B1); PG8_BAR; PG8_SCHED;
            PG8_LDA(At, 0, 1); PG8_STAGE(PG8_SB(0, 0), b2, voffB); PG8_STAGE(PG8_SB(0, 1), b2 + hstep, voffB); PG8_STAGE(PG8_SA(0, 0), a2, voffA);
            PG8_WAIT_V(8); PG8_WAIT_L(0); PG8_BAR; PG8_MMA(1, 0, At, B0); PG8_MMA(1, 1, At, B1); PG8_BAR; PG8_SCHED;
            PG8_LDB(B0, 1, 0); PG8_LDB(B1, 1, 1); PG8_SCHED; PG8_LDA(At, 1, 0); PG8_STAGE(PG8_SA(0, 1), a2 + hstep, voffA);
            PG8_WAIT_V(8); PG8_WAIT_L(0); PG8_BAR; PG8_MMA(0, 0, At, B0); PG8_MMA(0, 1, At, B1); PG8_BAR; PG8_SCHED;
            PG8_LDA(At, 1, 1); PG8_STAGE(PG8_SB(1, 0), b3, voffB); PG8_STAGE(PG8_SB(1, 1), b3 + hstep, voffB); PG8_STAGE(PG8_SA(1, 0), a3, voffA);
            PG8_WAIT_V(8); PG8_WAIT_L(0); PG8_BAR; PG8_MMA(1, 0, At, B0); PG8_MMA(1, 1, At, B1); PG8_BAR; PG8_SCHED;
            } else {
            PG8_LDB(B0, 0, 0); PG8_SCHED; PG8_LDA(At, 0, 0); PG8_STAGE(PG8_SA(1, 1), a1 + hstep, voffA);
            PG8_WAIT_L(8); PG8_BAR; PG8_WAIT_L(0); PG8_MMA(0, 0, At, B0); PG8_BAR; PG8_SCHED;
            PG8_LDB(B1, 0, 1); PG8_STAGE(PG8_SB(0, 0), b2, voffB);
            PG8_BAR; PG8_WAIT_L(0); PG8_MMA(0, 1, At, B1); PG8_BAR;
            PG8_LDA(At, 0, 1); PG8_STAGE(PG8_SA(0, 0), a2, voffA);
            PG8_BAR; PG8_WAIT_L(0); PG8_MMA(1, 0, At, B0); PG8_BAR; PG8_SCHED;
            PG8_STAGE(PG8_SB(0, 1), b2 + hstep, voffB);
            PG8_WAIT_V(6); PG8_BAR; PG8_MMA(1, 1, At, B1); PG8_BAR;
            PG8_LDB(B0, 1, 0); PG8_SCHED; PG8_LDA(At, 1, 0); PG8_STAGE(PG8_SA(0, 1), a2 + hstep, voffA);
            PG8_WAIT_L(8); PG8_BAR; PG8_WAIT_L(0); PG8_MMA(0, 0, At, B0); PG8_BAR; PG8_SCHED;
            PG8_LDB(B1, 1, 1); PG8_STAGE(PG8_SB(1, 0), b3, voffB);
            PG8_BAR; PG8_WAIT_L(0); PG8_MMA(0, 1, At, B1); PG8_BAR;
            PG8_LDA(At, 1, 1); PG8_STAGE(PG8_SA(1, 0), a3, voffA);
            PG8_BAR; PG8_WAIT_L(0); PG8_MMA(1, 0, At, B0); PG8_BAR; PG8_SCHED;
            PG8_STAGE(PG8_SB(1, 1), b3 + hstep, voffB);
            PG8_WAIT_V(6); PG8_BAR; PG8_MMA(1, 1, At, B1); PG8_BAR;
            }
        }
        if constexpr (ALIGN_EPI) { if (wr == 0) PG8_BAR; }
        if constexpr (!Epi::AFTER_DRAIN) { E(acc, cur, wr, wc, fr, fq); S.done(cur); }
        if (!has_next) break;
#pragma unroll
        for (int a = 0; a < 2; ++a)
#pragma unroll
            for (int b = 0; b < 2; ++b)
#pragma unroll
                for (int m = 0; m < 4; ++m)
#pragma unroll
                    for (int n = 0; n < 2; ++n) acc[a][b][m][n] = (f32x4){0.f, 0.f, 0.f, 0.f};
        cur = nxt; cA = nA; cB = nB; ++ui;
        if constexpr (ALIGN_EPI) { if (wr == 1) PG8_BAR; }
    }
    PG8_WAIT_V(0);
    if constexpr (!ALIGN_EPI) { if (wr == 0) PG8_BAR; }
    PG8_BAR;
    if constexpr (Epi::AFTER_DRAIN) { E.fused(acc, cur, wr, wc, fr, fq, lds, wid, lane); S.done(cur); }
#undef PG8_SA
#undef PG8_SB
#undef PG8_STAGE
#undef PG8_LDA
#undef PG8_LDB
#undef PG8_MMA
#undef PG8_WAIT_V
#undef PG8_WAIT_L
#undef PG8_BAR
#undef PG8_SCHED
}
}
#define MK_N_LAUNCHES 1
#ifndef MK_N_LAUNCHES
#define MK_N_LAUNCHES 1
#endif
constexpr int DM = 2048, NB = 8, SEQ = 2048, T = NB * SEQ;
constexpr int AW = 1024, NH = 8, HD = 64, VD = 128, INC = 6144;
constexpr int PNK = 128, PTOPK = 16, PEH = 8, EPT = PEH * PTOPK;
constexpr float EPS = 1e-6f;
constexpr float C2 = 0.125f * 1.4426950408889634f;
constexpr int NPHASE = 9;
constexpr float U8_SCALE = 1024.f, V8_SCALE = 16.f, H8_SCALE = 16.f;
constexpr size_t MiB = 1u << 20;
constexpr size_t WS_WIN = 1 * MiB, WS_WOUT = 25 * MiB, WS_WQ = 33 * MiB, WS_SK = 41 * MiB, WS_SSQ = 42 * MiB, WS_EIDX = 44 * MiB, WS_EGATE = 52 * MiB, WS_RSTD = 60 * MiB;
constexpr size_t WS_XN = 64 * MiB;
constexpr size_t WS_Q = 128 * MiB, WS_K = 160 * MiB, WS_V = 192 * MiB;
constexpr size_t WS_CB = 224 * MiB, WS_CC = 256 * MiB, WS_CX = 288 * MiB;
constexpr size_t WS_UT = 320 * MiB, WS_VT = 384 * MiB, WS_END = 448 * MiB;
constexpr size_t WS_CTL = 0; constexpr int CW_BAR = 1024, CTL_ZERO_BYTES = 65536;
constexpr size_t WS_H8 = 288 * MiB;
constexpr size_t WS_PART = 64 * MiB, WS_ACT = 192 * MiB;
constexpr int MISC_OFF = 143360;
constexpr int LDS_BYTES = 147456;
constexpr int NWAVES = 8, NTHREADS = 512;

#define LAS __attribute__((address_space(3)))
typedef unsigned short bf16;
typedef unsigned v4u __attribute__((ext_vector_type(4)));
typedef unsigned v2u __attribute__((ext_vector_type(2)));
typedef float f32x4 __attribute__((ext_vector_type(4)));
typedef float f32x2 __attribute__((ext_vector_type(2)));
typedef float f32x16 __attribute__((ext_vector_type(16)));
typedef short bf16x8 __attribute__((ext_vector_type(8)));
typedef short s16x4 __attribute__((ext_vector_type(4)));
typedef __bf16 bf16x2_t __attribute__((ext_vector_type(2)));
#define LDS_WAIT() asm volatile("s_waitcnt lgkmcnt(0)" ::: "memory")
__device__ __forceinline__ unsigned pk2(float lo, float hi) { f32x2 v = {lo, hi}; bf16x2_t b = __builtin_convertvector(v, bf16x2_t); return __builtin_bit_cast(unsigned, b); }
__device__ __forceinline__ float bflo(unsigned u) { return __uint_as_float(u << 16); }
__device__ __forceinline__ float bfhi(unsigned u) { return __uint_as_float(u & 0xffff0000u); }
__device__ __forceinline__ float wave_sum(float v) {
#pragma unroll
    for (int o = 1; o < 64; o <<= 1) v += __shfl_xor(v, o);
    return v;
}
__device__ __forceinline__ float wave_max(float v) {
#pragma unroll
    for (int o = 1; o < 64; o <<= 1) v = fmaxf(v, __shfl_xor(v, o));
    return v;
}

#define XB_TMO      128
#define XB_XCNT(j)  (256  + 64 * (j))
#define XB_XSUB(j)  (1280 + 64 * (j))
#define XB_XGEN(j)  (2304 + 64 * (j))
#define XB_TOP      3328
#define XB_TOPGEN   3392
#define XCD_BAR_WORDS 3456
#define XB_SPIN_CAP (1u << 18)

__device__ __forceinline__ unsigned xb_ld(unsigned* p)              { return __hip_atomic_load(p, __ATOMIC_RELAXED, __HIP_MEMORY_SCOPE_AGENT); }
__device__ __forceinline__ unsigned xb_add(unsigned* p, unsigned v) { return __hip_atomic_fetch_add(p, v, __ATOMIC_RELAXED, __HIP_MEMORY_SCOPE_AGENT); }
__device__ __forceinline__ unsigned xb_xcc_id() { return (unsigned)__builtin_amdgcn_s_getreg((3 << 11) | 20) & 0xFu; }
#define XB_SPIN(cond, bar) do { unsigned _sp = 0; while (cond) { __builtin_amdgcn_s_sleep(1); \
    if ((++_sp & 255u) == 0u) { if (xb_ld(&(bar)[XB_TMO])) break; if (_sp > XB_SPIN_CAP) { atomicAdd(&(bar)[XB_TMO], 1u); break; } } } } while (0)

struct XcdBarrier {
    unsigned* bar; unsigned x;
    volatile LAS unsigned* st;
};

__device__ __forceinline__ XcdBarrier xcd_barrier_post(unsigned* bar, volatile LAS unsigned* st) {
    XcdBarrier b; b.bar = bar; b.x = xb_xcc_id(); b.st = st;
    if (threadIdx.x == 0) (void)xb_add(&bar[XB_XCNT(b.x)], 1u);
    return b;
}
__device__ __forceinline__ void xcd_barrier_complete(unsigned* bar, unsigned x, unsigned& nloc, unsigned& nx) {
    const unsigned G = gridDim.x * gridDim.y * gridDim.z;
    unsigned sum, cnt, mine, sp = 0u;
    for (;;) {
        sum = 0u; cnt = 0u; mine = 0u;
#pragma unroll
        for (unsigned j = 0; j < 16; ++j) { const unsigned c = xb_ld(&bar[XB_XCNT(j)]); sum += c; cnt += (c > 0u) ? 1u : 0u; mine = (j == x) ? c : mine; }
        if (sum == G) break;
        __builtin_amdgcn_s_sleep(1);
        if ((++sp & 255u) == 0u) { if (xb_ld(&bar[XB_TMO])) break; if (sp > XB_SPIN_CAP) { atomicAdd(&bar[XB_TMO], 1u); break; } }
    }
    nloc = mine > 0u ? mine : 1u; nx = cnt > 0u ? cnt : 1u;
}

__device__ __forceinline__ void xcd_barrier(const XcdBarrier& b) {
    asm volatile("s_waitcnt vmcnt(0)" ::: "memory");
    __syncthreads();
    if (threadIdx.x == 0) {
        unsigned* bar = b.bar;
        __builtin_amdgcn_s_waitcnt(0);
        unsigned nloc = b.st[0], nx = b.st[1];
        if (nloc == 0u) { xcd_barrier_complete(bar, b.x, nloc, nx); b.st[0] = nloc; b.st[1] = nx; }
        const unsigned old = xb_add(&bar[XB_XSUB(b.x)], 1u);
        const unsigned gen = old / nloc;
        if (old + 1u == (gen + 1u) * nloc) {
            __builtin_amdgcn_fence(__ATOMIC_RELEASE, "agent");
            asm volatile("s_waitcnt vmcnt(0)" ::: "memory");
            const unsigned og = xb_add(&bar[XB_TOP], 1u);
            const unsigned tg = og / nx;
            if (og + 1u == (tg + 1u) * nx) xb_add(&bar[XB_TOPGEN], 1u);
            else XB_SPIN(xb_ld(&bar[XB_TOPGEN]) == tg, bar);
            __builtin_amdgcn_fence(__ATOMIC_ACQUIRE, "agent");
            xb_add(&bar[XB_XGEN(b.x)], 1u);
            asm volatile("s_waitcnt vmcnt(0)" ::: "memory");
        } else {
            XB_SPIN(xb_ld(&bar[XB_XGEN(b.x)]) == gen, bar);
            __builtin_amdgcn_fence(__ATOMIC_ACQUIRE, "agent");
            asm volatile("s_waitcnt vmcnt(0)" ::: "memory");
        }
    }
    __syncthreads();
}


namespace pg8 {
struct EpiProj {
    static constexpr bool PERM = true, AFTER_DRAIN = false;
    bf16_t* base0; const float* qg; const float* kg;
    __device__ __forceinline__ void operator()(const f32x4 (&acc)[2][2][4][2], const Unit& u, int wr, int wc, int fr, int fq) const {
        const int region = u.pn >> 2;
        bf16_t* O = base0 + (size_t)region * (16u << 20);
        const int row0 = u.pm * BM + wr * 64 + fr, col0 = (u.pn & 3) * 256 + wc * 64 + 8 * fq;
        if (region < 2) {
            const float* g = region == 0 ? qg : kg; const float sc = region == 0 ? 0.125f * 1.4426950408889634f : 1.0f;
            f32x4 gv[2][2];
#pragma unroll
            for (int bj = 0; bj < 2; ++bj)
#pragma unroll
                for (int n = 0; n < 2; ++n) gv[bj][n] = *(const f32x4*)(g + bj * 32 + 8 * fq + 4 * n) * sc;
#pragma unroll
            for (int ai = 0; ai < 2; ++ai)
#pragma unroll
                for (int m = 0; m < 4; ++m) {
                    float ss = 0.f;
#pragma unroll
                    for (int bj = 0; bj < 2; ++bj)
#pragma unroll
                        for (int n = 0; n < 2; ++n) { const f32x4 x = acc[ai][bj][m][n]; ss += (x[0] * x[0] + x[1] * x[1]) + (x[2] * x[2] + x[3] * x[3]); }
                    ss += __shfl_xor(ss, 16); ss += __shfl_xor(ss, 32);
                    const float rs = __builtin_amdgcn_rsqf(ss * (1.0f / 64.0f) + 1e-6f);
                    bf16_t* rowp = O + (size_t)(row0 + ai * HALF + m * 16) * 1024 + col0;
#pragma unroll
                    for (int bj = 0; bj < 2; ++bj) { const f32x4 v0 = acc[ai][bj][m][0] * rs * gv[bj][0], v1 = acc[ai][bj][m][1] * rs * gv[bj][1];
                        u32x4 w; w.x = cvt_pk_bf16(v0[0], v0[1]); w.y = cvt_pk_bf16(v0[2], v0[3]); w.z = cvt_pk_bf16(v1[0], v1[1]); w.w = cvt_pk_bf16(v1[2], v1[3]);
                        *(u32x4*)(rowp + bj * 32) = w; }
                }
        } else {
#pragma unroll
            for (int ai = 0; ai < 2; ++ai)
#pragma unroll
                for (int m = 0; m < 4; ++m) { bf16_t* rowp = O + (size_t)(row0 + ai * HALF + m * 16) * 1024 + col0;
#pragma unroll
                    for (int bj = 0; bj < 2; ++bj) { const f32x4 v0 = acc[ai][bj][m][0], v1 = acc[ai][bj][m][1];
                        u32x4 w; w.x = cvt_pk_bf16(v0[0], v0[1]); w.y = cvt_pk_bf16(v0[2], v0[3]); w.z = cvt_pk_bf16(v1[0], v1[1]); w.w = cvt_pk_bf16(v1[2], v1[3]);
                        *(u32x4*)(rowp + bj * 32) = w; } }
        }
    }
};
struct EpiX1 {
    static constexpr bool PERM = true, AFTER_DRAIN = false;
    const float* x; float* out; bf16_t* a2; const float* gf; float* ssq; unsigned char* h8;
    __device__ __forceinline__ void operator()(const f32x4 (&acc)[2][2][4][2], const Unit& u, int wr, int wc, int fr, int fq) const {
        const int row0 = u.pm * BM + wr * 64 + fr, col0 = u.pn * BM + wc * 32 + 8 * fq;
        f32x4 gv[2][2];
#pragma unroll
        for (int bj = 0; bj < 2; ++bj)
#pragma unroll
            for (int n = 0; n < 2; ++n) gv[bj][n] = *(const f32x4*)(gf + col0 + bj * HALF + 4 * n);
#pragma unroll
        for (int ai = 0; ai < 2; ++ai)
#pragma unroll
            for (int m = 0; m < 4; ++m) { const int row = row0 + ai * HALF + m * 16; const size_t off = (size_t)row * 2048 + col0; float ss = 0.f;
#pragma unroll
                for (int bj = 0; bj < 2; ++bj) {
                    const f32x4 x0 = *(const f32x4*)(x + off + bj * HALF), x1 = *(const f32x4*)(x + off + bj * HALF + 4);
                    const f32x4 v0 = x0 + acc[ai][bj][m][0], v1 = x1 + acc[ai][bj][m][1];
                    ss += (v0[0] * v0[0] + v0[1] * v0[1]) + (v0[2] * v0[2] + v0[3] * v0[3]); ss += (v1[0] * v1[0] + v1[1] * v1[1]) + (v1[2] * v1[2] + v1[3] * v1[3]);
                    const f32x4 a0 = v0 * gv[bj][0], a1 = v1 * gv[bj][1];
                    u32x4 w; w.x = cvt_pk_bf16(a0[0], a0[1]); w.y = cvt_pk_bf16(a0[2], a0[3]); w.z = cvt_pk_bf16(a1[0], a1[1]); w.w = cvt_pk_bf16(a1[2], a1[3]);
                    *(u32x4*)(a2 + off + bj * HALF) = w;
                    { const f32x4 b0 = a0 * 16.0f, b1 = a1 * 16.0f; unsigned p = 0u, q2 = 0u;
#pragma unroll
                      for (int e_ = 0; e_ < 4; ++e_) { const int i0_ = __builtin_amdgcn_fmed3f(__builtin_rintf(b0[e_]), -127.f, 127.f), i1_ = __builtin_amdgcn_fmed3f(__builtin_rintf(b1[e_]), -127.f, 127.f);
                          p |= ((unsigned)i0_ & 0xffu) << (8 * e_); q2 |= ((unsigned)i1_ & 0xffu) << (8 * e_); }
                      typedef unsigned u32x2_ __attribute__((ext_vector_type(2))); *(u32x2_*)(h8 + off + bj * HALF) = (u32x2_){p, q2}; } }
                ss += __shfl_xor(ss, 16); ss += __shfl_xor(ss, 32);
                if (fq == 0) ssq[(size_t)row * 32 + u.pn * 4 + wc] = ss; }
    }
};
}

__device__ __forceinline__ void p0_transpose_item(const float* W, int K, int N, bf16* WT, LAS float* scr, int item, int lane, bool permg) {
    const int nblk = N / 32, kb = item / nblk, nb = item % nblk, k0 = 64 * kb, n0 = 32 * nb;
#pragma unroll 8
    for (int i = 0; i < 32; ++i) { const int kk = 2 * i + (lane >> 5); scr[kk * 33 + (lane & 31)] = W[(size_t)(k0 + kk) * N + n0 + (lane & 31)]; }
    LDS_WAIT(); asm volatile("" ::: "memory");
    int nd = n0; if (permg) { const int gl = (n0 & 255) >> 5; nd = (n0 & ~255) + 32 * (4 * (gl & 1) + (gl >> 1)); }
    const int c = lane & 7;
#pragma unroll
    for (int j = 0; j < 4; ++j) { const int n = (lane >> 3) + 8 * j; const LAS float* s = scr + (8 * c) * 33 + n;
        v4u o; o.x = pk2(s[0 * 33], s[1 * 33]); o.y = pk2(s[2 * 33], s[3 * 33]); o.z = pk2(s[4 * 33], s[5 * 33]); o.w = pk2(s[6 * 33], s[7 * 33]);
        *(v4u*)(WT + (size_t)(nd + n) * K + k0 + 8 * c) = o; }
    LDS_WAIT(); asm volatile("" ::: "memory");
}
__device__ __forceinline__ void rms_row_to_bf16(const float* xrow, const float* g, bf16* orow, int lane) {
    const f32x4* xr = (const f32x4*)xrow + lane; const f32x4* gr = (const f32x4*)g + lane;
    f32x4 v[8]; float s = 0.f;
#pragma unroll
    for (int j = 0; j < 8; ++j) { v[j] = xr[64 * j]; s += (v[j].x * v[j].x + v[j].y * v[j].y) + (v[j].z * v[j].z + v[j].w * v[j].w); }
    const float rstd = 1.0f / sqrtf(wave_sum(s) * (1.f / DM) + EPS);
    v2u* o8 = (v2u*)orow + lane;
#pragma unroll
    for (int j = 0; j < 8; ++j) { const f32x4 gg = gr[64 * j]; v2u w; w.x = pk2(v[j].x * rstd * gg.x, v[j].y * rstd * gg.y); w.y = pk2(v[j].z * rstd * gg.z, v[j].w * rstd * gg.w); o8[64 * j] = w; }
}
__device__ __forceinline__ void cvt_bf16_stream(const float* src, bf16* dst, size_t n8, size_t gtid, size_t nthr) {
    for (size_t i = gtid; i < n8; i += nthr) { const f32x4 a = *(const f32x4*)(src + i * 8), b = *(const f32x4*)(src + i * 8 + 4);
        v4u o; o.x = pk2(a.x, a.y); o.y = pk2(a.z, a.w); o.z = pk2(b.x, b.y); o.w = pk2(b.z, b.w); *(v4u*)(dst + i * 8) = o; }
}

__device__ __forceinline__ void cvt_i4_slices(const float* src, unsigned char* dst, float inv_step, size_t gtid, size_t nthr) {
    for (size_t i = gtid; i < (size_t)16384 * 64; i += nthr) { v4u o; const size_t e = i >> 6; const int c32 = (int)(i & 63), s = c32 >> 3, sub = c32 & 7;
#pragma unroll
        for (int w = 0; w < 4; ++w) { const f32x4 a = *(const f32x4*)(src + i * 32 + 8 * w) * inv_step, b = *(const f32x4*)(src + i * 32 + 8 * w + 4) * inv_step; unsigned d = 0u;
#pragma unroll
            for (int e_ = 0; e_ < 4; ++e_) { const int lo = (int)__builtin_amdgcn_fmed3f(__builtin_rintf(a[e_]), -8.f, 7.f) + 8, hi = (int)__builtin_amdgcn_fmed3f(__builtin_rintf(b[e_]), -8.f, 7.f) + 8; d |= ((unsigned)lo | ((unsigned)hi << 4)) << (8 * e_); }
            if (w == 0) o.x = d; else if (w == 1) o.y = d; else if (w == 2) o.z = d; else o.w = d; }
        *(v4u*)(dst + ((size_t)s * 16384 + e) * 128 + 16 * sub) = o; }
}
__device__ __forceinline__ float table_std16(const float* src, LAS float* scr, int tid) {
    float s = 0.f;
#pragma unroll
    for (int j = 0; j < 16; ++j) { const f32x4 v = *(const f32x4*)(src + (size_t)(j * 512 + tid) * 4); s += (v.x * v.x + v.y * v.y) + (v.z * v.z + v.w * v.w); }
    s = wave_sum(s);
    __syncthreads();
    if ((tid & 63) == 0) scr[tid >> 6] = s;
    __syncthreads();
    float t = 0.f;
#pragma unroll
    for (int w = 0; w < 8; ++w) t += scr[w];
    __syncthreads();
    return sqrtf(t * (1.0f / 32768.0f));
}
__device__ __forceinline__ void cvt_i8_slices(const float* src, unsigned char* dst, float scale, size_t gtid, size_t nthr) {
    for (size_t i = gtid; i < (size_t)16384 * 128; i += nthr) { v4u o; const size_t e = i >> 7; const int c16 = (int)(i & 127), s = c16 >> 3, sub = c16 & 7;
#pragma unroll
        for (int q = 0; q < 4; ++q) { const f32x4 a = *(const f32x4*)(src + i * 16 + 4 * q) * scale; unsigned w = 0u;
#pragma unroll
            for (int e_ = 0; e_ < 4; ++e_) { const int iv = (int)__builtin_amdgcn_fmed3f(__builtin_rintf(a[e_]), -127.f, 127.f); w |= ((unsigned)iv & 0xffu) << (8 * e_); }
            if (q == 0) o.x = w; else if (q == 1) o.y = w; else if (q == 2) o.z = w; else o.w = w; }
        *(v4u*)(dst + ((size_t)s * 16384 + e) * 128 + 16 * sub) = o; }
}
__device__ __forceinline__ void cvt_fp8_slices(const float* src, unsigned char* dst, float scale, size_t gtid, size_t nthr) {
    for (size_t i = gtid; i < (size_t)16384 * 128; i += nthr) { v4u o; const size_t e = i >> 7; const int c16 = (int)(i & 127), s = c16 >> 3, sub = c16 & 7;
#pragma unroll
        for (int q = 0; q < 4; ++q) { const f32x4 a = *(const f32x4*)(src + i * 16 + 4 * q) * scale; int w = __builtin_amdgcn_cvt_pk_fp8_f32(a.x, a.y, 0, false); w = __builtin_amdgcn_cvt_pk_fp8_f32(a.z, a.w, w, true);
            if (q == 0) o.x = (unsigned)w; else if (q == 1) o.y = (unsigned)w; else if (q == 2) o.z = (unsigned)w; else o.w = (unsigned)w; }
        *(v4u*)(dst + ((size_t)s * 16384 + e) * 128 + 16 * sub) = o; }
}

namespace att {
constexpr int SLOTB = 32768;
constexpr int NSLOT = 3, LW_OFF = NSLOT * SLOTB;
constexpr int XSTR = 132;
__device__ __forceinline__ void glds16(const void* gsrc, unsigned lds_dst) { unsigned keep;
    asm volatile("s_mov_b32 %0, m0\n\ts_mov_b32 m0, %2\n\ts_nop 0\n\tglobal_load_lds_dwordx4 %1, off\n\ts_mov_b32 m0, %0" : "=&s"(keep) : "v"(gsrc), "s"(lds_dst) : "memory"); }
__device__ __forceinline__ int crow(int r, int hi) { return (r & 3) + 8 * (r >> 2) + 4 * hi; }
typedef short v4i16_t __attribute__((ext_vector_type(4)));
__device__ __forceinline__ s16x4 vtr(const LAS char* p) { return __builtin_bit_cast(s16x4, __builtin_amdgcn_ds_read_tr16_b64_v4i16((LAS v4i16_t*)p)); }
#define ATT_WAIT_BAR(N) asm volatile("s_waitcnt vmcnt(" #N ") lgkmcnt(0)\n\ts_barrier" ::: "memory")

__device__ __forceinline__ void attn_unit(int b, int h, int qblk, const bf16* Q, const bf16* K, const bf16* V, bf16* MIX, const float* subg, float lam, float M2, LAS char* lds) {
    const int tid = threadIdx.x, lane = tid & 63, r32 = lane & 31, hi = lane >> 5, wid = __builtin_amdgcn_readfirstlane(tid >> 6), c = wid >> 2, qs = wid & 3;
    const size_t rowbase = (size_t)b * SEQ; const int q0 = qblk * 128, NT = 2 * (qblk + 1);
    const unsigned lds0 = (unsigned)(uintptr_t)lds;
    const bf16* ksrc[2]; const bf16* vsrc[2]; unsigned kdst[2], vdst[2];
#pragma unroll
    for (int i = 0; i < 2; ++i) { const int pk = 2 * wid + i, rr = lane >> 4, p = lane & 15, r = 4 * pk + rr;
        ksrc[i] = K + (rowbase + r) * 1024 + h * 128 + ((p ^ (r & 15)) * 8); kdst[i] = lds0 + pk * 1024;
        vsrc[i] = V + (rowbase + r) * 1024 + h * 128 + ((p ^ (rr << 2)) * 8); vdst[i] = lds0 + 16384 + pk * 1024; }
#define ATT_DMA(t, slot) do { _Pragma("unroll") for (int i_ = 0; i_ < 2; ++i_) { glds16(ksrc[i_] + (size_t)(t) * 64 * 1024, (unsigned)__builtin_amdgcn_readfirstlane(kdst[i_] + (slot) * SLOTB)); \
        glds16(vsrc[i_] + (size_t)(t) * 64 * 1024, (unsigned)__builtin_amdgcn_readfirstlane(vdst[i_] + (slot) * SLOTB)); } } while (0)
    ATT_DMA(0, 0); ATT_DMA(1, 1);
    const int qrow = q0 + 32 * qs + r32;
    bf16x8 qr[4];
#pragma unroll
    for (int d0 = 0; d0 < 4; ++d0) qr[d0] = *(const bf16x8*)(Q + (rowbase + qrow) * 1024 + h * 128 + c * 64 + d0 * 16 + hi * 8);
    asm volatile("" : "+v"(qr[0]), "+v"(qr[1]), "+v"(qr[2]), "+v"(qr[3]));
    const float slope2 = exp2f(-(float)(h + 1)) * 1.4426950408889634f;
    float base = -slope2 * (float)(qrow - 4 * hi) - M2;
    const float s32 = 32.f * slope2, s64 = 64.f * slope2;
    f32x16 o[4]; o[0] = f32x16{}; o[1] = f32x16{}; o[2] = f32x16{}; o[3] = f32x16{};
    float lsum = 0.f;
    int kofs[4], vofs[4];
    { const int q4 = (lane & 15) >> 2, p4 = lane & 3, gb = (lane >> 4) & 1;
#pragma unroll
      for (int d0 = 0; d0 < 4; ++d0) { kofs[d0] = r32 * 256 + (((8 * c + 2 * d0 + hi) ^ (r32 & 15)) << 4); vofs[d0] = 16384 + (4 * hi + q4) * 256 + (((((d0 ^ q4) << 2) | (gb << 1) | (p4 >> 1))) << 4) + (p4 & 1) * 8; } }
    const LAS char* lbase = (const LAS char*)lds;
    const int qw0 = q0 + 32 * qs;
    int slot = 0;
    for (int t = 0; t < NT; ++t) {
        if (t == 0) { ATT_WAIT_BAR(0); } else if (t + 1 < NT) { ATT_WAIT_BAR(4); } else { ATT_WAIT_BAR(0); }
        if (t + 2 < NT) { const int s2_ = (slot == 0) ? 2 : slot - 1; ATT_DMA(t + 2, s2_); }
        const int k0 = 64 * t;
        if (k0 <= qw0 + 31) {
            const LAS char* sp_ = lbase + slot * SLOTB;
            f32x16 p0, p1;
#pragma unroll
            for (int r = 0; r < 16; ++r) { p0[r] = __builtin_fmaf(slope2, (float)((r & 3) + 8 * (r >> 2)), base); p1[r] = p0[r] + s32; }
            __builtin_amdgcn_s_setprio(1);
#pragma unroll
            for (int d0 = 0; d0 < 4; ++d0) {
                const bf16x8 ka = *(const LAS bf16x8*)(sp_ + kofs[d0]), kb = *(const LAS bf16x8*)(sp_ + kofs[d0] + 8192);
                p0 = __builtin_amdgcn_mfma_f32_32x32x16_bf16(ka, qr[d0], p0, 0, 0, 0);
                p1 = __builtin_amdgcn_mfma_f32_32x32x16_bf16(kb, qr[d0], p1, 0, 0, 0); }
            __builtin_amdgcn_s_setprio(0);
#pragma unroll
            for (int r = 0; r < 16; ++r) { p0[r] = __builtin_amdgcn_exp2f(p0[r]); p1[r] = __builtin_amdgcn_exp2f(p1[r]); }
            if (k0 + 63 > qw0) {
                const int dq = qrow - k0;
#pragma unroll
                for (int r = 0; r < 16; ++r) { const int kk = crow(r, hi); if (kk > dq) p0[r] = 0.f; if (kk + 32 > dq) p1[r] = 0.f; }
            }
            {
                float s0 = p0[0] + p1[0], s1 = p0[1] + p1[1], s2 = p0[2] + p1[2], s3 = p0[3] + p1[3];
#pragma unroll
                for (int r = 4; r < 16; r += 4) { s0 += p0[r] + p1[r]; s1 += p0[r + 1] + p1[r + 1]; s2 += p0[r + 2] + p1[r + 2]; s3 += p0[r + 3] + p1[r + 3]; }
                lsum += (s0 + s1) + (s2 + s3); }
            bf16x8 pw[4];
#pragma unroll
            for (int ks = 0; ks < 4; ++ks) { v4u w;
                if (ks < 2) { w.x = pk2(p0[8 * ks + 0], p0[8 * ks + 1]); w.y = pk2(p0[8 * ks + 2], p0[8 * ks + 3]); w.z = pk2(p0[8 * ks + 4], p0[8 * ks + 5]); w.w = pk2(p0[8 * ks + 6], p0[8 * ks + 7]); }
                else { const int k2 = ks - 2; w.x = pk2(p1[8 * k2 + 0], p1[8 * k2 + 1]); w.y = pk2(p1[8 * k2 + 2], p1[8 * k2 + 3]); w.z = pk2(p1[8 * k2 + 4], p1[8 * k2 + 5]); w.w = pk2(p1[8 * k2 + 6], p1[8 * k2 + 7]); }
                pw[ks] = __builtin_bit_cast(bf16x8, w); }
            s16x4 fa[8], fb[8];
#define ATT_VLD(F, d0_) do { _Pragma("unroll") for (int ks_ = 0; ks_ < 4; ++ks_) { F[2 * ks_] = vtr(sp_ + vofs[d0_] + ks_ * 4096); F[2 * ks_ + 1] = vtr(sp_ + vofs[d0_] + ks_ * 4096 + 2048); } } while (0)
#define ATT_PV(F, d0_) do { _Pragma("unroll") for (int ks_ = 0; ks_ < 4; ++ks_) { const bf16x8 vf_ = (bf16x8){F[2 * ks_][0], F[2 * ks_][1], F[2 * ks_][2], F[2 * ks_][3], F[2 * ks_ + 1][0], F[2 * ks_ + 1][1], F[2 * ks_ + 1][2], F[2 * ks_ + 1][3]}; \
                o[d0_] = __builtin_amdgcn_mfma_f32_32x32x16_bf16(pw[ks_], vf_, o[d0_], 0, 0, 0); } } while (0)
            __builtin_amdgcn_s_setprio(1);
            ATT_VLD(fa, 0); ATT_VLD(fb, 1); __builtin_amdgcn_sched_barrier(0);
            ATT_PV(fa, 0); __builtin_amdgcn_sched_barrier(0); ATT_VLD(fa, 2); __builtin_amdgcn_sched_barrier(0);
            ATT_PV(fb, 1); __builtin_amdgcn_sched_barrier(0); ATT_VLD(fb, 3); __builtin_amdgcn_sched_barrier(0);
            ATT_PV(fa, 2); __builtin_amdgcn_sched_barrier(0);
            ATT_PV(fb, 3);
            __builtin_amdgcn_s_setprio(0);
#undef ATT_VLD
#undef ATT_PV
        }
        base += s64;
        slot = (slot == NSLOT - 1) ? 0 : slot + 1;
    }
    ATT_WAIT_BAR(0);
    LAS float* lw = (LAS float*)(lds + LW_OFF) + wid * 32;
    { auto rr = __builtin_amdgcn_permlane32_swap(__float_as_uint(lsum), __float_as_uint(lsum), false, false); lsum = __uint_as_float(rr[0]) + __uint_as_float(rr[1]); }
    if (hi == 0) lw[r32] = lsum;
    LDS_WAIT();
    LAS float* X = (LAS float*)lds + qs * 32 * XSTR;
#pragma unroll
    for (int r = 0; r < 16; ++r) { const float rl = 1.0f / lw[crow(r, hi)];
#pragma unroll
        for (int d0 = 0; d0 < 4; ++d0) o[d0][r] *= rl; }
    if (c == 1) {
#pragma unroll
        for (int r = 0; r < 16; ++r)
#pragma unroll
            for (int d0 = 0; d0 < 4; ++d0) X[crow(r, hi) * XSTR + d0 * 32 + r32] = o[d0][r];
    }
    ATT_WAIT_BAR(0);
    if (c == 0) {
#pragma unroll
        for (int r = 0; r < 16; ++r)
#pragma unroll
            for (int d0 = 0; d0 < 4; ++d0) { LAS float* px = X + crow(r, hi) * XSTR + d0 * 32 + r32; const float a = o[d0][r] - lam * (*px); *px = a; }
        LDS_WAIT(); asm volatile("" ::: "memory");
        const LAS f32x4* rp = (const LAS f32x4*)(X + r32 * XSTR + hi * 64);
        f32x4 av[16]; float ss = 0.f;
#pragma unroll
        for (int j = 0; j < 16; ++j) { av[j] = rp[j]; ss += (av[j].x * av[j].x + av[j].y * av[j].y) + (av[j].z * av[j].z + av[j].w * av[j].w); }
        { auto rr = __builtin_amdgcn_permlane32_swap(__float_as_uint(ss), __float_as_uint(ss), false, false); ss = __uint_as_float(rr[0]) + __uint_as_float(rr[1]); }
        const float rs = 0.8f / sqrtf(ss * (1.0f / 128.0f) + EPS);
        bf16* op = MIX + (rowbase + qrow) * 2048 + h * 128 + hi * 64;
#pragma unroll
        for (int j = 0; j < 8; ++j) { const f32x4 g0 = *(const f32x4*)(subg + hi * 64 + 8 * j), g1 = *(const f32x4*)(subg + hi * 64 + 8 * j + 4); const f32x4 a0 = av[2 * j] * rs * g0, a1 = av[2 * j + 1] * rs * g1;
            v4u w; w.x = pk2(a0.x, a0.y); w.y = pk2(a0.z, a0.w); w.z = pk2(a1.x, a1.y); w.w = pk2(a1.z, a1.w); *(v4u*)(op + 8 * j) = w; }
    }
    ATT_WAIT_BAR(0);
#undef ATT_DMA
}
}


#ifndef DBG_NAIVE_ATTN
#define DBG_NAIVE_ATTN 0
#endif
#if DBG_NAIVE_ATTN
__device__ __forceinline__ void naive_attn_row(int b, int h, int q, const bf16* Q, const bf16* K, const bf16* V, bf16* MIX, const float* subg, float lam, LAS float* S, int lane) {
    const size_t rowbase = (size_t)b * SEQ; const float slope2 = exp2f(-(float)(h + 1)) * 1.4426950408889634f;
    for (int c = 0; c < 2; ++c) {
        float qv[64];
        const bf16* qp = Q + (rowbase + q) * 1024 + h * 128 + c * 64;
#pragma unroll
        for (int d = 0; d < 64; d += 2) { const unsigned u = *(const unsigned*)(qp + d); qv[d] = bflo(u); qv[d + 1] = bfhi(u); }
        for (int key = lane; key <= q; key += 64) { const bf16* kp = K + (rowbase + key) * 1024 + h * 128 + c * 64; float s = 0.f;
#pragma unroll
            for (int d = 0; d < 64; d += 2) { const unsigned u = *(const unsigned*)(kp + d); s += qv[d] * bflo(u) + qv[d + 1] * bfhi(u); }
            S[c * 2048 + key] = s - slope2 * (float)(q - key); }
    }
    LDS_WAIT();
    float linv[2];
    for (int c = 0; c < 2; ++c) { float m = -1e30f; for (int key = lane; key <= q; key += 64) m = fmaxf(m, S[c * 2048 + key]); m = wave_max(m);
        float l = 0.f; for (int key = lane; key <= q; key += 64) { const float p = exp2f(S[c * 2048 + key] - m); S[c * 2048 + key] = p; l += p; } linv[c] = 1.0f / wave_sum(l); }
    for (int key = lane; key <= q; key += 64) S[key] = S[key] * linv[0] - lam * S[2048 + key] * linv[1];
    LDS_WAIT();
    float o0 = 0.f, o1 = 0.f; const bf16* vp = V + rowbase * 1024 + h * 128 + lane;
    for (int key = 0; key <= q; ++key) { const float a = S[key]; o0 += a * __uint_as_float((unsigned)vp[(size_t)key * 1024] << 16); o1 += a * __uint_as_float((unsigned)vp[(size_t)key * 1024 + 64] << 16); }
    const float ss = wave_sum(o0 * o0 + o1 * o1); const float rs = 0.8f / sqrtf(ss * (1.0f / 128.0f) + EPS);
    bf16* op = MIX + (rowbase + q) * 2048 + h * 128 + lane;
    op[0] = (bf16)(pk2(o0 * rs * subg[lane], 0.f) & 0xffffu); op[64] = (bf16)(pk2(o1 * rs * subg[lane + 64], 0.f) & 0xffffu);
    LDS_WAIT();
}
#endif

__device__ __forceinline__ unsigned ord_key(float f) { const unsigned u = __float_as_uint(f); return (u & 0x80000000u) ? ~u : (u | 0x80000000u); }
__device__ __forceinline__ float ord_val(unsigned k) { return __uint_as_float((k & 0x80000000u) ? (k ^ 0x80000000u) : ~k); }
#define CE_DESC(a, b) do { const unsigned hi__ = max((a), (b)), lo__ = min((a), (b)); (a) = hi__; (b) = lo__; } while (0)
__device__ __forceinline__ void sort16_desc(unsigned (&v)[16]) {
#pragma unroll
    for (int k = 2; k <= 16; k <<= 1)
#pragma unroll
        for (int j = k >> 1; j > 0; j >>= 1)
#pragma unroll
            for (int i = 0; i < 16; ++i) { const int l = i ^ j; if (l > i) { if ((i & k) == 0) CE_DESC(v[i], v[l]); else CE_DESC(v[l], v[i]); } }
}
__device__ __forceinline__ void merge16_desc_rev(unsigned (&a)[16], const unsigned (&brev)[16]) {
#pragma unroll
    for (int i = 0; i < 16; ++i) a[i] = max(a[i], brev[i]);
#pragma unroll
    for (int j = 8; j > 0; j >>= 1)
#pragma unroll
        for (int i = 0; i < 16; ++i) { const int l = i ^ j; if (l > i) CE_DESC(a[i], a[l]); }
}

constexpr int P5_LST_OFF = 65536, P5_TAB_OFF = P5_LST_OFF + 16384;
__device__ __forceinline__ void peer_topk_item(int tile, int h, const bf16* QP, const float* SSQ, int* EIDX, float* EGATE, float* RSTD, LAS char* lds) {
    const int tid = threadIdx.x, lane = tid & 63, r32 = lane & 31, hi = lane >> 5, wid = __builtin_amdgcn_readfirstlane(tid >> 6);
    LAS unsigned* LST = (LAS unsigned*)(lds + P5_LST_OFF);
    const LAS unsigned char* TAB = (const LAS unsigned char*)(lds + P5_TAB_OFF);
    const int tok0 = tile * 128;
    {
        const int c = wid >> 2, tb = wid & 3;
        bf16x8 qf[8];
        const bf16* qp = QP + (size_t)(tok0 + tb * 32 + r32) * 2048 + h * 256 + c * 128 + hi * 8;
#pragma unroll
        for (int s = 0; s < 8; ++s) qf[s] = *(const bf16x8*)(qp + 16 * s);
        const LAS char* sp = lds + c * 32768 + hi * 2048 + r32 * 16;
        unsigned best[16];
#pragma unroll
        for (int kb = 0; kb < 4; ++kb) { f32x16 acc = f32x16{};
#pragma unroll
            for (int s = 0; s < 8; ++s) { const bf16x8 sf = *(const LAS bf16x8*)(sp + s * 4096 + kb * 512); acc = __builtin_amdgcn_mfma_f32_32x32x16_bf16(sf, qf[s], acc, 0, 0, 0); }
            unsigned v[16];
#pragma unroll
            for (int r = 0; r < 16; ++r) v[r] = (ord_key(acc[r]) & ~0x7Fu) | (unsigned)(32 * kb + (r & 3) + 8 * (r >> 2)) | (unsigned)(hi << 2);
            sort16_desc(v);
            if (kb == 0) {
#pragma unroll
                for (int i = 0; i < 16; ++i) best[i] = v[i];
            } else { unsigned vr[16];
#pragma unroll
                for (int i = 0; i < 16; ++i) vr[i] = v[15 - i];
                merge16_desc_rev(best, vr); } }
        {
            unsigned br[16];
#pragma unroll
            for (int i = 0; i < 16; ++i) br[i] = (unsigned)__shfl_xor((int)best[15 - i], 32);
            merge16_desc_rev(best, br); }
        if (hi == 0) { LAS unsigned* lrow = LST + (c * 128 + tb * 32 + r32) * 16;
#pragma unroll
            for (int i = 0; i < 4; ++i) *(LAS v4u*)(lrow + 4 * i) = (v4u){best[4 * i], best[4 * i + 1], best[4 * i + 2], best[4 * i + 3]}; }
    }
    __syncthreads();
    {
        const int token = tid >> 2, q = tid & 3;
        const LAS unsigned* l1 = LST + token * 16; const LAS unsigned* l2 = LST + (128 + token) * 16;
        unsigned v[16];
#pragma unroll
        for (int m = 0; m < 13; ++m) { const int n = 4 * m + q; const unsigned pid = TAB[n < 50 ? n : 0]; const unsigned a = l1[pid >> 4], b2 = l2[pid & 15u];
            const unsigned key = (ord_key(ord_val(a & ~0x7Fu) + ord_val(b2 & ~0x7Fu)) & ~0xFFu) | pid; v[m] = n < 50 ? key : 0u; }
        v[13] = 0u; v[14] = 0u; v[15] = 0u;
        sort16_desc(v);
#pragma unroll
        for (int w = 1; w <= 2; w <<= 1) { unsigned br[16];
#pragma unroll
            for (int i = 0; i < 16; ++i) br[i] = (unsigned)__shfl_xor((int)v[15 - i], w);
            merge16_desc_rev(v, br); }
        const int t = tok0 + token;
        const f32x4 p0 = *(const f32x4*)(SSQ + (size_t)t * 32 + 8 * q), p1 = *(const f32x4*)(SSQ + (size_t)t * 32 + 8 * q + 4);
        float ssq = ((p0.x + p0.y) + (p0.z + p0.w)) + ((p1.x + p1.y) + (p1.z + p1.w));
        ssq += __shfl_xor(ssq, 1); ssq += __shfl_xor(ssq, 2);
        const float rstd = 1.0f / sqrtf(ssq * (1.0f / DM) + EPS);
        if (h == 0 && q == 0) RSTD[t] = rstd;
        const unsigned p_top = v[0] & 0xFFu; const float vmax = (ord_val(l1[p_top >> 4] & ~0x7Fu) + ord_val(l2[p_top & 15u] & ~0x7Fu)) * rstd;
        float ev[4]; int ex[4]; float es = 0.f;
#pragma unroll
        for (int m = 0; m < 4; ++m) { const unsigned kk = q == 0 ? v[m] : q == 1 ? v[4 + m] : q == 2 ? v[8 + m] : v[12 + m];
            const unsigned pid = kk & 0xFFu; const unsigned a = l1[pid >> 4], b2 = l2[pid & 15u];
            const float sv = (ord_val(a & ~0x7Fu) + ord_val(b2 & ~0x7Fu)) * rstd;
            ev[m] = __expf(sv - vmax); es += ev[m]; ex[m] = (int)((a & 0x7Fu) * 128u + (b2 & 0x7Fu)); }
        es += __shfl_xor(es, 1); es += __shfl_xor(es, 2);
        const float inv = 1.0f / es;
        *(int4*)(EIDX + (size_t)t * 128 + h * 16 + 4 * q) = make_int4(ex[0], ex[1], ex[2], ex[3]);
        *(f32x4*)(EGATE + (size_t)t * 128 + h * 16 + 4 * q) = (f32x4){ev[0] * inv, ev[1] * inv, ev[2] * inv, ev[3] * inv};
    }
    __syncthreads();
}

__device__ __forceinline__ f32x2 dot16_fp8(const v4u u, const f32x2* h, f32x2 acc) {
#pragma unroll
    for (int w = 0; w < 4; ++w) { const unsigned d = w == 0 ? u.x : w == 1 ? u.y : w == 2 ? u.z : u.w;
        const f32x2 f0 = __builtin_amdgcn_cvt_pk_f32_fp8((int)d, false), f1 = __builtin_amdgcn_cvt_pk_f32_fp8((int)d, true);
        acc = __builtin_elementwise_fma(h[2 * w], f0, acc); acc = __builtin_elementwise_fma(h[2 * w + 1], f1, acc); }
    return acc;
}
__device__ __forceinline__ void axpy16_fp8(const v4u v, f32x2 a2, f32x2* o) {
#pragma unroll
    for (int w = 0; w < 4; ++w) { const unsigned d = w == 0 ? v.x : w == 1 ? v.y : w == 2 ? v.z : v.w;
        const f32x2 f0 = __builtin_amdgcn_cvt_pk_f32_fp8((int)d, false), f1 = __builtin_amdgcn_cvt_pk_f32_fp8((int)d, true);
        o[2 * w] = __builtin_elementwise_fma(a2, f0, o[2 * w]); o[2 * w + 1] = __builtin_elementwise_fma(a2, f1, o[2 * w + 1]); }
}
struct PItem { int t, s; };
__device__ __forceinline__ PItem peer_item(int q, int nq, int nper, int tb, int tstride, int xl) {
    const int j = (q < nq ? q : nq - 1) >> 1; PItem it; const int r = j >= nper ? 1 : 0; it.s = 8 * r + xl; const int t = tb + (j - r * nper) * tstride; it.t = t < T ? t : T - 1; return it; }
__device__ __forceinline__ void pe_idx8(const PItem it, int hh, const int* EIDX, int g, int (&ex)[8]) {
#pragma unroll
    for (int i = 0; i < 2; ++i) { const int4 v = *(const int4*)(EIDX + (size_t)it.t * 128 + g * 16 + 8 * hh + 4 * i); ex[4 * i] = v.x; ex[4 * i + 1] = v.y; ex[4 * i + 2] = v.z; ex[4 * i + 3] = v.w; }
}
__device__ __forceinline__ void pe_gather8(const PItem it, const unsigned char* TB, int sub, const int (&ex)[8], v4u (&uv)[8]) {
    const unsigned char* ub = TB + (size_t)it.s * 16384 * 128 + 16 * sub;
#pragma unroll
    for (int i = 0; i < 8; ++i) uv[i] = *(const v4u*)(ub + (size_t)ex[i] * 128);
}
__device__ __forceinline__ int sdot4(unsigned a, unsigned b, int acc) { return __builtin_amdgcn_sdot4((int)a, (int)b, acc, false); }
__device__ __forceinline__ void pu_acc8(const v4u (&uv)[8], const v4u ha, const v4u hb, int hs8, int (&r)[8]) {
#pragma unroll
    for (int i = 0; i < 8; ++i) { int a = -hs8;
        a = sdot4(uv[i].x & 0x0F0F0F0Fu, ha.x, a); a = sdot4((uv[i].x >> 4) & 0x0F0F0F0Fu, ha.y, a); a = sdot4(uv[i].y & 0x0F0F0F0Fu, ha.z, a); a = sdot4((uv[i].y >> 4) & 0x0F0F0F0Fu, ha.w, a);
        a = sdot4(uv[i].z & 0x0F0F0F0Fu, hb.x, a); a = sdot4((uv[i].z >> 4) & 0x0F0F0F0Fu, hb.y, a); a = sdot4(uv[i].w & 0x0F0F0F0Fu, hb.z, a); r[i] = sdot4((uv[i].w >> 4) & 0x0F0F0F0Fu, hb.w, a); }
}
__device__ __forceinline__ void pu_store(const PItem it, bool valid, float* PART, int lane, const int (&rlo)[8], const int (&rhi)[8]) {
    const int g = lane >> 3, sub = lane & 7;
    int r[16];
#pragma unroll
    for (int i = 0; i < 8; ++i) { r[i] = rlo[i]; r[8 + i] = rhi[i]; }
#pragma unroll
    for (int w = 4, n = 8; w >= 1; w >>= 1, n >>= 1) { const bool up = (lane & w) != 0;
#pragma unroll
        for (int j = 0; j < n; ++j) { const int a = r[j], b2 = r[j + n]; const int keep = up ? b2 : a, send = up ? a : b2; r[j] = keep + __shfl_xor(send, w); } }
    const int i0 = 8 * ((sub >> 2) & 1) + 4 * ((sub >> 1) & 1) + 2 * (sub & 1);
    if (valid) *(f32x2*)(PART + ((size_t)it.s * T + it.t) * 128 + g * 16 + i0) = (f32x2){(float)r[0], (float)r[1]};
}
__device__ __forceinline__ PItem peer_item1(int q, int nq, int tb, int tstride, int xl) { const int j = (q < nq ? q : nq - 1) >> 1; PItem it; it.s = xl; const int t = tb + j * tstride; it.t = t < T ? t : T - 1; return it; }
__device__ __forceinline__ void peer_u_stage(int nper, int tb, int tstride, int xl, const unsigned char* H8, const unsigned char* U8, const int* EIDX, float* PART, int lane) {
    const int g = lane >> 3, sub = lane & 7, NQ = 2 * nper;
    int ex0[8], ex1[8], ex2[8], ex3[8]; v4u uv0[8], uv1[8], uv2[8], uv3[8], ha0, ha1, ha2, ha3, hb0, hb1, hb2, hb3; int rs[8];
#define PU_I(q, X) do { const PItem it_ = peer_item1((q), NQ, tb, tstride, xl); pe_idx8(it_, (X) & 1, EIDX, g, ex##X); } while (0)
#define PU_G(q, X) do { const PItem it_ = peer_item1((q), NQ, tb, tstride, xl); pe_gather8(it_, U8, sub, ex##X, uv##X); const unsigned char* hp_ = H8 + (size_t)it_.t * 2048 + 256 * it_.s + 32 * sub; ha##X = *(const v4u*)hp_; hb##X = *(const v4u*)(hp_ + 16); } while (0)
#define PU_F(q, X) do { const PItem it_ = peer_item1((q), NQ, tb, tstride, xl); int hs_ = sdot4(ha##X.x, 0x01010101u, 0); hs_ = sdot4(ha##X.y, 0x01010101u, hs_); hs_ = sdot4(ha##X.z, 0x01010101u, hs_); hs_ = sdot4(ha##X.w, 0x01010101u, hs_); \
        hs_ = sdot4(hb##X.x, 0x01010101u, hs_); hs_ = sdot4(hb##X.y, 0x01010101u, hs_); hs_ = sdot4(hb##X.z, 0x01010101u, hs_); hs_ = sdot4(hb##X.w, 0x01010101u, hs_); \
        if (((X) & 1) == 0) pu_acc8(uv##X, ha##X, hb##X, 8 * hs_, rs); else { int rh_[8]; pu_acc8(uv##X, ha##X, hb##X, 8 * hs_, rh_); \
        pu_store(it_, (q) < NQ && (tb + ((q) >> 1) * tstride) < T, PART, lane, rs, rh_); } } while (0)
    PU_I(0, 0); PU_I(1, 1); PU_I(2, 2); PU_I(3, 3); PU_G(0, 0); PU_G(1, 1); PU_G(2, 2);
#pragma unroll 1
    for (int q = 0; q < NQ; q += 4) {
        PU_F(q, 0);     PU_G(q + 3, 3); PU_I(q + 4, 0);
        PU_F(q + 1, 1); PU_G(q + 4, 0); PU_I(q + 5, 1);
        PU_F(q + 2, 2); PU_G(q + 5, 1); PU_I(q + 6, 2);
        PU_F(q + 3, 3); PU_G(q + 6, 2); PU_I(q + 7, 3);
    }
#undef PU_I
#undef PU_G
#undef PU_F
}
__device__ __forceinline__ void tr4x4(unsigned r0, unsigned r1, unsigned r2, unsigned r3, unsigned& c0, unsigned& c1, unsigned& c2, unsigned& c3) {
    const unsigned a = __builtin_amdgcn_perm(r1, r0, 0x05010400u), b = __builtin_amdgcn_perm(r1, r0, 0x07030602u), c = __builtin_amdgcn_perm(r3, r2, 0x05010400u), d = __builtin_amdgcn_perm(r3, r2, 0x07030602u);
    c0 = __builtin_amdgcn_perm(c, a, 0x05040100u); c1 = __builtin_amdgcn_perm(c, a, 0x07060302u); c2 = __builtin_amdgcn_perm(d, b, 0x05040100u); c3 = __builtin_amdgcn_perm(d, b, 0x07060302u);
}
__device__ __forceinline__ void pv_acc8(const v4u (&vv)[8], const unsigned aq0, const unsigned aq1, int (&acc)[32]) {
#pragma unroll
    for (int m = 0; m < 2; ++m) { const unsigned aq = m == 0 ? aq0 : aq1;
#pragma unroll
        for (int w = 0; w < 4; ++w) { unsigned d[4];
#pragma unroll
            for (int i = 0; i < 4; ++i) d[i] = w == 0 ? vv[4 * m + i].x : w == 1 ? vv[4 * m + i].y : w == 2 ? vv[4 * m + i].z : vv[4 * m + i].w;
            unsigned c0, c1, c2, c3;
            tr4x4(d[0] & 0x0F0F0F0Fu, d[1] & 0x0F0F0F0Fu, d[2] & 0x0F0F0F0Fu, d[3] & 0x0F0F0F0Fu, c0, c1, c2, c3);
            acc[8 * w + 0] = sdot4(c0, aq, acc[8 * w + 0]); acc[8 * w + 1] = sdot4(c1, aq, acc[8 * w + 1]); acc[8 * w + 2] = sdot4(c2, aq, acc[8 * w + 2]); acc[8 * w + 3] = sdot4(c3, aq, acc[8 * w + 3]);
            tr4x4((d[0] >> 4) & 0x0F0F0F0Fu, (d[1] >> 4) & 0x0F0F0F0Fu, (d[2] >> 4) & 0x0F0F0F0Fu, (d[3] >> 4) & 0x0F0F0F0Fu, c0, c1, c2, c3);
            acc[8 * w + 4] = sdot4(c0, aq, acc[8 * w + 4]); acc[8 * w + 5] = sdot4(c1, aq, acc[8 * w + 5]); acc[8 * w + 6] = sdot4(c2, aq, acc[8 * w + 6]); acc[8 * w + 7] = sdot4(c3, aq, acc[8 * w + 7]); } }
}
__device__ __forceinline__ void pv_store(const PItem it, bool valid, float* out, const float* ffn_g, const float* ASC, int lane, int (&acc)[32], int asum, const v2u x1b) {
    const int g = lane >> 3, sub = lane & 7;
#pragma unroll
    for (int w = 32, n = 16; w >= 8; w >>= 1, n >>= 1) { const bool up = (lane & w) != 0;
#pragma unroll
        for (int j = 0; j < n; ++j) { const int a = acc[j], b2 = acc[j + n]; const int keep = up ? b2 : a, send = up ? a : b2; acc[j] = keep + __shfl_xor(send, w); } }
    asum += __shfl_xor(asum, 8); asum += __shfl_xor(asum, 16); asum += __shfl_xor(asum, 32);
    const int c0 = 16 * ((g >> 2) & 1) + 8 * ((g >> 1) & 1) + 4 * (g & 1);
    const f32x4 gg = *(const f32x4*)(ffn_g + 256 * it.s + 32 * sub + c0);
    const float sc = ASC[it.t];
    if (valid) *(f32x4*)(out + (size_t)it.t * 2048 + 256 * it.s + 32 * sub + c0) = (f32x4){bflo(x1b.x) / gg.x + sc * (float)(acc[0] - 8 * asum), bfhi(x1b.x) / gg.y + sc * (float)(acc[1] - 8 * asum),
                                                                                            bflo(x1b.y) / gg.z + sc * (float)(acc[2] - 8 * asum), bfhi(x1b.y) / gg.w + sc * (float)(acc[3] - 8 * asum)};
}
__device__ __forceinline__ void peer_v_stage(int nper, int tb, int tstride, int xl, const unsigned char* V8, const int* EIDX, const unsigned* ACTQ, const float* ASC, const bf16* A2, const float* ffn_g, float* out, int lane) {
    const int g = lane >> 3, sub = lane & 7, NQ = 2 * nper;
    const int c0 = 16 * ((g >> 2) & 1) + 8 * ((g >> 1) & 1) + 4 * (g & 1);
    int ex0[8], ex1[8], ex2[8], ex3[8]; v4u vv0[8], vv1[8], vv2[8], vv3[8]; v2u aq0, aq1, aq2, aq3, x1a, x1b; int acc[32]; int asum = 0;
#define PV_I(q, X) do { const PItem it_ = peer_item1((q), NQ, tb, tstride, xl); pe_idx8(it_, (X) & 1, EIDX, g, ex##X); } while (0)
#define PV_G(q, X, XV) do { const PItem it_ = peer_item1((q), NQ, tb, tstride, xl); pe_gather8(it_, V8, sub, ex##X, vv##X); \
        aq##X = *(const v2u*)(ACTQ + (size_t)it_.t * 32 + g * 4 + 2 * ((X) & 1)); \
        if ((X) & 1) XV = *(const v2u*)(A2 + (size_t)it_.t * 2048 + 256 * it_.s + 32 * sub + c0); } while (0)
#define PV_F(q, X, XV) do { const PItem it_ = peer_item1((q), NQ, tb, tstride, xl); if (((X) & 1) == 0) { _Pragma("unroll") for (int m_ = 0; m_ < 32; ++m_) acc[m_] = 0; asum = 0; } \
        asum = sdot4(aq##X.x, 0x01010101u, asum); asum = sdot4(aq##X.y, 0x01010101u, asum); \
        pv_acc8(vv##X, aq##X.x, aq##X.y, acc); if ((X) & 1) pv_store(it_, (q) < NQ && (tb + ((q) >> 1) * tstride) < T, out, ffn_g, ASC, lane, acc, asum, XV); } while (0)
    PV_I(0, 0); PV_I(1, 1); PV_I(2, 2); PV_I(3, 3); PV_G(0, 0, x1a); PV_G(1, 1, x1a); PV_G(2, 2, x1b);
#pragma unroll 1
    for (int q = 0; q < NQ; q += 4) {
        PV_F(q, 0, x1a);     PV_G(q + 3, 3, x1b); PV_I(q + 4, 0);
        PV_F(q + 1, 1, x1a); PV_G(q + 4, 0, x1a); PV_I(q + 5, 1);
        PV_F(q + 2, 2, x1b); PV_G(q + 5, 1, x1a); PV_I(q + 6, 2);
        PV_F(q + 3, 3, x1b); PV_G(q + 6, 2, x1b); PV_I(q + 7, 3);
    }
#undef PV_I
#undef PV_G
#undef PV_F
}

struct Args { const float* in[17]; float* out; unsigned char* ws; int ph_lo, ph_hi; };
__global__ void __launch_bounds__(NTHREADS, 2) mk_fwd(Args args) {
    extern __shared__ __attribute__((aligned(16))) unsigned char lds_raw[];
    LAS unsigned char* lds = (LAS unsigned char*)lds_raw;
    const int tid = threadIdx.x, lane = tid & 63, wave = __builtin_amdgcn_readfirstlane(tid >> 6);
    const int G = gridDim.x, bx = blockIdx.x;
    const int vcu = (G % 8 == 0) ? (bx % 8) * (G / 8) + bx / 8 : bx;
    unsigned char* ws = args.ws;
    const float* x = args.in[0]; const float* attn_g = args.in[1]; const float* w_in = args.in[2]; const float* qg = args.in[3]; const float* kg = args.in[4];
    const float* lq1 = args.in[5]; const float* lk1 = args.in[6]; const float* lq2 = args.in[7]; const float* lk2 = args.in[8]; const float* subg = args.in[9];
    const float* conv_w = args.in[10]; const float* w_out = args.in[11]; const float* ffn_g = args.in[12]; const float* w_q = args.in[13]; const float* subkeys = args.in[14];
    const float* peer_u = args.in[15]; const float* peer_v = args.in[16];
    float* out = args.out;
    bf16* WtIn = (bf16*)(ws + WS_WIN); bf16* WtOut = (bf16*)(ws + WS_WOUT); bf16* WtQ = (bf16*)(ws + WS_WQ); bf16* SK = (bf16*)(ws + WS_SK);
    float* SSQ = (float*)(ws + WS_SSQ); int* EIDX = (int*)(ws + WS_EIDX); float* EGATE = (float*)(ws + WS_EGATE); float* RSTD = (float*)(ws + WS_RSTD);
    bf16* XN = (bf16*)(ws + WS_XN); bf16* MIX = XN;
    bf16* Qb = (bf16*)(ws + WS_Q); bf16* Kb = (bf16*)(ws + WS_K); bf16* Vb = (bf16*)(ws + WS_V); bf16* QP = Qb;
    bf16* CB = (bf16*)(ws + WS_CB); bf16* CC = (bf16*)(ws + WS_CC); bf16* CX = (bf16*)(ws + WS_CX); bf16* A2 = CB;
    unsigned char* U8 = ws + WS_UT; unsigned char* V8 = ws + WS_VT;
    volatile LAS unsigned* MISC = (volatile LAS unsigned*)(lds + MISC_OFF);
    if (tid < 16) MISC[tid] = 0u;
    __syncthreads();
    XcdBarrier bar = xcd_barrier_post((unsigned*)(ws + WS_CTL) + CW_BAR, MISC + 8);
    const int lo = args.ph_lo, hi_ph = args.ph_hi & 255, dbg_flags = args.ph_hi >> 8;
#ifndef DBG_DUP
#define DBG_DUP -1
#endif
#ifndef DBG_MASK
#define DBG_MASK 0xfff
#endif
#define IN(k) (((DBG_MASK >> (k)) & 1) && lo <= (k) && (k) < hi_ph)
#define REPS(k) for (int rep_ = 0; rep_ < ((DBG_DUP == (k)) ? 2 : 1); ++rep_)
#define SEAM(k) do { if (IN(k) && IN((k) + 1)) xcd_barrier(bar); } while (0)
    const int gw = vcu * NWAVES + wave, NGW = G * NWAVES;
    const size_t gtid = (size_t)bx * NTHREADS + tid, nthr = (size_t)G * NTHREADS;

    if (IN(0)) REPS(0) {
        LAS float* scr = (LAS float*)(lds + wave * 16384);
        constexpr int I_IN = (DM / 64) * (INC / 32), I_SQ = (DM / 64) * (DM / 32);
        if (!(dbg_flags & 4))
        for (int it = gw; it < I_IN + 2 * I_SQ; it += NGW) {
            if (it < I_IN) p0_transpose_item(w_in, DM, INC, WtIn, scr, it, lane, true);
            else if (it < I_IN + I_SQ) p0_transpose_item(w_out, DM, DM, WtOut, scr, it - I_IN, lane, false);
            else p0_transpose_item(w_q, DM, DM, WtQ, scr, it - I_IN - I_SQ, lane, false);
        }
        if (!(dbg_flags & 8))
        for (int m = gw; m < T; m += NGW) rms_row_to_bf16(x + (size_t)m * DM, attn_g, XN + (size_t)m * DM, lane);
        cvt_bf16_stream(subkeys, SK, (size_t)PEH * 2 * PNK * 128 / 8, gtid, nthr);
        if (!(dbg_flags & 16))
        {
            const float sig = table_std16(peer_u, (LAS float*)(lds + MISC_OFF + 64), tid); const float step = 0.335f * sig;
            if (bx == 0 && tid == 0) ((float*)(ws + WS_RSTD))[T] = step;
            cvt_i4_slices(peer_u, U8, 1.0f / step, gtid, nthr); }
        if (!(dbg_flags & 32))
        {
            const float sig = table_std16(peer_v, (LAS float*)(lds + MISC_OFF + 64), tid); const float step = 0.335f * sig;
            if (bx == 0 && tid == 0) ((float*)(ws + WS_RSTD))[T + 1] = step;
            cvt_i4_slices(peer_v, V8, 1.0f / step, gtid, nthr); }
    }
    SEAM(0);
    if (IN(1)) REPS(1) {
        pg8::Gemm g{XN, WtIn, T, INC, DM}; pg8::StaticOrder S; S.init(T, INC, G, bx);
        pg8::EpiProj E{Qb, qg, kg};
        pg8::gemm_phase<pg8::EpiProj, pg8::StaticOrder, true, true>(lds, g, S, E);
    }
    SEAM(1);
    if (IN(2)) REPS(2) {
        float a = lq1[lane] * lk1[lane], b2 = lq2[lane] * lk2[lane];
        a = wave_sum(a); b2 = wave_sum(b2);
        const float lam = expf(a) - expf(b2) + 0.2f;
        const float mq = wave_max(fabsf(qg[lane])), mk = wave_max(fabsf(kg[lane]));
        const float M2 = 64.f * C2 * mq * mk;
#if DBG_NAIVE_ATTN
        for (int r = gw; r < NB * NH * SEQ; r += NGW) naive_attn_row(r >> 14, (r >> 11) & 7, r & 2047, Qb, Kb, Vb, MIX, subg, lam, (LAS float*)(lds + wave * 16384), lane);
        if (0)
#endif
        if (!(dbg_flags & 2))
        for (int v = vcu; v < NB * NH * 4; v += G) {
            const int bh = v >> 2, s = v & 3, b = bh >> 3, h = bh & 7;
#pragma unroll 1
            for (int i = 0; i < 4; ++i) { const int qblk = (i == 0) ? s : (i == 1) ? 7 - s : (i == 2) ? 8 + s : 15 - s;
                att::attn_unit(b, h, qblk, Qb, Kb, Vb, MIX, subg, lam, M2, (LAS char*)lds); }
        }
        if (!(dbg_flags & 1))
        for (size_t it = gtid; it < (size_t)(T / 16) * 128; it += nthr) {
            const int cg8 = (int)(it & 127), chunk = (int)(it >> 7), t0 = chunk * 16, col = cg8 * 8;
            f32x4 w0a = *(const f32x4*)(conv_w + col), w0b = *(const f32x4*)(conv_w + col + 4), w1a = *(const f32x4*)(conv_w + 1024 + col), w1b = *(const f32x4*)(conv_w + 1024 + col + 4),
                  w2a = *(const f32x4*)(conv_w + 2048 + col), w2b = *(const f32x4*)(conv_w + 2048 + col + 4);
            float u1[8], u2[8];
#pragma unroll
            for (int i = 0; i < 8; ++i) { u1[i] = 0.f; u2[i] = 0.f; }
            if ((t0 % SEQ) != 0) {
                const v4u c1 = *(const v4u*)(CC + (size_t)(t0 - 1) * 1024 + col), x1v = *(const v4u*)(CX + (size_t)(t0 - 1) * 1024 + col), c2 = *(const v4u*)(CC + (size_t)(t0 - 2) * 1024 + col), x2v = *(const v4u*)(CX + (size_t)(t0 - 2) * 1024 + col);
                u1[0] = bflo(c1.x) * bflo(x1v.x); u1[1] = bfhi(c1.x) * bfhi(x1v.x); u1[2] = bflo(c1.y) * bflo(x1v.y); u1[3] = bfhi(c1.y) * bfhi(x1v.y); u1[4] = bflo(c1.z) * bflo(x1v.z); u1[5] = bfhi(c1.z) * bfhi(x1v.z); u1[6] = bflo(c1.w) * bflo(x1v.w); u1[7] = bfhi(c1.w) * bfhi(x1v.w);
                u2[0] = bflo(c2.x) * bflo(x2v.x); u2[1] = bfhi(c2.x) * bfhi(x2v.x); u2[2] = bflo(c2.y) * bflo(x2v.y); u2[3] = bfhi(c2.y) * bfhi(x2v.y); u2[4] = bflo(c2.z) * bflo(x2v.z); u2[5] = bfhi(c2.z) * bfhi(x2v.z); u2[6] = bflo(c2.w) * bflo(x2v.w); u2[7] = bfhi(c2.w) * bfhi(x2v.w);
            }
            const float w0[8] = {w0a.x, w0a.y, w0a.z, w0a.w, w0b.x, w0b.y, w0b.z, w0b.w}, w1[8] = {w1a.x, w1a.y, w1a.z, w1a.w, w1b.x, w1b.y, w1b.z, w1b.w}, w2[8] = {w2a.x, w2a.y, w2a.z, w2a.w, w2b.x, w2b.y, w2b.z, w2b.w};
#pragma unroll 4
            for (int j = 0; j < 16; ++j) { const size_t ro = (size_t)(t0 + j) * 1024 + col;
                const v4u bv = *(const v4u*)(CB + ro), cv = *(const v4u*)(CC + ro), xv = *(const v4u*)(CX + ro);
                float u0[8], bb[8], y[8];
                u0[0] = bflo(cv.x) * bflo(xv.x); u0[1] = bfhi(cv.x) * bfhi(xv.x); u0[2] = bflo(cv.y) * bflo(xv.y); u0[3] = bfhi(cv.y) * bfhi(xv.y); u0[4] = bflo(cv.z) * bflo(xv.z); u0[5] = bfhi(cv.z) * bfhi(xv.z); u0[6] = bflo(cv.w) * bflo(xv.w); u0[7] = bfhi(cv.w) * bfhi(xv.w);
                bb[0] = bflo(bv.x); bb[1] = bfhi(bv.x); bb[2] = bflo(bv.y); bb[3] = bfhi(bv.y); bb[4] = bflo(bv.z); bb[5] = bfhi(bv.z); bb[6] = bflo(bv.w); bb[7] = bfhi(bv.w);
#pragma unroll
                for (int i = 0; i < 8; ++i) { y[i] = bb[i] * (u2[i] * w0[i] + u1[i] * w1[i] + u0[i] * w2[i]); u2[i] = u1[i]; u1[i] = u0[i]; }
                v4u o; o.x = pk2(y[0], y[1]); o.y = pk2(y[2], y[3]); o.z = pk2(y[4], y[5]); o.w = pk2(y[6], y[7]);
                *(v4u*)(MIX + (size_t)(t0 + j) * 2048 + 1024 + col) = o; }
        }
    }
    SEAM(2);
    if (IN(3)) REPS(3) {
        pg8::Gemm g{MIX, WtOut, T, DM, DM}; pg8::StaticOrder S; S.init(T, DM, G, bx);
        pg8::EpiX1 E{x, out, A2, ffn_g, SSQ, ws + WS_H8};
        pg8::gemm_phase<pg8::EpiX1, pg8::StaticOrder, true, true>(lds, g, S, E);
    }
    SEAM(3);
    if (IN(4)) REPS(4) {
        pg8::Gemm g{A2, WtQ, T, DM, DM}; pg8::StaticOrder S; S.init(T, DM, G, bx);
        pg8::EpiBf16<0> E{QP, DM, nullptr, 0, 0, 1.f};
        pg8::gemm_phase<pg8::EpiBf16<0>, pg8::StaticOrder, true, true>(lds, g, S, E);
    }
    SEAM(4);
    if (IN(5)) REPS(5) {
        if (tid < 64) {
            int n = tid, i = 0;
#pragma unroll 1
            for (; i < 16; ++i) { const int len = 16 / (i + 1); if (n < len) break; n -= len; }
            ((LAS unsigned char*)(lds + P5_TAB_OFF))[tid] = (unsigned char)(i < 16 ? ((i << 4) | n) : 0);
        }
        int cur_h = -1;
        for (int it = vcu; it < (T / 128) * PEH; it += G) { const int h = it & 7;
            if (h != cur_h) {
                __syncthreads();
                for (int i = tid; i < 4096; i += NTHREADS) { const int ch = i & 15, key = (i >> 4) & 127, c = i >> 11;
                    *(LAS v4u*)(lds + c * 32768 + ch * 2048 + key * 16) = *(const v4u*)(SK + (size_t)((h * 2 + c) * 128 + key) * 128 + ch * 8); }
                cur_h = h; __syncthreads(); }
            peer_topk_item(it >> 3, h, QP, SSQ, EIDX, EGATE, RSTD, (LAS char*)lds); }
    }
    SEAM(5);
    if (IN(6)) {
        float* PART = (float*)(ws + WS_PART);
        const int tstride = (G >> 3) * NWAVES, nper = (T + tstride - 1) / tstride;
        peer_u_stage(nper, (bx >> 3) * NWAVES + wave, tstride, bx & 7, ws + WS_H8, U8, EIDX, PART, lane);
    }
    SEAM(6);
    if (IN(7)) {
        const float* PART = (const float*)(ws + WS_PART); unsigned* ACTQ = (unsigned*)(ws + WS_ACT); float* ASC = (float*)(ws + WS_ACT + 4 * MiB);
        const float ustep = RSTD[T] * (1.0f / H8_SCALE), vstep = RSTD[T + 1];
        for (int tp = gw; tp < T / 2; tp += NGW) { const int t = 2 * tp + (lane >> 5), k4 = 4 * (lane & 31);
            f32x4 z = (f32x4){0.f, 0.f, 0.f, 0.f};
#pragma unroll
            for (int s = 0; s < 8; ++s) z += *(const f32x4*)(PART + ((size_t)s * T + t) * 128 + k4);
            z *= RSTD[t] * ustep;
            const f32x4 gt = *(const f32x4*)(EGATE + (size_t)t * 128 + k4);
            f32x4 a; float am = 0.f;
#pragma unroll
            for (int i = 0; i < 4; ++i) { a[i] = 0.5f * z[i] * (1.0f + erff(z[i] * 0.70710678118654752f)) * gt[i]; am = fmaxf(am, fabsf(a[i])); }
#pragma unroll
            for (int o = 1; o < 32; o <<= 1) am = fmaxf(am, __shfl_xor(am, o));
            const float asc = am > 0.f ? am * (1.0f / 127.0f) : 1.0f, inv = 1.0f / asc; unsigned w = 0u;
#pragma unroll
            for (int i = 0; i < 4; ++i) { const int q = (int)__builtin_rintf(a[i] * inv); w |= ((unsigned)q & 0xffu) << (8 * i); }
            ACTQ[(size_t)t * 32 + (lane & 31)] = w;
            if ((lane & 31) == 0) ASC[t] = asc * vstep; }
    }
    SEAM(7);
    if (IN(8)) {
        const unsigned* ACTQ = (const unsigned*)(ws + WS_ACT); const float* ASC = (const float*)(ws + WS_ACT + 4 * MiB);
        const int tstride = (G >> 3) * NWAVES, nper = (T + tstride - 1) / tstride;
        peer_v_stage(nper, (bx >> 3) * NWAVES + wave, tstride, bx & 7, V8, EIDX, ACTQ, ASC, A2, ffn_g, out, lane);
    }
#undef IN
#undef SEAM
}

extern "C" void kernel_launch(void* const* d_in, const int* in_sizes, int n_in, void* d_out, int out_size, void* d_ws, size_t ws_size, hipStream_t stream) {
    static int grid = 0;
    if (grid == 0) {
        if (n_in != 17 || out_size != T * DM || ws_size < WS_END) { fprintf(stderr, "kernel_launch: unexpected shapes (n_in %d out %d ws %zu)\n", n_in, out_size, ws_size); grid = -1; return; }
        int dev = 0, cus = 0, per_cu = 0;
        if (hipGetDevice(&dev) != hipSuccess || hipDeviceGetAttribute(&cus, hipDeviceAttributeMultiprocessorCount, dev) != hipSuccess) { grid = -1; return; }
        if (hipFuncSetAttribute((const void*)mk_fwd, hipFuncAttributeMaxDynamicSharedMemorySize, LDS_BYTES) != hipSuccess) { fprintf(stderr, "kernel_launch: hipFuncSetAttribute failed\n"); grid = -1; return; }
        if (hipOccupancyMaxActiveBlocksPerMultiprocessor(&per_cu, (const void*)mk_fwd, NTHREADS, LDS_BYTES) != hipSuccess || per_cu < 1) { fprintf(stderr, "kernel_launch: occupancy query says %d blocks per CU\n", per_cu); (void)hipGetLastError(); grid = -1; return; }
        grid = cus;
    }
    if (grid < 0) return;
    if (hipMemsetAsync((char*)d_ws + WS_CTL, 0, CTL_ZERO_BYTES, stream) != hipSuccess) { fprintf(stderr, "kernel_launch: memset failed\n"); return; }
    Args a{};
    for (int i = 0; i < 17; ++i) a.in[i] = (const float*)d_in[i];
    a.out = (float*)d_out; a.ws = (unsigned char*)d_ws;
#if MK_N_LAUNCHES == 1
    a.ph_lo = 0; a.ph_hi = NPHASE;
    void* kargs[] = {&a};
    hipError_t e = hipLaunchCooperativeKernel((const void*)mk_fwd, dim3(grid), dim3(NTHREADS), kargs, LDS_BYTES, stream);
    if (e != hipSuccess) fprintf(stderr, "kernel_launch: cooperative launch failed: %s (grid %d)\n", hipGetErrorString(e), grid);
#else
#ifndef DBG_DUPL
#define DBG_DUPL -1
#endif
#ifndef DBG_DUPFLAGS
#define DBG_DUPFLAGS 0
#endif
    for (int p = 0; p < NPHASE; ++p) { a.ph_lo = p; for (int r = 0; r < (p == DBG_DUPL ? 2 : 1); ++r) { a.ph_hi = (p + 1) | ((r == 1 ? DBG_DUPFLAGS : 0) << 8); hipLaunchKernelGGL(mk_fwd, dim3(grid), dim3(NTHREADS), LDS_BYTES, stream, a); } }
#endif
}
```

```cpp
#include <hip/hip_runtime.h>
#include <hip/hip_cooperative_groups.h>
#include <cstdio>
#include <cstdint>
#include <cmath>
namespace cg = cooperative_groups;
namespace pg8 {
#define PG8_LAS __attribute__((address_space(3)))
typedef unsigned short bf16_t;
typedef short bf16x8 __attribute__((ext_vector_type(8)));
typedef float f32x4 __attribute__((ext_vector_type(4)));
typedef unsigned u32x4 __attribute__((ext_vector_type(4)));
constexpr int BM = 256, BK = 64, HALF = 128, HTB = HALF * BK * 2  , STAGE_BYTES = 8 * HTB, NXCD = 8, WGM = 8;

__host__ __device__ __forceinline__ int lds_byte(int r, int c) { const int st = (r >> 4) * 2 + (c >> 5), rr = r & 15, cc = c & 31, ob = rr * 64 + cc * 2; return st * 1024 + (ob ^ (((ob >> 9) & 1) << 5)); }
__host__ __device__ __forceinline__ void stage_rc(int b, int& R, int& C) { const int st = b / 1024, sb = b % 1024, swz = sb ^ (((sb >> 9) & 1) << 5); R = (st >> 1) * 16 + swz / 64; C = (st & 1) * 32 + (swz % 64) / 2; }
__host__ __device__ __forceinline__ int perm32(int rho) { const int n = rho >> 4, i = rho & 15; return 8 * (i >> 2) + 4 * n + (i & 3); }

struct Unit { int pm, pn; };
struct Gemm { const bf16_t* A; const bf16_t* Bt; int M, N, K; };

struct StaticOrder {
    int nM, nN, nwg, G, c;
    __host__ __device__ void init(int M, int N, int G_, int c_) { nM = M / BM; nN = N / BM; nwg = nM * nN; G = G_; c = c_; }
    __host__ __device__ bool next(int i, Unit& u) const {
        const long L = (long)i * G + c; if (L >= nwg) return false;
        int wgid = (int)L; { const int q = nwg / NXCD, r = nwg % NXCD, xcd = wgid % NXCD, off = wgid / NXCD; wgid = (xcd < r ? xcd * (q + 1) : r * (q + 1) + (xcd - r) * q) + off; }
        const int nig = WGM * nN, gid = wgid / nig, fm = gid * WGM, gsz = (nM - fm) < WGM ? (nM - fm) : WGM;
        u.pm = fm + ((wgid % nig) % gsz); u.pn = (wgid % nig) / gsz; return true;
    }
    __device__ __forceinline__ void a_ready(const Unit&) const {}
    __device__ __forceinline__ void done(const Unit&) const {}
};

__device__ __forceinline__ unsigned cvt_pk_bf16(float lo, float hi) { unsigned r; asm volatile("v_cvt_pk_bf16_f32 %0, %1, %2" : "=v"(r) : "v"(lo), "v"(hi)); return r; }
typedef float f32x2 __attribute__((ext_vector_type(2)));
__device__ __forceinline__ f32x2 gelu_pk(f32x2 v) {
    const f32x2 av = __builtin_elementwise_abs(v), d = av * 0.2316418882f + 1.0f;
    f32x2 t; t.x = __builtin_amdgcn_rcpf(d.x); t.y = __builtin_amdgcn_rcpf(d.y);
    f32x2 q = t * 0.5307027145f + (-0.7265760135f); q = q * t + 0.7107068705f; q = q * t + (-0.142248368f); q = q * t + 0.127414796f; q = q * t;
    const f32x2 s = (v * v) * (-0.72134752044f);
    f32x2 e; e.x = __builtin_amdgcn_exp2f(s.x); e.y = __builtin_amdgcn_exp2f(s.y);
    const f32x2 m = v * (q * e), r = v - m;
    f32x2 o; o.x = v.x < 0.f ? m.x : r.x; o.y = v.y < 0.f ? m.y : r.y; return o;
}

template <int ACT  > struct EpiBf16 {
    static constexpr bool PERM = true, AFTER_DRAIN = false; static_assert(ACT == 0 || ACT == 1, "EpiBf16: ACT is 0 (none) or 1 (gelu_pk)");
    bf16_t* O; int ldc; const float* bias; int split_cols; size_t split_stride; float scale0;
    __device__ __forceinline__ void operator()(const f32x4 (&acc)[2][2][4][2], const Unit& u, int wr, int wc, int fr, int fq) const {
        const int row0 = u.pm * BM + wr * 64 + fr; int colt = u.pn * BM; bf16_t* base = O;
        float sc = 1.f; if (split_cols) { const int t = colt / split_cols; base += (size_t)t * split_stride; colt -= t * split_cols; if (t == 0) sc = scale0; }
        const int col0 = colt + wc * 32 + 8 * fq, bcol0 = u.pn * BM + wc * 32 + 8 * fq;
        f32x4 bv[2][2];
#pragma unroll
        for (int bj = 0; bj < 2; ++bj)
#pragma unroll
            for (int n = 0; n < 2; ++n) bv[bj][n] = bias ? *(const f32x4*)(bias + bcol0 + bj * HALF + 4 * n) : (f32x4){0.f, 0.f, 0.f, 0.f};
#pragma unroll
        for (int ai = 0; ai < 2; ++ai)
#pragma unroll
            for (int m = 0; m < 4; ++m) { bf16_t* rowp = base + (size_t)(row0 + ai * HALF + m * 16) * ldc + col0;
#pragma unroll
                for (int bj = 0; bj < 2; ++bj) { f32x4 v0 = acc[ai][bj][m][0] + bv[bj][0], v1 = acc[ai][bj][m][1] + bv[bj][1];
                    if (ACT == 1) { f32x2 a = gelu_pk((f32x2){v0[0], v0[1]}), b = gelu_pk((f32x2){v0[2], v0[3]}), c = gelu_pk((f32x2){v1[0], v1[1]}), d = gelu_pk((f32x2){v1[2], v1[3]});
                        v0 = (f32x4){a.x, a.y, b.x, b.y}; v1 = (f32x4){c.x, c.y, d.x, d.y}; }
                    v0 = v0 * sc; v1 = v1 * sc; u32x4 w; w.x = cvt_pk_bf16(v0[0], v0[1]); w.y = cvt_pk_bf16(v0[2], v0[3]); w.z = cvt_pk_bf16(v1[0], v1[1]); w.w = cvt_pk_bf16(v1[2], v1[3]);
                    *(u32x4*)(rowp + bj * HALF) = w; } }
    }
};
template <class Epi, class Sched, bool ALIGN_EPI = false, bool SP2 = false>
__device__ __forceinline__ void gemm_phase(PG8_LAS unsigned char* lds, const Gemm g, const Sched& S, const Epi& E) {
    const int tid = threadIdx.x, wid = __builtin_amdgcn_readfirstlane(tid >> 6), lane = tid & 63, wr = wid >> 2, wc = wid & 3, fr = lane & 15, fq = lane >> 4;
    const int K = g.K, nt = K / BK;
    unsigned voffA[2], voffB[2];
#pragma unroll
    for (int i = 0; i < 2; ++i) { int R, C; stage_rc(tid * 16 + i * 8192, R, C); const int Rb = Epi::PERM ? ((R & ~31) + perm32(R & 31)) : R;
        voffA[i] = (unsigned)(R * K + C) * 2u; voffB[i] = (unsigned)(Rb * K + C) * 2u; }
    const size_t kstep = (size_t)(BK * 2);
    const size_t hstep = (size_t)HALF * K * 2;
    const size_t tstep = 2 * hstep;
    const unsigned ldsw = (unsigned)wid * 1024u;
    const int aoff = lds_byte(wr * 64 + fr, fq * 8), boff = lds_byte(wc * 32 + fr, fq * 8);
#define PG8_SA(b, h) (((b) * 2 + (h)) * HTB)
#define PG8_SB(b, h) ((4 + (b) * 2 + (h)) * HTB)
#define PG8_STAGE(bufoff, gbase, voff) do { _Pragma("unroll") for (int _i = 0; _i < 2; ++_i) \
        __builtin_amdgcn_global_load_lds((const unsigned*)((const char*)(gbase) + (voff)[_i]), (PG8_LAS unsigned*)(lds + (bufoff) + ldsw + _i * 8192), 16, 0, 0); } while (0)
#define PG8_LDA(dst, b, h) do { _Pragma("unroll") for (int m = 0; m < 4; ++m) _Pragma("unroll") for (int k = 0; k < 2; ++k) dst[m][k] = *(const PG8_LAS bf16x8*)(lds + PG8_SA(b, h) + aoff + m * 2048 + k * 1024); } while (0)
#define PG8_LDB(dst, b, h) do { _Pragma("unroll") for (int n = 0; n < 2; ++n) _Pragma("unroll") for (int k = 0; k < 2; ++k) dst[n][k] = *(const PG8_LAS bf16x8*)(lds + PG8_SB(b, h) + boff + n * 2048 + k * 1024); } while (0)
#define PG8_MMA(ai, bj, At, Bt) do { __builtin_amdgcn_s_setprio(1); _Pragma("unroll") for (int m = 0; m < 4; ++m) _Pragma("unroll") for (int n = 0; n < 2; ++n) _Pragma("unroll") for (int k = 0; k < 2; ++k) \
        acc[ai][bj][m][n] = __builtin_amdgcn_mfma_f32_16x16x32_bf16(Bt[n][k], At[m][k], acc[ai][bj][m][n], 0, 0, 0); __builtin_amdgcn_s_setprio(0); } while (0)
#define PG8_WAIT_V(n) asm volatile("s_waitcnt vmcnt(" #n ")" ::: "memory")
#define PG8_WAIT_L(n) asm volatile("s_waitcnt lgkmcnt(" #n ")" ::: "memory")
#define PG8_BAR __builtin_amdgcn_s_barrier()
#define PG8_SCHED __builtin_amdgcn_sched_barrier(0)
    Unit cur, nxt; int ui = 0;
    if (!S.next(0, cur)) return;
    f32x4 acc[2][2][4][2];
#pragma unroll
    for (int a = 0; a < 2; ++a)
#pragma unroll
        for (int b = 0; b < 2; ++b)
#pragma unroll
            for (int m = 0; m < 4; ++m)
#pragma unroll
                for (int n = 0; n < 2; ++n) acc[a][b][m][n] = (f32x4){0.f, 0.f, 0.f, 0.f};
    bf16x8 At[4][2], B0[2][2], B1[2][2];
    const char* cA = (const char*)g.A + (size_t)cur.pm * tstep; const char* cB = (const char*)g.Bt + (size_t)cur.pn * tstep;
    S.a_ready(cur);
    if constexpr (SP2) {
        PG8_STAGE(PG8_SB(0, 0), cB, voffB); PG8_STAGE(PG8_SB(0, 1), cB + hstep, voffB); PG8_STAGE(PG8_SA(0, 0), cA, voffA); PG8_STAGE(PG8_SA(0, 1), cA + hstep, voffA);
        if (wr == 1) PG8_BAR;
        PG8_WAIT_V(2); PG8_BAR;
        PG8_STAGE(PG8_SB(1, 0), cB + kstep, voffB); PG8_STAGE(PG8_SA(1, 0), cA + kstep, voffA); PG8_STAGE(PG8_SB(1, 1), cB + hstep + kstep, voffB);
        PG8_WAIT_V(6); PG8_BAR;
    } else {
        PG8_STAGE(PG8_SB(0, 0), cB, voffB); PG8_STAGE(PG8_SA(0, 0), cA, voffA); PG8_STAGE(PG8_SB(0, 1), cB + hstep, voffB); PG8_STAGE(PG8_SA(0, 1), cA + hstep, voffA);
        if (wr == 1) PG8_BAR;
        PG8_WAIT_V(4); PG8_BAR;
        PG8_STAGE(PG8_SB(1, 0), cB + kstep, voffB); PG8_STAGE(PG8_SA(1, 0), cA + kstep, voffA); PG8_STAGE(PG8_SB(1, 1), cB + hstep + kstep, voffB);
        PG8_WAIT_V(6); PG8_BAR;
    }
    for (;;) {
        const bool has_next = S.next(ui + 1, nxt);
        const char* nA = has_next ? (const char*)g.A + (size_t)nxt.pm * tstep : cA; const char* nB = has_next ? (const char*)g.Bt + (size_t)nxt.pn * tstep : cB;
        for (int t = 0; t < nt; t += 2) {
            const bool last = (t == nt - 2);
            const char* a1 = cA + (size_t)(t + 1) * kstep;
            const char* a2 = last ? nA : cA + (size_t)(t + 2) * kstep; const char* b2 = last ? nB : cB + (size_t)(t + 2) * kstep;
            const char* a3 = a2 + kstep; const char* b3 = b2 + kstep;
            if (last && has_next) S.a_ready(nxt);
            if constexpr (SP2) {
            PG8_LDB(B0, 0, 0); PG8_LDB(B1, 0, 1); PG8_SCHED; PG8_LDA(At, 0, 0); PG8_STAGE(PG8_SA(1, 1), a1 + hstep, voffA);
            PG8_WAIT_V(8); PG8_WAIT_L(0); PG8_BAR; PG8_MMA(0, 0, At, B0); PG8_MMA(0, 1, At, B1); PG8_BAR; PG8_SCHED;
            PG8_LDA(At, 0, 1); PG8_STAGE(PG8_SB(0, 0), b2, voffB); PG8_STAGE(PG8_SB(0, 1), b2 + hstep, voffB); PG8_STAGE(PG8_SA(0, 0), a2, voffA);
            PG8_WAIT_V(8); PG8_WAIT_L(0); PG8_BAR; PG8_MMA(1, 0, At, B0); PG8_MMA(1, 1, At, B1); PG8_BAR; PG8_SCHED;
            PG8_LDB(B0, 1, 0); PG8_LDB(B1, 1, 1); PG8_SCHED; PG8_LDA(At, 1, 0); PG8_STAGE(PG8_SA(0, 1), a2 + hstep, voffA);
            PG8_WAIT_V(8); PG8_WAIT_L(0); PG8_BAR; PG8_MMA(0, 0, At, B0); PG8_MMA(0, 1, At, B1); PG8_BAR; PG8_SCHED;
            PG8_LDA(At, 1, 1); PG8_STAGE(PG8_SB(1, 0), b3, voffB); PG8_STAGE(PG8_SB(1, 1), b3 + hstep, voffB); PG8_STAGE(PG8_SA(1, 0), a3, voffA);
            PG8_WAIT_V(8); PG8_WAIT_L(0); PG8_BAR; PG8_MMA(1, 0, At, B0); PG8_MMA(1, 1, At, B1); PG8_BAR; PG8_SCHED;
            } else {
            PG8_LDB(B0, 0, 0); PG8_SCHED; PG8_LDA(At, 0, 0); PG8_STAGE(PG8_SA(1, 1), a1 + hstep, voffA);
            PG8_WAIT_L(8); PG8_BAR; PG8_WAIT_L(0); PG8_MMA(0, 0, At, B0); PG8_BAR; PG8_SCHED;
            PG8_LDB(B1, 0, 1); PG8_STAGE(PG8_SB(0, 0), b2, voffB);
            PG8_BAR; PG8_WAIT_L(0); PG8_MMA(0, 1, At, B1); PG8_BAR;
            PG8_LDA(At, 0, 1); PG8_STAGE(PG8_SA(0, 0), a2, voffA);
            PG8_BAR; PG8_WAIT_L(0); PG8_MMA(1, 0, At, B0); PG8_BAR; PG8_SCHED;
            PG8_STAGE(PG8_SB(0, 1), b2 + hstep, voffB);
            PG8_WAIT_V(6); PG8_BAR; PG8_MMA(1, 1, At, B1); PG8_BAR;
            PG8_LDB(B0, 1, 0); PG8_SCHED; PG8_LDA(At, 1, 0); PG8_STAGE(PG8_SA(0, 1), a2 + hstep, voffA);
            PG8_WAIT_L(8); PG8_BAR; PG8_WAIT_L(0); PG8_MMA(0, 0, At, B0); PG8_BAR; PG8_SCHED;
            PG8_LDB(B1, 1, 1); PG8_STAGE(PG8_SB(1, 0), b3, voffB);
            PG8_BAR; PG8_WAIT_L(0); PG8_MMA(0, 1, At, B1); PG8_BAR;
            PG8_LDA(At, 1, 1); PG8_STAGE(PG8_SA(1, 0), a3, voffA);
            PG8_BAR; PG8_WAIT_L(0); PG8_MMA(1, 0, At, B0); PG8_BAR; PG8_SCHED;
            PG8_STAGE(PG8_SB(1, 1), b3 + hstep, voffB);
            PG8_WAIT_V(6); PG8_BAR; PG8_MMA(1, 1, At, B1); PG8_BAR;
            }
        }
        if constexpr (ALIGN_EPI) { if (wr == 0) PG8_BAR; }
        if constexpr (!Epi::AFTER_DRAIN) { E(acc, cur, wr, wc, fr, fq); S.done(cur); }
        if (!has_next) break;
#pragma unroll
        for (int a = 0; a < 2; ++a)
#pragma unroll
            for (int b = 0; b < 2; ++b)
#pragma unroll
                for (int m = 0; m < 4; ++m)
#pragma unroll
                    for (int n = 0; n < 2; ++n) acc[a][b][m][n] = (f32x4){0.f, 0.f, 0.f, 0.f};
        cur = nxt; cA = nA; cB = nB; ++ui;
        if constexpr (ALIGN_EPI) { if (wr == 1) PG8_BAR; }
    }
    PG8_WAIT_V(0);
    if constexpr (!ALIGN_EPI) { if (wr == 0) PG8_BAR; }
    PG8_BAR;
    if constexpr (Epi::AFTER_DRAIN) { E.fused(acc, cur, wr, wc, fr, fq, lds, wid, lane); S.done(cur); }
#undef PG8_SA
#undef PG8_SB
#undef PG8_STAGE
#undef PG8_LDA
#undef PG8_LDB
#undef PG8_MMA
#undef PG8_WAIT_V
#undef PG8_WAIT_L
#undef PG8_BAR
#undef PG8_SCHED
}
}
#define MK_N_LAUNCHES 1
#ifndef MK_N_LAUNCHES
#define MK_N_LAUNCHES 1
#endif
constexpr int DM = 2048, NB = 8, SEQ = 2048, T = NB * SEQ;
constexpr int AW = 1024, NH = 8, HD = 64, VD = 128, INC = 6144;
constexpr int PNK = 128, PTOPK = 16, PEH = 8, EPT = PEH * PTOPK;
constexpr float EPS = 1e-6f;
constexpr float C2 = 0.125f * 1.4426950408889634f;
constexpr int NPHASE = 9;
constexpr float U8_SCALE = 1024.f, V8_SCALE = 16.f, H8_SCALE = 16.f;
constexpr size_t MiB = 1u << 20;
constexpr size_t WS_WIN = 1 * MiB, WS_WOUT = 25 * MiB, WS_WQ = 33 * MiB, WS_SK = 41 * MiB, WS_SSQ = 42 * MiB, WS_EIDX = 44 * MiB, WS_EGATE = 52 * MiB, WS_RSTD = 60 * MiB;
constexpr size_t WS_XN = 64 * MiB;
constexpr size_t WS_Q = 128 * MiB, WS_K = 160 * MiB, WS_V = 192 * MiB;
constexpr size_t WS_CB = 224 * MiB, WS_CC = 256 * MiB, WS_CX = 288 * MiB;
constexpr size_t WS_UT = 320 * MiB, WS_VT = 384 * MiB, WS_END = 448 * MiB;
constexpr size_t WS_CTL = 0; constexpr int CW_BAR = 1024, CTL_ZERO_BYTES = 65536;
constexpr size_t WS_H8 = 288 * MiB;
constexpr size_t WS_PART = 64 * MiB, WS_ACT = 192 * MiB;
constexpr int MISC_OFF = 143360;
constexpr int LDS_BYTES = 147456;
constexpr int NWAVES = 8, NTHREADS = 512;

#define LAS __attribute__((address_space(3)))
typedef unsigned short bf16;
typedef unsigned v4u __attribute__((ext_vector_type(4)));
typedef unsigned v2u __attribute__((ext_vector_type(2)));
typedef float f32x4 __attribute__((ext_vector_type(4)));
typedef float f32x2 __attribute__((ext_vector_type(2)));
typedef float f32x16 __attribute__((ext_vector_type(16)));
typedef short bf16x8 __attribute__((ext_vector_type(8)));
typedef short s16x4 __attribute__((ext_vector_type(4)));
typedef __bf16 bf16x2_t __attribute__((ext_vector_type(2)));
#define LDS_WAIT() asm volatile("s_waitcnt lgkmcnt(0)" ::: "memory")
__device__ __forceinline__ unsigned pk2(float lo, float hi) { f32x2 v = {lo, hi}; bf16x2_t b = __builtin_convertvector(v, bf16x2_t); return __builtin_bit_cast(unsigned, b); }
__device__ __forceinline__ float bflo(unsigned u) { return __uint_as_float(u << 16); }
__device__ __forceinline__ float bfhi(unsigned u) { return __uint_as_float(u & 0xffff0000u); }
__device__ __forceinline__ float wave_sum(float v) {
#pragma unroll
    for (int o = 1; o < 64; o <<= 1) v += __shfl_xor(v, o);
    return v;
}
__device__ __forceinline__ float wave_max(float v) {
#pragma unroll
    for (int o = 1; o < 64; o <<= 1) v = fmaxf(v, __shfl_xor(v, o));
    return v;
}

#define XB_TMO      128
#define XB_XCNT(j)  (256  + 64 * (j))
#define XB_XSUB(j)  (1280 + 64 * (j))
#define XB_XGEN(j)  (2304 + 64 * (j))
#define XB_TOP      3328
#define XB_TOPGEN   3392
#define XCD_BAR_WORDS 3456
#define XB_SPIN_CAP (1u << 18)

__device__ __forceinline__ unsigned xb_ld(unsigned* p)              { return __hip_atomic_load(p, __ATOMIC_RELAXED, __HIP_MEMORY_SCOPE_AGENT); }
__device__ __forceinline__ unsigned xb_add(unsigned* p, unsigned v) { return __hip_atomic_fetch_add(p, v, __ATOMIC_RELAXED, __HIP_MEMORY_SCOPE_AGENT); }
__device__ __forceinline__ unsigned xb_xcc_id() { return (unsigned)__builtin_amdgcn_s_getreg((3 << 11) | 20) & 0xFu; }
#define XB_SPIN(cond, bar) do { unsigned _sp = 0; while (cond) { __builtin_amdgcn_s_sleep(1); \
    if ((++_sp & 255u) == 0u) { if (xb_ld(&(bar)[XB_TMO])) break; if (_sp > XB_SPIN_CAP) { atomicAdd(&(bar)[XB_TMO], 1u); break; } } } } while (0)

struct XcdBarrier {
    unsigned* bar; unsigned x;
    volatile LAS unsigned* st;
};

__device__ __forceinline__ XcdBarrier xcd_barrier_post(unsigned* bar, volatile LAS unsigned* st) {
    XcdBarrier b; b.bar = bar; b.x = xb_xcc_id(); b.st = st;
    if (threadIdx.x == 0) (void)xb_add(&bar[XB_XCNT(b.x)], 1u);
    return b;
}
__device__ __forceinline__ void xcd_barrier_complete(unsigned* bar, unsigned x, unsigned& nloc, unsigned& nx) {
    const unsigned G = gridDim.x * gridDim.y * gridDim.z;
    unsigned sum, cnt, mine, sp = 0u;
    for (;;) {
        sum = 0u; cnt = 0u; mine = 0u;
#pragma unroll
        for (unsigned j = 0; j < 16; ++j) { const unsigned c = xb_ld(&bar[XB_XCNT(j)]); sum += c; cnt += (c > 0u) ? 1u : 0u; mine = (j == x) ? c : mine; }
        if (sum == G) break;
        __builtin_amdgcn_s_sleep(1);
        if ((++sp & 255u) == 0u) { if (xb_ld(&bar[XB_TMO])) break; if (sp > XB_SPIN_CAP) { atomicAdd(&bar[XB_TMO], 1u); break; } }
    }
    nloc = mine > 0u ? mine : 1u; nx = cnt > 0u ? cnt : 1u;
}

__device__ __forceinline__ void xcd_barrier(const XcdBarrier& b) {
    asm volatile("s_waitcnt vmcnt(0)" ::: "memory");
    __syncthreads();
    if (threadIdx.x == 0) {
        unsigned* bar = b.bar;
        __builtin_amdgcn_s_waitcnt(0);
        unsigned nloc = b.st[0], nx = b.st[1];
        if (nloc == 0u) { xcd_barrier_complete(bar, b.x, nloc, nx); b.st[0] = nloc; b.st[1] = nx; }
        const unsigned old = xb_add(&bar[XB_XSUB(b.x)], 1u);
        const unsigned gen = old / nloc;
        if (old + 1u == (gen + 1u) * nloc) {
            __builtin_amdgcn_fence(__ATOMIC_RELEASE, "agent");
            asm volatile("s_waitcnt vmcnt(0)" ::: "memory");
            const unsigned og = xb_add(&bar[XB_TOP], 1u);
            const unsigned tg = og / nx;
            if (og + 1u == (tg + 1u) * nx) xb_add(&bar[XB_TOPGEN], 1u);
            else XB_SPIN(xb_ld(&bar[XB_TOPGEN]) == tg, bar);
            __builtin_amdgcn_fence(__ATOMIC_ACQUIRE, "agent");
            xb_add(&bar[XB_XGEN(b.x)], 1u);
            asm volatile("s_waitcnt vmcnt(0)" ::: "memory");
        } else {
            XB_SPIN(xb_ld(&bar[XB_XGEN(b.x)]) == gen, bar);
            __builtin_amdgcn_fence(__ATOMIC_ACQUIRE, "agent");
            asm volatile("s_waitcnt vmcnt(0)" ::: "memory");
        }
    }
    __syncthreads();
}


namespace pg8 {
struct EpiProj {
    static constexpr bool PERM = true, AFTER_DRAIN = false;
    bf16_t* base0; const float* qg; const float* kg;
    __device__ __forceinline__ void operator()(const f32x4 (&acc)[2][2][4][2], const Unit& u, int wr, int wc, int fr, int fq) const {
        const int region = u.pn >> 2;
        bf16_t* O = base0 + (size_t)region * (16u << 20);
        const int row0 = u.pm * BM + wr * 64 + fr, col0 = (u.pn & 3) * 256 + wc * 64 + 8 * fq;
        if (region < 2) {
            const float* g = region == 0 ? qg : kg; const float sc = region == 0 ? 0.125f * 1.4426950408889634f : 1.0f;
            f32x4 gv[2][2];
#pragma unroll
            for (int bj = 0; bj < 2; ++bj)
#pragma unroll
                for (int n = 0; n < 2; ++n) gv[bj][n] = *(const f32x4*)(g + bj * 32 + 8 * fq + 4 * n) * sc;
#pragma unroll
            for (int ai = 0; ai < 2; ++ai)
#pragma unroll
                for (int m = 0; m < 4; ++m) {
                    float ss = 0.f;
#pragma unroll
                    for (int bj = 0; bj < 2; ++bj)
#pragma unroll
                        for (int n = 0; n < 2; ++n) { const f32x4 x = acc[ai][bj][m][n]; ss += (x[0] * x[0] + x[1] * x[1]) + (x[2] * x[2] + x[3] * x[3]); }
                    ss += __shfl_xor(ss, 16); ss += __shfl_xor(ss, 32);
                    const float rs = __builtin_amdgcn_rsqf(ss * (1.0f / 64.0f) + 1e-6f);
                    bf16_t* rowp = O + (size_t)(row0 + ai * HALF + m * 16) * 1024 + col0;
#pragma unroll
                    for (int bj = 0; bj < 2; ++bj) { const f32x4 v0 = acc[ai][bj][m][0] * rs * gv[bj][0], v1 = acc[ai][bj][m][1] * rs * gv[bj][1];
                        u32x4 w; w.x = cvt_pk_bf16(v0[0], v0[1]); w.y = cvt_pk_bf16(v0[2], v0[3]); w.z = cvt_pk_bf16(v1[0], v1[1]); w.w = cvt_pk_bf16(v1[2], v1[3]);
                        *(u32x4*)(rowp + bj * 32) = w; }
                }
        } else {
#pragma unroll
            for (int ai = 0; ai < 2; ++ai)
#pragma unroll
                for (int m = 0; m < 4; ++m) { bf16_t* rowp = O + (size_t)(row0 + ai * HALF + m * 16) * 1024 + col0;
#pragma unroll
                    for (int bj = 0; bj < 2; ++bj) { const f32x4 v0 = acc[ai][bj][m][0], v1 = acc[ai][bj][m][1];
                        u32x4 w; w.x = cvt_pk_bf16(v0[0], v0[1]); w.y = cvt_pk_bf16(v0[2], v0[3]); w.z = cvt_pk_bf16(v1[0], v1[1]); w.w = cvt_pk_bf16(v1[2], v1[3]);
                        *(u32x4*)(rowp + bj * 32) = w; } }
        }
    }
};
struct EpiX1 {
    static constexpr bool PERM = true, AFTER_DRAIN = false;
    const float* x; float* out; bf16_t* a2; const float* gf; float* ssq; unsigned char* h8;
    __device__ __forceinline__ void operator()(const f32x4 (&acc)[2][2][4][2], const Unit& u, int wr, int wc, int fr, int fq) const {
        const int row0 = u.pm * BM + wr * 64 + fr, col0 = u.pn * BM + wc * 32 + 8 * fq;
        f32x4 gv[2][2];
#pragma unroll
        for (int bj = 0; bj < 2; ++bj)
#pragma unroll
            for (int n = 0; n < 2; ++n) gv[bj][n] = *(const f32x4*)(gf + col0 + bj * HALF + 4 * n);
#pragma unroll
        for (int ai = 0; ai < 2; ++ai)
#pragma unroll
            for (int m = 0; m < 4; ++m) { const int row = row0 + ai * HALF + m * 16; const size_t off = (size_t)row * 2048 + col0; float ss = 0.f;
#pragma unroll
                for (int bj = 0; bj < 2; ++bj) {
                    const f32x4 x0 = *(const f32x4*)(x + off + bj * HALF), x1 = *(const f32x4*)(x + off + bj * HALF + 4);
                    const f32x4 v0 = x0 + acc[ai][bj][m][0], v1 = x1 + acc[ai][bj][m][1];
                    ss += (v0[0] * v0[0] + v0[1] * v0[1]) + (v0[2] * v0[2] + v0[3] * v0[3]); ss += (v1[0] * v1[0] + v1[1] * v1[1]) + (v1[2] * v1[2] + v1[3] * v1[3]);
                    const f32x4 a0 = v0 * gv[bj][0], a1 = v1 * gv[bj][1];
                    u32x4 w; w.x = cvt_pk_bf16(a0[0], a0[1]); w.y = cvt_pk_bf16(a0[2], a0[3]); w.z = cvt_pk_bf16(a1[0], a1[1]); w.w = cvt_pk_bf16(a1[2], a1[3]);
                    *(u32x4*)(a2 + off + bj * HALF) = w;
                    { const f32x4 b0 = a0 * 16.0f, b1 = a1 * 16.0f; unsigned p = 0u, q2 = 0u;
#pragma unroll
                      for (int e_ = 0; e_ < 4; ++e_) { const int i0_ = __builtin_amdgcn_fmed3f(__builtin_rintf(b0[e_]), -127.f, 127.f), i1_ = __builtin_amdgcn_fmed3f(__builtin_rintf(b1[e_]), -127.f, 127.f);
                          p |= ((unsigned)i0_ & 0xffu) << (8 * e_); q2 |= ((unsigned)i1_ & 0xffu) << (8 * e_); }
                      typedef unsigned u32x2_ __attribute__((ext_vector_type(2))); *(u32x2_*)(h8 + off + bj * HALF) = (u32x2_){p, q2}; } }
                ss += __shfl_xor(ss, 16); ss += __shfl_xor(ss, 32);
                if (fq == 0) ssq[(size_t)row * 32 + u.pn * 4 + wc] = ss; }
    }
};
}

__device__ __forceinline__ void p0_transpose_item(const float* W, int K, int N, bf16* WT, LAS float* scr, int item, int lane, bool permg) {
    const int nblk = N / 32, kb = item / nblk, nb = item % nblk, k0 = 64 * kb, n0 = 32 * nb;
#pragma unroll 8
    for (int i = 0; i < 32; ++i) { const int kk = 2 * i + (lane >> 5); scr[kk * 33 + (lane & 31)] = W[(size_t)(k0 + kk) * N + n0 + (lane & 31)]; }
    LDS_WAIT(); asm volatile("" ::: "memory");
    int nd = n0; if (permg) { const int gl = (n0 & 255) >> 5; nd = (n0 & ~255) + 32 * (4 * (gl & 1) + (gl >> 1)); }
    const int c = lane & 7;
#pragma unroll
    for (int j = 0; j < 4; ++j) { const int n = (lane >> 3) + 8 * j; const LAS float* s = scr + (8 * c) * 33 + n;
        v4u o; o.x = pk2(s[0 * 33], s[1 * 33]); o.y = pk2(s[2 * 33], s[3 * 33]); o.z = pk2(s[4 * 33], s[5 * 33]); o.w = pk2(s[6 * 33], s[7 * 33]);
        *(v4u*)(WT + (size_t)(nd + n) * K + k0 + 8 * c) = o; }
    LDS_WAIT(); asm volatile("" ::: "memory");
}
__device__ __forceinline__ void rms_row_to_bf16(const float* xrow, const float* g, bf16* orow, int lane) {
    const f32x4* xr = (const f32x4*)xrow + lane; const f32x4* gr = (const f32x4*)g + lane;
    f32x4 v[8]; float s = 0.f;
#pragma unroll
    for (int j = 0; j < 8; ++j) { v[j] = xr[64 * j]; s += (v[j].x * v[j].x + v[j].y * v[j].y) + (v[j].z * v[j].z + v[j].w * v[j].w); }
    const float rstd = 1.0f / sqrtf(wave_sum(s) * (1.f / DM) + EPS);
    v2u* o8 = (v2u*)orow + lane;
#pragma unroll
    for (int j = 0; j < 8; ++j) { const f32x4 gg = gr[64 * j]; v2u w; w.x = pk2(v[j].x * rstd * gg.x, v[j].y * rstd * gg.y); w.y = pk2(v[j].z * rstd * gg.z, v[j].w * rstd * gg.w); o8[64 * j] = w; }
}
__device__ __forceinline__ void cvt_bf16_stream(const float* src, bf16* dst, size_t n8, size_t gtid, size_t nthr) {
    for (size_t i = gtid; i < n8; i += nthr) { const f32x4 a = *(const f32x4*)(src + i * 8), b = *(const f32x4*)(src + i * 8 + 4);
        v4u o; o.x = pk2(a.x, a.y); o.y = pk2(a.z, a.w); o.z = pk2(b.x, b.y); o.w = pk2(b.z, b.w); *(v4u*)(dst + i * 8) = o; }
}

__device__ __forceinline__ void cvt_i4_slices(const float* src, unsigned char* dst, float inv_step, size_t gtid, size_t nthr) {
    for (size_t i = gtid; i < (size_t)16384 * 64; i += nthr) { v4u o; const size_t e = i >> 6; const int c32 = (int)(i & 63), s = c32 >> 3, sub = c32 & 7;
#pragma unroll
        for (int w = 0; w < 4; ++w) { const f32x4 a = *(const f32x4*)(src + i * 32 + 8 * w) * inv_step, b = *(const f32x4*)(src + i * 32 + 8 * w + 4) * inv_step; unsigned d = 0u;
#pragma unroll
            for (int e_ = 0; e_ < 4; ++e_) { const int lo = (int)__builtin_amdgcn_fmed3f(__builtin_rintf(a[e_]), -8.f, 7.f) + 8, hi = (int)__builtin_amdgcn_fmed3f(__builtin_rintf(b[e_]), -8.f, 7.f) & 15; d |= ((unsigned)lo | ((unsigned)hi << 4)) << (8 * e_); }
            if (w == 0) o.x = d; else if (w == 1) o.y = d; else if (w == 2) o.z = d; else o.w = d; }
        *(v4u*)(dst + ((size_t)s * 16384 + e) * 128 + 16 * sub) = o; }
}
__device__ __forceinline__ float table_std16(const float* src, LAS float* scr, int tid) {
    float s = 0.f;
#pragma unroll
    for (int j = 0; j < 16; ++j) { const f32x4 v = *(const f32x4*)(src + (size_t)(j * 512 + tid) * 4); s += (v.x * v.x + v.y * v.y) + (v.z * v.z + v.w * v.w); }
    s = wave_sum(s);
    __syncthreads();
    if ((tid & 63) == 0) scr[tid >> 6] = s;
    __syncthreads();
    float t = 0.f;
#pragma unroll
    for (int w = 0; w < 8; ++w) t += scr[w];
    __syncthreads();
    return sqrtf(t * (1.0f / 32768.0f));
}
__device__ __forceinline__ void cvt_i8_slices(const float* src, unsigned char* dst, float scale, size_t gtid, size_t nthr) {
    for (size_t i = gtid; i < (size_t)16384 * 128; i += nthr) { v4u o; const size_t e = i >> 7; const int c16 = (int)(i & 127), s = c16 >> 3, sub = c16 & 7;
#pragma unroll
        for (int q = 0; q < 4; ++q) { const f32x4 a = *(const f32x4*)(src + i * 16 + 4 * q) * scale; unsigned w = 0u;
#pragma unroll
            for (int e_ = 0; e_ < 4; ++e_) { const int iv = (int)__builtin_amdgcn_fmed3f(__builtin_rintf(a[e_]), -127.f, 127.f); w |= ((unsigned)iv & 0xffu) << (8 * e_); }
            if (q == 0) o.x = w; else if (q == 1) o.y = w; else if (q == 2) o.z = w; else o.w = w; }
        *(v4u*)(dst + ((size_t)s * 16384 + e) * 128 + 16 * sub) = o; }
}
__device__ __forceinline__ void cvt_fp8_slices(const float* src, unsigned char* dst, float scale, size_t gtid, size_t nthr) {
    for (size_t i = gtid; i < (size_t)16384 * 128; i += nthr) { v4u o; const size_t e = i >> 7; const int c16 = (int)(i & 127), s = c16 >> 3, sub = c16 & 7;
#pragma unroll
        for (int q = 0; q < 4; ++q) { const f32x4 a = *(const f32x4*)(src + i * 16 + 4 * q) * scale; int w = __builtin_amdgcn_cvt_pk_fp8_f32(a.x, a.y, 0, false); w = __builtin_amdgcn_cvt_pk_fp8_f32(a.z, a.w, w, true);
            if (q == 0) o.x = (unsigned)w; else if (q == 1) o.y = (unsigned)w; else if (q == 2) o.z = (unsigned)w; else o.w = (unsigned)w; }
        *(v4u*)(dst + ((size_t)s * 16384 + e) * 128 + 16 * sub) = o; }
}

namespace att {
constexpr int SLOTB = 32768;
constexpr int NSLOT = 3, LW_OFF = NSLOT * SLOTB;
constexpr int XSTR = 132;
__device__ __forceinline__ void glds16(const void* gsrc, unsigned lds_dst) { unsigned keep;
    asm volatile("s_mov_b32 %0, m0\n\ts_mov_b32 m0, %2\n\ts_nop 0\n\tglobal_load_lds_dwordx4 %1, off\n\ts_mov_b32 m0, %0" : "=&s"(keep) : "v"(gsrc), "s"(lds_dst) : "memory"); }
__device__ __forceinline__ int crow(int r, int hi) { return (r & 3) + 8 * (r >> 2) + 4 * hi; }
typedef short v4i16_t __attribute__((ext_vector_type(4)));
__device__ __forceinline__ s16x4 vtr(const LAS char* p) { return __builtin_bit_cast(s16x4, __builtin_amdgcn_ds_read_tr16_b64_v4i16((LAS v4i16_t*)p)); }
#define ATT_WAIT_BAR(N) asm volatile("s_waitcnt vmcnt(" #N ") lgkmcnt(0)\n\ts_barrier" ::: "memory")

__device__ __forceinline__ void attn_unit(int b, int h, int qblk, const bf16* Q, const bf16* K, const bf16* V, bf16* MIX, const float* subg, float lam, float M2, LAS char* lds) {
    const int tid = threadIdx.x, lane = tid & 63, r32 = lane & 31, hi = lane >> 5, wid = __builtin_amdgcn_readfirstlane(tid >> 6), c = wid >> 2, qs = wid & 3;
    const size_t rowbase = (size_t)b * SEQ; const int q0 = qblk * 128, NT = 2 * (qblk + 1);
    const unsigned lds0 = (unsigned)(uintptr_t)lds;
    const bf16* ksrc[2]; const bf16* vsrc[2]; unsigned kdst[2], vdst[2];
#pragma unroll
    for (int i = 0; i < 2; ++i) { const int pk = 2 * wid + i, rr = lane >> 4, p = lane & 15, r = 4 * pk + rr;
        ksrc[i] = K + (rowbase + r) * 1024 + h * 128 + ((p ^ (r & 15)) * 8); kdst[i] = lds0 + pk * 1024;
        vsrc[i] = V + (rowbase + r) * 1024 + h * 128 + ((p ^ (rr << 2)) * 8); vdst[i] = lds0 + 16384 + pk * 1024; }
#define ATT_DMA(t, slot) do { _Pragma("unroll") for (int i_ = 0; i_ < 2; ++i_) { glds16(ksrc[i_] + (size_t)(t) * 64 * 1024, (unsigned)__builtin_amdgcn_readfirstlane(kdst[i_] + (slot) * SLOTB)); \
        glds16(vsrc[i_] + (size_t)(t) * 64 * 1024, (unsigned)__builtin_amdgcn_readfirstlane(vdst[i_] + (slot) * SLOTB)); } } while (0)
    ATT_DMA(0, 0); ATT_DMA(1, 1);
    const int qrow = q0 + 32 * qs + r32;
    bf16x8 qr[4];
#pragma unroll
    for (int d0 = 0; d0 < 4; ++d0) qr[d0] = *(const bf16x8*)(Q + (rowbase + qrow) * 1024 + h * 128 + c * 64 + d0 * 16 + hi * 8);
    asm volatile("" : "+v"(qr[0]), "+v"(qr[1]), "+v"(qr[2]), "+v"(qr[3]));
    const float slope2 = exp2f(-(float)(h + 1)) * 1.4426950408889634f;
    float base = -slope2 * (float)(qrow - 4 * hi) - M2;
    const float s32 = 32.f * slope2, s64 = 64.f * slope2;
    f32x16 o[4]; o[0] = f32x16{}; o[1] = f32x16{}; o[2] = f32x16{}; o[3] = f32x16{};
    float lsum = 0.f;
    int kofs[4], vofs[4];
    { const int q4 = (lane & 15) >> 2, p4 = lane & 3, gb = (lane >> 4) & 1;
#pragma unroll
      for (int d0 = 0; d0 < 4; ++d0) { kofs[d0] = r32 * 256 + (((8 * c + 2 * d0 + hi) ^ (r32 & 15)) << 4); vofs[d0] = 16384 + (4 * hi + q4) * 256 + (((((d0 ^ q4) << 2) | (gb << 1) | (p4 >> 1))) << 4) + (p4 & 1) * 8; } }
    const LAS char* lbase = (const LAS char*)lds;
    const int qw0 = q0 + 32 * qs;
    int slot = 0;
    for (int t = 0; t < NT; ++t) {
        if (t == 0) { ATT_WAIT_BAR(0); } else if (t + 1 < NT) { ATT_WAIT_BAR(4); } else { ATT_WAIT_BAR(0); }
        if (t + 2 < NT) { const int s2_ = (slot == 0) ? 2 : slot - 1; ATT_DMA(t + 2, s2_); }
        const int k0 = 64 * t;
        if (k0 <= qw0 + 31) {
            const LAS char* sp_ = lbase + slot * SLOTB;
            f32x16 p0, p1;
#pragma unroll
            for (int r = 0; r < 16; ++r) { p0[r] = __builtin_fmaf(slope2, (float)((r & 3) + 8 * (r >> 2)), base); p1[r] = p0[r] + s32; }
            __builtin_amdgcn_s_setprio(1);
#pragma unroll
            for (int d0 = 0; d0 < 4; ++d0) {
                const bf16x8 ka = *(const LAS bf16x8*)(sp_ + kofs[d0]), kb = *(const LAS bf16x8*)(sp_ + kofs[d0] + 8192);
                p0 = __builtin_amdgcn_mfma_f32_32x32x16_bf16(ka, qr[d0], p0, 0, 0, 0);
                p1 = __builtin_amdgcn_mfma_f32_32x32x16_bf16(kb, qr[d0], p1, 0, 0, 0); }
            __builtin_amdgcn_s_setprio(0);
#pragma unroll
            for (int r = 0; r < 16; ++r) { p0[r] = __builtin_amdgcn_exp2f(p0[r]); p1[r] = __builtin_amdgcn_exp2f(p1[r]); }
            if (k0 + 63 > qw0) {
                const int dq = qrow - k0;
#pragma unroll
                for (int r = 0; r < 16; ++r) { const int kk = crow(r, hi); if (kk > dq) p0[r] = 0.f; if (kk + 32 > dq) p1[r] = 0.f; }
            }
            {
                float s0 = p0[0] + p1[0], s1 = p0[1] + p1[1], s2 = p0[2] + p1[2], s3 = p0[3] + p1[3];
#pragma unroll
                for (int r = 4; r < 16; r += 4) { s0 += p0[r] + p1[r]; s1 += p0[r + 1] + p1[r + 1]; s2 += p0[r + 2] + p1[r + 2]; s3 += p0[r + 3] + p1[r + 3]; }
                lsum += (s0 + s1) + (s2 + s3); }
            bf16x8 pw[4];
#pragma unroll
            for (int ks = 0; ks < 4; ++ks) { v4u w;
                if (ks < 2) { w.x = pk2(p0[8 * ks + 0], p0[8 * ks + 1]); w.y = pk2(p0[8 * ks + 2], p0[8 * ks + 3]); w.z = pk2(p0[8 * ks + 4], p0[8 * ks + 5]); w.w = pk2(p0[8 * ks + 6], p0[8 * ks + 7]); }
                else { const int k2 = ks - 2; w.x = pk2(p1[8 * k2 + 0], p1[8 * k2 + 1]); w.y = pk2(p1[8 * k2 + 2], p1[8 * k2 + 3]); w.z = pk2(p1[8 * k2 + 4], p1[8 * k2 + 5]); w.w = pk2(p1[8 * k2 + 6], p1[8 * k2 + 7]); }
                pw[ks] = __builtin_bit_cast(bf16x8, w); }
            s16x4 fa[8], fb[8];
#define ATT_VLD(F, d0_) do { _Pragma("unroll") for (int ks_ = 0; ks_ < 4; ++ks_) { F[2 * ks_] = vtr(sp_ + vofs[d0_] + ks_ * 4096); F[2 * ks_ + 1] = vtr(sp_ + vofs[d0_] + ks_ * 4096 + 2048); } } while (0)
#define ATT_PV(F, d0_) do { _Pragma("unroll") for (int ks_ = 0; ks_ < 4; ++ks_) { const bf16x8 vf_ = (bf16x8){F[2 * ks_][0], F[2 * ks_][1], F[2 * ks_][2], F[2 * ks_][3], F[2 * ks_ + 1][0], F[2 * ks_ + 1][1], F[2 * ks_ + 1][2], F[2 * ks_ + 1][3]}; \
                o[d0_] = __builtin_amdgcn_mfma_f32_32x32x16_bf16(pw[ks_], vf_, o[d0_], 0, 0, 0); } } while (0)
            __builtin_amdgcn_s_setprio(1);
            ATT_VLD(fa, 0); ATT_VLD(fb, 1); __builtin_amdgcn_sched_barrier(0);
            ATT_PV(fa, 0); __builtin_amdgcn_sched_barrier(0); ATT_VLD(fa, 2); __builtin_amdgcn_sched_barrier(0);
            ATT_PV(fb, 1); __builtin_amdgcn_sched_barrier(0); ATT_VLD(fb, 3); __builtin_amdgcn_sched_barrier(0);
            ATT_PV(fa, 2); __builtin_amdgcn_sched_barrier(0);
            ATT_PV(fb, 3);
            __builtin_amdgcn_s_setprio(0);
#undef ATT_VLD
#undef ATT_PV
        }
        base += s64;
        slot = (slot == NSLOT - 1) ? 0 : slot + 1;
    }
    ATT_WAIT_BAR(0);
    LAS float* lw = (LAS float*)(lds + LW_OFF) + wid * 32;
    { auto rr = __builtin_amdgcn_permlane32_swap(__float_as_uint(lsum), __float_as_uint(lsum), false, false); lsum = __uint_as_float(rr[0]) + __uint_as_float(rr[1]); }
    if (hi == 0) lw[r32] = lsum;
    LDS_WAIT();
    LAS float* X = (LAS float*)lds + qs * 32 * XSTR;
#pragma unroll
    for (int r = 0; r < 16; ++r) { const float rl = 1.0f / lw[crow(r, hi)];
#pragma unroll
        for (int d0 = 0; d0 < 4; ++d0) o[d0][r] *= rl; }
    if (c == 1) {
#pragma unroll
        for (int r = 0; r < 16; ++r)
#pragma unroll
            for (int d0 = 0; d0 < 4; ++d0) X[crow(r, hi) * XSTR + d0 * 32 + r32] = o[d0][r];
    }
    ATT_WAIT_BAR(0);
    if (c == 0) {
#pragma unroll
        for (int r = 0; r < 16; ++r)
#pragma unroll
            for (int d0 = 0; d0 < 4; ++d0) { LAS float* px = X + crow(r, hi) * XSTR + d0 * 32 + r32; const float a = o[d0][r] - lam * (*px); *px = a; }
        LDS_WAIT(); asm volatile("" ::: "memory");
        const LAS f32x4* rp = (const LAS f32x4*)(X + r32 * XSTR + hi * 64);
        f32x4 av[16]; float ss = 0.f;
#pragma unroll
        for (int j = 0; j < 16; ++j) { av[j] = rp[j]; ss += (av[j].x * av[j].x + av[j].y * av[j].y) + (av[j].z * av[j].z + av[j].w * av[j].w); }
        { auto rr = __builtin_amdgcn_permlane32_swap(__float_as_uint(ss), __float_as_uint(ss), false, false); ss = __uint_as_float(rr[0]) + __uint_as_float(rr[1]); }
        const float rs = 0.8f / sqrtf(ss * (1.0f / 128.0f) + EPS);
        bf16* op = MIX + (rowbase + qrow) * 2048 + h * 128 + hi * 64;
#pragma unroll
        for (int j = 0; j < 8; ++j) { const f32x4 g0 = *(const f32x4*)(subg + hi * 64 + 8 * j), g1 = *(const f32x4*)(subg + hi * 64 + 8 * j + 4); const f32x4 a0 = av[2 * j] * rs * g0, a1 = av[2 * j + 1] * rs * g1;
            v4u w; w.x = pk2(a0.x, a0.y); w.y = pk2(a0.z, a0.w); w.z = pk2(a1.x, a1.y); w.w = pk2(a1.z, a1.w); *(v4u*)(op + 8 * j) = w; }
    }
    ATT_WAIT_BAR(0);
#undef ATT_DMA
}
}


#ifndef DBG_NAIVE_ATTN
#define DBG_NAIVE_ATTN 0
#endif
#if DBG_NAIVE_ATTN
__device__ __forceinline__ void naive_attn_row(int b, int h, int q, const bf16* Q, const bf16* K, const bf16* V, bf16* MIX, const float* subg, float lam, LAS float* S, int lane) {
    const size_t rowbase = (size_t)b * SEQ; const float slope2 = exp2f(-(float)(h + 1)) * 1.4426950408889634f;
    for (int c = 0; c < 2; ++c) {
        float qv[64];
        const bf16* qp = Q + (rowbase + q) * 1024 + h * 128 + c * 64;
#pragma unroll
        for (int d = 0; d < 64; d += 2) { const unsigned u = *(const unsigned*)(qp + d); qv[d] = bflo(u); qv[d + 1] = bfhi(u); }
        for (int key = lane; key <= q; key += 64) { const bf16* kp = K + (rowbase + key) * 1024 + h * 128 + c * 64; float s = 0.f;
#pragma unroll
            for (int d = 0; d < 64; d += 2) { const unsigned u = *(const unsigned*)(kp + d); s += qv[d] * bflo(u) + qv[d + 1] * bfhi(u); }
            S[c * 2048 + key] = s - slope2 * (float)(q - key); }
    }
    LDS_WAIT();
    float linv[2];
    for (int c = 0; c < 2; ++c) { float m = -1e30f; for (int key = lane; key <= q; key += 64) m = fmaxf(m, S[c * 2048 + key]); m = wave_max(m);
        float l = 0.f; for (int key = lane; key <= q; key += 64) { const float p = exp2f(S[c * 2048 + key] - m); S[c * 2048 + key] = p; l += p; } linv[c] = 1.0f / wave_sum(l); }
    for (int key = lane; key <= q; key += 64) S[key] = S[key] * linv[0] - lam * S[2048 + key] * linv[1];
    LDS_WAIT();
    float o0 = 0.f, o1 = 0.f; const bf16* vp = V + rowbase * 1024 + h * 128 + lane;
    for (int key = 0; key <= q; ++key) { const float a = S[key]; o0 += a * __uint_as_float((unsigned)vp[(size_t)key * 1024] << 16); o1 += a * __uint_as_float((unsigned)vp[(size_t)key * 1024 + 64] << 16); }
    const float ss = wave_sum(o0 * o0 + o1 * o1); const float rs = 0.8f / sqrtf(ss * (1.0f / 128.0f) + EPS);
    bf16* op = MIX + (rowbase + q) * 2048 + h * 128 + lane;
    op[0] = (bf16)(pk2(o0 * rs * subg[lane], 0.f) & 0xffffu); op[64] = (bf16)(pk2(o1 * rs * subg[lane + 64], 0.f) & 0xffffu);
    LDS_WAIT();
}
#endif

__device__ __forceinline__ unsigned ord_key(float f) { const unsigned u = __float_as_uint(f); return (u & 0x80000000u) ? ~u : (u | 0x80000000u); }
__device__ __forceinline__ float ord_val(unsigned k) { return __uint_as_float((k & 0x80000000u) ? (k ^ 0x80000000u) : ~k); }
#define CE_DESC(a, b) do { const unsigned hi__ = max((a), (b)), lo__ = min((a), (b)); (a) = hi__; (b) = lo__; } while (0)
__device__ __forceinline__ void sort16_desc(unsigned (&v)[16]) {
#pragma unroll
    for (int k = 2; k <= 16; k <<= 1)
#pragma unroll
        for (int j = k >> 1; j > 0; j >>= 1)
#pragma unroll
            for (int i = 0; i < 16; ++i) { const int l = i ^ j; if (l > i) { if ((i & k) == 0) CE_DESC(v[i], v[l]); else CE_DESC(v[l], v[i]); } }
}
__device__ __forceinline__ void merge16_desc_rev(unsigned (&a)[16], const unsigned (&brev)[16]) {
#pragma unroll
    for (int i = 0; i < 16; ++i) a[i] = max(a[i], brev[i]);
#pragma unroll
    for (int j = 8; j > 0; j >>= 1)
#pragma unroll
        for (int i = 0; i < 16; ++i) { const int l = i ^ j; if (l > i) CE_DESC(a[i], a[l]); }
}

constexpr int P5_LST_OFF = 65536, P5_TAB_OFF = P5_LST_OFF + 16384;
__device__ __forceinline__ void peer_topk_item(int tile, int h, const bf16* QP, const float* SSQ, int* EIDX, float* EGATE, float* RSTD, LAS char* lds) {
    const int tid = threadIdx.x, lane = tid & 63, r32 = lane & 31, hi = lane >> 5, wid = __builtin_amdgcn_readfirstlane(tid >> 6);
    LAS unsigned* LST = (LAS unsigned*)(lds + P5_LST_OFF);
    const LAS unsigned char* TAB = (const LAS unsigned char*)(lds + P5_TAB_OFF);
    const int tok0 = tile * 128;
    {
        const int c = wid >> 2, tb = wid & 3;
        bf16x8 qf[8];
        const bf16* qp = QP + (size_t)(tok0 + tb * 32 + r32) * 2048 + h * 256 + c * 128 + hi * 8;
#pragma unroll
        for (int s = 0; s < 8; ++s) qf[s] = *(const bf16x8*)(qp + 16 * s);
        const LAS char* sp = lds + c * 32768 + hi * 2048 + r32 * 16;
        unsigned best[16];
#pragma unroll
        for (int kb = 0; kb < 4; ++kb) { f32x16 acc = f32x16{};
#pragma unroll
            for (int s = 0; s < 8; ++s) { const bf16x8 sf = *(const LAS bf16x8*)(sp + s * 4096 + kb * 512); acc = __builtin_amdgcn_mfma_f32_32x32x16_bf16(sf, qf[s], acc, 0, 0, 0); }
            unsigned v[16];
#pragma unroll
            for (int r = 0; r < 16; ++r) v[r] = (ord_key(acc[r]) & ~0x7Fu) | (unsigned)(32 * kb + (r & 3) + 8 * (r >> 2)) | (unsigned)(hi << 2);
            sort16_desc(v);
            if (kb == 0) {
#pragma unroll
                for (int i = 0; i < 16; ++i) best[i] = v[i];
            } else { unsigned vr[16];
#pragma unroll
                for (int i = 0; i < 16; ++i) vr[i] = v[15 - i];
                merge16_desc_rev(best, vr); } }
        {
            unsigned br[16];
#pragma unroll
            for (int i = 0; i < 16; ++i) br[i] = (unsigned)__shfl_xor((int)best[15 - i], 32);
            merge16_desc_rev(best, br); }
        if (hi == 0) { LAS unsigned* lrow = LST + (c * 128 + tb * 32 + r32) * 16;
#pragma unroll
            for (int i = 0; i < 4; ++i) *(LAS v4u*)(lrow + 4 * i) = (v4u){best[4 * i], best[4 * i + 1], best[4 * i + 2], best[4 * i + 3]}; }
    }
    __syncthreads();
    {
        const int token = tid >> 2, q = tid & 3;
        const LAS unsigned* l1 = LST + token * 16; const LAS unsigned* l2 = LST + (128 + token) * 16;
        unsigned v[16];
#pragma unroll
        for (int m = 0; m < 13; ++m) { const int n = 4 * m + q; const unsigned pid = TAB[n < 50 ? n : 0]; const unsigned a = l1[pid >> 4], b2 = l2[pid & 15u];
            const unsigned key = (ord_key(ord_val(a & ~0x7Fu) + ord_val(b2 & ~0x7Fu)) & ~0xFFu) | pid; v[m] = n < 50 ? key : 0u; }
        v[13] = 0u; v[14] = 0u; v[15] = 0u;
        sort16_desc(v);
#pragma unroll
        for (int w = 1; w <= 2; w <<= 1) { unsigned br[16];
#pragma unroll
            for (int i = 0; i < 16; ++i) br[i] = (unsigned)__shfl_xor((int)v[15 - i], w);
            merge16_desc_rev(v, br); }
        const int t = tok0 + token;
        const f32x4 p0 = *(const f32x4*)(SSQ + (size_t)t * 32 + 8 * q), p1 = *(const f32x4*)(SSQ + (size_t)t * 32 + 8 * q + 4);
        float ssq = ((p0.x + p0.y) + (p0.z + p0.w)) + ((p1.x + p1.y) + (p1.z + p1.w));
        ssq += __shfl_xor(ssq, 1); ssq += __shfl_xor(ssq, 2);
        const float rstd = 1.0f / sqrtf(ssq * (1.0f / DM) + EPS);
        if (h == 0 && q == 0) RSTD[t] = rstd;
        const unsigned p_top = v[0] & 0xFFu; const float vmax = (ord_val(l1[p_top >> 4] & ~0x7Fu) + ord_val(l2[p_top & 15u] & ~0x7Fu)) * rstd;
        float ev[4]; int ex[4]; float es = 0.f;
#pragma unroll
        for (int m = 0; m < 4; ++m) { const unsigned kk = q == 0 ? v[m] : q == 1 ? v[4 + m] : q == 2 ? v[8 + m] : v[12 + m];
            const unsigned pid = kk & 0xFFu; const unsigned a = l1[pid >> 4], b2 = l2[pid & 15u];
            const float sv = (ord_val(a & ~0x7Fu) + ord_val(b2 & ~0x7Fu)) * rstd;
            ev[m] = __expf(sv - vmax); es += ev[m]; ex[m] = (int)((a & 0x7Fu) * 128u + (b2 & 0x7Fu)); }
        es += __shfl_xor(es, 1); es += __shfl_xor(es, 2);
        const float inv = 1.0f / es;
        *(int4*)(EIDX + (size_t)t * 128 + h * 16 + 4 * q) = make_int4(ex[0], ex[1], ex[2], ex[3]);
        *(f32x4*)(EGATE + (size_t)t * 128 + h * 16 + 4 * q) = (f32x4){ev[0] * inv, ev[1] * inv, ev[2] * inv, ev[3] * inv};
    }
    __syncthreads();
}

__device__ __forceinline__ f32x2 dot16_fp8(const v4u u, const f32x2* h, f32x2 acc) {
#pragma unroll
    for (int w = 0; w < 4; ++w) { const unsigned d = w == 0 ? u.x : w == 1 ? u.y : w == 2 ? u.z : u.w;
        const f32x2 f0 = __builtin_amdgcn_cvt_pk_f32_fp8((int)d, false), f1 = __builtin_amdgcn_cvt_pk_f32_fp8((int)d, true);
        acc = __builtin_elementwise_fma(h[2 * w], f0, acc); acc = __builtin_elementwise_fma(h[2 * w + 1], f1, acc); }
    return acc;
}
__device__ __forceinline__ void axpy16_fp8(const v4u v, f32x2 a2, f32x2* o) {
#pragma unroll
    for (int w = 0; w < 4; ++w) { const unsigned d = w == 0 ? v.x : w == 1 ? v.y : w == 2 ? v.z : v.w;
        const f32x2 f0 = __builtin_amdgcn_cvt_pk_f32_fp8((int)d, false), f1 = __builtin_amdgcn_cvt_pk_f32_fp8((int)d, true);
        o[2 * w] = __builtin_elementwise_fma(a2, f0, o[2 * w]); o[2 * w + 1] = __builtin_elementwise_fma(a2, f1, o[2 * w + 1]); }
}
struct PItem { int t, s; };
__device__ __forceinline__ PItem peer_item(int q, int nq, int nper, int tb, int tstride, int xl) {
    const int j = (q < nq ? q : nq - 1) >> 1; PItem it; const int r = j >= nper ? 1 : 0; it.s = 8 * r + xl; const int t = tb + (j - r * nper) * tstride; it.t = t < T ? t : T - 1; return it; }
__device__ __forceinline__ void pe_idx8(const PItem it, int hh, const int* EIDX, int g, int (&ex)[8]) {
#pragma unroll
    for (int i = 0; i < 2; ++i) { const int4 v = *(const int4*)(EIDX + (size_t)it.t * 128 + g * 16 + 8 * hh + 4 * i); ex[4 * i] = v.x; ex[4 * i + 1] = v.y; ex[4 * i + 2] = v.z; ex[4 * i + 3] = v.w; }
}
__device__ __forceinline__ void pe_gather8(const PItem it, const unsigned char* TB, int sub, const int (&ex)[8], v4u (&uv)[8]) {
    const unsigned char* ub = TB + (size_t)it.s * 16384 * 128 + 16 * sub;
#pragma unroll
    for (int i = 0; i < 8; ++i) uv[i] = *(const v4u*)(ub + (size_t)ex[i] * 128);
}
__device__ __forceinline__ int sdot4(unsigned a, unsigned b, int acc) { return __builtin_amdgcn_sdot4((int)a, (int)b, acc, false); }
__device__ __forceinline__ void pu_acc8(const v4u (&uv)[8], const v4u ha, const v4u hb, int hs8, int (&r)[8]) {
#pragma unroll
    for (int i = 0; i < 8; ++i) { int a = -hs8, b = 0;
        a = sdot4(uv[i].x & 0x0F0F0F0Fu, ha.x, a); b = sdot4(uv[i].x & 0xF0F0F0F0u, ha.y, b); a = sdot4(uv[i].y & 0x0F0F0F0Fu, ha.z, a); b = sdot4(uv[i].y & 0xF0F0F0F0u, ha.w, b);
        a = sdot4(uv[i].z & 0x0F0F0F0Fu, hb.x, a); b = sdot4(uv[i].z & 0xF0F0F0F0u, hb.y, b); a = sdot4(uv[i].w & 0x0F0F0F0Fu, hb.z, a); b = sdot4(uv[i].w & 0xF0F0F0F0u, hb.w, b);
        r[i] = a + (b >> 4); }
}
__device__ __forceinline__ void pu_store(const PItem it, bool valid, float* PART, int lane, const int (&rlo)[8], const int (&rhi)[8]) {
    const int g = lane >> 3, sub = lane & 7;
    int r[16];
#pragma unroll
    for (int i = 0; i < 8; ++i) { r[i] = rlo[i]; r[8 + i] = rhi[i]; }
#pragma unroll
    for (int w = 4, n = 8; w >= 1; w >>= 1, n >>= 1) { const bool up = (lane & w) != 0;
#pragma unroll
        for (int j = 0; j < n; ++j) { const int a = r[j], b2 = r[j + n]; const int keep = up ? b2 : a, send = up ? a : b2; r[j] = keep + __shfl_xor(send, w); } }
    const int i0 = 8 * ((sub >> 2) & 1) + 4 * ((sub >> 1) & 1) + 2 * (sub & 1);
    if (valid) *(f32x2*)(PART + ((size_t)it.s * T + it.t) * 128 + g * 16 + i0) = (f32x2){(float)r[0], (float)r[1]};
}
__device__ __forceinline__ PItem peer_item1(int q, int nq, int tb, int tstride, int xl) { const int j = (q < nq ? q : nq - 1) >> 1; PItem it; it.s = xl; const int t = tb + j * tstride; it.t = t < T ? t : T - 1; return it; }
__device__ __forceinline__ void peer_u_stage(int nper, int tb, int tstride, int xl, const unsigned char* H8, const unsigned char* U8, const int* EIDX, float* PART, int lane) {
    const int g = lane >> 3, sub = lane & 7, NQ = 2 * nper;
    int ex0[8], ex1[8], ex2[8], ex3[8]; v4u uv0[8], uv1[8], uv2[8], uv3[8], ha0, ha1, ha2, ha3, hb0, hb1, hb2, hb3; int rs[8];
#define PU_I(q, X) do { const PItem it_ = peer_item1((q), NQ, tb, tstride, xl); pe_idx8(it_, (X) & 1, EIDX, g, ex##X); } while (0)
#define PU_G(q, X) do { const PItem it_ = peer_item1((q), NQ, tb, tstride, xl); pe_gather8(it_, U8, sub, ex##X, uv##X); const unsigned char* hp_ = H8 + (size_t)it_.t * 2048 + 256 * it_.s + 32 * sub; ha##X = *(const v4u*)hp_; hb##X = *(const v4u*)(hp_ + 16); } while (0)
#define PU_F(q, X) do { const PItem it_ = peer_item1((q), NQ, tb, tstride, xl); int hs_ = sdot4(ha##X.x, 0x01010101u, 0); hs_ = sdot4(ha##X.z, 0x01010101u, hs_); hs_ = sdot4(hb##X.x, 0x01010101u, hs_); hs_ = sdot4(hb##X.z, 0x01010101u, hs_); \
        if (((X) & 1) == 0) pu_acc8(uv##X, ha##X, hb##X, 8 * hs_, rs); else { int rh_[8]; pu_acc8(uv##X, ha##X, hb##X, 8 * hs_, rh_); \
        pu_store(it_, (q) < NQ && (tb + ((q) >> 1) * tstride) < T, PART, lane, rs, rh_); } } while (0)
    PU_I(0, 0); PU_I(1, 1); PU_I(2, 2); PU_I(3, 3); PU_G(0, 0); PU_G(1, 1); PU_G(2, 2);
#pragma unroll 1
    for (int q = 0; q < NQ; q += 4) {
        PU_F(q, 0);     PU_G(q + 3, 3); PU_I(q + 4, 0);
        PU_F(q + 1, 1); PU_G(q + 4, 0); PU_I(q + 5, 1);
        PU_F(q + 2, 2); PU_G(q + 5, 1); PU_I(q + 6, 2);
        PU_F(q + 3, 3); PU_G(q + 6, 2); PU_I(q + 7, 3);
    }
#undef PU_I
#undef PU_G
#undef PU_F
}
__device__ __forceinline__ void tr4x4(unsigned r0, unsigned r1, unsigned r2, unsigned r3, unsigned& c0, unsigned& c1, unsigned& c2, unsigned& c3) {
    const unsigned a = __builtin_amdgcn_perm(r1, r0, 0x05010400u), b = __builtin_amdgcn_perm(r1, r0, 0x07030602u), c = __builtin_amdgcn_perm(r3, r2, 0x05010400u), d = __builtin_amdgcn_perm(r3, r2, 0x07030602u);
    c0 = __builtin_amdgcn_perm(c, a, 0x05040100u); c1 = __builtin_amdgcn_perm(c, a, 0x07060302u); c2 = __builtin_amdgcn_perm(d, b, 0x05040100u); c3 = __builtin_amdgcn_perm(d, b, 0x07060302u);
}
__device__ __forceinline__ void pv_acc8(const v4u (&vv)[8], const unsigned aq0, const unsigned aq1, int (&acc)[32]) {
#pragma unroll
    for (int m = 0; m < 2; ++m) { const unsigned aq = m == 0 ? aq0 : aq1;
#pragma unroll
        for (int w = 0; w < 4; ++w) { unsigned d[4];
#pragma unroll
            for (int i = 0; i < 4; ++i) d[i] = w == 0 ? vv[4 * m + i].x : w == 1 ? vv[4 * m + i].y : w == 2 ? vv[4 * m + i].z : vv[4 * m + i].w;
            unsigned c0, c1, c2, c3;
            tr4x4(d[0], d[1], d[2], d[3], c0, c1, c2, c3);
            acc[8 * w + 0] = sdot4(c0 & 0x0F0F0F0Fu, aq, acc[8 * w + 0]); acc[8 * w + 1] = sdot4(c1 & 0x0F0F0F0Fu, aq, acc[8 * w + 1]); acc[8 * w + 2] = sdot4(c2 & 0x0F0F0F0Fu, aq, acc[8 * w + 2]); acc[8 * w + 3] = sdot4(c3 & 0x0F0F0F0Fu, aq, acc[8 * w + 3]);
            acc[8 * w + 4] = sdot4(c0 & 0xF0F0F0F0u, aq, acc[8 * w + 4]); acc[8 * w + 5] = sdot4(c1 & 0xF0F0F0F0u, aq, acc[8 * w + 5]); acc[8 * w + 6] = sdot4(c2 & 0xF0F0F0F0u, aq, acc[8 * w + 6]); acc[8 * w + 7] = sdot4(c3 & 0xF0F0F0F0u, aq, acc[8 * w + 7]); } }
}
__device__ __forceinline__ void pv_store(const PItem it, bool valid, float* out, const float* ffn_g, const float* ASC, int lane, int (&acc)[32], int asum, const v2u x1b) {
    const int g = lane >> 3, sub = lane & 7;
#pragma unroll
    for (int w = 32, n = 16; w >= 8; w >>= 1, n >>= 1) { const bool up = (lane & w) != 0;
#pragma unroll
        for (int j = 0; j < n; ++j) { const int a = acc[j], b2 = acc[j + n]; const int keep = up ? b2 : a, send = up ? a : b2; acc[j] = keep + __shfl_xor(send, w); } }
    asum += __shfl_xor(asum, 8); asum += __shfl_xor(asum, 16); asum += __shfl_xor(asum, 32);
    const int c0 = 16 * ((g >> 2) & 1) + 8 * ((g >> 1) & 1) + 4 * (g & 1);
    const f32x4 gg = *(const f32x4*)(ffn_g + 256 * it.s + 32 * sub + c0);
    const float sc = ASC[it.t];
    const bool hicol = (c0 & 4) != 0;
    int v_[4];
#pragma unroll
    for (int i = 0; i < 4; ++i) v_[i] = hicol ? (acc[i] >> 4) : (acc[i] - 8 * asum);
    if (valid) *(f32x4*)(out + (size_t)it.t * 2048 + 256 * it.s + 32 * sub + c0) = (f32x4){bflo(x1b.x) / gg.x + sc * (float)v_[0], bfhi(x1b.x) / gg.y + sc * (float)v_[1], bflo(x1b.y) / gg.z + sc * (float)v_[2], bfhi(x1b.y) / gg.w + sc * (float)v_[3]};
}
__device__ __forceinline__ void peer_v_stage(int nper, int tb, int tstride, int xl, const unsigned char* V8, const int* EIDX, const unsigned* ACTQ, const float* ASC, const bf16* A2, const float* ffn_g, float* out, int lane) {
    const int g = lane >> 3, sub = lane & 7, NQ = 2 * nper;
    const int c0 = 16 * ((g >> 2) & 1) + 8 * ((g >> 1) & 1) + 4 * (g & 1);
    int ex0[8], ex1[8], ex2[8], ex3[8]; v4u vv0[8], vv1[8], vv2[8], vv3[8]; v2u aq0, aq1, aq2, aq3, x1a, x1b; int acc[32]; int asum = 0;
#define PV_I(q, X) do { const PItem it_ = peer_item1((q), NQ, tb, tstride, xl); pe_idx8(it_, (X) & 1, EIDX, g, ex##X); } while (0)
#define PV_G(q, X, XV) do { const PItem it_ = peer_item1((q), NQ, tb, tstride, xl); pe_gather8(it_, V8, sub, ex##X, vv##X); \
        aq##X = *(const v2u*)(ACTQ + (size_t)it_.t * 32 + g * 4 + 2 * ((X) & 1)); \
        if ((X) & 1) XV = *(const v2u*)(A2 + (size_t)it_.t * 2048 + 256 * it_.s + 32 * sub + c0); } while (0)
#define PV_F(q, X, XV) do { const PItem it_ = peer_item1((q), NQ, tb, tstride, xl); if (((X) & 1) == 0) { _Pragma("unroll") for (int m_ = 0; m_ < 32; ++m_) acc[m_] = 0; asum = 0; } \
        asum = sdot4(aq##X.x, 0x01010101u, asum); asum = sdot4(aq##X.y, 0x01010101u, asum); \
        pv_acc8(vv##X, aq##X.x, aq##X.y, acc); if ((X) & 1) pv_store(it_, (q) < NQ && (tb + ((q) >> 1) * tstride) < T, out, ffn_g, ASC, lane, acc, asum, XV); } while (0)
    PV_I(0, 0); PV_I(1, 1); PV_I(2, 2); PV_I(3, 3); PV_G(0, 0, x1a); PV_G(1, 1, x1a); PV_G(2, 2, x1b);
#pragma unroll 1
    for (int q = 0; q < NQ; q += 4) {
        PV_F(q, 0, x1a);     PV_G(q + 3, 3, x1b); PV_I(q + 4, 0);
        PV_F(q + 1, 1, x1a); PV_G(q + 4, 0, x1a); PV_I(q + 5, 1);
        PV_F(q + 2, 2, x1b); PV_G(q + 5, 1, x1a); PV_I(q + 6, 2);
        PV_F(q + 3, 3, x1b); PV_G(q + 6, 2, x1b); PV_I(q + 7, 3);
    }
#undef PV_I
#undef PV_G
#undef PV_F
}

struct Args { const float* in[17]; float* out; unsigned char* ws; int ph_lo, ph_hi; };
__global__ void __launch_bounds__(NTHREADS, 2) mk_fwd(Args args) {
    extern __shared__ __attribute__((aligned(16))) unsigned char lds_raw[];
    LAS unsigned char* lds = (LAS unsigned char*)lds_raw;
    const int tid = threadIdx.x, lane = tid & 63, wave = __builtin_amdgcn_readfirstlane(tid >> 6);
    const int G = gridDim.x, bx = blockIdx.x;
    const int vcu = (G % 8 == 0) ? (bx % 8) * (G / 8) + bx / 8 : bx;
    unsigned char* ws = args.ws;
    const float* x = args.in[0]; const float* attn_g = args.in[1]; const float* w_in = args.in[2]; const float* qg = args.in[3]; const float* kg = args.in[4];
    const float* lq1 = args.in[5]; const float* lk1 = args.in[6]; const float* lq2 = args.in[7]; const float* lk2 = args.in[8]; const float* subg = args.in[9];
    const float* conv_w = args.in[10]; const float* w_out = args.in[11]; const float* ffn_g = args.in[12]; const float* w_q = args.in[13]; const float* subkeys = args.in[14];
    const float* peer_u = args.in[15]; const float* peer_v = args.in[16];
    float* out = args.out;
    bf16* WtIn = (bf16*)(ws + WS_WIN); bf16* WtOut = (bf16*)(ws + WS_WOUT); bf16* WtQ = (bf16*)(ws + WS_WQ); bf16* SK = (bf16*)(ws + WS_SK);
    float* SSQ = (float*)(ws + WS_SSQ); int* EIDX = (int*)(ws + WS_EIDX); float* EGATE = (float*)(ws + WS_EGATE); float* RSTD = (float*)(ws + WS_RSTD);
    bf16* XN = (bf16*)(ws + WS_XN); bf16* MIX = XN;
    bf16* Qb = (bf16*)(ws + WS_Q); bf16* Kb = (bf16*)(ws + WS_K); bf16* Vb = (bf16*)(ws + WS_V); bf16* QP = Qb;
    bf16* CB = (bf16*)(ws + WS_CB); bf16* CC = (bf16*)(ws + WS_CC); bf16* CX = (bf16*)(ws + WS_CX); bf16* A2 = CB;
    unsigned char* U8 = ws + WS_UT; unsigned char* V8 = ws + WS_VT;
    volatile LAS unsigned* MISC = (volatile LAS unsigned*)(lds + MISC_OFF);
    if (tid < 16) MISC[tid] = 0u;
    __syncthreads();
    XcdBarrier bar = xcd_barrier_post((unsigned*)(ws + WS_CTL) + CW_BAR, MISC + 8);
    const int lo = args.ph_lo, hi_ph = args.ph_hi & 255, dbg_flags = args.ph_hi >> 8;
#ifndef DBG_DUP
#define DBG_DUP -1
#endif
#ifndef DBG_MASK
#define DBG_MASK 0xfff
#endif
#define IN(k) (((DBG_MASK >> (k)) & 1) && lo <= (k) && (k) < hi_ph)
#define REPS(k) for (int rep_ = 0; rep_ < ((DBG_DUP == (k)) ? 2 : 1); ++rep_)
#define SEAM(k) do { if (IN(k) && IN((k) + 1)) xcd_barrier(bar); } while (0)
    const int gw = vcu * NWAVES + wave, NGW = G * NWAVES;
    const size_t gtid = (size_t)bx * NTHREADS + tid, nthr = (size_t)G * NTHREADS;

    if (IN(0)) REPS(0) {
        LAS float* scr = (LAS float*)(lds + wave * 16384);
        constexpr int I_IN = (DM / 64) * (INC / 32), I_SQ = (DM / 64) * (DM / 32);
        if (!(dbg_flags & 4))
        for (int it = gw; it < I_IN + 2 * I_SQ; it += NGW) {
            if (it < I_IN) p0_transpose_item(w_in, DM, INC, WtIn, scr, it, lane, true);
            else if (it < I_IN + I_SQ) p0_transpose_item(w_out, DM, DM, WtOut, scr, it - I_IN, lane, false);
            else p0_transpose_item(w_q, DM, DM, WtQ, scr, it - I_IN - I_SQ, lane, false);
        }
        if (!(dbg_flags & 8))
        for (int m = gw; m < T; m += NGW) rms_row_to_bf16(x + (size_t)m * DM, attn_g, XN + (size_t)m * DM, lane);
        cvt_bf16_stream(subkeys, SK, (size_t)PEH * 2 * PNK * 128 / 8, gtid, nthr);
        if (!(dbg_flags & 16))
        {
            const float sig = table_std16(peer_u, (LAS float*)(lds + MISC_OFF + 64), tid); const float step = 0.335f * sig;
            if (bx == 0 && tid == 0) ((float*)(ws + WS_RSTD))[T] = step;
            cvt_i4_slices(peer_u, U8, 1.0f / step, gtid, nthr); }
        if (!(dbg_flags & 32))
        {
            const float sig = table_std16(peer_v, (LAS float*)(lds + MISC_OFF + 64), tid); const float step = 0.335f * sig;
            if (bx == 0 && tid == 0) ((float*)(ws + WS_RSTD))[T + 1] = step;
            cvt_i4_slices(peer_v, V8, 1.0f / step, gtid, nthr); }
    }
    SEAM(0);
    if (IN(1)) REPS(1) {
        pg8::Gemm g{XN, WtIn, T, INC, DM}; pg8::StaticOrder S; S.init(T, INC, G, bx);
        pg8::EpiProj E{Qb, qg, kg};
        pg8::gemm_phase<pg8::EpiProj, pg8::StaticOrder, true, true>(lds, g, S, E);
    }
    SEAM(1);
    if (IN(2)) REPS(2) {
        float a = lq1[lane] * lk1[lane], b2 = lq2[lane] * lk2[lane];
        a = wave_sum(a); b2 = wave_sum(b2);
        const float lam = expf(a) - expf(b2) + 0.2f;
        const float mq = wave_max(fabsf(qg[lane])), mk = wave_max(fabsf(kg[lane]));
        const float M2 = 64.f * C2 * mq * mk;
#if DBG_NAIVE_ATTN
        for (int r = gw; r < NB * NH * SEQ; r += NGW) naive_attn_row(r >> 14, (r >> 11) & 7, r & 2047, Qb, Kb, Vb, MIX, subg, lam, (LAS float*)(lds + wave * 16384), lane);
        if (0)
#endif
        if (!(dbg_flags & 2))
        for (int v = vcu; v < NB * NH * 4; v += G) {
            const int bh = v >> 2, s = v & 3, b = bh >> 3, h = bh & 7;
#pragma unroll 1
            for (int i = 0; i < 4; ++i) { const int qblk = (i == 0) ? s : (i == 1) ? 7 - s : (i == 2) ? 8 + s : 15 - s;
                att::attn_unit(b, h, qblk, Qb, Kb, Vb, MIX, subg, lam, M2, (LAS char*)lds); }
        }
        if (!(dbg_flags & 1))
        for (size_t it = gtid; it < (size_t)(T / 16) * 128; it += nthr) {
            const int cg8 = (int)(it & 127), chunk = (int)(it >> 7), t0 = chunk * 16, col = cg8 * 8;
            f32x4 w0a = *(const f32x4*)(conv_w + col), w0b = *(const f32x4*)(conv_w + col + 4), w1a = *(const f32x4*)(conv_w + 1024 + col), w1b = *(const f32x4*)(conv_w + 1024 + col + 4),
                  w2a = *(const f32x4*)(conv_w + 2048 + col), w2b = *(const f32x4*)(conv_w + 2048 + col + 4);
            float u1[8], u2[8];
#pragma unroll
            for (int i = 0; i < 8; ++i) { u1[i] = 0.f; u2[i] = 0.f; }
            if ((t0 % SEQ) != 0) {
                const v4u c1 = *(const v4u*)(CC + (size_t)(t0 - 1) * 1024 + col), x1v = *(const v4u*)(CX + (size_t)(t0 - 1) * 1024 + col), c2 = *(const v4u*)(CC + (size_t)(t0 - 2) * 1024 + col), x2v = *(const v4u*)(CX + (size_t)(t0 - 2) * 1024 + col);
                u1[0] = bflo(c1.x) * bflo(x1v.x); u1[1] = bfhi(c1.x) * bfhi(x1v.x); u1[2] = bflo(c1.y) * bflo(x1v.y); u1[3] = bfhi(c1.y) * bfhi(x1v.y); u1[4] = bflo(c1.z) * bflo(x1v.z); u1[5] = bfhi(c1.z) * bfhi(x1v.z); u1[6] = bflo(c1.w) * bflo(x1v.w); u1[7] = bfhi(c1.w) * bfhi(x1v.w);
                u2[0] = bflo(c2.x) * bflo(x2v.x); u2[1] = bfhi(c2.x) * bfhi(x2v.x); u2[2] = bflo(c2.y) * bflo(x2v.y); u2[3] = bfhi(c2.y) * bfhi(x2v.y); u2[4] = bflo(c2.z) * bflo(x2v.z); u2[5] = bfhi(c2.z) * bfhi(x2v.z); u2[6] = bflo(c2.w) * bflo(x2v.w); u2[7] = bfhi(c2.w) * bfhi(x2v.w);
            }
            const float w0[8] = {w0a.x, w0a.y, w0a.z, w0a.w, w0b.x, w0b.y, w0b.z, w0b.w}, w1[8] = {w1a.x, w1a.y, w1a.z, w1a.w, w1b.x, w1b.y, w1b.z, w1b.w}, w2[8] = {w2a.x, w2a.y, w2a.z, w2a.w, w2b.x, w2b.y, w2b.z, w2b.w};
#pragma unroll 4
            for (int j = 0; j < 16; ++j) { const size_t ro = (size_t)(t0 + j) * 1024 + col;
                const v4u bv = *(const v4u*)(CB + ro), cv = *(const v4u*)(CC + ro), xv = *(const v4u*)(CX + ro);
                float u0[8], bb[8], y[8];
                u0[0] = bflo(cv.x) * bflo(xv.x); u0[1] = bfhi(cv.x) * bfhi(xv.x); u0[2] = bflo(cv.y) * bflo(xv.y); u0[3] = bfhi(cv.y) * bfhi(xv.y); u0[4] = bflo(cv.z) * bflo(xv.z); u0[5] = bfhi(cv.z) * bfhi(xv.z); u0[6] = bflo(cv.w) * bflo(xv.w); u0[7] = bfhi(cv.w) * bfhi(xv.w);
                bb[0] = bflo(bv.x); bb[1] = bfhi(bv.x); bb[2] = bflo(bv.y); bb[3] = bfhi(bv.y); bb[4] = bflo(bv.z); bb[5] = bfhi(bv.z); bb[6] = bflo(bv.w); bb[7] = bfhi(bv.w);
#pragma unroll
                for (int i = 0; i < 8; ++i) { y[i] = bb[i] * (u2[i] * w0[i] + u1[i] * w1[i] + u0[i] * w2[i]); u2[i] = u1[i]; u1[i] = u0[i]; }
                v4u o; o.x = pk2(y[0], y[1]); o.y = pk2(y[2], y[3]); o.z = pk2(y[4], y[5]); o.w = pk2(y[6], y[7]);
                *(v4u*)(MIX + (size_t)(t0 + j) * 2048 + 1024 + col) = o; }
        }
    }
    SEAM(2);
    if (IN(3)) REPS(3) {
        pg8::Gemm g{MIX, WtOut, T, DM, DM}; pg8::StaticOrder S; S.init(T, DM, G, bx);
        pg8::EpiX1 E{x, out, A2, ffn_g, SSQ, ws + WS_H8};
        pg8::gemm_phase<pg8::EpiX1, pg8::StaticOrder, true, true>(lds, g, S, E);
    }
    SEAM(3);
    if (IN(4)) REPS(4) {
        pg8::Gemm g{A2, WtQ, T, DM, DM}; pg8::StaticOrder S; S.init(T, DM, G, bx);
        pg8::EpiBf16<0> E{QP, DM, nullptr, 0, 0, 1.f};
        pg8::gemm_phase<pg8::EpiBf16<0>, pg8::StaticOrder, true, true>(lds, g, S, E);
    }
    SEAM(4);
    if (IN(5)) REPS(5) {
        if (tid < 64) {
            int n = tid, i = 0;
#pragma unroll 1
            for (; i < 16; ++i) { const int len = 16 / (i + 1); if (n < len) break; n -= len; }
            ((LAS unsigned char*)(lds + P5_TAB_OFF))[tid] = (unsigned char)(i < 16 ? ((i << 4) | n) : 0);
        }
        int cur_h = -1;
        for (int it = vcu; it < (T / 128) * PEH; it += G) { const int h = it & 7;
            if (h != cur_h) {
                __syncthreads();
                for (int i = tid; i < 4096; i += NTHREADS) { const int ch = i & 15, key = (i >> 4) & 127, c = i >> 11;
                    *(LAS v4u*)(lds + c * 32768 + ch * 2048 + key * 16) = *(const v4u*)(SK + (size_t)((h * 2 + c) * 128 + key) * 128 + ch * 8); }
                cur_h = h; __syncthreads(); }
            peer_topk_item(it >> 3, h, QP, SSQ, EIDX, EGATE, RSTD, (LAS char*)lds); }
    }
    SEAM(5);
    if (IN(6)) {
        float* PART = (float*)(ws + WS_PART);
        const int tstride = (G >> 3) * NWAVES, nper = (T + tstride - 1) / tstride;
        peer_u_stage(nper, (bx >> 3) * NWAVES + wave, tstride, bx & 7, ws + WS_H8, U8, EIDX, PART, lane);
    }
    SEAM(6);
    if (IN(7)) {
        const float* PART = (const float*)(ws + WS_PART); unsigned* ACTQ = (unsigned*)(ws + WS_ACT); float* ASC = (float*)(ws + WS_ACT + 4 * MiB);
        const float ustep = RSTD[T] * (1.0f / H8_SCALE), vstep = RSTD[T + 1];
        for (int tp = gw; tp < T / 2; tp += NGW) { const int t = 2 * tp + (lane >> 5), k4 = 4 * (lane & 31);
            f32x4 z = (f32x4){0.f, 0.f, 0.f, 0.f};
#pragma unroll
            for (int s = 0; s < 8; ++s) z += *(const f32x4*)(PART + ((size_t)s * T + t) * 128 + k4);
            z *= RSTD[t] * ustep;
            const f32x4 gt = *(const f32x4*)(EGATE + (size_t)t * 128 + k4);
            f32x4 a; float am = 0.f;
#pragma unroll
            for (int i = 0; i < 4; ++i) { a[i] = 0.5f * z[i] * (1.0f + erff(z[i] * 0.70710678118654752f)) * gt[i]; am = fmaxf(am, fabsf(a[i])); }
#pragma unroll
            for (int o = 1; o < 32; o <<= 1) am = fmaxf(am, __shfl_xor(am, o));
            const float asc = am > 0.f ? am * (1.0f / 127.0f) : 1.0f, inv = 1.0f / asc; unsigned w = 0u;
#pragma unroll
            for (int i = 0; i < 4; ++i) { const int q = (int)__builtin_rintf(a[i] * inv); w |= ((unsigned)q & 0xffu) << (8 * i); }
            ACTQ[(size_t)t * 32 + (lane & 31)] = w;
            if ((lane & 31) == 0) ASC[t] = asc * vstep; }
    }
    SEAM(7);
    if (IN(8)) {
        const unsigned* ACTQ = (const unsigned*)(ws + WS_ACT); const float* ASC = (const float*)(ws + WS_ACT + 4 * MiB);
        const int tstride = (G >> 3) * NWAVES, nper = (T + tstride - 1) / tstride;
        peer_v_stage(nper, (bx >> 3) * NWAVES + wave, tstride, bx & 7, V8, EIDX, ACTQ, ASC, A2, ffn_g, out, lane);
    }
#undef IN
#undef SEAM
}

extern "C" void kernel_launch(void* const* d_in, const int* in_sizes, int n_in, void* d_out, int out_size, void* d_ws, size_t ws_size, hipStream_t stream) {
    static int grid = 0;
    if (grid == 0) {
        if (n_in != 17 || out_size != T * DM || ws_size < WS_END) { fprintf(stderr, "kernel_launch: unexpected shapes (n_in %d out %d ws %zu)\n", n_in, out_size, ws_size); grid = -1; return; }
        int dev = 0, cus = 0, per_cu = 0;
        if (hipGetDevice(&dev) != hipSuccess || hipDeviceGetAttribute(&cus, hipDeviceAttributeMultiprocessorCount, dev) != hipSuccess) { grid = -1; return; }
        if (hipFuncSetAttribute((const void*)mk_fwd, hipFuncAttributeMaxDynamicSharedMemorySize, LDS_BYTES) != hipSuccess) { fprintf(stderr, "kernel_launch: hipFuncSetAttribute failed\n"); grid = -1; return; }
        if (hipOccupancyMaxActiveBlocksPerMultiprocessor(&per_cu, (const void*)mk_fwd, NTHREADS, LDS_BYTES) != hipSuccess || per_cu < 1) { fprintf(stderr, "kernel_launch: occupancy query says %d blocks per CU\n", per_cu); (void)hipGetLastError(); grid = -1; return; }
        grid = cus;
    }
    if (grid < 0) return;
    if (hipMemsetAsync((char*)d_ws + WS_CTL, 0, CTL_ZERO_BYTES, stream) != hipSuccess) { fprintf(stderr, "kernel_launch: memset failed\n"); return; }
    Args a{};
    for (int i = 0; i < 17; ++i) a.in[i] = (const float*)d_in[i];
    a.out = (float*)d_out; a.ws = (unsigned char*)d_ws;
#if MK_N_LAUNCHES == 1
    a.ph_lo = 0; a.ph_hi = NPHASE;
    void* kargs[] = {&a};
    hipError_t e = hipLaunchCooperativeKernel((const void*)mk_fwd, dim3(grid), dim3(NTHREADS), kargs, LDS_BYTES, stream);
    if (e != hipSuccess) fprintf(stderr, "kernel_launch: cooperative launch failed: %s (grid %d)\n", hipGetErrorString(e), grid);
#else
#ifndef DBG_DUPL
#define DBG_DUPL -1
#endif
#ifndef DBG_DUPFLAGS
#define DBG_DUPFLAGS 0
#endif
    for (int p = 0; p < NPHASE; ++p) { a.ph_lo = p; for (int r = 0; r < (p == DBG_DUPL ? 2 : 1); ++r) { a.ph_hi = (p + 1) | ((r == 1 ? DBG_DUPFLAGS : 0) << 8); hipLaunchKernelGGL(mk_fwd, dim3(grid), dim3(NTHREADS), LDS_BYTES, stream, a); } }
#endif
}
```

```cpp
#include <hip/hip_runtime.h>
#include <hip/hip_cooperative_groups.h>
#include <cstdio>
#include <cstdint>
#include <cmath>
namespace cg = cooperative_groups;
namespace pg8 {
#define PG8_LAS __attribute__((address_space(3)))
typedef unsigned short bf16_t;
typedef short bf16x8 __attribute__((ext_vector_type(8)));
typedef float f32x4 __attribute__((ext_vector_type(4)));
typedef unsigned u32x4 __attribute__((ext_vector_type(4)));
constexpr int BM = 256, BK = 64, HALF = 128, HTB = HALF * BK * 2  , STAGE_BYTES = 8 * HTB, NXCD = 8, WGM = 8;

__host__ __device__ __forceinline__ int lds_byte(int r, int c) { const int st = (r >> 4) * 2 + (c >> 5), rr = r & 15, cc = c & 31, ob = rr * 64 + cc * 2; return st * 1024 + (ob ^ (((ob >> 9) & 1) << 5)); }
__host__ __device__ __forceinline__ void stage_rc(int b, int& R, int& C) { const int st = b / 1024, sb = b % 1024, swz = sb ^ (((sb >> 9) & 1) << 5); R = (st >> 1) * 16 + swz / 64; C = (st & 1) * 32 + (swz % 64) / 2; }
__host__ __device__ __forceinline__ int perm32(int rho) { const int n = rho >> 4, i = rho & 15; return 8 * (i >> 2) + 4 * n + (i & 3); }

struct Unit { int pm, pn; };
struct Gemm { const bf16_t* A; const bf16_t* Bt; int M, N, K; };

struct StaticOrder {
    int nM, nN, nwg, G, c;
    __host__ __device__ void init(int M, int N, int G_, int c_) { nM = M / BM; nN = N / BM; nwg = nM * nN; G = G_; c = c_; }
    __host__ __device__ bool next(int i, Unit& u) const {
        const long L = (long)i * G + c; if (L >= nwg) return false;
        int wgid = (int)L; { const int q = nwg / NXCD, r = nwg % NXCD, xcd = wgid % NXCD, off = wgid / NXCD; wgid = (xcd < r ? xcd * (q + 1) : r * (q + 1) + (xcd - r) * q) + off; }
        const int nig = WGM * nN, gid = wgid / nig, fm = gid * WGM, gsz = (nM - fm) < WGM ? (nM - fm) : WGM;
        u.pm = fm + ((wgid % nig) % gsz); u.pn = (wgid % nig) / gsz; return true;
    }
    __device__ __forceinline__ void a_ready(const Unit&) const {}
    __device__ __forceinline__ void done(const Unit&) const {}
};

__device__ __forceinline__ unsigned cvt_pk_bf16(float lo, float hi) { unsigned r; asm volatile("v_cvt_pk_bf16_f32 %0, %1, %2" : "=v"(r) : "v"(lo), "v"(hi)); return r; }
typedef float f32x2 __attribute__((ext_vector_type(2)));
__device__ __forceinline__ f32x2 gelu_pk(f32x2 v) {
    const f32x2 av = __builtin_elementwise_abs(v), d = av * 0.2316418882f + 1.0f;
    f32x2 t; t.x = __builtin_amdgcn_rcpf(d.x); t.y = __builtin_amdgcn_rcpf(d.y);
    f32x2 q = t * 0.5307027145f + (-0.7265760135f); q = q * t + 0.7107068705f; q = q * t + (-0.142248368f); q = q * t + 0.127414796f; q = q * t;
    const f32x2 s = (v * v) * (-0.72134752044f);
    f32x2 e; e.x = __builtin_amdgcn_exp2f(s.x); e.y = __builtin_amdgcn_exp2f(s.y);
    const f32x2 m = v * (q * e), r = v - m;
    f32x2 o; o.x = v.x < 0.f ? m.x : r.x; o.y = v.y < 0.f ? m.y : r.y; return o;
}

template <int ACT  > struct EpiBf16 {
    static constexpr bool PERM = true, AFTER_DRAIN = false; static_assert(ACT == 0 || ACT == 1, "EpiBf16: ACT is 0 (none) or 1 (gelu_pk)");
    bf16_t* O; int ldc; const float* bias; int split_cols; size_t split_stride; float scale0;
    __device__ __forceinline__ void operator()(const f32x4 (&acc)[2][2][4][2], const Unit& u, int wr, int wc, int fr, int fq) const {
        const int row0 = u.pm * BM + wr * 64 + fr; int colt = u.pn * BM; bf16_t* base = O;
        float sc = 1.f; if (split_cols) { const int t = colt / split_cols; base += (size_t)t * split_stride; colt -= t * split_cols; if (t == 0) sc = scale0; }
        const int col0 = colt + wc * 32 + 8 * fq, bcol0 = u.pn * BM + wc * 32 + 8 * fq;
        f32x4 bv[2][2];
#pragma unroll
        for (int bj = 0; bj < 2; ++bj)
#pragma unroll
            for (int n = 0; n < 2; ++n) bv[bj][n] = bias ? *(const f32x4*)(bias + bcol0 + bj * HALF + 4 * n) : (f32x4){0.f, 0.f, 0.f, 0.f};
#pragma unroll
        for (int ai = 0; ai < 2; ++ai)
#pragma unroll
            for (int m = 0; m < 4; ++m) { bf16_t* rowp = base + (size_t)(row0 + ai * HALF + m * 16) * ldc + col0;
#pragma unroll
                for (int bj = 0; bj < 2; ++bj) { f32x4 v0 = acc[ai][bj][m][0] + bv[bj][0], v1 = acc[ai][bj][m][1] + bv[bj][1];
                    if (ACT == 1) { f32x2 a = gelu_pk((f32x2){v0[0], v0[1]}), b = gelu_pk((f32x2){v0[2], v0[3]}), c = gelu_pk((f32x2){v1[0], v1[1]}), d = gelu_pk((f32x2){v1[2], v1[3]});
                        v0 = (f32x4){a.x, a.y, b.x, b.y}; v1 = (f32x4){c.x, c.y, d.x, d.y}; }
                    v0 = v0 * sc; v1 = v1 * sc; u32x4 w; w.x = cvt_pk_bf16(v0[0], v0[1]); w.y = cvt_pk_bf16(v0[2], v0[3]); w.z = cvt_pk_bf16(v1[0], v1[1]); w.w = cvt_pk_bf16(v1[2], v1[3]);
                    *(u32x4*)(rowp + bj * HALF) = w; } }
    }
};
template <class Epi, class Sched, bool ALIGN_EPI = false, bool SP2 = false>
__device__ __forceinline__ void gemm_phase(PG8_LAS unsigned char* lds, const Gemm g, const Sched& S, const Epi& E) {
    const int tid = threadIdx.x, wid = __builtin_amdgcn_readfirstlane(tid >> 6), lane = tid & 63, wr = wid >> 2, wc = wid & 3, fr = lane & 15, fq = lane >> 4;
    const int K = g.K, nt = K / BK;
    unsigned voffA[2], voffB[2];
#pragma unroll
    for (int i = 0; i < 2; ++i) { int R, C; stage_rc(tid * 16 + i * 8192, R, C); const int Rb = Epi::PERM ? ((R & ~31) + perm32(R & 31)) : R;
        voffA[i] = (unsigned)(R * K + C) * 2u; voffB[i] = (unsigned)(Rb * K + C) * 2u; }
    const size_t kstep = (size_t)(BK * 2);
    const size_t hstep = (size_t)HALF * K * 2;
    const size_t tstep = 2 * hstep;
    const unsigned ldsw = (unsigned)wid * 1024u;
    const int aoff = lds_byte(wr * 64 + fr, fq * 8), boff = lds_byte(wc * 32 + fr, fq * 8);
#define PG8_SA(b, h) (((b) * 2 + (h)) * HTB)
#define PG8_SB(b, h) ((4 + (b) * 2 + (h)) * HTB)
#define PG8_STAGE(bufoff, gbase, voff) do { _Pragma("unroll") for (int _i = 0; _i < 2; ++_i) \
        __builtin_amdgcn_global_load_lds((const unsigned*)((const char*)(gbase) + (voff)[_i]), (PG8_LAS unsigned*)(lds + (bufoff) + ldsw + _i * 8192), 16, 0, 0); } while (0)
#define PG8_LDA(dst, b, h) do { _Pragma("unroll") for (int m = 0; m < 4; ++m) _Pragma("unroll") for (int k = 0; k < 2; ++k) dst[m][k] = *(const PG8_LAS bf16x8*)(lds + PG8_SA(b, h) + aoff + m * 2048 + k * 1024); } while (0)
#define PG8_LDB(dst, b, h) do { _Pragma("unroll") for (int n = 0; n < 2; ++n) _Pragma("unroll") for (int k = 0; k < 2; ++k) dst[n][k] = *(const PG8_LAS bf16x8*)(lds + PG8_SB(b, h) + boff + n * 2048 + k * 1024); } while (0)
#define PG8_MMA(ai, bj, At, Bt) do { __builtin_amdgcn_s_setprio(1); _Pragma("unroll") for (int m = 0; m < 4; ++m) _Pragma("unroll") for (int n = 0; n < 2; ++n) _Pragma("unroll") for (int k = 0; k < 2; ++k) \
        acc[ai][bj][m][n] = __builtin_amdgcn_mfma_f32_16x16x32_bf16(Bt[n][k], At[m][k], acc[ai][bj][m][n], 0, 0, 0); __builtin_amdgcn_s_setprio(0); } while (0)
#define PG8_WAIT_V(n) asm volatile("s_waitcnt vmcnt(" #n ")" ::: "memory")
#define PG8_WAIT_L(n) asm volatile("s_waitcnt lgkmcnt(" #n ")" ::: "memory")
#define PG8_BAR __builtin_amdgcn_s_barrier()
#define PG8_SCHED __builtin_amdgcn_sched_barrier(0)
    Unit cur, nxt; int ui = 0;
    if (!S.next(0, cur)) return;
    f32x4 acc[2][2][4][2];
#pragma unroll
    for (int a = 0; a < 2; ++a)
#pragma unroll
        for (int b = 0; b < 2; ++b)
#pragma unroll
            for (int m = 0; m < 4; ++m)
#pragma unroll
                for (int n = 0; n < 2; ++n) acc[a][b][m][n] = (f32x4){0.f, 0.f, 0.f, 0.f};
    bf16x8 At[4][2], B0[2][2], B1[2][2];
    const char* cA = (const char*)g.A + (size_t)cur.pm * tstep; const char* cB = (const char*)g.Bt + (size_t)cur.pn * tstep;
    S.a_ready(cur);
    if constexpr (SP2) {
        PG8_STAGE(PG8_SB(0, 0), cB, voffB); PG8_STAGE(PG8_SB(0, 1), cB + hstep, voffB); PG8_STAGE(PG8_SA(0, 0), cA, voffA); PG8_STAGE(PG8_SA(0, 1), cA + hstep, voffA);
        if (wr == 1) PG8_BAR;
        PG8_WAIT_V(2); PG8_BAR;
        PG8_STAGE(PG8_SB(1, 0), cB + kstep, voffB); PG8_STAGE(PG8_SA(1, 0), cA + kstep, voffA); PG8_STAGE(PG8_SB(1, 1), cB + hstep + kstep, voffB);
        PG8_WAIT_V(6); PG8_BAR;
    } else {
        PG8_STAGE(PG8_SB(0, 0), cB, voffB); PG8_STAGE(PG8_SA(0, 0), cA, voffA); PG8_STAGE(PG8_SB(0, 1), cB + hstep, voffB); PG8_STAGE(PG8_SA(0, 1), cA + hstep, voffA);
        if (wr == 1) PG8_BAR;
        PG8_WAIT_V(4); PG8_BAR;
        PG8_STAGE(PG8_SB(1, 0), cB + kstep, voffB); PG8_STAGE(PG8_SA(1, 0), cA + kstep, voffA); PG8_STAGE(PG8_SB(1, 1), cB + hstep + kstep, voffB);
        PG8_WAIT_V(6); PG8_BAR;
    }
    for (;;) {
        const bool has_next = S.next(ui + 1, nxt);
        const char* nA = has_next ? (const char*)g.A + (size_t)nxt.pm * tstep : cA; const char* nB = has_next ? (const char*)g.Bt + (size_t)nxt.pn * tstep : cB;
        for (int t = 0; t < nt; t += 2) {
            const bool last = (t == nt - 2);
            const char* a1 = cA + (size_t)(t + 1) * kstep;
            const char* a2 = last ? nA : cA + (size_t)(t + 2) * kstep; const char* b2 = last ? nB : cB + (size_t)(t + 2) * kstep;
            const char* a3 = a2 + kstep; const char* b3 = b2 + kstep;
            if (last && has_next) S.a_ready(nxt);
            if constexpr (SP2) {
            PG8_LDB(B0, 0, 0); PG8_LDB(B1, 0, 1); PG8_SCHED; PG8_LDA(At, 0, 0); PG8_STAGE(PG8_SA(1, 1), a1 + hstep, voffA);
            PG8_WAIT_V(8); PG8_WAIT_L(0); PG8_BAR; PG8_MMA(0, 0, At, B0); PG8_MMA(0, 1, At, B1); PG8_BAR; PG8_SCHED;
            PG8_LDA(At, 0, 1); PG8_STAGE(PG8_SB(0, 0), b2, voffB); PG8_STAGE(PG8_SB(0, 1), b2 + hstep, voffB); PG8_STAGE(PG8_SA(0, 0), a2, voffA);
            PG8_WAIT_V(8); PG8_WAIT_L(0); PG8_BAR; PG8_MMA(1, 0, At, B0); PG8_MMA(1, 1, At, B1); PG8_BAR; PG8_SCHED;
            PG8_LDB(B0, 1, 0); PG8_LDB(B1, 1, 1); PG8_SCHED; PG8_LDA(At, 1, 0); PG8_STAGE(PG8_SA(0, 1), a2 + hstep, voffA);
            PG8_WAIT_V(8); PG8_WAIT_L(0); PG8_BAR; PG8_MMA(0, 0, At, B0); PG8_MMA(0, 1, At, B1); PG8_BAR; PG8_SCHED;
            PG8_LDA(At, 1, 1); PG8_STAGE(PG8_SB(1, 0), b3, voffB); PG8_STAGE(PG8_SB(1, 1), b3 + hstep, voffB); PG8_STAGE(PG8_SA(1, 0), a3, voffA);
            PG8_WAIT_V(8); PG8_WAIT_L(0); PG8_BAR; PG8_MMA(1, 0, At, B0); PG8_MMA(1, 1, At, B1); PG8_BAR; PG8_SCHED;
            } else {
            PG8_LDB(B0, 0, 0); PG8_SCHED; PG8_LDA(At, 0, 0); PG8_STAGE(PG8_SA(1, 1), a1 + hstep, voffA);
            PG8_WAIT_L(8); PG8_BAR; PG8_WAIT_L(0); PG8_MMA(0, 0, At, B0); PG8_BAR; PG8_SCHED;
            PG8_LDB(B1, 0, 1); PG8_STAGE(PG8_SB(0, 0), b2, voffB);
            PG8_BAR; PG8_WAIT_L(0); PG8_MMA(0, 1, At, B1); PG8_BAR;
            PG8_LDA(At, 0, 1); PG8_STAGE(PG8_SA(0, 0), a2, voffA);
            PG8_BAR; PG8_WAIT_L(0); PG8_MMA(1, 0, At, B0); PG8_BAR; PG8_SCHED;
            PG8_STAGE(PG8_SB(0, 1), b2 + hstep, voffB);
            PG8_WAIT_V(6); PG8_BAR; PG8_MMA(1, 1, At, B1); PG8_BAR;
            PG8_LDB(B0, 1, 0); PG8_SCHED; PG8_LDA(At, 1, 0); PG8_STAGE(PG8_SA(0, 1), a2 + hstep, voffA);
            PG8_WAIT_L(8); PG8_BAR; PG8_WAIT_L(0); PG8_MMA(0, 0, At, B0); PG8_BAR; PG8_SCHED;
            PG8_LDB(B1, 1, 1); PG8_STAGE(PG8_SB(1, 0), b3, voffB);
            PG8_BAR; PG8_WAIT_L(0); PG8_MMA(0, 1, At, B1); PG8_BAR;
            PG8_LDA(At, 1, 1); PG8_STAGE(PG8_SA(1, 0), a3, voffA);
            PG8_BAR; PG8_WAIT_L(0); PG8_MMA(1, 0, At, B0); PG8_BAR; PG8_SCHED;
            PG8_STAGE(PG8_SB(1, 1), b3 + hstep, voffB);
            PG8_WAIT_V(6); PG8_BAR; PG8_MMA(1, 1, At, B1); PG8_BAR;
            }
        }
        if constexpr (ALIGN_EPI) { if (wr == 0) PG8_BAR; }
        if constexpr (!Epi::AFTER_DRAIN) { E(acc, cur, wr, wc, fr, fq); S.done(cur); }
        if (!has_next) break;
#pragma unroll
        for (int a = 0; a < 2; ++a)
#pragma unroll
            for (int b = 0; b < 2; ++b)
#pragma unroll
                for (int m = 0; m < 4; ++m)
#pragma unroll
                    for (int n = 0; n < 2; ++n) acc[a][b][m][n] = (f32x4){0.f, 0.f, 0.f, 0.f};
        cur = nxt; cA = nA; cB = nB; ++ui;
        if constexpr (ALIGN_EPI) { if (wr == 1) PG8_BAR; }
    }
    PG8_WAIT_V(0);
    if constexpr (!ALIGN_EPI) { if (wr == 0) PG8_BAR; }
    PG8_BAR;
    if constexpr (Epi::AFTER_DRAIN) { E.fused(acc, cur, wr, wc, fr, fq, lds, wid, lane); S.done(cur); }
#undef PG8_SA
#undef PG8_SB
#undef PG8_STAGE
#undef PG8_LDA
#undef PG8_LDB
#undef PG8_MMA
#undef PG8_WAIT_V
#undef PG8_WAIT_L
#undef PG8_BAR
#undef PG8_SCHED
}
}
#define MK_N_LAUNCHES 1
#ifndef MK_N_LAUNCHES
#define MK_N_LAUNCHES 1
#endif
constexpr int DM = 2048, NB = 8, SEQ = 2048, T = NB * SEQ;
constexpr int AW = 1024, NH = 8, HD = 64, VD = 128, INC = 6144;
constexpr int PNK = 128, PTOPK = 16, PEH = 8, EPT = PEH * PTOPK;
constexpr float EPS = 1e-6f;
constexpr float C2 = 0.125f * 1.4426950408889634f;
constexpr int NPHASE = 9;
constexpr float U8_SCALE = 1024.f, V8_SCALE = 16.f, H8_SCALE = 16.f;
constexpr size_t MiB = 1u << 20;
constexpr size_t WS_WIN = 1 * MiB, WS_WOUT = 25 * MiB, WS_WQ = 33 * MiB, WS_SK = 41 * MiB, WS_SSQ = 42 * MiB, WS_EIDX = 44 * MiB, WS_EGATE = 52 * MiB, WS_RSTD = 60 * MiB;
constexpr size_t WS_XN = 64 * MiB;
constexpr size_t WS_Q = 128 * MiB, WS_K = 160 * MiB, WS_V = 192 * MiB;
constexpr size_t WS_CB = 224 * MiB, WS_CC = 256 * MiB, WS_CX = 288 * MiB;
constexpr size_t WS_UT = 320 * MiB, WS_VT = 384 * MiB, WS_END = 448 * MiB;
constexpr size_t WS_CTL = 0; constexpr int CW_BAR = 1024, CTL_ZERO_BYTES = 65536;
constexpr size_t WS_H8 = 288 * MiB;
constexpr size_t WS_PART = 64 * MiB, WS_ACT = 192 * MiB;
constexpr int MISC_OFF = 143360;
constexpr int LDS_BYTES = 147456;
constexpr int NWAVES = 8, NTHREADS = 512;

#define LAS __attribute__((address_space(3)))
typedef unsigned short bf16;
typedef unsigned v4u __attribute__((ext_vector_type(4)));
typedef unsigned v2u __attribute__((ext_vector_type(2)));
typedef float f32x4 __attribute__((ext_vector_type(4)));
typedef float f32x2 __attribute__((ext_vector_type(2)));
typedef float f32x16 __attribute__((ext_vector_type(16)));
typedef short bf16x8 __attribute__((ext_vector_type(8)));
typedef short s16x4 __attribute__((ext_vector_type(4)));
typedef __bf16 bf16x2_t __attribute__((ext_vector_type(2)));
#define LDS_WAIT() asm volatile("s_waitcnt lgkmcnt(0)" ::: "memory")
__device__ __forceinline__ unsigned pk2(float lo, float hi) { f32x2 v = {lo, hi}; bf16x2_t b = __builtin_convertvector(v, bf16x2_t); return __builtin_bit_cast(unsigned, b); }
__device__ __forceinline__ float bflo(unsigned u) { return __uint_as_float(u << 16); }
__device__ __forceinline__ float bfhi(unsigned u) { return __uint_as_float(u & 0xffff0000u); }
__device__ __forceinline__ float wave_sum(float v) {
#pragma unroll
    for (int o = 1; o < 64; o <<= 1) v += __shfl_xor(v, o);
    return v;
}
__device__ __forceinline__ float wave_max(float v) {
#pragma unroll
    for (int o = 1; o < 64; o <<= 1) v = fmaxf(v, __shfl_xor(v, o));
    return v;
}

#define XB_TMO      128
#define XB_XCNT(j)  (256  + 64 * (j))
#define XB_XSUB(j)  (1280 + 64 * (j))
#define XB_XGEN(j)  (2304 + 64 * (j))
#define XB_TOP      3328
#define XB_TOPGEN   3392
#define XCD_BAR_WORDS 3456
#define XB_SPIN_CAP (1u << 18)

__device__ __forceinline__ unsigned xb_ld(unsigned* p)              { return __hip_atomic_load(p, __ATOMIC_RELAXED, __HIP_MEMORY_SCOPE_AGENT); }
__device__ __forceinline__ unsigned xb_add(unsigned* p, unsigned v) { return __hip_atomic_fetch_add(p, v, __ATOMIC_RELAXED, __HIP_MEMORY_SCOPE_AGENT); }
__device__ __forceinline__ unsigned xb_xcc_id() { return (unsigned)__builtin_amdgcn_s_getreg((3 << 11) | 20) & 0xFu; }
#define XB_SPIN(cond, bar) do { unsigned _sp = 0; while (cond) { __builtin_amdgcn_s_sleep(1); \
    if ((++_sp & 255u) == 0u) { if (xb_ld(&(bar)[XB_TMO])) break; if (_sp > XB_SPIN_CAP) { atomicAdd(&(bar)[XB_TMO], 1u); break; } } } } while (0)

struct XcdBarrier {
    unsigned* bar; unsigned x;
    volatile LAS unsigned* st;
};

__device__ __forceinline__ XcdBarrier xcd_barrier_post(unsigned* bar, volatile LAS unsigned* st) {
    XcdBarrier b; b.bar = bar; b.x = xb_xcc_id(); b.st = st;
    if (threadIdx.x == 0) (void)xb_add(&bar[XB_XCNT(b.x)], 1u);
    return b;
}
__device__ __forceinline__ void xcd_barrier_complete(unsigned* bar, unsigned x, unsigned& nloc, unsigned& nx) {
    const unsigned G = gridDim.x * gridDim.y * gridDim.z;
    unsigned sum, cnt, mine, sp = 0u;
    for (;;) {
        sum = 0u; cnt = 0u; mine = 0u;
#pragma unroll
        for (unsigned j = 0; j < 16; ++j) { const unsigned c = xb_ld(&bar[XB_XCNT(j)]); sum += c; cnt += (c > 0u) ? 1u : 0u; mine = (j == x) ? c : mine; }
        if (sum == G) break;
        __builtin_amdgcn_s_sleep(1);
        if ((++sp & 255u) == 0u) { if (xb_ld(&bar[XB_TMO])) break; if (sp > XB_SPIN_CAP) { atomicAdd(&bar[XB_TMO], 1u); break; } }
    }
    nloc = mine > 0u ? mine : 1u; nx = cnt > 0u ? cnt : 1u;
}

__device__ __forceinline__ void xcd_barrier(const XcdBarrier& b) {
    asm volatile("s_waitcnt vmcnt(0)" ::: "memory");
    __syncthreads();
    if (threadIdx.x == 0) {
        unsigned* bar = b.bar;
        __builtin_amdgcn_s_waitcnt(0);
        unsigned nloc = b.st[0], nx = b.st[1];
        if (nloc == 0u) { xcd_barrier_complete(bar, b.x, nloc, nx); b.st[0] = nloc; b.st[1] = nx; }
        const unsigned old = xb_add(&bar[XB_XSUB(b.x)], 1u);
        const unsigned gen = old / nloc;
        if (old + 1u == (gen + 1u) * nloc) {
            __builtin_amdgcn_fence(__ATOMIC_RELEASE, "agent");
            asm volatile("s_waitcnt vmcnt(0)" ::: "memory");
            const unsigned og = xb_add(&bar[XB_TOP], 1u);
            const unsigned tg = og / nx;
            if (og + 1u == (tg + 1u) * nx) xb_add(&bar[XB_TOPGEN], 1u);
            else XB_SPIN(xb_ld(&bar[XB_TOPGEN]) == tg, bar);
            __builtin_amdgcn_fence(__ATOMIC_ACQUIRE, "agent");
            xb_add(&bar[XB_XGEN(b.x)], 1u);
            asm volatile("s_waitcnt vmcnt(0)" ::: "memory");
        } else {
            XB_SPIN(xb_ld(&bar[XB_XGEN(b.x)]) == gen, bar);
            __builtin_amdgcn_fence(__ATOMIC_ACQUIRE, "agent");
            asm volatile("s_waitcnt vmcnt(0)" ::: "memory");
        }
    }
    __syncthreads();
}


namespace pg8 {
struct EpiProj {
    static constexpr bool PERM = true, AFTER_DRAIN = false;
    bf16_t* base0; const float* qg; const float* kg;
    __device__ __forceinline__ void operator()(const f32x4 (&acc)[2][2][4][2], const Unit& u, int wr, int wc, int fr, int fq) const {
        const int region = u.pn >> 2;
        bf16_t* O = base0 + (size_t)region * (16u << 20);
        const int row0 = u.pm * BM + wr * 64 + fr, col0 = (u.pn & 3) * 256 + wc * 64 + 8 * fq;
        if (region < 2) {
            const float* g = region == 0 ? qg : kg; const float sc = region == 0 ? 0.125f * 1.4426950408889634f : 1.0f;
            f32x4 gv[2][2];
#pragma unroll
            for (int bj = 0; bj < 2; ++bj)
#pragma unroll
                for (int n = 0; n < 2; ++n) gv[bj][n] = *(const f32x4*)(g + bj * 32 + 8 * fq + 4 * n) * sc;
#pragma unroll
            for (int ai = 0; ai < 2; ++ai)
#pragma unroll
                for (int m = 0; m < 4; ++m) {
                    float ss = 0.f;
#pragma unroll
                    for (int bj = 0; bj < 2; ++bj)
#pragma unroll
                        for (int n = 0; n < 2; ++n) { const f32x4 x = acc[ai][bj][m][n]; ss += (x[0] * x[0] + x[1] * x[1]) + (x[2] * x[2] + x[3] * x[3]); }
                    ss += __shfl_xor(ss, 16); ss += __shfl_xor(ss, 32);
                    const float rs = __builtin_amdgcn_rsqf(ss * (1.0f / 64.0f) + 1e-6f);
                    bf16_t* rowp = O + (size_t)(row0 + ai * HALF + m * 16) * 1024 + col0;
#pragma unroll
                    for (int bj = 0; bj < 2; ++bj) { const f32x4 v0 = acc[ai][bj][m][0] * rs * gv[bj][0], v1 = acc[ai][bj][m][1] * rs * gv[bj][1];
                        u32x4 w; w.x = cvt_pk_bf16(v0[0], v0[1]); w.y = cvt_pk_bf16(v0[2], v0[3]); w.z = cvt_pk_bf16(v1[0], v1[1]); w.w = cvt_pk_bf16(v1[2], v1[3]);
                        *(u32x4*)(rowp + bj * 32) = w; }
                }
        } else {
#pragma unroll
            for (int ai = 0; ai < 2; ++ai)
#pragma unroll
                for (int m = 0; m < 4; ++m) { bf16_t* rowp = O + (size_t)(row0 + ai * HALF + m * 16) * 1024 + col0;
#pragma unroll
                    for (int bj = 0; bj < 2; ++bj) { const f32x4 v0 = acc[ai][bj][m][0], v1 = acc[ai][bj][m][1];
                        u32x4 w; w.x = cvt_pk_bf16(v0[0], v0[1]); w.y = cvt_pk_bf16(v0[2], v0[3]); w.z = cvt_pk_bf16(v1[0], v1[1]); w.w = cvt_pk_bf16(v1[2], v1[3]);
                        *(u32x4*)(rowp + bj * 32) = w; } }
        }
    }
};
struct EpiX1 {
    static constexpr bool PERM = true, AFTER_DRAIN = false;
    const float* x; float* out; bf16_t* a2; const float* gf; float* ssq; unsigned char* h8;
    __device__ __forceinline__ void operator()(const f32x4 (&acc)[2][2][4][2], const Unit& u, int wr, int wc, int fr, int fq) const {
        const int row0 = u.pm * BM + wr * 64 + fr, col0 = u.pn * BM + wc * 32 + 8 * fq;
        f32x4 gv[2][2];
#pragma unroll
        for (int bj = 0; bj < 2; ++bj)
#pragma unroll
            for (int n = 0; n < 2; ++n) gv[bj][n] = *(const f32x4*)(gf + col0 + bj * HALF + 4 * n);
#pragma unroll
        for (int ai = 0; ai < 2; ++ai)
#pragma unroll
            for (int m = 0; m < 4; ++m) { const int row = row0 + ai * HALF + m * 16; const size_t off = (size_t)row * 2048 + col0; float ss = 0.f;
#pragma unroll
                for (int bj = 0; bj < 2; ++bj) {
                    const f32x4 x0 = *(const f32x4*)(x + off + bj * HALF), x1 = *(const f32x4*)(x + off + bj * HALF + 4);
                    const f32x4 v0 = x0 + acc[ai][bj][m][0], v1 = x1 + acc[ai][bj][m][1];
                    ss += (v0[0] * v0[0] + v0[1] * v0[1]) + (v0[2] * v0[2] + v0[3] * v0[3]); ss += (v1[0] * v1[0] + v1[1] * v1[1]) + (v1[2] * v1[2] + v1[3] * v1[3]);
                    const f32x4 a0 = v0 * gv[bj][0], a1 = v1 * gv[bj][1];
                    u32x4 w; w.x = cvt_pk_bf16(a0[0], a0[1]); w.y = cvt_pk_bf16(a0[2], a0[3]); w.z = cvt_pk_bf16(a1[0], a1[1]); w.w = cvt_pk_bf16(a1[2], a1[3]);
                    *(u32x4*)(a2 + off + bj * HALF) = w;
                    { const f32x4 b0 = a0 * 16.0f, b1 = a1 * 16.0f; unsigned p = 0u, q2 = 0u;
#pragma unroll
                      for (int e_ = 0; e_ < 4; ++e_) { const int i0_ = __builtin_amdgcn_fmed3f(__builtin_rintf(b0[e_]), -127.f, 127.f), i1_ = __builtin_amdgcn_fmed3f(__builtin_rintf(b1[e_]), -127.f, 127.f);
                          p |= ((unsigned)i0_ & 0xffu) << (8 * e_); q2 |= ((unsigned)i1_ & 0xffu) << (8 * e_); }
                      typedef unsigned u32x2_ __attribute__((ext_vector_type(2))); *(u32x2_*)(h8 + off + bj * HALF) = (u32x2_){p, q2}; } }
                ss += __shfl_xor(ss, 16); ss += __shfl_xor(ss, 32);
                if (fq == 0) ssq[(size_t)row * 32 + u.pn * 4 + wc] = ss; }
    }
};
}

__device__ __forceinline__ void p0_transpose_item(const float* W, int K, int N, bf16* WT, LAS float* scr, int item, int lane, bool permg) {
    const int nblk = N / 32, kb = item / nblk, nb = item % nblk, k0 = 64 * kb, n0 = 32 * nb;
#pragma unroll 8
    for (int i = 0; i < 32; ++i) { const int kk = 2 * i + (lane >> 5); scr[kk * 33 + (lane & 31)] = W[(size_t)(k0 + kk) * N + n0 + (lane & 31)]; }
    LDS_WAIT(); asm volatile("" ::: "memory");
    int nd = n0; if (permg) { const int gl = (n0 & 255) >> 5; nd = (n0 & ~255) + 32 * (4 * (gl & 1) + (gl >> 1)); }
    const int c = lane & 7;
#pragma unroll
    for (int j = 0; j < 4; ++j) { const int n = (lane >> 3) + 8 * j; const LAS float* s = scr + (8 * c) * 33 + n;
        v4u o; o.x = pk2(s[0 * 33], s[1 * 33]); o.y = pk2(s[2 * 33], s[3 * 33]); o.z = pk2(s[4 * 33], s[5 * 33]); o.w = pk2(s[6 * 33], s[7 * 33]);
        *(v4u*)(WT + (size_t)(nd + n) * K + k0 + 8 * c) = o; }
    LDS_WAIT(); asm volatile("" ::: "memory");
}
__device__ __forceinline__ void rms_row_to_bf16(const float* xrow, const float* g, bf16* orow, int lane) {
    const f32x4* xr = (const f32x4*)xrow + lane; const f32x4* gr = (const f32x4*)g + lane;
    f32x4 v[8]; float s = 0.f;
#pragma unroll
    for (int j = 0; j < 8; ++j) { v[j] = xr[64 * j]; s += (v[j].x * v[j].x + v[j].y * v[j].y) + (v[j].z * v[j].z + v[j].w * v[j].w); }
    const float rstd = 1.0f / sqrtf(wave_sum(s) * (1.f / DM) + EPS);
    v2u* o8 = (v2u*)orow + lane;
#pragma unroll
    for (int j = 0; j < 8; ++j) { const f32x4 gg = gr[64 * j]; v2u w; w.x = pk2(v[j].x * rstd * gg.x, v[j].y * rstd * gg.y); w.y = pk2(v[j].z * rstd * gg.z, v[j].w * rstd * gg.w); o8[64 * j] = w; }
}
__device__ __forceinline__ void cvt_bf16_stream(const float* src, bf16* dst, size_t n8, size_t gtid, size_t nthr) {
    for (size_t i = gtid; i < n8; i += nthr) { const f32x4 a = *(const f32x4*)(src + i * 8), b = *(const f32x4*)(src + i * 8 + 4);
        v4u o; o.x = pk2(a.x, a.y); o.y = pk2(a.z, a.w); o.z = pk2(b.x, b.y); o.w = pk2(b.z, b.w); *(v4u*)(dst + i * 8) = o; }
}

__device__ __forceinline__ void cvt_i4_slices(const float* src, unsigned char* dst, float inv_step, size_t gtid, size_t nthr) {
    for (size_t i = gtid; i < (size_t)16384 * 64; i += nthr) { v4u o; const size_t e = i >> 6; const int c32 = (int)(i & 63), s = c32 >> 3, sub = c32 & 7;
#pragma unroll
        for (int w = 0; w < 4; ++w) { const f32x4 a = *(const f32x4*)(src + i * 32 + 8 * w) * inv_step, b = *(const f32x4*)(src + i * 32 + 8 * w + 4) * inv_step; unsigned d = 0u;
#pragma unroll
            for (int e_ = 0; e_ < 4; ++e_) { const int lo = (int)__builtin_amdgcn_fmed3f(__builtin_rintf(a[e_]), -8.f, 7.f) + 8, hi = (int)__builtin_amdgcn_fmed3f(__builtin_rintf(b[e_]), -8.f, 7.f) & 15; d |= ((unsigned)lo | ((unsigned)hi << 4)) << (8 * e_); }
            if (w == 0) o.x = d; else if (w == 1) o.y = d; else if (w == 2) o.z = d; else o.w = d; }
        *(v4u*)(dst + ((size_t)s * 16384 + e) * 128 + 16 * sub) = o; }
}
__device__ __forceinline__ float table_std16(const float* src, LAS float* scr, int tid) {
    float s = 0.f;
#pragma unroll
    for (int j = 0; j < 16; ++j) { const f32x4 v = *(const f32x4*)(src + (size_t)(j * 512 + tid) * 4); s += (v.x * v.x + v.y * v.y) + (v.z * v.z + v.w * v.w); }
    s = wave_sum(s);
    __syncthreads();
    if ((tid & 63) == 0) scr[tid >> 6] = s;
    __syncthreads();
    float t = 0.f;
#pragma unroll
    for (int w = 0; w < 8; ++w) t += scr[w];
    __syncthreads();
    return sqrtf(t * (1.0f / 32768.0f));
}
__device__ __forceinline__ void cvt_i8_slices(const float* src, unsigned char* dst, float scale, size_t gtid, size_t nthr) {
    for (size_t i = gtid; i < (size_t)16384 * 128; i += nthr) { v4u o; const size_t e = i >> 7; const int c16 = (int)(i & 127), s = c16 >> 3, sub = c16 & 7;
#pragma unroll
        for (int q = 0; q < 4; ++q) { const f32x4 a = *(const f32x4*)(src + i * 16 + 4 * q) * scale; unsigned w = 0u;
#pragma unroll
            for (int e_ = 0; e_ < 4; ++e_) { const int iv = (int)__builtin_amdgcn_fmed3f(__builtin_rintf(a[e_]), -127.f, 127.f); w |= ((unsigned)iv & 0xffu) << (8 * e_); }
            if (q == 0) o.x = w; else if (q == 1) o.y = w; else if (q == 2) o.z = w; else o.w = w; }
        *(v4u*)(dst + ((size_t)s * 16384 + e) * 128 + 16 * sub) = o; }
}
__device__ __forceinline__ void cvt_fp8_slices(const float* src, unsigned char* dst, float scale, size_t gtid, size_t nthr) {
    for (size_t i = gtid; i < (size_t)16384 * 128; i += nthr) { v4u o; const size_t e = i >> 7; const int c16 = (int)(i & 127), s = c16 >> 3, sub = c16 & 7;
#pragma unroll
        for (int q = 0; q < 4; ++q) { const f32x4 a = *(const f32x4*)(src + i * 16 + 4 * q) * scale; int w = __builtin_amdgcn_cvt_pk_fp8_f32(a.x, a.y, 0, false); w = __builtin_amdgcn_cvt_pk_fp8_f32(a.z, a.w, w, true);
            if (q == 0) o.x = (unsigned)w; else if (q == 1) o.y = (unsigned)w; else if (q == 2) o.z = (unsigned)w; else o.w = (unsigned)w; }
        *(v4u*)(dst + ((size_t)s * 16384 + e) * 128 + 16 * sub) = o; }
}

namespace att {
constexpr int SLOTB = 32768;
constexpr int NSLOT = 3, LW_OFF = NSLOT * SLOTB;
constexpr int XSTR = 132;
__device__ __forceinline__ void glds16(const void* gsrc, unsigned lds_dst) { unsigned keep;
    asm volatile("s_mov_b32 %0, m0\n\ts_mov_b32 m0, %2\n\ts_nop 0\n\tglobal_load_lds_dwordx4 %1, off\n\ts_mov_b32 m0, %0" : "=&s"(keep) : "v"(gsrc), "s"(lds_dst) : "memory"); }
__device__ __forceinline__ int crow(int r, int hi) { return (r & 3) + 8 * (r >> 2) + 4 * hi; }
typedef short v4i16_t __attribute__((ext_vector_type(4)));
__device__ __forceinline__ s16x4 vtr(const LAS char* p) { return __builtin_bit_cast(s16x4, __builtin_amdgcn_ds_read_tr16_b64_v4i16((LAS v4i16_t*)p)); }
#define ATT_WAIT_BAR(N) asm volatile("s_waitcnt vmcnt(" #N ") lgkmcnt(0)\n\ts_barrier" ::: "memory")
#define ATT_BAR() asm volatile("s_waitcnt lgkmcnt(0)\n\ts_barrier" ::: "memory")

template <int ABL> __device__ __forceinline__ void attn_unit(int b, int h, int qblk, const bf16* Q, const bf16* K, const bf16* V, bf16* MIX, const float* subg, float lam, float M2, LAS char* lds) {
    const int tid = threadIdx.x, lane = tid & 63, r32 = lane & 31, hi = lane >> 5, wid = __builtin_amdgcn_readfirstlane(tid >> 6), c = wid >> 2, qs = wid & 3;
    const size_t rowbase = (size_t)b * SEQ; const int q0 = qblk * 128, NT = 2 * (qblk + 1);
    const unsigned lds0 = (unsigned)(uintptr_t)lds;
    const bf16* ksrc[2]; const bf16* vsrc[2]; unsigned kdst[2], vdst[2];
#pragma unroll
    for (int i = 0; i < 2; ++i) { const int pk = 2 * wid + i, rr = lane >> 4, p = lane & 15, r = 4 * pk + rr;
        ksrc[i] = K + (rowbase + r) * 1024 + h * 128 + ((p ^ (r & 15)) * 8); kdst[i] = lds0 + pk * 1024;
        vsrc[i] = V + (rowbase + r) * 1024 + h * 128 + ((p ^ (rr << 2)) * 8); vdst[i] = lds0 + 16384 + pk * 1024; }
#define ATT_DMA(t, slot) do { _Pragma("unroll") for (int i_ = 0; i_ < 2; ++i_) { glds16(ksrc[i_] + (size_t)(t) * 64 * 1024, (unsigned)__builtin_amdgcn_readfirstlane(kdst[i_] + (slot) * SLOTB)); \
        glds16(vsrc[i_] + (size_t)(t) * 64 * 1024, (unsigned)__builtin_amdgcn_readfirstlane(vdst[i_] + (slot) * SLOTB)); } } while (0)
    ATT_DMA(0, 0); ATT_DMA(1, 1);
    const int qrow = q0 + 32 * qs + r32;
    bf16x8 qr[4];
#pragma unroll
    for (int d0 = 0; d0 < 4; ++d0) qr[d0] = *(const bf16x8*)(Q + (rowbase + qrow) * 1024 + h * 128 + c * 64 + d0 * 16 + hi * 8);
    asm volatile("" : "+v"(qr[0]), "+v"(qr[1]), "+v"(qr[2]), "+v"(qr[3]));
    const float slope2 = exp2f(-(float)(h + 1)) * 1.4426950408889634f;
    float base = -slope2 * (float)(qrow - 4 * hi) - M2;
    const float s32 = 32.f * slope2, s64 = 64.f * slope2;
    f32x16 o[4]; o[0] = f32x16{}; o[1] = f32x16{}; o[2] = f32x16{}; o[3] = f32x16{};
    float lsum = 0.f;
    int kofs[4], vofs[4];
    { const int q4 = (lane & 15) >> 2, p4 = lane & 3, gb = (lane >> 4) & 1;
#pragma unroll
      for (int d0 = 0; d0 < 4; ++d0) { kofs[d0] = r32 * 256 + (((8 * c + 2 * d0 + hi) ^ (r32 & 15)) << 4); vofs[d0] = 16384 + (4 * hi + q4) * 256 + (((((d0 ^ q4) << 2) | (gb << 1) | (p4 >> 1))) << 4) + (p4 & 1) * 8; } }
    const LAS char* lbase = (const LAS char*)lds;
    const int qw0 = q0 + 32 * qs;
#define ATT_PW(ks_) __builtin_bit_cast(bf16x8, ((v4u){pwd[4 * (ks_)], pwd[4 * (ks_) + 1], pwd[4 * (ks_) + 2], pwd[4 * (ks_) + 3]}))
#define ATT_VF(F, d_) ((bf16x8){F[2 * (d_)][0], F[2 * (d_)][1], F[2 * (d_)][2], F[2 * (d_)][3], F[2 * (d_) + 1][0], F[2 * (d_) + 1][1], F[2 * (d_) + 1][2], F[2 * (d_) + 1][3]})
#define ATT_VLDK(F, ks_) do { if (ABL & 16) { _Pragma("unroll") for (int d_ = 0; d_ < 8; ++d_) F[d_] = (s16x4){0, 0, 0, 0}; } else { _Pragma("unroll") for (int d_ = 0; d_ < 4; ++d_) { F[2 * d_] = vtr(sp_ + vofs[d_] + (ks_) * 4096); F[2 * d_ + 1] = vtr(sp_ + vofs[d_] + (ks_) * 4096 + 2048); } } } while (0)
#define ATT_MF(acc_, a_, b_) do { if (ABL & 2) { bf16x8 a__ = (a_), b__ = (b_); asm volatile("" :: "v"(a__), "v"(b__)); } else acc_ = __builtin_amdgcn_mfma_f32_32x32x16_bf16((a_), (b_), acc_, 0, 0, 0); } while (0)
#define ATT_PVK(F, ks_) do { _Pragma("unroll") for (int d_ = 0; d_ < 4; ++d_) ATT_MF(o[d_], ATT_PW(ks_), ATT_VF(F, d_)); } while (0)
#define ATT_SB() __builtin_amdgcn_sched_barrier(0)
    int slot = 0;
    for (int t = 0; t < NT; ++t) {
        if ((ABL & 64) && t > 0) { } else if (t == 0 || (ABL & 8)) { ATT_WAIT_BAR(0); } else if (t + 1 < NT) { ATT_WAIT_BAR(4); } else { ATT_WAIT_BAR(0); }
        if (!(ABL & 8) && t + 2 < NT) { const int s2_ = (slot == 0) ? 2 : slot - 1; ATT_DMA(t + 2, s2_); }
        const int k0 = 64 * t;
        if (k0 <= qw0 + 31) {
            const LAS char* sp_ = lbase + slot * SLOTB;
            f32x16 p0, p1; s16x4 fa[8], fb[8]; unsigned pwd[16];
#pragma unroll
            for (int r = 0; r < 16; ++r) { p0[r] = __builtin_fmaf(slope2, (float)((r & 3) + 8 * (r >> 2)), base); p1[r] = p0[r] + s32; }
            const bool diag = k0 + 63 > qw0;
            const int dq = qrow - k0;
            {
                float sA = 0.f, sB = 0.f, sC = 0.f, sD = 0.f; float e0[16], e1[16];
                __builtin_amdgcn_s_setprio(1);
#pragma unroll
                for (int d0 = 0; d0 < 4; ++d0) { const bf16x8 ka = *(const LAS bf16x8*)(sp_ + kofs[d0]); if (ABL & 4) { asm volatile("" :: "v"(ka)); } else p0 = __builtin_amdgcn_mfma_f32_32x32x16_bf16(ka, qr[d0], p0, 0, 0, 0); }
                ATT_VLDK(fa, 0); ATT_SB();
#pragma unroll
                for (int d0 = 0; d0 < 4; ++d0) { const bf16x8 kb = *(const LAS bf16x8*)(sp_ + kofs[d0] + 8192); if (ABL & 4) { asm volatile("" :: "v"(kb)); } else p1 = __builtin_amdgcn_mfma_f32_32x32x16_bf16(kb, qr[d0], p1, 0, 0, 0);
#pragma unroll
                    for (int i = 0; i < 4; ++i) e0[4 * d0 + i] = (ABL & 1) ? p0[4 * d0 + i] : __builtin_amdgcn_exp2f(p0[4 * d0 + i]);
                    if (diag) {
#pragma unroll
                        for (int i = 0; i < 4; ++i) if (crow(4 * d0 + i, hi) > dq) e0[4 * d0 + i] = 0.f; }
                    sA += e0[4 * d0]; sB += e0[4 * d0 + 1]; sC += e0[4 * d0 + 2]; sD += e0[4 * d0 + 3]; ATT_SB(); }
                ATT_VLDK(fb, 1);
#pragma unroll
                for (int j = 0; j < 8; ++j) pwd[j] = pk2(e0[2 * j], e0[2 * j + 1]);
                ATT_SB();
#pragma unroll
                for (int d_ = 0; d_ < 4; ++d_) { ATT_MF(o[d_], ATT_PW(0), ATT_VF(fa, d_));
                    e1[2 * d_] = (ABL & 1) ? p1[2 * d_] : __builtin_amdgcn_exp2f(p1[2 * d_]); e1[2 * d_ + 1] = (ABL & 1) ? p1[2 * d_ + 1] : __builtin_amdgcn_exp2f(p1[2 * d_ + 1]);
                    if (diag) { if (crow(2 * d_, hi) + 32 > dq) e1[2 * d_] = 0.f; if (crow(2 * d_ + 1, hi) + 32 > dq) e1[2 * d_ + 1] = 0.f; }
                    sA += e1[2 * d_]; sB += e1[2 * d_ + 1]; ATT_SB(); }
                ATT_VLDK(fa, 2); ATT_SB();
#pragma unroll
                for (int d_ = 0; d_ < 4; ++d_) { ATT_MF(o[d_], ATT_PW(1), ATT_VF(fb, d_));
                    e1[8 + 2 * d_] = (ABL & 1) ? p1[8 + 2 * d_] : __builtin_amdgcn_exp2f(p1[8 + 2 * d_]); e1[8 + 2 * d_ + 1] = (ABL & 1) ? p1[8 + 2 * d_ + 1] : __builtin_amdgcn_exp2f(p1[8 + 2 * d_ + 1]);
                    if (diag) { if (crow(8 + 2 * d_, hi) + 32 > dq) e1[8 + 2 * d_] = 0.f; if (crow(8 + 2 * d_ + 1, hi) + 32 > dq) e1[8 + 2 * d_ + 1] = 0.f; }
                    sC += e1[8 + 2 * d_]; sD += e1[8 + 2 * d_ + 1];
                    pwd[8 + d_] = pk2(e1[2 * d_], e1[2 * d_ + 1]); ATT_SB(); }
                ATT_VLDK(fb, 3);
#pragma unroll
                for (int j = 4; j < 8; ++j) pwd[8 + j] = pk2(e1[2 * j], e1[2 * j + 1]);
                lsum += (sA + sB) + (sC + sD);
                ATT_SB();
                ATT_PVK(fa, 2); ATT_SB(); ATT_PVK(fb, 3);
                __builtin_amdgcn_s_setprio(0);
            }
        }
        base += s64;
        slot = (slot == NSLOT - 1) ? 0 : slot + 1;
    }
#undef ATT_PW
#undef ATT_VF
#undef ATT_VLDK
#undef ATT_PVK
#undef ATT_MF
#undef ATT_SB
    ATT_WAIT_BAR(0);
    if (ABL & 32) { float keep_ = lsum + o[0][0] + o[1][1] + o[2][2] + o[3][3]; asm volatile("" :: "v"(keep_)); return; }
    LAS float* lw = (LAS float*)(lds + LW_OFF) + wid * 32;
    { auto rr = __builtin_amdgcn_permlane32_swap(__float_as_uint(lsum), __float_as_uint(lsum), false, false); lsum = __uint_as_float(rr[0]) + __uint_as_float(rr[1]); }
    if (hi == 0) lw[r32] = lsum;
    LDS_WAIT();
    LAS float* X = (LAS float*)lds + qs * 32 * XSTR;
#pragma unroll
    for (int r = 0; r < 16; ++r) { const float rl = 1.0f / lw[crow(r, hi)];
#pragma unroll
        for (int d0 = 0; d0 < 4; ++d0) o[d0][r] *= rl; }
    if (c == 1) {
#pragma unroll
        for (int r = 0; r < 16; ++r)
#pragma unroll
            for (int d0 = 0; d0 < 4; ++d0) X[crow(r, hi) * XSTR + d0 * 32 + r32] = o[d0][r];
    }
    ATT_WAIT_BAR(0);
    if (c == 0) {
#pragma unroll
        for (int r = 0; r < 16; ++r)
#pragma unroll
            for (int d0 = 0; d0 < 4; ++d0) { LAS float* px = X + crow(r, hi) * XSTR + d0 * 32 + r32; const float a = o[d0][r] - lam * (*px); *px = a; }
        LDS_WAIT(); asm volatile("" ::: "memory");
        const LAS f32x4* rp = (const LAS f32x4*)(X + r32 * XSTR + hi * 64);
        f32x4 av[16]; float ss = 0.f;
#pragma unroll
        for (int j = 0; j < 16; ++j) { av[j] = rp[j]; ss += (av[j].x * av[j].x + av[j].y * av[j].y) + (av[j].z * av[j].z + av[j].w * av[j].w); }
        { auto rr = __builtin_amdgcn_permlane32_swap(__float_as_uint(ss), __float_as_uint(ss), false, false); ss = __uint_as_float(rr[0]) + __uint_as_float(rr[1]); }
        const float rs = 0.8f / sqrtf(ss * (1.0f / 128.0f) + EPS);
        bf16* op = MIX + (rowbase + qrow) * 2048 + h * 128 + hi * 64;
#pragma unroll
        for (int j = 0; j < 8; ++j) { const f32x4 g0 = *(const f32x4*)(subg + hi * 64 + 8 * j), g1 = *(const f32x4*)(subg + hi * 64 + 8 * j + 4); const f32x4 a0 = av[2 * j] * rs * g0, a1 = av[2 * j + 1] * rs * g1;
            v4u w; w.x = pk2(a0.x, a0.y); w.y = pk2(a0.z, a0.w); w.z = pk2(a1.x, a1.y); w.w = pk2(a1.z, a1.w); *(v4u*)(op + 8 * j) = w; }
    }
    ATT_BAR();
#undef ATT_DMA
}
}


#ifndef DBG_NAIVE_ATTN
#define DBG_NAIVE_ATTN 0
#endif
#if DBG_NAIVE_ATTN
__device__ __forceinline__ void naive_attn_row(int b, int h, int q, const bf16* Q, const bf16* K, const bf16* V, bf16* MIX, const float* subg, float lam, LAS float* S, int lane) {
    const size_t rowbase = (size_t)b * SEQ; const float slope2 = exp2f(-(float)(h + 1)) * 1.4426950408889634f;
    for (int c = 0; c < 2; ++c) {
        float qv[64];
        const bf16* qp = Q + (rowbase + q) * 1024 + h * 128 + c * 64;
#pragma unroll
        for (int d = 0; d < 64; d += 2) { const unsigned u = *(const unsigned*)(qp + d); qv[d] = bflo(u); qv[d + 1] = bfhi(u); }
        for (int key = lane; key <= q; key += 64) { const bf16* kp = K + (rowbase + key) * 1024 + h * 128 + c * 64; float s = 0.f;
#pragma unroll
            for (int d = 0; d < 64; d += 2) { const unsigned u = *(const unsigned*)(kp + d); s += qv[d] * bflo(u) + qv[d + 1] * bfhi(u); }
            S[c * 2048 + key] = s - slope2 * (float)(q - key); }
    }
    LDS_WAIT();
    float linv[2];
    for (int c = 0; c < 2; ++c) { float m = -1e30f; for (int key = lane; key <= q; key += 64) m = fmaxf(m, S[c * 2048 + key]); m = wave_max(m);
        float l = 0.f; for (int key = lane; key <= q; key += 64) { const float p = exp2f(S[c * 2048 + key] - m); S[c * 2048 + key] = p; l += p; } linv[c] = 1.0f / wave_sum(l); }
    for (int key = lane; key <= q; key += 64) S[key] = S[key] * linv[0] - lam * S[2048 + key] * linv[1];
    LDS_WAIT();
    float o0 = 0.f, o1 = 0.f; const bf16* vp = V + rowbase * 1024 + h * 128 + lane;
    for (int key = 0; key <= q; ++key) { const float a = S[key]; o0 += a * __uint_as_float((unsigned)vp[(size_t)key * 1024] << 16); o1 += a * __uint_as_float((unsigned)vp[(size_t)key * 1024 + 64] << 16); }
    const float ss = wave_sum(o0 * o0 + o1 * o1); const float rs = 0.8f / sqrtf(ss * (1.0f / 128.0f) + EPS);
    bf16* op = MIX + (rowbase + q) * 2048 + h * 128 + lane;
    op[0] = (bf16)(pk2(o0 * rs * subg[lane], 0.f) & 0xffffu); op[64] = (bf16)(pk2(o1 * rs * subg[lane + 64], 0.f) & 0xffffu);
    LDS_WAIT();
}
#endif

__device__ __forceinline__ unsigned ord_key(float f) { const unsigned u = __float_as_uint(f); return (u & 0x80000000u) ? ~u : (u | 0x80000000u); }
__device__ __forceinline__ float ord_val(unsigned k) { return __uint_as_float((k & 0x80000000u) ? (k ^ 0x80000000u) : ~k); }
#define CE_DESC(a, b) do { const unsigned hi__ = max((a), (b)), lo__ = min((a), (b)); (a) = hi__; (b) = lo__; } while (0)
__device__ __forceinline__ void sort16_desc(unsigned (&v)[16]) {
#pragma unroll
    for (int k = 2; k <= 16; k <<= 1)
#pragma unroll
        for (int j = k >> 1; j > 0; j >>= 1)
#pragma unroll
            for (int i = 0; i < 16; ++i) { const int l = i ^ j; if (l > i) { if ((i & k) == 0) CE_DESC(v[i], v[l]); else CE_DESC(v[l], v[i]); } }
}
__device__ __forceinline__ void merge16_desc_rev(unsigned (&a)[16], const unsigned (&brev)[16]) {
#pragma unroll
    for (int i = 0; i < 16; ++i) a[i] = max(a[i], brev[i]);
#pragma unroll
    for (int j = 8; j > 0; j >>= 1)
#pragma unroll
        for (int i = 0; i < 16; ++i) { const int l = i ^ j; if (l > i) CE_DESC(a[i], a[l]); }
}

constexpr int P5_LST_OFF = 65536, P5_TAB_OFF = P5_LST_OFF + 16384;
__device__ __forceinline__ void peer_topk_item(int tile, int h, const bf16* QP, const float* SSQ, int* EIDX, float* EGATE, float* RSTD, LAS char* lds) {
    const int tid = threadIdx.x, lane = tid & 63, r32 = lane & 31, hi = lane >> 5, wid = __builtin_amdgcn_readfirstlane(tid >> 6);
    LAS unsigned* LST = (LAS unsigned*)(lds + P5_LST_OFF);
    const LAS unsigned char* TAB = (const LAS unsigned char*)(lds + P5_TAB_OFF);
    const int tok0 = tile * 128;
    {
        const int c = wid >> 2, tb = wid & 3;
        bf16x8 qf[8];
        const bf16* qp = QP + (size_t)(tok0 + tb * 32 + r32) * 2048 + h * 256 + c * 128 + hi * 8;
#pragma unroll
        for (int s = 0; s < 8; ++s) qf[s] = *(const bf16x8*)(qp + 16 * s);
        const LAS char* sp = lds + c * 32768 + hi * 2048 + r32 * 16;
        unsigned best[16];
#pragma unroll
        for (int kb = 0; kb < 4; ++kb) { f32x16 acc = f32x16{};
#pragma unroll
            for (int s = 0; s < 8; ++s) { const bf16x8 sf = *(const LAS bf16x8*)(sp + s * 4096 + kb * 512); acc = __builtin_amdgcn_mfma_f32_32x32x16_bf16(sf, qf[s], acc, 0, 0, 0); }
            unsigned v[16];
#pragma unroll
            for (int r = 0; r < 16; ++r) v[r] = (ord_key(acc[r]) & ~0x7Fu) | (unsigned)(32 * kb + (r & 3) + 8 * (r >> 2)) | (unsigned)(hi << 2);
            sort16_desc(v);
            if (kb == 0) {
#pragma unroll
                for (int i = 0; i < 16; ++i) best[i] = v[i];
            } else { unsigned vr[16];
#pragma unroll
                for (int i = 0; i < 16; ++i) vr[i] = v[15 - i];
                merge16_desc_rev(best, vr); } }
        {
            unsigned br[16];
#pragma unroll
            for (int i = 0; i < 16; ++i) br[i] = (unsigned)__shfl_xor((int)best[15 - i], 32);
            merge16_desc_rev(best, br); }
        if (hi == 0) { LAS unsigned* lrow = LST + (c * 128 + tb * 32 + r32) * 16;
#pragma unroll
            for (int i = 0; i < 4; ++i) *(LAS v4u*)(lrow + 4 * i) = (v4u){best[4 * i], best[4 * i + 1], best[4 * i + 2], best[4 * i + 3]}; }
    }
    __syncthreads();
    {
        const int token = tid >> 2, q = tid & 3;
        const LAS unsigned* l1 = LST + token * 16; const LAS unsigned* l2 = LST + (128 + token) * 16;
        unsigned v[16];
#pragma unroll
        for (int m = 0; m < 13; ++m) { const int n = 4 * m + q; const unsigned pid = TAB[n < 50 ? n : 0]; const unsigned a = l1[pid >> 4], b2 = l2[pid & 15u];
            const unsigned key = (ord_key(ord_val(a & ~0x7Fu) + ord_val(b2 & ~0x7Fu)) & ~0xFFu) | pid; v[m] = n < 50 ? key : 0u; }
        v[13] = 0u; v[14] = 0u; v[15] = 0u;
        sort16_desc(v);
#pragma unroll
        for (int w = 1; w <= 2; w <<= 1) { unsigned br[16];
#pragma unroll
            for (int i = 0; i < 16; ++i) br[i] = (unsigned)__shfl_xor((int)v[15 - i], w);
            merge16_desc_rev(v, br); }
        const int t = tok0 + token;
        const f32x4 p0 = *(const f32x4*)(SSQ + (size_t)t * 32 + 8 * q), p1 = *(const f32x4*)(SSQ + (size_t)t * 32 + 8 * q + 4);
        float ssq = ((p0.x + p0.y) + (p0.z + p0.w)) + ((p1.x + p1.y) + (p1.z + p1.w));
        ssq += __shfl_xor(ssq, 1); ssq += __shfl_xor(ssq, 2);
        const float rstd = 1.0f / sqrtf(ssq * (1.0f / DM) + EPS);
        if (h == 0 && q == 0) RSTD[t] = rstd;
        const unsigned p_top = v[0] & 0xFFu; const float vmax = (ord_val(l1[p_top >> 4] & ~0x7Fu) + ord_val(l2[p_top & 15u] & ~0x7Fu)) * rstd;
        float ev[4]; int ex[4]; float es = 0.f;
#pragma unroll
        for (int m = 0; m < 4; ++m) { const unsigned kk = q == 0 ? v[m] : q == 1 ? v[4 + m] : q == 2 ? v[8 + m] : v[12 + m];
            const unsigned pid = kk & 0xFFu; const unsigned a = l1[pid >> 4], b2 = l2[pid & 15u];
            const float sv = (ord_val(a & ~0x7Fu) + ord_val(b2 & ~0x7Fu)) * rstd;
            ev[m] = __expf(sv - vmax); es += ev[m]; ex[m] = (int)((a & 0x7Fu) * 128u + (b2 & 0x7Fu)); }
        es += __shfl_xor(es, 1); es += __shfl_xor(es, 2);
        const float inv = 1.0f / es;
        *(int4*)(EIDX + (size_t)t * 128 + h * 16 + 4 * q) = make_int4(ex[0], ex[1], ex[2], ex[3]);
        *(f32x4*)(EGATE + (size_t)t * 128 + h * 16 + 4 * q) = (f32x4){ev[0] * inv, ev[1] * inv, ev[2] * inv, ev[3] * inv};
    }
    __syncthreads();
}

__device__ __forceinline__ f32x2 dot16_fp8(const v4u u, const f32x2* h, f32x2 acc) {
#pragma unroll
    for (int w = 0; w < 4; ++w) { const unsigned d = w == 0 ? u.x : w == 1 ? u.y : w == 2 ? u.z : u.w;
        const f32x2 f0 = __builtin_amdgcn_cvt_pk_f32_fp8((int)d, false), f1 = __builtin_amdgcn_cvt_pk_f32_fp8((int)d, true);
        acc = __builtin_elementwise_fma(h[2 * w], f0, acc); acc = __builtin_elementwise_fma(h[2 * w + 1], f1, acc); }
    return acc;
}
__device__ __forceinline__ void axpy16_fp8(const v4u v, f32x2 a2, f32x2* o) {
#pragma unroll
    for (int w = 0; w < 4; ++w) { const unsigned d = w == 0 ? v.x : w == 1 ? v.y : w == 2 ? v.z : v.w;
        const f32x2 f0 = __builtin_amdgcn_cvt_pk_f32_fp8((int)d, false), f1 = __builtin_amdgcn_cvt_pk_f32_fp8((int)d, true);
        o[2 * w] = __builtin_elementwise_fma(a2, f0, o[2 * w]); o[2 * w + 1] = __builtin_elementwise_fma(a2, f1, o[2 * w + 1]); }
}
struct PItem { int t, s; };
__device__ __forceinline__ PItem peer_item(int q, int nq, int nper, int tb, int tstride, int xl) {
    const int j = (q < nq ? q : nq - 1) >> 1; PItem it; const int r = j >= nper ? 1 : 0; it.s = 8 * r + xl; const int t = tb + (j - r * nper) * tstride; it.t = t < T ? t : T - 1; return it; }
__device__ __forceinline__ void pe_idx8(const PItem it, int hh, const int* EIDX, int g, int (&ex)[8]) {
#pragma unroll
    for (int i = 0; i < 2; ++i) { const int4 v = *(const int4*)(EIDX + (size_t)it.t * 128 + g * 16 + 8 * hh + 4 * i); ex[4 * i] = v.x; ex[4 * i + 1] = v.y; ex[4 * i + 2] = v.z; ex[4 * i + 3] = v.w; }
}
__device__ __forceinline__ void pe_gather8(const PItem it, const unsigned char* TB, int sub, const int (&ex)[8], v4u (&uv)[8]) {
    const unsigned char* ub = TB + (size_t)it.s * 16384 * 128 + 16 * sub;
#pragma unroll
    for (int i = 0; i < 8; ++i) uv[i] = *(const v4u*)(ub + (size_t)ex[i] * 128);
}
__device__ __forceinline__ int sdot4(unsigned a, unsigned b, int acc) { return __builtin_amdgcn_sdot4((int)a, (int)b, acc, false); }
__device__ __forceinline__ void pu_acc8(const v4u (&uv)[8], const v4u ha, const v4u hb, int hs8, int (&r)[8]) {
#pragma unroll
    for (int i = 0; i < 8; ++i) { int a = -hs8, b = 0;
        a = sdot4(uv[i].x & 0x0F0F0F0Fu, ha.x, a); b = sdot4(uv[i].x & 0xF0F0F0F0u, ha.y, b); a = sdot4(uv[i].y & 0x0F0F0F0Fu, ha.z, a); b = sdot4(uv[i].y & 0xF0F0F0F0u, ha.w, b);
        a = sdot4(uv[i].z & 0x0F0F0F0Fu, hb.x, a); b = sdot4(uv[i].z & 0xF0F0F0F0u, hb.y, b); a = sdot4(uv[i].w & 0x0F0F0F0Fu, hb.z, a); b = sdot4(uv[i].w & 0xF0F0F0F0u, hb.w, b);
        r[i] = a + (b >> 4); }
}
__device__ __forceinline__ void pu_store(const PItem it, bool valid, float* PART, int lane, const int (&rlo)[8], const int (&rhi)[8]) {
    const int g = lane >> 3, sub = lane & 7;
    int r[16];
#pragma unroll
    for (int i = 0; i < 8; ++i) { r[i] = rlo[i]; r[8 + i] = rhi[i]; }
    { const bool up = (lane & 4) != 0;
#pragma unroll
      for (int j = 0; j < 8; ++j) { const int a = r[j], b2 = r[j + 8]; const int keep = up ? b2 : a, send = up ? a : b2; const int m_ = __builtin_amdgcn_update_dpp(0, send, 0x141, 0xf, 0xf, false); r[j] = keep + __builtin_amdgcn_update_dpp(0, m_, 0x1B, 0xf, 0xf, false); } }
    { const bool up = (lane & 2) != 0;
#pragma unroll
      for (int j = 0; j < 4; ++j) { const int a = r[j], b2 = r[j + 4]; const int keep = up ? b2 : a, send = up ? a : b2; r[j] = keep + __builtin_amdgcn_update_dpp(0, send, 0x4E, 0xf, 0xf, false); } }
    { const bool up = (lane & 1) != 0;
#pragma unroll
      for (int j = 0; j < 2; ++j) { const int a = r[j], b2 = r[j + 2]; const int keep = up ? b2 : a, send = up ? a : b2; r[j] = keep + __builtin_amdgcn_update_dpp(0, send, 0xB1, 0xf, 0xf, false); } }
    const int i0 = 8 * ((sub >> 2) & 1) + 4 * ((sub >> 1) & 1) + 2 * (sub & 1);
    if (valid) *(f32x2*)(PART + ((size_t)it.s * T + it.t) * 128 + g * 16 + i0) = (f32x2){(float)r[0], (float)r[1]};
}
__device__ __forceinline__ PItem peer_item1(int q, int nq, int tb, int tstride, int xl) { const int j = (q < nq ? q : nq - 1) >> 1; PItem it; it.s = xl; const int t = tb + j * tstride; it.t = t < T ? t : T - 1; return it; }
__device__ __forceinline__ void peer_u_stage(int nper, int tb, int tstride, int xl, const unsigned char* H8, const unsigned char* U8, const int* EIDX, float* PART, int lane) {
    const int g = lane >> 3, sub = lane & 7, NQ = 2 * nper;
    int ex0[8], ex1[8], ex2[8], ex3[8]; v4u uv0[8], uv1[8], uv2[8], uv3[8], ha0, ha1, ha2, ha3, hb0, hb1, hb2, hb3; int rs[8];
#define PU_I(q, X) do { const PItem it_ = peer_item1((q), NQ, tb, tstride, xl); pe_idx8(it_, (X) & 1, EIDX, g, ex##X); } while (0)
#define PU_G(q, X) do { const PItem it_ = peer_item1((q), NQ, tb, tstride, xl); pe_gather8(it_, U8, sub, ex##X, uv##X); const unsigned char* hp_ = H8 + (size_t)it_.t * 2048 + 256 * it_.s + 32 * sub; ha##X = *(const v4u*)hp_; hb##X = *(const v4u*)(hp_ + 16); } while (0)
#define PU_F(q, X) do { const PItem it_ = peer_item1((q), NQ, tb, tstride, xl); int hs_ = sdot4(ha##X.x, 0x01010101u, 0); hs_ = sdot4(ha##X.z, 0x01010101u, hs_); hs_ = sdot4(hb##X.x, 0x01010101u, hs_); hs_ = sdot4(hb##X.z, 0x01010101u, hs_); \
        if (((X) & 1) == 0) pu_acc8(uv##X, ha##X, hb##X, 8 * hs_, rs); else { int rh_[8]; pu_acc8(uv##X, ha##X, hb##X, 8 * hs_, rh_); \
        pu_store(it_, (q) < NQ && (tb + ((q) >> 1) * tstride) < T, PART, lane, rs, rh_); } } while (0)
    PU_I(0, 0); PU_I(1, 1); PU_I(2, 2); PU_I(3, 3); PU_G(0, 0); PU_G(1, 1); PU_G(2, 2);
#pragma unroll 1
    for (int q = 0; q < NQ; q += 4) {
        PU_F(q, 0);     PU_G(q + 3, 3); PU_I(q + 4, 0);
        PU_F(q + 1, 1); PU_G(q + 4, 0); PU_I(q + 5, 1);
        PU_F(q + 2, 2); PU_G(q + 5, 1); PU_I(q + 6, 2);
        PU_F(q + 3, 3); PU_G(q + 6, 2); PU_I(q + 7, 3);
    }
#undef PU_I
#undef PU_G
#undef PU_F
}
__device__ __forceinline__ void tr4x4(unsigned r0, unsigned r1, unsigned r2, unsigned r3, unsigned& c0, unsigned& c1, unsigned& c2, unsigned& c3) {
    const unsigned a = __builtin_amdgcn_perm(r1, r0, 0x05010400u), b = __builtin_amdgcn_perm(r1, r0, 0x07030602u), c = __builtin_amdgcn_perm(r3, r2, 0x05010400u), d = __builtin_amdgcn_perm(r3, r2, 0x07030602u);
    c0 = __builtin_amdgcn_perm(c, a, 0x05040100u); c1 = __builtin_amdgcn_perm(c, a, 0x07060302u); c2 = __builtin_amdgcn_perm(d, b, 0x05040100u); c3 = __builtin_amdgcn_perm(d, b, 0x07060302u);
}
__device__ __forceinline__ void pv_acc8(const v4u (&vv)[8], const unsigned aq0, const unsigned aq1, int (&acc)[32]) {
#pragma unroll
    for (int m = 0; m < 2; ++m) { const unsigned aq = m == 0 ? aq0 : aq1;
#pragma unroll
        for (int w = 0; w < 4; ++w) { unsigned d[4];
#pragma unroll
            for (int i = 0; i < 4; ++i) d[i] = w == 0 ? vv[4 * m + i].x : w == 1 ? vv[4 * m + i].y : w == 2 ? vv[4 * m + i].z : vv[4 * m + i].w;
            unsigned c0, c1, c2, c3;
            tr4x4(d[0], d[1], d[2], d[3], c0, c1, c2, c3);
            acc[8 * w + 0] = sdot4(c0 & 0x0F0F0F0Fu, aq, acc[8 * w + 0]); acc[8 * w + 1] = sdot4(c1 & 0x0F0F0F0Fu, aq, acc[8 * w + 1]); acc[8 * w + 2] = sdot4(c2 & 0x0F0F0F0Fu, aq, acc[8 * w + 2]); acc[8 * w + 3] = sdot4(c3 & 0x0F0F0F0Fu, aq, acc[8 * w + 3]);
            acc[8 * w + 4] = sdot4(c0 & 0xF0F0F0F0u, aq, acc[8 * w + 4]); acc[8 * w + 5] = sdot4(c1 & 0xF0F0F0F0u, aq, acc[8 * w + 5]); acc[8 * w + 6] = sdot4(c2 & 0xF0F0F0F0u, aq, acc[8 * w + 6]); acc[8 * w + 7] = sdot4(c3 & 0xF0F0F0F0u, aq, acc[8 * w + 7]); } }
}
__device__ __forceinline__ void pv_store(const PItem it, bool valid, float* out, const f32x4 ginv, const float sc, int lane, int (&acc)[32], int asum, const v2u x1b) {
    const int g = lane >> 3, sub = lane & 7;
#pragma unroll
    for (int j = 0; j < 16; ++j) { const auto r_ = __builtin_amdgcn_permlane32_swap((unsigned)acc[j], (unsigned)acc[j + 16], false, false); acc[j] = (int)r_[0] + (int)r_[1]; }
#pragma unroll
    for (int j = 0; j < 8; ++j) { const auto r_ = __builtin_amdgcn_permlane16_swap((unsigned)acc[j], (unsigned)acc[j + 8], false, false); acc[j] = (int)r_[0] + (int)r_[1]; }
    { const bool up = (lane & 8) != 0;
#pragma unroll
      for (int j = 0; j < 4; ++j) { const int a = acc[j], b2 = acc[j + 4]; const int keep = up ? b2 : a, send = up ? a : b2; acc[j] = keep + __builtin_amdgcn_update_dpp(0, send, 0x128, 0xf, 0xf, false); } }
    asum += __builtin_amdgcn_update_dpp(0, asum, 0x128, 0xf, 0xf, false);
    { const auto r_ = __builtin_amdgcn_permlane16_swap((unsigned)asum, (unsigned)asum, false, false); asum = (int)r_[0] + (int)r_[1]; }
    { const auto r_ = __builtin_amdgcn_permlane32_swap((unsigned)asum, (unsigned)asum, false, false); asum = (int)r_[0] + (int)r_[1]; }
    const int c0 = 16 * ((g >> 2) & 1) + 8 * ((g >> 1) & 1) + 4 * (g & 1);
    const bool hicol = (c0 & 4) != 0;
    int v_[4];
#pragma unroll
    for (int i = 0; i < 4; ++i) v_[i] = hicol ? (acc[i] >> 4) : (acc[i] - 8 * asum);
    if (valid) *(f32x4*)(out + (size_t)it.t * 2048 + 256 * it.s + 32 * sub + c0) = (f32x4){bflo(x1b.x) * ginv.x + sc * (float)v_[0], bfhi(x1b.x) * ginv.y + sc * (float)v_[1], bflo(x1b.y) * ginv.z + sc * (float)v_[2], bfhi(x1b.y) * ginv.w + sc * (float)v_[3]};
}
template <int ABL> __device__ __forceinline__ void peer_v_stage(int nper, int tb, int tstride, int xl, const unsigned char* V8, const int* EIDX, const unsigned* ACTQ, const float* ASC, const bf16* A2, const float* ffn_g, float* out, int lane) {
    const int g = lane >> 3, sub = lane & 7, NQ = 2 * nper;
    const int c0 = 16 * ((g >> 2) & 1) + 8 * ((g >> 1) & 1) + 4 * (g & 1);
    int ex0[8], ex1[8], ex2[8], ex3[8]; v4u vv0[8], vv1[8], vv2[8], vv3[8]; v2u aq0, aq1, aq2, aq3, x1a, x1b; float sca = 0.f, scb = 0.f; int acc[32]; int asum = 0;
    f32x4 ginv; { const f32x4 gg = *(const f32x4*)(ffn_g + 256 * xl + 32 * sub + c0); ginv = (f32x4){1.0f / gg.x, 1.0f / gg.y, 1.0f / gg.z, 1.0f / gg.w}; }
#define PV_I(q, X) do { const PItem it_ = peer_item1((q), NQ, tb, tstride, xl); pe_idx8(it_, (X) & 1, EIDX, g, ex##X); } while (0)
#define PV_G(q, X, XV, SCV) do { const PItem it_ = peer_item1((q), NQ, tb, tstride, xl); if (ABL & 2) { _Pragma("unroll") for (int i_ = 0; i_ < 8; ++i_) vv##X[i_] = (v4u){(unsigned)ex##X[i_], 1u, 2u, 3u}; } else pe_gather8(it_, V8, sub, ex##X, vv##X); \
        aq##X = *(const v2u*)(ACTQ + (size_t)it_.t * 32 + g * 4 + 2 * ((X) & 1)); \
        if ((X) & 1) { XV = *(const v2u*)(A2 + (size_t)it_.t * 2048 + 256 * it_.s + 32 * sub + c0); SCV = ASC[it_.t]; } } while (0)
#define PV_F(q, X, XV, SCV) do { const PItem it_ = peer_item1((q), NQ, tb, tstride, xl); if (((X) & 1) == 0) { _Pragma("unroll") for (int m_ = 0; m_ < 32; ++m_) acc[m_] = 0; asum = 0; } \
        asum = sdot4(aq##X.x, 0x01010101u, asum); asum = sdot4(aq##X.y, 0x01010101u, asum); \
        if (ABL & 1) { _Pragma("unroll") for (int i_ = 0; i_ < 8; ++i_) asm volatile("" :: "v"(vv##X[i_])); acc[0] += (int)aq##X.x; } else pv_acc8(vv##X, aq##X.x, aq##X.y, acc); if ((X) & 1) pv_store(it_, (q) < NQ && (tb + ((q) >> 1) * tstride) < T, out, ginv, SCV, lane, acc, asum, XV); } while (0)
    PV_I(0, 0); PV_I(1, 1); PV_I(2, 2); PV_I(3, 3); PV_G(0, 0, x1a, sca); PV_G(1, 1, x1a, sca); PV_G(2, 2, x1b, scb);
#pragma unroll 1
    for (int q = 0; q < NQ; q += 4) {
        PV_F(q, 0, x1a, sca);     PV_G(q + 3, 3, x1b, scb); PV_I(q + 4, 0);
        PV_F(q + 1, 1, x1a, sca); PV_G(q + 4, 0, x1a, sca); PV_I(q + 5, 1);
        PV_F(q + 2, 2, x1b, scb); PV_G(q + 5, 1, x1a, sca); PV_I(q + 6, 2);
        PV_F(q + 3, 3, x1b, scb); PV_G(q + 6, 2, x1b, scb); PV_I(q + 7, 3);
    }
#undef PV_I
#undef PV_G
#undef PV_F
}

struct Args { const float* in[17]; float* out; unsigned char* ws; int ph_lo, ph_hi; };
__global__ void __launch_bounds__(NTHREADS, 2) mk_fwd(Args args) {
    extern __shared__ __attribute__((aligned(16))) unsigned char lds_raw[];
    LAS unsigned char* lds = (LAS unsigned char*)lds_raw;
    const int tid = threadIdx.x, lane = tid & 63, wave = __builtin_amdgcn_readfirstlane(tid >> 6);
    const int G = gridDim.x, bx = blockIdx.x;
    const int vcu = (G % 8 == 0) ? (bx % 8) * (G / 8) + bx / 8 : bx;
    unsigned char* ws = args.ws;
    const float* x = args.in[0]; const float* attn_g = args.in[1]; const float* w_in = args.in[2]; const float* qg = args.in[3]; const float* kg = args.in[4];
    const float* lq1 = args.in[5]; const float* lk1 = args.in[6]; const float* lq2 = args.in[7]; const float* lk2 = args.in[8]; const float* subg = args.in[9];
    const float* conv_w = args.in[10]; const float* w_out = args.in[11]; const float* ffn_g = args.in[12]; const float* w_q = args.in[13]; const float* subkeys = args.in[14];
    const float* peer_u = args.in[15]; const float* peer_v = args.in[16];
    float* out = args.out;
    bf16* WtIn = (bf16*)(ws + WS_WIN); bf16* WtOut = (bf16*)(ws + WS_WOUT); bf16* WtQ = (bf16*)(ws + WS_WQ); bf16* SK = (bf16*)(ws + WS_SK);
    float* SSQ = (float*)(ws + WS_SSQ); int* EIDX = (int*)(ws + WS_EIDX); float* EGATE = (float*)(ws + WS_EGATE); float* RSTD = (float*)(ws + WS_RSTD);
    bf16* XN = (bf16*)(ws + WS_XN); bf16* MIX = XN;
    bf16* Qb = (bf16*)(ws + WS_Q); bf16* Kb = (bf16*)(ws + WS_K); bf16* Vb = (bf16*)(ws + WS_V); bf16* QP = Qb;
    bf16* CB = (bf16*)(ws + WS_CB); bf16* CC = (bf16*)(ws + WS_CC); bf16* CX = (bf16*)(ws + WS_CX); bf16* A2 = CB;
    unsigned char* U8 = ws + WS_UT; unsigned char* V8 = ws + WS_VT;
    volatile LAS unsigned* MISC = (volatile LAS unsigned*)(lds + MISC_OFF);
    if (tid < 16) MISC[tid] = 0u;
    __syncthreads();
    XcdBarrier bar = xcd_barrier_post((unsigned*)(ws + WS_CTL) + CW_BAR, MISC + 8);
    const int lo = args.ph_lo, hi_ph = args.ph_hi & 255, dbg_flags = args.ph_hi >> 8;
#ifndef DBG_DUP
#define DBG_DUP -1
#endif
#ifndef DBG_MASK
#define DBG_MASK 0xfff
#endif
#define IN(k) (((DBG_MASK >> (k)) & 1) && lo <= (k) && (k) < hi_ph)
#define REPS(k) for (int rep_ = 0; rep_ < ((DBG_DUP == (k)) ? 2 : 1); ++rep_)
#define SEAM(k) do { if (IN(k) && IN((k) + 1)) xcd_barrier(bar); } while (0)
    const int gw = vcu * NWAVES + wave, NGW = G * NWAVES;
    const size_t gtid = (size_t)bx * NTHREADS + tid, nthr = (size_t)G * NTHREADS;

    if (IN(0)) REPS(0) {
        LAS float* scr = (LAS float*)(lds + wave * 16384);
        constexpr int I_IN = (DM / 64) * (INC / 32), I_SQ = (DM / 64) * (DM / 32);
        if (!(dbg_flags & 4))
        for (int it = gw; it < I_IN + 2 * I_SQ; it += NGW) {
            if (it < I_IN) p0_transpose_item(w_in, DM, INC, WtIn, scr, it, lane, true);
            else if (it < I_IN + I_SQ) p0_transpose_item(w_out, DM, DM, WtOut, scr, it - I_IN, lane, false);
            else p0_transpose_item(w_q, DM, DM, WtQ, scr, it - I_IN - I_SQ, lane, false);
        }
        if (!(dbg_flags & 8))
        for (int m = gw; m < T; m += NGW) rms_row_to_bf16(x + (size_t)m * DM, attn_g, XN + (size_t)m * DM, lane);
        cvt_bf16_stream(subkeys, SK, (size_t)PEH * 2 * PNK * 128 / 8, gtid, nthr);
        if (!(dbg_flags & 16))
        {
            const float sig = table_std16(peer_u, (LAS float*)(lds + MISC_OFF + 64), tid); const float step = 0.335f * sig;
            if (bx == 0 && tid == 0) ((float*)(ws + WS_RSTD))[T] = step;
            cvt_i4_slices(peer_u, U8, 1.0f / step, gtid, nthr); }
        if (!(dbg_flags & 32))
        {
            const float sig = table_std16(peer_v, (LAS float*)(lds + MISC_OFF + 64), tid); const float step = 0.335f * sig;
            if (bx == 0 && tid == 0) ((float*)(ws + WS_RSTD))[T + 1] = step;
            cvt_i4_slices(peer_v, V8, 1.0f / step, gtid, nthr); }
    }
    SEAM(0);
    if (IN(1)) REPS(1) {
        pg8::Gemm g{XN, WtIn, T, INC, DM}; pg8::StaticOrder S; S.init(T, INC, G, bx);
        pg8::EpiProj E{Qb, qg, kg};
        pg8::gemm_phase<pg8::EpiProj, pg8::StaticOrder, true, true>(lds, g, S, E);
    }
    SEAM(1);
    if (IN(2)) REPS(2) {
        float a = lq1[lane] * lk1[lane], b2 = lq2[lane] * lk2[lane];
        a = wave_sum(a); b2 = wave_sum(b2);
        const float lam = expf(a) - expf(b2) + 0.2f;
        const float mq = wave_max(fabsf(qg[lane])), mk = wave_max(fabsf(kg[lane]));
        const float M2 = 64.f * C2 * mq * mk;
#if DBG_NAIVE_ATTN
        for (int r = gw; r < NB * NH * SEQ; r += NGW) naive_attn_row(r >> 14, (r >> 11) & 7, r & 2047, Qb, Kb, Vb, MIX, subg, lam, (LAS float*)(lds + wave * 16384), lane);
        if (0)
#endif
        if (!(dbg_flags & 2))
        for (int v = vcu; v < NB * NH * 4; v += G) {
            const int bh = v >> 2, s = v & 3, b = bh >> 3, h = bh & 7;
#pragma unroll 1
            for (int i = 0; i < 4; ++i) { const int qblk = (i == 0) ? s : (i == 1) ? 7 - s : (i == 2) ? 8 + s : 15 - s;
                att::attn_unit<0>(b, h, qblk, Qb, Kb, Vb, MIX, subg, lam, M2, (LAS char*)lds); }
        }
        if (!(dbg_flags & 1))
        for (size_t it = gtid; it < (size_t)(T / 16) * 128; it += nthr) {
            const int cg8 = (int)(it & 127), chunk = (int)(it >> 7), t0 = chunk * 16, col = cg8 * 8;
            f32x4 w0a = *(const f32x4*)(conv_w + col), w0b = *(const f32x4*)(conv_w + col + 4), w1a = *(const f32x4*)(conv_w + 1024 + col), w1b = *(const f32x4*)(conv_w + 1024 + col + 4),
                  w2a = *(const f32x4*)(conv_w + 2048 + col), w2b = *(const f32x4*)(conv_w + 2048 + col + 4);
            float u1[8], u2[8];
#pragma unroll
            for (int i = 0; i < 8; ++i) { u1[i] = 0.f; u2[i] = 0.f; }
            if ((t0 % SEQ) != 0) {
                const v4u c1 = *(const v4u*)(CC + (size_t)(t0 - 1) * 1024 + col), x1v = *(const v4u*)(CX + (size_t)(t0 - 1) * 1024 + col), c2 = *(const v4u*)(CC + (size_t)(t0 - 2) * 1024 + col), x2v = *(const v4u*)(CX + (size_t)(t0 - 2) * 1024 + col);
                u1[0] = bflo(c1.x) * bflo(x1v.x); u1[1] = bfhi(c1.x) * bfhi(x1v.x); u1[2] = bflo(c1.y) * bflo(x1v.y); u1[3] = bfhi(c1.y) * bfhi(x1v.y); u1[4] = bflo(c1.z) * bflo(x1v.z); u1[5] = bfhi(c1.z) * bfhi(x1v.z); u1[6] = bflo(c1.w) * bflo(x1v.w); u1[7] = bfhi(c1.w) * bfhi(x1v.w);
                u2[0] = bflo(c2.x) * bflo(x2v.x); u2[1] = bfhi(c2.x) * bfhi(x2v.x); u2[2] = bflo(c2.y) * bflo(x2v.y); u2[3] = bfhi(c2.y) * bfhi(x2v.y); u2[4] = bflo(c2.z) * bflo(x2v.z); u2[5] = bfhi(c2.z) * bfhi(x2v.z); u2[6] = bflo(c2.w) * bflo(x2v.w); u2[7] = bfhi(c2.w) * bfhi(x2v.w);
            }
            const float w0[8] = {w0a.x, w0a.y, w0a.z, w0a.w, w0b.x, w0b.y, w0b.z, w0b.w}, w1[8] = {w1a.x, w1a.y, w1a.z, w1a.w, w1b.x, w1b.y, w1b.z, w1b.w}, w2[8] = {w2a.x, w2a.y, w2a.z, w2a.w, w2b.x, w2b.y, w2b.z, w2b.w};
#pragma unroll 4
            for (int j = 0; j < 16; ++j) { const size_t ro = (size_t)(t0 + j) * 1024 + col;
                const v4u bv = *(const v4u*)(CB + ro), cv = *(const v4u*)(CC + ro), xv = *(const v4u*)(CX + ro);
                float u0[8], bb[8], y[8];
                u0[0] = bflo(cv.x) * bflo(xv.x); u0[1] = bfhi(cv.x) * bfhi(xv.x); u0[2] = bflo(cv.y) * bflo(xv.y); u0[3] = bfhi(cv.y) * bfhi(xv.y); u0[4] = bflo(cv.z) * bflo(xv.z); u0[5] = bfhi(cv.z) * bfhi(xv.z); u0[6] = bflo(cv.w) * bflo(xv.w); u0[7] = bfhi(cv.w) * bfhi(xv.w);
                bb[0] = bflo(bv.x); bb[1] = bfhi(bv.x); bb[2] = bflo(bv.y); bb[3] = bfhi(bv.y); bb[4] = bflo(bv.z); bb[5] = bfhi(bv.z); bb[6] = bflo(bv.w); bb[7] = bfhi(bv.w);
#pragma unroll
                for (int i = 0; i < 8; ++i) { y[i] = bb[i] * (u2[i] * w0[i] + u1[i] * w1[i] + u0[i] * w2[i]); u2[i] = u1[i]; u1[i] = u0[i]; }
                v4u o; o.x = pk2(y[0], y[1]); o.y = pk2(y[2], y[3]); o.z = pk2(y[4], y[5]); o.w = pk2(y[6], y[7]);
                *(v4u*)(MIX + (size_t)(t0 + j) * 2048 + 1024 + col) = o; }
        }
    }
    SEAM(2);
    if (IN(3)) REPS(3) {
        pg8::Gemm g{MIX, WtOut, T, DM, DM}; pg8::StaticOrder S; S.init(T, DM, G, bx);
        pg8::EpiX1 E{x, out, A2, ffn_g, SSQ, ws + WS_H8};
        pg8::gemm_phase<pg8::EpiX1, pg8::StaticOrder, true, true>(lds, g, S, E);
    }
    SEAM(3);
    if (IN(4)) REPS(4) {
        pg8::Gemm g{A2, WtQ, T, DM, DM}; pg8::StaticOrder S; S.init(T, DM, G, bx);
        pg8::EpiBf16<0> E{QP, DM, nullptr, 0, 0, 1.f};
        pg8::gemm_phase<pg8::EpiBf16<0>, pg8::StaticOrder, true, true>(lds, g, S, E);
    }
    SEAM(4);
    if (IN(5)) REPS(5) {
        if (tid < 64) {
            int n = tid, i = 0;
#pragma unroll 1
            for (; i < 16; ++i) { const int len = 16 / (i + 1); if (n < len) break; n -= len; }
            ((LAS unsigned char*)(lds + P5_TAB_OFF))[tid] = (unsigned char)(i < 16 ? ((i << 4) | n) : 0);
        }
        int cur_h = -1;
        for (int it = vcu; it < (T / 128) * PEH; it += G) { const int h = it & 7;
            if (h != cur_h) {
                __syncthreads();
                for (int i = tid; i < 4096; i += NTHREADS) { const int ch = i & 15, key = (i >> 4) & 127, c = i >> 11;
                    *(LAS v4u*)(lds + c * 32768 + ch * 2048 + key * 16) = *(const v4u*)(SK + (size_t)((h * 2 + c) * 128 + key) * 128 + ch * 8); }
                cur_h = h; __syncthreads(); }
            peer_topk_item(it >> 3, h, QP, SSQ, EIDX, EGATE, RSTD, (LAS char*)lds); }
    }
    SEAM(5);
    if (IN(6)) {
        float* PART = (float*)(ws + WS_PART);
        const int tstride = (G >> 3) * NWAVES, nper = (T + tstride - 1) / tstride;
        peer_u_stage(nper, (bx >> 3) * NWAVES + wave, tstride, bx & 7, ws + WS_H8, U8, EIDX, PART, lane);
    }
    SEAM(6);
    if (IN(7)) {
        const float* PART = (const float*)(ws + WS_PART); unsigned* ACTQ = (unsigned*)(ws + WS_ACT); float* ASC = (float*)(ws + WS_ACT + 4 * MiB);
        const float ustep = RSTD[T] * (1.0f / H8_SCALE), vstep = RSTD[T + 1];
        for (int tp = gw; tp < T / 2; tp += NGW) { const int t = 2 * tp + (lane >> 5), k4 = 4 * (lane & 31);
            f32x4 z = (f32x4){0.f, 0.f, 0.f, 0.f};
#pragma unroll
            for (int s = 0; s < 8; ++s) z += *(const f32x4*)(PART + ((size_t)s * T + t) * 128 + k4);
            z *= RSTD[t] * ustep;
            const f32x4 gt = *(const f32x4*)(EGATE + (size_t)t * 128 + k4);
            f32x4 a; float am = 0.f;
#pragma unroll
            for (int i = 0; i < 4; ++i) { a[i] = 0.5f * z[i] * (1.0f + erff(z[i] * 0.70710678118654752f)) * gt[i]; am = fmaxf(am, fabsf(a[i])); }
#pragma unroll
            for (int o = 1; o < 32; o <<= 1) am = fmaxf(am, __shfl_xor(am, o));
            const float asc = am > 0.f ? am * (1.0f / 127.0f) : 1.0f, inv = 1.0f / asc; unsigned w = 0u;
#pragma unroll
            for (int i = 0; i < 4; ++i) { const int q = (int)__builtin_rintf(a[i] * inv); w |= ((unsigned)q & 0xffu) << (8 * i); }
            ACTQ[(size_t)t * 32 + (lane & 31)] = w;
            if ((lane & 31) == 0) ASC[t] = asc * vstep; }
    }
    SEAM(7);
    if (IN(8)) {
        const unsigned* ACTQ = (const unsigned*)(ws + WS_ACT); const float* ASC = (const float*)(ws + WS_ACT + 4 * MiB);
        const int tstride = (G >> 3) * NWAVES, nper = (T + tstride - 1) / tstride;
        peer_v_stage<0>(nper, (bx >> 3) * NWAVES + wave, tstride, bx & 7, V8, EIDX, ACTQ, ASC, A2, ffn_g, out, lane);
    }
#undef IN
#undef SEAM
}


#ifdef DBG_ABL
__global__ void __launch_bounds__(NTHREADS, 2) attn_probe(Args args) {
    extern __shared__ __attribute__((aligned(16))) unsigned char lds_raw[];
    LAS unsigned char* lds = (LAS unsigned char*)lds_raw;
    const int tid = threadIdx.x, lane = tid & 63; const int G = gridDim.x, bx = blockIdx.x;
    const int vcu = (G % 8 == 0) ? (bx % 8) * (G / 8) + bx / 8 : bx;
    unsigned char* ws = args.ws;
    const float* qg = args.in[3]; const float* kg = args.in[4]; const float* lq1 = args.in[5]; const float* lk1 = args.in[6]; const float* lq2 = args.in[7]; const float* lk2 = args.in[8]; const float* subg = args.in[9];
    bf16* Qb = (bf16*)(ws + WS_Q); bf16* Kb = (bf16*)(ws + WS_K); bf16* Vb = (bf16*)(ws + WS_V); bf16* MIX2 = (bf16*)(ws + 448 * MiB);
    float a = lq1[lane] * lk1[lane], b2 = lq2[lane] * lk2[lane]; a = wave_sum(a); b2 = wave_sum(b2);
    const float lam = expf(a) - expf(b2) + 0.2f; const float mq = wave_max(fabsf(qg[lane])), mk = wave_max(fabsf(kg[lane])); const float M2 = 64.f * C2 * mq * mk;
    for (int v = vcu; v < NB * NH * 4; v += G) { const int bh = v >> 2, s = v & 3, b = bh >> 3, h = bh & 7;
#pragma unroll 1
        for (int i = 0; i < 4; ++i) { const int qblk = (i == 0) ? s : (i == 1) ? 7 - s : (i == 2) ? 8 + s : 15 - s;
            att::attn_unit<DBG_ABL>(b, h, qblk, Qb, Kb, Vb, MIX2, subg, lam, M2, (LAS char*)lds); } }
}
#endif


#ifdef DBG_ABLV
__global__ void __launch_bounds__(NTHREADS, 2) pv_probe(Args args) {
    const int tid = threadIdx.x, lane = tid & 63, wave = __builtin_amdgcn_readfirstlane(tid >> 6); const int G = gridDim.x, bx = blockIdx.x;
    unsigned char* ws = args.ws;
    const unsigned* ACTQ = (const unsigned*)(ws + WS_ACT); const float* ASC = (const float*)(ws + WS_ACT + 4 * MiB);
    const int tstride = (G >> 3) * NWAVES, nper = (T + tstride - 1) / tstride;
    peer_v_stage<DBG_ABLV>(nper, (bx >> 3) * NWAVES + wave, tstride, bx & 7, ws + WS_VT, (const int*)(ws + WS_EIDX), ACTQ, ASC, (const bf16*)(ws + WS_CB), args.in[12], (float*)(ws + WS_PART), lane);
}
#endif

extern "C" void kernel_launch(void* const* d_in, const int* in_sizes, int n_in, void* d_out, int out_size, void* d_ws, size_t ws_size, hipStream_t stream) {
    static int grid = 0;
    if (grid == 0) {
        if (n_in != 17 || out_size != T * DM || ws_size < WS_END) { fprintf(stderr, "kernel_launch: unexpected shapes (n_in %d out %d ws %zu)\n", n_in, out_size, ws_size); grid = -1; return; }
        int dev = 0, cus = 0, per_cu = 0;
        if (hipGetDevice(&dev) != hipSuccess || hipDeviceGetAttribute(&cus, hipDeviceAttributeMultiprocessorCount, dev) != hipSuccess) { grid = -1; return; }
        if (hipFuncSetAttribute((const void*)mk_fwd, hipFuncAttributeMaxDynamicSharedMemorySize, LDS_BYTES) != hipSuccess) { fprintf(stderr, "kernel_launch: hipFuncSetAttribute failed\n"); grid = -1; return; }
        if (hipOccupancyMaxActiveBlocksPerMultiprocessor(&per_cu, (const void*)mk_fwd, NTHREADS, LDS_BYTES) != hipSuccess || per_cu < 1) { fprintf(stderr, "kernel_launch: occupancy query says %d blocks per CU\n", per_cu); (void)hipGetLastError(); grid = -1; return; }
        grid = cus;
    }
    if (grid < 0) return;
    if (hipMemsetAsync((char*)d_ws + WS_CTL, 0, CTL_ZERO_BYTES, stream) != hipSuccess) { fprintf(stderr, "kernel_launch: memset failed\n"); return; }
    Args a{};
    for (int i = 0; i < 17; ++i) a.in[i] = (const float*)d_in[i];
    a.out = (float*)d_out; a.ws = (unsigned char*)d_ws;
#if MK_N_LAUNCHES == 1
    a.ph_lo = 0; a.ph_hi = NPHASE;
    void* kargs[] = {&a};
    hipError_t e = hipLaunchCooperativeKernel((const void*)mk_fwd, dim3(grid), dim3(NTHREADS), kargs, LDS_BYTES, stream);
    if (e != hipSuccess) fprintf(stderr, "kernel_launch: cooperative launch failed: %s (grid %d)\n", hipGetErrorString(e), grid);
#else
#ifndef DBG_DUPL
#define DBG_DUPL -1
#endif
#ifndef DBG_DUPFLAGS
#define DBG_DUPFLAGS 0
#endif
    for (int p = 0; p < NPHASE; ++p) { a.ph_lo = p; for (int r = 0; r < (p == DBG_DUPL ? 2 : 1); ++r) { a.ph_hi = (p + 1) | ((r == 1 ? DBG_DUPFLAGS : 0) << 8); hipLaunchKernelGGL(mk_fwd, dim3(grid), dim3(NTHREADS), LDS_BYTES, stream, a); }
#ifdef DBG_ABLV
        if (p == 8) hipLaunchKernelGGL(pv_probe, dim3(grid), dim3(NTHREADS), 0, stream, a);
#endif
#ifdef DBG_ABL
        if (p == 2 && ws_size >= 512 * MiB) { static bool once = false; if (!once) { once = true; (void)hipFuncSetAttribute((const void*)attn_probe, hipFuncAttributeMaxDynamicSharedMemorySize, LDS_BYTES); } hipLaunchKernelGGL(attn_probe, dim3(grid), dim3(NTHREADS), LDS_BYTES, stream, a); }
#endif
    }
#endif
}
```

```cpp
#include <hip/hip_runtime.h>
#include <hip/hip_cooperative_groups.h>
#include <cstdio>
#include <cstdint>
#include <cmath>
namespace cg = cooperative_groups;
namespace pg8 {
#define PG8_LAS __attribute__((address_space(3)))
typedef unsigned short bf16_t;
typedef short bf16x8 __attribute__((ext_vector_type(8)));
typedef float f32x4 __attribute__((ext_vector_type(4)));
typedef unsigned u32x4 __attribute__((ext_vector_type(4)));
constexpr int BM = 256, BK = 64, HALF = 128, HTB = HALF * BK * 2  , STAGE_BYTES = 8 * HTB, NXCD = 8, WGM = 8;

__host__ __device__ __forceinline__ int lds_byte(int r, int c) { const int st = (r >> 4) * 2 + (c >> 5), rr = r & 15, cc = c & 31, ob = rr * 64 + cc * 2; return st * 1024 + (ob ^ (((ob >> 9) & 1) << 5)); }
__host__ __device__ __forceinline__ void stage_rc(int b, int& R, int& C) { const int st = b / 1024, sb = b % 1024, swz = sb ^ (((sb >> 9) & 1) << 5); R = (st >> 1) * 16 + swz / 64; C = (st & 1) * 32 + (swz % 64) / 2; }
__host__ __device__ __forceinline__ int perm32(int rho) { const int n = rho >> 4, i = rho & 15; return 8 * (i >> 2) + 4 * n + (i & 3); }

struct Unit { int pm, pn; };
struct Gemm { const bf16_t* A; const bf16_t* Bt; int M, N, K; };

struct StaticOrder {
    int nM, nN, nwg, G, c, wgm;
    __host__ __device__ void init(int M, int N, int G_, int c_, int wgm_ = WGM) { nM = M / BM; nN = N / BM; nwg = nM * nN; G = G_; c = c_; wgm = wgm_; }
    __host__ __device__ bool next(int i, Unit& u) const {
        const long L = (long)i * G + c; if (L >= nwg) return false;
        int wgid = (int)L; { const int q = nwg / NXCD, r = nwg % NXCD, xcd = wgid % NXCD, off = wgid / NXCD; wgid = (xcd < r ? xcd * (q + 1) : r * (q + 1) + (xcd - r) * q) + off; }
        const int nig = wgm * nN, gid = wgid / nig, fm = gid * wgm, gsz = (nM - fm) < wgm ? (nM - fm) : wgm;
        u.pm = fm + ((wgid % nig) % gsz); u.pn = (wgid % nig) / gsz; return true;
    }
    __device__ __forceinline__ void a_ready(const Unit&) const {}
    __device__ __forceinline__ void done(const Unit&) const {}
};

__device__ __forceinline__ unsigned cvt_pk_bf16(float lo, float hi) { unsigned r; asm volatile("v_cvt_pk_bf16_f32 %0, %1, %2" : "=v"(r) : "v"(lo), "v"(hi)); return r; }
typedef float f32x2 __attribute__((ext_vector_type(2)));
__device__ __forceinline__ f32x2 gelu_pk(f32x2 v) {
    const f32x2 av = __builtin_elementwise_abs(v), d = av * 0.2316418882f + 1.0f;
    f32x2 t; t.x = __builtin_amdgcn_rcpf(d.x); t.y = __builtin_amdgcn_rcpf(d.y);
    f32x2 q = t * 0.5307027145f + (-0.7265760135f); q = q * t + 0.7107068705f; q = q * t + (-0.142248368f); q = q * t + 0.127414796f; q = q * t;
    const f32x2 s = (v * v) * (-0.72134752044f);
    f32x2 e; e.x = __builtin_amdgcn_exp2f(s.x); e.y = __builtin_amdgcn_exp2f(s.y);
    const f32x2 m = v * (q * e), r = v - m;
    f32x2 o; o.x = v.x < 0.f ? m.x : r.x; o.y = v.y < 0.f ? m.y : r.y; return o;
}

template <int ACT  > struct EpiBf16 {
    static constexpr bool PERM = true, AFTER_DRAIN = false; static_assert(ACT == 0 || ACT == 1, "EpiBf16: ACT is 0 (none) or 1 (gelu_pk)");
    bf16_t* O; int ldc; const float* bias; int split_cols; size_t split_stride; float scale0;
    __device__ __forceinline__ void operator()(const f32x4 (&acc)[2][2][4][2], const Unit& u, int wr, int wc, int fr, int fq) const {
        const int row0 = u.pm * BM + wr * 64 + fr; int colt = u.pn * BM; bf16_t* base = O;
        float sc = 1.f; if (split_cols) { const int t = colt / split_cols; base += (size_t)t * split_stride; colt -= t * split_cols; if (t == 0) sc = scale0; }
        const int col0 = colt + wc * 32 + 8 * fq, bcol0 = u.pn * BM + wc * 32 + 8 * fq;
        f32x4 bv[2][2];
#pragma unroll
        for (int bj = 0; bj < 2; ++bj)
#pragma unroll
            for (int n = 0; n < 2; ++n) bv[bj][n] = bias ? *(const f32x4*)(bias + bcol0 + bj * HALF + 4 * n) : (f32x4){0.f, 0.f, 0.f, 0.f};
#pragma unroll
        for (int ai = 0; ai < 2; ++ai)
#pragma unroll
            for (int m = 0; m < 4; ++m) { bf16_t* rowp = base + (size_t)(row0 + ai * HALF + m * 16) * ldc + col0;
#pragma unroll
                for (int bj = 0; bj < 2; ++bj) { f32x4 v0 = acc[ai][bj][m][0] + bv[bj][0], v1 = acc[ai][bj][m][1] + bv[bj][1];
                    if (ACT == 1) { f32x2 a = gelu_pk((f32x2){v0[0], v0[1]}), b = gelu_pk((f32x2){v0[2], v0[3]}), c = gelu_pk((f32x2){v1[0], v1[1]}), d = gelu_pk((f32x2){v1[2], v1[3]});
                        v0 = (f32x4){a.x, a.y, b.x, b.y}; v1 = (f32x4){c.x, c.y, d.x, d.y}; }
                    v0 = v0 * sc; v1 = v1 * sc; u32x4 w; w.x = cvt_pk_bf16(v0[0], v0[1]); w.y = cvt_pk_bf16(v0[2], v0[3]); w.z = cvt_pk_bf16(v1[0], v1[1]); w.w = cvt_pk_bf16(v1[2], v1[3]);
                    *(u32x4*)(rowp + bj * HALF) = w; } }
    }
};
template <class Epi, class Sched, bool ALIGN_EPI = false, bool SP2 = false>
__device__ __forceinline__ void gemm_phase(PG8_LAS unsigned char* lds, const Gemm g, const Sched& S, const Epi& E) {
    const int tid = threadIdx.x, wid = __builtin_amdgcn_readfirstlane(tid >> 6), lane = tid & 63, wr = wid >> 2, wc = wid & 3, fr = lane & 15, fq = lane >> 4;
    const int K = g.K, nt = K / BK;
    unsigned voffA[2], voffB[2];
#pragma unroll
    for (int i = 0; i < 2; ++i) { int R, C; stage_rc(tid * 16 + i * 8192, R, C); const int Rb = Epi::PERM ? ((R & ~31) + perm32(R & 31)) : R;
        voffA[i] = (unsigned)(R * K + C) * 2u; voffB[i] = (unsigned)(Rb * K + C) * 2u; }
    const size_t kstep = (size_t)(BK * 2);
    const size_t hstep = (size_t)HALF * K * 2;
    const size_t tstep = 2 * hstep;
    const unsigned ldsw = (unsigned)wid * 1024u;
    const int aoff = lds_byte(wr * 64 + fr, fq * 8), boff = lds_byte(wc * 32 + fr, fq * 8);
#define PG8_SA(b, h) (((b) * 2 + (h)) * HTB)
#define PG8_SB(b, h) ((4 + (b) * 2 + (h)) * HTB)
#define PG8_STAGE(bufoff, gbase, voff) do { _Pragma("unroll") for (int _i = 0; _i < 2; ++_i) \
        __builtin_amdgcn_global_load_lds((const unsigned*)((const char*)(gbase) + (voff)[_i]), (PG8_LAS unsigned*)(lds + (bufoff) + ldsw + _i * 8192), 16, 0, 0); } while (0)
#define PG8_LDA(dst, b, h) do { _Pragma("unroll") for (int m = 0; m < 4; ++m) _Pragma("unroll") for (int k = 0; k < 2; ++k) dst[m][k] = *(const PG8_LAS bf16x8*)(lds + PG8_SA(b, h) + aoff + m * 2048 + k * 1024); } while (0)
#define PG8_LDB(dst, b, h) do { _Pragma("unroll") for (int n = 0; n < 2; ++n) _Pragma("unroll") for (int k = 0; k < 2; ++k) dst[n][k] = *(const PG8_LAS bf16x8*)(lds + PG8_SB(b, h) + boff + n * 2048 + k * 1024); } while (0)
#define PG8_MMA(ai, bj, At, Bt) do { __builtin_amdgcn_s_setprio(1); _Pragma("unroll") for (int m = 0; m < 4; ++m) _Pragma("unroll") for (int n = 0; n < 2; ++n) _Pragma("unroll") for (int k = 0; k < 2; ++k) \
        acc[ai][bj][m][n] = __builtin_amdgcn_mfma_f32_16x16x32_bf16(Bt[n][k], At[m][k], acc[ai][bj][m][n], 0, 0, 0); __builtin_amdgcn_s_setprio(0); } while (0)
#define PG8_WAIT_V(n) asm volatile("s_waitcnt vmcnt(" #n ")" ::: "memory")
#define PG8_WAIT_L(n) asm volatile("s_waitcnt lgkmcnt(" #n ")" ::: "memory")
#define PG8_BAR __builtin_amdgcn_s_barrier()
#define PG8_SCHED __builtin_amdgcn_sched_barrier(0)
    Unit cur, nxt; int ui = 0;
    if (!S.next(0, cur)) return;
    f32x4 acc[2][2][4][2];
#pragma unroll
    for (int a = 0; a < 2; ++a)
#pragma unroll
        for (int b = 0; b < 2; ++b)
#pragma unroll
            for (int m = 0; m < 4; ++m)
#pragma unroll
                for (int n = 0; n < 2; ++n) acc[a][b][m][n] = (f32x4){0.f, 0.f, 0.f, 0.f};
    bf16x8 At[4][2], B0[2][2], B1[2][2];
    const char* cA = (const char*)g.A + (size_t)cur.pm * tstep; const char* cB = (const char*)g.Bt + (size_t)cur.pn * tstep;
    S.a_ready(cur);
    if constexpr (SP2) {
        PG8_STAGE(PG8_SB(0, 0), cB, voffB); PG8_STAGE(PG8_SB(0, 1), cB + hstep, voffB); PG8_STAGE(PG8_SA(0, 0), cA, voffA); PG8_STAGE(PG8_SA(0, 1), cA + hstep, voffA);
        if (wr == 1) PG8_BAR;
        PG8_WAIT_V(2); PG8_BAR;
        PG8_STAGE(PG8_SB(1, 0), cB + kstep, voffB); PG8_STAGE(PG8_SA(1, 0), cA + kstep, voffA); PG8_STAGE(PG8_SB(1, 1), cB + hstep + kstep, voffB);
        PG8_WAIT_V(6); PG8_BAR;
    } else {
        PG8_STAGE(PG8_SB(0, 0), cB, voffB); PG8_STAGE(PG8_SA(0, 0), cA, voffA); PG8_STAGE(PG8_SB(0, 1), cB + hstep, voffB); PG8_STAGE(PG8_SA(0, 1), cA + hstep, voffA);
        if (wr == 1) PG8_BAR;
        PG8_WAIT_V(4); PG8_BAR;
        PG8_STAGE(PG8_SB(1, 0), cB + kstep, voffB); PG8_STAGE(PG8_SA(1, 0), cA + kstep, voffA); PG8_STAGE(PG8_SB(1, 1), cB + hstep + kstep, voffB);
        PG8_WAIT_V(6); PG8_BAR;
    }
    for (;;) {
        const bool has_next = S.next(ui + 1, nxt);
        const char* nA = has_next ? (const char*)g.A + (size_t)nxt.pm * tstep : cA; const char* nB = has_next ? (const char*)g.Bt + (size_t)nxt.pn * tstep : cB;
        for (int t = 0; t < nt; t += 2) {
            const bool last = (t == nt - 2);
            const char* a1 = cA + (size_t)(t + 1) * kstep;
            const char* a2 = last ? nA : cA + (size_t)(t + 2) * kstep; const char* b2 = last ? nB : cB + (size_t)(t + 2) * kstep;
            const char* a3 = a2 + kstep; const char* b3 = b2 + kstep;
            if (last && has_next) S.a_ready(nxt);
            if constexpr (SP2) {
            PG8_LDB(B0, 0, 0); PG8_LDB(B1, 0, 1); PG8_SCHED; PG8_LDA(At, 0, 0); PG8_STAGE(PG8_SA(1, 1), a1 + hstep, voffA);
            PG8_WAIT_V(8); PG8_WAIT_L(0); PG8_BAR; PG8_MMA(0, 0, At, B0); PG8_MMA(0, 1, At, B1); PG8_BAR; PG8_SCHED;
            PG8_LDA(At, 0, 1); PG8_STAGE(PG8_SB(0, 0), b2, voffB); PG8_STAGE(PG8_SB(0, 1), b2 + hstep, voffB); PG8_STAGE(PG8_SA(0, 0), a2, voffA);
            PG8_WAIT_V(8); PG8_WAIT_L(0); PG8_BAR; PG8_MMA(1, 0, At, B0); PG8_MMA(1, 1, At, B1); PG8_BAR; PG8_SCHED;
            PG8_LDB(B0, 1, 0); PG8_LDB(B1, 1, 1); PG8_SCHED; PG8_LDA(At, 1, 0); PG8_STAGE(PG8_SA(0, 1), a2 + hstep, voffA);
            PG8_WAIT_V(8); PG8_WAIT_L(0); PG8_BAR; PG8_MMA(0, 0, At, B0); PG8_MMA(0, 1, At, B1); PG8_BAR; PG8_SCHED;
            PG8_LDA(At, 1, 1); PG8_STAGE(PG8_SB(1, 0), b3, voffB); PG8_STAGE(PG8_SB(1, 1), b3 + hstep, voffB); PG8_STAGE(PG8_SA(1, 0), a3, voffA);
            PG8_WAIT_V(8); PG8_WAIT_L(0); PG8_BAR; PG8_MMA(1, 0, At, B0); PG8_MMA(1, 1, At, B1); PG8_BAR; PG8_SCHED;
            } else {
            PG8_LDB(B0, 0, 0); PG8_SCHED; PG8_LDA(At, 0, 0); PG8_STAGE(PG8_SA(1, 1), a1 + hstep, voffA);
            PG8_WAIT_L(8); PG8_BAR; PG8_WAIT_L(0); PG8_MMA(0, 0, At, B0); PG8_BAR; PG8_SCHED;
            PG8_LDB(B1, 0, 1); PG8_STAGE(PG8_SB(0, 0), b2, voffB);
            PG8_BAR; PG8_WAIT_L(0); PG8_MMA(0, 1, At, B1); PG8_BAR;
            PG8_LDA(At, 0, 1); PG8_STAGE(PG8_SA(0, 0), a2, voffA);
            PG8_BAR; PG8_WAIT_L(0); PG8_MMA(1, 0, At, B0); PG8_BAR; PG8_SCHED;
            PG8_STAGE(PG8_SB(0, 1), b2 + hstep, voffB);
            PG8_WAIT_V(6); PG8_BAR; PG8_MMA(1, 1, At, B1); PG8_BAR;
            PG8_LDB(B0, 1, 0); PG8_SCHED; PG8_LDA(At, 1, 0); PG8_STAGE(PG8_SA(0, 1), a2 + hstep, voffA);
            PG8_WAIT_L(8); PG8_BAR; PG8_WAIT_L(0); PG8_MMA(0, 0, At, B0); PG8_BAR; PG8_SCHED;
            PG8_LDB(B1, 1, 1); PG8_STAGE(PG8_SB(1, 0), b3, voffB);
            PG8_BAR; PG8_WAIT_L(0); PG8_MMA(0, 1, At, B1); PG8_BAR;
            PG8_LDA(At, 1, 1); PG8_STAGE(PG8_SA(1, 0), a3, voffA);
            PG8_BAR; PG8_WAIT_L(0); PG8_MMA(1, 0, At, B0); PG8_BAR; PG8_SCHED;
            PG8_STAGE(PG8_SB(1, 1), b3 + hstep, voffB);
            PG8_WAIT_V(6); PG8_BAR; PG8_MMA(1, 1, At, B1); PG8_BAR;
            }
        }
        if constexpr (ALIGN_EPI) { if (wr == 0) PG8_BAR; }
        if constexpr (!Epi::AFTER_DRAIN) { E(acc, cur, wr, wc, fr, fq); S.done(cur); }
        if (!has_next) break;
#pragma unroll
        for (int a = 0; a < 2; ++a)
#pragma unroll
            for (int b = 0; b < 2; ++b)
#pragma unroll
                for (int m = 0; m < 4; ++m)
#pragma unroll
                    for (int n = 0; n < 2; ++n) acc[a][b][m][n] = (f32x4){0.f, 0.f, 0.f, 0.f};
        cur = nxt; cA = nA; cB = nB; ++ui;
        if constexpr (ALIGN_EPI) { if (wr == 1) PG8_BAR; }
    }
    PG8_WAIT_V(0);
    if constexpr (!ALIGN_EPI) { if (wr == 0) PG8_BAR; }
    PG8_BAR;
    if constexpr (Epi::AFTER_DRAIN) { E.fused(acc, cur, wr, wc, fr, fq, lds, wid, lane); S.done(cur); }
#undef PG8_SA
#undef PG8_SB
#undef PG8_STAGE
#undef PG8_LDA
#undef PG8_LDB
#undef PG8_MMA
#undef PG8_WAIT_V
#undef PG8_WAIT_L
#undef PG8_BAR
#undef PG8_SCHED
}
}
#define MK_N_LAUNCHES 1
#ifndef MK_N_LAUNCHES
#define MK_N_LAUNCHES 1
#endif
constexpr int DM = 2048, NB = 8, SEQ = 2048, T = NB * SEQ;
constexpr int AW = 1024, NH = 8, HD = 64, VD = 128, INC = 6144;
constexpr int PNK = 128, PTOPK = 16, PEH = 8, EPT = PEH * PTOPK;
constexpr float EPS = 1e-6f;
constexpr float C2 = 0.125f * 1.4426950408889634f;
constexpr int NPHASE = 9;
#ifndef WGM_P1
#define WGM_P1 16
#endif
#ifndef WGM_P3
#define WGM_P3 4
#endif
constexpr float U8_SCALE = 1024.f, V8_SCALE = 16.f, H8_SCALE = 16.f;
constexpr size_t MiB = 1u << 20;
constexpr size_t WS_WIN = 1 * MiB, WS_WOUT = 25 * MiB, WS_WQ = 33 * MiB, WS_SK = 41 * MiB, WS_SSQ = 42 * MiB, WS_EIDX = 44 * MiB, WS_EGATE = 52 * MiB, WS_RSTD = 60 * MiB;
constexpr size_t WS_XN = 64 * MiB;
constexpr size_t WS_Q = 128 * MiB, WS_K = 160 * MiB, WS_V = 192 * MiB;
constexpr size_t WS_CB = 224 * MiB, WS_CC = 256 * MiB, WS_CX = 288 * MiB;
constexpr size_t WS_UT = 320 * MiB, WS_VT = 384 * MiB, WS_END = 448 * MiB;
constexpr size_t WS_CTL = 0; constexpr int CW_BAR = 1024, CTL_ZERO_BYTES = 65536;
constexpr size_t WS_H8 = 288 * MiB;
constexpr size_t WS_PART = 64 * MiB, WS_ACT = 192 * MiB;
constexpr int MISC_OFF = 143360;
constexpr int LDS_BYTES = 147456;
constexpr int NWAVES = 8, NTHREADS = 512;

#define LAS __attribute__((address_space(3)))
typedef unsigned short bf16;
typedef unsigned v4u __attribute__((ext_vector_type(4)));
typedef unsigned v2u __attribute__((ext_vector_type(2)));
typedef float f32x4 __attribute__((ext_vector_type(4)));
typedef float f32x2 __attribute__((ext_vector_type(2)));
typedef float f32x16 __attribute__((ext_vector_type(16)));
typedef short bf16x8 __attribute__((ext_vector_type(8)));
typedef short s16x4 __attribute__((ext_vector_type(4)));
typedef __bf16 bf16x2_t __attribute__((ext_vector_type(2)));
#define LDS_WAIT() asm volatile("s_waitcnt lgkmcnt(0)" ::: "memory")
__device__ __forceinline__ unsigned pk2(float lo, float hi) { f32x2 v = {lo, hi}; bf16x2_t b = __builtin_convertvector(v, bf16x2_t); return __builtin_bit_cast(unsigned, b); }
__device__ __forceinline__ float bflo(unsigned u) { return __uint_as_float(u << 16); }
__device__ __forceinline__ float bfhi(unsigned u) { return __uint_as_float(u & 0xffff0000u); }
__device__ __forceinline__ float wave_sum(float v) {
#pragma unroll
    for (int o = 1; o < 64; o <<= 1) v += __shfl_xor(v, o);
    return v;
}
__device__ __forceinline__ float wave_max(float v) {
#pragma unroll
    for (int o = 1; o < 64; o <<= 1) v = fmaxf(v, __shfl_xor(v, o));
    return v;
}

#define XB_TMO      128
#define XB_XCNT(j)  (256  + 64 * (j))
#define XB_XSUB(j)  (1280 + 64 * (j))
#define XB_XGEN(j)  (2304 + 64 * (j))
#define XB_TOP      3328
#define XB_TOPGEN   3392
#define XCD_BAR_WORDS 3456
#define XB_SPIN_CAP (1u << 18)

__device__ __forceinline__ unsigned xb_ld(unsigned* p)              { return __hip_atomic_load(p, __ATOMIC_RELAXED, __HIP_MEMORY_SCOPE_AGENT); }
__device__ __forceinline__ unsigned xb_add(unsigned* p, unsigned v) { return __hip_atomic_fetch_add(p, v, __ATOMIC_RELAXED, __HIP_MEMORY_SCOPE_AGENT); }
__device__ __forceinline__ unsigned xb_xcc_id() { return (unsigned)__builtin_amdgcn_s_getreg((3 << 11) | 20) & 0xFu; }
#define XB_SPIN(cond, bar) do { unsigned _sp = 0; while (cond) { __builtin_amdgcn_s_sleep(1); \
    if ((++_sp & 255u) == 0u) { if (xb_ld(&(bar)[XB_TMO])) break; if (_sp > XB_SPIN_CAP) { atomicAdd(&(bar)[XB_TMO], 1u); break; } } } } while (0)

struct XcdBarrier {
    unsigned* bar; unsigned x;
    volatile LAS unsigned* st;
};

__device__ __forceinline__ XcdBarrier xcd_barrier_post(unsigned* bar, volatile LAS unsigned* st) {
    XcdBarrier b; b.bar = bar; b.x = xb_xcc_id(); b.st = st;
    if (threadIdx.x == 0) (void)xb_add(&bar[XB_XCNT(b.x)], 1u);
    return b;
}
__device__ __forceinline__ void xcd_barrier_complete(unsigned* bar, unsigned x, unsigned& nloc, unsigned& nx) {
    const unsigned G = gridDim.x * gridDim.y * gridDim.z;
    unsigned sum, cnt, mine, sp = 0u;
    for (;;) {
        sum = 0u; cnt = 0u; mine = 0u;
#pragma unroll
        for (unsigned j = 0; j < 16; ++j) { const unsigned c = xb_ld(&bar[XB_XCNT(j)]); sum += c; cnt += (c > 0u) ? 1u : 0u; mine = (j == x) ? c : mine; }
        if (sum == G) break;
        __builtin_amdgcn_s_sleep(1);
        if ((++sp & 255u) == 0u) { if (xb_ld(&bar[XB_TMO])) break; if (sp > XB_SPIN_CAP) { atomicAdd(&bar[XB_TMO], 1u); break; } }
    }
    nloc = mine > 0u ? mine : 1u; nx = cnt > 0u ? cnt : 1u;
}

__device__ __forceinline__ void xcd_barrier(const XcdBarrier& b) {
    asm volatile("s_waitcnt vmcnt(0)" ::: "memory");
    __syncthreads();
    if (threadIdx.x == 0) {
        unsigned* bar = b.bar;
        __builtin_amdgcn_s_waitcnt(0);
        unsigned nloc = b.st[0], nx = b.st[1];
        if (nloc == 0u) { xcd_barrier_complete(bar, b.x, nloc, nx); b.st[0] = nloc; b.st[1] = nx; }
        const unsigned old = xb_add(&bar[XB_XSUB(b.x)], 1u);
        const unsigned gen = old / nloc;
        if (old + 1u == (gen + 1u) * nloc) {
            __builtin_amdgcn_fence(__ATOMIC_RELEASE, "agent");
            asm volatile("s_waitcnt vmcnt(0)" ::: "memory");
            const unsigned og = xb_add(&bar[XB_TOP], 1u);
            const unsigned tg = og / nx;
            if (og + 1u == (tg + 1u) * nx) xb_add(&bar[XB_TOPGEN], 1u);
            else XB_SPIN(xb_ld(&bar[XB_TOPGEN]) == tg, bar);
            __builtin_amdgcn_fence(__ATOMIC_ACQUIRE, "agent");
            xb_add(&bar[XB_XGEN(b.x)], 1u);
            asm volatile("s_waitcnt vmcnt(0)" ::: "memory");
        } else {
            XB_SPIN(xb_ld(&bar[XB_XGEN(b.x)]) == gen, bar);
            __builtin_amdgcn_fence(__ATOMIC_ACQUIRE, "agent");
            asm volatile("s_waitcnt vmcnt(0)" ::: "memory");
        }
    }
    __syncthreads();
}


namespace pg8 {
struct EpiProj {
    static constexpr bool PERM = true, AFTER_DRAIN = false;
    bf16_t* base0; const float* qg; const float* kg;
    __device__ __forceinline__ void operator()(const f32x4 (&acc)[2][2][4][2], const Unit& u, int wr, int wc, int fr, int fq) const {
        const int region = u.pn >> 2;
        bf16_t* O = base0 + (size_t)region * (16u << 20);
        const int row0 = u.pm * BM + wr * 64 + fr, col0 = (u.pn & 3) * 256 + wc * 64 + 8 * fq;
        if (region < 2) {
            const float* g = region == 0 ? qg : kg; const float sc = region == 0 ? 0.125f * 1.4426950408889634f : 1.0f;
            f32x4 gv[2][2];
#pragma unroll
            for (int bj = 0; bj < 2; ++bj)
#pragma unroll
                for (int n = 0; n < 2; ++n) gv[bj][n] = *(const f32x4*)(g + bj * 32 + 8 * fq + 4 * n) * sc;
#pragma unroll
            for (int ai = 0; ai < 2; ++ai)
#pragma unroll
                for (int m = 0; m < 4; ++m) {
                    float ss = 0.f;
#pragma unroll
                    for (int bj = 0; bj < 2; ++bj)
#pragma unroll
                        for (int n = 0; n < 2; ++n) { const f32x4 x = acc[ai][bj][m][n]; ss += (x[0] * x[0] + x[1] * x[1]) + (x[2] * x[2] + x[3] * x[3]); }
                    ss += __shfl_xor(ss, 16); ss += __shfl_xor(ss, 32);
                    const float rs = __builtin_amdgcn_rsqf(ss * (1.0f / 64.0f) + 1e-6f);
                    bf16_t* rowp = O + (size_t)(row0 + ai * HALF + m * 16) * 1024 + col0;
#pragma unroll
                    for (int bj = 0; bj < 2; ++bj) { const f32x4 v0 = acc[ai][bj][m][0] * rs * gv[bj][0], v1 = acc[ai][bj][m][1] * rs * gv[bj][1];
                        u32x4 w; w.x = cvt_pk_bf16(v0[0], v0[1]); w.y = cvt_pk_bf16(v0[2], v0[3]); w.z = cvt_pk_bf16(v1[0], v1[1]); w.w = cvt_pk_bf16(v1[2], v1[3]);
                        *(u32x4*)(rowp + bj * 32) = w; }
                }
        } else {
#pragma unroll
            for (int ai = 0; ai < 2; ++ai)
#pragma unroll
                for (int m = 0; m < 4; ++m) { bf16_t* rowp = O + (size_t)(row0 + ai * HALF + m * 16) * 1024 + col0;
#pragma unroll
                    for (int bj = 0; bj < 2; ++bj) { const f32x4 v0 = acc[ai][bj][m][0], v1 = acc[ai][bj][m][1];
                        u32x4 w; w.x = cvt_pk_bf16(v0[0], v0[1]); w.y = cvt_pk_bf16(v0[2], v0[3]); w.z = cvt_pk_bf16(v1[0], v1[1]); w.w = cvt_pk_bf16(v1[2], v1[3]);
                        *(u32x4*)(rowp + bj * 32) = w; } }
        }
    }
};
struct EpiX1 {
    static constexpr bool PERM = true, AFTER_DRAIN = false;
    const float* x; float* out; bf16_t* a2; const float* gf; float* ssq; unsigned char* h8;
    __device__ __forceinline__ void operator()(const f32x4 (&acc)[2][2][4][2], const Unit& u, int wr, int wc, int fr, int fq) const {
        const int row0 = u.pm * BM + wr * 64 + fr, col0 = u.pn * BM + wc * 32 + 8 * fq;
        f32x4 gv[2][2];
#pragma unroll
        for (int bj = 0; bj < 2; ++bj)
#pragma unroll
            for (int n = 0; n < 2; ++n) gv[bj][n] = *(const f32x4*)(gf + col0 + bj * HALF + 4 * n);
#pragma unroll
        for (int ai = 0; ai < 2; ++ai)
#pragma unroll
            for (int m = 0; m < 4; ++m) { const int row = row0 + ai * HALF + m * 16; const size_t off = (size_t)row * 2048 + col0; float ss = 0.f;
#pragma unroll
                for (int bj = 0; bj < 2; ++bj) {
                    const f32x4 x0 = *(const f32x4*)(x + off + bj * HALF), x1 = *(const f32x4*)(x + off + bj * HALF + 4);
                    const f32x4 v0 = x0 + acc[ai][bj][m][0], v1 = x1 + acc[ai][bj][m][1];
                    ss += (v0[0] * v0[0] + v0[1] * v0[1]) + (v0[2] * v0[2] + v0[3] * v0[3]); ss += (v1[0] * v1[0] + v1[1] * v1[1]) + (v1[2] * v1[2] + v1[3] * v1[3]);
                    const f32x4 a0 = v0 * gv[bj][0], a1 = v1 * gv[bj][1];
                    u32x4 w; w.x = cvt_pk_bf16(a0[0], a0[1]); w.y = cvt_pk_bf16(a0[2], a0[3]); w.z = cvt_pk_bf16(a1[0], a1[1]); w.w = cvt_pk_bf16(a1[2], a1[3]);
                    *(u32x4*)(a2 + off + bj * HALF) = w;
                    { const f32x4 b0 = a0 * 16.0f, b1 = a1 * 16.0f; unsigned p = 0u, q2 = 0u;
#pragma unroll
                      for (int e_ = 0; e_ < 4; ++e_) { const int i0_ = __builtin_amdgcn_fmed3f(__builtin_rintf(b0[e_]), -127.f, 127.f), i1_ = __builtin_amdgcn_fmed3f(__builtin_rintf(b1[e_]), -127.f, 127.f);
                          p |= ((unsigned)i0_ & 0xffu) << (8 * e_); q2 |= ((unsigned)i1_ & 0xffu) << (8 * e_); }
                      typedef unsigned u32x2_ __attribute__((ext_vector_type(2))); *(u32x2_*)(h8 + off + bj * HALF) = (u32x2_){p, q2}; } }
                ss += __shfl_xor(ss, 16); ss += __shfl_xor(ss, 32);
                if (fq == 0) ssq[(size_t)row * 32 + u.pn * 4 + wc] = ss; }
    }
};
}

__device__ __forceinline__ void p0_transpose_item(const float* W, int K, int N, bf16* WT, LAS float* scr, int item, int lane, bool permg) {
    const int nblk = N / 32, kb = item / nblk, nb = item % nblk, k0 = 64 * kb, n0 = 32 * nb;
#pragma unroll 8
    for (int i = 0; i < 32; ++i) { const int kk = 2 * i + (lane >> 5); scr[kk * 33 + (lane & 31)] = W[(size_t)(k0 + kk) * N + n0 + (lane & 31)]; }
    LDS_WAIT(); asm volatile("" ::: "memory");
    int nd = n0; if (permg) { const int gl = (n0 & 255) >> 5; nd = (n0 & ~255) + 32 * (4 * (gl & 1) + (gl >> 1)); }
    const int c = lane & 7;
#pragma unroll
    for (int j = 0; j < 4; ++j) { const int n = (lane >> 3) + 8 * j; const LAS float* s = scr + (8 * c) * 33 + n;
        v4u o; o.x = pk2(s[0 * 33], s[1 * 33]); o.y = pk2(s[2 * 33], s[3 * 33]); o.z = pk2(s[4 * 33], s[5 * 33]); o.w = pk2(s[6 * 33], s[7 * 33]);
        *(v4u*)(WT + (size_t)(nd + n) * K + k0 + 8 * c) = o; }
    LDS_WAIT(); asm volatile("" ::: "memory");
}
__device__ __forceinline__ void rms_row_to_bf16(const float* xrow, const float* g, bf16* orow, int lane) {
    const f32x4* xr = (const f32x4*)xrow + lane; const f32x4* gr = (const f32x4*)g + lane;
    f32x4 v[8]; float s = 0.f;
#pragma unroll
    for (int j = 0; j < 8; ++j) { v[j] = xr[64 * j]; s += (v[j].x * v[j].x + v[j].y * v[j].y) + (v[j].z * v[j].z + v[j].w * v[j].w); }
    const float rstd = 1.0f / sqrtf(wave_sum(s) * (1.f / DM) + EPS);
    v2u* o8 = (v2u*)orow + lane;
#pragma unroll
    for (int j = 0; j < 8; ++j) { const f32x4 gg = gr[64 * j]; v2u w; w.x = pk2(v[j].x * rstd * gg.x, v[j].y * rstd * gg.y); w.y = pk2(v[j].z * rstd * gg.z, v[j].w * rstd * gg.w); o8[64 * j] = w; }
}
__device__ __forceinline__ void cvt_bf16_stream(const float* src, bf16* dst, size_t n8, size_t gtid, size_t nthr) {
    for (size_t i = gtid; i < n8; i += nthr) { const f32x4 a = *(const f32x4*)(src + i * 8), b = *(const f32x4*)(src + i * 8 + 4);
        v4u o; o.x = pk2(a.x, a.y); o.y = pk2(a.z, a.w); o.z = pk2(b.x, b.y); o.w = pk2(b.z, b.w); *(v4u*)(dst + i * 8) = o; }
}

__device__ __forceinline__ void cvt_i4_slices(const float* src, unsigned char* dst, float inv_step, size_t gtid, size_t nthr) {
    for (size_t i = gtid; i < (size_t)16384 * 64; i += nthr) { v4u o; const size_t e = i >> 6; const int c32 = (int)(i & 63), s = c32 >> 3, sub = c32 & 7;
#pragma unroll
        for (int w = 0; w < 4; ++w) { const f32x4 a = *(const f32x4*)(src + i * 32 + 8 * w) * inv_step, b = *(const f32x4*)(src + i * 32 + 8 * w + 4) * inv_step; unsigned d = 0u;
#pragma unroll
            for (int e_ = 0; e_ < 4; ++e_) { const int lo = (int)__builtin_amdgcn_fmed3f(__builtin_rintf(a[e_]), -8.f, 7.f) + 8, hi = (int)__builtin_amdgcn_fmed3f(__builtin_rintf(b[e_]), -8.f, 7.f) & 15; d |= ((unsigned)lo | ((unsigned)hi << 4)) << (8 * e_); }
            if (w == 0) o.x = d; else if (w == 1) o.y = d; else if (w == 2) o.z = d; else o.w = d; }
        *(v4u*)(dst + ((size_t)s * 16384 + e) * 128 + 16 * sub) = o; }
}
__device__ __forceinline__ float table_std16(const float* src, LAS float* scr, int tid) {
    float s = 0.f;
#pragma unroll
    for (int j = 0; j < 16; ++j) { const f32x4 v = *(const f32x4*)(src + (size_t)(j * 512 + tid) * 4); s += (v.x * v.x + v.y * v.y) + (v.z * v.z + v.w * v.w); }
    s = wave_sum(s);
    __syncthreads();
    if ((tid & 63) == 0) scr[tid >> 6] = s;
    __syncthreads();
    float t = 0.f;
#pragma unroll
    for (int w = 0; w < 8; ++w) t += scr[w];
    __syncthreads();
    return sqrtf(t * (1.0f / 32768.0f));
}
__device__ __forceinline__ void cvt_i8_slices(const float* src, unsigned char* dst, float scale, size_t gtid, size_t nthr) {
    for (size_t i = gtid; i < (size_t)16384 * 128; i += nthr) { v4u o; const size_t e = i >> 7; const int c16 = (int)(i & 127), s = c16 >> 3, sub = c16 & 7;
#pragma unroll
        for (int q = 0; q < 4; ++q) { const f32x4 a = *(const f32x4*)(src + i * 16 + 4 * q) * scale; unsigned w = 0u;
#pragma unroll
            for (int e_ = 0; e_ < 4; ++e_) { const int iv = (int)__builtin_amdgcn_fmed3f(__builtin_rintf(a[e_]), -127.f, 127.f); w |= ((unsigned)iv & 0xffu) << (8 * e_); }
            if (q == 0) o.x = w; else if (q == 1) o.y = w; else if (q == 2) o.z = w; else o.w = w; }
        *(v4u*)(dst + ((size_t)s * 16384 + e) * 128 + 16 * sub) = o; }
}
__device__ __forceinline__ void cvt_fp8_slices(const float* src, unsigned char* dst, float scale, size_t gtid, size_t nthr) {
    for (size_t i = gtid; i < (size_t)16384 * 128; i += nthr) { v4u o; const size_t e = i >> 7; const int c16 = (int)(i & 127), s = c16 >> 3, sub = c16 & 7;
#pragma unroll
        for (int q = 0; q < 4; ++q) { const f32x4 a = *(const f32x4*)(src + i * 16 + 4 * q) * scale; int w = __builtin_amdgcn_cvt_pk_fp8_f32(a.x, a.y, 0, false); w = __builtin_amdgcn_cvt_pk_fp8_f32(a.z, a.w, w, true);
            if (q == 0) o.x = (unsigned)w; else if (q == 1) o.y = (unsigned)w; else if (q == 2) o.z = (unsigned)w; else o.w = (unsigned)w; }
        *(v4u*)(dst + ((size_t)s * 16384 + e) * 128 + 16 * sub) = o; }
}

namespace att {
constexpr int SLOTB = 32768;
constexpr int NSLOT = 3, LW_OFF = NSLOT * SLOTB;
constexpr int XSTR = 132;
__device__ __forceinline__ void glds16(const void* gsrc, unsigned lds_dst) { unsigned keep;
    asm volatile("s_mov_b32 %0, m0\n\ts_mov_b32 m0, %2\n\ts_nop 0\n\tglobal_load_lds_dwordx4 %1, off\n\ts_mov_b32 m0, %0" : "=&s"(keep) : "v"(gsrc), "s"(lds_dst) : "memory"); }
__device__ __forceinline__ int crow(int r, int hi) { return (r & 3) + 8 * (r >> 2) + 4 * hi; }
typedef short v4i16_t __attribute__((ext_vector_type(4)));
__device__ __forceinline__ s16x4 vtr(const LAS char* p) { return __builtin_bit_cast(s16x4, __builtin_amdgcn_ds_read_tr16_b64_v4i16((LAS v4i16_t*)p)); }
#define ATT_WAIT_BAR(N) asm volatile("s_waitcnt vmcnt(" #N ") lgkmcnt(0)\n\ts_barrier" ::: "memory")
#define ATT_BAR() asm volatile("s_waitcnt lgkmcnt(0)\n\ts_barrier" ::: "memory")

template <int ABL> __device__ __forceinline__ void attn_unit(int b, int h, int qblk, const bf16* Q, const bf16* K, const bf16* V, bf16* MIX, const float* subg, float lam, float M2, LAS char* lds) {
    const int tid = threadIdx.x, lane = tid & 63, r32 = lane & 31, hi = lane >> 5, wid = __builtin_amdgcn_readfirstlane(tid >> 6), c = wid >> 2, qs = wid & 3;
    const size_t rowbase = (size_t)b * SEQ; const int q0 = qblk * 128, NT = 2 * (qblk + 1);
    const unsigned lds0 = (unsigned)(uintptr_t)lds;
    const bf16* ksrc[2]; const bf16* vsrc[2]; unsigned kdst[2], vdst[2];
#pragma unroll
    for (int i = 0; i < 2; ++i) { const int pk = 2 * wid + i, rr = lane >> 4, p = lane & 15, r = 4 * pk + rr;
        ksrc[i] = K + (rowbase + r) * 1024 + h * 128 + ((p ^ (r & 15)) * 8); kdst[i] = lds0 + pk * 1024;
        vsrc[i] = V + (rowbase + r) * 1024 + h * 128 + ((p ^ (rr << 2)) * 8); vdst[i] = lds0 + 16384 + pk * 1024; }
#define ATT_DMA(t, slot) do { _Pragma("unroll") for (int i_ = 0; i_ < 2; ++i_) { glds16(ksrc[i_] + (size_t)(t) * 64 * 1024, (unsigned)__builtin_amdgcn_readfirstlane(kdst[i_] + (slot) * SLOTB)); \
        glds16(vsrc[i_] + (size_t)(t) * 64 * 1024, (unsigned)__builtin_amdgcn_readfirstlane(vdst[i_] + (slot) * SLOTB)); } } while (0)
    ATT_DMA(0, 0); ATT_DMA(1, 1);
    const int qrow = q0 + 32 * qs + r32;
    bf16x8 qr[4];
#pragma unroll
    for (int d0 = 0; d0 < 4; ++d0) qr[d0] = *(const bf16x8*)(Q + (rowbase + qrow) * 1024 + h * 128 + c * 64 + d0 * 16 + hi * 8);
    asm volatile("" : "+v"(qr[0]), "+v"(qr[1]), "+v"(qr[2]), "+v"(qr[3]));
    const float slope2 = exp2f(-(float)(h + 1)) * 1.4426950408889634f;
    float base = -slope2 * (float)(qrow - 4 * hi) - M2;
    const float s32 = 32.f * slope2, s64 = 64.f * slope2;
    f32x16 o[4]; o[0] = f32x16{}; o[1] = f32x16{}; o[2] = f32x16{}; o[3] = f32x16{};
    float lsum = 0.f;
    int kofs[4], vofs[4];
    { const int q4 = (lane & 15) >> 2, p4 = lane & 3, gb = (lane >> 4) & 1;
#pragma unroll
      for (int d0 = 0; d0 < 4; ++d0) { kofs[d0] = r32 * 256 + (((8 * c + 2 * d0 + hi) ^ (r32 & 15)) << 4); vofs[d0] = 16384 + (4 * hi + q4) * 256 + (((((d0 ^ q4) << 2) | (gb << 1) | (p4 >> 1))) << 4) + (p4 & 1) * 8; } }
    const LAS char* lbase = (const LAS char*)lds;
    const int qw0 = q0 + 32 * qs;
#define ATT_PW(ks_) __builtin_bit_cast(bf16x8, ((v4u){pwd[4 * (ks_)], pwd[4 * (ks_) + 1], pwd[4 * (ks_) + 2], pwd[4 * (ks_) + 3]}))
#define ATT_VF(F, d_) ((bf16x8){F[2 * (d_)][0], F[2 * (d_)][1], F[2 * (d_)][2], F[2 * (d_)][3], F[2 * (d_) + 1][0], F[2 * (d_) + 1][1], F[2 * (d_) + 1][2], F[2 * (d_) + 1][3]})
#define ATT_VLDK(F, ks_) do { if (ABL & 16) { _Pragma("unroll") for (int d_ = 0; d_ < 8; ++d_) F[d_] = (s16x4){0, 0, 0, 0}; } else { _Pragma("unroll") for (int d_ = 0; d_ < 4; ++d_) { F[2 * d_] = vtr(sp_ + vofs[d_] + (ks_) * 4096); F[2 * d_ + 1] = vtr(sp_ + vofs[d_] + (ks_) * 4096 + 2048); } } } while (0)
#define ATT_MF(acc_, a_, b_) do { if (ABL & 2) { bf16x8 a__ = (a_), b__ = (b_); asm volatile("" :: "v"(a__), "v"(b__)); } else acc_ = __builtin_amdgcn_mfma_f32_32x32x16_bf16((a_), (b_), acc_, 0, 0, 0); } while (0)
#define ATT_PVK(F, ks_) do { _Pragma("unroll") for (int d_ = 0; d_ < 4; ++d_) ATT_MF(o[d_], ATT_PW(ks_), ATT_VF(F, d_)); } while (0)
#define ATT_SB() __builtin_amdgcn_sched_barrier(0)
    int slot = 0;
    for (int t = 0; t < NT; ++t) {
        if ((ABL & 64) && t > 0) { } else if (t == 0 || (ABL & 8)) { ATT_WAIT_BAR(0); } else if (t + 1 < NT) { ATT_WAIT_BAR(4); } else { ATT_WAIT_BAR(0); }
        if (!(ABL & 8) && t + 2 < NT) { const int s2_ = (slot == 0) ? 2 : slot - 1; ATT_DMA(t + 2, s2_); }
        const int k0 = 64 * t;
        if (k0 <= qw0 + 31) {
            const LAS char* sp_ = lbase + slot * SLOTB;
            f32x16 p0, p1; s16x4 fa[8], fb[8]; unsigned pwd[16];
#pragma unroll
            for (int r = 0; r < 16; ++r) { p0[r] = __builtin_fmaf(slope2, (float)((r & 3) + 8 * (r >> 2)), base); p1[r] = p0[r] + s32; }
            const bool diag = k0 + 63 > qw0;
            const int dq = qrow - k0;
            {
                float sA = 0.f, sB = 0.f, sC = 0.f, sD = 0.f; float e0[16], e1[16];
                __builtin_amdgcn_s_setprio(1);
#pragma unroll
                for (int d0 = 0; d0 < 4; ++d0) { const bf16x8 ka = *(const LAS bf16x8*)(sp_ + kofs[d0]); if (ABL & 4) { asm volatile("" :: "v"(ka)); } else p0 = __builtin_amdgcn_mfma_f32_32x32x16_bf16(ka, qr[d0], p0, 0, 0, 0); }
                ATT_VLDK(fa, 0); ATT_SB();
#pragma unroll
                for (int d0 = 0; d0 < 4; ++d0) { const bf16x8 kb = *(const LAS bf16x8*)(sp_ + kofs[d0] + 8192); if (ABL & 4) { asm volatile("" :: "v"(kb)); } else p1 = __builtin_amdgcn_mfma_f32_32x32x16_bf16(kb, qr[d0], p1, 0, 0, 0);
#pragma unroll
                    for (int i = 0; i < 4; ++i) e0[4 * d0 + i] = (ABL & 1) ? p0[4 * d0 + i] : __builtin_amdgcn_exp2f(p0[4 * d0 + i]);
                    if (diag) {
#pragma unroll
                        for (int i = 0; i < 4; ++i) if (crow(4 * d0 + i, hi) > dq) e0[4 * d0 + i] = 0.f; }
                    sA += e0[4 * d0]; sB += e0[4 * d0 + 1]; sC += e0[4 * d0 + 2]; sD += e0[4 * d0 + 3]; ATT_SB(); }
                ATT_VLDK(fb, 1);
#pragma unroll
                for (int j = 0; j < 8; ++j) pwd[j] = pk2(e0[2 * j], e0[2 * j + 1]);
                ATT_SB();
#pragma unroll
                for (int d_ = 0; d_ < 4; ++d_) { ATT_MF(o[d_], ATT_PW(0), ATT_VF(fa, d_));
                    e1[2 * d_] = (ABL & 1) ? p1[2 * d_] : __builtin_amdgcn_exp2f(p1[2 * d_]); e1[2 * d_ + 1] = (ABL & 1) ? p1[2 * d_ + 1] : __builtin_amdgcn_exp2f(p1[2 * d_ + 1]);
                    if (diag) { if (crow(2 * d_, hi) + 32 > dq) e1[2 * d_] = 0.f; if (crow(2 * d_ + 1, hi) + 32 > dq) e1[2 * d_ + 1] = 0.f; }
                    sA += e1[2 * d_]; sB += e1[2 * d_ + 1]; ATT_SB(); }
                ATT_VLDK(fa, 2); ATT_SB();
#pragma unroll
                for (int d_ = 0; d_ < 4; ++d_) { ATT_MF(o[d_], ATT_PW(1), ATT_VF(fb, d_));
                    e1[8 + 2 * d_] = (ABL & 1) ? p1[8 + 2 * d_] : __builtin_amdgcn_exp2f(p1[8 + 2 * d_]); e1[8 + 2 * d_ + 1] = (ABL & 1) ? p1[8 + 2 * d_ + 1] : __builtin_amdgcn_exp2f(p1[8 + 2 * d_ + 1]);
                    if (diag) { if (crow(8 + 2 * d_, hi) + 32 > dq) e1[8 + 2 * d_] = 0.f; if (crow(8 + 2 * d_ + 1, hi) + 32 > dq) e1[8 + 2 * d_ + 1] = 0.f; }
                    sC += e1[8 + 2 * d_]; sD += e1[8 + 2 * d_ + 1];
                    pwd[8 + d_] = pk2(e1[2 * d_], e1[2 * d_ + 1]); ATT_SB(); }
                ATT_VLDK(fb, 3);
#pragma unroll
                for (int j = 4; j < 8; ++j) pwd[8 + j] = pk2(e1[2 * j], e1[2 * j + 1]);
                lsum += (sA + sB) + (sC + sD);
                ATT_SB();
                ATT_PVK(fa, 2); ATT_SB(); ATT_PVK(fb, 3);
                __builtin_amdgcn_s_setprio(0);
            }
        }
        base += s64;
        slot = (slot == NSLOT - 1) ? 0 : slot + 1;
    }
#undef ATT_PW
#undef ATT_VF
#undef ATT_VLDK
#undef ATT_PVK
#undef ATT_MF
#undef ATT_SB
    ATT_WAIT_BAR(0);
    if (ABL & 32) { float keep_ = lsum + o[0][0] + o[1][1] + o[2][2] + o[3][3]; asm volatile("" :: "v"(keep_)); return; }
    LAS float* lw = (LAS float*)(lds + LW_OFF) + wid * 32;
    { auto rr = __builtin_amdgcn_permlane32_swap(__float_as_uint(lsum), __float_as_uint(lsum), false, false); lsum = __uint_as_float(rr[0]) + __uint_as_float(rr[1]); }
    if (hi == 0) lw[r32] = lsum;
    LDS_WAIT();
    LAS float* X = (LAS float*)lds + qs * 32 * XSTR;
#pragma unroll
    for (int r = 0; r < 16; ++r) { const float rl = 1.0f / lw[crow(r, hi)];
#pragma unroll
        for (int d0 = 0; d0 < 4; ++d0) o[d0][r] *= rl; }
    if (c == 1) {
#pragma unroll
        for (int r = 0; r < 16; ++r)
#pragma unroll
            for (int d0 = 0; d0 < 4; ++d0) X[crow(r, hi) * XSTR + d0 * 32 + r32] = o[d0][r];
    }
    ATT_WAIT_BAR(0);
    if (c == 0) {
#pragma unroll
        for (int r = 0; r < 16; ++r)
#pragma unroll
            for (int d0 = 0; d0 < 4; ++d0) { LAS float* px = X + crow(r, hi) * XSTR + d0 * 32 + r32; const float a = o[d0][r] - lam * (*px); *px = a; }
        LDS_WAIT(); asm volatile("" ::: "memory");
        const LAS f32x4* rp = (const LAS f32x4*)(X + r32 * XSTR + hi * 64);
        f32x4 av[16]; float ss = 0.f;
#pragma unroll
        for (int j = 0; j < 16; ++j) { av[j] = rp[j]; ss += (av[j].x * av[j].x + av[j].y * av[j].y) + (av[j].z * av[j].z + av[j].w * av[j].w); }
        { auto rr = __builtin_amdgcn_permlane32_swap(__float_as_uint(ss), __float_as_uint(ss), false, false); ss = __uint_as_float(rr[0]) + __uint_as_float(rr[1]); }
        const float rs = 0.8f / sqrtf(ss * (1.0f / 128.0f) + EPS);
        bf16* op = MIX + (rowbase + qrow) * 2048 + h * 128 + hi * 64;
#pragma unroll
        for (int j = 0; j < 8; ++j) { const f32x4 g0 = *(const f32x4*)(subg + hi * 64 + 8 * j), g1 = *(const f32x4*)(subg + hi * 64 + 8 * j + 4); const f32x4 a0 = av[2 * j] * rs * g0, a1 = av[2 * j + 1] * rs * g1;
            v4u w; w.x = pk2(a0.x, a0.y); w.y = pk2(a0.z, a0.w); w.z = pk2(a1.x, a1.y); w.w = pk2(a1.z, a1.w); *(v4u*)(op + 8 * j) = w; }
    }
    ATT_BAR();
#undef ATT_DMA
}
}


#ifndef DBG_NAIVE_ATTN
#define DBG_NAIVE_ATTN 0
#endif
#if DBG_NAIVE_ATTN
__device__ __forceinline__ void naive_attn_row(int b, int h, int q, const bf16* Q, const bf16* K, const bf16* V, bf16* MIX, const float* subg, float lam, LAS float* S, int lane) {
    const size_t rowbase = (size_t)b * SEQ; const float slope2 = exp2f(-(float)(h + 1)) * 1.4426950408889634f;
    for (int c = 0; c < 2; ++c) {
        float qv[64];
        const bf16* qp = Q + (rowbase + q) * 1024 + h * 128 + c * 64;
#pragma unroll
        for (int d = 0; d < 64; d += 2) { const unsigned u = *(const unsigned*)(qp + d); qv[d] = bflo(u); qv[d + 1] = bfhi(u); }
        for (int key = lane; key <= q; key += 64) { const bf16* kp = K + (rowbase + key) * 1024 + h * 128 + c * 64; float s = 0.f;
#pragma unroll
            for (int d = 0; d < 64; d += 2) { const unsigned u = *(const unsigned*)(kp + d); s += qv[d] * bflo(u) + qv[d + 1] * bfhi(u); }
            S[c * 2048 + key] = s - slope2 * (float)(q - key); }
    }
    LDS_WAIT();
    float linv[2];
    for (int c = 0; c < 2; ++c) { float m = -1e30f; for (int key = lane; key <= q; key += 64) m = fmaxf(m, S[c * 2048 + key]); m = wave_max(m);
        float l = 0.f; for (int key = lane; key <= q; key += 64) { const float p = exp2f(S[c * 2048 + key] - m); S[c * 2048 + key] = p; l += p; } linv[c] = 1.0f / wave_sum(l); }
    for (int key = lane; key <= q; key += 64) S[key] = S[key] * linv[0] - lam * S[2048 + key] * linv[1];
    LDS_WAIT();
    float o0 = 0.f, o1 = 0.f; const bf16* vp = V + rowbase * 1024 + h * 128 + lane;
    for (int key = 0; key <= q; ++key) { const float a = S[key]; o0 += a * __uint_as_float((unsigned)vp[(size_t)key * 1024] << 16); o1 += a * __uint_as_float((unsigned)vp[(size_t)key * 1024 + 64] << 16); }
    const float ss = wave_sum(o0 * o0 + o1 * o1); const float rs = 0.8f / sqrtf(ss * (1.0f / 128.0f) + EPS);
    bf16* op = MIX + (rowbase + q) * 2048 + h * 128 + lane;
    op[0] = (bf16)(pk2(o0 * rs * subg[lane], 0.f) & 0xffffu); op[64] = (bf16)(pk2(o1 * rs * subg[lane + 64], 0.f) & 0xffffu);
    LDS_WAIT();
}
#endif

__device__ __forceinline__ unsigned ord_key(float f) { const unsigned u = __float_as_uint(f); return (u & 0x80000000u) ? ~u : (u | 0x80000000u); }
__device__ __forceinline__ float ord_val(unsigned k) { return __uint_as_float((k & 0x80000000u) ? (k ^ 0x80000000u) : ~k); }
#define CE_DESC(a, b) do { const unsigned hi__ = max((a), (b)), lo__ = min((a), (b)); (a) = hi__; (b) = lo__; } while (0)
__device__ __forceinline__ void sort16_desc(unsigned (&v)[16]) {
#pragma unroll
    for (int k = 2; k <= 16; k <<= 1)
#pragma unroll
        for (int j = k >> 1; j > 0; j >>= 1)
#pragma unroll
            for (int i = 0; i < 16; ++i) { const int l = i ^ j; if (l > i) { if ((i & k) == 0) CE_DESC(v[i], v[l]); else CE_DESC(v[l], v[i]); } }
}
__device__ __forceinline__ void merge16_desc_rev(unsigned (&a)[16], const unsigned (&brev)[16]) {
#pragma unroll
    for (int i = 0; i < 16; ++i) a[i] = max(a[i], brev[i]);
#pragma unroll
    for (int j = 8; j > 0; j >>= 1)
#pragma unroll
        for (int i = 0; i < 16; ++i) { const int l = i ^ j; if (l > i) CE_DESC(a[i], a[l]); }
}

constexpr int P5_LST_OFF = 65536, P5_TAB_OFF = P5_LST_OFF + 16384;
__device__ __forceinline__ void peer_topk_item(int tile, int h, const bf16* QP, const float* SSQ, int* EIDX, float* EGATE, float* RSTD, LAS char* lds) {
    const int tid = threadIdx.x, lane = tid & 63, r32 = lane & 31, hi = lane >> 5, wid = __builtin_amdgcn_readfirstlane(tid >> 6);
    LAS unsigned* LST = (LAS unsigned*)(lds + P5_LST_OFF);
    const LAS unsigned char* TAB = (const LAS unsigned char*)(lds + P5_TAB_OFF);
    const int tok0 = tile * 128;
    {
        const int c = wid >> 2, tb = wid & 3;
        bf16x8 qf[8];
        const bf16* qp = QP + (size_t)(tok0 + tb * 32 + r32) * 2048 + h * 256 + c * 128 + hi * 8;
#pragma unroll
        for (int s = 0; s < 8; ++s) qf[s] = *(const bf16x8*)(qp + 16 * s);
        const LAS char* sp = lds + c * 32768 + hi * 2048 + r32 * 16;
        unsigned best[16];
#pragma unroll
        for (int kb = 0; kb < 4; ++kb) { f32x16 acc = f32x16{};
#pragma unroll
            for (int s = 0; s < 8; ++s) { const bf16x8 sf = *(const LAS bf16x8*)(sp + s * 4096 + kb * 512); acc = __builtin_amdgcn_mfma_f32_32x32x16_bf16(sf, qf[s], acc, 0, 0, 0); }
            unsigned v[16];
#pragma unroll
            for (int r = 0; r < 16; ++r) v[r] = (ord_key(acc[r]) & ~0x7Fu) | (unsigned)(32 * kb + (r & 3) + 8 * (r >> 2)) | (unsigned)(hi << 2);
            sort16_desc(v);
            if (kb == 0) {
#pragma unroll
                for (int i = 0; i < 16; ++i) best[i] = v[i];
            } else { unsigned vr[16];
#pragma unroll
                for (int i = 0; i < 16; ++i) vr[i] = v[15 - i];
                merge16_desc_rev(best, vr); } }
        {
            unsigned br[16];
#pragma unroll
            for (int i = 0; i < 16; ++i) br[i] = (unsigned)__shfl_xor((int)best[15 - i], 32);
            merge16_desc_rev(best, br); }
        if (hi == 0) { LAS unsigned* lrow = LST + (c * 128 + tb * 32 + r32) * 16;
#pragma unroll
            for (int i = 0; i < 4; ++i) *(LAS v4u*)(lrow + 4 * i) = (v4u){best[4 * i], best[4 * i + 1], best[4 * i + 2], best[4 * i + 3]}; }
    }
    __syncthreads();
    {
        const int token = tid >> 2, q = tid & 3;
        const LAS unsigned* l1 = LST + token * 16; const LAS unsigned* l2 = LST + (128 + token) * 16;
        unsigned v[16];
#pragma unroll
        for (int m = 0; m < 13; ++m) { const int n = 4 * m + q; const unsigned pid = TAB[n < 50 ? n : 0]; const unsigned a = l1[pid >> 4], b2 = l2[pid & 15u];
            const unsigned key = (ord_key(ord_val(a & ~0x7Fu) + ord_val(b2 & ~0x7Fu)) & ~0xFFu) | pid; v[m] = n < 50 ? key : 0u; }
        v[13] = 0u; v[14] = 0u; v[15] = 0u;
        sort16_desc(v);
#pragma unroll
        for (int w = 1; w <= 2; w <<= 1) { unsigned br[16];
#pragma unroll
            for (int i = 0; i < 16; ++i) br[i] = (unsigned)__shfl_xor((int)v[15 - i], w);
            merge16_desc_rev(v, br); }
        const int t = tok0 + token;
        const f32x4 p0 = *(const f32x4*)(SSQ + (size_t)t * 32 + 8 * q), p1 = *(const f32x4*)(SSQ + (size_t)t * 32 + 8 * q + 4);
        float ssq = ((p0.x + p0.y) + (p0.z + p0.w)) + ((p1.x + p1.y) + (p1.z + p1.w));
        ssq += __shfl_xor(ssq, 1); ssq += __shfl_xor(ssq, 2);
        const float rstd = 1.0f / sqrtf(ssq * (1.0f / DM) + EPS);
        if (h == 0 && q == 0) RSTD[t] = rstd;
        const unsigned p_top = v[0] & 0xFFu; const float vmax = (ord_val(l1[p_top >> 4] & ~0x7Fu) + ord_val(l2[p_top & 15u] & ~0x7Fu)) * rstd;
        float ev[4]; int ex[4]; float es = 0.f;
#pragma unroll
        for (int m = 0; m < 4; ++m) { const unsigned kk = q == 0 ? v[m] : q == 1 ? v[4 + m] : q == 2 ? v[8 + m] : v[12 + m];
            const unsigned pid = kk & 0xFFu; const unsigned a = l1[pid >> 4], b2 = l2[pid & 15u];
            const float sv = (ord_val(a & ~0x7Fu) + ord_val(b2 & ~0x7Fu)) * rstd;
            ev[m] = __expf(sv - vmax); es += ev[m]; ex[m] = (int)((a & 0x7Fu) * 128u + (b2 & 0x7Fu)); }
        es += __shfl_xor(es, 1); es += __shfl_xor(es, 2);
        const float inv = 1.0f / es;
        *(int4*)(EIDX + (size_t)t * 128 + h * 16 + 4 * q) = make_int4(ex[0], ex[1], ex[2], ex[3]);
        *(f32x4*)(EGATE + (size_t)t * 128 + h * 16 + 4 * q) = (f32x4){ev[0] * inv, ev[1] * inv, ev[2] * inv, ev[3] * inv};
    }
    __syncthreads();
}

__device__ __forceinline__ f32x2 dot16_fp8(const v4u u, const f32x2* h, f32x2 acc) {
#pragma unroll
    for (int w = 0; w < 4; ++w) { const unsigned d = w == 0 ? u.x : w == 1 ? u.y : w == 2 ? u.z : u.w;
        const f32x2 f0 = __builtin_amdgcn_cvt_pk_f32_fp8((int)d, false), f1 = __builtin_amdgcn_cvt_pk_f32_fp8((int)d, true);
        acc = __builtin_elementwise_fma(h[2 * w], f0, acc); acc = __builtin_elementwise_fma(h[2 * w + 1], f1, acc); }
    return acc;
}
__device__ __forceinline__ void axpy16_fp8(const v4u v, f32x2 a2, f32x2* o) {
#pragma unroll
    for (int w = 0; w < 4; ++w) { const unsigned d = w == 0 ? v.x : w == 1 ? v.y : w == 2 ? v.z : v.w;
        const f32x2 f0 = __builtin_amdgcn_cvt_pk_f32_fp8((int)d, false), f1 = __builtin_amdgcn_cvt_pk_f32_fp8((int)d, true);
        o[2 * w] = __builtin_elementwise_fma(a2, f0, o[2 * w]); o[2 * w + 1] = __builtin_elementwise_fma(a2, f1, o[2 * w + 1]); }
}
struct PItem { int t, s; };
__device__ __forceinline__ PItem peer_item(int q, int nq, int nper, int tb, int tstride, int xl) {
    const int j = (q < nq ? q : nq - 1) >> 1; PItem it; const int r = j >= nper ? 1 : 0; it.s = 8 * r + xl; const int t = tb + (j - r * nper) * tstride; it.t = t < T ? t : T - 1; return it; }
__device__ __forceinline__ void pe_idx8(const PItem it, int hh, const int* EIDX, int g, int (&ex)[8]) {
#pragma unroll
    for (int i = 0; i < 2; ++i) { const int4 v = *(const int4*)(EIDX + (size_t)it.t * 128 + g * 16 + 8 * hh + 4 * i); ex[4 * i] = v.x; ex[4 * i + 1] = v.y; ex[4 * i + 2] = v.z; ex[4 * i + 3] = v.w; }
}
__device__ __forceinline__ void pe_gather8(const PItem it, const unsigned char* TB, int sub, const int (&ex)[8], v4u (&uv)[8]) {
    const unsigned char* ub = TB + (size_t)it.s * 16384 * 128 + 16 * sub;
#pragma unroll
    for (int i = 0; i < 8; ++i) uv[i] = *(const v4u*)(ub + (size_t)ex[i] * 128);
}
__device__ __forceinline__ int sdot4(unsigned a, unsigned b, int acc) { return __builtin_amdgcn_sdot4((int)a, (int)b, acc, false); }
__device__ __forceinline__ void pu_acc8(const v4u (&uv)[8], const v4u ha, const v4u hb, int hs8, int (&r)[8]) {
#pragma unroll
    for (int i = 0; i < 8; ++i) { int a = -hs8, b = 0;
        a = sdot4(uv[i].x & 0x0F0F0F0Fu, ha.x, a); b = sdot4(uv[i].x & 0xF0F0F0F0u, ha.y, b); a = sdot4(uv[i].y & 0x0F0F0F0Fu, ha.z, a); b = sdot4(uv[i].y & 0xF0F0F0F0u, ha.w, b);
        a = sdot4(uv[i].z & 0x0F0F0F0Fu, hb.x, a); b = sdot4(uv[i].z & 0xF0F0F0F0u, hb.y, b); a = sdot4(uv[i].w & 0x0F0F0F0Fu, hb.z, a); b = sdot4(uv[i].w & 0xF0F0F0F0u, hb.w, b);
        r[i] = a + (b >> 4); }
}
__device__ __forceinline__ void pu_store(const PItem it, bool valid, float* PART, int lane, const int (&rlo)[8], const int (&rhi)[8]) {
    const int g = lane >> 3, sub = lane & 7;
    int r[16];
#pragma unroll
    for (int i = 0; i < 8; ++i) { r[i] = rlo[i]; r[8 + i] = rhi[i]; }
    { const bool up = (lane & 4) != 0;
#pragma unroll
      for (int j = 0; j < 8; ++j) { const int a = r[j], b2 = r[j + 8]; const int keep = up ? b2 : a, send = up ? a : b2; const int m_ = __builtin_amdgcn_update_dpp(0, send, 0x141, 0xf, 0xf, false); r[j] = keep + __builtin_amdgcn_update_dpp(0, m_, 0x1B, 0xf, 0xf, false); } }
    { const bool up = (lane & 2) != 0;
#pragma unroll
      for (int j = 0; j < 4; ++j) { const int a = r[j], b2 = r[j + 4]; const int keep = up ? b2 : a, send = up ? a : b2; r[j] = keep + __builtin_amdgcn_update_dpp(0, send, 0x4E, 0xf, 0xf, false); } }
    { const bool up = (lane & 1) != 0;
#pragma unroll
      for (int j = 0; j < 2; ++j) { const int a = r[j], b2 = r[j + 2]; const int keep = up ? b2 : a, send = up ? a : b2; r[j] = keep + __builtin_amdgcn_update_dpp(0, send, 0xB1, 0xf, 0xf, false); } }
    const int i0 = 8 * ((sub >> 2) & 1) + 4 * ((sub >> 1) & 1) + 2 * (sub & 1);
    if (valid) *(f32x2*)(PART + ((size_t)it.s * T + it.t) * 128 + g * 16 + i0) = (f32x2){(float)r[0], (float)r[1]};
}
__device__ __forceinline__ PItem peer_item1(int q, int nq, int tb, int tstride, int xl) { const int j = (q < nq ? q : nq - 1) >> 1; PItem it; it.s = xl; const int t = tb + j * tstride; it.t = t < T ? t : T - 1; return it; }
__device__ __forceinline__ void peer_u_stage(int nper, int tb, int tstride, int xl, const unsigned char* H8, const unsigned char* U8, const int* EIDX, float* PART, int lane) {
    const int g = lane >> 3, sub = lane & 7, NQ = 2 * nper;
    int ex0[8], ex1[8], ex2[8], ex3[8]; v4u uv0[8], uv1[8], uv2[8], uv3[8], ha0, ha1, ha2, ha3, hb0, hb1, hb2, hb3; int rs[8];
#define PU_I(q, X) do { const PItem it_ = peer_item1((q), NQ, tb, tstride, xl); pe_idx8(it_, (X) & 1, EIDX, g, ex##X); } while (0)
#define PU_G(q, X) do { const PItem it_ = peer_item1((q), NQ, tb, tstride, xl); pe_gather8(it_, U8, sub, ex##X, uv##X); const unsigned char* hp_ = H8 + (size_t)it_.t * 2048 + 256 * it_.s + 32 * sub; ha##X = *(const v4u*)hp_; hb##X = *(const v4u*)(hp_ + 16); } while (0)
#define PU_F(q, X) do { const PItem it_ = peer_item1((q), NQ, tb, tstride, xl); int hs_ = sdot4(ha##X.x, 0x01010101u, 0); hs_ = sdot4(ha##X.z, 0x01010101u, hs_); hs_ = sdot4(hb##X.x, 0x01010101u, hs_); hs_ = sdot4(hb##X.z, 0x01010101u, hs_); \
        if (((X) & 1) == 0) pu_acc8(uv##X, ha##X, hb##X, 8 * hs_, rs); else { int rh_[8]; pu_acc8(uv##X, ha##X, hb##X, 8 * hs_, rh_); \
        pu_store(it_, (q) < NQ && (tb + ((q) >> 1) * tstride) < T, PART, lane, rs, rh_); } } while (0)
    PU_I(0, 0); PU_I(1, 1); PU_I(2, 2); PU_I(3, 3); PU_G(0, 0); PU_G(1, 1); PU_G(2, 2);
#pragma unroll 1
    for (int q = 0; q < NQ; q += 4) {
        PU_F(q, 0);     PU_G(q + 3, 3); PU_I(q + 4, 0);
        PU_F(q + 1, 1); PU_G(q + 4, 0); PU_I(q + 5, 1);
        PU_F(q + 2, 2); PU_G(q + 5, 1); PU_I(q + 6, 2);
        PU_F(q + 3, 3); PU_G(q + 6, 2); PU_I(q + 7, 3);
    }
#undef PU_I
#undef PU_G
#undef PU_F
}
__device__ __forceinline__ void tr4x4(unsigned r0, unsigned r1, unsigned r2, unsigned r3, unsigned& c0, unsigned& c1, unsigned& c2, unsigned& c3) {
    const unsigned a = __builtin_amdgcn_perm(r1, r0, 0x05010400u), b = __builtin_amdgcn_perm(r1, r0, 0x07030602u), c = __builtin_amdgcn_perm(r3, r2, 0x05010400u), d = __builtin_amdgcn_perm(r3, r2, 0x07030602u);
    c0 = __builtin_amdgcn_perm(c, a, 0x05040100u); c1 = __builtin_amdgcn_perm(c, a, 0x07060302u); c2 = __builtin_amdgcn_perm(d, b, 0x05040100u); c3 = __builtin_amdgcn_perm(d, b, 0x07060302u);
}
__device__ __forceinline__ void pv_acc8(const v4u (&vv)[8], const unsigned aq0, const unsigned aq1, int (&acc)[32]) {
#pragma unroll
    for (int m = 0; m < 2; ++m) { const unsigned aq = m == 0 ? aq0 : aq1;
#pragma unroll
        for (int w = 0; w < 4; ++w) { unsigned d[4];
#pragma unroll
            for (int i = 0; i < 4; ++i) d[i] = w == 0 ? vv[4 * m + i].x : w == 1 ? vv[4 * m + i].y : w == 2 ? vv[4 * m + i].z : vv[4 * m + i].w;
            unsigned c0, c1, c2, c3;
            tr4x4(d[0], d[1], d[2], d[3], c0, c1, c2, c3);
            acc[8 * w + 0] = sdot4(c0 & 0x0F0F0F0Fu, aq, acc[8 * w + 0]); acc[8 * w + 1] = sdot4(c1 & 0x0F0F0F0Fu, aq, acc[8 * w + 1]); acc[8 * w + 2] = sdot4(c2 & 0x0F0F0F0Fu, aq, acc[8 * w + 2]); acc[8 * w + 3] = sdot4(c3 & 0x0F0F0F0Fu, aq, acc[8 * w + 3]);
            acc[8 * w + 4] = sdot4(c0 & 0xF0F0F0F0u, aq, acc[8 * w + 4]); acc[8 * w + 5] = sdot4(c1 & 0xF0F0F0F0u, aq, acc[8 * w + 5]); acc[8 * w + 6] = sdot4(c2 & 0xF0F0F0F0u, aq, acc[8 * w + 6]); acc[8 * w + 7] = sdot4(c3 & 0xF0F0F0F0u, aq, acc[8 * w + 7]); } }
}
__device__ __forceinline__ void pv_store(const PItem it, bool valid, float* out, const f32x4 ginv, const float sc, int lane, int (&acc)[32], int asum, const v2u x1b) {
    const int g = lane >> 3, sub = lane & 7;
#pragma unroll
    for (int j = 0; j < 16; ++j) { const auto r_ = __builtin_amdgcn_permlane32_swap((unsigned)acc[j], (unsigned)acc[j + 16], false, false); acc[j] = (int)r_[0] + (int)r_[1]; }
#pragma unroll
    for (int j = 0; j < 8; ++j) { const auto r_ = __builtin_amdgcn_permlane16_swap((unsigned)acc[j], (unsigned)acc[j + 8], false, false); acc[j] = (int)r_[0] + (int)r_[1]; }
    { const bool up = (lane & 8) != 0;
#pragma unroll
      for (int j = 0; j < 4; ++j) { const int a = acc[j], b2 = acc[j + 4]; const int keep = up ? b2 : a, send = up ? a : b2; acc[j] = keep + __builtin_amdgcn_update_dpp(0, send, 0x128, 0xf, 0xf, false); } }
    asum += __builtin_amdgcn_update_dpp(0, asum, 0x128, 0xf, 0xf, false);
    { const auto r_ = __builtin_amdgcn_permlane16_swap((unsigned)asum, (unsigned)asum, false, false); asum = (int)r_[0] + (int)r_[1]; }
    { const auto r_ = __builtin_amdgcn_permlane32_swap((unsigned)asum, (unsigned)asum, false, false); asum = (int)r_[0] + (int)r_[1]; }
    const int c0 = 16 * ((g >> 2) & 1) + 8 * ((g >> 1) & 1) + 4 * (g & 1);
    const bool hicol = (c0 & 4) != 0;
    int v_[4];
#pragma unroll
    for (int i = 0; i < 4; ++i) v_[i] = hicol ? (acc[i] >> 4) : (acc[i] - 8 * asum);
    if (valid) *(f32x4*)(out + (size_t)it.t * 2048 + 256 * it.s + 32 * sub + c0) = (f32x4){bflo(x1b.x) * ginv.x + sc * (float)v_[0], bfhi(x1b.x) * ginv.y + sc * (float)v_[1], bflo(x1b.y) * ginv.z + sc * (float)v_[2], bfhi(x1b.y) * ginv.w + sc * (float)v_[3]};
}
template <int ABL> __device__ __forceinline__ void peer_v_stage(int nper, int tb, int tstride, int xl, const unsigned char* V8, const int* EIDX, const unsigned* ACTQ, const float* ASC, const bf16* A2, const float* ffn_g, float* out, int lane) {
    const int g = lane >> 3, sub = lane & 7, NQ = 2 * nper;
    const int c0 = 16 * ((g >> 2) & 1) + 8 * ((g >> 1) & 1) + 4 * (g & 1);
    int ex0[8], ex1[8], ex2[8], ex3[8]; v4u vv0[8], vv1[8], vv2[8], vv3[8]; v2u aq0, aq1, aq2, aq3, x1a, x1b; float sca = 0.f, scb = 0.f; int acc[32]; int asum = 0;
    f32x4 ginv; { const f32x4 gg = *(const f32x4*)(ffn_g + 256 * xl + 32 * sub + c0); ginv = (f32x4){1.0f / gg.x, 1.0f / gg.y, 1.0f / gg.z, 1.0f / gg.w}; }
#define PV_I(q, X) do { const PItem it_ = peer_item1((q), NQ, tb, tstride, xl); pe_idx8(it_, (X) & 1, EIDX, g, ex##X); } while (0)
#define PV_G(q, X, XV, SCV) do { const PItem it_ = peer_item1((q), NQ, tb, tstride, xl); if (ABL & 2) { _Pragma("unroll") for (int i_ = 0; i_ < 8; ++i_) vv##X[i_] = (v4u){(unsigned)ex##X[i_], 1u, 2u, 3u}; } else pe_gather8(it_, V8, sub, ex##X, vv##X); \
        aq##X = *(const v2u*)(ACTQ + (size_t)it_.t * 32 + g * 4 + 2 * ((X) & 1)); \
        if ((X) & 1) { XV = *(const v2u*)(A2 + (size_t)it_.t * 2048 + 256 * it_.s + 32 * sub + c0); SCV = ASC[it_.t]; } } while (0)
#define PV_F(q, X, XV, SCV) do { const PItem it_ = peer_item1((q), NQ, tb, tstride, xl); if (((X) & 1) == 0) { _Pragma("unroll") for (int m_ = 0; m_ < 32; ++m_) acc[m_] = 0; asum = 0; } \
        asum = sdot4(aq##X.x, 0x01010101u, asum); asum = sdot4(aq##X.y, 0x01010101u, asum); \
        if (ABL & 1) { _Pragma("unroll") for (int i_ = 0; i_ < 8; ++i_) asm volatile("" :: "v"(vv##X[i_])); acc[0] += (int)aq##X.x; } else pv_acc8(vv##X, aq##X.x, aq##X.y, acc); if ((X) & 1) pv_store(it_, (q) < NQ && (tb + ((q) >> 1) * tstride) < T, out, ginv, SCV, lane, acc, asum, XV); } while (0)
    PV_I(0, 0); PV_I(1, 1); PV_I(2, 2); PV_I(3, 3); PV_G(0, 0, x1a, sca); PV_G(1, 1, x1a, sca); PV_G(2, 2, x1b, scb);
#pragma unroll 1
    for (int q = 0; q < NQ; q += 4) {
        PV_F(q, 0, x1a, sca);     PV_G(q + 3, 3, x1b, scb); PV_I(q + 4, 0);
        PV_F(q + 1, 1, x1a, sca); PV_G(q + 4, 0, x1a, sca); PV_I(q + 5, 1);
        PV_F(q + 2, 2, x1b, scb); PV_G(q + 5, 1, x1a, sca); PV_I(q + 6, 2);
        PV_F(q + 3, 3, x1b, scb); PV_G(q + 6, 2, x1b, scb); PV_I(q + 7, 3);
    }
#undef PV_I
#undef PV_G
#undef PV_F
}

struct Args { const float* in[17]; float* out; unsigned char* ws; int ph_lo, ph_hi; };
__global__ void __launch_bounds__(NTHREADS, 2) mk_fwd(Args args) {
    extern __shared__ __attribute__((aligned(16))) unsigned char lds_raw[];
    LAS unsigned char* lds = (LAS unsigned char*)lds_raw;
    const int tid = threadIdx.x, lane = tid & 63, wave = __builtin_amdgcn_readfirstlane(tid >> 6);
    const int G = gridDim.x, bx = blockIdx.x;
    const int vcu = (G % 8 == 0) ? (bx % 8) * (G / 8) + bx / 8 : bx;
    unsigned char* ws = args.ws;
    const float* x = args.in[0]; const float* attn_g = args.in[1]; const float* w_in = args.in[2]; const float* qg = args.in[3]; const float* kg = args.in[4];
    const float* lq1 = args.in[5]; const float* lk1 = args.in[6]; const float* lq2 = args.in[7]; const float* lk2 = args.in[8]; const float* subg = args.in[9];
    const float* conv_w = args.in[10]; const float* w_out = args.in[11]; const float* ffn_g = args.in[12]; const float* w_q = args.in[13]; const float* subkeys = args.in[14];
    const float* peer_u = args.in[15]; const float* peer_v = args.in[16];
    float* out = args.out;
    bf16* WtIn = (bf16*)(ws + WS_WIN); bf16* WtOut = (bf16*)(ws + WS_WOUT); bf16* WtQ = (bf16*)(ws + WS_WQ); bf16* SK = (bf16*)(ws + WS_SK);
    float* SSQ = (float*)(ws + WS_SSQ); int* EIDX = (int*)(ws + WS_EIDX); float* EGATE = (float*)(ws + WS_EGATE); float* RSTD = (float*)(ws + WS_RSTD);
    bf16* XN = (bf16*)(ws + WS_XN); bf16* MIX = XN;
    bf16* Qb = (bf16*)(ws + WS_Q); bf16* Kb = (bf16*)(ws + WS_K); bf16* Vb = (bf16*)(ws + WS_V); bf16* QP = Qb;
    bf16* CB = (bf16*)(ws + WS_CB); bf16* CC = (bf16*)(ws + WS_CC); bf16* CX = (bf16*)(ws + WS_CX); bf16* A2 = CB;
    unsigned char* U8 = ws + WS_UT; unsigned char* V8 = ws + WS_VT;
    volatile LAS unsigned* MISC = (volatile LAS unsigned*)(lds + MISC_OFF);
    if (tid < 16) MISC[tid] = 0u;
    __syncthreads();
    XcdBarrier bar = xcd_barrier_post((unsigned*)(ws + WS_CTL) + CW_BAR, MISC + 8);
    const int lo = args.ph_lo, hi_ph = args.ph_hi & 255, dbg_flags = args.ph_hi >> 8;
#ifndef DBG_DUP
#define DBG_DUP -1
#endif
#ifndef DBG_MASK
#define DBG_MASK 0xfff
#endif
#define IN(k) (((DBG_MASK >> (k)) & 1) && lo <= (k) && (k) < hi_ph)
#define REPS(k) for (int rep_ = 0; rep_ < ((DBG_DUP == (k)) ? 2 : 1); ++rep_)
#define SEAM(k) do { if (IN(k) && IN((k) + 1)) xcd_barrier(bar); } while (0)
    const int gw = vcu * NWAVES + wave, NGW = G * NWAVES;
    const size_t gtid = (size_t)bx * NTHREADS + tid, nthr = (size_t)G * NTHREADS;

    if (IN(0)) REPS(0) {
        LAS float* scr = (LAS float*)(lds + wave * 16384);
        constexpr int I_IN = (DM / 64) * (INC / 32), I_SQ = (DM / 64) * (DM / 32);
        if (!(dbg_flags & 4))
        for (int it = gw; it < I_IN + 2 * I_SQ; it += NGW) {
            if (it < I_IN) p0_transpose_item(w_in, DM, INC, WtIn, scr, it, lane, true);
            else if (it < I_IN + I_SQ) p0_transpose_item(w_out, DM, DM, WtOut, scr, it - I_IN, lane, false);
            else p0_transpose_item(w_q, DM, DM, WtQ, scr, it - I_IN - I_SQ, lane, false);
        }
        if (!(dbg_flags & 8))
        for (int m = gw; m < T; m += NGW) rms_row_to_bf16(x + (size_t)m * DM, attn_g, XN + (size_t)m * DM, lane);
        cvt_bf16_stream(subkeys, SK, (size_t)PEH * 2 * PNK * 128 / 8, gtid, nthr);
        if (!(dbg_flags & 16))
        {
            const float sig = table_std16(peer_u, (LAS float*)(lds + MISC_OFF + 64), tid); const float step = 0.335f * sig;
            if (bx == 0 && tid == 0) ((float*)(ws + WS_RSTD))[T] = step;
            cvt_i4_slices(peer_u, U8, 1.0f / step, gtid, nthr); }
        if (!(dbg_flags & 32))
        {
            const float sig = table_std16(peer_v, (LAS float*)(lds + MISC_OFF + 64), tid); const float step = 0.335f * sig;
            if (bx == 0 && tid == 0) ((float*)(ws + WS_RSTD))[T + 1] = step;
            cvt_i4_slices(peer_v, V8, 1.0f / step, gtid, nthr); }
    }
    SEAM(0);
    if (IN(1)) REPS(1) {
        pg8::Gemm g{XN, WtIn, T, INC, DM}; pg8::StaticOrder S; S.init(T, INC, G, bx, WGM_P1);
        pg8::EpiProj E{Qb, qg, kg};
        pg8::gemm_phase<pg8::EpiProj, pg8::StaticOrder, true, true>(lds, g, S, E);
    }
    SEAM(1);
    if (IN(2)) REPS(2) {
        float a = lq1[lane] * lk1[lane], b2 = lq2[lane] * lk2[lane];
        a = wave_sum(a); b2 = wave_sum(b2);
        const float lam = expf(a) - expf(b2) + 0.2f;
        const float mq = wave_max(fabsf(qg[lane])), mk = wave_max(fabsf(kg[lane]));
        const float M2 = 64.f * C2 * mq * mk;
#if DBG_NAIVE_ATTN
        for (int r = gw; r < NB * NH * SEQ; r += NGW) naive_attn_row(r >> 14, (r >> 11) & 7, r & 2047, Qb, Kb, Vb, MIX, subg, lam, (LAS float*)(lds + wave * 16384), lane);
        if (0)
#endif
        if (!(dbg_flags & 2))
        for (int v = vcu; v < NB * NH * 4; v += G) {
            const int bh = v >> 2, s = v & 3, b = bh >> 3, h = bh & 7;
#pragma unroll 1
            for (int i = 0; i < 4; ++i) { const int qblk = (i == 0) ? s : (i == 1) ? 7 - s : (i == 2) ? 8 + s : 15 - s;
                att::attn_unit<0>(b, h, qblk, Qb, Kb, Vb, MIX, subg, lam, M2, (LAS char*)lds); }
        }
        if (!(dbg_flags & 1))
        for (size_t it = gtid; it < (size_t)(T / 16) * 128; it += nthr) {
            const int cg8 = (int)(it & 127), chunk = (int)(it >> 7), t0 = chunk * 16, col = cg8 * 8;
            f32x4 w0a = *(const f32x4*)(conv_w + col), w0b = *(const f32x4*)(conv_w + col + 4), w1a = *(const f32x4*)(conv_w + 1024 + col), w1b = *(const f32x4*)(conv_w + 1024 + col + 4),
                  w2a = *(const f32x4*)(conv_w + 2048 + col), w2b = *(const f32x4*)(conv_w + 2048 + col + 4);
            float u1[8], u2[8];
#pragma unroll
            for (int i = 0; i < 8; ++i) { u1[i] = 0.f; u2[i] = 0.f; }
            if ((t0 % SEQ) != 0) {
                const v4u c1 = *(const v4u*)(CC + (size_t)(t0 - 1) * 1024 + col), x1v = *(const v4u*)(CX + (size_t)(t0 - 1) * 1024 + col), c2 = *(const v4u*)(CC + (size_t)(t0 - 2) * 1024 + col), x2v = *(const v4u*)(CX + (size_t)(t0 - 2) * 1024 + col);
                u1[0] = bflo(c1.x) * bflo(x1v.x); u1[1] = bfhi(c1.x) * bfhi(x1v.x); u1[2] = bflo(c1.y) * bflo(x1v.y); u1[3] = bfhi(c1.y) * bfhi(x1v.y); u1[4] = bflo(c1.z) * bflo(x1v.z); u1[5] = bfhi(c1.z) * bfhi(x1v.z); u1[6] = bflo(c1.w) * bflo(x1v.w); u1[7] = bfhi(c1.w) * bfhi(x1v.w);
                u2[0] = bflo(c2.x) * bflo(x2v.x); u2[1] = bfhi(c2.x) * bfhi(x2v.x); u2[2] = bflo(c2.y) * bflo(x2v.y); u2[3] = bfhi(c2.y) * bfhi(x2v.y); u2[4] = bflo(c2.z) * bflo(x2v.z); u2[5] = bfhi(c2.z) * bfhi(x2v.z); u2[6] = bflo(c2.w) * bflo(x2v.w); u2[7] = bfhi(c2.w) * bfhi(x2v.w);
            }
            const float w0[8] = {w0a.x, w0a.y, w0a.z, w0a.w, w0b.x, w0b.y, w0b.z, w0b.w}, w1[8] = {w1a.x, w1a.y, w1a.z, w1a.w, w1b.x, w1b.y, w1b.z, w1b.w}, w2[8] = {w2a.x, w2a.y, w2a.z, w2a.w, w2b.x, w2b.y, w2b.z, w2b.w};
#pragma unroll 4
            for (int j = 0; j < 16; ++j) { const size_t ro = (size_t)(t0 + j) * 1024 + col;
                const v4u bv = *(const v4u*)(CB + ro), cv = *(const v4u*)(CC + ro), xv = *(const v4u*)(CX + ro);
                float u0[8], bb[8], y[8];
                u0[0] = bflo(cv.x) * bflo(xv.x); u0[1] = bfhi(cv.x) * bfhi(xv.x); u0[2] = bflo(cv.y) * bflo(xv.y); u0[3] = bfhi(cv.y) * bfhi(xv.y); u0[4] = bflo(cv.z) * bflo(xv.z); u0[5] = bfhi(cv.z) * bfhi(xv.z); u0[6] = bflo(cv.w) * bflo(xv.w); u0[7] = bfhi(cv.w) * bfhi(xv.w);
                bb[0] = bflo(bv.x); bb[1] = bfhi(bv.x); bb[2] = bflo(bv.y); bb[3] = bfhi(bv.y); bb[4] = bflo(bv.z); bb[5] = bfhi(bv.z); bb[6] = bflo(bv.w); bb[7] = bfhi(bv.w);
#pragma unroll
                for (int i = 0; i < 8; ++i) { y[i] = bb[i] * (u2[i] * w0[i] + u1[i] * w1[i] + u0[i] * w2[i]); u2[i] = u1[i]; u1[i] = u0[i]; }
                v4u o; o.x = pk2(y[0], y[1]); o.y = pk2(y[2], y[3]); o.z = pk2(y[4], y[5]); o.w = pk2(y[6], y[7]);
                *(v4u*)(MIX + (size_t)(t0 + j) * 2048 + 1024 + col) = o; }
        }
    }
    SEAM(2);
    if (IN(3)) REPS(3) {
        pg8::Gemm g{MIX, WtOut, T, DM, DM}; pg8::StaticOrder S; S.init(T, DM, G, bx, WGM_P3);
        pg8::EpiX1 E{x, out, A2, ffn_g, SSQ, ws + WS_H8};
        pg8::gemm_phase<pg8::EpiX1, pg8::StaticOrder, true, true>(lds, g, S, E);
    }
    SEAM(3);
    if (IN(4)) REPS(4) {
        pg8::Gemm g{A2, WtQ, T, DM, DM}; pg8::StaticOrder S; S.init(T, DM, G, bx, WGM_P3);
        pg8::EpiBf16<0> E{QP, DM, nullptr, 0, 0, 1.f};
        pg8::gemm_phase<pg8::EpiBf16<0>, pg8::StaticOrder, true, true>(lds, g, S, E);
    }
    SEAM(4);
    if (IN(5)) REPS(5) {
        if (tid < 64) {
            int n = tid, i = 0;
#pragma unroll 1
            for (; i < 16; ++i) { const int len = 16 / (i + 1); if (n < len) break; n -= len; }
            ((LAS unsigned char*)(lds + P5_TAB_OFF))[tid] = (unsigned char)(i < 16 ? ((i << 4) | n) : 0);
        }
        int cur_h = -1;
        for (int it = vcu; it < (T / 128) * PEH; it += G) { const int h = it & 7;
            if (h != cur_h) {
                __syncthreads();
                for (int i = tid; i < 4096; i += NTHREADS) { const int ch = i & 15, key = (i >> 4) & 127, c = i >> 11;
                    *(LAS v4u*)(lds + c * 32768 + ch * 2048 + key * 16) = *(const v4u*)(SK + (size_t)((h * 2 + c) * 128 + key) * 128 + ch * 8); }
                cur_h = h; __syncthreads(); }
            peer_topk_item(it >> 3, h, QP, SSQ, EIDX, EGATE, RSTD, (LAS char*)lds); }
    }
    SEAM(5);
    if (IN(6)) {
        float* PART = (float*)(ws + WS_PART);
        const int tstride = (G >> 3) * NWAVES, nper = (T + tstride - 1) / tstride;
        peer_u_stage(nper, (bx >> 3) * NWAVES + wave, tstride, bx & 7, ws + WS_H8, U8, EIDX, PART, lane);
    }
    SEAM(6);
    if (IN(7)) {
        const float* PART = (const float*)(ws + WS_PART); unsigned* ACTQ = (unsigned*)(ws + WS_ACT); float* ASC = (float*)(ws + WS_ACT + 4 * MiB);
        const float ustep = RSTD[T] * (1.0f / H8_SCALE), vstep = RSTD[T + 1];
        for (int tp = gw; tp < T / 2; tp += NGW) { const int t = 2 * tp + (lane >> 5), k4 = 4 * (lane & 31);
            f32x4 z = (f32x4){0.f, 0.f, 0.f, 0.f};
#pragma unroll
            for (int s = 0; s < 8; ++s) z += *(const f32x4*)(PART + ((size_t)s * T + t) * 128 + k4);
            z *= RSTD[t] * ustep;
            const f32x4 gt = *(const f32x4*)(EGATE + (size_t)t * 128 + k4);
            f32x4 a; float am = 0.f;
#pragma unroll
            for (int i = 0; i < 4; ++i) { a[i] = 0.5f * z[i] * (1.0f + erff(z[i] * 0.70710678118654752f)) * gt[i]; am = fmaxf(am, fabsf(a[i])); }
#pragma unroll
            for (int o = 1; o < 32; o <<= 1) am = fmaxf(am, __shfl_xor(am, o));
            const float asc = am > 0.f ? am * (1.0f / 127.0f) : 1.0f, inv = 1.0f / asc; unsigned w = 0u;
#pragma unroll
            for (int i = 0; i < 4; ++i) { const int q = (int)__builtin_rintf(a[i] * inv); w |= ((unsigned)q & 0xffu) << (8 * i); }
            ACTQ[(size_t)t * 32 + (lane & 31)] = w;
            if ((lane & 31) == 0) ASC[t] = asc * vstep; }
    }
    SEAM(7);
    if (IN(8)) {
        const unsigned* ACTQ = (const unsigned*)(ws + WS_ACT); const float* ASC = (const float*)(ws + WS_ACT + 4 * MiB);
        const int tstride = (G >> 3) * NWAVES, nper = (T + tstride - 1) / tstride;
        peer_v_stage<0>(nper, (bx >> 3) * NWAVES + wave, tstride, bx & 7, V8, EIDX, ACTQ, ASC, A2, ffn_g, out, lane);
    }
#undef IN
#undef SEAM
}


#ifdef DBG_ABL
__global__ void __launch_bounds__(NTHREADS, 2) attn_probe(Args args) {
    extern __shared__ __attribute__((aligned(16))) unsigned char lds_raw[];
    LAS unsigned char* lds = (LAS unsigned char*)lds_raw;
    const int tid = threadIdx.x, lane = tid & 63; const int G = gridDim.x, bx = blockIdx.x;
    const int vcu = (G % 8 == 0) ? (bx % 8) * (G / 8) + bx / 8 : bx;
    unsigned char* ws = args.ws;
    const float* qg = args.in[3]; const float* kg = args.in[4]; const float* lq1 = args.in[5]; const float* lk1 = args.in[6]; const float* lq2 = args.in[7]; const float* lk2 = args.in[8]; const float* subg = args.in[9];
    bf16* Qb = (bf16*)(ws + WS_Q); bf16* Kb = (bf16*)(ws + WS_K); bf16* Vb = (bf16*)(ws + WS_V); bf16* MIX2 = (bf16*)(ws + 448 * MiB);
    float a = lq1[lane] * lk1[lane], b2 = lq2[lane] * lk2[lane]; a = wave_sum(a); b2 = wave_sum(b2);
    const float lam = expf(a) - expf(b2) + 0.2f; const float mq = wave_max(fabsf(qg[lane])), mk = wave_max(fabsf(kg[lane])); const float M2 = 64.f * C2 * mq * mk;
    for (int v = vcu; v < NB * NH * 4; v += G) { const int bh = v >> 2, s = v & 3, b = bh >> 3, h = bh & 7;
#pragma unroll 1
        for (int i = 0; i < 4; ++i) { const int qblk = (i == 0) ? s : (i == 1) ? 7 - s : (i == 2) ? 8 + s : 15 - s;
            att::attn_unit<DBG_ABL>(b, h, qblk, Qb, Kb, Vb, MIX2, subg, lam, M2, (LAS char*)lds); } }
}
#endif


#ifdef DBG_ABLV
__global__ void __launch_bounds__(NTHREADS, 2) pv_probe(Args args) {
    const int tid = threadIdx.x, lane = tid & 63, wave = __builtin_amdgcn_readfirstlane(tid >> 6); const int G = gridDim.x, bx = blockIdx.x;
    unsigned char* ws = args.ws;
    const unsigned* ACTQ = (const unsigned*)(ws + WS_ACT); const float* ASC = (const float*)(ws + WS_ACT + 4 * MiB);
    const int tstride = (G >> 3) * NWAVES, nper = (T + tstride - 1) / tstride;
    peer_v_stage<DBG_ABLV>(nper, (bx >> 3) * NWAVES + wave, tstride, bx & 7, ws + WS_VT, (const int*)(ws + WS_EIDX), ACTQ, ASC, (const bf16*)(ws + WS_CB), args.in[12], (float*)(ws + WS_PART), lane);
}
#endif

extern "C" void kernel_launch(void* const* d_in, const int* in_sizes, int n_in, void* d_out, int out_size, void* d_ws, size_t ws_size, hipStream_t stream) {
    static int grid = 0;
    if (grid == 0) {
        if (n_in != 17 || out_size != T * DM || ws_size < WS_END) { fprintf(stderr, "kernel_launch: unexpected shapes (n_in %d out %d ws %zu)\n", n_in, out_size, ws_size); grid = -1; return; }
        int dev = 0, cus = 0, per_cu = 0;
        if (hipGetDevice(&dev) != hipSuccess || hipDeviceGetAttribute(&cus, hipDeviceAttributeMultiprocessorCount, dev) != hipSuccess) { grid = -1; return; }
        if (hipFuncSetAttribute((const void*)mk_fwd, hipFuncAttributeMaxDynamicSharedMemorySize, LDS_BYTES) != hipSuccess) { fprintf(stderr, "kernel_launch: hipFuncSetAttribute failed\n"); grid = -1; return; }
        if (hipOccupancyMaxActiveBlocksPerMultiprocessor(&per_cu, (const void*)mk_fwd, NTHREADS, LDS_BYTES) != hipSuccess || per_cu < 1) { fprintf(stderr, "kernel_launch: occupancy query says %d blocks per CU\n", per_cu); (void)hipGetLastError(); grid = -1; return; }
        grid = cus;
    }
    if (grid < 0) return;
    if (hipMemsetAsync((char*)d_ws + WS_CTL, 0, CTL_ZERO_BYTES, stream) != hipSuccess) { fprintf(stderr, "kernel_launch: memset failed\n"); return; }
    Args a{};
    for (int i = 0; i < 17; ++i) a.in[i] = (const float*)d_in[i];
    a.out = (float*)d_out; a.ws = (unsigned char*)d_ws;
#if MK_N_LAUNCHES == 1
    a.ph_lo = 0; a.ph_hi = NPHASE;
    void* kargs[] = {&a};
    hipError_t e = hipLaunchCooperativeKernel((const void*)mk_fwd, dim3(grid), dim3(NTHREADS), kargs, LDS_BYTES, stream);
    if (e != hipSuccess) fprintf(stderr, "kernel_launch: cooperative launch failed: %s (grid %d)\n", hipGetErrorString(e), grid);
#else
#ifndef DBG_DUPL
#define DBG_DUPL -1
#endif
#ifndef DBG_DUPFLAGS
#define DBG_DUPFLAGS 0
#endif
    for (int p = 0; p < NPHASE; ++p) { a.ph_lo = p; for (int r = 0; r < (p == DBG_DUPL ? 2 : 1); ++r) { a.ph_hi = (p + 1) | ((r == 1 ? DBG_DUPFLAGS : 0) << 8); hipLaunchKernelGGL(mk_fwd, dim3(grid), dim3(NTHREADS), LDS_BYTES, stream, a); }
#ifdef DBG_ABLV
        if (p == 8) hipLaunchKernelGGL(pv_probe, dim3(grid), dim3(NTHREADS), 0, stream, a);
#endif
#ifdef DBG_ABL
        if (p == 2 && ws_size >= 512 * MiB) { static bool once = false; if (!once) { once = true; (void)hipFuncSetAttribute((const void*)attn_probe, hipFuncAttributeMaxDynamicSharedMemorySize, LDS_BYTES); } hipLaunchKernelGGL(attn_probe, dim3(grid), dim3(NTHREADS), LDS_BYTES, stream, a); }
#endif
    }
#endif
}
```

```cpp
#include <hip/hip_runtime.h>
#include <hip/hip_cooperative_groups.h>
#include <cstdio>
#include <cstdint>
#include <cmath>
namespace cg = cooperative_groups;
namespace pg8 {
#define PG8_LAS __attribute__((address_space(3)))
typedef unsigned short bf16_t;
typedef short bf16x8 __attribute__((ext_vector_type(8)));
typedef float f32x4 __attribute__((ext_vector_type(4)));
typedef unsigned u32x4 __attribute__((ext_vector_type(4)));
constexpr int BM = 256, BK = 64, HALF = 128, HTB = HALF * BK * 2  , STAGE_BYTES = 8 * HTB, NXCD = 8, WGM = 8;

__host__ __device__ __forceinline__ int lds_byte(int r, int c) { const int st = (r >> 4) * 2 + (c >> 5), rr = r & 15, cc = c & 31, ob = rr * 64 + cc * 2; return st * 1024 + (ob ^ (((ob >> 9) & 1) << 5)); }
__host__ __device__ __forceinline__ void stage_rc(int b, int& R, int& C) { const int st = b / 1024, sb = b % 1024, swz = sb ^ (((sb >> 9) & 1) << 5); R = (st >> 1) * 16 + swz / 64; C = (st & 1) * 32 + (swz % 64) / 2; }
__host__ __device__ __forceinline__ int perm32(int rho) { const int n = rho >> 4, i = rho & 15; return 8 * (i >> 2) + 4 * n + (i & 3); }

struct Unit { int pm, pn; };
struct Gemm { const bf16_t* A; const bf16_t* Bt; int M, N, K; };

struct StaticOrder {
    int nM, nN, nwg, G, c, wgm;
    __host__ __device__ void init(int M, int N, int G_, int c_, int wgm_ = WGM) { nM = M / BM; nN = N / BM; nwg = nM * nN; G = G_; c = c_; wgm = wgm_; }
    __host__ __device__ bool next(int i, Unit& u) const {
        const long L = (long)i * G + c; if (L >= nwg) return false;
        int wgid = (int)L; { const int q = nwg / NXCD, r = nwg % NXCD, xcd = wgid % NXCD, off = wgid / NXCD; wgid = (xcd < r ? xcd * (q + 1) : r * (q + 1) + (xcd - r) * q) + off; }
        const int nig = wgm * nN, gid = wgid / nig, fm = gid * wgm, gsz = (nM - fm) < wgm ? (nM - fm) : wgm;
        u.pm = fm + ((wgid % nig) % gsz); u.pn = (wgid % nig) / gsz; return true;
    }
    __device__ __forceinline__ void a_ready(const Unit&) const {}
    __device__ __forceinline__ void done(const Unit&) const {}
};

__device__ __forceinline__ unsigned cvt_pk_bf16(float lo, float hi) { unsigned r; asm volatile("v_cvt_pk_bf16_f32 %0, %1, %2" : "=v"(r) : "v"(lo), "v"(hi)); return r; }
typedef float f32x2 __attribute__((ext_vector_type(2)));
__device__ __forceinline__ f32x2 gelu_pk(f32x2 v) {
    const f32x2 av = __builtin_elementwise_abs(v), d = av * 0.2316418882f + 1.0f;
    f32x2 t; t.x = __builtin_amdgcn_rcpf(d.x); t.y = __builtin_amdgcn_rcpf(d.y);
    f32x2 q = t * 0.5307027145f + (-0.7265760135f); q = q * t + 0.7107068705f; q = q * t + (-0.142248368f); q = q * t + 0.127414796f; q = q * t;
    const f32x2 s = (v * v) * (-0.72134752044f);
    f32x2 e; e.x = __builtin_amdgcn_exp2f(s.x); e.y = __builtin_amdgcn_exp2f(s.y);
    const f32x2 m = v * (q * e), r = v - m;
    f32x2 o; o.x = v.x < 0.f ? m.x : r.x; o.y = v.y < 0.f ? m.y : r.y; return o;
}

template <int ACT  > struct EpiBf16 {
    static constexpr bool PERM = true, AFTER_DRAIN = false; static_assert(ACT == 0 || ACT == 1, "EpiBf16: ACT is 0 (none) or 1 (gelu_pk)");
    bf16_t* O; int ldc; const float* bias; int split_cols; size_t split_stride; float scale0;
    __device__ __forceinline__ void operator()(const f32x4 (&acc)[2][2][4][2], const Unit& u, int wr, int wc, int fr, int fq) const {
        const int row0 = u.pm * BM + wr * 64 + fr; int colt = u.pn * BM; bf16_t* base = O;
        float sc = 1.f; if (split_cols) { const int t = colt / split_cols; base += (size_t)t * split_stride; colt -= t * split_cols; if (t == 0) sc = scale0; }
        const int col0 = colt + wc * 32 + 8 * fq, bcol0 = u.pn * BM + wc * 32 + 8 * fq;
        f32x4 bv[2][2];
#pragma unroll
        for (int bj = 0; bj < 2; ++bj)
#pragma unroll
            for (int n = 0; n < 2; ++n) bv[bj][n] = bias ? *(const f32x4*)(bias + bcol0 + bj * HALF + 4 * n) : (f32x4){0.f, 0.f, 0.f, 0.f};
#pragma unroll
        for (int ai = 0; ai < 2; ++ai)
#pragma unroll
            for (int m = 0; m < 4; ++m) { bf16_t* rowp = base + (size_t)(row0 + ai * HALF + m * 16) * ldc + col0;
#pragma unroll
                for (int bj = 0; bj < 2; ++bj) { f32x4 v0 = acc[ai][bj][m][0] + bv[bj][0], v1 = acc[ai][bj][m][1] + bv[bj][1];
                    if (ACT == 1) { f32x2 a = gelu_pk((f32x2){v0[0], v0[1]}), b = gelu_pk((f32x2){v0[2], v0[3]}), c = gelu_pk((f32x2){v1[0], v1[1]}), d = gelu_pk((f32x2){v1[2], v1[3]});
                        v0 = (f32x4){a.x, a.y, b.x, b.y}; v1 = (f32x4){c.x, c.y, d.x, d.y}; }
                    v0 = v0 * sc; v1 = v1 * sc; u32x4 w; w.x = cvt_pk_bf16(v0[0], v0[1]); w.y = cvt_pk_bf16(v0[2], v0[3]); w.z = cvt_pk_bf16(v1[0], v1[1]); w.w = cvt_pk_bf16(v1[2], v1[3]);
                    *(u32x4*)(rowp + bj * HALF) = w; } }
    }
};
template <class Epi, class Sched, bool ALIGN_EPI = false, bool SP2 = false>
__device__ __forceinline__ void gemm_phase(PG8_LAS unsigned char* lds, const Gemm g, const Sched& S, const Epi& E) {
    const int tid = threadIdx.x, wid = __builtin_amdgcn_readfirstlane(tid >> 6), lane = tid & 63, wr = wid >> 2, wc = wid & 3, fr = lane & 15, fq = lane >> 4;
    const int K = g.K, nt = K / BK;
    unsigned voffA[2], voffB[2];
#pragma unroll
    for (int i = 0; i < 2; ++i) { int R, C; stage_rc(tid * 16 + i * 8192, R, C); const int Rb = Epi::PERM ? ((R & ~31) + perm32(R & 31)) : R;
        voffA[i] = (unsigned)(R * K + C) * 2u; voffB[i] = (unsigned)(Rb * K + C) * 2u; }
    const size_t kstep = (size_t)(BK * 2);
    const size_t hstep = (size_t)HALF * K * 2;
    const size_t tstep = 2 * hstep;
    const unsigned ldsw = (unsigned)wid * 1024u;
    const int aoff = lds_byte(wr * 64 + fr, fq * 8), boff = lds_byte(wc * 32 + fr, fq * 8);
#define PG8_SA(b, h) (((b) * 2 + (h)) * HTB)
#define PG8_SB(b, h) ((4 + (b) * 2 + (h)) * HTB)
#define PG8_STAGE(bufoff, gbase, voff) do { _Pragma("unroll") for (int _i = 0; _i < 2; ++_i) \
        __builtin_amdgcn_global_load_lds((const unsigned*)((const char*)(gbase) + (voff)[_i]), (PG8_LAS unsigned*)(lds + (bufoff) + ldsw + _i * 8192), 16, 0, 0); } while (0)
#define PG8_LDA(dst, b, h) do { _Pragma("unroll") for (int m = 0; m < 4; ++m) _Pragma("unroll") for (int k = 0; k < 2; ++k) dst[m][k] = *(const PG8_LAS bf16x8*)(lds + PG8_SA(b, h) + aoff + m * 2048 + k * 1024); } while (0)
#define PG8_LDB(dst, b, h) do { _Pragma("unroll") for (int n = 0; n < 2; ++n) _Pragma("unroll") for (int k = 0; k < 2; ++k) dst[n][k] = *(const PG8_LAS bf16x8*)(lds + PG8_SB(b, h) + boff + n * 2048 + k * 1024); } while (0)
#define PG8_MMA(ai, bj, At, Bt) do { __builtin_amdgcn_s_setprio(1); _Pragma("unroll") for (int m = 0; m < 4; ++m) _Pragma("unroll") for (int n = 0; n < 2; ++n) _Pragma("unroll") for (int k = 0; k < 2; ++k) \
        acc[ai][bj][m][n] = __builtin_amdgcn_mfma_f32_16x16x32_bf16(Bt[n][k], At[m][k], acc[ai][bj][m][n], 0, 0, 0); __builtin_amdgcn_s_setprio(0); } while (0)
#define PG8_WAIT_V(n) asm volatile("s_waitcnt vmcnt(" #n ")" ::: "memory")
#define PG8_WAIT_L(n) asm volatile("s_waitcnt lgkmcnt(" #n ")" ::: "memory")
#define PG8_BAR __builtin_amdgcn_s_barrier()
#define PG8_SCHED __builtin_amdgcn_sched_barrier(0)
    Unit cur, nxt; int ui = 0;
    if (!S.next(0, cur)) return;
    f32x4 acc[2][2][4][2];
#pragma unroll
    for (int a = 0; a < 2; ++a)
#pragma unroll
        for (int b = 0; b < 2; ++b)
#pragma unroll
            for (int m = 0; m < 4; ++m)
#pragma unroll
                for (int n = 0; n < 2; ++n) acc[a][b][m][n] = (f32x4){0.f, 0.f, 0.f, 0.f};
    bf16x8 At[4][2], B0[2][2], B1[2][2];
    const char* cA = (const char*)g.A + (size_t)cur.pm * tstep; const char* cB = (const char*)g.Bt + (size_t)cur.pn * tstep;
    S.a_ready(cur);
    if constexpr (SP2) {
        PG8_STAGE(PG8_SB(0, 0), cB, voffB); PG8_STAGE(PG8_SB(0, 1), cB + hstep, voffB); PG8_STAGE(PG8_SA(0, 0), cA, voffA); PG8_STAGE(PG8_SA(0, 1), cA + hstep, voffA);
        if (wr == 1) PG8_BAR;
        PG8_WAIT_V(2); PG8_BAR;
        PG8_STAGE(PG8_SB(1, 0), cB + kstep, voffB); PG8_STAGE(PG8_SA(1, 0), cA + kstep, voffA); PG8_STAGE(PG8_SB(1, 1), cB + hstep + kstep, voffB);
        PG8_WAIT_V(6); PG8_BAR;
    } else {
        PG8_STAGE(PG8_SB(0, 0), cB, voffB); PG8_STAGE(PG8_SA(0, 0), cA, voffA); PG8_STAGE(PG8_SB(0, 1), cB + hstep, voffB); PG8_STAGE(PG8_SA(0, 1), cA + hstep, voffA);
        if (wr == 1) PG8_BAR;
        PG8_WAIT_V(4); PG8_BAR;
        PG8_STAGE(PG8_SB(1, 0), cB + kstep, voffB); PG8_STAGE(PG8_SA(1, 0), cA + kstep, voffA); PG8_STAGE(PG8_SB(1, 1), cB + hstep + kstep, voffB);
        PG8_WAIT_V(6); PG8_BAR;
    }
    for (;;) {
        const bool has_next = S.next(ui + 1, nxt);
        const char* nA = has_next ? (const char*)g.A + (size_t)nxt.pm * tstep : cA; const char* nB = has_next ? (const char*)g.Bt + (size_t)nxt.pn * tstep : cB;
        for (int t = 0; t < nt; t += 2) {
            const bool last = (t == nt - 2);
            const char* a1 = cA + (size_t)(t + 1) * kstep;
            const char* a2 = last ? nA : cA + (size_t)(t + 2) * kstep; const char* b2 = last ? nB : cB + (size_t)(t + 2) * kstep;
            const char* a3 = a2 + kstep; const char* b3 = b2 + kstep;
            if (last && has_next) S.a_ready(nxt);
            if constexpr (SP2) {
            PG8_LDB(B0, 0, 0); PG8_LDB(B1, 0, 1); PG8_SCHED; PG8_LDA(At, 0, 0); PG8_STAGE(PG8_SA(1, 1), a1 + hstep, voffA);
            PG8_WAIT_V(8); PG8_WAIT_L(0); PG8_BAR; PG8_MMA(0, 0, At, B0); PG8_MMA(0, 1, At, B1); PG8_BAR; PG8_SCHED;
            PG8_LDA(At, 0, 1); PG8_STAGE(PG8_SB(0, 0), b2, voffB); PG8_STAGE(PG8_SB(0, 1), b2 + hstep, voffB); PG8_STAGE(PG8_SA(0, 0), a2, voffA);
            PG8_WAIT_V(8); PG8_WAIT_L(0); PG8_BAR; PG8_MMA(1, 0, At, B0); PG8_MMA(1, 1, At, B1); PG8_BAR; PG8_SCHED;
            PG8_LDB(B0, 1, 0); PG8_LDB(B1, 1, 1); PG8_SCHED; PG8_LDA(At, 1, 0); PG8_STAGE(PG8_SA(0, 1), a2 + hstep, voffA);
            PG8_WAIT_V(8); PG8_WAIT_L(0); PG8_BAR; PG8_MMA(0, 0, At, B0); PG8_MMA(0, 1, At, B1); PG8_BAR; PG8_SCHED;
            PG8_LDA(At, 1, 1); PG8_STAGE(PG8_SB(1, 0), b3, voffB); PG8_STAGE(PG8_SB(1, 1), b3 + hstep, voffB); PG8_STAGE(PG8_SA(1, 0), a3, voffA);
            PG8_WAIT_V(8); PG8_WAIT_L(0); PG8_BAR; PG8_MMA(1, 0, At, B0); PG8_MMA(1, 1, At, B1); PG8_BAR; PG8_SCHED;
            } else {
            PG8_LDB(B0, 0, 0); PG8_SCHED; PG8_LDA(At, 0, 0); PG8_STAGE(PG8_SA(1, 1), a1 + hstep, voffA);
            PG8_WAIT_L(8); PG8_BAR; PG8_WAIT_L(0); PG8_MMA(0, 0, At, B0); PG8_BAR; PG8_SCHED;
            PG8_LDB(B1, 0, 1); PG8_STAGE(PG8_SB(0, 0), b2, voffB);
            PG8_BAR; PG8_WAIT_L(0); PG8_MMA(0, 1, At, B1); PG8_BAR;
            PG8_LDA(At, 0, 1); PG8_STAGE(PG8_SA(0, 0), a2, voffA);
            PG8_BAR; PG8_WAIT_L(0); PG8_MMA(1, 0, At, B0); PG8_BAR; PG8_SCHED;
            PG8_STAGE(PG8_SB(0, 1), b2 + hstep, voffB);
            PG8_WAIT_V(6); PG8_BAR; PG8_MMA(1, 1, At, B1); PG8_BAR;
            PG8_LDB(B0, 1, 0); PG8_SCHED; PG8_LDA(At, 1, 0); PG8_STAGE(PG8_SA(0, 1), a2 + hstep, voffA);
            PG8_WAIT_L(8); PG8_BAR; PG8_WAIT_L(0); PG8_MMA(0, 0, At, B0); PG8_BAR; PG8_SCHED;
            PG8_LDB(B1, 1, 1); PG8_STAGE(PG8_SB(1, 0), b3, voffB);
            PG8_BAR; PG8_WAIT_L(0); PG8_MMA(0, 1, At, B1); PG8_BAR;
            PG8_LDA(At, 1, 1); PG8_STAGE(PG8_SA(1, 0), a3, voffA);
            PG8_BAR; PG8_WAIT_L(0); PG8_MMA(1, 0, At, B0); PG8_BAR; PG8_SCHED;
            PG8_STAGE(PG8_SB(1, 1), b3 + hstep, voffB);
            PG8_WAIT_V(6); PG8_BAR; PG8_MMA(1, 1, At, B1); PG8_BAR;
            }
        }
        if constexpr (ALIGN_EPI) { if (wr == 0) PG8_BAR; }
        if constexpr (!Epi::AFTER_DRAIN) { E(acc, cur, wr, wc, fr, fq); S.done(cur); }
        if (!has_next) break;
#pragma unroll
        for (int a = 0; a < 2; ++a)
#pragma unroll
            for (int b = 0; b < 2; ++b)
#pragma unroll
                for (int m = 0; m < 4; ++m)
#pragma unroll
                    for (int n = 0; n < 2; ++n) acc[a][b][m][n] = (f32x4){0.f, 0.f, 0.f, 0.f};
        cur = nxt; cA = nA; cB = nB; ++ui;
        if constexpr (ALIGN_EPI) { if (wr == 1) PG8_BAR; }
    }
    PG8_WAIT_V(0);
    if constexpr (!ALIGN_EPI) { if (wr == 0) PG8_BAR; }
    PG8_BAR;
    if constexpr (Epi::AFTER_DRAIN) { E.fused(acc, cur, wr, wc, fr, fq, lds, wid, lane); S.done(cur); }
#undef PG8_SA
#undef PG8_SB
#undef PG8_STAGE
#undef PG8_LDA
#undef PG8_LDB
#undef PG8_MMA
#undef PG8_WAIT_V
#undef PG8_WAIT_L
#undef PG8_BAR
#undef PG8_SCHED
}
}
#define MK_N_LAUNCHES 1
#ifndef MK_N_LAUNCHES
#define MK_N_LAUNCHES 1
#endif
constexpr int DM = 2048, NB = 8, SEQ = 2048, T = NB * SEQ;
constexpr int AW = 1024, NH = 8, HD = 64, VD = 128, INC = 6144;
constexpr int PNK = 128, PTOPK = 16, PEH = 8, EPT = PEH * PTOPK;
constexpr float EPS = 1e-6f;
constexpr float C2 = 0.125f * 1.4426950408889634f;
constexpr int NPHASE = 9;
#ifndef WGM_P1
#define WGM_P1 16
#endif
#ifndef WGM_P3
#define WGM_P3 4
#endif
constexpr float U8_SCALE = 1024.f, V8_SCALE = 16.f, H8_SCALE = 16.f;
constexpr size_t MiB = 1u << 20;
constexpr size_t WS_WIN = 1 * MiB, WS_WOUT = 25 * MiB, WS_WQ = 33 * MiB, WS_SK = 41 * MiB, WS_SSQ = 42 * MiB, WS_EIDX = 44 * MiB, WS_EGATE = 52 * MiB, WS_RSTD = 60 * MiB;
constexpr size_t WS_XN = 64 * MiB;
constexpr size_t WS_Q = 128 * MiB, WS_K = 160 * MiB, WS_V = 192 * MiB;
constexpr size_t WS_CB = 224 * MiB, WS_CC = 256 * MiB, WS_CX = 288 * MiB;
constexpr size_t WS_UT = 320 * MiB, WS_VT = 384 * MiB, WS_END = 448 * MiB;
constexpr size_t WS_CTL = 0; constexpr int CW_BAR = 1024, CTL_ZERO_BYTES = 65536;
constexpr size_t WS_H8 = 288 * MiB;
constexpr size_t WS_PART = 64 * MiB, WS_ACT = 192 * MiB;
constexpr int MISC_OFF = 143360;
constexpr int LDS_BYTES = 147456;
constexpr int NWAVES = 8, NTHREADS = 512;

#define LAS __attribute__((address_space(3)))
typedef unsigned short bf16;
typedef unsigned v4u __attribute__((ext_vector_type(4)));
typedef unsigned v2u __attribute__((ext_vector_type(2)));
typedef float f32x4 __attribute__((ext_vector_type(4)));
typedef float f32x2 __attribute__((ext_vector_type(2)));
typedef float f32x16 __attribute__((ext_vector_type(16)));
typedef short bf16x8 __attribute__((ext_vector_type(8)));
typedef short s16x4 __attribute__((ext_vector_type(4)));
typedef __bf16 bf16x2_t __attribute__((ext_vector_type(2)));
#define LDS_WAIT() asm volatile("s_waitcnt lgkmcnt(0)" ::: "memory")
__device__ __forceinline__ unsigned pk2(float lo, float hi) { f32x2 v = {lo, hi}; bf16x2_t b = __builtin_convertvector(v, bf16x2_t); return __builtin_bit_cast(unsigned, b); }
__device__ __forceinline__ float bflo(unsigned u) { return __uint_as_float(u << 16); }
__device__ __forceinline__ float bfhi(unsigned u) { return __uint_as_float(u & 0xffff0000u); }
__device__ __forceinline__ float wave_sum(float v) {
#pragma unroll
    for (int o = 1; o < 64; o <<= 1) v += __shfl_xor(v, o);
    return v;
}
__device__ __forceinline__ float wave_max(float v) {
#pragma unroll
    for (int o = 1; o < 64; o <<= 1) v = fmaxf(v, __shfl_xor(v, o));
    return v;
}

#define XB_TMO      128
#define XB_XCNT(j)  (256  + 64 * (j))
#define XB_XSUB(j)  (1280 + 64 * (j))
#define XB_XGEN(j)  (2304 + 64 * (j))
#define XB_TOP      3328
#define XB_TOPGEN   3392
#define XCD_BAR_WORDS 3456
#define XB_SPIN_CAP (1u << 18)

__device__ __forceinline__ unsigned xb_ld(unsigned* p)              { return __hip_atomic_load(p, __ATOMIC_RELAXED, __HIP_MEMORY_SCOPE_AGENT); }
__device__ __forceinline__ unsigned xb_add(unsigned* p, unsigned v) { return __hip_atomic_fetch_add(p, v, __ATOMIC_RELAXED, __HIP_MEMORY_SCOPE_AGENT); }
__device__ __forceinline__ unsigned xb_xcc_id() { return (unsigned)__builtin_amdgcn_s_getreg((3 << 11) | 20) & 0xFu; }
#define XB_SPIN(cond, bar) do { unsigned _sp = 0; while (cond) { __builtin_amdgcn_s_sleep(1); \
    if ((++_sp & 255u) == 0u) { if (xb_ld(&(bar)[XB_TMO])) break; if (_sp > XB_SPIN_CAP) { atomicAdd(&(bar)[XB_TMO], 1u); break; } } } } while (0)

struct XcdBarrier {
    unsigned* bar; unsigned x;
    volatile LAS unsigned* st;
};

__device__ __forceinline__ XcdBarrier xcd_barrier_post(unsigned* bar, volatile LAS unsigned* st) {
    XcdBarrier b; b.bar = bar; b.x = xb_xcc_id(); b.st = st;
    if (threadIdx.x == 0) (void)xb_add(&bar[XB_XCNT(b.x)], 1u);
    return b;
}
__device__ __forceinline__ void xcd_barrier_complete(unsigned* bar, unsigned x, unsigned& nloc, unsigned& nx) {
    const unsigned G = gridDim.x * gridDim.y * gridDim.z;
    unsigned sum, cnt, mine, sp = 0u;
    for (;;) {
        sum = 0u; cnt = 0u; mine = 0u;
#pragma unroll
        for (unsigned j = 0; j < 16; ++j) { const unsigned c = xb_ld(&bar[XB_XCNT(j)]); sum += c; cnt += (c > 0u) ? 1u : 0u; mine = (j == x) ? c : mine; }
        if (sum == G) break;
        __builtin_amdgcn_s_sleep(1);
        if ((++sp & 255u) == 0u) { if (xb_ld(&bar[XB_TMO])) break; if (sp > XB_SPIN_CAP) { atomicAdd(&bar[XB_TMO], 1u); break; } }
    }
    nloc = mine > 0u ? mine : 1u; nx = cnt > 0u ? cnt : 1u;
}

__device__ __forceinline__ void xcd_barrier(const XcdBarrier& b) {
    asm volatile("s_waitcnt vmcnt(0)" ::: "memory");
    __syncthreads();
    if (threadIdx.x == 0) {
        unsigned* bar = b.bar;
        __builtin_amdgcn_s_waitcnt(0);
        unsigned nloc = b.st[0], nx = b.st[1];
        if (nloc == 0u) { xcd_barrier_complete(bar, b.x, nloc, nx); b.st[0] = nloc; b.st[1] = nx; }
        const unsigned old = xb_add(&bar[XB_XSUB(b.x)], 1u);
        const unsigned gen = old / nloc;
        if (old + 1u == (gen + 1u) * nloc) {
            __builtin_amdgcn_fence(__ATOMIC_RELEASE, "agent");
            asm volatile("s_waitcnt vmcnt(0)" ::: "memory");
            const unsigned og = xb_add(&bar[XB_TOP], 1u);
            const unsigned tg = og / nx;
            if (og + 1u == (tg + 1u) * nx) xb_add(&bar[XB_TOPGEN], 1u);
            else XB_SPIN(xb_ld(&bar[XB_TOPGEN]) == tg, bar);
            __builtin_amdgcn_fence(__ATOMIC_ACQUIRE, "agent");
            xb_add(&bar[XB_XGEN(b.x)], 1u);
            asm volatile("s_waitcnt vmcnt(0)" ::: "memory");
        } else {
            XB_SPIN(xb_ld(&bar[XB_XGEN(b.x)]) == gen, bar);
            __builtin_amdgcn_fence(__ATOMIC_ACQUIRE, "agent");
            asm volatile("s_waitcnt vmcnt(0)" ::: "memory");
        }
    }
    __syncthreads();
}


namespace pg8 {
struct EpiProj {
    static constexpr bool PERM = true, AFTER_DRAIN = false;
    bf16_t* base0; const float* qg; const float* kg;
    __device__ __forceinline__ void operator()(const f32x4 (&acc)[2][2][4][2], const Unit& u, int wr, int wc, int fr, int fq) const {
        const int region = u.pn >> 2;
        bf16_t* O = base0 + (size_t)region * (16u << 20);
        const int row0 = u.pm * BM + wr * 64 + fr, col0 = (u.pn & 3) * 256 + wc * 64 + 8 * fq;
        if (region < 2) {
            const float* g = region == 0 ? qg : kg; const float sc = region == 0 ? 0.125f * 1.4426950408889634f : 1.0f;
            f32x4 gv[2][2];
#pragma unroll
            for (int bj = 0; bj < 2; ++bj)
#pragma unroll
                for (int n = 0; n < 2; ++n) gv[bj][n] = *(const f32x4*)(g + bj * 32 + 8 * fq + 4 * n) * sc;
#pragma unroll
            for (int ai = 0; ai < 2; ++ai)
#pragma unroll
                for (int m = 0; m < 4; ++m) {
                    float ss = 0.f;
#pragma unroll
                    for (int bj = 0; bj < 2; ++bj)
#pragma unroll
                        for (int n = 0; n < 2; ++n) { const f32x4 x = acc[ai][bj][m][n]; ss += (x[0] * x[0] + x[1] * x[1]) + (x[2] * x[2] + x[3] * x[3]); }
                    ss += __shfl_xor(ss, 16); ss += __shfl_xor(ss, 32);
                    const float rs = __builtin_amdgcn_rsqf(ss * (1.0f / 64.0f) + 1e-6f);
                    bf16_t* rowp = O + (size_t)(row0 + ai * HALF + m * 16) * 1024 + col0;
#pragma unroll
                    for (int bj = 0; bj < 2; ++bj) { const f32x4 v0 = acc[ai][bj][m][0] * rs * gv[bj][0], v1 = acc[ai][bj][m][1] * rs * gv[bj][1];
                        u32x4 w; w.x = cvt_pk_bf16(v0[0], v0[1]); w.y = cvt_pk_bf16(v0[2], v0[3]); w.z = cvt_pk_bf16(v1[0], v1[1]); w.w = cvt_pk_bf16(v1[2], v1[3]);
                        *(u32x4*)(rowp + bj * 32) = w; }
                }
        } else {
#pragma unroll
            for (int ai = 0; ai < 2; ++ai)
#pragma unroll
                for (int m = 0; m < 4; ++m) { bf16_t* rowp = O + (size_t)(row0 + ai * HALF + m * 16) * 1024 + col0;
#pragma unroll
                    for (int bj = 0; bj < 2; ++bj) { const f32x4 v0 = acc[ai][bj][m][0], v1 = acc[ai][bj][m][1];
                        u32x4 w; w.x = cvt_pk_bf16(v0[0], v0[1]); w.y = cvt_pk_bf16(v0[2], v0[3]); w.z = cvt_pk_bf16(v1[0], v1[1]); w.w = cvt_pk_bf16(v1[2], v1[3]);
                        *(u32x4*)(rowp + bj * 32) = w; } }
        }
    }
};
struct EpiX1 {
    static constexpr bool PERM = true, AFTER_DRAIN = false;
    const float* x; float* out; bf16_t* a2; const float* gf; float* ssq; unsigned char* h8;
    __device__ __forceinline__ void operator()(const f32x4 (&acc)[2][2][4][2], const Unit& u, int wr, int wc, int fr, int fq) const {
        const int row0 = u.pm * BM + wr * 64 + fr, col0 = u.pn * BM + wc * 32 + 8 * fq;
        f32x4 gv[2][2];
#pragma unroll
        for (int bj = 0; bj < 2; ++bj)
#pragma unroll
            for (int n = 0; n < 2; ++n) gv[bj][n] = *(const f32x4*)(gf + col0 + bj * HALF + 4 * n);
#pragma unroll
        for (int ai = 0; ai < 2; ++ai)
#pragma unroll
            for (int m = 0; m < 4; ++m) { const int row = row0 + ai * HALF + m * 16; const size_t off = (size_t)row * 2048 + col0; float ss = 0.f;
#pragma unroll
                for (int bj = 0; bj < 2; ++bj) {
                    const f32x4 x0 = *(const f32x4*)(x + off + bj * HALF), x1 = *(const f32x4*)(x + off + bj * HALF + 4);
                    const f32x4 v0 = x0 + acc[ai][bj][m][0], v1 = x1 + acc[ai][bj][m][1];
                    ss += (v0[0] * v0[0] + v0[1] * v0[1]) + (v0[2] * v0[2] + v0[3] * v0[3]); ss += (v1[0] * v1[0] + v1[1] * v1[1]) + (v1[2] * v1[2] + v1[3] * v1[3]);
                    const f32x4 a0 = v0 * gv[bj][0], a1 = v1 * gv[bj][1];
                    u32x4 w; w.x = cvt_pk_bf16(a0[0], a0[1]); w.y = cvt_pk_bf16(a0[2], a0[3]); w.z = cvt_pk_bf16(a1[0], a1[1]); w.w = cvt_pk_bf16(a1[2], a1[3]);
                    *(u32x4*)(a2 + off + bj * HALF) = w;
                    { const f32x4 b0 = a0 * 16.0f, b1 = a1 * 16.0f; unsigned p = 0u, q2 = 0u;
#pragma unroll
                      for (int e_ = 0; e_ < 4; ++e_) { const int i0_ = __builtin_amdgcn_fmed3f(__builtin_rintf(b0[e_]), -127.f, 127.f), i1_ = __builtin_amdgcn_fmed3f(__builtin_rintf(b1[e_]), -127.f, 127.f);
                          p |= ((unsigned)i0_ & 0xffu) << (8 * e_); q2 |= ((unsigned)i1_ & 0xffu) << (8 * e_); }
                      typedef unsigned u32x2_ __attribute__((ext_vector_type(2))); *(u32x2_*)(h8 + off + bj * HALF) = (u32x2_){p, q2}; } }
                ss += __shfl_xor(ss, 16); ss += __shfl_xor(ss, 32);
                if (fq == 0) ssq[(size_t)row * 32 + u.pn * 4 + wc] = ss; }
    }
};
}

__device__ __forceinline__ void p0_transpose_item(const float* W, int K, int N, bf16* WT, LAS float* scr, int item, int lane, bool permg) {
    const int nblk = N / 32, kb = item / nblk, nb = item % nblk, k0 = 64 * kb, n0 = 32 * nb;
#pragma unroll 8
    for (int i = 0; i < 32; ++i) { const int kk = 2 * i + (lane >> 5); scr[kk * 33 + (lane & 31)] = W[(size_t)(k0 + kk) * N + n0 + (lane & 31)]; }
    LDS_WAIT(); asm volatile("" ::: "memory");
    int nd = n0; if (permg) { const int gl = (n0 & 255) >> 5; nd = (n0 & ~255) + 32 * (4 * (gl & 1) + (gl >> 1)); }
    const int c = lane & 7;
#pragma unroll
    for (int j = 0; j < 4; ++j) { const int n = (lane >> 3) + 8 * j; const LAS float* s = scr + (8 * c) * 33 + n;
        v4u o; o.x = pk2(s[0 * 33], s[1 * 33]); o.y = pk2(s[2 * 33], s[3 * 33]); o.z = pk2(s[4 * 33], s[5 * 33]); o.w = pk2(s[6 * 33], s[7 * 33]);
        *(v4u*)(WT + (size_t)(nd + n) * K + k0 + 8 * c) = o; }
    LDS_WAIT(); asm volatile("" ::: "memory");
}
__device__ __forceinline__ void rms_row_to_bf16(const float* xrow, const float* g, bf16* orow, int lane) {
    const f32x4* xr = (const f32x4*)xrow + lane; const f32x4* gr = (const f32x4*)g + lane;
    f32x4 v[8]; float s = 0.f;
#pragma unroll
    for (int j = 0; j < 8; ++j) { v[j] = xr[64 * j]; s += (v[j].x * v[j].x + v[j].y * v[j].y) + (v[j].z * v[j].z + v[j].w * v[j].w); }
    const float rstd = 1.0f / sqrtf(wave_sum(s) * (1.f / DM) + EPS);
    v2u* o8 = (v2u*)orow + lane;
#pragma unroll
    for (int j = 0; j < 8; ++j) { const f32x4 gg = gr[64 * j]; v2u w; w.x = pk2(v[j].x * rstd * gg.x, v[j].y * rstd * gg.y); w.y = pk2(v[j].z * rstd * gg.z, v[j].w * rstd * gg.w); o8[64 * j] = w; }
}
__device__ __forceinline__ void cvt_bf16_stream(const float* src, bf16* dst, size_t n8, size_t gtid, size_t nthr) {
    for (size_t i = gtid; i < n8; i += nthr) { const f32x4 a = *(const f32x4*)(src + i * 8), b = *(const f32x4*)(src + i * 8 + 4);
        v4u o; o.x = pk2(a.x, a.y); o.y = pk2(a.z, a.w); o.z = pk2(b.x, b.y); o.w = pk2(b.z, b.w); *(v4u*)(dst + i * 8) = o; }
}

__device__ __forceinline__ void cvt_i4_slices(const float* src, unsigned char* dst, float inv_step, size_t gtid, size_t nthr) {
    for (size_t i = gtid; i < (size_t)16384 * 64; i += nthr) { v4u o; const size_t e = i >> 6; const int c32 = (int)(i & 63), s = c32 >> 3, sub = c32 & 7;
#pragma unroll
        for (int w = 0; w < 4; ++w) { const f32x4 a = *(const f32x4*)(src + i * 32 + 8 * w) * inv_step, b = *(const f32x4*)(src + i * 32 + 8 * w + 4) * inv_step; unsigned d = 0u;
#pragma unroll
            for (int e_ = 0; e_ < 4; ++e_) { const int lo = (int)__builtin_amdgcn_fmed3f(__builtin_rintf(a[e_]), -8.f, 7.f) + 8, hi = (int)__builtin_amdgcn_fmed3f(__builtin_rintf(b[e_]), -8.f, 7.f) & 15; d |= ((unsigned)lo | ((unsigned)hi << 4)) << (8 * e_); }
            if (w == 0) o.x = d; else if (w == 1) o.y = d; else if (w == 2) o.z = d; else o.w = d; }
        *(v4u*)(dst + ((size_t)s * 16384 + e) * 128 + 16 * sub) = o; }
}
__device__ __forceinline__ float table_std16(const float* src, LAS float* scr, int tid) {
    float s = 0.f;
#pragma unroll
    for (int j = 0; j < 16; ++j) { const f32x4 v = *(const f32x4*)(src + (size_t)(j * 512 + tid) * 4); s += (v.x * v.x + v.y * v.y) + (v.z * v.z + v.w * v.w); }
    s = wave_sum(s);
    __syncthreads();
    if ((tid & 63) == 0) scr[tid >> 6] = s;
    __syncthreads();
    float t = 0.f;
#pragma unroll
    for (int w = 0; w < 8; ++w) t += scr[w];
    __syncthreads();
    return sqrtf(t * (1.0f / 32768.0f));
}
__device__ __forceinline__ void cvt_i8_slices(const float* src, unsigned char* dst, float scale, size_t gtid, size_t nthr) {
    for (size_t i = gtid; i < (size_t)16384 * 128; i += nthr) { v4u o; const size_t e = i >> 7; const int c16 = (int)(i & 127), s = c16 >> 3, sub = c16 & 7;
#pragma unroll
        for (int q = 0; q < 4; ++q) { const f32x4 a = *(const f32x4*)(src + i * 16 + 4 * q) * scale; unsigned w = 0u;
#pragma unroll
            for (int e_ = 0; e_ < 4; ++e_) { const int iv = (int)__builtin_amdgcn_fmed3f(__builtin_rintf(a[e_]), -127.f, 127.f); w |= ((unsigned)iv & 0xffu) << (8 * e_); }
            if (q == 0) o.x = w; else if (q == 1) o.y = w; else if (q == 2) o.z = w; else o.w = w; }
        *(v4u*)(dst + ((size_t)s * 16384 + e) * 128 + 16 * sub) = o; }
}
__device__ __forceinline__ void cvt_fp8_slices(const float* src, unsigned char* dst, float scale, size_t gtid, size_t nthr) {
    for (size_t i = gtid; i < (size_t)16384 * 128; i += nthr) { v4u o; const size_t e = i >> 7; const int c16 = (int)(i & 127), s = c16 >> 3, sub = c16 & 7;
#pragma unroll
        for (int q = 0; q < 4; ++q) { const f32x4 a = *(const f32x4*)(src + i * 16 + 4 * q) * scale; int w = __builtin_amdgcn_cvt_pk_fp8_f32(a.x, a.y, 0, false); w = __builtin_amdgcn_cvt_pk_fp8_f32(a.z, a.w, w, true);
            if (q == 0) o.x = (unsigned)w; else if (q == 1) o.y = (unsigned)w; else if (q == 2) o.z = (unsigned)w; else o.w = (unsigned)w; }
        *(v4u*)(dst + ((size_t)s * 16384 + e) * 128 + 16 * sub) = o; }
}

namespace att {
constexpr int SLOTB = 32768;
constexpr int NSLOT = 3, LW_OFF = NSLOT * SLOTB;
constexpr int XSTR = 132;
__device__ __forceinline__ void glds16(const void* gsrc, unsigned lds_dst) { unsigned keep;
    asm volatile("s_mov_b32 %0, m0\n\ts_mov_b32 m0, %2\n\ts_nop 0\n\tglobal_load_lds_dwordx4 %1, off\n\ts_mov_b32 m0, %0" : "=&s"(keep) : "v"(gsrc), "s"(lds_dst) : "memory"); }
__device__ __forceinline__ int crow(int r, int hi) { return (r & 3) + 8 * (r >> 2) + 4 * hi; }
typedef short v4i16_t __attribute__((ext_vector_type(4)));
__device__ __forceinline__ s16x4 vtr(const LAS char* p) { return __builtin_bit_cast(s16x4, __builtin_amdgcn_ds_read_tr16_b64_v4i16((LAS v4i16_t*)p)); }
#define ATT_WAIT_BAR(N) asm volatile("s_waitcnt vmcnt(" #N ") lgkmcnt(0)\n\ts_barrier" ::: "memory")
#define ATT_BAR() asm volatile("s_waitcnt lgkmcnt(0)\n\ts_barrier" ::: "memory")

template <int ABL> __device__ __forceinline__ void attn_unit(int b, int h, int qblk, const bf16* Q, const bf16* K, const bf16* V, bf16* MIX, const float* subg, float lam, float M2, LAS char* lds) {
    const int tid = threadIdx.x, lane = tid & 63, r32 = lane & 31, hi = lane >> 5, wid = __builtin_amdgcn_readfirstlane(tid >> 6), c = wid >> 2, qs = wid & 3;
    const size_t rowbase = (size_t)b * SEQ; const int q0 = qblk * 128, NT = 2 * (qblk + 1);
    const unsigned lds0 = (unsigned)(uintptr_t)lds;
    const bf16* ksrc[2]; const bf16* vsrc[2]; unsigned kdst[2], vdst[2];
#pragma unroll
    for (int i = 0; i < 2; ++i) { const int pk = 2 * wid + i, rr = lane >> 4, p = lane & 15, r = 4 * pk + rr;
        ksrc[i] = K + (rowbase + r) * 1024 + h * 128 + ((p ^ (r & 15)) * 8); kdst[i] = lds0 + pk * 1024;
        vsrc[i] = V + (rowbase + r) * 1024 + h * 128 + ((p ^ (rr << 2)) * 8); vdst[i] = lds0 + 16384 + pk * 1024; }
#define ATT_DMA(t, slot) do { _Pragma("unroll") for (int i_ = 0; i_ < 2; ++i_) { glds16(ksrc[i_] + (size_t)(t) * 64 * 1024, (unsigned)__builtin_amdgcn_readfirstlane(kdst[i_] + (slot) * SLOTB)); \
        glds16(vsrc[i_] + (size_t)(t) * 64 * 1024, (unsigned)__builtin_amdgcn_readfirstlane(vdst[i_] + (slot) * SLOTB)); } } while (0)
    ATT_DMA(0, 0); ATT_DMA(1, 1);
    const int qrow = q0 + 32 * qs + r32;
    bf16x8 qr[4];
#pragma unroll
    for (int d0 = 0; d0 < 4; ++d0) qr[d0] = *(const bf16x8*)(Q + (rowbase + qrow) * 1024 + h * 128 + c * 64 + d0 * 16 + hi * 8);
    asm volatile("" : "+v"(qr[0]), "+v"(qr[1]), "+v"(qr[2]), "+v"(qr[3]));
    const float slope2 = exp2f(-(float)(h + 1)) * 1.4426950408889634f;
    float base = -slope2 * (float)(qrow - 4 * hi) - M2;
    const float s32 = 32.f * slope2, s64 = 64.f * slope2;
    f32x16 o[4]; o[0] = f32x16{}; o[1] = f32x16{}; o[2] = f32x16{}; o[3] = f32x16{};
    float lsum = 0.f;
    int kofs[4], vofs[4];
    { const int q4 = (lane & 15) >> 2, p4 = lane & 3, gb = (lane >> 4) & 1;
#pragma unroll
      for (int d0 = 0; d0 < 4; ++d0) { kofs[d0] = r32 * 256 + (((8 * c + 2 * d0 + hi) ^ (r32 & 15)) << 4); vofs[d0] = 16384 + (4 * hi + q4) * 256 + (((((d0 ^ q4) << 2) | (gb << 1) | (p4 >> 1))) << 4) + (p4 & 1) * 8; } }
    const LAS char* lbase = (const LAS char*)lds;
    const int qw0 = q0 + 32 * qs;
#define ATT_PW(ks_) __builtin_bit_cast(bf16x8, ((v4u){pwd[4 * (ks_)], pwd[4 * (ks_) + 1], pwd[4 * (ks_) + 2], pwd[4 * (ks_) + 3]}))
#define ATT_VF(F, d_) ((bf16x8){F[2 * (d_)][0], F[2 * (d_)][1], F[2 * (d_)][2], F[2 * (d_)][3], F[2 * (d_) + 1][0], F[2 * (d_) + 1][1], F[2 * (d_) + 1][2], F[2 * (d_) + 1][3]})
#define ATT_VLDK(F, ks_) do { if (ABL & 16) { _Pragma("unroll") for (int d_ = 0; d_ < 8; ++d_) F[d_] = (s16x4){0, 0, 0, 0}; } else { _Pragma("unroll") for (int d_ = 0; d_ < 4; ++d_) { F[2 * d_] = vtr(sp_ + vofs[d_] + (ks_) * 4096); F[2 * d_ + 1] = vtr(sp_ + vofs[d_] + (ks_) * 4096 + 2048); } } } while (0)
#define ATT_MF(acc_, a_, b_) do { if (ABL & 2) { bf16x8 a__ = (a_), b__ = (b_); asm volatile("" :: "v"(a__), "v"(b__)); } else acc_ = __builtin_amdgcn_mfma_f32_32x32x16_bf16((a_), (b_), acc_, 0, 0, 0); } while (0)
#define ATT_PVK(F, ks_) do { _Pragma("unroll") for (int d_ = 0; d_ < 4; ++d_) ATT_MF(o[d_], ATT_PW(ks_), ATT_VF(F, d_)); } while (0)
#define ATT_SB() __builtin_amdgcn_sched_barrier(0)
    int slot = 0;
    for (int t = 0; t < NT; ++t) {
        if ((ABL & 64) && t > 0) { } else if (t == 0 || (ABL & 8)) { ATT_WAIT_BAR(0); } else if (t + 1 < NT) { ATT_WAIT_BAR(4); } else { ATT_WAIT_BAR(0); }
        if (!(ABL & 8) && t + 2 < NT) { const int s2_ = (slot == 0) ? 2 : slot - 1; ATT_DMA(t + 2, s2_); }
        const int k0 = 64 * t;
        if (k0 <= qw0 + 31) {
            const LAS char* sp_ = lbase + slot * SLOTB;
            f32x16 p0, p1; s16x4 fa[8], fb[8]; unsigned pwd[16];
#pragma unroll
            for (int r = 0; r < 16; ++r) { p0[r] = __builtin_fmaf(slope2, (float)((r & 3) + 8 * (r >> 2)), base); p1[r] = p0[r] + s32; }
            const bool diag = k0 + 63 > qw0;
            const int dq = qrow - k0;
            {
                float sA = 0.f, sB = 0.f, sC = 0.f, sD = 0.f; float e0[16], e1[16];
                __builtin_amdgcn_s_setprio(1);
#pragma unroll
                for (int d0 = 0; d0 < 4; ++d0) { const bf16x8 ka = *(const LAS bf16x8*)(sp_ + kofs[d0]); if (ABL & 4) { asm volatile("" :: "v"(ka)); } else p0 = __builtin_amdgcn_mfma_f32_32x32x16_bf16(ka, qr[d0], p0, 0, 0, 0); }
                ATT_VLDK(fa, 0); ATT_SB();
#pragma unroll
                for (int d0 = 0; d0 < 4; ++d0) { const bf16x8 kb = *(const LAS bf16x8*)(sp_ + kofs[d0] + 8192); if (ABL & 4) { asm volatile("" :: "v"(kb)); } else p1 = __builtin_amdgcn_mfma_f32_32x32x16_bf16(kb, qr[d0], p1, 0, 0, 0);
#pragma unroll
                    for (int i = 0; i < 4; ++i) e0[4 * d0 + i] = (ABL & 1) ? p0[4 * d0 + i] : __builtin_amdgcn_exp2f(p0[4 * d0 + i]);
                    if (diag) {
#pragma unroll
                        for (int i = 0; i < 4; ++i) if (crow(4 * d0 + i, hi) > dq) e0[4 * d0 + i] = 0.f; }
                    sA += e0[4 * d0]; sB += e0[4 * d0 + 1]; sC += e0[4 * d0 + 2]; sD += e0[4 * d0 + 3]; ATT_SB(); }
                ATT_VLDK(fb, 1);
#pragma unroll
                for (int j = 0; j < 8; ++j) pwd[j] = pk2(e0[2 * j], e0[2 * j + 1]);
                ATT_SB();
#pragma unroll
                for (int d_ = 0; d_ < 4; ++d_) { ATT_MF(o[d_], ATT_PW(0), ATT_VF(fa, d_));
                    e1[2 * d_] = (ABL & 1) ? p1[2 * d_] : __builtin_amdgcn_exp2f(p1[2 * d_]); e1[2 * d_ + 1] = (ABL & 1) ? p1[2 * d_ + 1] : __builtin_amdgcn_exp2f(p1[2 * d_ + 1]);
                    if (diag) { if (crow(2 * d_, hi) + 32 > dq) e1[2 * d_] = 0.f; if (crow(2 * d_ + 1, hi) + 32 > dq) e1[2 * d_ + 1] = 0.f; }
                    sA += e1[2 * d_]; sB += e1[2 * d_ + 1]; ATT_SB(); }
                ATT_VLDK(fa, 2); ATT_SB();
#pragma unroll
                for (int d_ = 0; d_ < 4; ++d_) { ATT_MF(o[d_], ATT_PW(1), ATT_VF(fb, d_));
                    e1[8 + 2 * d_] = (ABL & 1) ? p1[8 + 2 * d_] : __builtin_amdgcn_exp2f(p1[8 + 2 * d_]); e1[8 + 2 * d_ + 1] = (ABL & 1) ? p1[8 + 2 * d_ + 1] : __builtin_amdgcn_exp2f(p1[8 + 2 * d_ + 1]);
                    if (diag) { if (crow(8 + 2 * d_, hi) + 32 > dq) e1[8 + 2 * d_] = 0.f; if (crow(8 + 2 * d_ + 1, hi) + 32 > dq) e1[8 + 2 * d_ + 1] = 0.f; }
                    sC += e1[8 + 2 * d_]; sD += e1[8 + 2 * d_ + 1];
                    pwd[8 + d_] = pk2(e1[2 * d_], e1[2 * d_ + 1]); ATT_SB(); }
                ATT_VLDK(fb, 3);
#pragma unroll
                for (int j = 4; j < 8; ++j) pwd[8 + j] = pk2(e1[2 * j], e1[2 * j + 1]);
                lsum += (sA + sB) + (sC + sD);
                ATT_SB();
                ATT_PVK(fa, 2); ATT_SB(); ATT_PVK(fb, 3);
                __builtin_amdgcn_s_setprio(0);
            }
        }
        base += s64;
        slot = (slot == NSLOT - 1) ? 0 : slot + 1;
    }
#undef ATT_PW
#undef ATT_VF
#undef ATT_VLDK
#undef ATT_PVK
#undef ATT_MF
#undef ATT_SB
    ATT_WAIT_BAR(0);
    if (ABL & 32) { float keep_ = lsum + o[0][0] + o[1][1] + o[2][2] + o[3][3]; asm volatile("" :: "v"(keep_)); return; }
    LAS float* lw = (LAS float*)(lds + LW_OFF) + wid * 32;
    { auto rr = __builtin_amdgcn_permlane32_swap(__float_as_uint(lsum), __float_as_uint(lsum), false, false); lsum = __uint_as_float(rr[0]) + __uint_as_float(rr[1]); }
    if (hi == 0) lw[r32] = lsum;
    LDS_WAIT();
    LAS float* X = (LAS float*)lds + qs * 32 * XSTR;
#pragma unroll
    for (int r = 0; r < 16; ++r) { const float rl = 1.0f / lw[crow(r, hi)];
#pragma unroll
        for (int d0 = 0; d0 < 4; ++d0) o[d0][r] *= rl; }
    if (c == 1) {
#pragma unroll
        for (int r = 0; r < 16; ++r)
#pragma unroll
            for (int d0 = 0; d0 < 4; ++d0) X[crow(r, hi) * XSTR + d0 * 32 + r32] = o[d0][r];
    }
    ATT_WAIT_BAR(0);
    if (c == 0) {
#pragma unroll
        for (int r = 0; r < 16; ++r)
#pragma unroll
            for (int d0 = 0; d0 < 4; ++d0) { LAS float* px = X + crow(r, hi) * XSTR + d0 * 32 + r32; const float a = o[d0][r] - lam * (*px); *px = a; }
        LDS_WAIT(); asm volatile("" ::: "memory");
        const LAS f32x4* rp = (const LAS f32x4*)(X + r32 * XSTR + hi * 64);
        f32x4 av[16]; float ss = 0.f;
#pragma unroll
        for (int j = 0; j < 16; ++j) { av[j] = rp[j]; ss += (av[j].x * av[j].x + av[j].y * av[j].y) + (av[j].z * av[j].z + av[j].w * av[j].w); }
        { auto rr = __builtin_amdgcn_permlane32_swap(__float_as_uint(ss), __float_as_uint(ss), false, false); ss = __uint_as_float(rr[0]) + __uint_as_float(rr[1]); }
        const float rs = 0.8f / sqrtf(ss * (1.0f / 128.0f) + EPS);
        bf16* op = MIX + (rowbase + qrow) * 2048 + h * 128 + hi * 64;
#pragma unroll
        for (int j = 0; j < 8; ++j) { const f32x4 g0 = *(const f32x4*)(subg + hi * 64 + 8 * j), g1 = *(const f32x4*)(subg + hi * 64 + 8 * j + 4); const f32x4 a0 = av[2 * j] * rs * g0, a1 = av[2 * j + 1] * rs * g1;
            v4u w; w.x = pk2(a0.x, a0.y); w.y = pk2(a0.z, a0.w); w.z = pk2(a1.x, a1.y); w.w = pk2(a1.z, a1.w); *(v4u*)(op + 8 * j) = w; }
    }
    ATT_BAR();
#undef ATT_DMA
}
}


#ifndef DBG_NAIVE_ATTN
#define DBG_NAIVE_ATTN 0
#endif
#if DBG_NAIVE_ATTN
__device__ __forceinline__ void naive_attn_row(int b, int h, int q, const bf16* Q, const bf16* K, const bf16* V, bf16* MIX, const float* subg, float lam, LAS float* S, int lane) {
    const size_t rowbase = (size_t)b * SEQ; const float slope2 = exp2f(-(float)(h + 1)) * 1.4426950408889634f;
    for (int c = 0; c < 2; ++c) {
        float qv[64];
        const bf16* qp = Q + (rowbase + q) * 1024 + h * 128 + c * 64;
#pragma unroll
        for (int d = 0; d < 64; d += 2) { const unsigned u = *(const unsigned*)(qp + d); qv[d] = bflo(u); qv[d + 1] = bfhi(u); }
        for (int key = lane; key <= q; key += 64) { const bf16* kp = K + (rowbase + key) * 1024 + h * 128 + c * 64; float s = 0.f;
#pragma unroll
            for (int d = 0; d < 64; d += 2) { const unsigned u = *(const unsigned*)(kp + d); s += qv[d] * bflo(u) + qv[d + 1] * bfhi(u); }
            S[c * 2048 + key] = s - slope2 * (float)(q - key); }
    }
    LDS_WAIT();
    float linv[2];
    for (int c = 0; c < 2; ++c) { float m = -1e30f; for (int key = lane; key <= q; key += 64) m = fmaxf(m, S[c * 2048 + key]); m = wave_max(m);
        float l = 0.f; for (int key = lane; key <= q; key += 64) { const float p = exp2f(S[c * 2048 + key] - m); S[c * 2048 + key] = p; l += p; } linv[c] = 1.0f / wave_sum(l); }
    for (int key = lane; key <= q; key += 64) S[key] = S[key] * linv[0] - lam * S[2048 + key] * linv[1];
    LDS_WAIT();
    float o0 = 0.f, o1 = 0.f; const bf16* vp = V + rowbase * 1024 + h * 128 + lane;
    for (int key = 0; key <= q; ++key) { const float a = S[key]; o0 += a * __uint_as_float((unsigned)vp[(size_t)key * 1024] << 16); o1 += a * __uint_as_float((unsigned)vp[(size_t)key * 1024 + 64] << 16); }
    const float ss = wave_sum(o0 * o0 + o1 * o1); const float rs = 0.8f / sqrtf(ss * (1.0f / 128.0f) + EPS);
    bf16* op = MIX + (rowbase + q) * 2048 + h * 128 + lane;
    op[0] = (bf16)(pk2(o0 * rs * subg[lane], 0.f) & 0xffffu); op[64] = (bf16)(pk2(o1 * rs * subg[lane + 64], 0.f) & 0xffffu);
    LDS_WAIT();
}
#endif

__device__ __forceinline__ unsigned ord_key(float f) { const unsigned u = __float_as_uint(f); return (u & 0x80000000u) ? ~u : (u | 0x80000000u); }
__device__ __forceinline__ float ord_val(unsigned k) { return __uint_as_float((k & 0x80000000u) ? (k ^ 0x80000000u) : ~k); }
#define CE_DESC(a, b) do { const unsigned hi__ = max((a), (b)), lo__ = min((a), (b)); (a) = hi__; (b) = lo__; } while (0)
__device__ __forceinline__ void sort16_desc(unsigned (&v)[16]) {
#pragma unroll
    for (int k = 2; k <= 16; k <<= 1)
#pragma unroll
        for (int j = k >> 1; j > 0; j >>= 1)
#pragma unroll
            for (int i = 0; i < 16; ++i) { const int l = i ^ j; if (l > i) { if ((i & k) == 0) CE_DESC(v[i], v[l]); else CE_DESC(v[l], v[i]); } }
}
__device__ __forceinline__ void merge16_desc_rev(unsigned (&a)[16], const unsigned (&brev)[16]) {
#pragma unroll
    for (int i = 0; i < 16; ++i) a[i] = max(a[i], brev[i]);
#pragma unroll
    for (int j = 8; j > 0; j >>= 1)
#pragma unroll
        for (int i = 0; i < 16; ++i) { const int l = i ^ j; if (l > i) CE_DESC(a[i], a[l]); }
}

constexpr int P5_LST_OFF = 65536, P5_TAB_OFF = P5_LST_OFF + 16384;
__device__ __forceinline__ void peer_topk_item(int tile, int h, const bf16* QP, const float* SSQ, int* EIDX, float* EGATE, float* RSTD, LAS char* lds) {
    const int tid = threadIdx.x, lane = tid & 63, r32 = lane & 31, hi = lane >> 5, wid = __builtin_amdgcn_readfirstlane(tid >> 6);
    LAS unsigned* LST = (LAS unsigned*)(lds + P5_LST_OFF);
    const LAS unsigned char* TAB = (const LAS unsigned char*)(lds + P5_TAB_OFF);
    const int tok0 = tile * 128;
    {
        const int c = wid >> 2, tb = wid & 3;
        bf16x8 qf[8];
        const bf16* qp = QP + (size_t)(tok0 + tb * 32 + r32) * 2048 + h * 256 + c * 128 + hi * 8;
#pragma unroll
        for (int s = 0; s < 8; ++s) qf[s] = *(const bf16x8*)(qp + 16 * s);
        const LAS char* sp = lds + c * 32768 + hi * 2048 + r32 * 16;
        unsigned best[16];
#pragma unroll
        for (int kb = 0; kb < 4; ++kb) { f32x16 acc = f32x16{};
#pragma unroll
            for (int s = 0; s < 8; ++s) { const bf16x8 sf = *(const LAS bf16x8*)(sp + s * 4096 + kb * 512); acc = __builtin_amdgcn_mfma_f32_32x32x16_bf16(sf, qf[s], acc, 0, 0, 0); }
            unsigned v[16];
#pragma unroll
            for (int r = 0; r < 16; ++r) v[r] = (ord_key(acc[r]) & ~0x7Fu) | (unsigned)(32 * kb + (r & 3) + 8 * (r >> 2)) | (unsigned)(hi << 2);
            sort16_desc(v);
            if (kb == 0) {
#pragma unroll
                for (int i = 0; i < 16; ++i) best[i] = v[i];
            } else { unsigned vr[16];
#pragma unroll
                for (int i = 0; i < 16; ++i) vr[i] = v[15 - i];
                merge16_desc_rev(best, vr); } }
        {
            unsigned br[16];
#pragma unroll
            for (int i = 0; i < 16; ++i) br[i] = (unsigned)__shfl_xor((int)best[15 - i], 32);
            merge16_desc_rev(best, br); }
        if (hi == 0) { LAS unsigned* lrow = LST + (c * 128 + tb * 32 + r32) * 16;
#pragma unroll
            for (int i = 0; i < 4; ++i) *(LAS v4u*)(lrow + 4 * i) = (v4u){best[4 * i], best[4 * i + 1], best[4 * i + 2], best[4 * i + 3]}; }
    }
    __syncthreads();
    {
        const int token = tid >> 2, q = tid & 3;
        const LAS unsigned* l1 = LST + token * 16; const LAS unsigned* l2 = LST + (128 + token) * 16;
        unsigned v[16];
#pragma unroll
        for (int m = 0; m < 13; ++m) { const int n = 4 * m + q; const unsigned pid = TAB[n < 50 ? n : 0]; const unsigned a = l1[pid >> 4], b2 = l2[pid & 15u];
            const unsigned key = (ord_key(ord_val(a & ~0x7Fu) + ord_val(b2 & ~0x7Fu)) & ~0xFFu) | pid; v[m] = n < 50 ? key : 0u; }
        v[13] = 0u; v[14] = 0u; v[15] = 0u;
        sort16_desc(v);
#pragma unroll
        for (int w = 1; w <= 2; w <<= 1) { unsigned br[16];
#pragma unroll
            for (int i = 0; i < 16; ++i) br[i] = (unsigned)__shfl_xor((int)v[15 - i], w);
            merge16_desc_rev(v, br); }
        const int t = tok0 + token;
        const f32x4 p0 = *(const f32x4*)(SSQ + (size_t)t * 32 + 8 * q), p1 = *(const f32x4*)(SSQ + (size_t)t * 32 + 8 * q + 4);
        float ssq = ((p0.x + p0.y) + (p0.z + p0.w)) + ((p1.x + p1.y) + (p1.z + p1.w));
        ssq += __shfl_xor(ssq, 1); ssq += __shfl_xor(ssq, 2);
        const float rstd = 1.0f / sqrtf(ssq * (1.0f / DM) + EPS);
        if (h == 0 && q == 0) RSTD[t] = rstd;
        const unsigned p_top = v[0] & 0xFFu; const float vmax = (ord_val(l1[p_top >> 4] & ~0x7Fu) + ord_val(l2[p_top & 15u] & ~0x7Fu)) * rstd;
        float ev[4]; int ex[4]; float es = 0.f;
#pragma unroll
        for (int m = 0; m < 4; ++m) { const unsigned kk = q == 0 ? v[m] : q == 1 ? v[4 + m] : q == 2 ? v[8 + m] : v[12 + m];
            const unsigned pid = kk & 0xFFu; const unsigned a = l1[pid >> 4], b2 = l2[pid & 15u];
            const float sv = (ord_val(a & ~0x7Fu) + ord_val(b2 & ~0x7Fu)) * rstd;
            ev[m] = __expf(sv - vmax); es += ev[m]; ex[m] = (int)((a & 0x7Fu) * 128u + (b2 & 0x7Fu)); }
        es += __shfl_xor(es, 1); es += __shfl_xor(es, 2);
        const float inv = 1.0f / es;
        *(int4*)(EIDX + (size_t)t * 128 + h * 16 + 4 * q) = make_int4(ex[0], ex[1], ex[2], ex[3]);
        *(f32x4*)(EGATE + (size_t)t * 128 + h * 16 + 4 * q) = (f32x4){ev[0] * inv, ev[1] * inv, ev[2] * inv, ev[3] * inv};
    }
    __syncthreads();
}

__device__ __forceinline__ f32x2 dot16_fp8(const v4u u, const f32x2* h, f32x2 acc) {
#pragma unroll
    for (int w = 0; w < 4; ++w) { const unsigned d = w == 0 ? u.x : w == 1 ? u.y : w == 2 ? u.z : u.w;
        const f32x2 f0 = __builtin_amdgcn_cvt_pk_f32_fp8((int)d, false), f1 = __builtin_amdgcn_cvt_pk_f32_fp8((int)d, true);
        acc = __builtin_elementwise_fma(h[2 * w], f0, acc); acc = __builtin_elementwise_fma(h[2 * w + 1], f1, acc); }
    return acc;
}
__device__ __forceinline__ void axpy16_fp8(const v4u v, f32x2 a2, f32x2* o) {
#pragma unroll
    for (int w = 0; w < 4; ++w) { const unsigned d = w == 0 ? v.x : w == 1 ? v.y : w == 2 ? v.z : v.w;
        const f32x2 f0 = __builtin_amdgcn_cvt_pk_f32_fp8((int)d, false), f1 = __builtin_amdgcn_cvt_pk_f32_fp8((int)d, true);
        o[2 * w] = __builtin_elementwise_fma(a2, f0, o[2 * w]); o[2 * w + 1] = __builtin_elementwise_fma(a2, f1, o[2 * w + 1]); }
}
struct PItem { int t, s; };
__device__ __forceinline__ PItem peer_item(int q, int nq, int nper, int tb, int tstride, int xl) {
    const int j = (q < nq ? q : nq - 1) >> 1; PItem it; const int r = j >= nper ? 1 : 0; it.s = 8 * r + xl; const int t = tb + (j - r * nper) * tstride; it.t = t < T ? t : T - 1; return it; }
__device__ __forceinline__ void pe_idx8(const PItem it, int hh, const int* EIDX, int g, int (&ex)[8]) {
#pragma unroll
    for (int i = 0; i < 2; ++i) { const int4 v = *(const int4*)(EIDX + (size_t)it.t * 128 + g * 16 + 8 * hh + 4 * i); ex[4 * i] = v.x; ex[4 * i + 1] = v.y; ex[4 * i + 2] = v.z; ex[4 * i + 3] = v.w; }
}
__device__ __forceinline__ void pe_gather8(const PItem it, const unsigned char* TB, int sub, const int (&ex)[8], v4u (&uv)[8]) {
    const unsigned char* ub = TB + (size_t)it.s * 16384 * 128;
#pragma unroll
    for (int i = 0; i < 8; ++i) uv[i] = *(const v4u*)(ub + (unsigned)(ex[i] * 128 + 16 * sub));
}
__device__ __forceinline__ int sdot4(unsigned a, unsigned b, int acc) { return __builtin_amdgcn_sdot4((int)a, (int)b, acc, false); }
__device__ __forceinline__ void pu_acc8(const v4u (&uv)[8], const v4u ha, const v4u hb, int hs8, int (&r)[8]) {
#pragma unroll
    for (int i = 0; i < 8; ++i) { int a = -hs8, b = 0;
        a = sdot4(uv[i].x & 0x0F0F0F0Fu, ha.x, a); b = sdot4(uv[i].x & 0xF0F0F0F0u, ha.y, b); a = sdot4(uv[i].y & 0x0F0F0F0Fu, ha.z, a); b = sdot4(uv[i].y & 0xF0F0F0F0u, ha.w, b);
        a = sdot4(uv[i].z & 0x0F0F0F0Fu, hb.x, a); b = sdot4(uv[i].z & 0xF0F0F0F0u, hb.y, b); a = sdot4(uv[i].w & 0x0F0F0F0Fu, hb.z, a); b = sdot4(uv[i].w & 0xF0F0F0F0u, hb.w, b);
        r[i] = a + (b >> 4); }
}
__device__ __forceinline__ void pu_store(const PItem it, bool valid, float* PART, int lane, const int (&rlo)[8], const int (&rhi)[8]) {
    const int g = lane >> 3, sub = lane & 7;
    int r[16];
#pragma unroll
    for (int i = 0; i < 8; ++i) { r[i] = rlo[i]; r[8 + i] = rhi[i]; }
    { const bool up = (lane & 4) != 0;
#pragma unroll
      for (int j = 0; j < 8; ++j) { const int a = r[j], b2 = r[j + 8]; const int keep = up ? b2 : a, send = up ? a : b2; const int m_ = __builtin_amdgcn_update_dpp(0, send, 0x141, 0xf, 0xf, false); r[j] = keep + __builtin_amdgcn_update_dpp(0, m_, 0x1B, 0xf, 0xf, false); } }
    { const bool up = (lane & 2) != 0;
#pragma unroll
      for (int j = 0; j < 4; ++j) { const int a = r[j], b2 = r[j + 4]; const int keep = up ? b2 : a, send = up ? a : b2; r[j] = keep + __builtin_amdgcn_update_dpp(0, send, 0x4E, 0xf, 0xf, false); } }
    { const bool up = (lane & 1) != 0;
#pragma unroll
      for (int j = 0; j < 2; ++j) { const int a = r[j], b2 = r[j + 2]; const int keep = up ? b2 : a, send = up ? a : b2; r[j] = keep + __builtin_amdgcn_update_dpp(0, send, 0xB1, 0xf, 0xf, false); } }
    const int i0 = 8 * ((sub >> 2) & 1) + 4 * ((sub >> 1) & 1) + 2 * (sub & 1);
    if (valid) *(f32x2*)(PART + ((size_t)it.s * T + it.t) * 128 + g * 16 + i0) = (f32x2){(float)r[0], (float)r[1]};
}
__device__ __forceinline__ PItem peer_item1(int q, int nq, int tb, int tstride, int xl) { const int j = (q < nq ? q : nq - 1) >> 1; PItem it; it.s = xl; const int t = tb + j * tstride; it.t = t < T ? t : T - 1; return it; }
__device__ __forceinline__ void peer_u_stage(int nper, int tb, int tstride, int xl, const unsigned char* H8, const unsigned char* U8, const int* EIDX, float* PART, int lane) {
    const int g = lane >> 3, sub = lane & 7, NQ = 2 * nper;
    int ex0[8], ex1[8], ex2[8], ex3[8]; v4u uv0[8], uv1[8], uv2[8], uv3[8], ha0, ha1, ha2, ha3, hb0, hb1, hb2, hb3; int rs[8];
#define PU_I(q, X) do { const PItem it_ = peer_item1((q), NQ, tb, tstride, xl); pe_idx8(it_, (X) & 1, EIDX, g, ex##X); } while (0)
#define PU_G(q, X) do { const PItem it_ = peer_item1((q), NQ, tb, tstride, xl); pe_gather8(it_, U8, sub, ex##X, uv##X); const unsigned char* hp_ = H8 + (size_t)it_.t * 2048 + 256 * it_.s + 32 * sub; ha##X = *(const v4u*)hp_; hb##X = *(const v4u*)(hp_ + 16); } while (0)
#define PU_F(q, X) do { const PItem it_ = peer_item1((q), NQ, tb, tstride, xl); int hs_ = sdot4(ha##X.x, 0x01010101u, 0); hs_ = sdot4(ha##X.z, 0x01010101u, hs_); hs_ = sdot4(hb##X.x, 0x01010101u, hs_); hs_ = sdot4(hb##X.z, 0x01010101u, hs_); \
        if (((X) & 1) == 0) pu_acc8(uv##X, ha##X, hb##X, 8 * hs_, rs); else { int rh_[8]; pu_acc8(uv##X, ha##X, hb##X, 8 * hs_, rh_); \
        pu_store(it_, (q) < NQ && (tb + ((q) >> 1) * tstride) < T, PART, lane, rs, rh_); } } while (0)
    PU_I(0, 0); PU_I(1, 1); PU_I(2, 2); PU_I(3, 3); PU_G(0, 0); PU_G(1, 1); PU_G(2, 2);
#pragma unroll 1
    for (int q = 0; q < NQ; q += 4) {
        PU_F(q, 0);     PU_G(q + 3, 3); PU_I(q + 4, 0);
        PU_F(q + 1, 1); PU_G(q + 4, 0); PU_I(q + 5, 1);
        PU_F(q + 2, 2); PU_G(q + 5, 1); PU_I(q + 6, 2);
        PU_F(q + 3, 3); PU_G(q + 6, 2); PU_I(q + 7, 3);
    }
#undef PU_I
#undef PU_G
#undef PU_F
}
__device__ __forceinline__ void tr4x4(unsigned r0, unsigned r1, unsigned r2, unsigned r3, unsigned& c0, unsigned& c1, unsigned& c2, unsigned& c3) {
    const unsigned a = __builtin_amdgcn_perm(r1, r0, 0x05010400u), b = __builtin_amdgcn_perm(r1, r0, 0x07030602u), c = __builtin_amdgcn_perm(r3, r2, 0x05010400u), d = __builtin_amdgcn_perm(r3, r2, 0x07030602u);
    c0 = __builtin_amdgcn_perm(c, a, 0x05040100u); c1 = __builtin_amdgcn_perm(c, a, 0x07060302u); c2 = __builtin_amdgcn_perm(d, b, 0x05040100u); c3 = __builtin_amdgcn_perm(d, b, 0x07060302u);
}
template <bool FIRST> __device__ __forceinline__ void pv_acc8(const v4u (&vv)[8], const unsigned aq0, const unsigned aq1, int (&acc)[32]) {
#pragma unroll
    for (int m = 0; m < 2; ++m) { const unsigned aq = m == 0 ? aq0 : aq1;
#pragma unroll
        for (int w = 0; w < 4; ++w) { unsigned d[4];
#pragma unroll
            for (int i = 0; i < 4; ++i) d[i] = w == 0 ? vv[4 * m + i].x : w == 1 ? vv[4 * m + i].y : w == 2 ? vv[4 * m + i].z : vv[4 * m + i].w;
            unsigned c0, c1, c2, c3;
            tr4x4(d[0], d[1], d[2], d[3], c0, c1, c2, c3);
            const bool z_ = FIRST && m == 0;
            acc[8 * w + 0] = sdot4(c0, aq, z_ ? 0 : acc[8 * w + 0]); acc[8 * w + 1] = sdot4(c1, aq, z_ ? 0 : acc[8 * w + 1]); acc[8 * w + 2] = sdot4(c2, aq, z_ ? 0 : acc[8 * w + 2]); acc[8 * w + 3] = sdot4(c3, aq, z_ ? 0 : acc[8 * w + 3]);
            acc[8 * w + 4] = sdot4(c0 & 0xF0F0F0F0u, aq, z_ ? 0 : acc[8 * w + 4]); acc[8 * w + 5] = sdot4(c1 & 0xF0F0F0F0u, aq, z_ ? 0 : acc[8 * w + 5]); acc[8 * w + 6] = sdot4(c2 & 0xF0F0F0F0u, aq, z_ ? 0 : acc[8 * w + 6]); acc[8 * w + 7] = sdot4(c3 & 0xF0F0F0F0u, aq, z_ ? 0 : acc[8 * w + 7]); } }
}
__device__ __forceinline__ void pv_store(const PItem it, bool valid, float* out, const f32x4 ginv, const float sc, int lane, int (&acc)[32], int asum, const v2u x1b) {
    const int g = lane >> 3, sub = lane & 7;
#pragma unroll
    for (int w_ = 0; w_ < 4; ++w_)
#pragma unroll
        for (int b_ = 0; b_ < 4; ++b_) acc[8 * w_ + b_] -= acc[8 * w_ + 4 + b_];
#pragma unroll
    for (int j = 0; j < 16; ++j) { const auto r_ = __builtin_amdgcn_permlane32_swap((unsigned)acc[j], (unsigned)acc[j + 16], false, false); acc[j] = (int)r_[0] + (int)r_[1]; }
#pragma unroll
    for (int j = 0; j < 8; ++j) { const auto r_ = __builtin_amdgcn_permlane16_swap((unsigned)acc[j], (unsigned)acc[j + 8], false, false); acc[j] = (int)r_[0] + (int)r_[1]; }
    { const bool up = (lane & 8) != 0;
#pragma unroll
      for (int j = 0; j < 4; ++j) { const int a = acc[j], b2 = acc[j + 4]; const int keep = up ? b2 : a, send = up ? a : b2; acc[j] = keep + __builtin_amdgcn_update_dpp(0, send, 0x128, 0xf, 0xf, false); } }
    asum += __builtin_amdgcn_update_dpp(0, asum, 0x128, 0xf, 0xf, false);
    { const auto r_ = __builtin_amdgcn_permlane16_swap((unsigned)asum, (unsigned)asum, false, false); asum = (int)r_[0] + (int)r_[1]; }
    { const auto r_ = __builtin_amdgcn_permlane32_swap((unsigned)asum, (unsigned)asum, false, false); asum = (int)r_[0] + (int)r_[1]; }
    const int c0 = 16 * ((g >> 2) & 1) + 8 * ((g >> 1) & 1) + 4 * (g & 1);
    const bool hicol = (c0 & 4) != 0;
    int v_[4];
#pragma unroll
    for (int i = 0; i < 4; ++i) v_[i] = hicol ? (acc[i] >> 4) : (acc[i] - 8 * asum);
    if (valid) *(f32x4*)(out + (size_t)it.t * 2048 + 256 * it.s + 32 * sub + c0) = (f32x4){bflo(x1b.x) * ginv.x + sc * (float)v_[0], bfhi(x1b.x) * ginv.y + sc * (float)v_[1], bflo(x1b.y) * ginv.z + sc * (float)v_[2], bfhi(x1b.y) * ginv.w + sc * (float)v_[3]};
}
template <int ABL> __device__ __forceinline__ void peer_v_stage(int nper, int tb, int tstride, int xl, const unsigned char* V8, const int* EIDX, const unsigned* ACTQ, const float* ASC, const bf16* A2, const float* ffn_g, float* out, int lane) {
    const int g = lane >> 3, sub = lane & 7, NQ = 2 * nper;
    const int c0 = 16 * ((g >> 2) & 1) + 8 * ((g >> 1) & 1) + 4 * (g & 1);
    int ex0[8], ex1[8], ex2[8], ex3[8]; v4u vv0[8], vv1[8], vv2[8], vv3[8]; v2u aq0, aq1, aq2, aq3, x1a, x1b; float sca = 0.f, scb = 0.f; int acc[32]; int asum = 0;
    f32x4 ginv; { const f32x4 gg = *(const f32x4*)(ffn_g + 256 * xl + 32 * sub + c0); ginv = (f32x4){1.0f / gg.x, 1.0f / gg.y, 1.0f / gg.z, 1.0f / gg.w}; }
#define PV_I(q, X) do { const PItem it_ = peer_item1((q), NQ, tb, tstride, xl); pe_idx8(it_, (X) & 1, EIDX, g, ex##X); } while (0)
#define PV_G(q, X, XV, SCV) do { const PItem it_ = peer_item1((q), NQ, tb, tstride, xl); if (ABL & 2) { _Pragma("unroll") for (int i_ = 0; i_ < 8; ++i_) vv##X[i_] = (v4u){(unsigned)ex##X[i_], 1u, 2u, 3u}; } else pe_gather8(it_, V8, sub, ex##X, vv##X); \
        aq##X = *(const v2u*)(ACTQ + (size_t)it_.t * 32 + g * 4 + 2 * ((X) & 1)); \
        if ((X) & 1) { XV = *(const v2u*)(A2 + (size_t)it_.t * 2048 + 256 * it_.s + 32 * sub + c0); SCV = ASC[it_.t]; } } while (0)
#define PV_F(q, X, XV, SCV) do { const PItem it_ = peer_item1((q), NQ, tb, tstride, xl); if (((X) & 1) == 0) asum = 0; \
        asum = sdot4(aq##X.x, 0x01010101u, asum); asum = sdot4(aq##X.y, 0x01010101u, asum); \
        if (ABL & 1) { _Pragma("unroll") for (int i_ = 0; i_ < 8; ++i_) asm volatile("" :: "v"(vv##X[i_])); acc[0] += (int)aq##X.x; } else pv_acc8<((X) & 1) == 0>(vv##X, aq##X.x, aq##X.y, acc); if ((X) & 1) pv_store(it_, (q) < NQ && (tb + ((q) >> 1) * tstride) < T, out, ginv, SCV, lane, acc, asum, XV); } while (0)
    PV_I(0, 0); PV_I(1, 1); PV_I(2, 2); PV_I(3, 3); PV_G(0, 0, x1a, sca); PV_G(1, 1, x1a, sca); PV_G(2, 2, x1b, scb);
#pragma unroll 1
    for (int q = 0; q < NQ; q += 4) {
        PV_F(q, 0, x1a, sca);     PV_G(q + 3, 3, x1b, scb); PV_I(q + 4, 0);
        PV_F(q + 1, 1, x1a, sca); PV_G(q + 4, 0, x1a, sca); PV_I(q + 5, 1);
        PV_F(q + 2, 2, x1b, scb); PV_G(q + 5, 1, x1a, sca); PV_I(q + 6, 2);
        PV_F(q + 3, 3, x1b, scb); PV_G(q + 6, 2, x1b, scb); PV_I(q + 7, 3);
    }
#undef PV_I
#undef PV_G
#undef PV_F
}

struct Args { const float* in[17]; float* out; unsigned char* ws; int ph_lo, ph_hi; };
__global__ void __launch_bounds__(NTHREADS, 2) mk_fwd(Args args) {
    extern __shared__ __attribute__((aligned(16))) unsigned char lds_raw[];
    LAS unsigned char* lds = (LAS unsigned char*)lds_raw;
    const int tid = threadIdx.x, lane = tid & 63, wave = __builtin_amdgcn_readfirstlane(tid >> 6);
    const int G = gridDim.x, bx = blockIdx.x;
    const int vcu = (G % 8 == 0) ? (bx % 8) * (G / 8) + bx / 8 : bx;
    unsigned char* ws = args.ws;
    const float* x = args.in[0]; const float* attn_g = args.in[1]; const float* w_in = args.in[2]; const float* qg = args.in[3]; const float* kg = args.in[4];
    const float* lq1 = args.in[5]; const float* lk1 = args.in[6]; const float* lq2 = args.in[7]; const float* lk2 = args.in[8]; const float* subg = args.in[9];
    const float* conv_w = args.in[10]; const float* w_out = args.in[11]; const float* ffn_g = args.in[12]; const float* w_q = args.in[13]; const float* subkeys = args.in[14];
    const float* peer_u = args.in[15]; const float* peer_v = args.in[16];
    float* out = args.out;
    bf16* WtIn = (bf16*)(ws + WS_WIN); bf16* WtOut = (bf16*)(ws + WS_WOUT); bf16* WtQ = (bf16*)(ws + WS_WQ); bf16* SK = (bf16*)(ws + WS_SK);
    float* SSQ = (float*)(ws + WS_SSQ); int* EIDX = (int*)(ws + WS_EIDX); float* EGATE = (float*)(ws + WS_EGATE); float* RSTD = (float*)(ws + WS_RSTD);
    bf16* XN = (bf16*)(ws + WS_XN); bf16* MIX = XN;
    bf16* Qb = (bf16*)(ws + WS_Q); bf16* Kb = (bf16*)(ws + WS_K); bf16* Vb = (bf16*)(ws + WS_V); bf16* QP = Qb;
    bf16* CB = (bf16*)(ws + WS_CB); bf16* CC = (bf16*)(ws + WS_CC); bf16* CX = (bf16*)(ws + WS_CX); bf16* A2 = CB;
    unsigned char* U8 = ws + WS_UT; unsigned char* V8 = ws + WS_VT;
    volatile LAS unsigned* MISC = (volatile LAS unsigned*)(lds + MISC_OFF);
    if (tid < 16) MISC[tid] = 0u;
    __syncthreads();
    XcdBarrier bar = xcd_barrier_post((unsigned*)(ws + WS_CTL) + CW_BAR, MISC + 8);
    const int lo = args.ph_lo, hi_ph = args.ph_hi & 255, dbg_flags = args.ph_hi >> 8;
#ifndef DBG_DUP
#define DBG_DUP -1
#endif
#ifndef DBG_MASK
#define DBG_MASK 0xfff
#endif
#define IN(k) (((DBG_MASK >> (k)) & 1) && lo <= (k) && (k) < hi_ph)
#define REPS(k) for (int rep_ = 0; rep_ < ((DBG_DUP == (k)) ? 2 : 1); ++rep_)
#define SEAM(k) do { if (IN(k) && IN((k) + 1)) xcd_barrier(bar); } while (0)
    const int gw = vcu * NWAVES + wave, NGW = G * NWAVES;
    const size_t gtid = (size_t)bx * NTHREADS + tid, nthr = (size_t)G * NTHREADS;

    if (IN(0)) REPS(0) {
        LAS float* scr = (LAS float*)(lds + wave * 16384);
        constexpr int I_IN = (DM / 64) * (INC / 32), I_SQ = (DM / 64) * (DM / 32);
        if (!(dbg_flags & 4))
        for (int it = gw; it < I_IN + 2 * I_SQ; it += NGW) {
            if (it < I_IN) p0_transpose_item(w_in, DM, INC, WtIn, scr, it, lane, true);
            else if (it < I_IN + I_SQ) p0_transpose_item(w_out, DM, DM, WtOut, scr, it - I_IN, lane, false);
            else p0_transpose_item(w_q, DM, DM, WtQ, scr, it - I_IN - I_SQ, lane, false);
        }
        if (!(dbg_flags & 8))
        for (int m = gw; m < T; m += NGW) rms_row_to_bf16(x + (size_t)m * DM, attn_g, XN + (size_t)m * DM, lane);
        cvt_bf16_stream(subkeys, SK, (size_t)PEH * 2 * PNK * 128 / 8, gtid, nthr);
        if (!(dbg_flags & 16))
        {
            const float sig = table_std16(peer_u, (LAS float*)(lds + MISC_OFF + 64), tid); const float step = 0.335f * sig;
            if (bx == 0 && tid == 0) ((float*)(ws + WS_RSTD))[T] = step;
            cvt_i4_slices(peer_u, U8, 1.0f / step, gtid, nthr); }
        if (!(dbg_flags & 32))
        {
            const float sig = table_std16(peer_v, (LAS float*)(lds + MISC_OFF + 64), tid); const float step = 0.335f * sig;
            if (bx == 0 && tid == 0) ((float*)(ws + WS_RSTD))[T + 1] = step;
            cvt_i4_slices(peer_v, V8, 1.0f / step, gtid, nthr); }
    }
    SEAM(0);
    if (IN(1)) REPS(1) {
        pg8::Gemm g{XN, WtIn, T, INC, DM}; pg8::StaticOrder S; S.init(T, INC, G, bx, WGM_P1);
        pg8::EpiProj E{Qb, qg, kg};
        pg8::gemm_phase<pg8::EpiProj, pg8::StaticOrder, true, true>(lds, g, S, E);
    }
    SEAM(1);
    if (IN(2)) REPS(2) {
        float a = lq1[lane] * lk1[lane], b2 = lq2[lane] * lk2[lane];
        a = wave_sum(a); b2 = wave_sum(b2);
        const float lam = expf(a) - expf(b2) + 0.2f;
        const float mq = wave_max(fabsf(qg[lane])), mk = wave_max(fabsf(kg[lane]));
        const float M2 = 64.f * C2 * mq * mk;
#if DBG_NAIVE_ATTN
        for (int r = gw; r < NB * NH * SEQ; r += NGW) naive_attn_row(r >> 14, (r >> 11) & 7, r & 2047, Qb, Kb, Vb, MIX, subg, lam, (LAS float*)(lds + wave * 16384), lane);
        if (0)
#endif
        if (!(dbg_flags & 2))
        for (int v = vcu; v < NB * NH * 4; v += G) {
            const int bh = v >> 2, s = v & 3, b = bh >> 3, h = bh & 7;
#pragma unroll 1
            for (int i = 0; i < 4; ++i) { const int qblk = (i == 0) ? s : (i == 1) ? 7 - s : (i == 2) ? 8 + s : 15 - s;
                att::attn_unit<0>(b, h, qblk, Qb, Kb, Vb, MIX, subg, lam, M2, (LAS char*)lds); }
        }
        if (!(dbg_flags & 1))
        for (size_t it = gtid; it < (size_t)(T / 16) * 128; it += nthr) {
            const int cg8 = (int)(it & 127), chunk = (int)(it >> 7), t0 = chunk * 16, col = cg8 * 8;
            f32x4 w0a = *(const f32x4*)(conv_w + col), w0b = *(const f32x4*)(conv_w + col + 4), w1a = *(const f32x4*)(conv_w + 1024 + col), w1b = *(const f32x4*)(conv_w + 1024 + col + 4),
                  w2a = *(const f32x4*)(conv_w + 2048 + col), w2b = *(const f32x4*)(conv_w + 2048 + col + 4);
            float u1[8], u2[8];
#pragma unroll
            for (int i = 0; i < 8; ++i) { u1[i] = 0.f; u2[i] = 0.f; }
            if ((t0 % SEQ) != 0) {
                const v4u c1 = *(const v4u*)(CC + (size_t)(t0 - 1) * 1024 + col), x1v = *(const v4u*)(CX + (size_t)(t0 - 1) * 1024 + col), c2 = *(const v4u*)(CC + (size_t)(t0 - 2) * 1024 + col), x2v = *(const v4u*)(CX + (size_t)(t0 - 2) * 1024 + col);
                u1[0] = bflo(c1.x) * bflo(x1v.x); u1[1] = bfhi(c1.x) * bfhi(x1v.x); u1[2] = bflo(c1.y) * bflo(x1v.y); u1[3] = bfhi(c1.y) * bfhi(x1v.y); u1[4] = bflo(c1.z) * bflo(x1v.z); u1[5] = bfhi(c1.z) * bfhi(x1v.z); u1[6] = bflo(c1.w) * bflo(x1v.w); u1[7] = bfhi(c1.w) * bfhi(x1v.w);
                u2[0] = bflo(c2.x) * bflo(x2v.x); u2[1] = bfhi(c2.x) * bfhi(x2v.x); u2[2] = bflo(c2.y) * bflo(x2v.y); u2[3] = bfhi(c2.y) * bfhi(x2v.y); u2[4] = bflo(c2.z) * bflo(x2v.z); u2[5] = bfhi(c2.z) * bfhi(x2v.z); u2[6] = bflo(c2.w) * bflo(x2v.w); u2[7] = bfhi(c2.w) * bfhi(x2v.w);
            }
            const float w0[8] = {w0a.x, w0a.y, w0a.z, w0a.w, w0b.x, w0b.y, w0b.z, w0b.w}, w1[8] = {w1a.x, w1a.y, w1a.z, w1a.w, w1b.x, w1b.y, w1b.z, w1b.w}, w2[8] = {w2a.x, w2a.y, w2a.z, w2a.w, w2b.x, w2b.y, w2b.z, w2b.w};
#pragma unroll 4
            for (int j = 0; j < 16; ++j) { const size_t ro = (size_t)(t0 + j) * 1024 + col;
                const v4u bv = *(const v4u*)(CB + ro), cv = *(const v4u*)(CC + ro), xv = *(const v4u*)(CX + ro);
                float u0[8], bb[8], y[8];
                u0[0] = bflo(cv.x) * bflo(xv.x); u0[1] = bfhi(cv.x) * bfhi(xv.x); u0[2] = bflo(cv.y) * bflo(xv.y); u0[3] = bfhi(cv.y) * bfhi(xv.y); u0[4] = bflo(cv.z) * bflo(xv.z); u0[5] = bfhi(cv.z) * bfhi(xv.z); u0[6] = bflo(cv.w) * bflo(xv.w); u0[7] = bfhi(cv.w) * bfhi(xv.w);
                bb[0] = bflo(bv.x); bb[1] = bfhi(bv.x); bb[2] = bflo(bv.y); bb[3] = bfhi(bv.y); bb[4] = bflo(bv.z); bb[5] = bfhi(bv.z); bb[6] = bflo(bv.w); bb[7] = bfhi(bv.w);
#pragma unroll
                for (int i = 0; i < 8; ++i) { y[i] = bb[i] * (u2[i] * w0[i] + u1[i] * w1[i] + u0[i] * w2[i]); u2[i] = u1[i]; u1[i] = u0[i]; }
                v4u o; o.x = pk2(y[0], y[1]); o.y = pk2(y[2], y[3]); o.z = pk2(y[4], y[5]); o.w = pk2(y[6], y[7]);
                *(v4u*)(MIX + (size_t)(t0 + j) * 2048 + 1024 + col) = o; }
        }
    }
    SEAM(2);
    if (IN(3)) REPS(3) {
        pg8::Gemm g{MIX, WtOut, T, DM, DM}; pg8::StaticOrder S; S.init(T, DM, G, bx, WGM_P3);
        pg8::EpiX1 E{x, out, A2, ffn_g, SSQ, ws + WS_H8};
        pg8::gemm_phase<pg8::EpiX1, pg8::StaticOrder, true, true>(lds, g, S, E);
    }
    SEAM(3);
    if (IN(4)) REPS(4) {
        pg8::Gemm g{A2, WtQ, T, DM, DM}; pg8::StaticOrder S; S.init(T, DM, G, bx, WGM_P3);
        pg8::EpiBf16<0> E{QP, DM, nullptr, 0, 0, 1.f};
        pg8::gemm_phase<pg8::EpiBf16<0>, pg8::StaticOrder, true, true>(lds, g, S, E);
    }
    SEAM(4);
    if (IN(5)) REPS(5) {
        if (tid < 64) {
            int n = tid, i = 0;
#pragma unroll 1
            for (; i < 16; ++i) { const int len = 16 / (i + 1); if (n < len) break; n -= len; }
            ((LAS unsigned char*)(lds + P5_TAB_OFF))[tid] = (unsigned char)(i < 16 ? ((i << 4) | n) : 0);
        }
        int cur_h = -1;
        for (int it = vcu; it < (T / 128) * PEH; it += G) { const int h = it & 7;
            if (h != cur_h) {
                __syncthreads();
                for (int i = tid; i < 4096; i += NTHREADS) { const int ch = i & 15, key = (i >> 4) & 127, c = i >> 11;
                    *(LAS v4u*)(lds + c * 32768 + ch * 2048 + key * 16) = *(const v4u*)(SK + (size_t)((h * 2 + c) * 128 + key) * 128 + ch * 8); }
                cur_h = h; __syncthreads(); }
            peer_topk_item(it >> 3, h, QP, SSQ, EIDX, EGATE, RSTD, (LAS char*)lds); }
    }
    SEAM(5);
    if (IN(6)) {
        float* PART = (float*)(ws + WS_PART);
        const int tstride = (G >> 3) * NWAVES, nper = (T + tstride - 1) / tstride;
        peer_u_stage(nper, (bx >> 3) * NWAVES + wave, tstride, bx & 7, ws + WS_H8, U8, EIDX, PART, lane);
    }
    SEAM(6);
    if (IN(7)) {
        const float* PART = (const float*)(ws + WS_PART); unsigned* ACTQ = (unsigned*)(ws + WS_ACT); float* ASC = (float*)(ws + WS_ACT + 4 * MiB);
        const float ustep = RSTD[T] * (1.0f / H8_SCALE), vstep = RSTD[T + 1];
        for (int tp = gw; tp < T / 2; tp += NGW) { const int t = 2 * tp + (lane >> 5), k4 = 4 * (lane & 31);
            f32x4 z = (f32x4){0.f, 0.f, 0.f, 0.f};
#pragma unroll
            for (int s = 0; s < 8; ++s) z += *(const f32x4*)(PART + ((size_t)s * T + t) * 128 + k4);
            z *= RSTD[t] * ustep;
            const f32x4 gt = *(const f32x4*)(EGATE + (size_t)t * 128 + k4);
            f32x4 a; float am = 0.f;
#pragma unroll
            for (int i = 0; i < 4; ++i) { a[i] = 0.5f * z[i] * (1.0f + erff(z[i] * 0.70710678118654752f)) * gt[i]; am = fmaxf(am, fabsf(a[i])); }
#pragma unroll
            for (int o = 1; o < 32; o <<= 1) am = fmaxf(am, __shfl_xor(am, o));
            const float asc = am > 0.f ? am * (1.0f / 127.0f) : 1.0f, inv = 1.0f / asc; unsigned w = 0u;
#pragma unroll
            for (int i = 0; i < 4; ++i) { const int q = (int)__builtin_rintf(a[i] * inv); w |= ((unsigned)q & 0xffu) << (8 * i); }
            ACTQ[(size_t)t * 32 + (lane & 31)] = w;
            if ((lane & 31) == 0) ASC[t] = asc * vstep; }
    }
    SEAM(7);
    if (IN(8)) {
        const unsigned* ACTQ = (const unsigned*)(ws + WS_ACT); const float* ASC = (const float*)(ws + WS_ACT + 4 * MiB);
        const int tstride = (G >> 3) * NWAVES, nper = (T + tstride - 1) / tstride;
        peer_v_stage<0>(nper, (bx >> 3) * NWAVES + wave, tstride, bx & 7, V8, EIDX, ACTQ, ASC, A2, ffn_g, out, lane);
    }
#undef IN
#undef SEAM
}


#ifdef DBG_ABL
__global__ void __launch_bounds__(NTHREADS, 2) attn_probe(Args args) {
    extern __shared__ __attribute__((aligned(16))) unsigned char lds_raw[];
    LAS unsigned char* lds = (LAS unsigned char*)lds_raw;
    const int tid = threadIdx.x, lane = tid & 63; const int G = gridDim.x, bx = blockIdx.x;
    const int vcu = (G % 8 == 0) ? (bx % 8) * (G / 8) + bx / 8 : bx;
    unsigned char* ws = args.ws;
    const float* qg = args.in[3]; const float* kg = args.in[4]; const float* lq1 = args.in[5]; const float* lk1 = args.in[6]; const float* lq2 = args.in[7]; const float* lk2 = args.in[8]; const float* subg = args.in[9];
    bf16* Qb = (bf16*)(ws + WS_Q); bf16* Kb = (bf16*)(ws + WS_K); bf16* Vb = (bf16*)(ws + WS_V); bf16* MIX2 = (bf16*)(ws + 448 * MiB);
    float a = lq1[lane] * lk1[lane], b2 = lq2[lane] * lk2[lane]; a = wave_sum(a); b2 = wave_sum(b2);
    const float lam = expf(a) - expf(b2) + 0.2f; const float mq = wave_max(fabsf(qg[lane])), mk = wave_max(fabsf(kg[lane])); const float M2 = 64.f * C2 * mq * mk;
    for (int v = vcu; v < NB * NH * 4; v += G) { const int bh = v >> 2, s = v & 3, b = bh >> 3, h = bh & 7;
#pragma unroll 1
        for (int i = 0; i < 4; ++i) { const int qblk = (i == 0) ? s : (i == 1) ? 7 - s : (i == 2) ? 8 + s : 15 - s;
            att::attn_unit<DBG_ABL>(b, h, qblk, Qb, Kb, Vb, MIX2, subg, lam, M2, (LAS char*)lds); } }
}
#endif


#ifdef DBG_ABLV
__global__ void __launch_bounds__(NTHREADS, 2) pv_probe(Args args) {
    const int tid = threadIdx.x, lane = tid & 63, wave = __builtin_amdgcn_readfirstlane(tid >> 6); const int G = gridDim.x, bx = blockIdx.x;
    unsigned char* ws = args.ws;
    const unsigned* ACTQ = (const unsigned*)(ws + WS_ACT); const float* ASC = (const float*)(ws + WS_ACT + 4 * MiB);
    const int tstride = (G >> 3) * NWAVES, nper = (T + tstride - 1) / tstride;
    peer_v_stage<DBG_ABLV>(nper, (bx >> 3) * NWAVES + wave, tstride, bx & 7, ws + WS_VT, (const int*)(ws + WS_EIDX), ACTQ, ASC, (const bf16*)(ws + WS_CB), args.in[12], (float*)(ws + WS_PART), lane);
}
#endif

extern "C" void kernel_launch(void* const* d_in, const int* in_sizes, int n_in, void* d_out, int out_size, void* d_ws, size_t ws_size, hipStream_t stream) {
    static int grid = 0;
    if (grid == 0) {
        if (n_in != 17 || out_size != T * DM || ws_size < WS_END) { fprintf(stderr, "kernel_launch: unexpected shapes (n_in %d out %d ws %zu)\n", n_in, out_size, ws_size); grid = -1; return; }
        int dev = 0, cus = 0, per_cu = 0;
        if (hipGetDevice(&dev) != hipSuccess || hipDeviceGetAttribute(&cus, hipDeviceAttributeMultiprocessorCount, dev) != hipSuccess) { grid = -1; return; }
        if (hipFuncSetAttribute((const void*)mk_fwd, hipFuncAttributeMaxDynamicSharedMemorySize, LDS_BYTES) != hipSuccess) { fprintf(stderr, "kernel_launch: hipFuncSetAttribute failed\n"); grid = -1; return; }
        if (hipOccupancyMaxActiveBlocksPerMultiprocessor(&per_cu, (const void*)mk_fwd, NTHREADS, LDS_BYTES) != hipSuccess || per_cu < 1) { fprintf(stderr, "kernel_launch: occupancy query says %d blocks per CU\n", per_cu); (void)hipGetLastError(); grid = -1; return; }
        grid = cus;
    }
    if (grid < 0) return;
    if (hipMemsetAsync((char*)d_ws + WS_CTL, 0, CTL_ZERO_BYTES, stream) != hipSuccess) { fprintf(stderr, "kernel_launch: memset failed\n"); return; }
    Args a{};
    for (int i = 0; i < 17; ++i) a.in[i] = (const float*)d_in[i];
    a.out = (float*)d_out; a.ws = (unsigned char*)d_ws;
#if MK_N_LAUNCHES == 1
    a.ph_lo = 0; a.ph_hi = NPHASE;
    void* kargs[] = {&a};
    hipError_t e = hipLaunchCooperativeKernel((const void*)mk_fwd, dim3(grid), dim3(NTHREADS), kargs, LDS_BYTES, stream);
    if (e != hipSuccess) fprintf(stderr, "kernel_launch: cooperative launch failed: %s (grid %d)\n", hipGetErrorString(e), grid);
#else
#ifndef DBG_DUPL
#define DBG_DUPL -1
#endif
#ifndef DBG_DUPFLAGS
#define DBG_DUPFLAGS 0
#endif
    for (int p = 0; p < NPHASE; ++p) { a.ph_lo = p; for (int r = 0; r < (p == DBG_DUPL ? 2 : 1); ++r) { a.ph_hi = (p + 1) | ((r == 1 ? DBG_DUPFLAGS : 0) << 8); hipLaunchKernelGGL(mk_fwd, dim3(grid), dim3(NTHREADS), LDS_BYTES, stream, a); }
#ifdef DBG_ABLV
        if (p == 8) hipLaunchKernelGGL(pv_probe, dim3(grid), dim3(NTHREADS), 0, stream, a);
#endif
#ifdef DBG_ABL
        if (p == 2 && ws_size >= 512 * MiB) { static bool once = false; if (!once) { once = true; (void)hipFuncSetAttribute((const void*)attn_probe, hipFuncAttributeMaxDynamicSharedMemorySize, LDS_BYTES); } hipLaunchKernelGGL(attn_probe, dim3(grid), dim3(NTHREADS), LDS_BYTES, stream, a); }
#endif
    }
#endif
}
```

```cpp
#include <hip/hip_runtime.h>
#include <hip/hip_cooperative_groups.h>
#include <cstdio>
#include <cstdint>
#include <cmath>
namespace cg = cooperative_groups;
namespace pg8 {
#define PG8_LAS __attribute__((address_space(3)))
typedef unsigned short bf16_t;
typedef short bf16x8 __attribute__((ext_vector_type(8)));
typedef float f32x4 __attribute__((ext_vector_type(4)));
typedef unsigned u32x4 __attribute__((ext_vector_type(4)));
constexpr int BM = 256, BK = 64, HALF = 128, HTB = HALF * BK * 2  , STAGE_BYTES = 8 * HTB, NXCD = 8, WGM = 8;

__host__ __device__ __forceinline__ int lds_byte(int r, int c) { const int st = (r >> 4) * 2 + (c >> 5), rr = r & 15, cc = c & 31, ob = rr * 64 + cc * 2; return st * 1024 + (ob ^ (((ob >> 9) & 1) << 5)); }
__host__ __device__ __forceinline__ void stage_rc(int b, int& R, int& C) { const int st = b / 1024, sb = b % 1024, swz = sb ^ (((sb >> 9) & 1) << 5); R = (st >> 1) * 16 + swz / 64; C = (st & 1) * 32 + (swz % 64) / 2; }
__host__ __device__ __forceinline__ int perm32(int rho) { const int n = rho >> 4, i = rho & 15; return 8 * (i >> 2) + 4 * n + (i & 3); }

struct Unit { int pm, pn; };
struct Gemm { const bf16_t* A; const bf16_t* Bt; int M, N, K; };

struct StaticOrder {
    int nM, nN, nwg, G, c, wgm;
    __host__ __device__ void init(int M, int N, int G_, int c_, int wgm_ = WGM) { nM = M / BM; nN = N / BM; nwg = nM * nN; G = G_; c = c_; wgm = wgm_; }
    __host__ __device__ bool next(int i, Unit& u) const {
        const long L = (long)i * G + c; if (L >= nwg) return false;
        int wgid = (int)L; { const int q = nwg / NXCD, r = nwg % NXCD, xcd = wgid % NXCD, off = wgid / NXCD; wgid = (xcd < r ? xcd * (q + 1) : r * (q + 1) + (xcd - r) * q) + off; }
        const int nig = wgm * nN, gid = wgid / nig, fm = gid * wgm, gsz = (nM - fm) < wgm ? (nM - fm) : wgm;
        u.pm = fm + ((wgid % nig) % gsz); u.pn = (wgid % nig) / gsz; return true;
    }
    __device__ __forceinline__ void a_ready(const Unit&) const {}
    __device__ __forceinline__ void done(const Unit&) const {}
};

__device__ __forceinline__ unsigned cvt_pk_bf16(float lo, float hi) { unsigned r; asm volatile("v_cvt_pk_bf16_f32 %0, %1, %2" : "=v"(r) : "v"(lo), "v"(hi)); return r; }
typedef float f32x2 __attribute__((ext_vector_type(2)));
__device__ __forceinline__ f32x2 gelu_pk(f32x2 v) {
    const f32x2 av = __builtin_elementwise_abs(v), d = av * 0.2316418882f + 1.0f;
    f32x2 t; t.x = __builtin_amdgcn_rcpf(d.x); t.y = __builtin_amdgcn_rcpf(d.y);
    f32x2 q = t * 0.5307027145f + (-0.7265760135f); q = q * t + 0.7107068705f; q = q * t + (-0.142248368f); q = q * t + 0.127414796f; q = q * t;
    const f32x2 s = (v * v) * (-0.72134752044f);
    f32x2 e; e.x = __builtin_amdgcn_exp2f(s.x); e.y = __builtin_amdgcn_exp2f(s.y);
    const f32x2 m = v * (q * e), r = v - m;
    f32x2 o; o.x = v.x < 0.f ? m.x : r.x; o.y = v.y < 0.f ? m.y : r.y; return o;
}

template <int ACT  > struct EpiBf16 {
    static constexpr bool PERM = true, AFTER_DRAIN = false; static_assert(ACT == 0 || ACT == 1, "EpiBf16: ACT is 0 (none) or 1 (gelu_pk)");
    bf16_t* O; int ldc; const float* bias; int split_cols; size_t split_stride; float scale0;
    __device__ __forceinline__ void operator()(const f32x4 (&acc)[2][2][4][2], const Unit& u, int wr, int wc, int fr, int fq) const {
        const int row0 = u.pm * BM + wr * 64 + fr; int colt = u.pn * BM; bf16_t* base = O;
        float sc = 1.f; if (split_cols) { const int t = colt / split_cols; base += (size_t)t * split_stride; colt -= t * split_cols; if (t == 0) sc = scale0; }
        const int col0 = colt + wc * 32 + 8 * fq, bcol0 = u.pn * BM + wc * 32 + 8 * fq;
        f32x4 bv[2][2];
#pragma unroll
        for (int bj = 0; bj < 2; ++bj)
#pragma unroll
            for (int n = 0; n < 2; ++n) bv[bj][n] = bias ? *(const f32x4*)(bias + bcol0 + bj * HALF + 4 * n) : (f32x4){0.f, 0.f, 0.f, 0.f};
#pragma unroll
        for (int ai = 0; ai < 2; ++ai)
#pragma unroll
            for (int m = 0; m < 4; ++m) { bf16_t* rowp = base + (size_t)(row0 + ai * HALF + m * 16) * ldc + col0;
#pragma unroll
                for (int bj = 0; bj < 2; ++bj) { f32x4 v0 = acc[ai][bj][m][0] + bv[bj][0], v1 = acc[ai][bj][m][1] + bv[bj][1];
                    if (ACT == 1) { f32x2 a = gelu_pk((f32x2){v0[0], v0[1]}), b = gelu_pk((f32x2){v0[2], v0[3]}), c = gelu_pk((f32x2){v1[0], v1[1]}), d = gelu_pk((f32x2){v1[2], v1[3]});
                        v0 = (f32x4){a.x, a.y, b.x, b.y}; v1 = (f32x4){c.x, c.y, d.x, d.y}; }
                    v0 = v0 * sc; v1 = v1 * sc; u32x4 w; w.x = cvt_pk_bf16(v0[0], v0[1]); w.y = cvt_pk_bf16(v0[2], v0[3]); w.z = cvt_pk_bf16(v1[0], v1[1]); w.w = cvt_pk_bf16(v1[2], v1[3]);
                    *(u32x4*)(rowp + bj * HALF) = w; } }
    }
};
template <class Epi, class Sched, bool ALIGN_EPI = false, bool SP2 = false>
__device__ __forceinline__ void gemm_phase(PG8_LAS unsigned char* lds, const Gemm g, const Sched& S, const Epi& E) {
    const int tid = threadIdx.x, wid = __builtin_amdgcn_readfirstlane(tid >> 6), lane = tid & 63, wr = wid >> 2, wc = wid & 3, fr = lane & 15, fq = lane >> 4;
    const int K = g.K, nt = K / BK;
    unsigned voffA[2], voffB[2];
#pragma unroll
    for (int i = 0; i < 2; ++i) { int R, C; stage_rc(tid * 16 + i * 8192, R, C); const int Rb = Epi::PERM ? ((R & ~31) + perm32(R & 31)) : R;
        voffA[i] = (unsigned)(R * K + C) * 2u; voffB[i] = (unsigned)(Rb * K + C) * 2u; }
    const size_t kstep = (size_t)(BK * 2);
    const size_t hstep = (size_t)HALF * K * 2;
    const size_t tstep = 2 * hstep;
    const unsigned ldsw = (unsigned)wid * 1024u;
    const int aoff = lds_byte(wr * 64 + fr, fq * 8), boff = lds_byte(wc * 32 + fr, fq * 8);
#define PG8_SA(b, h) (((b) * 2 + (h)) * HTB)
#define PG8_SB(b, h) ((4 + (b) * 2 + (h)) * HTB)
#define PG8_STAGE(bufoff, gbase, voff) do { _Pragma("unroll") for (int _i = 0; _i < 2; ++_i) \
        __builtin_amdgcn_global_load_lds((const unsigned*)((const char*)(gbase) + (voff)[_i]), (PG8_LAS unsigned*)(lds + (bufoff) + ldsw + _i * 8192), 16, 0, 0); } while (0)
#define PG8_LDA(dst, b, h) do { _Pragma("unroll") for (int m = 0; m < 4; ++m) _Pragma("unroll") for (int k = 0; k < 2; ++k) dst[m][k] = *(const PG8_LAS bf16x8*)(lds + PG8_SA(b, h) + aoff + m * 2048 + k * 1024); } while (0)
#define PG8_LDB(dst, b, h) do { _Pragma("unroll") for (int n = 0; n < 2; ++n) _Pragma("unroll") for (int k = 0; k < 2; ++k) dst[n][k] = *(const PG8_LAS bf16x8*)(lds + PG8_SB(b, h) + boff + n * 2048 + k * 1024); } while (0)
#define PG8_MMA(ai, bj, At, Bt) do { __builtin_amdgcn_s_setprio(1); _Pragma("unroll") for (int m = 0; m < 4; ++m) _Pragma("unroll") for (int n = 0; n < 2; ++n) _Pragma("unroll") for (int k = 0; k < 2; ++k) \
        acc[ai][bj][m][n] = __builtin_amdgcn_mfma_f32_16x16x32_bf16(Bt[n][k], At[m][k], acc[ai][bj][m][n], 0, 0, 0); __builtin_amdgcn_s_setprio(0); } while (0)
#define PG8_WAIT_V(n) asm volatile("s_waitcnt vmcnt(" #n ")" ::: "memory")
#define PG8_WAIT_L(n) asm volatile("s_waitcnt lgkmcnt(" #n ")" ::: "memory")
#define PG8_BAR __builtin_amdgcn_s_barrier()
#define PG8_SCHED __builtin_amdgcn_sched_barrier(0)
    Unit cur, nxt; int ui = 0;
    if (!S.next(0, cur)) return;
    f32x4 acc[2][2][4][2];
#pragma unroll
    for (int a = 0; a < 2; ++a)
#pragma unroll
        for (int b = 0; b < 2; ++b)
#pragma unroll
            for (int m = 0; m < 4; ++m)
#pragma unroll
                for (int n = 0; n < 2; ++n) acc[a][b][m][n] = (f32x4){0.f, 0.f, 0.f, 0.f};
    bf16x8 At[4][2], B0[2][2], B1[2][2];
    const char* cA = (const char*)g.A + (size_t)cur.pm * tstep; const char* cB = (const char*)g.Bt + (size_t)cur.pn * tstep;
    S.a_ready(cur);
    if constexpr (SP2) {
        PG8_STAGE(PG8_SB(0, 0), cB, voffB); PG8_STAGE(PG8_SB(0, 1), cB + hstep, voffB); PG8_STAGE(PG8_SA(0, 0), cA, voffA); PG8_STAGE(PG8_SA(0, 1), cA + hstep, voffA);
        if (wr == 1) PG8_BAR;
        PG8_WAIT_V(2); PG8_BAR;
        PG8_STAGE(PG8_SB(1, 0), cB + kstep, voffB); PG8_STAGE(PG8_SA(1, 0), cA + kstep, voffA); PG8_STAGE(PG8_SB(1, 1), cB + hstep + kstep, voffB);
        PG8_WAIT_V(6); PG8_BAR;
    } else {
        PG8_STAGE(PG8_SB(0, 0), cB, voffB); PG8_STAGE(PG8_SA(0, 0), cA, voffA); PG8_STAGE(PG8_SB(0, 1), cB + hstep, voffB); PG8_STAGE(PG8_SA(0, 1), cA + hstep, voffA);
        if (wr == 1) PG8_BAR;
        PG8_WAIT_V(4); PG8_BAR;
        PG8_STAGE(PG8_SB(1, 0), cB + kstep, voffB); PG8_STAGE(PG8_SA(1, 0), cA + kstep, voffA); PG8_STAGE(PG8_SB(1, 1), cB + hstep + kstep, voffB);
        PG8_WAIT_V(6); PG8_BAR;
    }
    for (;;) {
        const bool has_next = S.next(ui + 1, nxt);
        const char* nA = has_next ? (const char*)g.A + (size_t)nxt.pm * tstep : cA; const char* nB = has_next ? (const char*)g.Bt + (size_t)nxt.pn * tstep : cB;
        for (int t = 0; t < nt; t += 2) {
            const bool last = (t == nt - 2);
            const char* a1 = cA + (size_t)(t + 1) * kstep;
            const char* a2 = last ? nA : cA + (size_t)(t + 2) * kstep; const char* b2 = last ? nB : cB + (size_t)(t + 2) * kstep;
            const char* a3 = a2 + kstep; const char* b3 = b2 + kstep;
            if (last && has_next) S.a_ready(nxt);
            if constexpr (SP2) {
            PG8_LDB(B0, 0, 0); PG8_LDB(B1, 0, 1); PG8_SCHED; PG8_LDA(At, 0, 0); PG8_STAGE(PG8_SA(1, 1), a1 + hstep, voffA);
            PG8_WAIT_V(8); PG8_WAIT_L(0); PG8_BAR; PG8_MMA(0, 0, At, B0); PG8_MMA(0, 1, At, B1); PG8_BAR; PG8_SCHED;
            PG8_LDA(At, 0, 1); PG8_STAGE(PG8_SB(0, 0), b2, voffB); PG8_STAGE(PG8_SB(0, 1), b2 + hstep, voffB); PG8_STAGE(PG8_SA(0, 0), a2, voffA);
            PG8_WAIT_V(8); PG8_WAIT_L(0); PG8_BAR; PG8_MMA(1, 0, At, B0); PG8_MMA(1, 1, At, B1); PG8_BAR; PG8_SCHED;
            PG8_LDB(B0, 1, 0); PG8_LDB(B1, 1, 1); PG8_SCHED; PG8_LDA(At, 1, 0); PG8_STAGE(PG8_SA(0, 1), a2 + hstep, voffA);
            PG8_WAIT_V(8); PG8_WAIT_L(0); PG8_BAR; PG8_MMA(0, 0, At, B0); PG8_MMA(0, 1, At, B1); PG8_BAR; PG8_SCHED;
            PG8_LDA(At, 1, 1); PG8_STAGE(PG8_SB(1, 0), b3, voffB); PG8_STAGE(PG8_SB(1, 1), b3 + hstep, voffB); PG8_STAGE(PG8_SA(1, 0), a3, voffA);
            PG8_WAIT_V(8); PG8_WAIT_L(0); PG8_BAR; PG8_MMA(1, 0, At, B0); PG8_MMA(1, 1, At, B1); PG8_BAR; PG8_SCHED;
            } else {
            PG8_LDB(B0, 0, 0); PG8_SCHED; PG8_LDA(At, 0, 0); PG8_STAGE(PG8_SA(1, 1), a1 + hstep, voffA);
            PG8_WAIT_L(8); PG8_BAR; PG8_WAIT_L(0); PG8_MMA(0, 0, At, B0); PG8_BAR; PG8_SCHED;
            PG8_LDB(B1, 0, 1); PG8_STAGE(PG8_SB(0, 0), b2, voffB);
            PG8_BAR; PG8_WAIT_L(0); PG8_MMA(0, 1, At, B1); PG8_BAR;
            PG8_LDA(At, 0, 1); PG8_STAGE(PG8_SA(0, 0), a2, voffA);
            PG8_BAR; PG8_WAIT_L(0); PG8_MMA(1, 0, At, B0); PG8_BAR; PG8_SCHED;
            PG8_STAGE(PG8_SB(0, 1), b2 + hstep, voffB);
            PG8_WAIT_V(6); PG8_BAR; PG8_MMA(1, 1, At, B1); PG8_BAR;
            PG8_LDB(B0, 1, 0); PG8_SCHED; PG8_LDA(At, 1, 0); PG8_STAGE(PG8_SA(0, 1), a2 + hstep, voffA);
            PG8_WAIT_L(8); PG8_BAR; PG8_WAIT_L(0); PG8_MMA(0, 0, At, B0); PG8_BAR; PG8_SCHED;
            PG8_LDB(B1, 1, 1); PG8_STAGE(PG8_SB(1, 0), b3, voffB);
            PG8_BAR; PG8_WAIT_L(0); PG8_MMA(0, 1, At, B1); PG8_BAR;
            PG8_LDA(At, 1, 1); PG8_STAGE(PG8_SA(1, 0), a3, voffA);
            PG8_BAR; PG8_WAIT_L(0); PG8_MMA(1, 0, At, B0); PG8_BAR; PG8_SCHED;
            PG8_STAGE(PG8_SB(1, 1), b3 + hstep, voffB);
            PG8_WAIT_V(6); PG8_BAR; PG8_MMA(1, 1, At, B1); PG8_BAR;
            }
        }
        if constexpr (ALIGN_EPI) { if (wr == 0) PG8_BAR; }
        if constexpr (!Epi::AFTER_DRAIN) { E(acc, cur, wr, wc, fr, fq); S.done(cur); }
        if (!has_next) break;
#pragma unroll
        for (int a = 0; a < 2; ++a)
#pragma unroll
            for (int b = 0; b < 2; ++b)
#pragma unroll
                for (int m = 0; m < 4; ++m)
#pragma unroll
                    for (int n = 0; n < 2; ++n) acc[a][b][m][n] = (f32x4){0.f, 0.f, 0.f, 0.f};
        cur = nxt; cA = nA; cB = nB; ++ui;
        if constexpr (ALIGN_EPI) { if (wr == 1) PG8_BAR; }
    }
    PG8_WAIT_V(0);
    if constexpr (!ALIGN_EPI) { if (wr == 0) PG8_BAR; }
    PG8_BAR;
    if constexpr (Epi::AFTER_DRAIN) { E.fused(acc, cur, wr, wc, fr, fq, lds, wid, lane); S.done(cur); }
#undef PG8_SA
#undef PG8_SB
#undef PG8_STAGE
#undef PG8_LDA
#undef PG8_LDB
#undef PG8_MMA
#undef PG8_WAIT_V
#undef PG8_WAIT_L
#undef PG8_BAR
#undef PG8_SCHED
}
}
#define MK_N_LAUNCHES 1
#ifndef MK_N_LAUNCHES
#define MK_N_LAUNCHES 1
#endif
constexpr int DM = 2048, NB = 8, SEQ = 2048, T = NB * SEQ;
constexpr int AW = 1024, NH = 8, HD = 64, VD = 128, INC = 6144;
constexpr int PNK = 128, PTOPK = 16, PEH = 8, EPT = PEH * PTOPK;
constexpr float EPS = 1e-6f;
constexpr float C2 = 0.125f * 1.4426950408889634f;
constexpr int NPHASE = 9;
#ifndef WGM_P1
#define WGM_P1 16
#endif
#ifndef WGM_P3
#define WGM_P3 4
#endif
constexpr float U8_SCALE = 1024.f, V8_SCALE = 16.f, H8_SCALE = 16.f;
constexpr size_t MiB = 1u << 20;
constexpr size_t WS_WIN = 1 * MiB, WS_WOUT = 25 * MiB, WS_WQ = 33 * MiB, WS_SK = 41 * MiB, WS_SSQ = 42 * MiB, WS_EIDX = 44 * MiB, WS_EGATE = 52 * MiB, WS_RSTD = 60 * MiB;
constexpr size_t WS_XN = 64 * MiB;
constexpr size_t WS_Q = 128 * MiB, WS_K = 160 * MiB, WS_V = 192 * MiB;
constexpr size_t WS_CB = 224 * MiB, WS_CC = 256 * MiB, WS_CX = 288 * MiB;
constexpr size_t WS_UT = 320 * MiB, WS_VT = 384 * MiB, WS_END = 448 * MiB;
constexpr size_t WS_CTL = 0; constexpr int CW_BAR = 1024, CTL_ZERO_BYTES = 65536;
constexpr size_t WS_H8 = 288 * MiB;
constexpr size_t WS_PART = 64 * MiB, WS_ACT = 192 * MiB;
constexpr int MISC_OFF = 143360;
constexpr int LDS_BYTES = 147456;
constexpr int NWAVES = 8, NTHREADS = 512;

#define LAS __attribute__((address_space(3)))
typedef unsigned short bf16;
typedef unsigned v4u __attribute__((ext_vector_type(4)));
typedef unsigned v2u __attribute__((ext_vector_type(2)));
typedef float f32x4 __attribute__((ext_vector_type(4)));
typedef float f32x2 __attribute__((ext_vector_type(2)));
typedef float f32x16 __attribute__((ext_vector_type(16)));
typedef short bf16x8 __attribute__((ext_vector_type(8)));
typedef short s16x4 __attribute__((ext_vector_type(4)));
typedef __bf16 bf16x2_t __attribute__((ext_vector_type(2)));
#define LDS_WAIT() asm volatile("s_waitcnt lgkmcnt(0)" ::: "memory")
__device__ __forceinline__ unsigned pk2(float lo, float hi) { f32x2 v = {lo, hi}; bf16x2_t b = __builtin_convertvector(v, bf16x2_t); return __builtin_bit_cast(unsigned, b); }
__device__ __forceinline__ float bflo(unsigned u) { return __uint_as_float(u << 16); }
__device__ __forceinline__ float bfhi(unsigned u) { return __uint_as_float(u & 0xffff0000u); }
#define DPPF(v, ctrl) __uint_as_float((unsigned)__builtin_amdgcn_update_dpp(0, (int)__float_as_uint(v), (ctrl), 0xf, 0xf, false))
__device__ __forceinline__ float xor16_sum(float v) { const auto r = __builtin_amdgcn_permlane16_swap(__float_as_uint(v), __float_as_uint(v), false, false); return __uint_as_float(r[0]) + __uint_as_float(r[1]); }
__device__ __forceinline__ float xor32_sum(float v) { const auto r = __builtin_amdgcn_permlane32_swap(__float_as_uint(v), __float_as_uint(v), false, false); return __uint_as_float(r[0]) + __uint_as_float(r[1]); }
__device__ __forceinline__ float wave_sum(float v) {
    v += DPPF(v, 0xB1); v += DPPF(v, 0x4E); v += DPPF(v, 0x124); v += DPPF(v, 0x128);
    return xor32_sum(xor16_sum(v));
}
__device__ __forceinline__ float wave_max(float v) {
    v = fmaxf(v, DPPF(v, 0xB1)); v = fmaxf(v, DPPF(v, 0x4E)); v = fmaxf(v, DPPF(v, 0x124)); v = fmaxf(v, DPPF(v, 0x128));
    { const auto r = __builtin_amdgcn_permlane16_swap(__float_as_uint(v), __float_as_uint(v), false, false); v = fmaxf(__uint_as_float(r[0]), __uint_as_float(r[1])); }
    { const auto r = __builtin_amdgcn_permlane32_swap(__float_as_uint(v), __float_as_uint(v), false, false); v = fmaxf(__uint_as_float(r[0]), __uint_as_float(r[1])); }
    return v;
}

#define XB_TMO      128
#define XB_XCNT(j)  (256  + 64 * (j))
#define XB_XSUB(j)  (1280 + 64 * (j))
#define XB_XGEN(j)  (2304 + 64 * (j))
#define XB_TOP      3328
#define XB_TOPGEN   3392
#define XCD_BAR_WORDS 3456
#define XB_SPIN_CAP (1u << 18)

__device__ __forceinline__ unsigned xb_ld(unsigned* p)              { return __hip_atomic_load(p, __ATOMIC_RELAXED, __HIP_MEMORY_SCOPE_AGENT); }
__device__ __forceinline__ unsigned xb_add(unsigned* p, unsigned v) { return __hip_atomic_fetch_add(p, v, __ATOMIC_RELAXED, __HIP_MEMORY_SCOPE_AGENT); }
__device__ __forceinline__ unsigned xb_xcc_id() { return (unsigned)__builtin_amdgcn_s_getreg((3 << 11) | 20) & 0xFu; }
#define XB_SPIN(cond, bar) do { unsigned _sp = 0; while (cond) { __builtin_amdgcn_s_sleep(1); \
    if ((++_sp & 255u) == 0u) { if (xb_ld(&(bar)[XB_TMO])) break; if (_sp > XB_SPIN_CAP) { atomicAdd(&(bar)[XB_TMO], 1u); break; } } } } while (0)

struct XcdBarrier {
    unsigned* bar; unsigned x;
    volatile LAS unsigned* st;
};

__device__ __forceinline__ XcdBarrier xcd_barrier_post(unsigned* bar, volatile LAS unsigned* st) {
    XcdBarrier b; b.bar = bar; b.x = xb_xcc_id(); b.st = st;
    if (threadIdx.x == 0) (void)xb_add(&bar[XB_XCNT(b.x)], 1u);
    return b;
}
__device__ __forceinline__ void xcd_barrier_complete(unsigned* bar, unsigned x, unsigned& nloc, unsigned& nx) {
    const unsigned G = gridDim.x * gridDim.y * gridDim.z;
    unsigned sum, cnt, mine, sp = 0u;
    for (;;) {
        sum = 0u; cnt = 0u; mine = 0u;
#pragma unroll
        for (unsigned j = 0; j < 16; ++j) { const unsigned c = xb_ld(&bar[XB_XCNT(j)]); sum += c; cnt += (c > 0u) ? 1u : 0u; mine = (j == x) ? c : mine; }
        if (sum == G) break;
        __builtin_amdgcn_s_sleep(1);
        if ((++sp & 255u) == 0u) { if (xb_ld(&bar[XB_TMO])) break; if (sp > XB_SPIN_CAP) { atomicAdd(&bar[XB_TMO], 1u); break; } }
    }
    nloc = mine > 0u ? mine : 1u; nx = cnt > 0u ? cnt : 1u;
}

__device__ __forceinline__ void xcd_barrier(const XcdBarrier& b) {
    asm volatile("s_waitcnt vmcnt(0)" ::: "memory");
    __syncthreads();
    if (threadIdx.x == 0) {
        unsigned* bar = b.bar;
        __builtin_amdgcn_s_waitcnt(0);
        unsigned nloc = b.st[0], nx = b.st[1];
        if (nloc == 0u) { xcd_barrier_complete(bar, b.x, nloc, nx); b.st[0] = nloc; b.st[1] = nx; }
        const unsigned old = xb_add(&bar[XB_XSUB(b.x)], 1u);
        const unsigned gen = old / nloc;
        if (old + 1u == (gen + 1u) * nloc) {
            __builtin_amdgcn_fence(__ATOMIC_RELEASE, "agent");
            asm volatile("s_waitcnt vmcnt(0)" ::: "memory");
            const unsigned og = xb_add(&bar[XB_TOP], 1u);
            const unsigned tg = og / nx;
            if (og + 1u == (tg + 1u) * nx) xb_add(&bar[XB_TOPGEN], 1u);
            else XB_SPIN(xb_ld(&bar[XB_TOPGEN]) == tg, bar);
            __builtin_amdgcn_fence(__ATOMIC_ACQUIRE, "agent");
            xb_add(&bar[XB_XGEN(b.x)], 1u);
            asm volatile("s_waitcnt vmcnt(0)" ::: "memory");
        } else {
            XB_SPIN(xb_ld(&bar[XB_XGEN(b.x)]) == gen, bar);
            __builtin_amdgcn_fence(__ATOMIC_ACQUIRE, "agent");
            asm volatile("s_waitcnt vmcnt(0)" ::: "memory");
        }
    }
    __syncthreads();
}


namespace pg8 {
struct EpiProj {
    static constexpr bool PERM = true, AFTER_DRAIN = false;
    bf16_t* base0; const float* qg; const float* kg;
    __device__ __forceinline__ void operator()(const f32x4 (&acc)[2][2][4][2], const Unit& u, int wr, int wc, int fr, int fq) const {
        const int region = u.pn >> 2;
        bf16_t* O = base0 + (size_t)region * (16u << 20);
        const int row0 = u.pm * BM + wr * 64 + fr, col0 = (u.pn & 3) * 256 + wc * 64 + 8 * fq;
        if (region < 2) {
            const float* g = region == 0 ? qg : kg; const float sc = region == 0 ? 0.125f * 1.4426950408889634f : 1.0f;
            f32x4 gv[2][2];
#pragma unroll
            for (int bj = 0; bj < 2; ++bj)
#pragma unroll
                for (int n = 0; n < 2; ++n) gv[bj][n] = *(const f32x4*)(g + bj * 32 + 8 * fq + 4 * n) * sc;
#pragma unroll
            for (int ai = 0; ai < 2; ++ai)
#pragma unroll
                for (int m = 0; m < 4; ++m) {
                    float ss = 0.f;
#pragma unroll
                    for (int bj = 0; bj < 2; ++bj)
#pragma unroll
                        for (int n = 0; n < 2; ++n) { const f32x4 x = acc[ai][bj][m][n]; ss += (x[0] * x[0] + x[1] * x[1]) + (x[2] * x[2] + x[3] * x[3]); }
                    ss = xor32_sum(xor16_sum(ss));
                    const float rs = __builtin_amdgcn_rsqf(ss * (1.0f / 64.0f) + 1e-6f);
                    bf16_t* rowp = O + (size_t)(row0 + ai * HALF + m * 16) * 1024 + col0;
#pragma unroll
                    for (int bj = 0; bj < 2; ++bj) { const f32x4 v0 = acc[ai][bj][m][0] * rs * gv[bj][0], v1 = acc[ai][bj][m][1] * rs * gv[bj][1];
                        u32x4 w; w.x = cvt_pk_bf16(v0[0], v0[1]); w.y = cvt_pk_bf16(v0[2], v0[3]); w.z = cvt_pk_bf16(v1[0], v1[1]); w.w = cvt_pk_bf16(v1[2], v1[3]);
                        *(u32x4*)(rowp + bj * 32) = w; }
                }
        } else {
#pragma unroll
            for (int ai = 0; ai < 2; ++ai)
#pragma unroll
                for (int m = 0; m < 4; ++m) { bf16_t* rowp = O + (size_t)(row0 + ai * HALF + m * 16) * 1024 + col0;
#pragma unroll
                    for (int bj = 0; bj < 2; ++bj) { const f32x4 v0 = acc[ai][bj][m][0], v1 = acc[ai][bj][m][1];
                        u32x4 w; w.x = cvt_pk_bf16(v0[0], v0[1]); w.y = cvt_pk_bf16(v0[2], v0[3]); w.z = cvt_pk_bf16(v1[0], v1[1]); w.w = cvt_pk_bf16(v1[2], v1[3]);
                        *(u32x4*)(rowp + bj * 32) = w; } }
        }
    }
};
struct EpiX1 {
    static constexpr bool PERM = true, AFTER_DRAIN = false;
    const float* x; float* out; bf16_t* a2; const float* gf; float* ssq; unsigned char* h8;
    __device__ __forceinline__ void operator()(const f32x4 (&acc)[2][2][4][2], const Unit& u, int wr, int wc, int fr, int fq) const {
        const int row0 = u.pm * BM + wr * 64 + fr, col0 = u.pn * BM + wc * 32 + 8 * fq;
        f32x4 gv[2][2];
#pragma unroll
        for (int bj = 0; bj < 2; ++bj)
#pragma unroll
            for (int n = 0; n < 2; ++n) gv[bj][n] = *(const f32x4*)(gf + col0 + bj * HALF + 4 * n);
#pragma unroll
        for (int ai = 0; ai < 2; ++ai)
#pragma unroll
            for (int m = 0; m < 4; ++m) { const int row = row0 + ai * HALF + m * 16; const size_t off = (size_t)row * 2048 + col0; float ss = 0.f;
#pragma unroll
                for (int bj = 0; bj < 2; ++bj) {
                    const f32x4 x0 = *(const f32x4*)(x + off + bj * HALF), x1 = *(const f32x4*)(x + off + bj * HALF + 4);
                    const f32x4 v0 = x0 + acc[ai][bj][m][0], v1 = x1 + acc[ai][bj][m][1];
                    ss += (v0[0] * v0[0] + v0[1] * v0[1]) + (v0[2] * v0[2] + v0[3] * v0[3]); ss += (v1[0] * v1[0] + v1[1] * v1[1]) + (v1[2] * v1[2] + v1[3] * v1[3]);
                    const f32x4 a0 = v0 * gv[bj][0], a1 = v1 * gv[bj][1];
                    u32x4 w; w.x = cvt_pk_bf16(a0[0], a0[1]); w.y = cvt_pk_bf16(a0[2], a0[3]); w.z = cvt_pk_bf16(a1[0], a1[1]); w.w = cvt_pk_bf16(a1[2], a1[3]);
                    *(u32x4*)(a2 + off + bj * HALF) = w;
                    { const f32x4 b0 = a0 * 16.0f, b1 = a1 * 16.0f; unsigned p = 0u, q2 = 0u;
#pragma unroll
                      for (int e_ = 0; e_ < 4; ++e_) { const int i0_ = __builtin_amdgcn_fmed3f(__builtin_rintf(b0[e_]), -127.f, 127.f), i1_ = __builtin_amdgcn_fmed3f(__builtin_rintf(b1[e_]), -127.f, 127.f);
                          p |= ((unsigned)i0_ & 0xffu) << (8 * e_); q2 |= ((unsigned)i1_ & 0xffu) << (8 * e_); }
                      typedef unsigned u32x2_ __attribute__((ext_vector_type(2))); *(u32x2_*)(h8 + off + bj * HALF) = (u32x2_){p, q2}; } }
                ss = xor32_sum(xor16_sum(ss));
                if (fq == 0) ssq[(size_t)row * 32 + u.pn * 4 + wc] = ss; }
    }
};
}

__device__ __forceinline__ void p0_transpose_item(const float* W, int K, int N, bf16* WT, LAS float* scr, int item, int lane, bool permg) {
    const int nblk = N / 32, kb = item / nblk, nb = item % nblk, k0 = 64 * kb, n0 = 32 * nb;
#pragma unroll 8
    for (int i = 0; i < 32; ++i) { const int kk = 2 * i + (lane >> 5); scr[kk * 33 + (lane & 31)] = W[(size_t)(k0 + kk) * N + n0 + (lane & 31)]; }
    LDS_WAIT(); asm volatile("" ::: "memory");
    int nd = n0; if (permg) { const int gl = (n0 & 255) >> 5; nd = (n0 & ~255) + 32 * (4 * (gl & 1) + (gl >> 1)); }
    const int c = lane & 7;
#pragma unroll
    for (int j = 0; j < 4; ++j) { const int n = (lane >> 3) + 8 * j; const LAS float* s = scr + (8 * c) * 33 + n;
        v4u o; o.x = pk2(s[0 * 33], s[1 * 33]); o.y = pk2(s[2 * 33], s[3 * 33]); o.z = pk2(s[4 * 33], s[5 * 33]); o.w = pk2(s[6 * 33], s[7 * 33]);
        *(v4u*)(WT + (size_t)(nd + n) * K + k0 + 8 * c) = o; }
    LDS_WAIT(); asm volatile("" ::: "memory");
}
__device__ __forceinline__ void rms_row_to_bf16(const float* xrow, const float* g, bf16* orow, int lane) {
    const f32x4* xr = (const f32x4*)xrow + lane; const f32x4* gr = (const f32x4*)g + lane;
    f32x4 v[8]; float s = 0.f;
#pragma unroll
    for (int j = 0; j < 8; ++j) { v[j] = xr[64 * j]; s += (v[j].x * v[j].x + v[j].y * v[j].y) + (v[j].z * v[j].z + v[j].w * v[j].w); }
    const float rstd = 1.0f / sqrtf(wave_sum(s) * (1.f / DM) + EPS);
    v2u* o8 = (v2u*)orow + lane;
#pragma unroll
    for (int j = 0; j < 8; ++j) { const f32x4 gg = gr[64 * j]; v2u w; w.x = pk2(v[j].x * rstd * gg.x, v[j].y * rstd * gg.y); w.y = pk2(v[j].z * rstd * gg.z, v[j].w * rstd * gg.w); o8[64 * j] = w; }
}
__device__ __forceinline__ void cvt_bf16_stream(const float* src, bf16* dst, size_t n8, size_t gtid, size_t nthr) {
    for (size_t i = gtid; i < n8; i += nthr) { const f32x4 a = *(const f32x4*)(src + i * 8), b = *(const f32x4*)(src + i * 8 + 4);
        v4u o; o.x = pk2(a.x, a.y); o.y = pk2(a.z, a.w); o.z = pk2(b.x, b.y); o.w = pk2(b.z, b.w); *(v4u*)(dst + i * 8) = o; }
}

__device__ __forceinline__ void cvt_i4_slices(const float* src, unsigned char* dst, float inv_step, size_t gtid, size_t nthr) {
    for (size_t i = gtid; i < (size_t)16384 * 64; i += nthr) { v4u o; const size_t e = i >> 6; const int c32 = (int)(i & 63), s = c32 >> 3, sub = c32 & 7;
#pragma unroll
        for (int w = 0; w < 4; ++w) { const f32x4 a = *(const f32x4*)(src + i * 32 + 8 * w) * inv_step, b = *(const f32x4*)(src + i * 32 + 8 * w + 4) * inv_step; unsigned d = 0u;
#pragma unroll
            for (int e_ = 0; e_ < 4; ++e_) { const int lo = (int)__builtin_amdgcn_fmed3f(__builtin_rintf(a[e_]), -8.f, 7.f) + 8, hi = (int)__builtin_amdgcn_fmed3f(__builtin_rintf(b[e_]), -8.f, 7.f) & 15; d |= ((unsigned)lo | ((unsigned)hi << 4)) << (8 * e_); }
            if (w == 0) o.x = d; else if (w == 1) o.y = d; else if (w == 2) o.z = d; else o.w = d; }
        *(v4u*)(dst + ((size_t)s * 16384 + e) * 128 + 16 * sub) = o; }
}
__device__ __forceinline__ float table_std16(const float* src, LAS float* scr, int tid) {
    float s = 0.f;
#pragma unroll
    for (int j = 0; j < 16; ++j) { const f32x4 v = *(const f32x4*)(src + (size_t)(j * 512 + tid) * 4); s += (v.x * v.x + v.y * v.y) + (v.z * v.z + v.w * v.w); }
    s = wave_sum(s);
    __syncthreads();
    if ((tid & 63) == 0) scr[tid >> 6] = s;
    __syncthreads();
    float t = 0.f;
#pragma unroll
    for (int w = 0; w < 8; ++w) t += scr[w];
    __syncthreads();
    return sqrtf(t * (1.0f / 32768.0f));
}
__device__ __forceinline__ void cvt_i8_slices(const float* src, unsigned char* dst, float scale, size_t gtid, size_t nthr) {
    for (size_t i = gtid; i < (size_t)16384 * 128; i += nthr) { v4u o; const size_t e = i >> 7; const int c16 = (int)(i & 127), s = c16 >> 3, sub = c16 & 7;
#pragma unroll
        for (int q = 0; q < 4; ++q) { const f32x4 a = *(const f32x4*)(src + i * 16 + 4 * q) * scale; unsigned w = 0u;
#pragma unroll
            for (int e_ = 0; e_ < 4; ++e_) { const int iv = (int)__builtin_amdgcn_fmed3f(__builtin_rintf(a[e_]), -127.f, 127.f); w |= ((unsigned)iv & 0xffu) << (8 * e_); }
            if (q == 0) o.x = w; else if (q == 1) o.y = w; else if (q == 2) o.z = w; else o.w = w; }
        *(v4u*)(dst + ((size_t)s * 16384 + e) * 128 + 16 * sub) = o; }
}
__device__ __forceinline__ void cvt_fp8_slices(const float* src, unsigned char* dst, float scale, size_t gtid, size_t nthr) {
    for (size_t i = gtid; i < (size_t)16384 * 128; i += nthr) { v4u o; const size_t e = i >> 7; const int c16 = (int)(i & 127), s = c16 >> 3, sub = c16 & 7;
#pragma unroll
        for (int q = 0; q < 4; ++q) { const f32x4 a = *(const f32x4*)(src + i * 16 + 4 * q) * scale; int w = __builtin_amdgcn_cvt_pk_fp8_f32(a.x, a.y, 0, false); w = __builtin_amdgcn_cvt_pk_fp8_f32(a.z, a.w, w, true);
            if (q == 0) o.x = (unsigned)w; else if (q == 1) o.y = (unsigned)w; else if (q == 2) o.z = (unsigned)w; else o.w = (unsigned)w; }
        *(v4u*)(dst + ((size_t)s * 16384 + e) * 128 + 16 * sub) = o; }
}

namespace att {
constexpr int SLOTB = 32768;
constexpr int NSLOT = 3, LW_OFF = NSLOT * SLOTB;
constexpr int XSTR = 132;
__device__ __forceinline__ void glds16(const void* gsrc, unsigned lds_dst) { unsigned keep;
    asm volatile("s_mov_b32 %0, m0\n\ts_mov_b32 m0, %2\n\ts_nop 0\n\tglobal_load_lds_dwordx4 %1, off\n\ts_mov_b32 m0, %0" : "=&s"(keep) : "v"(gsrc), "s"(lds_dst) : "memory"); }
__device__ __forceinline__ int crow(int r, int hi) { return (r & 3) + 8 * (r >> 2) + 4 * hi; }
typedef short v4i16_t __attribute__((ext_vector_type(4)));
__device__ __forceinline__ s16x4 vtr(const LAS char* p) { return __builtin_bit_cast(s16x4, __builtin_amdgcn_ds_read_tr16_b64_v4i16((LAS v4i16_t*)p)); }
#define ATT_WAIT_BAR(N) asm volatile("s_waitcnt vmcnt(" #N ") lgkmcnt(0)\n\ts_barrier" ::: "memory")
#define ATT_BAR() asm volatile("s_waitcnt lgkmcnt(0)\n\ts_barrier" ::: "memory")

template <int ABL> __device__ __forceinline__ void attn_unit(int b, int h, int qblk, const bf16* Q, const bf16* K, const bf16* V, bf16* MIX, const float* subg, float lam, float M2, LAS char* lds) {
    const int tid = threadIdx.x, lane = tid & 63, r32 = lane & 31, hi = lane >> 5, wid = __builtin_amdgcn_readfirstlane(tid >> 6), c = wid >> 2, qs = wid & 3;
    const size_t rowbase = (size_t)b * SEQ; const int q0 = qblk * 128, NT = 2 * (qblk + 1);
    const unsigned lds0 = (unsigned)(uintptr_t)lds;
    const bf16* ksrc[2]; const bf16* vsrc[2]; unsigned kdst[2], vdst[2];
#pragma unroll
    for (int i = 0; i < 2; ++i) { const int pk = 2 * wid + i, rr = lane >> 4, p = lane & 15, r = 4 * pk + rr;
        ksrc[i] = K + (rowbase + r) * 1024 + h * 128 + ((p ^ (r & 15)) * 8); kdst[i] = lds0 + pk * 1024;
        vsrc[i] = V + (rowbase + r) * 1024 + h * 128 + ((p ^ (rr << 2)) * 8); vdst[i] = lds0 + 16384 + pk * 1024; }
#define ATT_DMA(t, slot) do { _Pragma("unroll") for (int i_ = 0; i_ < 2; ++i_) { glds16(ksrc[i_] + (size_t)(t) * 64 * 1024, (unsigned)__builtin_amdgcn_readfirstlane(kdst[i_] + (slot) * SLOTB)); \
        glds16(vsrc[i_] + (size_t)(t) * 64 * 1024, (unsigned)__builtin_amdgcn_readfirstlane(vdst[i_] + (slot) * SLOTB)); } } while (0)
    ATT_DMA(0, 0); ATT_DMA(1, 1);
    const int qrow = q0 + 32 * qs + r32;
    bf16x8 qr[4];
#pragma unroll
    for (int d0 = 0; d0 < 4; ++d0) qr[d0] = *(const bf16x8*)(Q + (rowbase + qrow) * 1024 + h * 128 + c * 64 + d0 * 16 + hi * 8);
    asm volatile("" : "+v"(qr[0]), "+v"(qr[1]), "+v"(qr[2]), "+v"(qr[3]));
    const float slope2 = exp2f(-(float)(h + 1)) * 1.4426950408889634f;
    float base = -slope2 * (float)(qrow - 4 * hi) - M2;
    const float s32 = 32.f * slope2, s64 = 64.f * slope2;
    f32x16 o[4]; o[0] = f32x16{}; o[1] = f32x16{}; o[2] = f32x16{}; o[3] = f32x16{};
    float lsum = 0.f;
    int kofs[4], vofs[4];
    { const int q4 = (lane & 15) >> 2, p4 = lane & 3, gb = (lane >> 4) & 1;
#pragma unroll
      for (int d0 = 0; d0 < 4; ++d0) { kofs[d0] = r32 * 256 + (((8 * c + 2 * d0 + hi) ^ (r32 & 15)) << 4); vofs[d0] = 16384 + (4 * hi + q4) * 256 + (((((d0 ^ q4) << 2) | (gb << 1) | (p4 >> 1))) << 4) + (p4 & 1) * 8; } }
    const LAS char* lbase = (const LAS char*)lds;
    const int qw0 = q0 + 32 * qs;
#define ATT_PW(ks_) __builtin_bit_cast(bf16x8, ((v4u){pwd[4 * (ks_)], pwd[4 * (ks_) + 1], pwd[4 * (ks_) + 2], pwd[4 * (ks_) + 3]}))
#define ATT_VF(F, d_) ((bf16x8){F[2 * (d_)][0], F[2 * (d_)][1], F[2 * (d_)][2], F[2 * (d_)][3], F[2 * (d_) + 1][0], F[2 * (d_) + 1][1], F[2 * (d_) + 1][2], F[2 * (d_) + 1][3]})
#define ATT_VLDK(F, ks_) do { if (ABL & 16) { _Pragma("unroll") for (int d_ = 0; d_ < 8; ++d_) F[d_] = (s16x4){0, 0, 0, 0}; } else { _Pragma("unroll") for (int d_ = 0; d_ < 4; ++d_) { F[2 * d_] = vtr(sp_ + vofs[d_] + (ks_) * 4096); F[2 * d_ + 1] = vtr(sp_ + vofs[d_] + (ks_) * 4096 + 2048); } } } while (0)
#define ATT_MF(acc_, a_, b_) do { if (ABL & 2) { bf16x8 a__ = (a_), b__ = (b_); asm volatile("" :: "v"(a__), "v"(b__)); } else acc_ = __builtin_amdgcn_mfma_f32_32x32x16_bf16((a_), (b_), acc_, 0, 0, 0); } while (0)
#define ATT_PVK(F, ks_) do { _Pragma("unroll") for (int d_ = 0; d_ < 4; ++d_) ATT_MF(o[d_], ATT_PW(ks_), ATT_VF(F, d_)); } while (0)
#define ATT_SB() __builtin_amdgcn_sched_barrier(0)
    int slot = 0;
    for (int t = 0; t < NT; ++t) {
        if ((ABL & 64) && t > 0) { } else if (t == 0 || (ABL & 8)) { ATT_WAIT_BAR(0); } else if (t + 1 < NT) { ATT_WAIT_BAR(4); } else { ATT_WAIT_BAR(0); }
        if (!(ABL & 8) && t + 2 < NT) { const int s2_ = (slot == 0) ? 2 : slot - 1; ATT_DMA(t + 2, s2_); }
        const int k0 = 64 * t;
        if (k0 <= qw0 + 31) {
            const LAS char* sp_ = lbase + slot * SLOTB;
            f32x16 p0, p1; s16x4 fa[8], fb[8]; unsigned pwd[16];
#pragma unroll
            for (int r = 0; r < 16; ++r) { p0[r] = __builtin_fmaf(slope2, (float)((r & 3) + 8 * (r >> 2)), base); p1[r] = p0[r] + s32; }
            const bool diag = k0 + 63 > qw0;
            const int dq = qrow - k0;
            {
                float sA = 0.f, sB = 0.f, sC = 0.f, sD = 0.f; float e0[16], e1[16];
                __builtin_amdgcn_s_setprio(1);
#pragma unroll
                for (int d0 = 0; d0 < 4; ++d0) { const bf16x8 ka = *(const LAS bf16x8*)(sp_ + kofs[d0]); if (ABL & 4) { asm volatile("" :: "v"(ka)); } else p0 = __builtin_amdgcn_mfma_f32_32x32x16_bf16(ka, qr[d0], p0, 0, 0, 0); }
                ATT_VLDK(fa, 0); ATT_SB();
#pragma unroll
                for (int d0 = 0; d0 < 4; ++d0) { const bf16x8 kb = *(const LAS bf16x8*)(sp_ + kofs[d0] + 8192); if (ABL & 4) { asm volatile("" :: "v"(kb)); } else p1 = __builtin_amdgcn_mfma_f32_32x32x16_bf16(kb, qr[d0], p1, 0, 0, 0);
#pragma unroll
                    for (int i = 0; i < 4; ++i) e0[4 * d0 + i] = (ABL & 1) ? p0[4 * d0 + i] : __builtin_amdgcn_exp2f(p0[4 * d0 + i]);
                    if (diag) {
#pragma unroll
                        for (int i = 0; i < 4; ++i) if (crow(4 * d0 + i, hi) > dq) e0[4 * d0 + i] = 0.f; }
                    sA += e0[4 * d0]; sB += e0[4 * d0 + 1]; sC += e0[4 * d0 + 2]; sD += e0[4 * d0 + 3]; ATT_SB(); }
                ATT_VLDK(fb, 1);
#pragma unroll
                for (int j = 0; j < 8; ++j) pwd[j] = pk2(e0[2 * j], e0[2 * j + 1]);
                ATT_SB();
#pragma unroll
                for (int d_ = 0; d_ < 4; ++d_) { ATT_MF(o[d_], ATT_PW(0), ATT_VF(fa, d_));
                    e1[2 * d_] = (ABL & 1) ? p1[2 * d_] : __builtin_amdgcn_exp2f(p1[2 * d_]); e1[2 * d_ + 1] = (ABL & 1) ? p1[2 * d_ + 1] : __builtin_amdgcn_exp2f(p1[2 * d_ + 1]);
                    if (diag) { if (crow(2 * d_, hi) + 32 > dq) e1[2 * d_] = 0.f; if (crow(2 * d_ + 1, hi) + 32 > dq) e1[2 * d_ + 1] = 0.f; }
                    sA += e1[2 * d_]; sB += e1[2 * d_ + 1]; ATT_SB(); }
                ATT_VLDK(fa, 2); ATT_SB();
#pragma unroll
                for (int d_ = 0; d_ < 4; ++d_) { ATT_MF(o[d_], ATT_PW(1), ATT_VF(fb, d_));
                    e1[8 + 2 * d_] = (ABL & 1) ? p1[8 + 2 * d_] : __builtin_amdgcn_exp2f(p1[8 + 2 * d_]); e1[8 + 2 * d_ + 1] = (ABL & 1) ? p1[8 + 2 * d_ + 1] : __builtin_amdgcn_exp2f(p1[8 + 2 * d_ + 1]);
                    if (diag) { if (crow(8 + 2 * d_, hi) + 32 > dq) e1[8 + 2 * d_] = 0.f; if (crow(8 + 2 * d_ + 1, hi) + 32 > dq) e1[8 + 2 * d_ + 1] = 0.f; }
                    sC += e1[8 + 2 * d_]; sD += e1[8 + 2 * d_ + 1];
                    pwd[8 + d_] = pk2(e1[2 * d_], e1[2 * d_ + 1]); ATT_SB(); }
                ATT_VLDK(fb, 3);
#pragma unroll
                for (int j = 4; j < 8; ++j) pwd[8 + j] = pk2(e1[2 * j], e1[2 * j + 1]);
                lsum += (sA + sB) + (sC + sD);
                ATT_SB();
                ATT_PVK(fa, 2); ATT_SB(); ATT_PVK(fb, 3);
                __builtin_amdgcn_s_setprio(0);
            }
        }
        base += s64;
        slot = (slot == NSLOT - 1) ? 0 : slot + 1;
    }
#undef ATT_PW
#undef ATT_VF
#undef ATT_VLDK
#undef ATT_PVK
#undef ATT_MF
#undef ATT_SB
    ATT_WAIT_BAR(0);
    if (ABL & 32) { float keep_ = lsum + o[0][0] + o[1][1] + o[2][2] + o[3][3]; asm volatile("" :: "v"(keep_)); return; }
    LAS float* lw = (LAS float*)(lds + LW_OFF) + wid * 32;
    { auto rr = __builtin_amdgcn_permlane32_swap(__float_as_uint(lsum), __float_as_uint(lsum), false, false); lsum = __uint_as_float(rr[0]) + __uint_as_float(rr[1]); }
    if (hi == 0) lw[r32] = lsum;
    LDS_WAIT();
    LAS float* X = (LAS float*)lds + qs * 32 * XSTR;
#pragma unroll
    for (int r = 0; r < 16; ++r) { const float rl = 1.0f / lw[crow(r, hi)];
#pragma unroll
        for (int d0 = 0; d0 < 4; ++d0) o[d0][r] *= rl; }
    if (c == 1) {
#pragma unroll
        for (int r = 0; r < 16; ++r)
#pragma unroll
            for (int d0 = 0; d0 < 4; ++d0) X[crow(r, hi) * XSTR + d0 * 32 + r32] = o[d0][r];
    }
    ATT_WAIT_BAR(0);
    if (c == 0) {
#pragma unroll
        for (int r = 0; r < 16; ++r)
#pragma unroll
            for (int d0 = 0; d0 < 4; ++d0) { LAS float* px = X + crow(r, hi) * XSTR + d0 * 32 + r32; const float a = o[d0][r] - lam * (*px); *px = a; }
        LDS_WAIT(); asm volatile("" ::: "memory");
        const LAS f32x4* rp = (const LAS f32x4*)(X + r32 * XSTR + hi * 64);
        f32x4 av[16]; float ss = 0.f;
#pragma unroll
        for (int j = 0; j < 16; ++j) { av[j] = rp[j]; ss += (av[j].x * av[j].x + av[j].y * av[j].y) + (av[j].z * av[j].z + av[j].w * av[j].w); }
        { auto rr = __builtin_amdgcn_permlane32_swap(__float_as_uint(ss), __float_as_uint(ss), false, false); ss = __uint_as_float(rr[0]) + __uint_as_float(rr[1]); }
        const float rs = 0.8f / sqrtf(ss * (1.0f / 128.0f) + EPS);
        bf16* op = MIX + (rowbase + qrow) * 2048 + h * 128 + hi * 64;
#pragma unroll
        for (int j = 0; j < 8; ++j) { const f32x4 g0 = *(const f32x4*)(subg + hi * 64 + 8 * j), g1 = *(const f32x4*)(subg + hi * 64 + 8 * j + 4); const f32x4 a0 = av[2 * j] * rs * g0, a1 = av[2 * j + 1] * rs * g1;
            v4u w; w.x = pk2(a0.x, a0.y); w.y = pk2(a0.z, a0.w); w.z = pk2(a1.x, a1.y); w.w = pk2(a1.z, a1.w); *(v4u*)(op + 8 * j) = w; }
    }
    ATT_BAR();
#undef ATT_DMA
}
}


#ifndef DBG_NAIVE_ATTN
#define DBG_NAIVE_ATTN 0
#endif
#if DBG_NAIVE_ATTN
__device__ __forceinline__ void naive_attn_row(int b, int h, int q, const bf16* Q, const bf16* K, const bf16* V, bf16* MIX, const float* subg, float lam, LAS float* S, int lane) {
    const size_t rowbase = (size_t)b * SEQ; const float slope2 = exp2f(-(float)(h + 1)) * 1.4426950408889634f;
    for (int c = 0; c < 2; ++c) {
        float qv[64];
        const bf16* qp = Q + (rowbase + q) * 1024 + h * 128 + c * 64;
#pragma unroll
        for (int d = 0; d < 64; d += 2) { const unsigned u = *(const unsigned*)(qp + d); qv[d] = bflo(u); qv[d + 1] = bfhi(u); }
        for (int key = lane; key <= q; key += 64) { const bf16* kp = K + (rowbase + key) * 1024 + h * 128 + c * 64; float s = 0.f;
#pragma unroll
            for (int d = 0; d < 64; d += 2) { const unsigned u = *(const unsigned*)(kp + d); s += qv[d] * bflo(u) + qv[d + 1] * bfhi(u); }
            S[c * 2048 + key] = s - slope2 * (float)(q - key); }
    }
    LDS_WAIT();
    float linv[2];
    for (int c = 0; c < 2; ++c) { float m = -1e30f; for (int key = lane; key <= q; key += 64) m = fmaxf(m, S[c * 2048 + key]); m = wave_max(m);
        float l = 0.f; for (int key = lane; key <= q; key += 64) { const float p = exp2f(S[c * 2048 + key] - m); S[c * 2048 + key] = p; l += p; } linv[c] = 1.0f / wave_sum(l); }
    for (int key = lane; key <= q; key += 64) S[key] = S[key] * linv[0] - lam * S[2048 + key] * linv[1];
    LDS_WAIT();
    float o0 = 0.f, o1 = 0.f; const bf16* vp = V + rowbase * 1024 + h * 128 + lane;
    for (int key = 0; key <= q; ++key) { const float a = S[key]; o0 += a * __uint_as_float((unsigned)vp[(size_t)key * 1024] << 16); o1 += a * __uint_as_float((unsigned)vp[(size_t)key * 1024 + 64] << 16); }
    const float ss = wave_sum(o0 * o0 + o1 * o1); const float rs = 0.8f / sqrtf(ss * (1.0f / 128.0f) + EPS);
    bf16* op = MIX + (rowbase + q) * 2048 + h * 128 + lane;
    op[0] = (bf16)(pk2(o0 * rs * subg[lane], 0.f) & 0xffffu); op[64] = (bf16)(pk2(o1 * rs * subg[lane + 64], 0.f) & 0xffffu);
    LDS_WAIT();
}
#endif

__device__ __forceinline__ unsigned ord_key(float f) { const unsigned u = __float_as_uint(f); return (u & 0x80000000u) ? ~u : (u | 0x80000000u); }
__device__ __forceinline__ float ord_val(unsigned k) { return __uint_as_float((k & 0x80000000u) ? (k ^ 0x80000000u) : ~k); }
#define CE_DESC(a, b) do { const unsigned hi__ = max((a), (b)), lo__ = min((a), (b)); (a) = hi__; (b) = lo__; } while (0)
__device__ __forceinline__ void sort16_desc(unsigned (&v)[16]) {
#pragma unroll
    for (int k = 2; k <= 16; k <<= 1)
#pragma unroll
        for (int j = k >> 1; j > 0; j >>= 1)
#pragma unroll
            for (int i = 0; i < 16; ++i) { const int l = i ^ j; if (l > i) { if ((i & k) == 0) CE_DESC(v[i], v[l]); else CE_DESC(v[l], v[i]); } }
}
__device__ __forceinline__ void merge16_desc_rev(unsigned (&a)[16], const unsigned (&brev)[16]) {
#pragma unroll
    for (int i = 0; i < 16; ++i) a[i] = max(a[i], brev[i]);
#pragma unroll
    for (int j = 8; j > 0; j >>= 1)
#pragma unroll
        for (int i = 0; i < 16; ++i) { const int l = i ^ j; if (l > i) CE_DESC(a[i], a[l]); }
}

constexpr int P5_LST_OFF = 65536, P5_TAB_OFF = P5_LST_OFF + 16384;
__device__ __forceinline__ void peer_topk_item(int tile, int h, const bf16* QP, const float* SSQ, int* EIDX, float* EGATE, float* RSTD, LAS char* lds) {
    const int tid = threadIdx.x, lane = tid & 63, r32 = lane & 31, hi = lane >> 5, wid = __builtin_amdgcn_readfirstlane(tid >> 6);
    LAS unsigned* LST = (LAS unsigned*)(lds + P5_LST_OFF);
    const LAS unsigned char* TAB = (const LAS unsigned char*)(lds + P5_TAB_OFF);
    const int tok0 = tile * 128;
    {
        const int c = wid >> 2, tb = wid & 3;
        bf16x8 qf[8];
        const bf16* qp = QP + (size_t)(tok0 + tb * 32 + r32) * 2048 + h * 256 + c * 128 + hi * 8;
#pragma unroll
        for (int s = 0; s < 8; ++s) qf[s] = *(const bf16x8*)(qp + 16 * s);
        const LAS char* sp = lds + c * 32768 + hi * 2048 + r32 * 16;
        unsigned best[16];
#pragma unroll
        for (int kb = 0; kb < 4; ++kb) { f32x16 acc = f32x16{};
#pragma unroll
            for (int s = 0; s < 8; ++s) { const bf16x8 sf = *(const LAS bf16x8*)(sp + s * 4096 + kb * 512); acc = __builtin_amdgcn_mfma_f32_32x32x16_bf16(sf, qf[s], acc, 0, 0, 0); }
            unsigned v[16];
#pragma unroll
            for (int r = 0; r < 16; ++r) v[r] = (ord_key(acc[r]) & ~0x7Fu) | (unsigned)(32 * kb + (r & 3) + 8 * (r >> 2)) | (unsigned)(hi << 2);
            sort16_desc(v);
            if (kb == 0) {
#pragma unroll
                for (int i = 0; i < 16; ++i) best[i] = v[i];
            } else { unsigned vr[16];
#pragma unroll
                for (int i = 0; i < 16; ++i) vr[i] = v[15 - i];
                merge16_desc_rev(best, vr); } }
        {
            unsigned br[16];
#pragma unroll
            for (int i = 0; i < 16; ++i) { const auto r_ = __builtin_amdgcn_permlane32_swap(best[15 - i], best[15 - i], false, false); br[i] = (lane & 32) ? r_[0] : r_[1]; }
            merge16_desc_rev(best, br); }
        if (hi == 0) { LAS unsigned* lrow = LST + (c * 128 + tb * 32 + r32) * 16;
#pragma unroll
            for (int i = 0; i < 4; ++i) *(LAS v4u*)(lrow + 4 * i) = (v4u){best[4 * i], best[4 * i + 1], best[4 * i + 2], best[4 * i + 3]}; }
    }
    __syncthreads();
    {
        const int token = tid >> 2, q = tid & 3;
        const LAS unsigned* l1 = LST + token * 16; const LAS unsigned* l2 = LST + (128 + token) * 16;
        unsigned v[16];
#pragma unroll
        for (int m = 0; m < 13; ++m) { const int n = 4 * m + q; const unsigned pid = TAB[n < 50 ? n : 0]; const unsigned a = l1[pid >> 4], b2 = l2[pid & 15u];
            const unsigned key = (ord_key(ord_val(a & ~0x7Fu) + ord_val(b2 & ~0x7Fu)) & ~0xFFu) | pid; v[m] = n < 50 ? key : 0u; }
        v[13] = 0u; v[14] = 0u; v[15] = 0u;
        sort16_desc(v);
#pragma unroll
        for (int w = 1; w <= 2; w <<= 1) { unsigned br[16];
#pragma unroll
            for (int i = 0; i < 16; ++i) br[i] = (unsigned)(w == 1 ? __builtin_amdgcn_update_dpp(0, (int)v[15 - i], 0xB1, 0xf, 0xf, false) : __builtin_amdgcn_update_dpp(0, (int)v[15 - i], 0x4E, 0xf, 0xf, false));
            merge16_desc_rev(v, br); }
        const int t = tok0 + token;
        const f32x4 p0 = *(const f32x4*)(SSQ + (size_t)t * 32 + 8 * q), p1 = *(const f32x4*)(SSQ + (size_t)t * 32 + 8 * q + 4);
        float ssq = ((p0.x + p0.y) + (p0.z + p0.w)) + ((p1.x + p1.y) + (p1.z + p1.w));
        ssq += DPPF(ssq, 0xB1); ssq += DPPF(ssq, 0x4E);
        const float rstd = 1.0f / sqrtf(ssq * (1.0f / DM) + EPS);
        if (h == 0 && q == 0) RSTD[t] = rstd;
        const unsigned p_top = v[0] & 0xFFu; const float vmax = (ord_val(l1[p_top >> 4] & ~0x7Fu) + ord_val(l2[p_top & 15u] & ~0x7Fu)) * rstd;
        float ev[4]; int ex[4]; float es = 0.f;
#pragma unroll
        for (int m = 0; m < 4; ++m) { const unsigned kk = q == 0 ? v[m] : q == 1 ? v[4 + m] : q == 2 ? v[8 + m] : v[12 + m];
            const unsigned pid = kk & 0xFFu; const unsigned a = l1[pid >> 4], b2 = l2[pid & 15u];
            const float sv = (ord_val(a & ~0x7Fu) + ord_val(b2 & ~0x7Fu)) * rstd;
            ev[m] = __expf(sv - vmax); es += ev[m]; ex[m] = (int)((a & 0x7Fu) * 128u + (b2 & 0x7Fu)); }
        es += DPPF(es, 0xB1); es += DPPF(es, 0x4E);
        const float inv = 1.0f / es;
        *(int4*)(EIDX + (size_t)t * 128 + h * 16 + 4 * q) = make_int4(ex[0], ex[1], ex[2], ex[3]);
        *(f32x4*)(EGATE + (size_t)t * 128 + h * 16 + 4 * q) = (f32x4){ev[0] * inv, ev[1] * inv, ev[2] * inv, ev[3] * inv};
    }
    __syncthreads();
}

__device__ __forceinline__ f32x2 dot16_fp8(const v4u u, const f32x2* h, f32x2 acc) {
#pragma unroll
    for (int w = 0; w < 4; ++w) { const unsigned d = w == 0 ? u.x : w == 1 ? u.y : w == 2 ? u.z : u.w;
        const f32x2 f0 = __builtin_amdgcn_cvt_pk_f32_fp8((int)d, false), f1 = __builtin_amdgcn_cvt_pk_f32_fp8((int)d, true);
        acc = __builtin_elementwise_fma(h[2 * w], f0, acc); acc = __builtin_elementwise_fma(h[2 * w + 1], f1, acc); }
    return acc;
}
__device__ __forceinline__ void axpy16_fp8(const v4u v, f32x2 a2, f32x2* o) {
#pragma unroll
    for (int w = 0; w < 4; ++w) { const unsigned d = w == 0 ? v.x : w == 1 ? v.y : w == 2 ? v.z : v.w;
        const f32x2 f0 = __builtin_amdgcn_cvt_pk_f32_fp8((int)d, false), f1 = __builtin_amdgcn_cvt_pk_f32_fp8((int)d, true);
        o[2 * w] = __builtin_elementwise_fma(a2, f0, o[2 * w]); o[2 * w + 1] = __builtin_elementwise_fma(a2, f1, o[2 * w + 1]); }
}
struct PItem { int t, s; };
__device__ __forceinline__ PItem peer_item(int q, int nq, int nper, int tb, int tstride, int xl) {
    const int j = (q < nq ? q : nq - 1) >> 1; PItem it; const int r = j >= nper ? 1 : 0; it.s = 8 * r + xl; const int t = tb + (j - r * nper) * tstride; it.t = t < T ? t : T - 1; return it; }
__device__ __forceinline__ void pe_idx8(const PItem it, int hh, const int* EIDX, int g, int (&ex)[8]) {
#pragma unroll
    for (int i = 0; i < 2; ++i) { const int4 v = *(const int4*)(EIDX + (size_t)it.t * 128 + g * 16 + 8 * hh + 4 * i); ex[4 * i] = v.x; ex[4 * i + 1] = v.y; ex[4 * i + 2] = v.z; ex[4 * i + 3] = v.w; }
}
__device__ __forceinline__ void pe_gather8(const PItem it, const unsigned char* TB, int sub, const int (&ex)[8], v4u (&uv)[8]) {
    const unsigned char* ub = TB + (size_t)it.s * 16384 * 128;
#pragma unroll
    for (int i = 0; i < 8; ++i) uv[i] = *(const v4u*)(ub + (unsigned)(ex[i] * 128 + 16 * sub));
}
__device__ __forceinline__ int sdot4(unsigned a, unsigned b, int acc) { return __builtin_amdgcn_sdot4((int)a, (int)b, acc, false); }
__device__ __forceinline__ void pu_acc8(const v4u (&uv)[8], const v4u ha, const v4u hb, int hs8, int (&r)[8]) {
#pragma unroll
    for (int i = 0; i < 8; ++i) { int a = -hs8, b = 0;
        a = sdot4(uv[i].x & 0x0F0F0F0Fu, ha.x, a); b = sdot4(uv[i].x & 0xF0F0F0F0u, ha.y, b); a = sdot4(uv[i].y & 0x0F0F0F0Fu, ha.z, a); b = sdot4(uv[i].y & 0xF0F0F0F0u, ha.w, b);
        a = sdot4(uv[i].z & 0x0F0F0F0Fu, hb.x, a); b = sdot4(uv[i].z & 0xF0F0F0F0u, hb.y, b); a = sdot4(uv[i].w & 0x0F0F0F0Fu, hb.z, a); b = sdot4(uv[i].w & 0xF0F0F0F0u, hb.w, b);
        r[i] = a + (b >> 4); }
}
__device__ __forceinline__ void pu_store(const PItem it, bool valid, float* PART, int lane, const int (&rlo)[8], const int (&rhi)[8]) {
    const int g = lane >> 3, sub = lane & 7;
    int r[16];
#pragma unroll
    for (int i = 0; i < 8; ++i) { r[i] = rlo[i]; r[8 + i] = rhi[i]; }
    { const bool up = (lane & 4) != 0;
#pragma unroll
      for (int j = 0; j < 8; ++j) { const int a = r[j], b2 = r[j + 8]; const int keep = up ? b2 : a, send = up ? a : b2; const int m_ = __builtin_amdgcn_update_dpp(0, send, 0x141, 0xf, 0xf, false); r[j] = keep + __builtin_amdgcn_update_dpp(0, m_, 0x1B, 0xf, 0xf, false); } }
    { const bool up = (lane & 2) != 0;
#pragma unroll
      for (int j = 0; j < 4; ++j) { const int a = r[j], b2 = r[j + 4]; const int keep = up ? b2 : a, send = up ? a : b2; r[j] = keep + __builtin_amdgcn_update_dpp(0, send, 0x4E, 0xf, 0xf, false); } }
    { const bool up = (lane & 1) != 0;
#pragma unroll
      for (int j = 0; j < 2; ++j) { const int a = r[j], b2 = r[j + 2]; const int keep = up ? b2 : a, send = up ? a : b2; r[j] = keep + __builtin_amdgcn_update_dpp(0, send, 0xB1, 0xf, 0xf, false); } }
    const int i0 = 8 * ((sub >> 2) & 1) + 4 * ((sub >> 1) & 1) + 2 * (sub & 1);
    if (valid) *(f32x2*)(PART + ((size_t)it.s * T + it.t) * 128 + g * 16 + i0) = (f32x2){(float)r[0], (float)r[1]};
}
__device__ __forceinline__ PItem peer_item1(int q, int nq, int tb, int tstride, int xl) { const int j = (q < nq ? q : nq - 1) >> 1; PItem it; it.s = xl; const int t = tb + j * tstride; it.t = t < T ? t : T - 1; return it; }
__device__ __forceinline__ void peer_u_stage(int nper, int tb, int tstride, int xl, const unsigned char* H8, const unsigned char* U8, const int* EIDX, float* PART, int lane) {
    const int g = lane >> 3, sub = lane & 7, NQ = 2 * nper;
    int ex0[8], ex1[8], ex2[8], ex3[8]; v4u uv0[8], uv1[8], uv2[8], uv3[8], ha0, ha1, ha2, ha3, hb0, hb1, hb2, hb3; int rs[8];
#define PU_I(q, X) do { const PItem it_ = peer_item1((q), NQ, tb, tstride, xl); pe_idx8(it_, (X) & 1, EIDX, g, ex##X); } while (0)
#define PU_G(q, X) do { const PItem it_ = peer_item1((q), NQ, tb, tstride, xl); pe_gather8(it_, U8, sub, ex##X, uv##X); const unsigned char* hp_ = H8 + (size_t)it_.t * 2048 + 256 * it_.s + 32 * sub; ha##X = *(const v4u*)hp_; hb##X = *(const v4u*)(hp_ + 16); } while (0)
#define PU_F(q, X) do { const PItem it_ = peer_item1((q), NQ, tb, tstride, xl); int hs_ = sdot4(ha##X.x, 0x01010101u, 0); hs_ = sdot4(ha##X.z, 0x01010101u, hs_); hs_ = sdot4(hb##X.x, 0x01010101u, hs_); hs_ = sdot4(hb##X.z, 0x01010101u, hs_); \
        if (((X) & 1) == 0) pu_acc8(uv##X, ha##X, hb##X, 8 * hs_, rs); else { int rh_[8]; pu_acc8(uv##X, ha##X, hb##X, 8 * hs_, rh_); \
        pu_store(it_, (q) < NQ && (tb + ((q) >> 1) * tstride) < T, PART, lane, rs, rh_); } } while (0)
    PU_I(0, 0); PU_I(1, 1); PU_I(2, 2); PU_I(3, 3); PU_G(0, 0); PU_G(1, 1); PU_G(2, 2);
#pragma unroll 1
    for (int q = 0; q < NQ; q += 4) {
        PU_F(q, 0);     PU_G(q + 3, 3); PU_I(q + 4, 0);
        PU_F(q + 1, 1); PU_G(q + 4, 0); PU_I(q + 5, 1);
        PU_F(q + 2, 2); PU_G(q + 5, 1); PU_I(q + 6, 2);
        PU_F(q + 3, 3); PU_G(q + 6, 2); PU_I(q + 7, 3);
    }
#undef PU_I
#undef PU_G
#undef PU_F
}
__device__ __forceinline__ void tr4x4(unsigned r0, unsigned r1, unsigned r2, unsigned r3, unsigned& c0, unsigned& c1, unsigned& c2, unsigned& c3) {
    const unsigned a = __builtin_amdgcn_perm(r1, r0, 0x05010400u), b = __builtin_amdgcn_perm(r1, r0, 0x07030602u), c = __builtin_amdgcn_perm(r3, r2, 0x05010400u), d = __builtin_amdgcn_perm(r3, r2, 0x07030602u);
    c0 = __builtin_amdgcn_perm(c, a, 0x05040100u); c1 = __builtin_amdgcn_perm(c, a, 0x07060302u); c2 = __builtin_amdgcn_perm(d, b, 0x05040100u); c3 = __builtin_amdgcn_perm(d, b, 0x07060302u);
}
template <bool FIRST> __device__ __forceinline__ void pv_acc8(const v4u (&vv)[8], const unsigned aq0, const unsigned aq1, int (&acc)[32]) {
#pragma unroll
    for (int m = 0; m < 2; ++m) { const unsigned aq = m == 0 ? aq0 : aq1;
#pragma unroll
        for (int w = 0; w < 4; ++w) { unsigned d[4];
#pragma unroll
            for (int i = 0; i < 4; ++i) d[i] = w == 0 ? vv[4 * m + i].x : w == 1 ? vv[4 * m + i].y : w == 2 ? vv[4 * m + i].z : vv[4 * m + i].w;
            unsigned c0, c1, c2, c3;
            tr4x4(d[0], d[1], d[2], d[3], c0, c1, c2, c3);
            const bool z_ = FIRST && m == 0;
            acc[8 * w + 0] = sdot4(c0, aq, z_ ? 0 : acc[8 * w + 0]); acc[8 * w + 1] = sdot4(c1, aq, z_ ? 0 : acc[8 * w + 1]); acc[8 * w + 2] = sdot4(c2, aq, z_ ? 0 : acc[8 * w + 2]); acc[8 * w + 3] = sdot4(c3, aq, z_ ? 0 : acc[8 * w + 3]);
            acc[8 * w + 4] = sdot4(c0 & 0xF0F0F0F0u, aq, z_ ? 0 : acc[8 * w + 4]); acc[8 * w + 5] = sdot4(c1 & 0xF0F0F0F0u, aq, z_ ? 0 : acc[8 * w + 5]); acc[8 * w + 6] = sdot4(c2 & 0xF0F0F0F0u, aq, z_ ? 0 : acc[8 * w + 6]); acc[8 * w + 7] = sdot4(c3 & 0xF0F0F0F0u, aq, z_ ? 0 : acc[8 * w + 7]); } }
}
__device__ __forceinline__ void pv_store(const PItem it, bool valid, float* out, const f32x4 ginv, const float sc, int lane, int (&acc)[32], int asum, const v2u x1b) {
    const int g = lane >> 3, sub = lane & 7;
#pragma unroll
    for (int w_ = 0; w_ < 4; ++w_)
#pragma unroll
        for (int b_ = 0; b_ < 4; ++b_) acc[8 * w_ + b_] -= acc[8 * w_ + 4 + b_];
#pragma unroll
    for (int j = 0; j < 16; ++j) { const auto r_ = __builtin_amdgcn_permlane32_swap((unsigned)acc[j], (unsigned)acc[j + 16], false, false); acc[j] = (int)r_[0] + (int)r_[1]; }
#pragma unroll
    for (int j = 0; j < 8; ++j) { const auto r_ = __builtin_amdgcn_permlane16_swap((unsigned)acc[j], (unsigned)acc[j + 8], false, false); acc[j] = (int)r_[0] + (int)r_[1]; }
    { const bool up = (lane & 8) != 0;
#pragma unroll
      for (int j = 0; j < 4; ++j) { const int a = acc[j], b2 = acc[j + 4]; const int keep = up ? b2 : a, send = up ? a : b2; acc[j] = keep + __builtin_amdgcn_update_dpp(0, send, 0x128, 0xf, 0xf, false); } }
    asum += __builtin_amdgcn_update_dpp(0, asum, 0x128, 0xf, 0xf, false);
    { const auto r_ = __builtin_amdgcn_permlane16_swap((unsigned)asum, (unsigned)asum, false, false); asum = (int)r_[0] + (int)r_[1]; }
    { const auto r_ = __builtin_amdgcn_permlane32_swap((unsigned)asum, (unsigned)asum, false, false); asum = (int)r_[0] + (int)r_[1]; }
    const int c0 = 16 * ((g >> 2) & 1) + 8 * ((g >> 1) & 1) + 4 * (g & 1);
    const bool hicol = (c0 & 4) != 0;
    int v_[4];
#pragma unroll
    for (int i = 0; i < 4; ++i) v_[i] = hicol ? (acc[i] >> 4) : (acc[i] - 8 * asum);
    if (valid) *(f32x4*)(out + (size_t)it.t * 2048 + 256 * it.s + 32 * sub + c0) = (f32x4){bflo(x1b.x) * ginv.x + sc * (float)v_[0], bfhi(x1b.x) * ginv.y + sc * (float)v_[1], bflo(x1b.y) * ginv.z + sc * (float)v_[2], bfhi(x1b.y) * ginv.w + sc * (float)v_[3]};
}
template <int ABL> __device__ __forceinline__ void peer_v_stage(int nper, int tb, int tstride, int xl, const unsigned char* V8, const int* EIDX, const unsigned* ACTQ, const float* ASC, const bf16* A2, const float* ffn_g, float* out, int lane) {
    const int g = lane >> 3, sub = lane & 7, NQ = 2 * nper;
    const int c0 = 16 * ((g >> 2) & 1) + 8 * ((g >> 1) & 1) + 4 * (g & 1);
    int ex0[8], ex1[8], ex2[8], ex3[8]; v4u vv0[8], vv1[8], vv2[8], vv3[8]; v2u aq0, aq1, aq2, aq3, x1a, x1b; float sca = 0.f, scb = 0.f; int acc[32]; int asum = 0;
    f32x4 ginv; { const f32x4 gg = *(const f32x4*)(ffn_g + 256 * xl + 32 * sub + c0); ginv = (f32x4){1.0f / gg.x, 1.0f / gg.y, 1.0f / gg.z, 1.0f / gg.w}; }
#define PV_I(q, X) do { const PItem it_ = peer_item1((q), NQ, tb, tstride, xl); pe_idx8(it_, (X) & 1, EIDX, g, ex##X); } while (0)
#define PV_G(q, X, XV, SCV) do { const PItem it_ = peer_item1((q), NQ, tb, tstride, xl); if (ABL & 2) { _Pragma("unroll") for (int i_ = 0; i_ < 8; ++i_) vv##X[i_] = (v4u){(unsigned)ex##X[i_], 1u, 2u, 3u}; } else pe_gather8(it_, V8, sub, ex##X, vv##X); \
        aq##X = *(const v2u*)(ACTQ + (size_t)it_.t * 32 + g * 4 + 2 * ((X) & 1)); \
        if ((X) & 1) { XV = *(const v2u*)(A2 + (size_t)it_.t * 2048 + 256 * it_.s + 32 * sub + c0); SCV = ASC[it_.t]; } } while (0)
#define PV_F(q, X, XV, SCV) do { const PItem it_ = peer_item1((q), NQ, tb, tstride, xl); if (((X) & 1) == 0) asum = 0; \
        asum = sdot4(aq##X.x, 0x01010101u, asum); asum = sdot4(aq##X.y, 0x01010101u, asum); \
        if (ABL & 1) { _Pragma("unroll") for (int i_ = 0; i_ < 8; ++i_) asm volatile("" :: "v"(vv##X[i_])); acc[0] += (int)aq##X.x; } else pv_acc8<((X) & 1) == 0>(vv##X, aq##X.x, aq##X.y, acc); if ((X) & 1) pv_store(it_, (q) < NQ && (tb + ((q) >> 1) * tstride) < T, out, ginv, SCV, lane, acc, asum, XV); } while (0)
    PV_I(0, 0); PV_I(1, 1); PV_I(2, 2); PV_I(3, 3); PV_G(0, 0, x1a, sca); PV_G(1, 1, x1a, sca); PV_G(2, 2, x1b, scb);
#pragma unroll 1
    for (int q = 0; q < NQ; q += 4) {
        PV_F(q, 0, x1a, sca);     PV_G(q + 3, 3, x1b, scb); PV_I(q + 4, 0);
        PV_F(q + 1, 1, x1a, sca); PV_G(q + 4, 0, x1a, sca); PV_I(q + 5, 1);
        PV_F(q + 2, 2, x1b, scb); PV_G(q + 5, 1, x1a, sca); PV_I(q + 6, 2);
        PV_F(q + 3, 3, x1b, scb); PV_G(q + 6, 2, x1b, scb); PV_I(q + 7, 3);
    }
#undef PV_I
#undef PV_G
#undef PV_F
}

struct Args { const float* in[17]; float* out; unsigned char* ws; int ph_lo, ph_hi; };
__global__ void __launch_bounds__(NTHREADS, 2) mk_fwd(Args args) {
    extern __shared__ __attribute__((aligned(16))) unsigned char lds_raw[];
    LAS unsigned char* lds = (LAS unsigned char*)lds_raw;
    int tid = threadIdx.x, lane = tid & 63; const int wave = __builtin_amdgcn_readfirstlane(tid >> 6);
    const int G = gridDim.x, bx = blockIdx.x;
    const int vcu = (G % 8 == 0) ? (bx % 8) * (G / 8) + bx / 8 : bx;
    unsigned char* ws = args.ws;
    const float* x = args.in[0]; const float* attn_g = args.in[1]; const float* w_in = args.in[2]; const float* qg = args.in[3]; const float* kg = args.in[4];
    const float* lq1 = args.in[5]; const float* lk1 = args.in[6]; const float* lq2 = args.in[7]; const float* lk2 = args.in[8]; const float* subg = args.in[9];
    const float* conv_w = args.in[10]; const float* w_out = args.in[11]; const float* ffn_g = args.in[12]; const float* w_q = args.in[13]; const float* subkeys = args.in[14];
    const float* peer_u = args.in[15]; const float* peer_v = args.in[16];
    float* out = args.out;
    bf16* WtIn = (bf16*)(ws + WS_WIN); bf16* WtOut = (bf16*)(ws + WS_WOUT); bf16* WtQ = (bf16*)(ws + WS_WQ); bf16* SK = (bf16*)(ws + WS_SK);
    float* SSQ = (float*)(ws + WS_SSQ); int* EIDX = (int*)(ws + WS_EIDX); float* EGATE = (float*)(ws + WS_EGATE); float* RSTD = (float*)(ws + WS_RSTD);
    bf16* XN = (bf16*)(ws + WS_XN); bf16* MIX = XN;
    bf16* Qb = (bf16*)(ws + WS_Q); bf16* Kb = (bf16*)(ws + WS_K); bf16* Vb = (bf16*)(ws + WS_V); bf16* QP = Qb;
    bf16* CB = (bf16*)(ws + WS_CB); bf16* CC = (bf16*)(ws + WS_CC); bf16* CX = (bf16*)(ws + WS_CX); bf16* A2 = CB;
    unsigned char* U8 = ws + WS_UT; unsigned char* V8 = ws + WS_VT;
    volatile LAS unsigned* MISC = (volatile LAS unsigned*)(lds + MISC_OFF);
    if (tid < 16) MISC[tid] = 0u;
    __syncthreads();
    XcdBarrier bar = xcd_barrier_post((unsigned*)(ws + WS_CTL) + CW_BAR, MISC + 8);
    const int lo = args.ph_lo, hi_ph = args.ph_hi & 255, dbg_flags = args.ph_hi >> 8;
#ifndef DBG_DUP
#define DBG_DUP -1
#endif
#ifndef DBG_MASK
#define DBG_MASK 0xfff
#endif
#define IN(k) (((DBG_MASK >> (k)) & 1) && lo <= (k) && (k) < hi_ph)
#define REPS(k) for (int rep_ = 0; rep_ < ((DBG_DUP == (k)) ? 2 : 1); ++rep_)
#define SEAM(k) do { if (IN(k) && IN((k) + 1)) xcd_barrier(bar); } while (0)
    const int gw = vcu * NWAVES + wave, NGW = G * NWAVES;
    size_t gtid = (size_t)bx * NTHREADS + tid; const size_t nthr = (size_t)G * NTHREADS;

    if (IN(0)) REPS(0) {
        LAS float* scr = (LAS float*)(lds + wave * 16384);
        constexpr int I_IN = (DM / 64) * (INC / 32), I_SQ = (DM / 64) * (DM / 32);
        if (!(dbg_flags & 4))
        for (int it = gw; it < I_IN + 2 * I_SQ; it += NGW) {
            if (it < I_IN) p0_transpose_item(w_in, DM, INC, WtIn, scr, it, lane, true);
            else if (it < I_IN + I_SQ) p0_transpose_item(w_out, DM, DM, WtOut, scr, it - I_IN, lane, false);
            else p0_transpose_item(w_q, DM, DM, WtQ, scr, it - I_IN - I_SQ, lane, false);
        }
        if (!(dbg_flags & 8))
        for (int m = gw; m < T; m += NGW) rms_row_to_bf16(x + (size_t)m * DM, attn_g, XN + (size_t)m * DM, lane);
        cvt_bf16_stream(subkeys, SK, (size_t)PEH * 2 * PNK * 128 / 8, gtid, nthr);
    }
    SEAM(0);
    if (IN(1)) REPS(1) {
        pg8::Gemm g{XN, WtIn, T, INC, DM}; pg8::StaticOrder S; S.init(T, INC, G, bx, WGM_P1);
        pg8::EpiProj E{Qb, qg, kg};
        pg8::gemm_phase<pg8::EpiProj, pg8::StaticOrder, true, true>(lds, g, S, E);
    }
    SEAM(1);
    if (IN(2)) REPS(2) {
        float a = lq1[lane] * lk1[lane], b2 = lq2[lane] * lk2[lane];
        a = wave_sum(a); b2 = wave_sum(b2);
        const float lam = expf(a) - expf(b2) + 0.2f;
        const float mq = wave_max(fabsf(qg[lane])), mk = wave_max(fabsf(kg[lane]));
        const float M2 = 64.f * C2 * mq * mk;
        const bool mem_first = ((bx >> 3) & 1) != 0;
        if (mem_first) {
            int tl_ = threadIdx.x; asm volatile("" : "+v"(tl_)); const size_t gtid_l = (size_t)blockIdx.x * NTHREADS + tl_, nthr_l = (size_t)gridDim.x * NTHREADS;
            {
                const float sig = table_std16(peer_u, (LAS float*)(lds + MISC_OFF + 64), tl_); const float step = 0.335f * sig;
                if (blockIdx.x == 0 && tl_ == 0) ((float*)(ws + WS_RSTD))[T] = step;
                cvt_i4_slices(peer_u, U8, 1.0f / step, gtid_l, nthr_l); }
            {
                const float sig = table_std16(peer_v, (LAS float*)(lds + MISC_OFF + 64), tl_); const float step = 0.335f * sig;
                if (blockIdx.x == 0 && tl_ == 0) ((float*)(ws + WS_RSTD))[T + 1] = step;
                cvt_i4_slices(peer_v, V8, 1.0f / step, gtid_l, nthr_l); }
            if (!(dbg_flags & 1))
            for (size_t it = gtid_l; it < (size_t)(T / 16) * 128; it += nthr_l) {
                const int cg8 = (int)(it & 127), chunk = (int)(it >> 7), t0 = chunk * 16, col = cg8 * 8;
                f32x4 w0a = *(const f32x4*)(conv_w + col), w0b = *(const f32x4*)(conv_w + col + 4), w1a = *(const f32x4*)(conv_w + 1024 + col), w1b = *(const f32x4*)(conv_w + 1024 + col + 4),
                      w2a = *(const f32x4*)(conv_w + 2048 + col), w2b = *(const f32x4*)(conv_w + 2048 + col + 4);
                float u1[8], u2[8];
#pragma unroll
                for (int i = 0; i < 8; ++i) { u1[i] = 0.f; u2[i] = 0.f; }
                if ((t0 % SEQ) != 0) {
                    const v4u c1 = *(const v4u*)(CC + (size_t)(t0 - 1) * 1024 + col), x1v = *(const v4u*)(CX + (size_t)(t0 - 1) * 1024 + col), c2 = *(const v4u*)(CC + (size_t)(t0 - 2) * 1024 + col), x2v = *(const v4u*)(CX + (size_t)(t0 - 2) * 1024 + col);
                    u1[0] = bflo(c1.x) * bflo(x1v.x); u1[1] = bfhi(c1.x) * bfhi(x1v.x); u1[2] = bflo(c1.y) * bflo(x1v.y); u1[3] = bfhi(c1.y) * bfhi(x1v.y); u1[4] = bflo(c1.z) * bflo(x1v.z); u1[5] = bfhi(c1.z) * bfhi(x1v.z); u1[6] = bflo(c1.w) * bflo(x1v.w); u1[7] = bfhi(c1.w) * bfhi(x1v.w);
                    u2[0] = bflo(c2.x) * bflo(x2v.x); u2[1] = bfhi(c2.x) * bfhi(x2v.x); u2[2] = bflo(c2.y) * bflo(x2v.y); u2[3] = bfhi(c2.y) * bfhi(x2v.y); u2[4] = bflo(c2.z) * bflo(x2v.z); u2[5] = bfhi(c2.z) * bfhi(x2v.z); u2[6] = bflo(c2.w) * bflo(x2v.w); u2[7] = bfhi(c2.w) * bfhi(x2v.w);
                }
                const float w0[8] = {w0a.x, w0a.y, w0a.z, w0a.w, w0b.x, w0b.y, w0b.z, w0b.w}, w1[8] = {w1a.x, w1a.y, w1a.z, w1a.w, w1b.x, w1b.y, w1b.z, w1b.w}, w2[8] = {w2a.x, w2a.y, w2a.z, w2a.w, w2b.x, w2b.y, w2b.z, w2b.w};
#pragma unroll 4
                for (int j = 0; j < 16; ++j) { const size_t ro = (size_t)(t0 + j) * 1024 + col;
                    const v4u bv = *(const v4u*)(CB + ro), cv = *(const v4u*)(CC + ro), xv = *(const v4u*)(CX + ro);
                    float u0[8], bb[8], y[8];
                    u0[0] = bflo(cv.x) * bflo(xv.x); u0[1] = bfhi(cv.x) * bfhi(xv.x); u0[2] = bflo(cv.y) * bflo(xv.y); u0[3] = bfhi(cv.y) * bfhi(xv.y); u0[4] = bflo(cv.z) * bflo(xv.z); u0[5] = bfhi(cv.z) * bfhi(xv.z); u0[6] = bflo(cv.w) * bflo(xv.w); u0[7] = bfhi(cv.w) * bfhi(xv.w);
                    bb[0] = bflo(bv.x); bb[1] = bfhi(bv.x); bb[2] = bflo(bv.y); bb[3] = bfhi(bv.y); bb[4] = bflo(bv.z); bb[5] = bfhi(bv.z); bb[6] = bflo(bv.w); bb[7] = bfhi(bv.w);
#pragma unroll
                    for (int i = 0; i < 8; ++i) { y[i] = bb[i] * (u2[i] * w0[i] + u1[i] * w1[i] + u0[i] * w2[i]); u2[i] = u1[i]; u1[i] = u0[i]; }
                    v4u o; o.x = pk2(y[0], y[1]); o.y = pk2(y[2], y[3]); o.z = pk2(y[4], y[5]); o.w = pk2(y[6], y[7]);
                    *(v4u*)(MIX + (size_t)(t0 + j) * 2048 + 1024 + col) = o; }
            }
        }
        {
#if DBG_NAIVE_ATTN
            for (int r = gw; r < NB * NH * SEQ; r += NGW) naive_attn_row(r >> 14, (r >> 11) & 7, r & 2047, Qb, Kb, Vb, MIX, subg, lam, (LAS float*)(lds + wave * 16384), lane);
            if (0)
#endif
            if (!(dbg_flags & 2))
            for (int v = vcu; v < NB * NH * 4; v += G) {
                const int bh = v >> 2, s = v & 3, b = bh >> 3, h = bh & 7;
#pragma unroll 1
                for (int i = 0; i < 4; ++i) { const int qblk = (i == 0) ? s : (i == 1) ? 7 - s : (i == 2) ? 8 + s : 15 - s;
                    att::attn_unit<0>(b, h, qblk, Qb, Kb, Vb, MIX, subg, lam, M2, (LAS char*)lds); }
            }
        }
        { int t_ = threadIdx.x; asm volatile("" : "+v"(t_)); tid = t_; lane = t_ & 63; gtid = (size_t)bx * NTHREADS + t_; }
        if (!mem_first) {
            int tl_ = threadIdx.x; asm volatile("" : "+v"(tl_)); const size_t gtid_l = (size_t)blockIdx.x * NTHREADS + tl_, nthr_l = (size_t)gridDim.x * NTHREADS;
            {
                const float sig = table_std16(peer_u, (LAS float*)(lds + MISC_OFF + 64), tl_); const float step = 0.335f * sig;
                if (blockIdx.x == 0 && tl_ == 0) ((float*)(ws + WS_RSTD))[T] = step;
                cvt_i4_slices(peer_u, U8, 1.0f / step, gtid_l, nthr_l); }
            {
                const float sig = table_std16(peer_v, (LAS float*)(lds + MISC_OFF + 64), tl_); const float step = 0.335f * sig;
                if (blockIdx.x == 0 && tl_ == 0) ((float*)(ws + WS_RSTD))[T + 1] = step;
                cvt_i4_slices(peer_v, V8, 1.0f / step, gtid_l, nthr_l); }
            if (!(dbg_flags & 1))
            for (size_t it = gtid_l; it < (size_t)(T / 16) * 128; it += nthr_l) {
                const int cg8 = (int)(it & 127), chunk = (int)(it >> 7), t0 = chunk * 16, col = cg8 * 8;
                f32x4 w0a = *(const f32x4*)(conv_w + col), w0b = *(const f32x4*)(conv_w + col + 4), w1a = *(const f32x4*)(conv_w + 1024 + col), w1b = *(const f32x4*)(conv_w + 1024 + col + 4),
                      w2a = *(const f32x4*)(conv_w + 2048 + col), w2b = *(const f32x4*)(conv_w + 2048 + col + 4);
                float u1[8], u2[8];
#pragma unroll
                for (int i = 0; i < 8; ++i) { u1[i] = 0.f; u2[i] = 0.f; }
                if ((t0 % SEQ) != 0) {
                    const v4u c1 = *(const v4u*)(CC + (size_t)(t0 - 1) * 1024 + col), x1v = *(const v4u*)(CX + (size_t)(t0 - 1) * 1024 + col), c2 = *(const v4u*)(CC + (size_t)(t0 - 2) * 1024 + col), x2v = *(const v4u*)(CX + (size_t)(t0 - 2) * 1024 + col);
                    u1[0] = bflo(c1.x) * bflo(x1v.x); u1[1] = bfhi(c1.x) * bfhi(x1v.x); u1[2] = bflo(c1.y) * bflo(x1v.y); u1[3] = bfhi(c1.y) * bfhi(x1v.y); u1[4] = bflo(c1.z) * bflo(x1v.z); u1[5] = bfhi(c1.z) * bfhi(x1v.z); u1[6] = bflo(c1.w) * bflo(x1v.w); u1[7] = bfhi(c1.w) * bfhi(x1v.w);
                    u2[0] = bflo(c2.x) * bflo(x2v.x); u2[1] = bfhi(c2.x) * bfhi(x2v.x); u2[2] = bflo(c2.y) * bflo(x2v.y); u2[3] = bfhi(c2.y) * bfhi(x2v.y); u2[4] = bflo(c2.z) * bflo(x2v.z); u2[5] = bfhi(c2.z) * bfhi(x2v.z); u2[6] = bflo(c2.w) * bflo(x2v.w); u2[7] = bfhi(c2.w) * bfhi(x2v.w);
                }
                const float w0[8] = {w0a.x, w0a.y, w0a.z, w0a.w, w0b.x, w0b.y, w0b.z, w0b.w}, w1[8] = {w1a.x, w1a.y, w1a.z, w1a.w, w1b.x, w1b.y, w1b.z, w1b.w}, w2[8] = {w2a.x, w2a.y, w2a.z, w2a.w, w2b.x, w2b.y, w2b.z, w2b.w};
#pragma unroll 4
                for (int j = 0; j < 16; ++j) { const size_t ro = (size_t)(t0 + j) * 1024 + col;
                    const v4u bv = *(const v4u*)(CB + ro), cv = *(const v4u*)(CC + ro), xv = *(const v4u*)(CX + ro);
                    float u0[8], bb[8], y[8];
                    u0[0] = bflo(cv.x) * bflo(xv.x); u0[1] = bfhi(cv.x) * bfhi(xv.x); u0[2] = bflo(cv.y) * bflo(xv.y); u0[3] = bfhi(cv.y) * bfhi(xv.y); u0[4] = bflo(cv.z) * bflo(xv.z); u0[5] = bfhi(cv.z) * bfhi(xv.z); u0[6] = bflo(cv.w) * bflo(xv.w); u0[7] = bfhi(cv.w) * bfhi(xv.w);
                    bb[0] = bflo(bv.x); bb[1] = bfhi(bv.x); bb[2] = bflo(bv.y); bb[3] = bfhi(bv.y); bb[4] = bflo(bv.z); bb[5] = bfhi(bv.z); bb[6] = bflo(bv.w); bb[7] = bfhi(bv.w);
#pragma unroll
                    for (int i = 0; i < 8; ++i) { y[i] = bb[i] * (u2[i] * w0[i] + u1[i] * w1[i] + u0[i] * w2[i]); u2[i] = u1[i]; u1[i] = u0[i]; }
                    v4u o; o.x = pk2(y[0], y[1]); o.y = pk2(y[2], y[3]); o.z = pk2(y[4], y[5]); o.w = pk2(y[6], y[7]);
                    *(v4u*)(MIX + (size_t)(t0 + j) * 2048 + 1024 + col) = o; }
            }
        }
    }
    SEAM(2);
    if (IN(3)) REPS(3) {
        pg8::Gemm g{MIX, WtOut, T, DM, DM}; pg8::StaticOrder S; S.init(T, DM, G, bx, WGM_P3);
        pg8::EpiX1 E{x, out, A2, ffn_g, SSQ, ws + WS_H8};
        pg8::gemm_phase<pg8::EpiX1, pg8::StaticOrder, true, true>(lds, g, S, E);
    }
    SEAM(3);
    if (IN(4)) REPS(4) {
        pg8::Gemm g{A2, WtQ, T, DM, DM}; pg8::StaticOrder S; S.init(T, DM, G, bx, WGM_P3);
        pg8::EpiBf16<0> E{QP, DM, nullptr, 0, 0, 1.f};
        pg8::gemm_phase<pg8::EpiBf16<0>, pg8::StaticOrder, true, true>(lds, g, S, E);
    }
    SEAM(4);
    if (IN(5)) REPS(5) {
        if (tid < 64) {
            int n = tid, i = 0;
#pragma unroll 1
            for (; i < 16; ++i) { const int len = 16 / (i + 1); if (n < len) break; n -= len; }
            ((LAS unsigned char*)(lds + P5_TAB_OFF))[tid] = (unsigned char)(i < 16 ? ((i << 4) | n) : 0);
        }
        int cur_h = -1;
        for (int it = vcu; it < (T / 128) * PEH; it += G) { const int h = it & 7;
            if (h != cur_h) {
                __syncthreads();
                for (int i = tid; i < 4096; i += NTHREADS) { const int ch = i & 15, key = (i >> 4) & 127, c = i >> 11;
                    *(LAS v4u*)(lds + c * 32768 + ch * 2048 + key * 16) = *(const v4u*)(SK + (size_t)((h * 2 + c) * 128 + key) * 128 + ch * 8); }
                cur_h = h; __syncthreads(); }
            peer_topk_item(it >> 3, h, QP, SSQ, EIDX, EGATE, RSTD, (LAS char*)lds); }
    }
    SEAM(5);
    if (IN(6)) {
        float* PART = (float*)(ws + WS_PART);
        const int tstride = (G >> 3) * NWAVES, nper = (T + tstride - 1) / tstride;
        peer_u_stage(nper, (bx >> 3) * NWAVES + wave, tstride, bx & 7, ws + WS_H8, U8, EIDX, PART, lane);
    }
    SEAM(6);
    if (IN(7)) {
        const float* PART = (const float*)(ws + WS_PART); unsigned* ACTQ = (unsigned*)(ws + WS_ACT); float* ASC = (float*)(ws + WS_ACT + 4 * MiB);
        const float ustep = RSTD[T] * (1.0f / H8_SCALE), vstep = RSTD[T + 1];
        for (int tp = gw; tp < T / 2; tp += NGW) { const int t = 2 * tp + (lane >> 5), k4 = 4 * (lane & 31);
            f32x4 z = (f32x4){0.f, 0.f, 0.f, 0.f};
#pragma unroll
            for (int s = 0; s < 8; ++s) z += *(const f32x4*)(PART + ((size_t)s * T + t) * 128 + k4);
            z *= RSTD[t] * ustep;
            const f32x4 gt = *(const f32x4*)(EGATE + (size_t)t * 128 + k4);
            f32x4 a; float am = 0.f;
#pragma unroll
            for (int i = 0; i < 4; ++i) { a[i] = 0.5f * z[i] * (1.0f + erff(z[i] * 0.70710678118654752f)) * gt[i]; am = fmaxf(am, fabsf(a[i])); }
            am = fmaxf(am, DPPF(am, 0xB1)); am = fmaxf(am, DPPF(am, 0x4E)); am = fmaxf(am, DPPF(am, 0x124)); am = fmaxf(am, DPPF(am, 0x128));
            { const auto r_ = __builtin_amdgcn_permlane16_swap(__float_as_uint(am), __float_as_uint(am), false, false); am = fmaxf(__uint_as_float(r_[0]), __uint_as_float(r_[1])); }
            const float asc = am > 0.f ? am * (1.0f / 127.0f) : 1.0f, inv = 1.0f / asc; unsigned w = 0u;
#pragma unroll
            for (int i = 0; i < 4; ++i) { const int q = (int)__builtin_rintf(a[i] * inv); w |= ((unsigned)q & 0xffu) << (8 * i); }
            ACTQ[(size_t)t * 32 + (lane & 31)] = w;
            if ((lane & 31) == 0) ASC[t] = asc * vstep; }
    }
    SEAM(7);
    if (IN(8)) {
        const unsigned* ACTQ = (const unsigned*)(ws + WS_ACT); const float* ASC = (const float*)(ws + WS_ACT + 4 * MiB);
        const int tstride = (G >> 3) * NWAVES, nper = (T + tstride - 1) / tstride;
        peer_v_stage<0>(nper, (bx >> 3) * NWAVES + wave, tstride, bx & 7, V8, EIDX, ACTQ, ASC, A2, ffn_g, out, lane);
    }
#undef IN
#undef SEAM
}


#ifdef DBG_ABL
__global__ void __launch_bounds__(NTHREADS, 2) attn_probe(Args args) {
    extern __shared__ __attribute__((aligned(16))) unsigned char lds_raw[];
    LAS unsigned char* lds = (LAS unsigned char*)lds_raw;
    const int tid = threadIdx.x, lane = tid & 63; const int G = gridDim.x, bx = blockIdx.x;
    const int vcu = (G % 8 == 0) ? (bx % 8) * (G / 8) + bx / 8 : bx;
    unsigned char* ws = args.ws;
    const float* qg = args.in[3]; const float* kg = args.in[4]; const float* lq1 = args.in[5]; const float* lk1 = args.in[6]; const float* lq2 = args.in[7]; const float* lk2 = args.in[8]; const float* subg = args.in[9];
    bf16* Qb = (bf16*)(ws + WS_Q); bf16* Kb = (bf16*)(ws + WS_K); bf16* Vb = (bf16*)(ws + WS_V); bf16* MIX2 = (bf16*)(ws + 448 * MiB);
    float a = lq1[lane] * lk1[lane], b2 = lq2[lane] * lk2[lane]; a = wave_sum(a); b2 = wave_sum(b2);
    const float lam = expf(a) - expf(b2) + 0.2f; const float mq = wave_max(fabsf(qg[lane])), mk = wave_max(fabsf(kg[lane])); const float M2 = 64.f * C2 * mq * mk;
    for (int v = vcu; v < NB * NH * 4; v += G) { const int bh = v >> 2, s = v & 3, b = bh >> 3, h = bh & 7;
#pragma unroll 1
        for (int i = 0; i < 4; ++i) { const int qblk = (i == 0) ? s : (i == 1) ? 7 - s : (i == 2) ? 8 + s : 15 - s;
            att::attn_unit<DBG_ABL>(b, h, qblk, Qb, Kb, Vb, MIX2, subg, lam, M2, (LAS char*)lds); } }
}
#endif


#ifdef DBG_ABLV
__global__ void __launch_bounds__(NTHREADS, 2) pv_probe(Args args) {
    const int tid = threadIdx.x, lane = tid & 63, wave = __builtin_amdgcn_readfirstlane(tid >> 6); const int G = gridDim.x, bx = blockIdx.x;
    unsigned char* ws = args.ws;
    const unsigned* ACTQ = (const unsigned*)(ws + WS_ACT); const float* ASC = (const float*)(ws + WS_ACT + 4 * MiB);
    const int tstride = (G >> 3) * NWAVES, nper = (T + tstride - 1) / tstride;
    peer_v_stage<DBG_ABLV>(nper, (bx >> 3) * NWAVES + wave, tstride, bx & 7, ws + WS_VT, (const int*)(ws + WS_EIDX), ACTQ, ASC, (const bf16*)(ws + WS_CB), args.in[12], (float*)(ws + WS_PART), lane);
}
#endif

extern "C" void kernel_launch(void* const* d_in, const int* in_sizes, int n_in, void* d_out, int out_size, void* d_ws, size_t ws_size, hipStream_t stream) {
    static int grid = 0;
    if (grid == 0) {
        if (n_in != 17 || out_size != T * DM || ws_size < WS_END) { fprintf(stderr, "kernel_launch: unexpected shapes (n_in %d out %d ws %zu)\n", n_in, out_size, ws_size); grid = -1; return; }
        int dev = 0, cus = 0, per_cu = 0;
        if (hipGetDevice(&dev) != hipSuccess || hipDeviceGetAttribute(&cus, hipDeviceAttributeMultiprocessorCount, dev) != hipSuccess) { grid = -1; return; }
        if (hipFuncSetAttribute((const void*)mk_fwd, hipFuncAttributeMaxDynamicSharedMemorySize, LDS_BYTES) != hipSuccess) { fprintf(stderr, "kernel_launch: hipFuncSetAttribute failed\n"); grid = -1; return; }
        if (hipOccupancyMaxActiveBlocksPerMultiprocessor(&per_cu, (const void*)mk_fwd, NTHREADS, LDS_BYTES) != hipSuccess || per_cu < 1) { fprintf(stderr, "kernel_launch: occupancy query says %d blocks per CU\n", per_cu); (void)hipGetLastError(); grid = -1; return; }
        grid = cus;
    }
    if (grid < 0) return;
    if (hipMemsetAsync((char*)d_ws + WS_CTL, 0, CTL_ZERO_BYTES, stream) != hipSuccess) { fprintf(stderr, "kernel_launch: memset failed\n"); return; }
    Args a{};
    for (int i = 0; i < 17; ++i) a.in[i] = (const float*)d_in[i];
    a.out = (float*)d_out; a.ws = (unsigned char*)d_ws;
#if MK_N_LAUNCHES == 1
    a.ph_lo = 0; a.ph_hi = NPHASE;
    void* kargs[] = {&a};
    hipError_t e = hipLaunchCooperativeKernel((const void*)mk_fwd, dim3(grid), dim3(NTHREADS), kargs, LDS_BYTES, stream);
    if (e != hipSuccess) fprintf(stderr, "kernel_launch: cooperative launch failed: %s (grid %d)\n", hipGetErrorString(e), grid);
#else
#ifndef DBG_DUPL
#define DBG_DUPL -1
#endif
#ifndef DBG_DUPFLAGS
#define DBG_DUPFLAGS 0
#endif
    for (int p = 0; p < NPHASE; ++p) { a.ph_lo = p; for (int r = 0; r < (p == DBG_DUPL ? 2 : 1); ++r) { a.ph_hi = (p + 1) | ((r == 1 ? DBG_DUPFLAGS : 0) << 8); hipLaunchKernelGGL(mk_fwd, dim3(grid), dim3(NTHREADS), LDS_BYTES, stream, a); }
#ifdef DBG_ABLV
        if (p == 8) hipLaunchKernelGGL(pv_probe, dim3(grid), dim3(NTHREADS), 0, stream, a);
#endif
#ifdef DBG_ABL
        if (p == 2 && ws_size >= 512 * MiB) { static bool once = false; if (!once) { once = true; (void)hipFuncSetAttribute((const void*)attn_probe, hipFuncAttributeMaxDynamicSharedMemorySize, LDS_BYTES); } hipLaunchKernelGGL(attn_probe, dim3(grid), dim3(NTHREADS), LDS_BYTES, stream, a); }
#endif
    }
#endif
}
```

```cpp
#include <hip/hip_runtime.h>
#include <hip/hip_cooperative_groups.h>
#include <cstdio>
#include <cstdint>
#include <cmath>
namespace cg = cooperative_groups;
namespace pg8 {
#define PG8_LAS __attribute__((address_space(3)))
typedef unsigned short bf16_t;
typedef short bf16x8 __attribute__((ext_vector_type(8)));
typedef float f32x4 __attribute__((ext_vector_type(4)));
typedef unsigned u32x4 __attribute__((ext_vector_type(4)));
constexpr int BM = 256, BK = 64, HALF = 128, HTB = HALF * BK * 2  , STAGE_BYTES = 8 * HTB, NXCD = 8, WGM = 8;

__host__ __device__ __forceinline__ int lds_byte(int r, int c) { const int st = (r >> 4) * 2 + (c >> 5), rr = r & 15, cc = c & 31, ob = rr * 64 + cc * 2; return st * 1024 + (ob ^ (((ob >> 9) & 1) << 5)); }
__host__ __device__ __forceinline__ void stage_rc(int b, int& R, int& C) { const int st = b / 1024, sb = b % 1024, swz = sb ^ (((sb >> 9) & 1) << 5); R = (st >> 1) * 16 + swz / 64; C = (st & 1) * 32 + (swz % 64) / 2; }
__host__ __device__ __forceinline__ int perm32(int rho) { const int n = rho >> 4, i = rho & 15; return 8 * (i >> 2) + 4 * n + (i & 3); }

struct Unit { int pm, pn; };
struct Gemm { const bf16_t* A; const bf16_t* Bt; int M, N, K; };

struct StaticOrder {
    int nM, nN, nwg, G, c, wgm;
    __host__ __device__ void init(int M, int N, int G_, int c_, int wgm_ = WGM) { nM = M / BM; nN = N / BM; nwg = nM * nN; G = G_; c = c_; wgm = wgm_; }
    __host__ __device__ bool next(int i, Unit& u) const {
        const long L = (long)i * G + c; if (L >= nwg) return false;
        int wgid = (int)L; { const int q = nwg / NXCD, r = nwg % NXCD, xcd = wgid % NXCD, off = wgid / NXCD; wgid = (xcd < r ? xcd * (q + 1) : r * (q + 1) + (xcd - r) * q) + off; }
        const int nig = wgm * nN, gid = wgid / nig, fm = gid * wgm, gsz = (nM - fm) < wgm ? (nM - fm) : wgm;
        u.pm = fm + ((wgid % nig) % gsz); u.pn = (wgid % nig) / gsz; return true;
    }
    __device__ __forceinline__ void a_ready(const Unit&) const {}
    __device__ __forceinline__ void done(const Unit&) const {}
};

__device__ __forceinline__ unsigned cvt_pk_bf16(float lo, float hi) { unsigned r; asm volatile("v_cvt_pk_bf16_f32 %0, %1, %2" : "=v"(r) : "v"(lo), "v"(hi)); return r; }
typedef float f32x2 __attribute__((ext_vector_type(2)));
__device__ __forceinline__ f32x2 gelu_pk(f32x2 v) {
    const f32x2 av = __builtin_elementwise_abs(v), d = av * 0.2316418882f + 1.0f;
    f32x2 t; t.x = __builtin_amdgcn_rcpf(d.x); t.y = __builtin_amdgcn_rcpf(d.y);
    f32x2 q = t * 0.5307027145f + (-0.7265760135f); q = q * t + 0.7107068705f; q = q * t + (-0.142248368f); q = q * t + 0.127414796f; q = q * t;
    const f32x2 s = (v * v) * (-0.72134752044f);
    f32x2 e; e.x = __builtin_amdgcn_exp2f(s.x); e.y = __builtin_amdgcn_exp2f(s.y);
    const f32x2 m = v * (q * e), r = v - m;
    f32x2 o; o.x = v.x < 0.f ? m.x : r.x; o.y = v.y < 0.f ? m.y : r.y; return o;
}

template <int ACT  > struct EpiBf16 {
    static constexpr bool PERM = true, AFTER_DRAIN = false; static_assert(ACT == 0 || ACT == 1, "EpiBf16: ACT is 0 (none) or 1 (gelu_pk)");
    bf16_t* O; int ldc; const float* bias; int split_cols; size_t split_stride; float scale0;
    __device__ __forceinline__ void operator()(const f32x4 (&acc)[2][2][4][2], const Unit& u, int wr, int wc, int fr, int fq) const {
        const int row0 = u.pm * BM + wr * 64 + fr; int colt = u.pn * BM; bf16_t* base = O;
        float sc = 1.f; if (split_cols) { const int t = colt / split_cols; base += (size_t)t * split_stride; colt -= t * split_cols; if (t == 0) sc = scale0; }
        const int col0 = colt + wc * 32 + 8 * fq, bcol0 = u.pn * BM + wc * 32 + 8 * fq;
        f32x4 bv[2][2];
#pragma unroll
        for (int bj = 0; bj < 2; ++bj)
#pragma unroll
            for (int n = 0; n < 2; ++n) bv[bj][n] = bias ? *(const f32x4*)(bias + bcol0 + bj * HALF + 4 * n) : (f32x4){0.f, 0.f, 0.f, 0.f};
#pragma unroll
        for (int ai = 0; ai < 2; ++ai)
#pragma unroll
            for (int m = 0; m < 4; ++m) { bf16_t* rowp = base + (size_t)(row0 + ai * HALF + m * 16) * ldc + col0;
#pragma unroll
                for (int bj = 0; bj < 2; ++bj) { f32x4 v0 = acc[ai][bj][m][0] + bv[bj][0], v1 = acc[ai][bj][m][1] + bv[bj][1];
                    if (ACT == 1) { f32x2 a = gelu_pk((f32x2){v0[0], v0[1]}), b = gelu_pk((f32x2){v0[2], v0[3]}), c = gelu_pk((f32x2){v1[0], v1[1]}), d = gelu_pk((f32x2){v1[2], v1[3]});
                        v0 = (f32x4){a.x, a.y, b.x, b.y}; v1 = (f32x4){c.x, c.y, d.x, d.y}; }
                    v0 = v0 * sc; v1 = v1 * sc; u32x4 w; w.x = cvt_pk_bf16(v0[0], v0[1]); w.y = cvt_pk_bf16(v0[2], v0[3]); w.z = cvt_pk_bf16(v1[0], v1[1]); w.w = cvt_pk_bf16(v1[2], v1[3]);
                    *(u32x4*)(rowp + bj * HALF) = w; } }
    }
};
template <class Epi, class Sched, bool ALIGN_EPI = false, bool SP2 = false>
__device__ __forceinline__ void gemm_phase(PG8_LAS unsigned char* lds, const Gemm g, const Sched& S, const Epi& E) {
    const int tid = threadIdx.x, wid = __builtin_amdgcn_readfirstlane(tid >> 6), lane = tid & 63, wr = wid >> 2, wc = wid & 3, fr = lane & 15, fq = lane >> 4;
    const int K = g.K, nt = K / BK;
    unsigned voffA[2], voffB[2];
#pragma unroll
    for (int i = 0; i < 2; ++i) { int R, C; stage_rc(tid * 16 + i * 8192, R, C); const int Rb = Epi::PERM ? ((R & ~31) + perm32(R & 31)) : R;
        voffA[i] = (unsigned)(R * K + C) * 2u; voffB[i] = (unsigned)(Rb * K + C) * 2u; }
    const size_t kstep = (size_t)(BK * 2);
    const size_t hstep = (size_t)HALF * K * 2;
    const size_t tstep = 2 * hstep;
    const unsigned ldsw = (unsigned)wid * 1024u;
    const int aoff = lds_byte(wr * 64 + fr, fq * 8), boff = lds_byte(wc * 32 + fr, fq * 8);
#define PG8_SA(b, h) (((b) * 2 + (h)) * HTB)
#define PG8_SB(b, h) ((4 + (b) * 2 + (h)) * HTB)
#define PG8_STAGE(bufoff, gbase, voff) do { _Pragma("unroll") for (int _i = 0; _i < 2; ++_i) \
        __builtin_amdgcn_global_load_lds((const unsigned*)((const char*)(gbase) + (voff)[_i]), (PG8_LAS unsigned*)(lds + (bufoff) + ldsw + _i * 8192), 16, 0, 0); } while (0)
#define PG8_LDA(dst, b, h) do { _Pragma("unroll") for (int m = 0; m < 4; ++m) _Pragma("unroll") for (int k = 0; k < 2; ++k) dst[m][k] = *(const PG8_LAS bf16x8*)(lds + PG8_SA(b, h) + aoff + m * 2048 + k * 1024); } while (0)
#define PG8_LDB(dst, b, h) do { _Pragma("unroll") for (int n = 0; n < 2; ++n) _Pragma("unroll") for (int k = 0; k < 2; ++k) dst[n][k] = *(const PG8_LAS bf16x8*)(lds + PG8_SB(b, h) + boff + n * 2048 + k * 1024); } while (0)
#define PG8_MMA(ai, bj, At, Bt) do { __builtin_amdgcn_s_setprio(1); _Pragma("unroll") for (int m = 0; m < 4; ++m) _Pragma("unroll") for (int n = 0; n < 2; ++n) _Pragma("unroll") for (int k = 0; k < 2; ++k) \
        acc[ai][bj][m][n] = __builtin_amdgcn_mfma_f32_16x16x32_bf16(Bt[n][k], At[m][k], acc[ai][bj][m][n], 0, 0, 0); __builtin_amdgcn_s_setprio(0); } while (0)
#define PG8_WAIT_V(n) asm volatile("s_waitcnt vmcnt(" #n ")" ::: "memory")
#define PG8_WAIT_L(n) asm volatile("s_waitcnt lgkmcnt(" #n ")" ::: "memory")
#define PG8_BAR __builtin_amdgcn_s_barrier()
#define PG8_SCHED __builtin_amdgcn_sched_barrier(0)
    Unit cur, nxt; int ui = 0;
    if (!S.next(0, cur)) return;
    f32x4 acc[2][2][4][2];
#pragma unroll
    for (int a = 0; a < 2; ++a)
#pragma unroll
        for (int b = 0; b < 2; ++b)
#pragma unroll
            for (int m = 0; m < 4; ++m)
#pragma unroll
                for (int n = 0; n < 2; ++n) acc[a][b][m][n] = (f32x4){0.f, 0.f, 0.f, 0.f};
    bf16x8 At[4][2], B0[2][2], B1[2][2];
    const char* cA = (const char*)g.A + (size_t)cur.pm * tstep; const char* cB = (const char*)g.Bt + (size_t)cur.pn * tstep;
    S.a_ready(cur);
    if constexpr (SP2) {
        PG8_STAGE(PG8_SB(0, 0), cB, voffB); PG8_STAGE(PG8_SB(0, 1), cB + hstep, voffB); PG8_STAGE(PG8_SA(0, 0), cA, voffA); PG8_STAGE(PG8_SA(0, 1), cA + hstep, voffA);
        if (wr == 1) PG8_BAR;
        PG8_WAIT_V(2); PG8_BAR;
        PG8_STAGE(PG8_SB(1, 0), cB + kstep, voffB); PG8_STAGE(PG8_SA(1, 0), cA + kstep, voffA); PG8_STAGE(PG8_SB(1, 1), cB + hstep + kstep, voffB);
        PG8_WAIT_V(6); PG8_BAR;
    } else {
        PG8_STAGE(PG8_SB(0, 0), cB, voffB); PG8_STAGE(PG8_SA(0, 0), cA, voffA); PG8_STAGE(PG8_SB(0, 1), cB + hstep, voffB); PG8_STAGE(PG8_SA(0, 1), cA + hstep, voffA);
        if (wr == 1) PG8_BAR;
        PG8_WAIT_V(4); PG8_BAR;
        PG8_STAGE(PG8_SB(1, 0), cB + kstep, voffB); PG8_STAGE(PG8_SA(1, 0), cA + kstep, voffA); PG8_STAGE(PG8_SB(1, 1), cB + hstep + kstep, voffB);
        PG8_WAIT_V(6); PG8_BAR;
    }
    for (;;) {
        const bool has_next = S.next(ui + 1, nxt);
        const char* nA = has_next ? (const char*)g.A + (size_t)nxt.pm * tstep : cA; const char* nB = has_next ? (const char*)g.Bt + (size_t)nxt.pn * tstep : cB;
        for (int t = 0; t < nt; t += 2) {
            const bool last = (t == nt - 2);
            const char* a1 = cA + (size_t)(t + 1) * kstep;
            const char* a2 = last ? nA : cA + (size_t)(t + 2) * kstep; const char* b2 = last ? nB : cB + (size_t)(t + 2) * kstep;
            const char* a3 = a2 + kstep; const char* b3 = b2 + kstep;
            if (last && has_next) S.a_ready(nxt);
            if constexpr (SP2) {
            PG8_LDB(B0, 0, 0); PG8_LDB(B1, 0, 1); PG8_SCHED; PG8_LDA(At, 0, 0); PG8_STAGE(PG8_SA(1, 1), a1 + hstep, voffA);
            PG8_WAIT_V(8); PG8_WAIT_L(0); PG8_BAR; PG8_MMA(0, 0, At, B0); PG8_MMA(0, 1, At, B1); PG8_BAR; PG8_SCHED;
            PG8_LDA(At, 0, 1); PG8_STAGE(PG8_SB(0, 0), b2, voffB); PG8_STAGE(PG8_SB(0, 1), b2 + hstep, voffB); PG8_STAGE(PG8_SA(0, 0), a2, voffA);
            PG8_WAIT_V(8); PG8_WAIT_L(0); PG8_BAR; PG8_MMA(1, 0, At, B0); PG8_MMA(1, 1, At, B1); PG8_BAR; PG8_SCHED;
            PG8_LDB(B0, 1, 0); PG8_LDB(B1, 1, 1); PG8_SCHED; PG8_LDA(At, 1, 0); PG8_STAGE(PG8_SA(0, 1), a2 + hstep, voffA);
            PG8_WAIT_V(8); PG8_WAIT_L(0); PG8_BAR; PG8_MMA(0, 0, At, B0); PG8_MMA(0, 1, At, B1); PG8_BAR; PG8_SCHED;
            PG8_LDA(At, 1, 1); PG8_STAGE(PG8_SB(1, 0), b3, voffB); PG8_STAGE(PG8_SB(1, 1), b3 + hstep, voffB); PG8_STAGE(PG8_SA(1, 0), a3, voffA);
            PG8_WAIT_V(8); PG8_WAIT_L(0); PG8_BAR; PG8_MMA(1, 0, At, B0); PG8_MMA(1, 1, At, B1); PG8_BAR; PG8_SCHED;
            } else {
            PG8_LDB(B0, 0, 0); PG8_SCHED; PG8_LDA(At, 0, 0); PG8_STAGE(PG8_SA(1, 1), a1 + hstep, voffA);
            PG8_WAIT_L(8); PG8_BAR; PG8_WAIT_L(0); PG8_MMA(0, 0, At, B0); PG8_BAR; PG8_SCHED;
            PG8_LDB(B1, 0, 1); PG8_STAGE(PG8_SB(0, 0), b2, voffB);
            PG8_BAR; PG8_WAIT_L(0); PG8_MMA(0, 1, At, B1); PG8_BAR;
            PG8_LDA(At, 0, 1); PG8_STAGE(PG8_SA(0, 0), a2, voffA);
            PG8_BAR; PG8_WAIT_L(0); PG8_MMA(1, 0, At, B0); PG8_BAR; PG8_SCHED;
            PG8_STAGE(PG8_SB(0, 1), b2 + hstep, voffB);
            PG8_WAIT_V(6); PG8_BAR; PG8_MMA(1, 1, At, B1); PG8_BAR;
            PG8_LDB(B0, 1, 0); PG8_SCHED; PG8_LDA(At, 1, 0); PG8_STAGE(PG8_SA(0, 1), a2 + hstep, voffA);
            PG8_WAIT_L(8); PG8_BAR; PG8_WAIT_L(0); PG8_MMA(0, 0, At, B0); PG8_BAR; PG8_SCHED;
            PG8_LDB(B1, 1, 1); PG8_STAGE(PG8_SB(1, 0), b3, voffB);
            PG8_BAR; PG8_WAIT_L(0); PG8_MMA(0, 1, At, B1); PG8_BAR;
            PG8_LDA(At, 1, 1); PG8_STAGE(PG8_SA(1, 0), a3, voffA);
            PG8_BAR; PG8_WAIT_L(0); PG8_MMA(1, 0, At, B0); PG8_BAR; PG8_SCHED;
            PG8_STAGE(PG8_SB(1, 1), b3 + hstep, voffB);
            PG8_WAIT_V(6); PG8_BAR; PG8_MMA(1, 1, At, B1); PG8_BAR;
            }
        }
        if constexpr (ALIGN_EPI) { if (wr == 0) PG8_BAR; }
        if constexpr (!Epi::AFTER_DRAIN) { E(acc, cur, wr, wc, fr, fq); S.done(cur); }
        if (!has_next) break;
#pragma unroll
        for (int a = 0; a < 2; ++a)
#pragma unroll
            for (int b = 0; b < 2; ++b)
#pragma unroll
                for (int m = 0; m < 4; ++m)
#pragma unroll
                    for (int n = 0; n < 2; ++n) acc[a][b][m][n] = (f32x4){0.f, 0.f, 0.f, 0.f};
        cur = nxt; cA = nA; cB = nB; ++ui;
        if constexpr (ALIGN_EPI) { if (wr == 1) PG8_BAR; }
    }
    PG8_WAIT_V(0);
    if constexpr (!ALIGN_EPI) { if (wr == 0) PG8_BAR; }
    PG8_BAR;
    if constexpr (Epi::AFTER_DRAIN) { E.fused(acc, cur, wr, wc, fr, fq, lds, wid, lane); S.done(cur); }
#undef PG8_SA
#undef PG8_SB
#undef PG8_STAGE
#undef PG8_LDA
#undef PG8_LDB
#undef PG8_MMA
#undef PG8_WAIT_V
#undef PG8_WAIT_L
#undef PG8_BAR
#undef PG8_SCHED
}
}
#define MK_N_LAUNCHES 1
#ifndef MK_N_LAUNCHES
#define MK_N_LAUNCHES 1
#endif
constexpr int DM = 2048, NB = 8, SEQ = 2048, T = NB * SEQ;
constexpr int AW = 1024, NH = 8, HD = 64, VD = 128, INC = 6144;
constexpr int PNK = 128, PTOPK = 16, PEH = 8, EPT = PEH * PTOPK;
constexpr float EPS = 1e-6f;
constexpr float C2 = 0.125f * 1.4426950408889634f;
constexpr int NPHASE = 9;
#ifndef WGM_P1
#define WGM_P1 16
#endif
#ifndef WGM_P3
#define WGM_P3 4
#endif
constexpr float U8_SCALE = 1024.f, V8_SCALE = 16.f, H8_SCALE = 16.f;
constexpr size_t MiB = 1u << 20;
constexpr size_t WS_WIN = 1 * MiB, WS_WOUT = 25 * MiB, WS_WQ = 33 * MiB, WS_SK = 41 * MiB, WS_SSQ = 42 * MiB, WS_EIDX = 44 * MiB, WS_EGATE = 52 * MiB, WS_RSTD = 60 * MiB;
constexpr size_t WS_XN = 64 * MiB;
constexpr size_t WS_Q = 128 * MiB, WS_K = 160 * MiB, WS_V = 192 * MiB;
constexpr size_t WS_CB = 224 * MiB, WS_CC = 256 * MiB, WS_CX = 288 * MiB;
constexpr size_t WS_UT = 320 * MiB, WS_VT = 384 * MiB, WS_END = 448 * MiB;
constexpr size_t WS_CTL = 0; constexpr int CW_BAR = 1024, CTL_ZERO_BYTES = 65536;
constexpr size_t WS_H8 = 288 * MiB;
constexpr size_t WS_PART = 64 * MiB, WS_ACT = 192 * MiB;
constexpr int MISC_OFF = 143360;
constexpr int LDS_BYTES = 147456;
constexpr int NWAVES = 8, NTHREADS = 512;

#define LAS __attribute__((address_space(3)))
typedef unsigned short bf16;
typedef unsigned v4u __attribute__((ext_vector_type(4)));
typedef unsigned v2u __attribute__((ext_vector_type(2)));
typedef float f32x4 __attribute__((ext_vector_type(4)));
typedef float f32x2 __attribute__((ext_vector_type(2)));
typedef float f32x16 __attribute__((ext_vector_type(16)));
typedef short bf16x8 __attribute__((ext_vector_type(8)));
typedef short s16x4 __attribute__((ext_vector_type(4)));
typedef __bf16 bf16x2_t __attribute__((ext_vector_type(2)));
#define LDS_WAIT() asm volatile("s_waitcnt lgkmcnt(0)" ::: "memory")
__device__ __forceinline__ unsigned pk2(float lo, float hi) { f32x2 v = {lo, hi}; bf16x2_t b = __builtin_convertvector(v, bf16x2_t); return __builtin_bit_cast(unsigned, b); }
__device__ __forceinline__ float bflo(unsigned u) { return __uint_as_float(u << 16); }
__device__ __forceinline__ float bfhi(unsigned u) { return __uint_as_float(u & 0xffff0000u); }
#define DPPF(v, ctrl) __uint_as_float((unsigned)__builtin_amdgcn_update_dpp(0, (int)__float_as_uint(v), (ctrl), 0xf, 0xf, false))
__device__ __forceinline__ float xor16_sum(float v) { const auto r = __builtin_amdgcn_permlane16_swap(__float_as_uint(v), __float_as_uint(v), false, false); return __uint_as_float(r[0]) + __uint_as_float(r[1]); }
__device__ __forceinline__ float xor32_sum(float v) { const auto r = __builtin_amdgcn_permlane32_swap(__float_as_uint(v), __float_as_uint(v), false, false); return __uint_as_float(r[0]) + __uint_as_float(r[1]); }
__device__ __forceinline__ float wave_sum(float v) {
    v += DPPF(v, 0xB1); v += DPPF(v, 0x4E); v += DPPF(v, 0x124); v += DPPF(v, 0x128);
    return xor32_sum(xor16_sum(v));
}
__device__ __forceinline__ float wave_max(float v) {
    v = fmaxf(v, DPPF(v, 0xB1)); v = fmaxf(v, DPPF(v, 0x4E)); v = fmaxf(v, DPPF(v, 0x124)); v = fmaxf(v, DPPF(v, 0x128));
    { const auto r = __builtin_amdgcn_permlane16_swap(__float_as_uint(v), __float_as_uint(v), false, false); v = fmaxf(__uint_as_float(r[0]), __uint_as_float(r[1])); }
    { const auto r = __builtin_amdgcn_permlane32_swap(__float_as_uint(v), __float_as_uint(v), false, false); v = fmaxf(__uint_as_float(r[0]), __uint_as_float(r[1])); }
    return v;
}

#define XB_TMO      128
#define XB_XCNT(j)  (256  + 64 * (j))
#define XB_XSUB(j)  (1280 + 64 * (j))
#define XB_XGEN(j)  (2304 + 64 * (j))
#define XB_TOP      3328
#define XB_TOPGEN   3392
#define XCD_BAR_WORDS 3456
#define XB_SPIN_CAP (1u << 18)

__device__ __forceinline__ unsigned xb_ld(unsigned* p)              { return __hip_atomic_load(p, __ATOMIC_RELAXED, __HIP_MEMORY_SCOPE_AGENT); }
__device__ __forceinline__ unsigned xb_add(unsigned* p, unsigned v) { return __hip_atomic_fetch_add(p, v, __ATOMIC_RELAXED, __HIP_MEMORY_SCOPE_AGENT); }
__device__ __forceinline__ unsigned xb_xcc_id() { return (unsigned)__builtin_amdgcn_s_getreg((3 << 11) | 20) & 0xFu; }
#define XB_SPIN(cond, bar) do { unsigned _sp = 0; while (cond) { __builtin_amdgcn_s_sleep(1); \
    if ((++_sp & 255u) == 0u) { if (xb_ld(&(bar)[XB_TMO])) break; if (_sp > XB_SPIN_CAP) { atomicAdd(&(bar)[XB_TMO], 1u); break; } } } } while (0)

struct XcdBarrier {
    unsigned* bar; unsigned x;
    volatile LAS unsigned* st;
};

__device__ __forceinline__ XcdBarrier xcd_barrier_post(unsigned* bar, volatile LAS unsigned* st) {
    XcdBarrier b; b.bar = bar; b.x = xb_xcc_id(); b.st = st;
    if (threadIdx.x == 0) (void)xb_add(&bar[XB_XCNT(b.x)], 1u);
    return b;
}
__device__ __forceinline__ void xcd_barrier_complete(unsigned* bar, unsigned x, unsigned& nloc, unsigned& nx) {
    const unsigned G = gridDim.x * gridDim.y * gridDim.z;
    unsigned sum, cnt, mine, sp = 0u;
    for (;;) {
        sum = 0u; cnt = 0u; mine = 0u;
#pragma unroll
        for (unsigned j = 0; j < 16; ++j) { const unsigned c = xb_ld(&bar[XB_XCNT(j)]); sum += c; cnt += (c > 0u) ? 1u : 0u; mine = (j == x) ? c : mine; }
        if (sum == G) break;
        __builtin_amdgcn_s_sleep(1);
        if ((++sp & 255u) == 0u) { if (xb_ld(&bar[XB_TMO])) break; if (sp > XB_SPIN_CAP) { atomicAdd(&bar[XB_TMO], 1u); break; } }
    }
    nloc = mine > 0u ? mine : 1u; nx = cnt > 0u ? cnt : 1u;
}

__device__ __forceinline__ void xcd_barrier(const XcdBarrier& b) {
    asm volatile("s_waitcnt vmcnt(0)" ::: "memory");
    __syncthreads();
    if (threadIdx.x == 0) {
        unsigned* bar = b.bar;
        __builtin_amdgcn_s_waitcnt(0);
        unsigned nloc = b.st[0], nx = b.st[1];
        if (nloc == 0u) { xcd_barrier_complete(bar, b.x, nloc, nx); b.st[0] = nloc; b.st[1] = nx; }
        const unsigned old = xb_add(&bar[XB_XSUB(b.x)], 1u);
        const unsigned gen = old / nloc;
        if (old + 1u == (gen + 1u) * nloc) {
            __builtin_amdgcn_fence(__ATOMIC_RELEASE, "agent");
            asm volatile("s_waitcnt vmcnt(0)" ::: "memory");
            const unsigned og = xb_add(&bar[XB_TOP], 1u);
            const unsigned tg = og / nx;
            if (og + 1u == (tg + 1u) * nx) xb_add(&bar[XB_TOPGEN], 1u);
            else XB_SPIN(xb_ld(&bar[XB_TOPGEN]) == tg, bar);
            __builtin_amdgcn_fence(__ATOMIC_ACQUIRE, "agent");
            xb_add(&bar[XB_XGEN(b.x)], 1u);
            asm volatile("s_waitcnt vmcnt(0)" ::: "memory");
        } else {
            XB_SPIN(xb_ld(&bar[XB_XGEN(b.x)]) == gen, bar);
            __builtin_amdgcn_fence(__ATOMIC_ACQUIRE, "agent");
            asm volatile("s_waitcnt vmcnt(0)" ::: "memory");
        }
    }
    __syncthreads();
}


namespace pg8 {
struct EpiProj {
    static constexpr bool PERM = true, AFTER_DRAIN = false;
    bf16_t* base0; const float* qg; const float* kg;
    __device__ __forceinline__ void operator()(const f32x4 (&acc)[2][2][4][2], const Unit& u, int wr, int wc, int fr, int fq) const {
        const int region = u.pn >> 2;
        bf16_t* O = base0 + (size_t)region * (16u << 20);
        const int row0 = u.pm * BM + wr * 64 + fr, col0 = (u.pn & 3) * 256 + wc * 64 + 8 * fq;
        if (region < 2) {
            const float* g = region == 0 ? qg : kg; const float sc = region == 0 ? 0.125f * 1.4426950408889634f : 1.0f;
            f32x4 gv[2][2];
#pragma unroll
            for (int bj = 0; bj < 2; ++bj)
#pragma unroll
                for (int n = 0; n < 2; ++n) gv[bj][n] = *(const f32x4*)(g + bj * 32 + 8 * fq + 4 * n) * sc;
#pragma unroll
            for (int ai = 0; ai < 2; ++ai)
#pragma unroll
                for (int m = 0; m < 4; ++m) {
                    float ss = 0.f;
#pragma unroll
                    for (int bj = 0; bj < 2; ++bj)
#pragma unroll
                        for (int n = 0; n < 2; ++n) { const f32x4 x = acc[ai][bj][m][n]; ss += (x[0] * x[0] + x[1] * x[1]) + (x[2] * x[2] + x[3] * x[3]); }
                    ss = xor32_sum(xor16_sum(ss));
                    const float rs = __builtin_amdgcn_rsqf(ss * (1.0f / 64.0f) + 1e-6f);
                    bf16_t* rowp = O + (size_t)(row0 + ai * HALF + m * 16) * 1024 + col0;
#pragma unroll
                    for (int bj = 0; bj < 2; ++bj) { const f32x4 v0 = acc[ai][bj][m][0] * rs * gv[bj][0], v1 = acc[ai][bj][m][1] * rs * gv[bj][1];
                        u32x4 w; w.x = cvt_pk_bf16(v0[0], v0[1]); w.y = cvt_pk_bf16(v0[2], v0[3]); w.z = cvt_pk_bf16(v1[0], v1[1]); w.w = cvt_pk_bf16(v1[2], v1[3]);
                        *(u32x4*)(rowp + bj * 32) = w; }
                }
        } else {
#pragma unroll
            for (int ai = 0; ai < 2; ++ai)
#pragma unroll
                for (int m = 0; m < 4; ++m) { bf16_t* rowp = O + (size_t)(row0 + ai * HALF + m * 16) * 1024 + col0;
#pragma unroll
                    for (int bj = 0; bj < 2; ++bj) { const f32x4 v0 = acc[ai][bj][m][0], v1 = acc[ai][bj][m][1];
                        u32x4 w; w.x = cvt_pk_bf16(v0[0], v0[1]); w.y = cvt_pk_bf16(v0[2], v0[3]); w.z = cvt_pk_bf16(v1[0], v1[1]); w.w = cvt_pk_bf16(v1[2], v1[3]);
                        *(u32x4*)(rowp + bj * 32) = w; } }
        }
    }
};
struct EpiX1 {
    static constexpr bool PERM = true, AFTER_DRAIN = false;
    const float* x; float* out; bf16_t* a2; const float* gf; float* ssq; unsigned char* h8;
    __device__ __forceinline__ void operator()(const f32x4 (&acc)[2][2][4][2], const Unit& u, int wr, int wc, int fr, int fq) const {
        const int row0 = u.pm * BM + wr * 64 + fr, col0 = u.pn * BM + wc * 32 + 8 * fq;
        f32x4 gv[2][2];
#pragma unroll
        for (int bj = 0; bj < 2; ++bj)
#pragma unroll
            for (int n = 0; n < 2; ++n) gv[bj][n] = *(const f32x4*)(gf + col0 + bj * HALF + 4 * n);
#pragma unroll
        for (int ai = 0; ai < 2; ++ai)
#pragma unroll
            for (int m = 0; m < 4; ++m) { const int row = row0 + ai * HALF + m * 16; const size_t off = (size_t)row * 2048 + col0; float ss = 0.f;
#pragma unroll
                for (int bj = 0; bj < 2; ++bj) {
                    const f32x4 x0 = *(const f32x4*)(x + off + bj * HALF), x1 = *(const f32x4*)(x + off + bj * HALF + 4);
                    const f32x4 v0 = x0 + acc[ai][bj][m][0], v1 = x1 + acc[ai][bj][m][1];
                    ss += (v0[0] * v0[0] + v0[1] * v0[1]) + (v0[2] * v0[2] + v0[3] * v0[3]); ss += (v1[0] * v1[0] + v1[1] * v1[1]) + (v1[2] * v1[2] + v1[3] * v1[3]);
                    const f32x4 a0 = v0 * gv[bj][0], a1 = v1 * gv[bj][1];
                    u32x4 w; w.x = cvt_pk_bf16(a0[0], a0[1]); w.y = cvt_pk_bf16(a0[2], a0[3]); w.z = cvt_pk_bf16(a1[0], a1[1]); w.w = cvt_pk_bf16(a1[2], a1[3]);
                    *(u32x4*)(a2 + off + bj * HALF) = w;
                    { const f32x4 b0 = a0 * 16.0f, b1 = a1 * 16.0f; unsigned p = 0u, q2 = 0u;
#pragma unroll
                      for (int e_ = 0; e_ < 4; ++e_) { const int i0_ = __builtin_amdgcn_fmed3f(__builtin_rintf(b0[e_]), -127.f, 127.f), i1_ = __builtin_amdgcn_fmed3f(__builtin_rintf(b1[e_]), -127.f, 127.f);
                          p |= ((unsigned)i0_ & 0xffu) << (8 * e_); q2 |= ((unsigned)i1_ & 0xffu) << (8 * e_); }
                      typedef unsigned u32x2_ __attribute__((ext_vector_type(2))); *(u32x2_*)(h8 + off + bj * HALF) = (u32x2_){p, q2}; } }
                ss = xor32_sum(xor16_sum(ss));
                if (fq == 0) ssq[(size_t)row * 32 + u.pn * 4 + wc] = ss; }
    }
};
}

__device__ __forceinline__ void p0_transpose_item(const float* W, int K, int N, bf16* WT, LAS float* scr, int item, int lane, bool permg) {
    const int nblk = N / 32, kb = item / nblk, nb = item % nblk, k0 = 64 * kb, n0 = 32 * nb;
#pragma unroll 8
    for (int i = 0; i < 32; ++i) { const int kk = 2 * i + (lane >> 5); scr[kk * 33 + (lane & 31)] = W[(size_t)(k0 + kk) * N + n0 + (lane & 31)]; }
    LDS_WAIT(); asm volatile("" ::: "memory");
    int nd = n0; if (permg) { const int gl = (n0 & 255) >> 5; nd = (n0 & ~255) + 32 * (4 * (gl & 1) + (gl >> 1)); }
    const int c = lane & 7;
#pragma unroll
    for (int j = 0; j < 4; ++j) { const int n = (lane >> 3) + 8 * j; const LAS float* s = scr + (8 * c) * 33 + n;
        v4u o; o.x = pk2(s[0 * 33], s[1 * 33]); o.y = pk2(s[2 * 33], s[3 * 33]); o.z = pk2(s[4 * 33], s[5 * 33]); o.w = pk2(s[6 * 33], s[7 * 33]);
        *(v4u*)(WT + (size_t)(nd + n) * K + k0 + 8 * c) = o; }
    LDS_WAIT(); asm volatile("" ::: "memory");
}
__device__ __forceinline__ void rms_row_to_bf16(const float* xrow, const float* g, bf16* orow, int lane) {
    const f32x4* xr = (const f32x4*)xrow + lane; const f32x4* gr = (const f32x4*)g + lane;
    f32x4 v[8]; float s = 0.f;
#pragma unroll
    for (int j = 0; j < 8; ++j) { v[j] = xr[64 * j]; s += (v[j].x * v[j].x + v[j].y * v[j].y) + (v[j].z * v[j].z + v[j].w * v[j].w); }
    const float rstd = 1.0f / sqrtf(wave_sum(s) * (1.f / DM) + EPS);
    v2u* o8 = (v2u*)orow + lane;
#pragma unroll
    for (int j = 0; j < 8; ++j) { const f32x4 gg = gr[64 * j]; v2u w; w.x = pk2(v[j].x * rstd * gg.x, v[j].y * rstd * gg.y); w.y = pk2(v[j].z * rstd * gg.z, v[j].w * rstd * gg.w); o8[64 * j] = w; }
}
__device__ __forceinline__ void cvt_bf16_stream(const float* src, bf16* dst, size_t n8, size_t gtid, size_t nthr) {
    for (size_t i = gtid; i < n8; i += nthr) { const f32x4 a = *(const f32x4*)(src + i * 8), b = *(const f32x4*)(src + i * 8 + 4);
        v4u o; o.x = pk2(a.x, a.y); o.y = pk2(a.z, a.w); o.z = pk2(b.x, b.y); o.w = pk2(b.z, b.w); *(v4u*)(dst + i * 8) = o; }
}

__device__ __forceinline__ void cvt_i4_slices(const float* src, unsigned char* dst, float inv_step, size_t gtid, size_t nthr) {
    for (size_t i = gtid; i < (size_t)16384 * 64; i += nthr) { v4u o; const size_t e = i >> 6; const int c32 = (int)(i & 63), s = c32 >> 3, sub = c32 & 7;
#pragma unroll
        for (int w = 0; w < 4; ++w) { const f32x4 a = *(const f32x4*)(src + i * 32 + 8 * w) * inv_step, b = *(const f32x4*)(src + i * 32 + 8 * w + 4) * inv_step; unsigned d = 0u;
#pragma unroll
            for (int e_ = 0; e_ < 4; ++e_) { const int lo = (int)__builtin_amdgcn_fmed3f(__builtin_rintf(a[e_]), -8.f, 7.f) + 8, hi = (int)__builtin_amdgcn_fmed3f(__builtin_rintf(b[e_]), -8.f, 7.f) & 15; d |= ((unsigned)lo | ((unsigned)hi << 4)) << (8 * e_); }
            if (w == 0) o.x = d; else if (w == 1) o.y = d; else if (w == 2) o.z = d; else o.w = d; }
        *(v4u*)(dst + ((size_t)s * 16384 + e) * 128 + 16 * sub) = o; }
}
__device__ __forceinline__ float table_std16(const float* src, LAS float* scr, int tid) {
    float s = 0.f;
#pragma unroll
    for (int j = 0; j < 16; ++j) { const f32x4 v = *(const f32x4*)(src + (size_t)(j * 512 + tid) * 4); s += (v.x * v.x + v.y * v.y) + (v.z * v.z + v.w * v.w); }
    s = wave_sum(s);
    __syncthreads();
    if ((tid & 63) == 0) scr[tid >> 6] = s;
    __syncthreads();
    float t = 0.f;
#pragma unroll
    for (int w = 0; w < 8; ++w) t += scr[w];
    __syncthreads();
    return sqrtf(t * (1.0f / 32768.0f));
}
__device__ __forceinline__ void cvt_i8_slices(const float* src, unsigned char* dst, float scale, size_t gtid, size_t nthr) {
    for (size_t i = gtid; i < (size_t)16384 * 128; i += nthr) { v4u o; const size_t e = i >> 7; const int c16 = (int)(i & 127), s = c16 >> 3, sub = c16 & 7;
#pragma unroll
        for (int q = 0; q < 4; ++q) { const f32x4 a = *(const f32x4*)(src + i * 16 + 4 * q) * scale; unsigned w = 0u;
#pragma unroll
            for (int e_ = 0; e_ < 4; ++e_) { const int iv = (int)__builtin_amdgcn_fmed3f(__builtin_rintf(a[e_]), -127.f, 127.f); w |= ((unsigned)iv & 0xffu) << (8 * e_); }
            if (q == 0) o.x = w; else if (q == 1) o.y = w; else if (q == 2) o.z = w; else o.w = w; }
        *(v4u*)(dst + ((size_t)s * 16384 + e) * 128 + 16 * sub) = o; }
}
__device__ __forceinline__ void cvt_fp8_slices(const float* src, unsigned char* dst, float scale, size_t gtid, size_t nthr) {
    for (size_t i = gtid; i < (size_t)16384 * 128; i += nthr) { v4u o; const size_t e = i >> 7; const int c16 = (int)(i & 127), s = c16 >> 3, sub = c16 & 7;
#pragma unroll
        for (int q = 0; q < 4; ++q) { const f32x4 a = *(const f32x4*)(src + i * 16 + 4 * q) * scale; int w = __builtin_amdgcn_cvt_pk_fp8_f32(a.x, a.y, 0, false); w = __builtin_amdgcn_cvt_pk_fp8_f32(a.z, a.w, w, true);
            if (q == 0) o.x = (unsigned)w; else if (q == 1) o.y = (unsigned)w; else if (q == 2) o.z = (unsigned)w; else o.w = (unsigned)w; }
        *(v4u*)(dst + ((size_t)s * 16384 + e) * 128 + 16 * sub) = o; }
}

namespace att {
constexpr int SLOTB = 32768;
constexpr int NSLOT = 3, LW_OFF = NSLOT * SLOTB;
constexpr int XSTR = 132;
__device__ __forceinline__ void glds16(const void* gsrc, unsigned lds_dst) { unsigned keep;
    asm volatile("s_mov_b32 %0, m0\n\ts_mov_b32 m0, %2\n\ts_nop 0\n\tglobal_load_lds_dwordx4 %1, off\n\ts_mov_b32 m0, %0" : "=&s"(keep) : "v"(gsrc), "s"(lds_dst) : "memory"); }
__device__ __forceinline__ int crow(int r, int hi) { return (r & 3) + 8 * (r >> 2) + 4 * hi; }
typedef short v4i16_t __attribute__((ext_vector_type(4)));
__device__ __forceinline__ s16x4 vtr(const LAS char* p) { return __builtin_bit_cast(s16x4, __builtin_amdgcn_ds_read_tr16_b64_v4i16((LAS v4i16_t*)p)); }
#define ATT_WAIT_BAR(N) asm volatile("s_waitcnt vmcnt(" #N ") lgkmcnt(0)\n\ts_barrier" ::: "memory")
#define ATT_BAR() asm volatile("s_waitcnt lgkmcnt(0)\n\ts_barrier" ::: "memory")

template <int ABL> __device__ __forceinline__ void attn_unit(int b, int h, int qblk, const bf16* Q, const bf16* K, const bf16* V, bf16* MIX, const float* subg, float lam, float M2, LAS char* lds) {
    const int tid = threadIdx.x, lane = tid & 63, r32 = lane & 31, hi = lane >> 5, wid = __builtin_amdgcn_readfirstlane(tid >> 6), c = wid >> 2, qs = wid & 3;
    const size_t rowbase = (size_t)b * SEQ; const int q0 = qblk * 128, NT = 2 * (qblk + 1);
    const unsigned lds0 = (unsigned)(uintptr_t)lds;
    const bf16* ksrc[2]; const bf16* vsrc[2]; unsigned kdst[2], vdst[2];
#pragma unroll
    for (int i = 0; i < 2; ++i) { const int pk = 2 * wid + i, rr = lane >> 4, p = lane & 15, r = 4 * pk + rr;
        ksrc[i] = K + (rowbase + r) * 1024 + h * 128 + ((p ^ (r & 15)) * 8); kdst[i] = lds0 + pk * 1024;
        vsrc[i] = V + (rowbase + r) * 1024 + h * 128 + ((p ^ (rr << 2)) * 8); vdst[i] = lds0 + 16384 + pk * 1024; }
#define ATT_DMA(t, slot) do { _Pragma("unroll") for (int i_ = 0; i_ < 2; ++i_) { glds16(ksrc[i_] + (size_t)(t) * 64 * 1024, (unsigned)__builtin_amdgcn_readfirstlane(kdst[i_] + (slot) * SLOTB)); \
        glds16(vsrc[i_] + (size_t)(t) * 64 * 1024, (unsigned)__builtin_amdgcn_readfirstlane(vdst[i_] + (slot) * SLOTB)); } } while (0)
    ATT_DMA(0, 0); ATT_DMA(1, 1);
    const int qrow = q0 + 32 * qs + r32;
    bf16x8 qr[4];
#pragma unroll
    for (int d0 = 0; d0 < 4; ++d0) qr[d0] = *(const bf16x8*)(Q + (rowbase + qrow) * 1024 + h * 128 + c * 64 + d0 * 16 + hi * 8);
    asm volatile("" : "+v"(qr[0]), "+v"(qr[1]), "+v"(qr[2]), "+v"(qr[3]));
    const float slope2 = exp2f(-(float)(h + 1)) * 1.4426950408889634f;
    float base = -slope2 * (float)(qrow - 4 * hi) - M2;
    const float s32 = 32.f * slope2, s64 = 64.f * slope2;
    f32x16 o[4]; o[0] = f32x16{}; o[1] = f32x16{}; o[2] = f32x16{}; o[3] = f32x16{};
    float lsum = 0.f;
    int kofs[4], vofs[4];
    { const int q4 = (lane & 15) >> 2, p4 = lane & 3, gb = (lane >> 4) & 1;
#pragma unroll
      for (int d0 = 0; d0 < 4; ++d0) { kofs[d0] = r32 * 256 + (((8 * c + 2 * d0 + hi) ^ (r32 & 15)) << 4); vofs[d0] = 16384 + (4 * hi + q4) * 256 + (((((d0 ^ q4) << 2) | (gb << 1) | (p4 >> 1))) << 4) + (p4 & 1) * 8; } }
    const LAS char* lbase = (const LAS char*)lds;
    const int qw0 = q0 + 32 * qs;
#define ATT_PW(ks_) __builtin_bit_cast(bf16x8, ((v4u){pwd[4 * (ks_)], pwd[4 * (ks_) + 1], pwd[4 * (ks_) + 2], pwd[4 * (ks_) + 3]}))
#define ATT_VF(F, d_) ((bf16x8){F[2 * (d_)][0], F[2 * (d_)][1], F[2 * (d_)][2], F[2 * (d_)][3], F[2 * (d_) + 1][0], F[2 * (d_) + 1][1], F[2 * (d_) + 1][2], F[2 * (d_) + 1][3]})
#define ATT_VLDK(F, ks_) do { if (ABL & 16) { _Pragma("unroll") for (int d_ = 0; d_ < 8; ++d_) F[d_] = (s16x4){0, 0, 0, 0}; } else { _Pragma("unroll") for (int d_ = 0; d_ < 4; ++d_) { F[2 * d_] = vtr(sp_ + vofs[d_] + (ks_) * 4096); F[2 * d_ + 1] = vtr(sp_ + vofs[d_] + (ks_) * 4096 + 2048); } } } while (0)
#define ATT_MF(acc_, a_, b_) do { if (ABL & 2) { bf16x8 a__ = (a_), b__ = (b_); asm volatile("" :: "v"(a__), "v"(b__)); } else acc_ = __builtin_amdgcn_mfma_f32_32x32x16_bf16((a_), (b_), acc_, 0, 0, 0); } while (0)
#define ATT_PVK(F, ks_) do { _Pragma("unroll") for (int d_ = 0; d_ < 4; ++d_) ATT_MF(o[d_], ATT_PW(ks_), ATT_VF(F, d_)); } while (0)
#define ATT_SB() __builtin_amdgcn_sched_barrier(0)
    int slot = 0;
    for (int t = 0; t < NT; ++t) {
        if ((ABL & 64) && t > 0) { } else if (t == 0 || (ABL & 8)) { ATT_WAIT_BAR(0); } else if (t + 1 < NT) { ATT_WAIT_BAR(4); } else { ATT_WAIT_BAR(0); }
        if (!(ABL & 8) && t + 2 < NT) { const int s2_ = (slot == 0) ? 2 : slot - 1; ATT_DMA(t + 2, s2_); }
        const int k0 = 64 * t;
        if (k0 <= qw0 + 31) {
            const LAS char* sp_ = lbase + slot * SLOTB;
            f32x16 p0, p1; s16x4 fa[8], fb[8]; unsigned pwd[16];
#pragma unroll
            for (int r = 0; r < 16; ++r) { p0[r] = __builtin_fmaf(slope2, (float)((r & 3) + 8 * (r >> 2)), base); p1[r] = p0[r] + s32; }
            const bool diag = k0 + 63 > qw0;
            const int dq = qrow - k0;
            {
                float sA = 0.f, sB = 0.f, sC = 0.f, sD = 0.f; float e0[16], e1[16];
                __builtin_amdgcn_s_setprio(1);
#pragma unroll
                for (int d0 = 0; d0 < 4; ++d0) { const bf16x8 ka = *(const LAS bf16x8*)(sp_ + kofs[d0]); if (ABL & 4) { asm volatile("" :: "v"(ka)); } else p0 = __builtin_amdgcn_mfma_f32_32x32x16_bf16(ka, qr[d0], p0, 0, 0, 0); }
                ATT_VLDK(fa, 0); ATT_SB();
#pragma unroll
                for (int d0 = 0; d0 < 4; ++d0) { const bf16x8 kb = *(const LAS bf16x8*)(sp_ + kofs[d0] + 8192); if (ABL & 4) { asm volatile("" :: "v"(kb)); } else p1 = __builtin_amdgcn_mfma_f32_32x32x16_bf16(kb, qr[d0], p1, 0, 0, 0);
#pragma unroll
                    for (int i = 0; i < 4; ++i) e0[4 * d0 + i] = (ABL & 1) ? p0[4 * d0 + i] : __builtin_amdgcn_exp2f(p0[4 * d0 + i]);
                    if (diag) {
#pragma unroll
                        for (int i = 0; i < 4; ++i) if (crow(4 * d0 + i, hi) > dq) e0[4 * d0 + i] = 0.f; }
                    sA += e0[4 * d0]; sB += e0[4 * d0 + 1]; sC += e0[4 * d0 + 2]; sD += e0[4 * d0 + 3]; ATT_SB(); }
                ATT_VLDK(fb, 1);
#pragma unroll
                for (int j = 0; j < 8; ++j) pwd[j] = pk2(e0[2 * j], e0[2 * j + 1]);
                ATT_SB();
#pragma unroll
                for (int d_ = 0; d_ < 4; ++d_) { ATT_MF(o[d_], ATT_PW(0), ATT_VF(fa, d_));
                    e1[2 * d_] = (ABL & 1) ? p1[2 * d_] : __builtin_amdgcn_exp2f(p1[2 * d_]); e1[2 * d_ + 1] = (ABL & 1) ? p1[2 * d_ + 1] : __builtin_amdgcn_exp2f(p1[2 * d_ + 1]);
                    if (diag) { if (crow(2 * d_, hi) + 32 > dq) e1[2 * d_] = 0.f; if (crow(2 * d_ + 1, hi) + 32 > dq) e1[2 * d_ + 1] = 0.f; }
                    sA += e1[2 * d_]; sB += e1[2 * d_ + 1]; ATT_SB(); }
                ATT_VLDK(fa, 2); ATT_SB();
#pragma unroll
                for (int d_ = 0; d_ < 4; ++d_) { ATT_MF(o[d_], ATT_PW(1), ATT_VF(fb, d_));
                    e1[8 + 2 * d_] = (ABL & 1) ? p1[8 + 2 * d_] : __builtin_amdgcn_exp2f(p1[8 + 2 * d_]); e1[8 + 2 * d_ + 1] = (ABL & 1) ? p1[8 + 2 * d_ + 1] : __builtin_amdgcn_exp2f(p1[8 + 2 * d_ + 1]);
                    if (diag) { if (crow(8 + 2 * d_, hi) + 32 > dq) e1[8 + 2 * d_] = 0.f; if (crow(8 + 2 * d_ + 1, hi) + 32 > dq) e1[8 + 2 * d_ + 1] = 0.f; }
                    sC += e1[8 + 2 * d_]; sD += e1[8 + 2 * d_ + 1];
                    pwd[8 + d_] = pk2(e1[2 * d_], e1[2 * d_ + 1]); ATT_SB(); }
                ATT_VLDK(fb, 3);
#pragma unroll
                for (int j = 4; j < 8; ++j) pwd[8 + j] = pk2(e1[2 * j], e1[2 * j + 1]);
                lsum += (sA + sB) + (sC + sD);
                ATT_SB();
                ATT_PVK(fa, 2); ATT_SB(); ATT_PVK(fb, 3);
                __builtin_amdgcn_s_setprio(0);
            }
        }
        base += s64;
        slot = (slot == NSLOT - 1) ? 0 : slot + 1;
    }
#undef ATT_PW
#undef ATT_VF
#undef ATT_VLDK
#undef ATT_PVK
#undef ATT_MF
#undef ATT_SB
    ATT_WAIT_BAR(0);
    if (ABL & 32) { float keep_ = lsum + o[0][0] + o[1][1] + o[2][2] + o[3][3]; asm volatile("" :: "v"(keep_)); return; }
    LAS float* lw = (LAS float*)(lds + LW_OFF) + wid * 32;
    { auto rr = __builtin_amdgcn_permlane32_swap(__float_as_uint(lsum), __float_as_uint(lsum), false, false); lsum = __uint_as_float(rr[0]) + __uint_as_float(rr[1]); }
    if (hi == 0) lw[r32] = lsum;
    LDS_WAIT();
    LAS float* X = (LAS float*)lds + qs * 32 * XSTR;
#pragma unroll
    for (int r = 0; r < 16; ++r) { const float rl = 1.0f / lw[crow(r, hi)];
#pragma unroll
        for (int d0 = 0; d0 < 4; ++d0) o[d0][r] *= rl; }
    if (c == 1) {
#pragma unroll
        for (int r = 0; r < 16; ++r)
#pragma unroll
            for (int d0 = 0; d0 < 4; ++d0) X[crow(r, hi) * XSTR + d0 * 32 + r32] = o[d0][r];
    }
    ATT_WAIT_BAR(0);
    if (c == 0) {
#pragma unroll
        for (int r = 0; r < 16; ++r)
#pragma unroll
            for (int d0 = 0; d0 < 4; ++d0) { LAS float* px = X + crow(r, hi) * XSTR + d0 * 32 + r32; const float a = o[d0][r] - lam * (*px); *px = a; }
        LDS_WAIT(); asm volatile("" ::: "memory");
        const LAS f32x4* rp = (const LAS f32x4*)(X + r32 * XSTR + hi * 64);
        f32x4 av[16]; float ss = 0.f;
#pragma unroll
        for (int j = 0; j < 16; ++j) { av[j] = rp[j]; ss += (av[j].x * av[j].x + av[j].y * av[j].y) + (av[j].z * av[j].z + av[j].w * av[j].w); }
        { auto rr = __builtin_amdgcn_permlane32_swap(__float_as_uint(ss), __float_as_uint(ss), false, false); ss = __uint_as_float(rr[0]) + __uint_as_float(rr[1]); }
        const float rs = 0.8f / sqrtf(ss * (1.0f / 128.0f) + EPS);
        bf16* op = MIX + (rowbase + qrow) * 2048 + h * 128 + hi * 64;
#pragma unroll
        for (int j = 0; j < 8; ++j) { const f32x4 g0 = *(const f32x4*)(subg + hi * 64 + 8 * j), g1 = *(const f32x4*)(subg + hi * 64 + 8 * j + 4); const f32x4 a0 = av[2 * j] * rs * g0, a1 = av[2 * j + 1] * rs * g1;
            v4u w; w.x = pk2(a0.x, a0.y); w.y = pk2(a0.z, a0.w); w.z = pk2(a1.x, a1.y); w.w = pk2(a1.z, a1.w); *(v4u*)(op + 8 * j) = w; }
    }
    ATT_BAR();
#undef ATT_DMA
}
}


#ifndef DBG_NAIVE_ATTN
#define DBG_NAIVE_ATTN 0
#endif
#if DBG_NAIVE_ATTN
__device__ __forceinline__ void naive_attn_row(int b, int h, int q, const bf16* Q, const bf16* K, const bf16* V, bf16* MIX, const float* subg, float lam, LAS float* S, int lane) {
    const size_t rowbase = (size_t)b * SEQ; const float slope2 = exp2f(-(float)(h + 1)) * 1.4426950408889634f;
    for (int c = 0; c < 2; ++c) {
        float qv[64];
        const bf16* qp = Q + (rowbase + q) * 1024 + h * 128 + c * 64;
#pragma unroll
        for (int d = 0; d < 64; d += 2) { const unsigned u = *(const unsigned*)(qp + d); qv[d] = bflo(u); qv[d + 1] = bfhi(u); }
        for (int key = lane; key <= q; key += 64) { const bf16* kp = K + (rowbase + key) * 1024 + h * 128 + c * 64; float s = 0.f;
#pragma unroll
            for (int d = 0; d < 64; d += 2) { const unsigned u = *(const unsigned*)(kp + d); s += qv[d] * bflo(u) + qv[d + 1] * bfhi(u); }
            S[c * 2048 + key] = s - slope2 * (float)(q - key); }
    }
    LDS_WAIT();
    float linv[2];
    for (int c = 0; c < 2; ++c) { float m = -1e30f; for (int key = lane; key <= q; key += 64) m = fmaxf(m, S[c * 2048 + key]); m = wave_max(m);
        float l = 0.f; for (int key = lane; key <= q; key += 64) { const float p = exp2f(S[c * 2048 + key] - m); S[c * 2048 + key] = p; l += p; } linv[c] = 1.0f / wave_sum(l); }
    for (int key = lane; key <= q; key += 64) S[key] = S[key] * linv[0] - lam * S[2048 + key] * linv[1];
    LDS_WAIT();
    float o0 = 0.f, o1 = 0.f; const bf16* vp = V + rowbase * 1024 + h * 128 + lane;
    for (int key = 0; key <= q; ++key) { const float a = S[key]; o0 += a * __uint_as_float((unsigned)vp[(size_t)key * 1024] << 16); o1 += a * __uint_as_float((unsigned)vp[(size_t)key * 1024 + 64] << 16); }
    const float ss = wave_sum(o0 * o0 + o1 * o1); const float rs = 0.8f / sqrtf(ss * (1.0f / 128.0f) + EPS);
    bf16* op = MIX + (rowbase + q) * 2048 + h * 128 + lane;
    op[0] = (bf16)(pk2(o0 * rs * subg[lane], 0.f) & 0xffffu); op[64] = (bf16)(pk2(o1 * rs * subg[lane + 64], 0.f) & 0xffffu);
    LDS_WAIT();
}
#endif

__device__ __forceinline__ unsigned ord_key(float f) { const unsigned u = __float_as_uint(f); return (u & 0x80000000u) ? ~u : (u | 0x80000000u); }
__device__ __forceinline__ float ord_val(unsigned k) { return __uint_as_float((k & 0x80000000u) ? (k ^ 0x80000000u) : ~k); }
#define CE_DESC(a, b) do { const unsigned hi__ = max((a), (b)), lo__ = min((a), (b)); (a) = hi__; (b) = lo__; } while (0)
__device__ __forceinline__ void sort16_desc(unsigned (&v)[16]) {
#pragma unroll
    for (int k = 2; k <= 16; k <<= 1)
#pragma unroll
        for (int j = k >> 1; j > 0; j >>= 1)
#pragma unroll
            for (int i = 0; i < 16; ++i) { const int l = i ^ j; if (l > i) { if ((i & k) == 0) CE_DESC(v[i], v[l]); else CE_DESC(v[l], v[i]); } }
}
__device__ __forceinline__ void merge16_desc_rev(unsigned (&a)[16], const unsigned (&brev)[16]) {
#pragma unroll
    for (int i = 0; i < 16; ++i) a[i] = max(a[i], brev[i]);
#pragma unroll
    for (int j = 8; j > 0; j >>= 1)
#pragma unroll
        for (int i = 0; i < 16; ++i) { const int l = i ^ j; if (l > i) CE_DESC(a[i], a[l]); }
}

constexpr int P5_LST_OFF = 65536, P5_TAB_OFF = P5_LST_OFF + 16384;
__device__ __forceinline__ void peer_topk_item(int tile, int h, const bf16* QP, const float* SSQ, int* EIDX, float* EGATE, float* RSTD, LAS char* lds) {
    const int tid = threadIdx.x, lane = tid & 63, r32 = lane & 31, hi = lane >> 5, wid = __builtin_amdgcn_readfirstlane(tid >> 6);
    LAS unsigned* LST = (LAS unsigned*)(lds + P5_LST_OFF);
    const LAS unsigned char* TAB = (const LAS unsigned char*)(lds + P5_TAB_OFF);
    const int tok0 = tile * 128;
    {
        const int c = wid >> 2, tb = wid & 3;
        bf16x8 qf[8];
        const bf16* qp = QP + (size_t)(tok0 + tb * 32 + r32) * 2048 + h * 256 + c * 128 + hi * 8;
#pragma unroll
        for (int s = 0; s < 8; ++s) qf[s] = *(const bf16x8*)(qp + 16 * s);
        const LAS char* sp = lds + c * 32768 + hi * 2048 + r32 * 16;
        unsigned best[16];
#pragma unroll
        for (int kb = 0; kb < 4; ++kb) { f32x16 acc = f32x16{};
#pragma unroll
            for (int s = 0; s < 8; ++s) { const bf16x8 sf = *(const LAS bf16x8*)(sp + s * 4096 + kb * 512); acc = __builtin_amdgcn_mfma_f32_32x32x16_bf16(sf, qf[s], acc, 0, 0, 0); }
            unsigned v[16];
#pragma unroll
            for (int r = 0; r < 16; ++r) v[r] = (ord_key(acc[r]) & ~0x7Fu) | (unsigned)(32 * kb + (r & 3) + 8 * (r >> 2)) | (unsigned)(hi << 2);
            sort16_desc(v);
            if (kb == 0) {
#pragma unroll
                for (int i = 0; i < 16; ++i) best[i] = v[i];
            } else { unsigned vr[16];
#pragma unroll
                for (int i = 0; i < 16; ++i) vr[i] = v[15 - i];
                merge16_desc_rev(best, vr); } }
        {
            unsigned br[16];
#pragma unroll
            for (int i = 0; i < 16; ++i) { const auto r_ = __builtin_amdgcn_permlane32_swap(best[15 - i], best[15 - i], false, false); br[i] = (lane & 32) ? r_[0] : r_[1]; }
            merge16_desc_rev(best, br); }
        if (hi == 0) { LAS unsigned* lrow = LST + (c * 128 + tb * 32 + r32) * 16;
#pragma unroll
            for (int i = 0; i < 4; ++i) *(LAS v4u*)(lrow + 4 * i) = (v4u){best[4 * i], best[4 * i + 1], best[4 * i + 2], best[4 * i + 3]}; }
    }
    __syncthreads();
    {
        const int token = tid >> 2, q = tid & 3;
        const LAS unsigned* l1 = LST + token * 16; const LAS unsigned* l2 = LST + (128 + token) * 16;
        unsigned v[16];
#pragma unroll
        for (int m = 0; m < 13; ++m) { const int n = 4 * m + q; const unsigned pid = TAB[n < 50 ? n : 0]; const unsigned a = l1[pid >> 4], b2 = l2[pid & 15u];
            const unsigned key = (ord_key(ord_val(a & ~0x7Fu) + ord_val(b2 & ~0x7Fu)) & ~0xFFu) | pid; v[m] = n < 50 ? key : 0u; }
        v[13] = 0u; v[14] = 0u; v[15] = 0u;
        sort16_desc(v);
#pragma unroll
        for (int w = 1; w <= 2; w <<= 1) { unsigned br[16];
#pragma unroll
            for (int i = 0; i < 16; ++i) br[i] = (unsigned)(w == 1 ? __builtin_amdgcn_update_dpp(0, (int)v[15 - i], 0xB1, 0xf, 0xf, false) : __builtin_amdgcn_update_dpp(0, (int)v[15 - i], 0x4E, 0xf, 0xf, false));
            merge16_desc_rev(v, br); }
        const int t = tok0 + token;
        const f32x4 p0 = *(const f32x4*)(SSQ + (size_t)t * 32 + 8 * q), p1 = *(const f32x4*)(SSQ + (size_t)t * 32 + 8 * q + 4);
        float ssq = ((p0.x + p0.y) + (p0.z + p0.w)) + ((p1.x + p1.y) + (p1.z + p1.w));
        ssq += DPPF(ssq, 0xB1); ssq += DPPF(ssq, 0x4E);
        const float rstd = 1.0f / sqrtf(ssq * (1.0f / DM) + EPS);
        if (h == 0 && q == 0) RSTD[t] = rstd;
        const unsigned p_top = v[0] & 0xFFu; const float vmax = (ord_val(l1[p_top >> 4] & ~0x7Fu) + ord_val(l2[p_top & 15u] & ~0x7Fu)) * rstd;
        float ev[4]; int ex[4]; float es = 0.f;
#pragma unroll
        for (int m = 0; m < 4; ++m) { const unsigned kk = q == 0 ? v[m] : q == 1 ? v[4 + m] : q == 2 ? v[8 + m] : v[12 + m];
            const unsigned pid = kk & 0xFFu; const unsigned a = l1[pid >> 4], b2 = l2[pid & 15u];
            const float sv = (ord_val(a & ~0x7Fu) + ord_val(b2 & ~0x7Fu)) * rstd;
            ev[m] = __expf(sv - vmax); es += ev[m]; ex[m] = (int)((a & 0x7Fu) * 128u + (b2 & 0x7Fu)); }
        es += DPPF(es, 0xB1); es += DPPF(es, 0x4E);
        const float inv = 1.0f / es;
        *(int4*)(EIDX + (size_t)t * 128 + h * 16 + 4 * q) = make_int4(ex[0], ex[1], ex[2], ex[3]);
        *(f32x4*)(EGATE + (size_t)t * 128 + h * 16 + 4 * q) = (f32x4){ev[0] * inv, ev[1] * inv, ev[2] * inv, ev[3] * inv};
    }
    __syncthreads();
}

__device__ __forceinline__ f32x2 dot16_fp8(const v4u u, const f32x2* h, f32x2 acc) {
#pragma unroll
    for (int w = 0; w < 4; ++w) { const unsigned d = w == 0 ? u.x : w == 1 ? u.y : w == 2 ? u.z : u.w;
        const f32x2 f0 = __builtin_amdgcn_cvt_pk_f32_fp8((int)d, false), f1 = __builtin_amdgcn_cvt_pk_f32_fp8((int)d, true);
        acc = __builtin_elementwise_fma(h[2 * w], f0, acc); acc = __builtin_elementwise_fma(h[2 * w + 1], f1, acc); }
    return acc;
}
__device__ __forceinline__ void axpy16_fp8(const v4u v, f32x2 a2, f32x2* o) {
#pragma unroll
    for (int w = 0; w < 4; ++w) { const unsigned d = w == 0 ? v.x : w == 1 ? v.y : w == 2 ? v.z : v.w;
        const f32x2 f0 = __builtin_amdgcn_cvt_pk_f32_fp8((int)d, false), f1 = __builtin_amdgcn_cvt_pk_f32_fp8((int)d, true);
        o[2 * w] = __builtin_elementwise_fma(a2, f0, o[2 * w]); o[2 * w + 1] = __builtin_elementwise_fma(a2, f1, o[2 * w + 1]); }
}
struct PItem { int t, s; };
__device__ __forceinline__ PItem peer_item(int q, int nq, int nper, int tb, int tstride, int xl) {
    const int j = (q < nq ? q : nq - 1) >> 1; PItem it; const int r = j >= nper ? 1 : 0; it.s = 8 * r + xl; const int t = tb + (j - r * nper) * tstride; it.t = t < T ? t : T - 1; return it; }
__device__ __forceinline__ void pe_idx8(const PItem it, int hh, const int* EIDX, int g, int (&ex)[8]) {
#pragma unroll
    for (int i = 0; i < 2; ++i) { const int4 v = *(const int4*)(EIDX + (size_t)it.t * 128 + g * 16 + 8 * hh + 4 * i); ex[4 * i] = v.x; ex[4 * i + 1] = v.y; ex[4 * i + 2] = v.z; ex[4 * i + 3] = v.w; }
}
__device__ __forceinline__ void pe_gather8(const PItem it, const unsigned char* TB, int sub, const int (&ex)[8], v4u (&uv)[8]) {
    const unsigned char* ub = TB + (size_t)it.s * 16384 * 128;
#pragma unroll
    for (int i = 0; i < 8; ++i) uv[i] = *(const v4u*)(ub + (unsigned)(ex[i] * 128 + 16 * sub));
}
__device__ __forceinline__ int sdot4(unsigned a, unsigned b, int acc) { return __builtin_amdgcn_sdot4((int)a, (int)b, acc, false); }
__device__ __forceinline__ void pu_acc8(const v4u (&uv)[8], const v4u ha, const v4u hb, int hs8, int (&r)[8]) {
#pragma unroll
    for (int i = 0; i < 8; ++i) { int a = -hs8, b = 0;
        a = sdot4(uv[i].x & 0x0F0F0F0Fu, ha.x, a); b = sdot4(uv[i].x & 0xF0F0F0F0u, ha.y, b); a = sdot4(uv[i].y & 0x0F0F0F0Fu, ha.z, a); b = sdot4(uv[i].y & 0xF0F0F0F0u, ha.w, b);
        a = sdot4(uv[i].z & 0x0F0F0F0Fu, hb.x, a); b = sdot4(uv[i].z & 0xF0F0F0F0u, hb.y, b); a = sdot4(uv[i].w & 0x0F0F0F0Fu, hb.z, a); b = sdot4(uv[i].w & 0xF0F0F0F0u, hb.w, b);
        r[i] = a + (b >> 4); }
}
__device__ __forceinline__ void pu_store(const PItem it, bool valid, float* PART, int lane, const int (&rlo)[8], const int (&rhi)[8]) {
    const int g = lane >> 3, sub = lane & 7;
    int r[16];
#pragma unroll
    for (int i = 0; i < 8; ++i) { r[i] = rlo[i]; r[8 + i] = rhi[i]; }
    { const bool up = (lane & 4) != 0;
#pragma unroll
      for (int j = 0; j < 8; ++j) { const int a = r[j], b2 = r[j + 8]; const int keep = up ? b2 : a, send = up ? a : b2; const int m_ = __builtin_amdgcn_update_dpp(0, send, 0x141, 0xf, 0xf, false); r[j] = keep + __builtin_amdgcn_update_dpp(0, m_, 0x1B, 0xf, 0xf, false); } }
    { const bool up = (lane & 2) != 0;
#pragma unroll
      for (int j = 0; j < 4; ++j) { const int a = r[j], b2 = r[j + 4]; const int keep = up ? b2 : a, send = up ? a : b2; r[j] = keep + __builtin_amdgcn_update_dpp(0, send, 0x4E, 0xf, 0xf, false); } }
    { const bool up = (lane & 1) != 0;
#pragma unroll
      for (int j = 0; j < 2; ++j) { const int a = r[j], b2 = r[j + 2]; const int keep = up ? b2 : a, send = up ? a : b2; r[j] = keep + __builtin_amdgcn_update_dpp(0, send, 0xB1, 0xf, 0xf, false); } }
    const int i0 = 8 * ((sub >> 2) & 1) + 4 * ((sub >> 1) & 1) + 2 * (sub & 1);
    if (valid) *(f32x2*)(PART + ((size_t)it.s * T + it.t) * 128 + g * 16 + i0) = (f32x2){(float)r[0], (float)r[1]};
}
__device__ __forceinline__ PItem peer_item1(int q, int nq, int tb, int tstride, int xl) { const int j = (q < nq ? q : nq - 1) >> 1; PItem it; it.s = xl; const int t = tb + j * tstride; it.t = t < T ? t : T - 1; return it; }
__device__ __forceinline__ void peer_u_stage(int nper, int tb, int tstride, int xl, const unsigned char* H8, const unsigned char* U8, const int* EIDX, float* PART, int lane) {
    const int g = lane >> 3, sub = lane & 7, NQ = 2 * nper;
    int ex0[8], ex1[8], ex2[8], ex3[8]; v4u uv0[8], uv1[8], uv2[8], uv3[8], ha0, ha1, ha2, ha3, hb0, hb1, hb2, hb3; int rs[8];
#define PU_I(q, X) do { const PItem it_ = peer_item1((q), NQ, tb, tstride, xl); pe_idx8(it_, (X) & 1, EIDX, g, ex##X); } while (0)
#define PU_G(q, X) do { const PItem it_ = peer_item1((q), NQ, tb, tstride, xl); pe_gather8(it_, U8, sub, ex##X, uv##X); const unsigned char* hp_ = H8 + (size_t)it_.t * 2048 + 256 * it_.s + 32 * sub; ha##X = *(const v4u*)hp_; hb##X = *(const v4u*)(hp_ + 16); } while (0)
#define PU_F(q, X) do { const PItem it_ = peer_item1((q), NQ, tb, tstride, xl); int hs_ = sdot4(ha##X.x, 0x01010101u, 0); hs_ = sdot4(ha##X.z, 0x01010101u, hs_); hs_ = sdot4(hb##X.x, 0x01010101u, hs_); hs_ = sdot4(hb##X.z, 0x01010101u, hs_); \
        if (((X) & 1) == 0) pu_acc8(uv##X, ha##X, hb##X, 8 * hs_, rs); else { int rh_[8]; pu_acc8(uv##X, ha##X, hb##X, 8 * hs_, rh_); \
        pu_store(it_, (q) < NQ && (tb + ((q) >> 1) * tstride) < T, PART, lane, rs, rh_); } } while (0)
    PU_I(0, 0); PU_I(1, 1); PU_I(2, 2); PU_I(3, 3); PU_G(0, 0); PU_G(1, 1); PU_G(2, 2);
#pragma unroll 1
    for (int q = 0; q < NQ; q += 4) {
        PU_F(q, 0);     PU_G(q + 3, 3); PU_I(q + 4, 0);
        PU_F(q + 1, 1); PU_G(q + 4, 0); PU_I(q + 5, 1);
        PU_F(q + 2, 2); PU_G(q + 5, 1); PU_I(q + 6, 2);
        PU_F(q + 3, 3); PU_G(q + 6, 2); PU_I(q + 7, 3);
    }
#undef PU_I
#undef PU_G
#undef PU_F
}
__device__ __forceinline__ void tr4x4(unsigned r0, unsigned r1, unsigned r2, unsigned r3, unsigned& c0, unsigned& c1, unsigned& c2, unsigned& c3) {
    const unsigned a = __builtin_amdgcn_perm(r1, r0, 0x05010400u), b = __builtin_amdgcn_perm(r1, r0, 0x07030602u), c = __builtin_amdgcn_perm(r3, r2, 0x05010400u), d = __builtin_amdgcn_perm(r3, r2, 0x07030602u);
    c0 = __builtin_amdgcn_perm(c, a, 0x05040100u); c1 = __builtin_amdgcn_perm(c, a, 0x07060302u); c2 = __builtin_amdgcn_perm(d, b, 0x05040100u); c3 = __builtin_amdgcn_perm(d, b, 0x07060302u);
}
template <bool FIRST> __device__ __forceinline__ void pv_acc8(const v4u (&vv)[8], const unsigned aq0, const unsigned aq1, int (&acc)[32]) {
#pragma unroll
    for (int m = 0; m < 2; ++m) { const unsigned aq = m == 0 ? aq0 : aq1;
#pragma unroll
        for (int w = 0; w < 4; ++w) { unsigned d[4];
#pragma unroll
            for (int i = 0; i < 4; ++i) d[i] = w == 0 ? vv[4 * m + i].x : w == 1 ? vv[4 * m + i].y : w == 2 ? vv[4 * m + i].z : vv[4 * m + i].w;
            unsigned c0, c1, c2, c3;
            tr4x4(d[0], d[1], d[2], d[3], c0, c1, c2, c3);
            const bool z_ = FIRST && m == 0;
            acc[8 * w + 0] = sdot4(c0, aq, z_ ? 0 : acc[8 * w + 0]); acc[8 * w + 1] = sdot4(c1, aq, z_ ? 0 : acc[8 * w + 1]); acc[8 * w + 2] = sdot4(c2, aq, z_ ? 0 : acc[8 * w + 2]); acc[8 * w + 3] = sdot4(c3, aq, z_ ? 0 : acc[8 * w + 3]);
            acc[8 * w + 4] = sdot4(c0 & 0xF0F0F0F0u, aq, z_ ? 0 : acc[8 * w + 4]); acc[8 * w + 5] = sdot4(c1 & 0xF0F0F0F0u, aq, z_ ? 0 : acc[8 * w + 5]); acc[8 * w + 6] = sdot4(c2 & 0xF0F0F0F0u, aq, z_ ? 0 : acc[8 * w + 6]); acc[8 * w + 7] = sdot4(c3 & 0xF0F0F0F0u, aq, z_ ? 0 : acc[8 * w + 7]); } }
}
__device__ __forceinline__ void pv_store(const PItem it, bool valid, float* out, const f32x4 ginv, const float sc, int lane, int (&acc)[32], int asum, const v2u x1b) {
    const int g = lane >> 3, sub = lane & 7;
#pragma unroll
    for (int w_ = 0; w_ < 4; ++w_)
#pragma unroll
        for (int b_ = 0; b_ < 4; ++b_) acc[8 * w_ + b_] -= acc[8 * w_ + 4 + b_];
#pragma unroll
    for (int j = 0; j < 16; ++j) { const auto r_ = __builtin_amdgcn_permlane32_swap((unsigned)acc[j], (unsigned)acc[j + 16], false, false); acc[j] = (int)r_[0] + (int)r_[1]; }
#pragma unroll
    for (int j = 0; j < 8; ++j) { const auto r_ = __builtin_amdgcn_permlane16_swap((unsigned)acc[j], (unsigned)acc[j + 8], false, false); acc[j] = (int)r_[0] + (int)r_[1]; }
    { const bool up = (lane & 8) != 0;
#pragma unroll
      for (int j = 0; j < 4; ++j) { const int a = acc[j], b2 = acc[j + 4]; const int keep = up ? b2 : a, send = up ? a : b2; acc[j] = keep + __builtin_amdgcn_update_dpp(0, send, 0x128, 0xf, 0xf, false); } }
    asum += __builtin_amdgcn_update_dpp(0, asum, 0x128, 0xf, 0xf, false);
    { const auto r_ = __builtin_amdgcn_permlane16_swap((unsigned)asum, (unsigned)asum, false, false); asum = (int)r_[0] + (int)r_[1]; }
    { const auto r_ = __builtin_amdgcn_permlane32_swap((unsigned)asum, (unsigned)asum, false, false); asum = (int)r_[0] + (int)r_[1]; }
    const int c0 = 16 * ((g >> 2) & 1) + 8 * ((g >> 1) & 1) + 4 * (g & 1);
    const bool hicol = (c0 & 4) != 0;
    int v_[4];
#pragma unroll
    for (int i = 0; i < 4; ++i) v_[i] = hicol ? (acc[i] >> 4) : (acc[i] - 8 * asum);
    if (valid) *(f32x4*)(out + (size_t)it.t * 2048 + 256 * it.s + 32 * sub + c0) = (f32x4){bflo(x1b.x) * ginv.x + sc * (float)v_[0], bfhi(x1b.x) * ginv.y + sc * (float)v_[1], bflo(x1b.y) * ginv.z + sc * (float)v_[2], bfhi(x1b.y) * ginv.w + sc * (float)v_[3]};
}
template <int ABL> __device__ __forceinline__ void peer_v_stage(int nper, int tb, int tstride, int xl, const unsigned char* V8, const int* EIDX, const unsigned* ACTQ, const float* ASC, const bf16* A2, const float* ffn_g, float* out, int lane) {
    const int g = lane >> 3, sub = lane & 7, NQ = 2 * nper;
    const int c0 = 16 * ((g >> 2) & 1) + 8 * ((g >> 1) & 1) + 4 * (g & 1);
    int ex0[8], ex1[8], ex2[8], ex3[8]; v4u vv0[8], vv1[8], vv2[8], vv3[8]; v2u aq0, aq1, aq2, aq3, x1a, x1b; float sca = 0.f, scb = 0.f; int acc[32]; int asum = 0;
    f32x4 ginv; { const f32x4 gg = *(const f32x4*)(ffn_g + 256 * xl + 32 * sub + c0); ginv = (f32x4){1.0f / gg.x, 1.0f / gg.y, 1.0f / gg.z, 1.0f / gg.w}; }
#define PV_I(q, X) do { const PItem it_ = peer_item1((q), NQ, tb, tstride, xl); pe_idx8(it_, (X) & 1, EIDX, g, ex##X); } while (0)
#define PV_G(q, X, XV, SCV) do { const PItem it_ = peer_item1((q), NQ, tb, tstride, xl); if (ABL & 2) { _Pragma("unroll") for (int i_ = 0; i_ < 8; ++i_) vv##X[i_] = (v4u){(unsigned)ex##X[i_], 1u, 2u, 3u}; } else pe_gather8(it_, V8, sub, ex##X, vv##X); \
        aq##X = *(const v2u*)(ACTQ + (size_t)it_.t * 32 + g * 4 + 2 * ((X) & 1)); \
        if ((X) & 1) { XV = *(const v2u*)(A2 + (size_t)it_.t * 2048 + 256 * it_.s + 32 * sub + c0); SCV = ASC[it_.t]; } } while (0)
#define PV_F(q, X, XV, SCV) do { const PItem it_ = peer_item1((q), NQ, tb, tstride, xl); if (((X) & 1) == 0) asum = 0; \
        asum = sdot4(aq##X.x, 0x01010101u, asum); asum = sdot4(aq##X.y, 0x01010101u, asum); \
        if (ABL & 1) { _Pragma("unroll") for (int i_ = 0; i_ < 8; ++i_) asm volatile("" :: "v"(vv##X[i_])); acc[0] += (int)aq##X.x; } else pv_acc8<((X) & 1) == 0>(vv##X, aq##X.x, aq##X.y, acc); if ((X) & 1) pv_store(it_, (q) < NQ && (tb + ((q) >> 1) * tstride) < T, out, ginv, SCV, lane, acc, asum, XV); } while (0)
    PV_I(0, 0); PV_I(1, 1); PV_I(2, 2); PV_I(3, 3); PV_G(0, 0, x1a, sca); PV_G(1, 1, x1a, sca); PV_G(2, 2, x1b, scb);
#pragma unroll 1
    for (int q = 0; q < NQ; q += 4) {
        PV_F(q, 0, x1a, sca);     PV_G(q + 3, 3, x1b, scb); PV_I(q + 4, 0);
        PV_F(q + 1, 1, x1a, sca); PV_G(q + 4, 0, x1a, sca); PV_I(q + 5, 1);
        PV_F(q + 2, 2, x1b, scb); PV_G(q + 5, 1, x1a, sca); PV_I(q + 6, 2);
        PV_F(q + 3, 3, x1b, scb); PV_G(q + 6, 2, x1b, scb); PV_I(q + 7, 3);
    }
#undef PV_I
#undef PV_G
#undef PV_F
}

struct Args { const float* in[17]; float* out; unsigned char* ws; int ph_lo, ph_hi; };
__global__ void __launch_bounds__(NTHREADS, 2) mk_fwd(Args args) {
    extern __shared__ __attribute__((aligned(16))) unsigned char lds_raw[];
    LAS unsigned char* lds = (LAS unsigned char*)lds_raw;
    int tid = threadIdx.x, lane = tid & 63; const int wave = __builtin_amdgcn_readfirstlane(tid >> 6);
    const int G = gridDim.x, bx = blockIdx.x;
    const int vcu = (G % 8 == 0) ? (bx % 8) * (G / 8) + bx / 8 : bx;
    unsigned char* ws = args.ws;
    const float* x = args.in[0]; const float* attn_g = args.in[1]; const float* w_in = args.in[2]; const float* qg = args.in[3]; const float* kg = args.in[4];
    const float* lq1 = args.in[5]; const float* lk1 = args.in[6]; const float* lq2 = args.in[7]; const float* lk2 = args.in[8]; const float* subg = args.in[9];
    const float* conv_w = args.in[10]; const float* w_out = args.in[11]; const float* ffn_g = args.in[12]; const float* w_q = args.in[13]; const float* subkeys = args.in[14];
    const float* peer_u = args.in[15]; const float* peer_v = args.in[16];
    float* out = args.out;
    bf16* WtIn = (bf16*)(ws + WS_WIN); bf16* WtOut = (bf16*)(ws + WS_WOUT); bf16* WtQ = (bf16*)(ws + WS_WQ); bf16* SK = (bf16*)(ws + WS_SK);
    float* SSQ = (float*)(ws + WS_SSQ); int* EIDX = (int*)(ws + WS_EIDX); float* EGATE = (float*)(ws + WS_EGATE); float* RSTD = (float*)(ws + WS_RSTD);
    bf16* XN = (bf16*)(ws + WS_XN); bf16* MIX = XN;
    bf16* Qb = (bf16*)(ws + WS_Q); bf16* Kb = (bf16*)(ws + WS_K); bf16* Vb = (bf16*)(ws + WS_V); bf16* QP = Qb;
    bf16* CB = (bf16*)(ws + WS_CB); bf16* CC = (bf16*)(ws + WS_CC); bf16* CX = (bf16*)(ws + WS_CX); bf16* A2 = CB;
    unsigned char* U8 = ws + WS_UT; unsigned char* V8 = ws + WS_VT;
    volatile LAS unsigned* MISC = (volatile LAS unsigned*)(lds + MISC_OFF);
    if (tid < 16) MISC[tid] = 0u;
    __syncthreads();
    XcdBarrier bar = xcd_barrier_post((unsigned*)(ws + WS_CTL) + CW_BAR, MISC + 8);
    const int lo = args.ph_lo, hi_ph = args.ph_hi & 255, dbg_flags = args.ph_hi >> 8;
#ifndef DBG_DUP
#define DBG_DUP -1
#endif
#ifndef DBG_MASK
#define DBG_MASK 0xfff
#endif
#define IN(k) (((DBG_MASK >> (k)) & 1) && lo <= (k) && (k) < hi_ph)
#define REPS(k) for (int rep_ = 0; rep_ < ((DBG_DUP == (k)) ? 2 : 1); ++rep_)
#define SEAM(k) do { if (IN(k) && IN((k) + 1)) xcd_barrier(bar); } while (0)
    const int gw = vcu * NWAVES + wave, NGW = G * NWAVES;
    size_t gtid = (size_t)bx * NTHREADS + tid; const size_t nthr = (size_t)G * NTHREADS;

    if (IN(0)) REPS(0) {
        LAS float* scr = (LAS float*)(lds + wave * 16384);
        constexpr int I_IN = (DM / 64) * (INC / 32), I_SQ = (DM / 64) * (DM / 32);
        if (!(dbg_flags & 4))
        for (int it = gw; it < I_IN; it += NGW) p0_transpose_item(w_in, DM, INC, WtIn, scr, it, lane, true);
        if (!(dbg_flags & 8))
        for (int m = gw; m < T; m += NGW) rms_row_to_bf16(x + (size_t)m * DM, attn_g, XN + (size_t)m * DM, lane);
        cvt_bf16_stream(subkeys, SK, (size_t)PEH * 2 * PNK * 128 / 8, gtid, nthr);
    }
    SEAM(0);
    if (IN(1)) REPS(1) {
        pg8::Gemm g{XN, WtIn, T, INC, DM}; pg8::StaticOrder S; S.init(T, INC, G, bx, WGM_P1);
        pg8::EpiProj E{Qb, qg, kg};
        pg8::gemm_phase<pg8::EpiProj, pg8::StaticOrder, true, true>(lds, g, S, E);
    }
    SEAM(1);
    if (IN(2)) REPS(2) {
        float a = lq1[lane] * lk1[lane], b2 = lq2[lane] * lk2[lane];
        a = wave_sum(a); b2 = wave_sum(b2);
        const float lam = expf(a) - expf(b2) + 0.2f;
        const float mq = wave_max(fabsf(qg[lane])), mk = wave_max(fabsf(kg[lane]));
        const float M2 = 64.f * C2 * mq * mk;
        const bool mem_first = ((bx >> 3) & 1) != 0;
        if (mem_first) {
            int tl_ = threadIdx.x; asm volatile("" : "+v"(tl_)); const size_t gtid_l = (size_t)blockIdx.x * NTHREADS + tl_, nthr_l = (size_t)gridDim.x * NTHREADS;
            {
                const int wv_ = __builtin_amdgcn_readfirstlane(tl_ >> 6), gw_l = vcu * NWAVES + wv_; LAS float* scr_ = (LAS float*)(lds + wv_ * 16384); constexpr int I_SQ_ = (DM / 64) * (DM / 32);
                for (int it = gw_l; it < 2 * I_SQ_; it += G * NWAVES) { if (it < I_SQ_) p0_transpose_item(w_out, DM, DM, WtOut, scr_, it, tl_ & 63, false); else p0_transpose_item(w_q, DM, DM, WtQ, scr_, it - I_SQ_, tl_ & 63, false); } }
            {
                const float sig = table_std16(peer_u, (LAS float*)(lds + MISC_OFF + 64), tl_); const float step = 0.335f * sig;
                if (blockIdx.x == 0 && tl_ == 0) ((float*)(ws + WS_RSTD))[T] = step;
                cvt_i4_slices(peer_u, U8, 1.0f / step, gtid_l, nthr_l); }
            {
                const float sig = table_std16(peer_v, (LAS float*)(lds + MISC_OFF + 64), tl_); const float step = 0.335f * sig;
                if (blockIdx.x == 0 && tl_ == 0) ((float*)(ws + WS_RSTD))[T + 1] = step;
                cvt_i4_slices(peer_v, V8, 1.0f / step, gtid_l, nthr_l); }
            if (!(dbg_flags & 1))
            for (size_t it = gtid_l; it < (size_t)(T / 16) * 128; it += nthr_l) {
                const int cg8 = (int)(it & 127), chunk = (int)(it >> 7), t0 = chunk * 16, col = cg8 * 8;
                f32x4 w0a = *(const f32x4*)(conv_w + col), w0b = *(const f32x4*)(conv_w + col + 4), w1a = *(const f32x4*)(conv_w + 1024 + col), w1b = *(const f32x4*)(conv_w + 1024 + col + 4),
                      w2a = *(const f32x4*)(conv_w + 2048 + col), w2b = *(const f32x4*)(conv_w + 2048 + col + 4);
                float u1[8], u2[8];
#pragma unroll
                for (int i = 0; i < 8; ++i) { u1[i] = 0.f; u2[i] = 0.f; }
                if ((t0 % SEQ) != 0) {
                    const v4u c1 = *(const v4u*)(CC + (size_t)(t0 - 1) * 1024 + col), x1v = *(const v4u*)(CX + (size_t)(t0 - 1) * 1024 + col), c2 = *(const v4u*)(CC + (size_t)(t0 - 2) * 1024 + col), x2v = *(const v4u*)(CX + (size_t)(t0 - 2) * 1024 + col);
                    u1[0] = bflo(c1.x) * bflo(x1v.x); u1[1] = bfhi(c1.x) * bfhi(x1v.x); u1[2] = bflo(c1.y) * bflo(x1v.y); u1[3] = bfhi(c1.y) * bfhi(x1v.y); u1[4] = bflo(c1.z) * bflo(x1v.z); u1[5] = bfhi(c1.z) * bfhi(x1v.z); u1[6] = bflo(c1.w) * bflo(x1v.w); u1[7] = bfhi(c1.w) * bfhi(x1v.w);
                    u2[0] = bflo(c2.x) * bflo(x2v.x); u2[1] = bfhi(c2.x) * bfhi(x2v.x); u2[2] = bflo(c2.y) * bflo(x2v.y); u2[3] = bfhi(c2.y) * bfhi(x2v.y); u2[4] = bflo(c2.z) * bflo(x2v.z); u2[5] = bfhi(c2.z) * bfhi(x2v.z); u2[6] = bflo(c2.w) * bflo(x2v.w); u2[7] = bfhi(c2.w) * bfhi(x2v.w);
                }
                const float w0[8] = {w0a.x, w0a.y, w0a.z, w0a.w, w0b.x, w0b.y, w0b.z, w0b.w}, w1[8] = {w1a.x, w1a.y, w1a.z, w1a.w, w1b.x, w1b.y, w1b.z, w1b.w}, w2[8] = {w2a.x, w2a.y, w2a.z, w2a.w, w2b.x, w2b.y, w2b.z, w2b.w};
#pragma unroll 4
                for (int j = 0; j < 16; ++j) { const size_t ro = (size_t)(t0 + j) * 1024 + col;
                    const v4u bv = *(const v4u*)(CB + ro), cv = *(const v4u*)(CC + ro), xv = *(const v4u*)(CX + ro);
                    float u0[8], bb[8], y[8];
                    u0[0] = bflo(cv.x) * bflo(xv.x); u0[1] = bfhi(cv.x) * bfhi(xv.x); u0[2] = bflo(cv.y) * bflo(xv.y); u0[3] = bfhi(cv.y) * bfhi(xv.y); u0[4] = bflo(cv.z) * bflo(xv.z); u0[5] = bfhi(cv.z) * bfhi(xv.z); u0[6] = bflo(cv.w) * bflo(xv.w); u0[7] = bfhi(cv.w) * bfhi(xv.w);
                    bb[0] = bflo(bv.x); bb[1] = bfhi(bv.x); bb[2] = bflo(bv.y); bb[3] = bfhi(bv.y); bb[4] = bflo(bv.z); bb[5] = bfhi(bv.z); bb[6] = bflo(bv.w); bb[7] = bfhi(bv.w);
#pragma unroll
                    for (int i = 0; i < 8; ++i) { y[i] = bb[i] * (u2[i] * w0[i] + u1[i] * w1[i] + u0[i] * w2[i]); u2[i] = u1[i]; u1[i] = u0[i]; }
                    v4u o; o.x = pk2(y[0], y[1]); o.y = pk2(y[2], y[3]); o.z = pk2(y[4], y[5]); o.w = pk2(y[6], y[7]);
                    *(v4u*)(MIX + (size_t)(t0 + j) * 2048 + 1024 + col) = o; }
            }
        }
        {
#if DBG_NAIVE_ATTN
            for (int r = gw; r < NB * NH * SEQ; r += NGW) naive_attn_row(r >> 14, (r >> 11) & 7, r & 2047, Qb, Kb, Vb, MIX, subg, lam, (LAS float*)(lds + wave * 16384), lane);
            if (0)
#endif
            if (!(dbg_flags & 2))
            for (int v = vcu; v < NB * NH * 4; v += G) {
                const int bh = v >> 2, s = v & 3, b = bh >> 3, h = bh & 7;
#pragma unroll 1
                for (int i = 0; i < 4; ++i) { const int qblk = (i == 0) ? s : (i == 1) ? 7 - s : (i == 2) ? 8 + s : 15 - s;
                    att::attn_unit<0>(b, h, qblk, Qb, Kb, Vb, MIX, subg, lam, M2, (LAS char*)lds); }
            }
        }
        { int t_ = threadIdx.x; asm volatile("" : "+v"(t_)); tid = t_; lane = t_ & 63; gtid = (size_t)bx * NTHREADS + t_; }
        if (!mem_first) {
            int tl_ = threadIdx.x; asm volatile("" : "+v"(tl_)); const size_t gtid_l = (size_t)blockIdx.x * NTHREADS + tl_, nthr_l = (size_t)gridDim.x * NTHREADS;
            {
                const int wv_ = __builtin_amdgcn_readfirstlane(tl_ >> 6), gw_l = vcu * NWAVES + wv_; LAS float* scr_ = (LAS float*)(lds + wv_ * 16384); constexpr int I_SQ_ = (DM / 64) * (DM / 32);
                for (int it = gw_l; it < 2 * I_SQ_; it += G * NWAVES) { if (it < I_SQ_) p0_transpose_item(w_out, DM, DM, WtOut, scr_, it, tl_ & 63, false); else p0_transpose_item(w_q, DM, DM, WtQ, scr_, it - I_SQ_, tl_ & 63, false); } }
            {
                const float sig = table_std16(peer_u, (LAS float*)(lds + MISC_OFF + 64), tl_); const float step = 0.335f * sig;
                if (blockIdx.x == 0 && tl_ == 0) ((float*)(ws + WS_RSTD))[T] = step;
                cvt_i4_slices(peer_u, U8, 1.0f / step, gtid_l, nthr_l); }
            {
                const float sig = table_std16(peer_v, (LAS float*)(lds + MISC_OFF + 64), tl_); const float step = 0.335f * sig;
                if (blockIdx.x == 0 && tl_ == 0) ((float*)(ws + WS_RSTD))[T + 1] = step;
                cvt_i4_slices(peer_v, V8, 1.0f / step, gtid_l, nthr_l); }
            if (!(dbg_flags & 1))
            for (size_t it = gtid_l; it < (size_t)(T / 16) * 128; it += nthr_l) {
                const int cg8 = (int)(it & 127), chunk = (int)(it >> 7), t0 = chunk * 16, col = cg8 * 8;
                f32x4 w0a = *(const f32x4*)(conv_w + col), w0b = *(const f32x4*)(conv_w + col + 4), w1a = *(const f32x4*)(conv_w + 1024 + col), w1b = *(const f32x4*)(conv_w + 1024 + col + 4),
                      w2a = *(const f32x4*)(conv_w + 2048 + col), w2b = *(const f32x4*)(conv_w + 2048 + col + 4);
                float u1[8], u2[8];
#pragma unroll
                for (int i = 0; i < 8; ++i) { u1[i] = 0.f; u2[i] = 0.f; }
                if ((t0 % SEQ) != 0) {
                    const v4u c1 = *(const v4u*)(CC + (size_t)(t0 - 1) * 1024 + col), x1v = *(const v4u*)(CX + (size_t)(t0 - 1) * 1024 + col), c2 = *(const v4u*)(CC + (size_t)(t0 - 2) * 1024 + col), x2v = *(const v4u*)(CX + (size_t)(t0 - 2) * 1024 + col);
                    u1[0] = bflo(c1.x) * bflo(x1v.x); u1[1] = bfhi(c1.x) * bfhi(x1v.x); u1[2] = bflo(c1.y) * bflo(x1v.y); u1[3] = bfhi(c1.y) * bfhi(x1v.y); u1[4] = bflo(c1.z) * bflo(x1v.z); u1[5] = bfhi(c1.z) * bfhi(x1v.z); u1[6] = bflo(c1.w) * bflo(x1v.w); u1[7] = bfhi(c1.w) * bfhi(x1v.w);
                    u2[0] = bflo(c2.x) * bflo(x2v.x); u2[1] = bfhi(c2.x) * bfhi(x2v.x); u2[2] = bflo(c2.y) * bflo(x2v.y); u2[3] = bfhi(c2.y) * bfhi(x2v.y); u2[4] = bflo(c2.z) * bflo(x2v.z); u2[5] = bfhi(c2.z) * bfhi(x2v.z); u2[6] = bflo(c2.w) * bflo(x2v.w); u2[7] = bfhi(c2.w) * bfhi(x2v.w);
                }
                const float w0[8] = {w0a.x, w0a.y, w0a.z, w0a.w, w0b.x, w0b.y, w0b.z, w0b.w}, w1[8] = {w1a.x, w1a.y, w1a.z, w1a.w, w1b.x, w1b.y, w1b.z, w1b.w}, w2[8] = {w2a.x, w2a.y, w2a.z, w2a.w, w2b.x, w2b.y, w2b.z, w2b.w};
#pragma unroll 4
                for (int j = 0; j < 16; ++j) { const size_t ro = (size_t)(t0 + j) * 1024 + col;
                    const v4u bv = *(const v4u*)(CB + ro), cv = *(const v4u*)(CC + ro), xv = *(const v4u*)(CX + ro);
                    float u0[8], bb[8], y[8];
                    u0[0] = bflo(cv.x) * bflo(xv.x); u0[1] = bfhi(cv.x) * bfhi(xv.x); u0[2] = bflo(cv.y) * bflo(xv.y); u0[3] = bfhi(cv.y) * bfhi(xv.y); u0[4] = bflo(cv.z) * bflo(xv.z); u0[5] = bfhi(cv.z) * bfhi(xv.z); u0[6] = bflo(cv.w) * bflo(xv.w); u0[7] = bfhi(cv.w) * bfhi(xv.w);
                    bb[0] = bflo(bv.x); bb[1] = bfhi(bv.x); bb[2] = bflo(bv.y); bb[3] = bfhi(bv.y); bb[4] = bflo(bv.z); bb[5] = bfhi(bv.z); bb[6] = bflo(bv.w); bb[7] = bfhi(bv.w);
#pragma unroll
                    for (int i = 0; i < 8; ++i) { y[i] = bb[i] * (u2[i] * w0[i] + u1[i] * w1[i] + u0[i] * w2[i]); u2[i] = u1[i]; u1[i] = u0[i]; }
                    v4u o; o.x = pk2(y[0], y[1]); o.y = pk2(y[2], y[3]); o.z = pk2(y[4], y[5]); o.w = pk2(y[6], y[7]);
                    *(v4u*)(MIX + (size_t)(t0 + j) * 2048 + 1024 + col) = o; }
            }
        }
    }
    SEAM(2);
    if (IN(3)) REPS(3) {
        pg8::Gemm g{MIX, WtOut, T, DM, DM}; pg8::StaticOrder S; S.init(T, DM, G, bx, WGM_P3);
        pg8::EpiX1 E{x, out, A2, ffn_g, SSQ, ws + WS_H8};
        pg8::gemm_phase<pg8::EpiX1, pg8::StaticOrder, true, true>(lds, g, S, E);
    }
    SEAM(3);
    if (IN(4)) REPS(4) {
        pg8::Gemm g{A2, WtQ, T, DM, DM}; pg8::StaticOrder S; S.init(T, DM, G, bx, WGM_P3);
        pg8::EpiBf16<0> E{QP, DM, nullptr, 0, 0, 1.f};
        pg8::gemm_phase<pg8::EpiBf16<0>, pg8::StaticOrder, true, true>(lds, g, S, E);
    }
    SEAM(4);
    if (IN(5)) REPS(5) {
        if (tid < 64) {
            int n = tid, i = 0;
#pragma unroll 1
            for (; i < 16; ++i) { const int len = 16 / (i + 1); if (n < len) break; n -= len; }
            ((LAS unsigned char*)(lds + P5_TAB_OFF))[tid] = (unsigned char)(i < 16 ? ((i << 4) | n) : 0);
        }
        int cur_h = -1;
        for (int it = vcu; it < (T / 128) * PEH; it += G) { const int h = it & 7;
            if (h != cur_h) {
                __syncthreads();
                for (int i = tid; i < 4096; i += NTHREADS) { const int ch = i & 15, key = (i >> 4) & 127, c = i >> 11;
                    *(LAS v4u*)(lds + c * 32768 + ch * 2048 + key * 16) = *(const v4u*)(SK + (size_t)((h * 2 + c) * 128 + key) * 128 + ch * 8); }
                cur_h = h; __syncthreads(); }
            peer_topk_item(it >> 3, h, QP, SSQ, EIDX, EGATE, RSTD, (LAS char*)lds); }
    }
    SEAM(5);
    if (IN(6)) {
        float* PART = (float*)(ws + WS_PART);
        const int tstride = (G >> 3) * NWAVES, nper = (T + tstride - 1) / tstride;
        peer_u_stage(nper, (bx >> 3) * NWAVES + wave, tstride, bx & 7, ws + WS_H8, U8, EIDX, PART, lane);
    }
    SEAM(6);
    if (IN(7)) {
        const float* PART = (const float*)(ws + WS_PART); unsigned* ACTQ = (unsigned*)(ws + WS_ACT); float* ASC = (float*)(ws + WS_ACT + 4 * MiB);
        const float ustep = RSTD[T] * (1.0f / H8_SCALE), vstep = RSTD[T + 1];
        for (int tp = gw; tp < T / 2; tp += NGW) { const int t = 2 * tp + (lane >> 5), k4 = 4 * (lane & 31);
            f32x4 z = (f32x4){0.f, 0.f, 0.f, 0.f};
#pragma unroll
            for (int s = 0; s < 8; ++s) z += *(const f32x4*)(PART + ((size_t)s * T + t) * 128 + k4);
            z *= RSTD[t] * ustep;
            const f32x4 gt = *(const f32x4*)(EGATE + (size_t)t * 128 + k4);
            f32x4 a; float am = 0.f;
#pragma unroll
            for (int i = 0; i < 4; ++i) { a[i] = 0.5f * z[i] * (1.0f + erff(z[i] * 0.70710678118654752f)) * gt[i]; am = fmaxf(am, fabsf(a[i])); }
            am = fmaxf(am, DPPF(am, 0xB1)); am = fmaxf(am, DPPF(am, 0x4E)); am = fmaxf(am, DPPF(am, 0x124)); am = fmaxf(am, DPPF(am, 0x128));
            { const auto r_ = __builtin_amdgcn_permlane16_swap(__float_as_uint(am), __float_as_uint(am), false, false); am = fmaxf(__uint_as_float(r_[0]), __uint_as_float(r_[1])); }
            const float asc = am > 0.f ? am * (1.0f / 127.0f) : 1.0f, inv = 1.0f / asc; unsigned w = 0u;
#pragma unroll
            for (int i = 0; i < 4; ++i) { const int q = (int)__builtin_rintf(a[i] * inv); w |= ((unsigned)q & 0xffu) << (8 * i); }
            ACTQ[(size_t)t * 32 + (lane & 31)] = w;
            if ((lane & 31) == 0) ASC[t] = asc * vstep; }
    }
    SEAM(7);
    if (IN(8)) {
        const unsigned* ACTQ = (const unsigned*)(ws + WS_ACT); const float* ASC = (const float*)(ws + WS_ACT + 4 * MiB);
        const int tstride = (G >> 3) * NWAVES, nper = (T + tstride - 1) / tstride;
        peer_v_stage<0>(nper, (bx >> 3) * NWAVES + wave, tstride, bx & 7, V8, EIDX, ACTQ, ASC, A2, ffn_g, out, lane);
    }
#undef IN
#undef SEAM
}


#ifdef DBG_ABL
__global__ void __launch_bounds__(NTHREADS, 2) attn_probe(Args args) {
    extern __shared__ __attribute__((aligned(16))) unsigned char lds_raw[];
    LAS unsigned char* lds = (LAS unsigned char*)lds_raw;
    const int tid = threadIdx.x, lane = tid & 63; const int G = gridDim.x, bx = blockIdx.x;
    const int vcu = (G % 8 == 0) ? (bx % 8) * (G / 8) + bx / 8 : bx;
    unsigned char* ws = args.ws;
    const float* qg = args.in[3]; const float* kg = args.in[4]; const float* lq1 = args.in[5]; const float* lk1 = args.in[6]; const float* lq2 = args.in[7]; const float* lk2 = args.in[8]; const float* subg = args.in[9];
    bf16* Qb = (bf16*)(ws + WS_Q); bf16* Kb = (bf16*)(ws + WS_K); bf16* Vb = (bf16*)(ws + WS_V); bf16* MIX2 = (bf16*)(ws + 448 * MiB);
    float a = lq1[lane] * lk1[lane], b2 = lq2[lane] * lk2[lane]; a = wave_sum(a); b2 = wave_sum(b2);
    const float lam = expf(a) - expf(b2) + 0.2f; const float mq = wave_max(fabsf(qg[lane])), mk = wave_max(fabsf(kg[lane])); const float M2 = 64.f * C2 * mq * mk;
    for (int v = vcu; v < NB * NH * 4; v += G) { const int bh = v >> 2, s = v & 3, b = bh >> 3, h = bh & 7;
#pragma unroll 1
        for (int i = 0; i < 4; ++i) { const int qblk = (i == 0) ? s : (i == 1) ? 7 - s : (i == 2) ? 8 + s : 15 - s;
            att::attn_unit<DBG_ABL>(b, h, qblk, Qb, Kb, Vb, MIX2, subg, lam, M2, (LAS char*)lds); } }
}
#endif


#ifdef DBG_ABLV
__global__ void __launch_bounds__(NTHREADS, 2) pv_probe(Args args) {
    const int tid = threadIdx.x, lane = tid & 63, wave = __builtin_amdgcn_readfirstlane(tid >> 6); const int G = gridDim.x, bx = blockIdx.x;
    unsigned char* ws = args.ws;
    const unsigned* ACTQ = (const unsigned*)(ws + WS_ACT); const float* ASC = (const float*)(ws + WS_ACT + 4 * MiB);
    const int tstride = (G >> 3) * NWAVES, nper = (T + tstride - 1) / tstride;
    peer_v_stage<DBG_ABLV>(nper, (bx >> 3) * NWAVES + wave, tstride, bx & 7, ws + WS_VT, (const int*)(ws + WS_EIDX), ACTQ, ASC, (const bf16*)(ws + WS_CB), args.in[12], (float*)(ws + WS_PART), lane);
}
#endif

extern "C" void kernel_launch(void* const* d_in, const int* in_sizes, int n_in, void* d_out, int out_size, void* d_ws, size_t ws_size, hipStream_t stream) {
    static int grid = 0;
    if (grid == 0) {
        if (n_in != 17 || out_size != T * DM || ws_size < WS_END) { fprintf(stderr, "kernel_launch: unexpected shapes (n_in %d out %d ws %zu)\n", n_in, out_size, ws_size); grid = -1; return; }
        int dev = 0, cus = 0, per_cu = 0;
        if (hipGetDevice(&dev) != hipSuccess || hipDeviceGetAttribute(&cus, hipDeviceAttributeMultiprocessorCount, dev) != hipSuccess) { grid = -1; return; }
        if (hipFuncSetAttribute((const void*)mk_fwd, hipFuncAttributeMaxDynamicSharedMemorySize, LDS_BYTES) != hipSuccess) { fprintf(stderr, "kernel_launch: hipFuncSetAttribute failed\n"); grid = -1; return; }
        if (hipOccupancyMaxActiveBlocksPerMultiprocessor(&per_cu, (const void*)mk_fwd, NTHREADS, LDS_BYTES) != hipSuccess || per_cu < 1) { fprintf(stderr, "kernel_launch: occupancy query says %d blocks per CU\n", per_cu); (void)hipGetLastError(); grid = -1; return; }
        grid = cus;
    }
    if (grid < 0) return;
    if (hipMemsetAsync((char*)d_ws + WS_CTL, 0, CTL_ZERO_BYTES, stream) != hipSuccess) { fprintf(stderr, "kernel_launch: memset failed\n"); return; }
    Args a{};
    for (int i = 0; i < 17; ++i) a.in[i] = (const float*)d_in[i];
    a.out = (float*)d_out; a.ws = (unsigned char*)d_ws;
#if MK_N_LAUNCHES == 1
    a.ph_lo = 0; a.ph_hi = NPHASE;
    void* kargs[] = {&a};
    hipError_t e = hipLaunchCooperativeKernel((const void*)mk_fwd, dim3(grid), dim3(NTHREADS), kargs, LDS_BYTES, stream);
    if (e != hipSuccess) fprintf(stderr, "kernel_launch: cooperative launch failed: %s (grid %d)\n", hipGetErrorString(e), grid);
#else
#ifndef DBG_DUPL
#define DBG_DUPL -1
#endif
#ifndef DBG_DUPFLAGS
#define DBG_DUPFLAGS 0
#endif
    for (int p = 0; p < NPHASE; ++p) { a.ph_lo = p; for (int r = 0; r < (p == DBG_DUPL ? 2 : 1); ++r) { a.ph_hi = (p + 1) | ((r == 1 ? DBG_DUPFLAGS : 0) << 8); hipLaunchKernelGGL(mk_fwd, dim3(grid), dim3(NTHREADS), LDS_BYTES, stream, a); }
#ifdef DBG_ABLV
        if (p == 8) hipLaunchKernelGGL(pv_probe, dim3(grid), dim3(NTHREADS), 0, stream, a);
#endif
#ifdef DBG_ABL
        if (p == 2 && ws_size >= 512 * MiB) { static bool once = false; if (!once) { once = true; (void)hipFuncSetAttribute((const void*)attn_probe, hipFuncAttributeMaxDynamicSharedMemorySize, LDS_BYTES); } hipLaunchKernelGGL(attn_probe, dim3(grid), dim3(NTHREADS), LDS_BYTES, stream, a); }
#endif
    }
#endif
}
```
